# Optimizing an MI355X kernel written in HIP

```python
import math
import jax, jax.numpy as jnp
from jax import lax
import numpy as np

D_MODEL = 1024
BATCH = 8
SEQ = 4096
DEPTH = 1

GRID_W = 64
CTX_LEN = 256
D_MIX = D_MODEL
D_S5 = D_MIX // 2
S5_GROUP = 16
S5_GROUPS = D_S5 // S5_GROUP
S5_STATE = 64
D_FOURIER = D_MIX - D_S5
FOURIER_GROUPS = 4
FOURIER_GROUP = D_FOURIER // FOURIER_GROUPS
N_EXPERT_GROUPS = 4
EXPERTS_PER_GROUP = 8
N_EXPERTS = N_EXPERT_GROUPS * EXPERTS_PER_GROUP
TOP_K_INNER = 2
D_EXPERT = D_MODEL // 4
EPS = 1e-6
DT_MIN = 1e-3
DT_MAX = 1e-1

kernel_name = "hymba_s5_fnet_hmoe_prefix_block"


def rms_norm(x, g):
    xf = x.astype(jnp.float32)
    y = xf * lax.rsqrt(jnp.mean(xf * xf, axis=-1, keepdims=True) + EPS)
    return (y * g.astype(jnp.float32)).astype(x.dtype)


def adaln(cond, w, b):
    m = jax.nn.silu(cond) @ w + b
    return [p[:, None, :] for p in jnp.split(m, 6, axis=-1)]


def modulate(h, shift, scale):
    return h * (1.0 + scale) + shift


def to_lbgh(u):
    b, l, _ = u.shape
    return u.reshape(b, l, S5_GROUPS, S5_GROUP).transpose(1, 0, 2, 3)


def s5_discretize(lam_re, lam_im, b_re, b_im, log_step):
    f32 = jnp.float32
    dt = jnp.exp(log_step.astype(f32))[:, None]
    lr, li = lam_re.astype(f32), lam_im.astype(f32)
    mag = jnp.exp(lr * dt)
    abar_re, abar_im = mag * jnp.cos(li * dt), mag * jnp.sin(li * dt)
    den = lr * lr + li * li
    nr, ni = abar_re - 1.0, abar_im
    q_re = (nr * lr + ni * li) / den
    q_im = (ni * lr - nr * li) / den
    br, bi = b_re.astype(f32), b_im.astype(f32)
    bbar_re = q_re[..., None] * br - q_im[..., None] * bi
    bbar_im = q_re[..., None] * bi + q_im[..., None] * br
    return abar_re, abar_im, bbar_re, bbar_im


def _linear_recurrence_combine(e1, e2):
    a1r, a1i, b1r, b1i = e1
    a2r, a2i, b2r, b2i = e2
    return (a2r * a1r - a2i * a1i,
            a2r * a1i + a2i * a1r,
            a2r * b1r - a2i * b1i + b2r,
            a2r * b1i + a2i * b1r + b2i)


def s5_scan(u, disc, h0_re, h0_im, reverse):
    abar_re, abar_im, bbar_re, bbar_im = disc
    bu_re = jnp.einsum('lbgh,gph->lbgp', u, bbar_re)
    bu_im = jnp.einsum('lbgh,gph->lbgp', u, bbar_im)
    first = -1 if reverse else 0
    bu_re = bu_re.at[first].add(abar_re * h0_re - abar_im * h0_im)
    bu_im = bu_im.at[first].add(abar_re * h0_im + abar_im * h0_re)
    n = u.shape[0]
    a_re = jnp.broadcast_to(abar_re, (n, 1) + abar_re.shape)
    a_im = jnp.broadcast_to(abar_im, (n, 1) + abar_im.shape)
    _, _, h_re, h_im = lax.associative_scan(
        _linear_recurrence_combine, (a_re, a_im, bu_re, bu_im), reverse=reverse, axis=0)
    return h_re, h_im


def s5_bidirectional(u, lp, h0, need_output):
    y = None
    finals = []
    for d, reverse in enumerate((False, True)):
        disc = s5_discretize(lp["lam_re"][d], lp["lam_im"][d], lp["b_re"][d],
                             lp["b_im"][d], lp["log_step"][d])
        h_re, h_im = s5_scan(u, disc, h0[d][0], h0[d][1], reverse)
        last = 0 if reverse else -1
        finals.append((h_re[last], h_im[last]))
        if need_output:
            yd = (jnp.einsum('lbgp,ghp->lbgh', h_re, lp["c_re"][d].astype(jnp.float32))
                  - jnp.einsum('lbgp,ghp->lbgh', h_im, lp["c_im"][d].astype(jnp.float32)))
            y = yd if y is None else y + yd
    return y, finals


def fourier_mixer(v, w_four):
    b, l, _ = v.shape
    vg = v.reshape(b, l, FOURIER_GROUPS, FOURIER_GROUP).astype(jnp.float32)
    f = jnp.fft.fft2(vg, axes=(1, 3), norm="ortho").real.astype(v.dtype)
    return jnp.einsum('blgc,gcd->blgd', f, w_four).reshape(b, l, D_FOURIER)


def mixer_inputs(h_stream, shift, scale, lp):
    h = modulate(rms_norm(h_stream, lp["norm1_g"]), shift, scale)
    z = h @ lp["w_in"]
    return to_lbgh(z[..., :D_S5]), z[..., D_S5:]


def mixer_output(y_s5, u, v, lp):
    b, l = v.shape[0], v.shape[1]
    y = y_s5 + lp["s5_d"].reshape(S5_GROUPS, S5_GROUP) * u
    y = y.transpose(1, 0, 2, 3).reshape(b, l, D_S5).astype(v.dtype)
    y = jax.nn.gelu(y)
    y = y * jax.nn.sigmoid(y @ lp["s5_w_glu"])
    f = fourier_mixer(v, lp["fourier_w"])
    merged = jnp.concatenate([rms_norm(y, lp["mix_norm_s5_g"]),
                              rms_norm(f, lp["mix_norm_f_g"])], axis=-1)
    return merged @ lp["w_out"]


def hmoe(h, lp):
    def per_sample(t):
        f32 = jnp.float32
        g_logits = (t @ lp["w_group"] + lp["b_group"]).astype(f32)
        g_prob = jax.nn.softmax(g_logits, axis=-1)
        g_w, g_idx = lax.top_k(g_prob, 1)
        e_logits = (jnp.einsum('td,dge->tge', t, lp["w_router"]) + lp["b_router"]).astype(f32)
        sel = jax.nn.one_hot(g_idx[:, 0], N_EXPERT_GROUPS, dtype=f32)
        e_sel = jnp.sum(e_logits * sel[:, :, None], axis=1)
        top_v, top_i = lax.top_k(e_sel, TOP_K_INNER)
        weights = g_w * jax.nn.softmax(top_v, axis=-1)
        expert_id = g_idx * EXPERTS_PER_GROUP + top_i
        gates = jnp.sum(jax.nn.one_hot(expert_id, N_EXPERTS, dtype=f32) * weights[..., None], axis=1)
        hg = jnp.einsum('td,edf->tef', t, lp["w_gate"])
        hu = jnp.einsum('td,edf->tef', t, lp["w_up"])
        a = jax.nn.silu(hg) * hu * gates[..., None].astype(t.dtype)
        return jnp.einsum('tef,efd->td', a, lp["w_down"])
    return lax.map(per_sample, h)


def setup_inputs(seed: int = 0) -> dict:
    key = jax.random.key(seed)
    ks = jax.random.split(key, 30)
    f32 = jnp.float32

    def nrm(k, shape, s):
        return s * jax.random.normal(k, shape, f32)

    G, P, H = S5_GROUPS, S5_STATE, S5_GROUP
    lam_im0 = math.pi * jnp.arange(P, dtype=f32)
    return {
        "x": nrm(ks[0], (BATCH, SEQ, D_MODEL), 1.0),
        "c": nrm(ks[1], (BATCH, D_MODEL), 1.0),
        "ctx": nrm(ks[2], (BATCH, CTX_LEN, D_MODEL), 1.0),
        "c_ctx": nrm(ks[3], (D_MODEL,), 1.0),
        "w_ada": nrm(ks[4], (DEPTH, D_MODEL, 6 * D_MODEL), 0.5 * D_MODEL ** -0.5),
        "b_ada": nrm(ks[5], (DEPTH, 6 * D_MODEL), 0.02),
        "norm1_g": 1.0 + nrm(ks[6], (DEPTH, D_MODEL), 0.02),
        "norm2_g": 1.0 + nrm(ks[7], (DEPTH, D_MODEL), 0.02),
        "w_in": nrm(ks[8], (DEPTH, D_MODEL, D_MIX), D_MODEL ** -0.5),
        "s5_lam_re": -0.5 + nrm(ks[9], (DEPTH, 2, G, P), 0.01),
        "s5_lam_im": lam_im0 + nrm(ks[10], (DEPTH, 2, G, P), 0.01),
        "s5_b_re": nrm(ks[11], (DEPTH, 2, G, P, H), (2.0 * H) ** -0.5),
        "s5_b_im": nrm(ks[12], (DEPTH, 2, G, P, H), (2.0 * H) ** -0.5),
        "s5_c_re": nrm(ks[13], (DEPTH, 2, G, H, P), (2.0 * P) ** -0.5),
        "s5_c_im": nrm(ks[14], (DEPTH, 2, G, H, P), (2.0 * P) ** -0.5),
        "s5_log_step": jax.random.uniform(ks[15], (DEPTH, 2, G), f32,
                                          math.log(DT_MIN), math.log(DT_MAX)),
        "s5_d": nrm(ks[16], (DEPTH, D_S5), 1.0),
        "s5_w_glu": nrm(ks[17], (DEPTH, D_S5, D_S5), D_S5 ** -0.5),
        "fourier_w": nrm(ks[18], (DEPTH, FOURIER_GROUPS, FOURIER_GROUP, FOURIER_GROUP),
                          FOURIER_GROUP ** -0.5),
        "mix_norm_s5_g": 1.0 + nrm(ks[19], (DEPTH, D_S5), 0.02),
        "mix_norm_f_g": 1.0 + nrm(ks[20], (DEPTH, D_FOURIER), 0.02),
        "w_out": nrm(ks[21], (DEPTH, D_MIX, D_MODEL), D_MIX ** -0.5),
        "moe_w_group": nrm(ks[22], (DEPTH, D_MODEL, N_EXPERT_GROUPS), D_MODEL ** -0.5),
        "moe_b_group": nrm(ks[23], (DEPTH, N_EXPERT_GROUPS), 0.01),
        "moe_w_router": nrm(ks[24], (DEPTH, D_MODEL, N_EXPERT_GROUPS, EXPERTS_PER_GROUP),
                             D_MODEL ** -0.5),
        "moe_b_router": nrm(ks[25], (DEPTH, N_EXPERT_GROUPS, EXPERTS_PER_GROUP), 0.01),
        "moe_w_gate": nrm(ks[26], (DEPTH, N_EXPERTS, D_MODEL, D_EXPERT), D_MODEL ** -0.5),
        "moe_w_up": nrm(ks[27], (DEPTH, N_EXPERTS, D_MODEL, D_EXPERT), D_MODEL ** -0.5),
        "moe_w_down": nrm(ks[28], (DEPTH, N_EXPERTS, D_EXPERT, D_MODEL), D_EXPERT ** -0.5),
        "final_norm_g": 1.0 + nrm(ks[29], (D_MODEL,), 0.02),
    }


def reference(x, c, ctx, c_ctx, w_ada, b_ada, norm1_g, norm2_g, w_in,
              s5_lam_re, s5_lam_im, s5_b_re, s5_b_im, s5_c_re, s5_c_im, s5_log_step,
              s5_d, s5_w_glu, fourier_w, mix_norm_s5_g, mix_norm_f_g, w_out,
              moe_w_group, moe_b_group, moe_w_router, moe_b_router,
              moe_w_gate, moe_w_up, moe_w_down, final_norm_g):
    n_lat = x.shape[1]
    rows = n_lat // GRID_W
    assert rows * GRID_W == n_lat
    batch = x.shape[0]
    ctx_h = ctx
    for layer in range(DEPTH):
        last = layer == DEPTH - 1
        lp = {
            "norm1_g": norm1_g[layer], "norm2_g": norm2_g[layer], "w_in": w_in[layer],
            "lam_re": s5_lam_re[layer], "lam_im": s5_lam_im[layer],
            "b_re": s5_b_re[layer], "b_im": s5_b_im[layer],
            "c_re": s5_c_re[layer], "c_im": s5_c_im[layer],
            "log_step": s5_log_step[layer], "s5_d": s5_d[layer], "s5_w_glu": s5_w_glu[layer],
            "fourier_w": fourier_w[layer], "mix_norm_s5_g": mix_norm_s5_g[layer],
            "mix_norm_f_g": mix_norm_f_g[layer], "w_out": w_out[layer],
            "w_group": moe_w_group[layer], "b_group": moe_b_group[layer],
            "w_router": moe_w_router[layer], "b_router": moe_b_router[layer],
            "w_gate": moe_w_gate[layer], "w_up": moe_w_up[layer], "w_down": moe_w_down[layer],
        }
        sh1, sc1, g1, sh2, sc2, g2 = adaln(c, w_ada[layer], b_ada[layer])
        csh1, csc1, cg1, csh2, csc2, cg2 = adaln(c_ctx[None, :], w_ada[layer], b_ada[layer])

        u_c, v_c = mixer_inputs(ctx_h, csh1, csc1, lp)
        zero = jnp.zeros((batch, S5_GROUPS, S5_STATE), jnp.float32)
        y_c, ctx_finals = s5_bidirectional(u_c, lp, ((zero, zero), (zero, zero)),
                                           need_output=not last)

        u_x, v_x = mixer_inputs(x, sh1, sc1, lp)
        y_x, _ = s5_bidirectional(u_x, lp, ctx_finals, need_output=True)
        x = x + g1 * mixer_output(y_x, u_x, v_x, lp)
        x = x + g2 * hmoe(modulate(rms_norm(x, lp["norm2_g"]), sh2, sc2), lp)

        if not last:
            ctx_h = ctx_h + cg1 * mixer_output(y_c, u_c, v_c, lp)
            ctx_h = ctx_h + cg2 * hmoe(modulate(rms_norm(ctx_h, lp["norm2_g"]), csh2, csc2), lp)
    return rms_norm(x, final_norm_g)
```

```cpp
#include <hip/hip_runtime.h>
#include <cstdio>
#include <cstdint>

typedef unsigned short bf16;
typedef short bf16x8 __attribute__((ext_vector_type(8)));
typedef short bf16x4 __attribute__((ext_vector_type(4)));
typedef float f32x4 __attribute__((ext_vector_type(4)));
typedef unsigned u32x4 __attribute__((ext_vector_type(4)));
typedef unsigned u32x2 __attribute__((ext_vector_type(2)));
typedef __bf16 bf16v2 __attribute__((ext_vector_type(2)));
#define DI __device__ __forceinline__

constexpr int D = 1024, NB = 8, L = 4096, CTX = 256, NTOK = NB * L, NCTX = NB * CTX, NROWS1 = NTOK + NCTX;
constexpr int NEXP = 32, DE = 256;
constexpr float EPS = 1e-6f;
constexpr int NT = 512;

constexpr size_t MiB = 1u << 20;
constexpr size_t WS_CTL = 0;
constexpr size_t CTL_BYTES = 1 * MiB;
constexpr size_t CTL_ZERO = 4096;
constexpr size_t CTL_ECNT = 8192;
constexpr size_t CTL_PCNT = 8192 + 256;
constexpr size_t CTL_RSQ1 = 256 * 1024;
constexpr size_t CTL_RSQ2 = 384 * 1024;
constexpr size_t WS_MOD = 1 * MiB;
constexpr size_t WS_TILES = WS_MOD + 256 * 1024;
constexpr size_t WS_ABART = WS_TILES + 64 * 1024;
constexpr size_t WS_FFTC = 2 * MiB;
constexpr size_t WS_GW = 3 * MiB;
constexpr size_t WS_WINT = 4 * MiB;
constexpr size_t WS_WGLUT = 7 * MiB;
constexpr size_t WS_WOUTT = 8 * MiB;
constexpr size_t WS_WGUT = 10 * MiB;
constexpr size_t WS_WDT = 42 * MiB;
constexpr size_t WS_MG = 58 * MiB;
constexpr size_t WS_WST = 74 * MiB;
constexpr size_t WS_WOS = 82 * MiB;
constexpr size_t WS_ELIST = 90 * MiB;
constexpr size_t WS_PLIST = 94 * MiB;
constexpr size_t WS_R1 = 108 * MiB;
constexpr size_t WS_R2 = 176 * MiB;
constexpr size_t WS_R3 = 240 * MiB;
constexpr size_t WS_R4 = 274 * MiB;
constexpr size_t WS_R5 = 306 * MiB;
constexpr size_t WS_END = 338 * MiB;

struct Params {
    const float *x, *c, *ctx, *c_ctx, *w_ada, *b_ada, *norm1_g, *norm2_g, *w_in;
    const float *lam_re, *lam_im, *b_re, *b_im, *c_re, *c_im, *log_step, *s5_d, *w_glu, *fourier_w, *g_s, *g_f, *w_out;
    const float *w_group, *b_group, *w_router, *b_router, *w_gate, *w_up, *w_down, *final_g;
    float* out; unsigned char* ws;
};

DI unsigned pk2(float lo, float hi) { bf16v2 v; v.x = (__bf16)lo; v.y = (__bf16)hi; return __builtin_bit_cast(unsigned, v); }
DI float bf2f(unsigned short b) { return __uint_as_float(((unsigned)b) << 16); }
DI float wave_sum(float v) {
#pragma unroll
    for (int o = 1; o < 64; o <<= 1) v += __shfl_xor(v, o);
    return v;
}
DI float sigmoidf_(float x) { return 1.f / (1.f + __expf(-x)); }
DI float siluf_(float x) { return x / (1.f + __expf(-x)); }
DI float geluf_(float x) { const float u = 0.7978845608028654f * (x + 0.044715f * x * x * x); return x / (1.f + __expf(-2.f * u)); }

template <int MT> struct GC {
    static constexpr int BM = 64 * MT, PA = MT, ABYTES = BM * 128, BBYTES = 128 * 128, BUF = ABYTES + BBYTES, LDS = 2 * BUF;
};
template <int MT>
DI void gemm_loop(f32x4 (&acc)[MT][4], const bf16* (&ap)[MT], const int (&as)[MT], const bf16* (&bp)[2], int nk, unsigned char* lds) {
    typedef GC<MT> G;
    const int tid = threadIdx.x, lane = tid & 63, wid = tid >> 6, wm = wid >> 1, wn = wid & 1, fr = lane & 15, fq = lane >> 4;
    const int srow = tid >> 3, sck = tid & 7;
    const int soff = srow * 128 + ((sck ^ (srow & 7)) << 4);
    u32x4 ra[MT], rb[2];
#pragma unroll
    for (int i = 0; i < MT; ++i) ra[i] = *(const u32x4*)(ap[i]);
#pragma unroll
    for (int i = 0; i < 2; ++i) rb[i] = *(const u32x4*)(bp[i]);
#pragma unroll
    for (int i = 0; i < MT; ++i) *(u32x4*)(lds + i * 8192 + soff) = ra[i];
#pragma unroll
    for (int i = 0; i < 2; ++i) *(u32x4*)(lds + G::ABYTES + i * 8192 + soff) = rb[i];
    __syncthreads();
    const int aro = (wm * MT * 16 + fr) * 128, bro = (wn * 64 + fr) * 128;
    const int sw0 = ((0 + fq) ^ (fr & 7)) << 4, sw1 = ((4 + fq) ^ (fr & 7)) << 4;
    for (int kt = 0; kt < nk; ++kt) {
        const bool more = kt + 1 < nk;
        if (more) {
#pragma unroll
            for (int i = 0; i < MT; ++i) ra[i] = *(const u32x4*)(ap[i] + (size_t)(kt + 1) * as[i]);
#pragma unroll
            for (int i = 0; i < 2; ++i) rb[i] = *(const u32x4*)(bp[i] + (size_t)(kt + 1) * 64);
        }
        const unsigned char* Ab = lds + (kt & 1) * G::BUF; const unsigned char* Bb = Ab + G::ABYTES;
#pragma unroll
        for (int kk = 0; kk < 2; ++kk) {
            const int sw = kk ? sw1 : sw0;
            bf16x8 af[MT], bfr[4];
#pragma unroll
            for (int mt = 0; mt < MT; ++mt) af[mt] = *(const bf16x8*)(Ab + aro + mt * 2048 + sw);
#pragma unroll
            for (int nt = 0; nt < 4; ++nt) bfr[nt] = *(const bf16x8*)(Bb + bro + nt * 2048 + sw);
#pragma unroll
            for (int mt = 0; mt < MT; ++mt)
#pragma unroll
                for (int nt = 0; nt < 4; ++nt) acc[mt][nt] = __builtin_amdgcn_mfma_f32_16x16x32_bf16(bfr[nt], af[mt], acc[mt][nt], 0, 0, 0);
        }
        if (more) {
            unsigned char* nb = lds + ((kt + 1) & 1) * G::BUF;
#pragma unroll
            for (int i = 0; i < MT; ++i) *(u32x4*)(nb + i * 8192 + soff) = ra[i];
#pragma unroll
            for (int i = 0; i < 2; ++i) *(u32x4*)(nb + G::ABYTES + i * 8192 + soff) = rb[i];
        }
        __syncthreads();
    }
}
template <int MT>
DI void gemm_loop_alds(f32x4 (&acc)[MT][4], const unsigned char* abase, int apitch, const bf16* (&bp)[2], int nk, unsigned char* lds) {
    typedef GC<MT> G;
    const int tid = threadIdx.x, lane = tid & 63, wid = tid >> 6, wm = wid >> 1, wn = wid & 1, fr = lane & 15, fq = lane >> 4;
    const int srow = tid >> 3, sck = tid & 7;
    const int soff = srow * 128 + ((sck ^ (srow & 7)) << 4);
    u32x4 rb[2];
#pragma unroll
    for (int i = 0; i < 2; ++i) rb[i] = *(const u32x4*)(bp[i]);
#pragma unroll
    for (int i = 0; i < 2; ++i) *(u32x4*)(lds + G::ABYTES + i * 8192 + soff) = rb[i];
    __syncthreads();
    const int bro = (wn * 64 + fr) * 128;
    const int sw0 = ((0 + fq) ^ (fr & 7)) << 4, sw1 = ((4 + fq) ^ (fr & 7)) << 4;
    const unsigned char* arow = abase + (size_t)(wm * MT * 16 + fr) * apitch + fq * 16;
    for (int kt = 0; kt < nk; ++kt) {
        const bool more = kt + 1 < nk;
        if (more) {
#pragma unroll
            for (int i = 0; i < 2; ++i) rb[i] = *(const u32x4*)(bp[i] + (size_t)(kt + 1) * 64);
        }
        const unsigned char* Bb = lds + (kt & 1) * G::BUF + G::ABYTES;
#pragma unroll
        for (int kk = 0; kk < 2; ++kk) {
            const int sw = kk ? sw1 : sw0;
            bf16x8 af[MT], bfr[4];
#pragma unroll
            for (int mt = 0; mt < MT; ++mt) af[mt] = *(const bf16x8*)(arow + (size_t)mt * 16 * apitch + kt * 128 + kk * 64);
#pragma unroll
            for (int nt = 0; nt < 4; ++nt) bfr[nt] = *(const bf16x8*)(Bb + bro + nt * 2048 + sw);
#pragma unroll
            for (int mt = 0; mt < MT; ++mt)
#pragma unroll
                for (int nt = 0; nt < 4; ++nt) acc[mt][nt] = __builtin_amdgcn_mfma_f32_16x16x32_bf16(bfr[nt], af[mt], acc[mt][nt], 0, 0, 0);
        }
        if (more) {
            unsigned char* nb = lds + ((kt + 1) & 1) * G::BUF;
#pragma unroll
            for (int i = 0; i < 2; ++i) *(u32x4*)(nb + G::ABYTES + i * 8192 + soff) = rb[i];
        }
        __syncthreads();
    }
}
template <int MT> DI void zero_acc(f32x4 (&acc)[MT][4]) {
#pragma unroll
    for (int m = 0; m < MT; ++m)
#pragma unroll
        for (int n = 0; n < 4; ++n) acc[m][n] = (f32x4){0.f, 0.f, 0.f, 0.f};
}

DI void adaln_item(const Params& p, unsigned char* lds, int item) {
    float* scond = (float*)lds;
    float* red = scond + 9 * 1024;
    const int tid = threadIdx.x;
    for (int i = tid; i < 9 * 1024; i += NT) { const int r = i >> 10, k = i & 1023; const float v = r < 8 ? p.c[r * 1024 + k] : p.c_ctx[k]; scond[i] = v / (1.f + __expf(-v)); }
    __syncthreads();
    const int cc = tid & 63, ks = tid >> 6, col = item * 64 + cc;
    float a[9];
#pragma unroll
    for (int r = 0; r < 9; ++r) a[r] = 0.f;
    for (int k = ks * 128; k < ks * 128 + 128; ++k) {
        const float w = p.w_ada[(size_t)k * 6144 + col];
#pragma unroll
        for (int r = 0; r < 9; ++r) a[r] += scond[r * 1024 + k] * w;
    }
#pragma unroll
    for (int r = 0; r < 9; ++r) red[(ks * 9 + r) * 64 + cc] = a[r];
    __syncthreads();
    float* mod = (float*)(p.ws + WS_MOD);
    for (int o = tid; o < 9 * 64; o += NT) { const int r = o >> 6, c2 = o & 63; float s = 0.f;
#pragma unroll
        for (int q = 0; q < 8; ++q) s += red[(q * 9 + r) * 64 + c2];
        mod[r * 6144 + item * 64 + c2] = s + p.b_ada[item * 64 + c2]; }
    __syncthreads();
}
DI void tp_tile(const float* src, int ld, int k0, int n0, unsigned char* lds, bf16* dst, long row_stride_unused, int jobkind, int e) {
    float* tile = (float*)lds;
    const int tid = threadIdx.x;
    { const int nn = tid & 63, kk0 = tid >> 6;
#pragma unroll
      for (int i = 0; i < 8; ++i) { const int kk = kk0 + 8 * i; tile[kk * 65 + nn] = src[(size_t)(k0 + kk) * ld + n0 + nn]; } }
    __syncthreads();
    { const int n = tid >> 3, kc = tid & 7; const int ng = n0 + n;
      u32x4 o;
      o.x = pk2(tile[(kc * 8 + 0) * 65 + n], tile[(kc * 8 + 1) * 65 + n]); o.y = pk2(tile[(kc * 8 + 2) * 65 + n], tile[(kc * 8 + 3) * 65 + n]);
      o.z = pk2(tile[(kc * 8 + 4) * 65 + n], tile[(kc * 8 + 5) * 65 + n]); o.w = pk2(tile[(kc * 8 + 6) * 65 + n], tile[(kc * 8 + 7) * 65 + n]);
      size_t drow; int K;
      switch (jobkind) {
        case 0: drow = ng; K = 1024; break;
        case 1: drow = ng; K = 512; break;
        case 2: drow = ng; K = 1024; break;
        case 3: case 4: { const int h = ng, R = (h >> 6) * 128 + ((h >> 5) & 1) * 64 + (h & 31) + (jobkind == 4 ? 32 : 0); drow = (size_t)e * 512 + R; K = 1024; } break;
        default: drow = (size_t)e * 1024 + ng; K = 256; break;
      }
      *(u32x4*)(dst + drow * K + k0 + kc * 8) = o; }
    __syncthreads();
}
constexpr int TP_J0 = 16 * 8, TP_J1 = 8 * 8, TP_J2 = 16 * 16, TP_J3 = 32 * 16 * 4, TP_J4 = TP_J3, TP_J5 = 32 * 4 * 16;
constexpr int TP_ITEMS = TP_J0 + TP_J1 + TP_J2 + TP_J3 + TP_J4 + TP_J5;
DI void tp_item(const Params& p, unsigned char* lds, int it) {
    unsigned char* ws = p.ws;
    if (it < TP_J0) { tp_tile(p.w_in, 1024, (it >> 3) * 64, (it & 7) * 64, lds, (bf16*)(ws + WS_WINT), 0, 0, 0); return; } it -= TP_J0;
    if (it < TP_J1) { tp_tile(p.w_glu, 512, (it >> 3) * 64, (it & 7) * 64, lds, (bf16*)(ws + WS_WGLUT), 0, 1, 0); return; } it -= TP_J1;
    if (it < TP_J2) { tp_tile(p.w_out, 1024, (it >> 4) * 64, (it & 15) * 64, lds, (bf16*)(ws + WS_WOUTT), 0, 2, 0); return; } it -= TP_J2;
    if (it < TP_J3) { const int e = it >> 6, r = it & 63; tp_tile(p.w_gate + (size_t)e * 1024 * 256, 256, (r >> 2) * 64, (r & 3) * 64, lds, (bf16*)(ws + WS_WGUT), 0, 3, e); return; } it -= TP_J3;
    if (it < TP_J4) { const int e = it >> 6, r = it & 63; tp_tile(p.w_up + (size_t)e * 1024 * 256, 256, (r >> 2) * 64, (r & 3) * 64, lds, (bf16*)(ws + WS_WGUT), 0, 4, e); return; } it -= TP_J4;
    { const int e = it >> 6, r = it & 63; tp_tile(p.w_down + (size_t)e * 256 * 1024, 1024, (r >> 4) * 64, (r & 15) * 64, lds, (bf16*)(ws + WS_WDT), 0, 5, e); }
}
DI void gfold_item(const Params& p, unsigned char* lds, int item) {
    const int q = item >> 6, k0 = (item & 63) * 16, tid = threadIdx.x;
    float* wv = (float*)lds;
    float* T = wv + 16 * 128;
    float* fw = T + 16 * 2 * 128;
    float* cs = fw + 128 * 128;
    float* sn = cs + 128;
    for (int i = tid; i < 16 * 128; i += NT) wv[i] = p.w_in[(size_t)(k0 + (i >> 7)) * 1024 + 512 + 128 * q + (i & 127)];
    for (int i = tid; i < 128 * 128; i += NT) fw[i] = p.fourier_w[(size_t)q * 128 * 128 + i];
    if (tid < 128) { double s, c; sincospi((double)tid / 64.0, &s, &c); cs[tid] = (float)c; sn[tid] = (float)s; }
    __syncthreads();
    for (int o = tid; o < 16 * 128; o += NT) { const int r = o >> 7, n = o & 127; float sr = 0.f, si = 0.f;
        for (int m = 0; m < 128; ++m) { const float w = wv[r * 128 + m]; const int ix = (n * m) & 127; sr += w * cs[ix]; si -= w * sn[ix]; }
        T[(r * 2 + 0) * 128 + n] = sr; T[(r * 2 + 1) * 128 + n] = si; }
    __syncthreads();
    bf16* WinT = (bf16*)(p.ws + WS_WINT);
    const float scale = 1.0f / 724.0773439350247f;
    for (int o = tid; o < 16 * 2 * 128; o += NT) { const int r = o & 15, c = (o >> 4) & 1, j = o >> 5; float s = 0.f;
        for (int n = 0; n < 128; ++n) s += T[(r * 2 + c) * 128 + n] * fw[n * 128 + j];
        WinT[(size_t)(512 + c * 512 + q * 128 + j) * 1024 + k0 + r] = (bf16)(pk2(s * scale, 0.f) & 0xffffu); }
    __syncthreads();
}
DI void s5mats_item(const Params& p, unsigned char* lds, int g) {
    const int tid = threadIdx.x;
    float* Bb = (float*)lds;
    float* Cc = Bb + 4096;
    float* pw = Cc + 4096;
    float* Kt = pw + 8448;
    for (int idx = tid; idx < 2 * 64 * 33; idx += NT) { const int d = idx / (64 * 33), rem = idx % (64 * 33), pp = rem / 33, k = rem % 33;
        const double dt = exp((double)p.log_step[d * 32 + g]); const double lr = p.lam_re[(d * 32 + g) * 64 + pp], li = p.lam_im[(d * 32 + g) * 64 + pp];
        const double mag = exp(lr * dt * k); double tt = li * dt * k / 3.14159265358979323846; tt -= 2.0 * floor(tt * 0.5);
        double s, c; sincospi(tt, &s, &c); pw[idx * 2] = (float)(mag * c); pw[idx * 2 + 1] = (float)(mag * s); }
    for (int idx = tid; idx < 2 * 64 * 16; idx += NT) { const int d = idx >> 10, pp = (idx >> 4) & 63, h = idx & 15;
        const double dt = exp((double)p.log_step[d * 32 + g]); const double lr = p.lam_re[(d * 32 + g) * 64 + pp], li = p.lam_im[(d * 32 + g) * 64 + pp];
        const double mag = exp(lr * dt); double tt = li * dt / 3.14159265358979323846; tt -= 2.0 * floor(tt * 0.5);
        double s, c; sincospi(tt, &s, &c); const double nr = mag * c - 1.0, ni = mag * s, den = lr * lr + li * li;
        const double qr = (nr * lr + ni * li) / den, qi = (ni * lr - nr * li) / den;
        const double br = p.b_re[((size_t)(d * 32 + g) * 64 + pp) * 16 + h], bi = p.b_im[((size_t)(d * 32 + g) * 64 + pp) * 16 + h];
        Bb[idx * 2] = (float)(qr * br - qi * bi); Bb[idx * 2 + 1] = (float)(qr * bi + qi * br); }
    for (int idx = tid; idx < 2 * 16 * 64; idx += NT) { const int d = idx >> 10, i = (idx >> 6) & 15, pp = idx & 63;
        Cc[idx * 2] = p.c_re[((size_t)(d * 32 + g) * 16 + i) * 64 + pp]; Cc[idx * 2 + 1] = p.c_im[((size_t)(d * 32 + g) * 16 + i) * 64 + pp]; }
    __syncthreads();
    for (int idx = tid; idx < 16384; idx += NT) { const int d = idx >> 13, k = (idx >> 8) & 31, i = (idx >> 4) & 15, h = idx & 15; float s = 0.f;
        for (int pp = 0; pp < 64; ++pp) { const float cr = Cc[((d * 16 + i) * 64 + pp) * 2], ci = Cc[((d * 16 + i) * 64 + pp) * 2 + 1];
            const float wr = pw[((d * 64 + pp) * 33 + k) * 2], wi = pw[((d * 64 + pp) * 33 + k) * 2 + 1];
            const float xr = cr * wr - ci * wi, xi = cr * wi + ci * wr;
            s += xr * Bb[((d * 64 + pp) * 16 + h) * 2] - xi * Bb[((d * 64 + pp) * 16 + h) * 2 + 1]; }
        Kt[idx] = s; }
    __syncthreads();
    bf16* Mg = (bf16*)(p.ws + WS_MG) + (size_t)g * 512 * 512;
    for (int ch = tid; ch < 512 * 64; ch += NT) { const int row = ch >> 6, c8 = ch & 63, j = row >> 4, i = row & 15, s = c8 >> 1, h0 = (c8 & 1) * 8; float v[8];
#pragma unroll
        for (int t = 0; t < 8; ++t) { float a = 0.f; if (s <= j) a += Kt[((0 * 32 + (j - s)) * 16 + i) * 16 + h0 + t]; if (s >= j) a += Kt[((1 * 32 + (s - j)) * 16 + i) * 16 + h0 + t]; v[t] = a; }
        u32x4 o; o.x = pk2(v[0], v[1]); o.y = pk2(v[2], v[3]); o.z = pk2(v[4], v[5]); o.w = pk2(v[6], v[7]);
        *(u32x4*)(Mg + (size_t)row * 512 + c8 * 8) = o; }
    bf16* Wst = (bf16*)(p.ws + WS_WST) + (size_t)g * 256 * 512;
    for (int ch = tid; ch < 256 * 64; ch += NT) { const int r = ch >> 6, c8 = ch & 63, s = c8 >> 1, h0 = (c8 & 1) * 8, d = r >> 7, c = (r >> 6) & 1, pp = r & 63;
        const int e = d == 0 ? 31 - s : s; const float wr = pw[((d * 64 + pp) * 33 + e) * 2], wi = pw[((d * 64 + pp) * 33 + e) * 2 + 1]; float v[8];
#pragma unroll
        for (int t = 0; t < 8; ++t) { const float br = Bb[((d * 64 + pp) * 16 + h0 + t) * 2], bi = Bb[((d * 64 + pp) * 16 + h0 + t) * 2 + 1]; v[t] = c == 0 ? wr * br - wi * bi : wr * bi + wi * br; }
        u32x4 o; o.x = pk2(v[0], v[1]); o.y = pk2(v[2], v[3]); o.z = pk2(v[4], v[5]); o.w = pk2(v[6], v[7]);
        *(u32x4*)(Wst + (size_t)r * 512 + c8 * 8) = o; }
    bf16* Wos = (bf16*)(p.ws + WS_WOS) + (size_t)g * 512 * 256;
    for (int ch = tid; ch < 512 * 32; ch += NT) { const int row = ch >> 5, c8 = ch & 31, j = row >> 4, i = row & 15, col0 = c8 * 8, d = col0 >> 7, c = (col0 >> 6) & 1, p0 = col0 & 63;
        const int e = d == 0 ? j + 1 : 32 - j; float v[8];
#pragma unroll
        for (int t = 0; t < 8; ++t) { const int pp = p0 + t; const float cr = Cc[((d * 16 + i) * 64 + pp) * 2], ci = Cc[((d * 16 + i) * 64 + pp) * 2 + 1];
            const float wr = pw[((d * 64 + pp) * 33 + e) * 2], wi = pw[((d * 64 + pp) * 33 + e) * 2 + 1]; v[t] = c == 0 ? cr * wr - ci * wi : -(cr * wi + ci * wr); }
        u32x4 o; o.x = pk2(v[0], v[1]); o.y = pk2(v[2], v[3]); o.z = pk2(v[4], v[5]); o.w = pk2(v[6], v[7]);
        *(u32x4*)(Wos + (size_t)row * 256 + c8 * 8) = o; }
    float* aT = (float*)(p.ws + WS_ABART) + g * 256;
    if (tid < 128) { const int d = tid >> 6, pp = tid & 63; aT[tid * 2] = pw[((d * 64 + pp) * 33 + 32) * 2]; aT[tid * 2 + 1] = pw[((d * 64 + pp) * 33 + 32) * 2 + 1]; }
    __syncthreads();
}
DI void fftc_item(const Params& p, int item) {
    const int tid = threadIdx.x;
    bf16* W1 = (bf16*)(p.ws + WS_FFTC);
    bf16* W2 = W1 + 128 * 128;
    float* tw = (float*)(p.ws + WS_FFTC + 32768 + 16384);
    for (int idx = item * NT + tid; idx < 128 * 128 + 4 * 64 * 32 + 4096; idx += 8 * NT) {
        if (idx < 16384) { const int n = idx >> 7, k = idx & 127, co = n >> 6, d = n & 63, ci = k >> 6, bq = k & 63; double s, c; sincospi((double)((d * bq) & 63) / 32.0, &s, &c);
            const float v = (ci == co) ? (float)c : (ci == 1 ? (float)s : (float)(-s)); W1[idx] = (bf16)(pk2(v, 0.f) & 0xffffu); }
        else if (idx < 16384 + 8192) { const int i2 = idx - 16384, s_ = i2 >> 11, cf = (i2 >> 5) & 63, slot = i2 & 31, gq = slot >> 3, jp = slot & 7;
            const int a = 16 * (2 * (s_ & 1) + (jp >> 2)) + 4 * gq + (jp & 3); double s, c; sincospi((double)((cf * a) & 63) / 32.0, &s, &c);
            W2[i2] = (bf16)(pk2((s_ >> 1) == 0 ? (float)c : (float)s, 0.f) & 0xffffu); }
        else { const int i3 = idx - 16384 - 8192; double s, c; sincospi((double)i3 / 2048.0, &s, &c); tw[i3 * 2] = (float)c; tw[i3 * 2 + 1] = (float)s; }
    }
}
constexpr int P0_S5 = 32, P0_GF = 256, P0_ADA = 96, P0_FC = 8;
constexpr int P0_ITEMS = P0_S5 + P0_GF + P0_ADA + P0_FC + TP_ITEMS;
DI void phase0(const Params& p, unsigned char* lds, int bid, int nb) {
    for (int it = bid; it < P0_ITEMS; it += nb) {
        int r = it;
        if (r < P0_S5) { s5mats_item(p, lds, r); continue; } r -= P0_S5;
        if (r < P0_GF) { gfold_item(p, lds, r); continue; } r -= P0_GF;
        if (r < P0_ADA) { adaln_item(p, lds, r); continue; } r -= P0_ADA;
        if (r < P0_FC) { fftc_item(p, r); continue; } r -= P0_FC;
        tp_item(p, lds, r);
    }
}

DI void phase1a(const Params& p, int bid, int nb) {
    const int lane = threadIdx.x & 63, wave = threadIdx.x >> 6;
    const float* mod = (const float*)(p.ws + WS_MOD);
    bf16* A1 = (bf16*)(p.ws + WS_R1);
    for (int r = bid * 8 + wave; r < NROWS1; r += nb * 8) {
        const float* src = r < NTOK ? p.x + (size_t)r * D : p.ctx + (size_t)(r - NTOK) * D;
        const int mr = r < NTOK ? (r >> 12) : 8;
        const f32x4* xr = (const f32x4*)src + lane;
        f32x4 v[4]; float s = 0.f;
#pragma unroll
        for (int j = 0; j < 4; ++j) { v[j] = xr[64 * j]; s += v[j].x * v[j].x + v[j].y * v[j].y + v[j].z * v[j].z + v[j].w * v[j].w; }
        const float rs = rsqrtf(wave_sum(s) * (1.f / D) + EPS);
        u32x2* o = (u32x2*)(A1 + (size_t)r * D) + lane;
#pragma unroll
        for (int j = 0; j < 4; ++j) { const int k = lane * 4 + 256 * j;
            const f32x4 g = *(const f32x4*)(p.norm1_g + k), sh = *(const f32x4*)(mod + mr * 6144 + k), sc = *(const f32x4*)(mod + mr * 6144 + 1024 + k);
            const f32x4 h = v[j] * rs * g * (sc + 1.f) + sh; u32x2 w; w.x = pk2(h.x, h.y); w.y = pk2(h.z, h.w); o[64 * j] = w; }
    }
}
DI void phase1b(const Params& p, unsigned char* lds, int bid, int nb) {
    const int tid = threadIdx.x, lane = tid & 63, wid = tid >> 6, wm = wid >> 1, wn = wid & 1, fr = lane & 15, fq = lane >> 4, srow = tid >> 3, sck = tid & 7;
    const bf16* A1 = (const bf16*)(p.ws + WS_R1); const bf16* WinT = (const bf16*)(p.ws + WS_WINT);
    bf16* Ul = (bf16*)(p.ws + WS_R3); bf16* Uc = Ul + (size_t)32 * 8 * 4096 * 16; bf16* GT = (bf16*)(p.ws + WS_R2);
    constexpr int NU = 136 * 4, NG = 256 * 4;
    for (int item = bid; item < NU + NG; item += nb) {
        f32x4 acc[4][4]; zero_acc<4>(acc);
        const bf16* ap[4]; int as[4]; const bf16* bp[2];
        if (item < NU) {
            const int m0 = (item >> 2) * 256, n0 = (item & 3) * 128;
#pragma unroll
            for (int i = 0; i < 4; ++i) { ap[i] = A1 + (size_t)(m0 + 64 * i + srow) * D + sck * 8; as[i] = 64; }
#pragma unroll
            for (int i = 0; i < 2; ++i) bp[i] = WinT + (size_t)(n0 + 64 * i + srow) * D + sck * 8;
            gemm_loop<4>(acc, ap, as, bp, 16, lds);
#pragma unroll
            for (int mt = 0; mt < 4; ++mt) { const int row = m0 + wm * 64 + mt * 16 + fr;
#pragma unroll
                for (int nt = 0; nt < 4; ++nt) { const int col = n0 + wn * 64 + nt * 16 + 4 * fq, g = col >> 4, h = col & 15;
                    u32x2 w; w.x = pk2(acc[mt][nt][0], acc[mt][nt][1]); w.y = pk2(acc[mt][nt][2], acc[mt][nt][3]);
                    bf16* dst = row < NTOK ? Ul + (((size_t)(g * 8 + (row >> 12)) * 4096 + (row & 4095)) * 16 + h)
                                           : Uc + (((size_t)(g * 8 + ((row - NTOK) >> 8)) * 256 + ((row - NTOK) & 255)) * 16 + h);
                    *(u32x2*)dst = w; } }
        } else {
            const int it2 = item - NU, ct = it2 & 3, tt = it2 >> 2, b = tt >> 5, a0 = (tt & 31) * 2;
#pragma unroll
            for (int i = 0; i < 4; ++i) { ap[i] = WinT + (size_t)(512 + ct * 256 + 64 * i + srow) * D + sck * 8; as[i] = 64; }
#pragma unroll
            for (int i = 0; i < 2; ++i) bp[i] = A1 + (size_t)(b * 4096 + srow * 64 + a0 + i) * D + sck * 8;
            gemm_loop<4>(acc, ap, as, bp, 16, lds);
#pragma unroll
            for (int mt = 0; mt < 4; ++mt) { const int m = ct * 256 + wm * 64 + mt * 16 + fr, c = m >> 9, ch = m & 511;
#pragma unroll
                for (int nt = 0; nt < 4; ++nt) { const int a = a0 + wn, bq = nt * 16 + 4 * fq;
                    u32x2 w; w.x = pk2(acc[mt][nt][0], acc[mt][nt][1]); w.y = pk2(acc[mt][nt][2], acc[mt][nt][3]);
                    *(u32x2*)(GT + ((size_t)((b * 512 + ch) * 2 + c) * 4096 + a * 64 + bq)) = w; } }
        }
    }
}
constexpr int S5_SB_OFF = GC<2>::LDS, S5_PITCH = 528, S5_LDS = S5_SB_OFF + 144 * S5_PITCH;
DI void phase2_s5(const Params& p, unsigned char* lds, int bid, int nb) {
    const int tid = threadIdx.x, lane = tid & 63, wid = tid >> 6, wm = wid >> 1, wn = wid & 1, fr = lane & 15, fq = lane >> 4, srow = tid >> 3, sck = tid & 7;
    const bf16* zero = (const bf16*)(p.ws + WS_CTL + CTL_ZERO);
    unsigned char* Sb = lds + S5_SB_OFF;
    for (int item = bid; item < 256; item += nb) {
        const int g = item >> 3, b = item & 7;
        const bf16* Ul = (const bf16*)(p.ws + WS_R3) + (size_t)(g * 8 + b) * 4096 * 16;
        const bf16* Uc = (const bf16*)(p.ws + WS_R3) + (size_t)32 * 8 * 4096 * 16 + (size_t)(g * 8 + b) * 256 * 16;
        const bf16* Wst = (const bf16*)(p.ws + WS_WST) + (size_t)g * 256 * 512;
        const bf16* Mg = (const bf16*)(p.ws + WS_MG) + (size_t)g * 512 * 512;
        const bf16* Wos = (const bf16*)(p.ws + WS_WOS) + (size_t)g * 512 * 256;
        for (int pass = 0; pass < 4; ++pass) {
            const int n0 = (pass & 1) * 128, isctx = pass >> 1;
            f32x4 acc[2][4]; zero_acc<2>(acc);
            const bf16* ap[2]; int as[2]; const bf16* bp[2];
#pragma unroll
            for (int i = 0; i < 2; ++i) { const int r = 64 * i + srow;
                if (!isctx) { ap[i] = Ul + (size_t)r * 512 + sck * 8; as[i] = 64; }
                else if (r < 8) { ap[i] = Uc + (size_t)r * 512 + sck * 8; as[i] = 64; }
                else { ap[i] = zero; as[i] = 0; }
                bp[i] = Wst + (size_t)(n0 + r) * 512 + sck * 8; }
            gemm_loop<2>(acc, ap, as, bp, 8, lds);
#pragma unroll
            for (int mt = 0; mt < 2; ++mt) { const int row = wm * 32 + mt * 16 + fr;
                if (!isctx || row < 8) {
#pragma unroll
                    for (int nt = 0; nt < 4; ++nt) { const int col = n0 + wn * 64 + nt * 16 + 4 * fq;
                        u32x2 w; w.x = pk2(acc[mt][nt][0], acc[mt][nt][1]); w.y = pk2(acc[mt][nt][2], acc[mt][nt][3]);
                        *(u32x2*)(Sb + (size_t)((isctx ? 128 : 0) + row) * S5_PITCH + col * 2) = w; } } }
        }
        __syncthreads();
        if (tid < 128) {
            const int d = tid >> 6, pp = tid & 63; const float* aT = (const float*)(p.ws + WS_ABART) + g * 256 + tid * 2; const float ar = aT[0], ai = aT[1];
            bf16* colr = (bf16*)Sb + d * 128 + pp; bf16* coli = colr + 64; constexpr int RP = S5_PITCH / 2;
            float hr = 0.f, hi = 0.f;
            if (d == 0) {
                for (int c = 0; c < 8; ++c) { const float sr = bf2f(colr[(128 + c) * RP]), si = bf2f(coli[(128 + c) * RP]); const float nr = ar * hr - ai * hi + sr, ni = ar * hi + ai * hr + si; hr = nr; hi = ni; }
                for (int c = 0; c < 128; ++c) { const float sr = bf2f(colr[c * RP]), si = bf2f(coli[c * RP]); const unsigned w = pk2(hr, hi); colr[c * RP] = (bf16)(w & 0xffffu); coli[c * RP] = (bf16)(w >> 16);
                    const float nr = ar * hr - ai * hi + sr, ni = ar * hi + ai * hr + si; hr = nr; hi = ni; }
            } else {
                for (int c = 7; c >= 0; --c) { const float sr = bf2f(colr[(128 + c) * RP]), si = bf2f(coli[(128 + c) * RP]); const float nr = ar * hr - ai * hi + sr, ni = ar * hi + ai * hr + si; hr = nr; hi = ni; }
                for (int c = 127; c >= 0; --c) { const float sr = bf2f(colr[c * RP]), si = bf2f(coli[c * RP]); const unsigned w = pk2(hr, hi); colr[c * RP] = (bf16)(w & 0xffffu); coli[c * RP] = (bf16)(w >> 16);
                    const float nr = ar * hr - ai * hi + sr, ni = ar * hi + ai * hr + si; hr = nr; hi = ni; }
            }
        }
        __syncthreads();
        bf16* yact = (bf16*)(p.ws + WS_R4);
        for (int pass = 0; pass < 4; ++pass) {
            const int n0 = pass * 128;
            f32x4 acc[2][4]; zero_acc<2>(acc);
            const bf16* ap[2]; int as[2]; const bf16* bp[2];
#pragma unroll
            for (int i = 0; i < 2; ++i) { const int r = 64 * i + srow; ap[i] = Ul + (size_t)r * 512 + sck * 8; as[i] = 64; bp[i] = Mg + (size_t)(n0 + r) * 512 + sck * 8; }
            gemm_loop<2>(acc, ap, as, bp, 8, lds);
#pragma unroll
            for (int i = 0; i < 2; ++i) bp[i] = Wos + (size_t)(n0 + 64 * i + srow) * 256 + sck * 8;
            gemm_loop_alds<2>(acc, Sb, S5_PITCH, bp, 4, lds);
#pragma unroll
            for (int mt = 0; mt < 2; ++mt) { const int c = wm * 32 + mt * 16 + fr;
#pragma unroll
                for (int nt = 0; nt < 4; ++nt) { const int col = n0 + wn * 64 + nt * 16 + 4 * fq, j = col >> 4, i0 = col & 15, l = 32 * c + j;
                    const u32x2 uu = *(const u32x2*)(Ul + (size_t)l * 16 + i0); const f32x4 dd = *(const f32x4*)(p.s5_d + g * 16 + i0);
                    const float y0 = geluf_(acc[mt][nt][0] + dd.x * __uint_as_float(uu.x << 16)), y1 = geluf_(acc[mt][nt][1] + dd.y * __uint_as_float(uu.x & 0xffff0000u));
                    const float y2 = geluf_(acc[mt][nt][2] + dd.z * __uint_as_float(uu.y << 16)), y3 = geluf_(acc[mt][nt][3] + dd.w * __uint_as_float(uu.y & 0xffff0000u));
                    u32x2 w; w.x = pk2(y0, y1); w.y = pk2(y2, y3);
                    *(u32x2*)(yact + ((size_t)(b * 4096 + l) * 512 + g * 16 + i0)) = w; } }
        }
        __syncthreads();
    }
}
constexpr int FF_W1P = 272, FF_W2P = 80, FF_W1_OFF = 0, FF_W2_OFF = 128 * FF_W1P, FF_TW_OFF = FF_W2_OFF + 4 * 64 * FF_W2P, FF_LDS = FF_TW_OFF + 32768;
DI void phase2_fft(const Params& p, unsigned char* lds, int bid, int nb) {
    const int tid = threadIdx.x, lane = tid & 63, wid = tid >> 6, fr = lane & 15, fq = lane >> 4;
    { const bf16* W1 = (const bf16*)(p.ws + WS_FFTC); const bf16* W2 = W1 + 128 * 128; const float* tw = (const float*)(p.ws + WS_FFTC + 32768 + 16384);
      for (int i = tid; i < 128 * 16; i += NT) { const int n = i >> 4, c = i & 15; *(u32x4*)(lds + FF_W1_OFF + n * FF_W1P + c * 16) = *(const u32x4*)(W1 + n * 128 + c * 8); }
      for (int i = tid; i < 256 * 4; i += NT) { const int r = i >> 2, c = i & 3; *(u32x4*)(lds + FF_W2_OFF + r * FF_W2P + c * 16) = *(const u32x4*)(W2 + r * 32 + c * 8); }
      for (int i = tid; i < 2048; i += NT) *(u32x4*)(lds + FF_TW_OFF + i * 16) = *(const u32x4*)(tw + i * 4);
      __syncthreads(); }
    const bf16* GT = (const bf16*)(p.ws + WS_R2); bf16* FT = (bf16*)(p.ws + WS_R5);
    const float* twl = (const float*)(lds + FF_TW_OFF);
    for (int cidx = bid * 8 + wid; cidx < 4096; cidx += nb * 8) {
        const bf16* gt = GT + (size_t)cidx * 2 * 4096;
        bf16* ft = FT + (size_t)cidx * 4096;
        bf16x8 afr[4][4];
#pragma unroll
        for (int ks = 0; ks < 4; ++ks)
#pragma unroll
            for (int mt = 0; mt < 4; ++mt) afr[ks][mt] = *(const bf16x8*)(gt + (ks >> 1) * 4096 + (16 * mt + fr) * 64 + 32 * (ks & 1) + 8 * fq);
#pragma unroll 1
        for (int nt = 0; nt < 4; ++nt) {
            f32x4 dre[4], dim[4];
#pragma unroll
            for (int m = 0; m < 4; ++m) { dre[m] = (f32x4){0.f, 0.f, 0.f, 0.f}; dim[m] = (f32x4){0.f, 0.f, 0.f, 0.f}; }
#pragma unroll
            for (int ks = 0; ks < 4; ++ks) {
                const bf16x8 bre = *(const bf16x8*)(lds + FF_W1_OFF + (nt * 16 + fr) * FF_W1P + (ks * 32 + fq * 8) * 2);
                const bf16x8 bim = *(const bf16x8*)(lds + FF_W1_OFF + (64 + nt * 16 + fr) * FF_W1P + (ks * 32 + fq * 8) * 2);
#pragma unroll
                for (int mt = 0; mt < 4; ++mt) { dre[mt] = __builtin_amdgcn_mfma_f32_16x16x32_bf16(afr[ks][mt], bre, dre[mt], 0, 0, 0);
                                                 dim[mt] = __builtin_amdgcn_mfma_f32_16x16x32_bf16(afr[ks][mt], bim, dim[mt], 0, 0, 0); }
            }
            const int d = 16 * nt + fr; unsigned pr[4][2], pi[4][2];
#pragma unroll
            for (int mt = 0; mt < 4; ++mt) { float tr[4], ti[4];
#pragma unroll
                for (int r = 0; r < 4; ++r) { const int a = 16 * mt + 4 * fq + r, ix = (d * a) & 4095; const float cs = twl[ix * 2], sn = twl[ix * 2 + 1];
                    const float re = dre[mt][r], im = dim[mt][r]; tr[r] = re * cs + im * sn; ti[r] = im * cs - re * sn; }
                pr[mt][0] = pk2(tr[0], tr[1]); pr[mt][1] = pk2(tr[2], tr[3]); pi[mt][0] = pk2(ti[0], ti[1]); pi[mt][1] = pk2(ti[2], ti[3]); }
            u32x4 f0, f1, f2, f3;
            f0.x = pr[0][0]; f0.y = pr[0][1]; f0.z = pr[1][0]; f0.w = pr[1][1];
            f1.x = pr[2][0]; f1.y = pr[2][1]; f1.z = pr[3][0]; f1.w = pr[3][1];
            f2.x = pi[0][0]; f2.y = pi[0][1]; f2.z = pi[1][0]; f2.w = pi[1][1];
            f3.x = pi[2][0]; f3.y = pi[2][1]; f3.z = pi[3][0]; f3.w = pi[3][1];
            bf16x8 frag[4];
            frag[0] = __builtin_bit_cast(bf16x8, f0); frag[1] = __builtin_bit_cast(bf16x8, f1); frag[2] = __builtin_bit_cast(bf16x8, f2); frag[3] = __builtin_bit_cast(bf16x8, f3);
            f32x4 z[4];
#pragma unroll
            for (int n = 0; n < 4; ++n) z[n] = (f32x4){0.f, 0.f, 0.f, 0.f};
#pragma unroll
            for (int s2 = 0; s2 < 4; ++s2)
#pragma unroll
                for (int n2 = 0; n2 < 4; ++n2) { const bf16x8 bfr = *(const bf16x8*)(lds + FF_W2_OFF + ((s2 * 64 + n2 * 16 + fr) * FF_W2P) + fq * 16);
                    z[n2] = __builtin_amdgcn_mfma_f32_16x16x32_bf16(frag[s2], bfr, z[n2], 0, 0, 0); }
#pragma unroll
            for (int n2 = 0; n2 < 4; ++n2) { const int cf = 16 * n2 + fr; u32x2 w; w.x = pk2(z[n2][0], z[n2][1]); w.y = pk2(z[n2][2], z[n2][3]);
                *(u32x2*)(ft + 64 * cf + 16 * nt + 4 * fq) = w; }
        }
    }
}
DI void phase3_glu(const Params& p, unsigned char* lds, int bid, int nb) {
    const int tid = threadIdx.x, lane = tid & 63, wid = tid >> 6, wm = wid >> 1, wn = wid & 1, fr = lane & 15, fq = lane >> 4, srow = tid >> 3, sck = tid & 7;
    const bf16* yact = (const bf16*)(p.ws + WS_R4); const bf16* Wg = (const bf16*)(p.ws + WS_WGLUT); bf16* merged = (bf16*)(p.ws + WS_R1);
    for (int item = bid; item < 128 * 4; item += nb) {
        const int m0 = (item >> 2) * 256, n0 = (item & 3) * 128;
        f32x4 acc[4][4]; zero_acc<4>(acc);
        const bf16* ap[4]; int as[4]; const bf16* bp[2];
#pragma unroll
        for (int i = 0; i < 4; ++i) { ap[i] = yact + (size_t)(m0 + 64 * i + srow) * 512 + sck * 8; as[i] = 64; }
#pragma unroll
        for (int i = 0; i < 2; ++i) bp[i] = Wg + (size_t)(n0 + 64 * i + srow) * 512 + sck * 8;
        gemm_loop<4>(acc, ap, as, bp, 8, lds);
#pragma unroll
        for (int mt = 0; mt < 4; ++mt) { const int row = m0 + wm * 64 + mt * 16 + fr;
#pragma unroll
            for (int nt = 0; nt < 4; ++nt) { const int col = n0 + wn * 64 + nt * 16 + 4 * fq;
                const u32x2 yy = *(const u32x2*)(yact + (size_t)row * 512 + col);
                const float y0 = __uint_as_float(yy.x << 16) * sigmoidf_(acc[mt][nt][0]), y1 = __uint_as_float(yy.x & 0xffff0000u) * sigmoidf_(acc[mt][nt][1]);
                const float y2 = __uint_as_float(yy.y << 16) * sigmoidf_(acc[mt][nt][2]), y3 = __uint_as_float(yy.y & 0xffff0000u) * sigmoidf_(acc[mt][nt][3]);
                u32x2 w; w.x = pk2(y0, y1); w.y = pk2(y2, y3); *(u32x2*)(merged + (size_t)row * 1024 + col) = w; } }
    }
}
constexpr int FM_PITCH = 132, FM_LDS = 512 * FM_PITCH;
DI void phase3_fin(const Params& p, unsigned char* lds, int bid, int nb) {
    const int tid = threadIdx.x, lane = tid & 63, wid = tid >> 6;
    const bf16* FT = (const bf16*)(p.ws + WS_R5); bf16* merged = (bf16*)(p.ws + WS_R1);
    for (int item = bid; item < 512; item += nb) {
        const int b = item >> 6, k0 = (item & 63) * 64;
        for (int i = tid; i < 512 * 8; i += NT) { const int ch = i >> 3, c = i & 7; const u32x4 v = *(const u32x4*)(FT + ((size_t)(b * 512 + ch) * 4096 + k0 + c * 8));
            unsigned* d = (unsigned*)(lds + ch * FM_PITCH + c * 16); d[0] = v.x; d[1] = v.y; d[2] = v.z; d[3] = v.w; }
        __syncthreads();
        for (int t = wid * 8; t < wid * 8 + 8; ++t) {
            const size_t row = (size_t)b * 4096 + k0 + t;
            float f[8]; float s = 0.f;
#pragma unroll
            for (int j = 0; j < 8; ++j) { f[j] = bf2f(*(const bf16*)(lds + (lane + 64 * j) * FM_PITCH + t * 2)); s += f[j] * f[j]; }
            const float rs = rsqrtf(wave_sum(s) * (1.f / 512.f) + EPS);
#pragma unroll
            for (int j = 0; j < 8; ++j) merged[row * 1024 + 512 + lane + 64 * j] = (bf16)(pk2(f[j] * rs * p.g_f[lane + 64 * j], 0.f) & 0xffffu);
            u32x4 yv = *(const u32x4*)(merged + row * 1024 + lane * 8);
            float y[8]; y[0] = __uint_as_float(yv.x << 16); y[1] = __uint_as_float(yv.x & 0xffff0000u); y[2] = __uint_as_float(yv.y << 16); y[3] = __uint_as_float(yv.y & 0xffff0000u);
            y[4] = __uint_as_float(yv.z << 16); y[5] = __uint_as_float(yv.z & 0xffff0000u); y[6] = __uint_as_float(yv.w << 16); y[7] = __uint_as_float(yv.w & 0xffff0000u);
            float s2 = 0.f;
#pragma unroll
            for (int j = 0; j < 8; ++j) s2 += y[j] * y[j];
            const float rs2 = rsqrtf(wave_sum(s2) * (1.f / 512.f) + EPS);
            const f32x4 g0 = *(const f32x4*)(p.g_s + lane * 8), g1 = *(const f32x4*)(p.g_s + lane * 8 + 4);
            u32x4 o; o.x = pk2(y[0] * rs2 * g0.x, y[1] * rs2 * g0.y); o.y = pk2(y[2] * rs2 * g0.z, y[3] * rs2 * g0.w); o.z = pk2(y[4] * rs2 * g1.x, y[5] * rs2 * g1.y); o.w = pk2(y[6] * rs2 * g1.z, y[7] * rs2 * g1.w);
            *(u32x4*)(merged + row * 1024 + lane * 8) = o;
        }
        __syncthreads();
    }
}
DI void phase4_out(const Params& p, unsigned char* lds, int bid, int nb) {
    const int tid = threadIdx.x, lane = tid & 63, wid = tid >> 6, wm = wid >> 1, wn = wid & 1, fr = lane & 15, fq = lane >> 4, srow = tid >> 3, sck = tid & 7;
    const bf16* merged = (const bf16*)(p.ws + WS_R1); const bf16* Wo = (const bf16*)(p.ws + WS_WOUTT); const float* mod = (const float*)(p.ws + WS_MOD);
    float* rsq = (float*)(p.ws + WS_CTL + CTL_RSQ1);
    for (int item = bid; item < 128 * 8; item += nb) {
        const int m0 = (item >> 3) * 256, n0 = (item & 7) * 128;
        f32x4 acc[4][4]; zero_acc<4>(acc);
        const bf16* ap[4]; int as[4]; const bf16* bp[2];
#pragma unroll
        for (int i = 0; i < 4; ++i) { ap[i] = merged + (size_t)(m0 + 64 * i + srow) * 1024 + sck * 8; as[i] = 64; }
#pragma unroll
        for (int i = 0; i < 2; ++i) bp[i] = Wo + (size_t)(n0 + 64 * i + srow) * 1024 + sck * 8;
        gemm_loop<4>(acc, ap, as, bp, 16, lds);
#pragma unroll
        for (int mt = 0; mt < 4; ++mt) { const int row = m0 + wm * 64 + mt * 16 + fr, b = row >> 12; float s = 0.f;
#pragma unroll
            for (int nt = 0; nt < 4; ++nt) { const int col = n0 + wn * 64 + nt * 16 + 4 * fq;
                const f32x4 xv = *(const f32x4*)(p.x + (size_t)row * D + col), gv = *(const f32x4*)(mod + b * 6144 + 2048 + col);
                const f32x4 o = xv + gv * acc[mt][nt]; *(f32x4*)(p.out + (size_t)row * D + col) = o; s += o.x * o.x + o.y * o.y + o.z * o.z + o.w * o.w; }
            s += __shfl_xor(s, 16); s += __shfl_xor(s, 32);
            if (fq == 0) atomicAdd(rsq + row, s); }
    }
}
DI int pair_index(int lo, int hi) { return 7 * lo - (lo * (lo - 1)) / 2 + (hi - lo - 1); }
constexpr int RT_LDS = 1024 * 36 * 4;
DI void phase5_route(const Params& p, unsigned char* lds, int bid, int nb) {
    const int tid = threadIdx.x, lane = tid & 63, wid = tid >> 6;
    float* wr = (float*)lds;
    for (int i = tid; i < 1024 * 36; i += NT) { const int k = i / 36, o = i % 36; wr[i] = o < 4 ? p.w_group[k * 4 + o] : p.w_router[k * 32 + (o - 4)]; }
    __syncthreads();
    const float* mod = (const float*)(p.ws + WS_MOD); const float* rsq = (const float*)(p.ws + WS_CTL + CTL_RSQ1);
    bf16* A2 = (bf16*)(p.ws + WS_R2); float* gw = (float*)(p.ws + WS_GW);
    unsigned* ecnt = (unsigned*)(p.ws + WS_CTL + CTL_ECNT); unsigned* pcnt = (unsigned*)(p.ws + WS_CTL + CTL_PCNT);
    unsigned* elist = (unsigned*)(p.ws + WS_ELIST); unsigned* plist = (unsigned*)(p.ws + WS_PLIST);
    for (int row = bid * 8 + wid; row < NTOK; row += nb * 8) {
        const int b = row >> 12; const float rs = rsqrtf(rsq[row] * (1.f / D) + EPS);
        float acc[36];
#pragma unroll
        for (int o = 0; o < 36; ++o) acc[o] = 0.f;
#pragma unroll 1
        for (int j = 0; j < 4; ++j) { const int k = lane * 4 + 256 * j;
            const f32x4 xv = *(const f32x4*)(p.out + (size_t)row * D + k), g = *(const f32x4*)(p.norm2_g + k), sh = *(const f32x4*)(mod + b * 6144 + 3072 + k), sc = *(const f32x4*)(mod + b * 6144 + 4096 + k);
            const f32x4 t = xv * rs * g * (sc + 1.f) + sh;
            u32x2 w; w.x = pk2(t.x, t.y); w.y = pk2(t.z, t.w); *(u32x2*)(A2 + (size_t)row * D + k) = w;
#pragma unroll 1
            for (int e = 0; e < 4; ++e) { const float tv = e == 0 ? t.x : (e == 1 ? t.y : (e == 2 ? t.z : t.w)); const f32x4* wp = (const f32x4*)(wr + (k + e) * 36);
#pragma unroll
                for (int o4 = 0; o4 < 9; ++o4) { const f32x4 wv = wp[o4]; acc[o4 * 4] += tv * wv.x; acc[o4 * 4 + 1] += tv * wv.y; acc[o4 * 4 + 2] += tv * wv.z; acc[o4 * 4 + 3] += tv * wv.w; } } }
#pragma unroll
        for (int o = 0; o < 36; ++o) acc[o] = wave_sum(acc[o]);
        if (lane == 0) {
            float gl[4];
#pragma unroll
            for (int o = 0; o < 4; ++o) gl[o] = acc[o] + p.b_group[o];
            float gmax = gl[0]; int gi = 0;
#pragma unroll
            for (int o = 1; o < 4; ++o) if (gl[o] > gmax) { gmax = gl[o]; gi = o; }
            float se = 0.f;
#pragma unroll
            for (int o = 0; o < 4; ++o) se += __expf(gl[o] - gmax);
            const float g_w = 1.f / se;
            float ev[8];
#pragma unroll
            for (int o = 0; o < 8; ++o) { float v = 0.f;
#pragma unroll
                for (int q = 0; q < 4; ++q) v = (q == gi) ? acc[4 + q * 8 + o] + p.b_router[q * 8 + o] : v;
                ev[o] = v; }
            float v1 = ev[0]; int i1 = 0;
#pragma unroll
            for (int o = 1; o < 8; ++o) if (ev[o] > v1) { v1 = ev[o]; i1 = o; }
            float v2 = -3.0e38f; int i2 = -1;
#pragma unroll
            for (int o = 0; o < 8; ++o) if (o != i1 && ev[o] > v2) { v2 = ev[o]; i2 = o; }
            const float w1 = g_w / (1.f + __expf(v2 - v1)), w2 = g_w - w1;
            const int lo = i1 < i2 ? i1 : i2, hi = i1 < i2 ? i2 : i1; const int pos1 = i1 < i2 ? 0 : 1;
            gw[row * 2 + pos1] = w1; gw[row * 2 + (1 - pos1)] = w2;
            const int e1 = gi * 8 + i1, e2 = gi * 8 + i2;
            const unsigned q1 = atomicAdd(ecnt + e1, 1u); elist[(size_t)e1 * 32768 + q1] = (unsigned)row * 2u + (unsigned)pos1;
            const unsigned q2 = atomicAdd(ecnt + e2, 1u); elist[(size_t)e2 * 32768 + q2] = (unsigned)row * 2u + (unsigned)(1 - pos1);
            const int cls = gi * 28 + pair_index(lo, hi);
            const unsigned q3 = atomicAdd(pcnt + cls, 1u); plist[(size_t)cls * 32768 + q3] = (unsigned)row;
        }
    }
}
DI void build_tiles(const Params& p) {
    if (threadIdx.x == 0) {
        int* tb = (int*)(p.ws + WS_TILES); const unsigned* ecnt = (const unsigned*)(p.ws + WS_CTL + CTL_ECNT); const unsigned* pcnt = (const unsigned*)(p.ws + WS_CTL + CTL_PCNT);
        int n = 0;
        for (int e = 0; e < 32; ++e) { const int c = (int)ecnt[e]; for (int r0 = 0; r0 < c; r0 += 256) { tb[64 + n] = e; tb[64 + 512 + n] = r0; ++n; } }
        tb[0] = n; n = 0;
        for (int c2 = 0; c2 < 112; ++c2) { const int c = (int)pcnt[c2]; for (int r0 = 0; r0 < c; r0 += 256) { tb[64 + 1024 + n] = c2; tb[64 + 1536 + n] = r0; ++n; } }
        tb[1] = n;
    }
}
DI void phase6_gateup(const Params& p, unsigned char* lds, int bid, int nb) {
    const int tid = threadIdx.x, lane = tid & 63, wid = tid >> 6, wm = wid >> 1, wn = wid & 1, fr = lane & 15, fq = lane >> 4, srow = tid >> 3, sck = tid & 7;
    const int* tb = (const int*)(p.ws + WS_TILES); const int n_et = tb[0];
    const bf16* A2 = (const bf16*)(p.ws + WS_R2); const bf16* Wgu = (const bf16*)(p.ws + WS_WGUT); bf16* Hb = (bf16*)(p.ws + WS_R3);
    const bf16* zero = (const bf16*)(p.ws + WS_CTL + CTL_ZERO); const float* gw = (const float*)(p.ws + WS_GW);
    const unsigned* ecnt = (const unsigned*)(p.ws + WS_CTL + CTL_ECNT); const unsigned* elist = (const unsigned*)(p.ws + WS_ELIST);
    for (int item = bid; item < n_et * 4; item += nb) {
        const int tile = item >> 2, blk = item & 3, e = tb[64 + tile], r0 = tb[64 + 512 + tile], cnt = (int)ecnt[e];
        f32x4 acc[4][4]; zero_acc<4>(acc);
        const bf16* ap[4]; int as[4]; const bf16* bp[2];
#pragma unroll
        for (int i = 0; i < 4; ++i) { const int r = r0 + 64 * i + srow;
            if (r < cnt) { const unsigned ent = elist[(size_t)e * 32768 + r]; ap[i] = A2 + (size_t)(ent >> 1) * D + sck * 8; as[i] = 64; } else { ap[i] = zero; as[i] = 0; } }
#pragma unroll
        for (int i = 0; i < 2; ++i) bp[i] = Wgu + ((size_t)e * 512 + blk * 128 + 64 * i + srow) * D + sck * 8;
        gemm_loop<4>(acc, ap, as, bp, 16, lds);
#pragma unroll
        for (int mt = 0; mt < 4; ++mt) { const int r = r0 + wm * 64 + mt * 16 + fr;
            if (r < cnt) { const unsigned ent = elist[(size_t)e * 32768 + r]; const float w = gw[ent];
#pragma unroll
                for (int nt = 0; nt < 2; ++nt) { const int hid = blk * 64 + wn * 32 + nt * 16 + 4 * fq;
                    const float h0 = siluf_(acc[mt][nt][0]) * acc[mt][nt + 2][0] * w, h1 = siluf_(acc[mt][nt][1]) * acc[mt][nt + 2][1] * w;
                    const float h2 = siluf_(acc[mt][nt][2]) * acc[mt][nt + 2][2] * w, h3 = siluf_(acc[mt][nt][3]) * acc[mt][nt + 2][3] * w;
                    u32x2 o; o.x = pk2(h0, h1); o.y = pk2(h2, h3); *(u32x2*)(Hb + (size_t)ent * 256 + hid) = o; } } }
    }
}
DI void phase7_down(const Params& p, unsigned char* lds, int bid, int nb) {
    const int tid = threadIdx.x, lane = tid & 63, wid = tid >> 6, wm = wid >> 1, wn = wid & 1, fr = lane & 15, fq = lane >> 4, srow = tid >> 3, sck = tid & 7;
    const int* tb = (const int*)(p.ws + WS_TILES); const int n_pt = tb[1];
    const bf16* Hb = (const bf16*)(p.ws + WS_R3); const bf16* Wd = (const bf16*)(p.ws + WS_WDT);
    const bf16* zero = (const bf16*)(p.ws + WS_CTL + CTL_ZERO); const float* mod = (const float*)(p.ws + WS_MOD);
    const unsigned* pcnt = (const unsigned*)(p.ws + WS_CTL + CTL_PCNT); const unsigned* plist = (const unsigned*)(p.ws + WS_PLIST);
    float* rsq = (float*)(p.ws + WS_CTL + CTL_RSQ2);
    for (int item = bid; item < n_pt * 8; item += nb) {
        const int tile = item >> 3, n0 = (item & 7) * 128, cls = tb[64 + 1024 + tile], r0 = tb[64 + 1536 + tile], cnt = (int)pcnt[cls];
        const int gi = cls / 28, pi = cls % 28; int lo = 0, rem = pi;
        while (rem >= 7 - lo) { rem -= 7 - lo; ++lo; }
        const int hi = lo + 1 + rem, elo = gi * 8 + lo, ehi = gi * 8 + hi;
        f32x4 acc[4][4]; zero_acc<4>(acc);
        const bf16* ap[4]; int as[4]; const bf16* bp[2];
#pragma unroll
        for (int i = 0; i < 4; ++i) { const int r = r0 + 64 * i + srow;
            if (r < cnt) { const unsigned tok = plist[(size_t)cls * 32768 + r]; ap[i] = Hb + (size_t)tok * 512 + sck * 8; as[i] = 64; } else { ap[i] = zero; as[i] = 0; } }
#pragma unroll
        for (int i = 0; i < 2; ++i) bp[i] = Wd + ((size_t)elo * 1024 + n0 + 64 * i + srow) * 256 + sck * 8;
        gemm_loop<4>(acc, ap, as, bp, 4, lds);
#pragma unroll
        for (int i = 0; i < 4; ++i) if (as[i]) ap[i] += 256;
#pragma unroll
        for (int i = 0; i < 2; ++i) bp[i] = Wd + ((size_t)ehi * 1024 + n0 + 64 * i + srow) * 256 + sck * 8;
        gemm_loop<4>(acc, ap, as, bp, 4, lds);
#pragma unroll
        for (int mt = 0; mt < 4; ++mt) { const int r = r0 + wm * 64 + mt * 16 + fr; float s = 0.f; unsigned tok = 0;
            if (r < cnt) { tok = plist[(size_t)cls * 32768 + r]; const int b = tok >> 12;
#pragma unroll
                for (int nt = 0; nt < 4; ++nt) { const int col = n0 + wn * 64 + nt * 16 + 4 * fq;
                    float* xp = p.out + (size_t)tok * D + col; const f32x4 xv = *(const f32x4*)xp, gv = *(const f32x4*)(mod + b * 6144 + 5120 + col);
                    const f32x4 o = xv + gv * acc[mt][nt]; *(f32x4*)xp = o; s += o.x * o.x + o.y * o.y + o.z * o.z + o.w * o.w; } }
            s += __shfl_xor(s, 16); s += __shfl_xor(s, 32);
            if (fq == 0 && r < cnt) atomicAdd(rsq + tok, s); }
    }
}
DI void phase8_final(const Params& p, int bid, int nb) {
    const int lane = threadIdx.x & 63, wave = threadIdx.x >> 6;
    const float* rsq = (const float*)(p.ws + WS_CTL + CTL_RSQ2);
    for (int r = bid * 8 + wave; r < NTOK; r += nb * 8) {
        const float rs = rsqrtf(rsq[r] * (1.f / D) + EPS);
        f32x4* xr = (f32x4*)(p.out + (size_t)r * D) + lane;
#pragma unroll
        for (int j = 0; j < 4; ++j) { const f32x4 g = *(const f32x4*)(p.final_g + lane * 4 + 256 * j); xr[64 * j] = xr[64 * j] * rs * g; }
    }
}

template <int PH> __global__ void __launch_bounds__(NT, 2) phase_kernel(Params p) {
    extern __shared__ __attribute__((aligned(16))) unsigned char lds[];
    const int bid = blockIdx.x, nb = gridDim.x;
    if constexpr (PH == 0) phase0(p, lds, bid, nb);
    if constexpr (PH == 1) phase1a(p, bid, nb);
    if constexpr (PH == 2) phase1b(p, lds, bid, nb);
    if constexpr (PH == 3) phase2_s5(p, lds, bid, nb);
    if constexpr (PH == 4) phase2_fft(p, lds, bid, nb);
    if constexpr (PH == 5) phase3_glu(p, lds, bid, nb);
    if constexpr (PH == 6) phase3_fin(p, lds, bid, nb);
    if constexpr (PH == 7) phase4_out(p, lds, bid, nb);
    if constexpr (PH == 8) phase5_route(p, lds, bid, nb);
    if constexpr (PH == 9) build_tiles(p);
    if constexpr (PH == 10) phase6_gateup(p, lds, bid, nb);
    if constexpr (PH == 11) phase7_down(p, lds, bid, nb);
    if constexpr (PH == 12) phase8_final(p, bid, nb);
}
constexpr int P0_LDS = 4 * (4096 + 4096 + 8448 + 16384);
template <int PH> static void launch(const Params& p, int grid, int ldsb, hipStream_t s) {
    static bool attr = false;
    if (!attr) { (void)hipFuncSetAttribute((const void*)phase_kernel<PH>, hipFuncAttributeMaxDynamicSharedMemorySize, ldsb); attr = true; }
    hipLaunchKernelGGL(phase_kernel<PH>, dim3(grid), dim3(NT), ldsb, s, p);
}

extern "C" void kernel_launch(void* const* d_in, const int* in_sizes, int n_in, void* d_out, int out_size, void* d_ws, size_t ws_size, hipStream_t stream) {
    if (n_in != 30 || ws_size < WS_END) { fprintf(stderr, "kernel_launch: unexpected inputs (n_in %d, ws %zu)\n", n_in, ws_size); return; }
    Params p{};
    const float** f = (const float**)&p;
    for (int i = 0; i < 30; ++i) f[i] = (const float*)d_in[i];
    p.out = (float*)d_out; p.ws = (unsigned char*)d_ws;
    (void)hipMemsetAsync((char*)d_ws + WS_CTL, 0, CTL_BYTES, stream);
    const int G = 256;
    launch<0>(p, G, P0_LDS, stream);
    launch<1>(p, G * 4, 0, stream);
    launch<2>(p, G, GC<4>::LDS, stream);
    launch<3>(p, G, S5_LDS, stream);
    launch<4>(p, G, FF_LDS, stream);
    launch<5>(p, G, GC<4>::LDS, stream);
    launch<6>(p, G, FM_LDS, stream);
    launch<7>(p, G, GC<4>::LDS, stream);
    launch<8>(p, G, RT_LDS, stream);
    launch<9>(p, 1, 0, stream);
    launch<10>(p, G, GC<4>::LDS, stream);
    launch<11>(p, G, GC<4>::LDS, stream);
    launch<12>(p, G * 4, 0, stream);
}
```

```cpp
#include <hip/hip_runtime.h>
#include <cstdio>
#include <cstdint>

typedef unsigned short bf16;
typedef short bf16x8 __attribute__((ext_vector_type(8)));
typedef short bf16x4 __attribute__((ext_vector_type(4)));
typedef float f32x4 __attribute__((ext_vector_type(4)));
typedef unsigned u32x4 __attribute__((ext_vector_type(4)));
typedef unsigned u32x2 __attribute__((ext_vector_type(2)));
typedef __bf16 bf16v2 __attribute__((ext_vector_type(2)));
#define DI __device__ __forceinline__

constexpr int D = 1024, NB = 8, L = 4096, CTX = 256, NTOK = NB * L, NCTX = NB * CTX, NROWS1 = NTOK + NCTX;
constexpr int NEXP = 32, DE = 256;
constexpr float EPS = 1e-6f;
constexpr int NT = 512;

constexpr size_t MiB = 1u << 20;
constexpr size_t WS_CTL = 0;
constexpr size_t CTL_BYTES = 1 * MiB;
constexpr size_t CTL_ZERO = 4096;
constexpr size_t CTL_ECNT = 8192;
constexpr size_t CTL_PCNT = 8192 + 256;
constexpr size_t CTL_RSQ1 = 256 * 1024;
constexpr size_t CTL_RSQ2 = 384 * 1024;
constexpr size_t WS_MOD = 1 * MiB;
constexpr size_t WS_TILES = WS_MOD + 256 * 1024;
constexpr size_t WS_ABART = WS_TILES + 64 * 1024;
constexpr size_t WS_FFTC = 2 * MiB;
constexpr size_t WS_GW = 3 * MiB;
constexpr size_t WS_WINT = 4 * MiB;
constexpr size_t WS_WGLUT = 7 * MiB;
constexpr size_t WS_WOUTT = 8 * MiB;
constexpr size_t WS_WGUT = 10 * MiB;
constexpr size_t WS_WDT = 42 * MiB;
constexpr size_t WS_MG = 58 * MiB;
constexpr size_t WS_WST = 74 * MiB;
constexpr size_t WS_WOS = 82 * MiB;
constexpr size_t WS_ELIST = 90 * MiB;
constexpr size_t WS_PLIST = 94 * MiB;
constexpr size_t WS_R1 = 108 * MiB;
constexpr size_t WS_R2 = 176 * MiB;
constexpr size_t WS_R3 = 240 * MiB;
constexpr size_t WS_R4 = 274 * MiB;
constexpr size_t WS_R5 = 306 * MiB;
constexpr size_t WS_END = 338 * MiB;

struct Params {
    const float *x, *c, *ctx, *c_ctx, *w_ada, *b_ada, *norm1_g, *norm2_g, *w_in;
    const float *lam_re, *lam_im, *b_re, *b_im, *c_re, *c_im, *log_step, *s5_d, *w_glu, *fourier_w, *g_s, *g_f, *w_out;
    const float *w_group, *b_group, *w_router, *b_router, *w_gate, *w_up, *w_down, *final_g;
    float* out; unsigned char* ws;
};

DI unsigned pk2(float lo, float hi) { bf16v2 v; v.x = (__bf16)lo; v.y = (__bf16)hi; return __builtin_bit_cast(unsigned, v); }
DI float bf2f(unsigned short b) { return __uint_as_float(((unsigned)b) << 16); }
DI float wave_sum(float v) {
#pragma unroll
    for (int o = 1; o < 64; o <<= 1) v += __shfl_xor(v, o);
    return v;
}
DI float sigmoidf_(float x) { return 1.f / (1.f + __expf(-x)); }
DI float siluf_(float x) { return x / (1.f + __expf(-x)); }
DI float geluf_(float x) { const float u = 0.7978845608028654f * (x + 0.044715f * x * x * x); return x / (1.f + __expf(-2.f * u)); }

template <int MT> struct GC {
    static constexpr int BM = 64 * MT, PA = MT, ABYTES = BM * 128, BBYTES = 128 * 128, BUF = ABYTES + BBYTES, LDS = 2 * BUF;
};
template <int MT>
DI void gemm_loop(f32x4 (&acc)[MT][4], const bf16* (&ap)[MT], const int (&as)[MT], const bf16* (&bp)[2], int nk, unsigned char* lds) {
    typedef GC<MT> G;
    const int tid = threadIdx.x, lane = tid & 63, wid = tid >> 6, wm = wid >> 1, wn = wid & 1, fr = lane & 15, fq = lane >> 4;
    const int srow = tid >> 3, sck = tid & 7;
    const int soff = srow * 128 + ((sck ^ (srow & 7)) << 4);
    u32x4 ra[MT], rb[2];
#pragma unroll
    for (int i = 0; i < MT; ++i) ra[i] = *(const u32x4*)(ap[i]);
#pragma unroll
    for (int i = 0; i < 2; ++i) rb[i] = *(const u32x4*)(bp[i]);
#pragma unroll
    for (int i = 0; i < MT; ++i) *(u32x4*)(lds + i * 8192 + soff) = ra[i];
#pragma unroll
    for (int i = 0; i < 2; ++i) *(u32x4*)(lds + G::ABYTES + i * 8192 + soff) = rb[i];
    __syncthreads();
    const int aro = (wm * MT * 16 + fr) * 128, bro = (wn * 64 + fr) * 128;
    const int sw0 = ((0 + fq) ^ (fr & 7)) << 4, sw1 = ((4 + fq) ^ (fr & 7)) << 4;
    for (int kt = 0; kt < nk; ++kt) {
        const bool more = kt + 1 < nk;
        if (more) {
#pragma unroll
            for (int i = 0; i < MT; ++i) ra[i] = *(const u32x4*)(ap[i] + (size_t)(kt + 1) * as[i]);
#pragma unroll
            for (int i = 0; i < 2; ++i) rb[i] = *(const u32x4*)(bp[i] + (size_t)(kt + 1) * 64);
        }
        const unsigned char* Ab = lds + (kt & 1) * G::BUF; const unsigned char* Bb = Ab + G::ABYTES;
#pragma unroll
        for (int kk = 0; kk < 2; ++kk) {
            const int sw = kk ? sw1 : sw0;
            bf16x8 af[MT], bfr[4];
#pragma unroll
            for (int mt = 0; mt < MT; ++mt) af[mt] = *(const bf16x8*)(Ab + aro + mt * 2048 + sw);
#pragma unroll
            for (int nt = 0; nt < 4; ++nt) bfr[nt] = *(const bf16x8*)(Bb + bro + nt * 2048 + sw);
#pragma unroll
            for (int mt = 0; mt < MT; ++mt)
#pragma unroll
                for (int nt = 0; nt < 4; ++nt) acc[mt][nt] = __builtin_amdgcn_mfma_f32_16x16x32_bf16(bfr[nt], af[mt], acc[mt][nt], 0, 0, 0);
        }
        if (more) {
            unsigned char* nb = lds + ((kt + 1) & 1) * G::BUF;
#pragma unroll
            for (int i = 0; i < MT; ++i) *(u32x4*)(nb + i * 8192 + soff) = ra[i];
#pragma unroll
            for (int i = 0; i < 2; ++i) *(u32x4*)(nb + G::ABYTES + i * 8192 + soff) = rb[i];
        }
        __syncthreads();
    }
}
template <int MT>
DI void gemm_loop_alds(f32x4 (&acc)[MT][4], const unsigned char* abase, int apitch, const bf16* (&bp)[2], int nk, unsigned char* lds) {
    typedef GC<MT> G;
    const int tid = threadIdx.x, lane = tid & 63, wid = tid >> 6, wm = wid >> 1, wn = wid & 1, fr = lane & 15, fq = lane >> 4;
    const int srow = tid >> 3, sck = tid & 7;
    const int soff = srow * 128 + ((sck ^ (srow & 7)) << 4);
    u32x4 rb[2];
#pragma unroll
    for (int i = 0; i < 2; ++i) rb[i] = *(const u32x4*)(bp[i]);
#pragma unroll
    for (int i = 0; i < 2; ++i) *(u32x4*)(lds + G::ABYTES + i * 8192 + soff) = rb[i];
    __syncthreads();
    const int bro = (wn * 64 + fr) * 128;
    const int sw0 = ((0 + fq) ^ (fr & 7)) << 4, sw1 = ((4 + fq) ^ (fr & 7)) << 4;
    const unsigned char* arow = abase + (size_t)(wm * MT * 16 + fr) * apitch + fq * 16;
    for (int kt = 0; kt < nk; ++kt) {
        const bool more = kt + 1 < nk;
        if (more) {
#pragma unroll
            for (int i = 0; i < 2; ++i) rb[i] = *(const u32x4*)(bp[i] + (size_t)(kt + 1) * 64);
        }
        const unsigned char* Bb = lds + (kt & 1) * G::BUF + G::ABYTES;
#pragma unroll
        for (int kk = 0; kk < 2; ++kk) {
            const int sw = kk ? sw1 : sw0;
            bf16x8 af[MT], bfr[4];
#pragma unroll
            for (int mt = 0; mt < MT; ++mt) af[mt] = *(const bf16x8*)(arow + (size_t)mt * 16 * apitch + kt * 128 + kk * 64);
#pragma unroll
            for (int nt = 0; nt < 4; ++nt) bfr[nt] = *(const bf16x8*)(Bb + bro + nt * 2048 + sw);
#pragma unroll
            for (int mt = 0; mt < MT; ++mt)
#pragma unroll
                for (int nt = 0; nt < 4; ++nt) acc[mt][nt] = __builtin_amdgcn_mfma_f32_16x16x32_bf16(bfr[nt], af[mt], acc[mt][nt], 0, 0, 0);
        }
        if (more) {
            unsigned char* nb = lds + ((kt + 1) & 1) * G::BUF;
#pragma unroll
            for (int i = 0; i < 2; ++i) *(u32x4*)(nb + G::ABYTES + i * 8192 + soff) = rb[i];
        }
        __syncthreads();
    }
}
template <int MT> DI void zero_acc(f32x4 (&acc)[MT][4]) {
#pragma unroll
    for (int m = 0; m < MT; ++m)
#pragma unroll
        for (int n = 0; n < 4; ++n) acc[m][n] = (f32x4){0.f, 0.f, 0.f, 0.f};
}

DI void adaln_item(const Params& p, unsigned char* lds, int item) {
    float* scond = (float*)lds;
    float* red = scond + 9 * 1024;
    const int tid = threadIdx.x;
    for (int i = tid; i < 9 * 1024; i += NT) { const int r = i >> 10, k = i & 1023; const float v = r < 8 ? p.c[r * 1024 + k] : p.c_ctx[k]; scond[i] = v / (1.f + __expf(-v)); }
    __syncthreads();
    const int cc = tid & 63, ks = tid >> 6, col = item * 64 + cc;
    float a[9];
#pragma unroll
    for (int r = 0; r < 9; ++r) a[r] = 0.f;
    for (int k = ks * 128; k < ks * 128 + 128; ++k) {
        const float w = p.w_ada[(size_t)k * 6144 + col];
#pragma unroll
        for (int r = 0; r < 9; ++r) a[r] += scond[r * 1024 + k] * w;
    }
#pragma unroll
    for (int r = 0; r < 9; ++r) red[(ks * 9 + r) * 64 + cc] = a[r];
    __syncthreads();
    float* mod = (float*)(p.ws + WS_MOD);
    for (int o = tid; o < 9 * 64; o += NT) { const int r = o >> 6, c2 = o & 63; float s = 0.f;
#pragma unroll
        for (int q = 0; q < 8; ++q) s += red[(q * 9 + r) * 64 + c2];
        mod[r * 6144 + item * 64 + c2] = s + p.b_ada[item * 64 + c2]; }
    __syncthreads();
}
DI void tp_tile(const float* src, int ld, int k0, int n0, unsigned char* lds, bf16* dst, long row_stride_unused, int jobkind, int e) {
    float* tile = (float*)lds;
    const int tid = threadIdx.x;
    { const int nn = tid & 63, kk0 = tid >> 6;
#pragma unroll
      for (int i = 0; i < 8; ++i) { const int kk = kk0 + 8 * i; tile[kk * 65 + nn] = src[(size_t)(k0 + kk) * ld + n0 + nn]; } }
    __syncthreads();
    { const int n = tid >> 3, kc = tid & 7; const int ng = n0 + n;
      u32x4 o;
      o.x = pk2(tile[(kc * 8 + 0) * 65 + n], tile[(kc * 8 + 1) * 65 + n]); o.y = pk2(tile[(kc * 8 + 2) * 65 + n], tile[(kc * 8 + 3) * 65 + n]);
      o.z = pk2(tile[(kc * 8 + 4) * 65 + n], tile[(kc * 8 + 5) * 65 + n]); o.w = pk2(tile[(kc * 8 + 6) * 65 + n], tile[(kc * 8 + 7) * 65 + n]);
      size_t drow; int K;
      switch (jobkind) {
        case 0: drow = ng; K = 1024; break;
        case 1: drow = ng; K = 512; break;
        case 2: drow = ng; K = 1024; break;
        case 3: case 4: { const int h = ng, R = (h >> 6) * 128 + ((h >> 5) & 1) * 64 + (h & 31) + (jobkind == 4 ? 32 : 0); drow = (size_t)e * 512 + R; K = 1024; } break;
        default: drow = (size_t)e * 1024 + ng; K = 256; break;
      }
      *(u32x4*)(dst + drow * K + k0 + kc * 8) = o; }
    __syncthreads();
}
constexpr int TP_J0 = 16 * 8, TP_J1 = 8 * 8, TP_J2 = 16 * 16, TP_J3 = 32 * 16 * 4, TP_J4 = TP_J3, TP_J5 = 32 * 4 * 16;
constexpr int TP_ITEMS = TP_J0 + TP_J1 + TP_J2 + TP_J3 + TP_J4 + TP_J5;
DI void tp_item(const Params& p, unsigned char* lds, int it) {
    unsigned char* ws = p.ws;
    if (it < TP_J0) { tp_tile(p.w_in, 1024, (it >> 3) * 64, (it & 7) * 64, lds, (bf16*)(ws + WS_WINT), 0, 0, 0); return; } it -= TP_J0;
    if (it < TP_J1) { tp_tile(p.w_glu, 512, (it >> 3) * 64, (it & 7) * 64, lds, (bf16*)(ws + WS_WGLUT), 0, 1, 0); return; } it -= TP_J1;
    if (it < TP_J2) { tp_tile(p.w_out, 1024, (it >> 4) * 64, (it & 15) * 64, lds, (bf16*)(ws + WS_WOUTT), 0, 2, 0); return; } it -= TP_J2;
    if (it < TP_J3) { const int e = it >> 6, r = it & 63; tp_tile(p.w_gate + (size_t)e * 1024 * 256, 256, (r >> 2) * 64, (r & 3) * 64, lds, (bf16*)(ws + WS_WGUT), 0, 3, e); return; } it -= TP_J3;
    if (it < TP_J4) { const int e = it >> 6, r = it & 63; tp_tile(p.w_up + (size_t)e * 1024 * 256, 256, (r >> 2) * 64, (r & 3) * 64, lds, (bf16*)(ws + WS_WGUT), 0, 4, e); return; } it -= TP_J4;
    { const int e = it >> 6, r = it & 63; tp_tile(p.w_down + (size_t)e * 256 * 1024, 1024, (r >> 4) * 64, (r & 15) * 64, lds, (bf16*)(ws + WS_WDT), 0, 5, e); }
}
DI void gfold_item(const Params& p, unsigned char* lds, int item) {
    const int q = item >> 6, k0 = (item & 63) * 16, tid = threadIdx.x;
    float* wv = (float*)lds;
    float* T = wv + 16 * 128;
    float* fw = T + 16 * 2 * 128;
    float* cs = fw + 128 * 128;
    float* sn = cs + 128;
    for (int i = tid; i < 16 * 128; i += NT) wv[i] = p.w_in[(size_t)(k0 + (i >> 7)) * 1024 + 512 + 128 * q + (i & 127)];
    for (int i = tid; i < 128 * 128; i += NT) fw[i] = p.fourier_w[(size_t)q * 128 * 128 + i];
    if (tid < 128) { double s, c; sincospi((double)tid / 64.0, &s, &c); cs[tid] = (float)c; sn[tid] = (float)s; }
    __syncthreads();
    for (int o = tid; o < 16 * 128; o += NT) { const int r = o >> 7, n = o & 127; float sr = 0.f, si = 0.f;
        for (int m = 0; m < 128; ++m) { const float w = wv[r * 128 + m]; const int ix = (n * m) & 127; sr += w * cs[ix]; si -= w * sn[ix]; }
        T[(r * 2 + 0) * 128 + n] = sr; T[(r * 2 + 1) * 128 + n] = si; }
    __syncthreads();
    bf16* WinT = (bf16*)(p.ws + WS_WINT);
    const float scale = 1.0f / 724.0773439350247f;
    for (int o = tid; o < 16 * 2 * 128; o += NT) { const int r = o & 15, c = (o >> 4) & 1, j = o >> 5; float s = 0.f;
        for (int n = 0; n < 128; ++n) s += T[(r * 2 + c) * 128 + n] * fw[n * 128 + j];
        WinT[(size_t)(512 + c * 512 + q * 128 + j) * 1024 + k0 + r] = (bf16)(pk2(s * scale, 0.f) & 0xffffu); }
    __syncthreads();
}
DI void s5mats_item(const Params& p, unsigned char* lds, int g) {
    const int tid = threadIdx.x;
    float* Bb = (float*)lds;
    float* Cc = Bb + 4096;
    float* pw = Cc + 4096;
    float* Kt = pw + 8448;
    for (int idx = tid; idx < 2 * 64 * 33; idx += NT) { const int d = idx / (64 * 33), rem = idx % (64 * 33), pp = rem / 33, k = rem % 33;
        const double dt = exp((double)p.log_step[d * 32 + g]); const double lr = p.lam_re[(d * 32 + g) * 64 + pp], li = p.lam_im[(d * 32 + g) * 64 + pp];
        const double mag = exp(lr * dt * k); double tt = li * dt * k / 3.14159265358979323846; tt -= 2.0 * floor(tt * 0.5);
        double s, c; sincospi(tt, &s, &c); pw[idx * 2] = (float)(mag * c); pw[idx * 2 + 1] = (float)(mag * s); }
    for (int idx = tid; idx < 2 * 64 * 16; idx += NT) { const int d = idx >> 10, pp = (idx >> 4) & 63, h = idx & 15;
        const double dt = exp((double)p.log_step[d * 32 + g]); const double lr = p.lam_re[(d * 32 + g) * 64 + pp], li = p.lam_im[(d * 32 + g) * 64 + pp];
        const double mag = exp(lr * dt); double tt = li * dt / 3.14159265358979323846; tt -= 2.0 * floor(tt * 0.5);
        double s, c; sincospi(tt, &s, &c); const double nr = mag * c - 1.0, ni = mag * s, den = lr * lr + li * li;
        const double qr = (nr * lr + ni * li) / den, qi = (ni * lr - nr * li) / den;
        const double br = p.b_re[((size_t)(d * 32 + g) * 64 + pp) * 16 + h], bi = p.b_im[((size_t)(d * 32 + g) * 64 + pp) * 16 + h];
        Bb[idx * 2] = (float)(qr * br - qi * bi); Bb[idx * 2 + 1] = (float)(qr * bi + qi * br); }
    for (int idx = tid; idx < 2 * 16 * 64; idx += NT) { const int d = idx >> 10, i = (idx >> 6) & 15, pp = idx & 63;
        Cc[idx * 2] = p.c_re[((size_t)(d * 32 + g) * 16 + i) * 64 + pp]; Cc[idx * 2 + 1] = p.c_im[((size_t)(d * 32 + g) * 16 + i) * 64 + pp]; }
    __syncthreads();
    for (int idx = tid; idx < 16384; idx += NT) { const int d = idx >> 13, k = (idx >> 8) & 31, i = (idx >> 4) & 15, h = idx & 15; float s = 0.f;
        for (int pp = 0; pp < 64; ++pp) { const float cr = Cc[((d * 16 + i) * 64 + pp) * 2], ci = Cc[((d * 16 + i) * 64 + pp) * 2 + 1];
            const float wr = pw[((d * 64 + pp) * 33 + k) * 2], wi = pw[((d * 64 + pp) * 33 + k) * 2 + 1];
            const float xr = cr * wr - ci * wi, xi = cr * wi + ci * wr;
            s += xr * Bb[((d * 64 + pp) * 16 + h) * 2] - xi * Bb[((d * 64 + pp) * 16 + h) * 2 + 1]; }
        Kt[idx] = s; }
    __syncthreads();
    bf16* Mg = (bf16*)(p.ws + WS_MG) + (size_t)g * 512 * 512;
    for (int ch = tid; ch < 512 * 64; ch += NT) { const int row = ch >> 6, c8 = ch & 63, j = row >> 4, i = row & 15, s = c8 >> 1, h0 = (c8 & 1) * 8; float v[8];
#pragma unroll
        for (int t = 0; t < 8; ++t) { float a = 0.f; if (s <= j) a += Kt[((0 * 32 + (j - s)) * 16 + i) * 16 + h0 + t]; if (s >= j) a += Kt[((1 * 32 + (s - j)) * 16 + i) * 16 + h0 + t]; v[t] = a; }
        u32x4 o; o.x = pk2(v[0], v[1]); o.y = pk2(v[2], v[3]); o.z = pk2(v[4], v[5]); o.w = pk2(v[6], v[7]);
        *(u32x4*)(Mg + (size_t)row * 512 + c8 * 8) = o; }
    bf16* Wst = (bf16*)(p.ws + WS_WST) + (size_t)g * 256 * 512;
    for (int ch = tid; ch < 256 * 64; ch += NT) { const int r = ch >> 6, c8 = ch & 63, s = c8 >> 1, h0 = (c8 & 1) * 8, d = r >> 7, c = (r >> 6) & 1, pp = r & 63;
        const int e = d == 0 ? 31 - s : s; const float wr = pw[((d * 64 + pp) * 33 + e) * 2], wi = pw[((d * 64 + pp) * 33 + e) * 2 + 1]; float v[8];
#pragma unroll
        for (int t = 0; t < 8; ++t) { const float br = Bb[((d * 64 + pp) * 16 + h0 + t) * 2], bi = Bb[((d * 64 + pp) * 16 + h0 + t) * 2 + 1]; v[t] = c == 0 ? wr * br - wi * bi : wr * bi + wi * br; }
        u32x4 o; o.x = pk2(v[0], v[1]); o.y = pk2(v[2], v[3]); o.z = pk2(v[4], v[5]); o.w = pk2(v[6], v[7]);
        *(u32x4*)(Wst + (size_t)r * 512 + c8 * 8) = o; }
    bf16* Wos = (bf16*)(p.ws + WS_WOS) + (size_t)g * 512 * 256;
    for (int ch = tid; ch < 512 * 32; ch += NT) { const int row = ch >> 5, c8 = ch & 31, j = row >> 4, i = row & 15, col0 = c8 * 8, d = col0 >> 7, c = (col0 >> 6) & 1, p0 = col0 & 63;
        const int e = d == 0 ? j + 1 : 32 - j; float v[8];
#pragma unroll
        for (int t = 0; t < 8; ++t) { const int pp = p0 + t; const float cr = Cc[((d * 16 + i) * 64 + pp) * 2], ci = Cc[((d * 16 + i) * 64 + pp) * 2 + 1];
            const float wr = pw[((d * 64 + pp) * 33 + e) * 2], wi = pw[((d * 64 + pp) * 33 + e) * 2 + 1]; v[t] = c == 0 ? cr * wr - ci * wi : -(cr * wi + ci * wr); }
        u32x4 o; o.x = pk2(v[0], v[1]); o.y = pk2(v[2], v[3]); o.z = pk2(v[4], v[5]); o.w = pk2(v[6], v[7]);
        *(u32x4*)(Wos + (size_t)row * 256 + c8 * 8) = o; }
    float* aT = (float*)(p.ws + WS_ABART) + g * 256;
    if (tid < 128) { const int d = tid >> 6, pp = tid & 63; aT[tid * 2] = pw[((d * 64 + pp) * 33 + 32) * 2]; aT[tid * 2 + 1] = pw[((d * 64 + pp) * 33 + 32) * 2 + 1]; }
    __syncthreads();
}
DI void fftc_item(const Params& p, int item) {
    const int tid = threadIdx.x;
    bf16* W1 = (bf16*)(p.ws + WS_FFTC);
    bf16* W2 = W1 + 128 * 128;
    float* tw = (float*)(p.ws + WS_FFTC + 32768 + 16384);
    for (int idx = item * NT + tid; idx < 128 * 128 + 4 * 64 * 32 + 4096; idx += 8 * NT) {
        if (idx < 16384) { const int n = idx >> 7, k = idx & 127, co = n >> 6, d = n & 63, ci = k >> 6, bq = k & 63; double s, c; sincospi((double)((d * bq) & 63) / 32.0, &s, &c);
            const float v = (ci == co) ? (float)c : (ci == 1 ? (float)s : (float)(-s)); W1[idx] = (bf16)(pk2(v, 0.f) & 0xffffu); }
        else if (idx < 16384 + 8192) { const int i2 = idx - 16384, s_ = i2 >> 11, cf = (i2 >> 5) & 63, slot = i2 & 31, gq = slot >> 3, jp = slot & 7;
            const int a = 16 * (2 * (s_ & 1) + (jp >> 2)) + 4 * gq + (jp & 3); double s, c; sincospi((double)((cf * a) & 63) / 32.0, &s, &c);
            W2[i2] = (bf16)(pk2((s_ >> 1) == 0 ? (float)c : (float)s, 0.f) & 0xffffu); }
        else { const int i3 = idx - 16384 - 8192; double s, c; sincospi((double)i3 / 2048.0, &s, &c); tw[i3 * 2] = (float)c; tw[i3 * 2 + 1] = (float)s; }
    }
}
constexpr int P0_S5 = 32, P0_GF = 256, P0_ADA = 96, P0_FC = 8;
constexpr int P0_ITEMS = P0_S5 + P0_GF + P0_ADA + P0_FC + TP_ITEMS;
DI void phase0(const Params& p, unsigned char* lds, int bid, int nb) {
    for (int it = bid; it < P0_ITEMS; it += nb) {
        int r = it;
        if (r < P0_S5) { s5mats_item(p, lds, r); continue; } r -= P0_S5;
        if (r < P0_GF) { gfold_item(p, lds, r); continue; } r -= P0_GF;
        if (r < P0_ADA) { adaln_item(p, lds, r); continue; } r -= P0_ADA;
        if (r < P0_FC) { fftc_item(p, r); continue; } r -= P0_FC;
        tp_item(p, lds, r);
    }
}

DI void phase1a(const Params& p, int bid, int nb) {
    const int lane = threadIdx.x & 63, wave = threadIdx.x >> 6;
    const float* mod = (const float*)(p.ws + WS_MOD);
    bf16* A1 = (bf16*)(p.ws + WS_R1);
    for (int r = bid * 8 + wave; r < NROWS1; r += nb * 8) {
        const float* src = r < NTOK ? p.x + (size_t)r * D : p.ctx + (size_t)(r - NTOK) * D;
        const int mr = r < NTOK ? (r >> 12) : 8;
        const f32x4* xr = (const f32x4*)src + lane;
        f32x4 v[4]; float s = 0.f;
#pragma unroll
        for (int j = 0; j < 4; ++j) { v[j] = xr[64 * j]; s += v[j].x * v[j].x + v[j].y * v[j].y + v[j].z * v[j].z + v[j].w * v[j].w; }
        const float rs = rsqrtf(wave_sum(s) * (1.f / D) + EPS);
        u32x2* o = (u32x2*)(A1 + (size_t)r * D) + lane;
#pragma unroll
        for (int j = 0; j < 4; ++j) { const int k = lane * 4 + 256 * j;
            const f32x4 g = *(const f32x4*)(p.norm1_g + k), sh = *(const f32x4*)(mod + mr * 6144 + k), sc = *(const f32x4*)(mod + mr * 6144 + 1024 + k);
            const f32x4 h = v[j] * rs * g * (sc + 1.f) + sh; u32x2 w; w.x = pk2(h.x, h.y); w.y = pk2(h.z, h.w); o[64 * j] = w; }
    }
}
DI void phase1b(const Params& p, unsigned char* lds, int bid, int nb) {
    const int tid = threadIdx.x, lane = tid & 63, wid = tid >> 6, wm = wid >> 1, wn = wid & 1, fr = lane & 15, fq = lane >> 4, srow = tid >> 3, sck = tid & 7;
    const bf16* A1 = (const bf16*)(p.ws + WS_R1); const bf16* WinT = (const bf16*)(p.ws + WS_WINT);
    bf16* Ul = (bf16*)(p.ws + WS_R3); bf16* Uc = Ul + (size_t)32 * 8 * 4096 * 16; bf16* GT = (bf16*)(p.ws + WS_R2);
    constexpr int NU = 136 * 4, NG = 256 * 4;
    for (int item = bid; item < NU + NG; item += nb) {
        f32x4 acc[4][4]; zero_acc<4>(acc);
        const bf16* ap[4]; int as[4]; const bf16* bp[2];
        if (item < NU) {
            const int m0 = (item >> 2) * 256, n0 = (item & 3) * 128;
#pragma unroll
            for (int i = 0; i < 4; ++i) { ap[i] = A1 + (size_t)(m0 + 64 * i + srow) * D + sck * 8; as[i] = 64; }
#pragma unroll
            for (int i = 0; i < 2; ++i) bp[i] = WinT + (size_t)(n0 + 64 * i + srow) * D + sck * 8;
            gemm_loop<4>(acc, ap, as, bp, 16, lds);
#pragma unroll
            for (int mt = 0; mt < 4; ++mt) { const int row = m0 + wm * 64 + mt * 16 + fr;
#pragma unroll
                for (int nt = 0; nt < 4; ++nt) { const int col = n0 + wn * 64 + nt * 16 + 4 * fq, g = col >> 4, h = col & 15;
                    u32x2 w; w.x = pk2(acc[mt][nt][0], acc[mt][nt][1]); w.y = pk2(acc[mt][nt][2], acc[mt][nt][3]);
                    bf16* dst = row < NTOK ? Ul + (((size_t)(g * 8 + (row >> 12)) * 4096 + (row & 4095)) * 16 + h)
                                           : Uc + (((size_t)(g * 8 + ((row - NTOK) >> 8)) * 256 + ((row - NTOK) & 255)) * 16 + h);
                    *(u32x2*)dst = w; } }
        } else {
            const int it2 = item - NU, ct = it2 & 3, tt = it2 >> 2, b = tt >> 5, a0 = (tt & 31) * 2;
#pragma unroll
            for (int i = 0; i < 4; ++i) { ap[i] = WinT + (size_t)(512 + ct * 256 + 64 * i + srow) * D + sck * 8; as[i] = 64; }
#pragma unroll
            for (int i = 0; i < 2; ++i) bp[i] = A1 + (size_t)(b * 4096 + srow * 64 + a0 + i) * D + sck * 8;
            gemm_loop<4>(acc, ap, as, bp, 16, lds);
#pragma unroll
            for (int mt = 0; mt < 4; ++mt) { const int m = ct * 256 + wm * 64 + mt * 16 + fr, c = m >> 9, ch = m & 511;
#pragma unroll
                for (int nt = 0; nt < 4; ++nt) { const int a = a0 + wn, bq = nt * 16 + 4 * fq;
                    u32x2 w; w.x = pk2(acc[mt][nt][0], acc[mt][nt][1]); w.y = pk2(acc[mt][nt][2], acc[mt][nt][3]);
                    *(u32x2*)(GT + ((size_t)((b * 512 + ch) * 2 + c) * 4096 + a * 64 + bq)) = w; } }
        }
    }
}
constexpr int S5_SB_OFF = GC<2>::LDS, S5_PITCH = 528, S5_LDS = S5_SB_OFF + 144 * S5_PITCH;
DI void phase2_s5(const Params& p, unsigned char* lds, int bid, int nb) {
    const int tid = threadIdx.x, lane = tid & 63, wid = tid >> 6, wm = wid >> 1, wn = wid & 1, fr = lane & 15, fq = lane >> 4, srow = tid >> 3, sck = tid & 7;
    const bf16* zero = (const bf16*)(p.ws + WS_CTL + CTL_ZERO);
    unsigned char* Sb = lds + S5_SB_OFF;
    for (int item = bid; item < 256; item += nb) {
        const int g = item >> 3, b = item & 7;
        const bf16* Ul = (const bf16*)(p.ws + WS_R3) + (size_t)(g * 8 + b) * 4096 * 16;
        const bf16* Uc = (const bf16*)(p.ws + WS_R3) + (size_t)32 * 8 * 4096 * 16 + (size_t)(g * 8 + b) * 256 * 16;
        const bf16* Wst = (const bf16*)(p.ws + WS_WST) + (size_t)g * 256 * 512;
        const bf16* Mg = (const bf16*)(p.ws + WS_MG) + (size_t)g * 512 * 512;
        const bf16* Wos = (const bf16*)(p.ws + WS_WOS) + (size_t)g * 512 * 256;
        for (int pass = 0; pass < 4; ++pass) {
            const int n0 = (pass & 1) * 128, isctx = pass >> 1;
            f32x4 acc[2][4]; zero_acc<2>(acc);
            const bf16* ap[2]; int as[2]; const bf16* bp[2];
#pragma unroll
            for (int i = 0; i < 2; ++i) { const int r = 64 * i + srow;
                if (!isctx) { ap[i] = Ul + (size_t)r * 512 + sck * 8; as[i] = 64; }
                else if (r < 8) { ap[i] = Uc + (size_t)r * 512 + sck * 8; as[i] = 64; }
                else { ap[i] = zero; as[i] = 0; }
                bp[i] = Wst + (size_t)(n0 + r) * 512 + sck * 8; }
            gemm_loop<2>(acc, ap, as, bp, 8, lds);
#pragma unroll
            for (int mt = 0; mt < 2; ++mt) { const int row = wm * 32 + mt * 16 + fr;
                if (!isctx || row < 8) {
#pragma unroll
                    for (int nt = 0; nt < 4; ++nt) { const int col = n0 + wn * 64 + nt * 16 + 4 * fq;
                        u32x2 w; w.x = pk2(acc[mt][nt][0], acc[mt][nt][1]); w.y = pk2(acc[mt][nt][2], acc[mt][nt][3]);
                        *(u32x2*)(Sb + (size_t)((isctx ? 128 : 0) + row) * S5_PITCH + col * 2) = w; } } }
        }
        __syncthreads();
        if (tid < 128) {
            const int d = tid >> 6, pp = tid & 63; const float* aT = (const float*)(p.ws + WS_ABART) + g * 256 + tid * 2; const float ar = aT[0], ai = aT[1];
            bf16* colr = (bf16*)Sb + d * 128 + pp; bf16* coli = colr + 64; constexpr int RP = S5_PITCH / 2;
            float hr = 0.f, hi = 0.f;
            if (d == 0) {
                for (int c = 0; c < 8; ++c) { const float sr = bf2f(colr[(128 + c) * RP]), si = bf2f(coli[(128 + c) * RP]); const float nr = ar * hr - ai * hi + sr, ni = ar * hi + ai * hr + si; hr = nr; hi = ni; }
                for (int c = 0; c < 128; ++c) { const float sr = bf2f(colr[c * RP]), si = bf2f(coli[c * RP]); const unsigned w = pk2(hr, hi); colr[c * RP] = (bf16)(w & 0xffffu); coli[c * RP] = (bf16)(w >> 16);
                    const float nr = ar * hr - ai * hi + sr, ni = ar * hi + ai * hr + si; hr = nr; hi = ni; }
            } else {
                for (int c = 7; c >= 0; --c) { const float sr = bf2f(colr[(128 + c) * RP]), si = bf2f(coli[(128 + c) * RP]); const float nr = ar * hr - ai * hi + sr, ni = ar * hi + ai * hr + si; hr = nr; hi = ni; }
                for (int c = 127; c >= 0; --c) { const float sr = bf2f(colr[c * RP]), si = bf2f(coli[c * RP]); const unsigned w = pk2(hr, hi); colr[c * RP] = (bf16)(w & 0xffffu); coli[c * RP] = (bf16)(w >> 16);
                    const float nr = ar * hr - ai * hi + sr, ni = ar * hi + ai * hr + si; hr = nr; hi = ni; }
            }
        }
        __syncthreads();
        bf16* yact = (bf16*)(p.ws + WS_R4);
        for (int pass = 0; pass < 4; ++pass) {
            const int n0 = pass * 128;
            f32x4 acc[2][4]; zero_acc<2>(acc);
            const bf16* ap[2]; int as[2]; const bf16* bp[2];
#pragma unroll
            for (int i = 0; i < 2; ++i) { const int r = 64 * i + srow; ap[i] = Ul + (size_t)r * 512 + sck * 8; as[i] = 64; bp[i] = Mg + (size_t)(n0 + r) * 512 + sck * 8; }
            gemm_loop<2>(acc, ap, as, bp, 8, lds);
#pragma unroll
            for (int i = 0; i < 2; ++i) bp[i] = Wos + (size_t)(n0 + 64 * i + srow) * 256 + sck * 8;
            gemm_loop_alds<2>(acc, Sb, S5_PITCH, bp, 4, lds);
#pragma unroll
            for (int mt = 0; mt < 2; ++mt) { const int c = wm * 32 + mt * 16 + fr;
#pragma unroll
                for (int nt = 0; nt < 4; ++nt) { const int col = n0 + wn * 64 + nt * 16 + 4 * fq, j = col >> 4, i0 = col & 15, l = 32 * c + j;
                    const u32x2 uu = *(const u32x2*)(Ul + (size_t)l * 16 + i0); const f32x4 dd = *(const f32x4*)(p.s5_d + g * 16 + i0);
                    const float y0 = geluf_(acc[mt][nt][0] + dd.x * __uint_as_float(uu.x << 16)), y1 = geluf_(acc[mt][nt][1] + dd.y * __uint_as_float(uu.x & 0xffff0000u));
                    const float y2 = geluf_(acc[mt][nt][2] + dd.z * __uint_as_float(uu.y << 16)), y3 = geluf_(acc[mt][nt][3] + dd.w * __uint_as_float(uu.y & 0xffff0000u));
                    u32x2 w; w.x = pk2(y0, y1); w.y = pk2(y2, y3);
                    *(u32x2*)(yact + ((size_t)(b * 4096 + l) * 512 + g * 16 + i0)) = w; } }
        }
        __syncthreads();
    }
}
constexpr int FF_W1P = 272, FF_W2P = 80, FF_W1_OFF = 0, FF_W2_OFF = 128 * FF_W1P, FF_TW_OFF = FF_W2_OFF + 4 * 64 * FF_W2P, FF_LDS = FF_TW_OFF + 32768;
DI void phase2_fft(const Params& p, unsigned char* lds, int bid, int nb) {
    const int tid = threadIdx.x, lane = tid & 63, wid = tid >> 6, fr = lane & 15, fq = lane >> 4;
    { const bf16* W1 = (const bf16*)(p.ws + WS_FFTC); const bf16* W2 = W1 + 128 * 128; const float* tw = (const float*)(p.ws + WS_FFTC + 32768 + 16384);
      for (int i = tid; i < 128 * 16; i += NT) { const int n = i >> 4, c = i & 15; *(u32x4*)(lds + FF_W1_OFF + n * FF_W1P + c * 16) = *(const u32x4*)(W1 + n * 128 + c * 8); }
      for (int i = tid; i < 256 * 4; i += NT) { const int r = i >> 2, c = i & 3; *(u32x4*)(lds + FF_W2_OFF + r * FF_W2P + c * 16) = *(const u32x4*)(W2 + r * 32 + c * 8); }
      for (int i = tid; i < 2048; i += NT) *(u32x4*)(lds + FF_TW_OFF + i * 16) = *(const u32x4*)(tw + i * 4);
      __syncthreads(); }
    const bf16* GT = (const bf16*)(p.ws + WS_R2); bf16* FT = (bf16*)(p.ws + WS_R5);
    const float* twl = (const float*)(lds + FF_TW_OFF);
    for (int cidx = bid * 8 + wid; cidx < 4096; cidx += nb * 8) {
        const bf16* gt = GT + (size_t)cidx * 2 * 4096;
        bf16* ft = FT + (size_t)cidx * 4096;
#pragma unroll 1
        for (int nt = 0; nt < 4; ++nt) {
            f32x4 dre[4], dim[4];
#pragma unroll
            for (int m = 0; m < 4; ++m) { dre[m] = (f32x4){0.f, 0.f, 0.f, 0.f}; dim[m] = (f32x4){0.f, 0.f, 0.f, 0.f}; }
#pragma unroll
            for (int ks = 0; ks < 4; ++ks) {
                bf16x8 afr[4];
#pragma unroll
                for (int mt = 0; mt < 4; ++mt) afr[mt] = *(const bf16x8*)(gt + (ks >> 1) * 4096 + (16 * mt + fr) * 64 + 32 * (ks & 1) + 8 * fq);
                const bf16x8 bre = *(const bf16x8*)(lds + FF_W1_OFF + (nt * 16 + fr) * FF_W1P + (ks * 32 + fq * 8) * 2);
                const bf16x8 bim = *(const bf16x8*)(lds + FF_W1_OFF + (64 + nt * 16 + fr) * FF_W1P + (ks * 32 + fq * 8) * 2);
#pragma unroll
                for (int mt = 0; mt < 4; ++mt) { dre[mt] = __builtin_amdgcn_mfma_f32_16x16x32_bf16(afr[mt], bre, dre[mt], 0, 0, 0);
                                                 dim[mt] = __builtin_amdgcn_mfma_f32_16x16x32_bf16(afr[mt], bim, dim[mt], 0, 0, 0); }
            }
            const int d = 16 * nt + fr; unsigned pr[4][2], pi[4][2];
#pragma unroll
            for (int mt = 0; mt < 4; ++mt) { float tr[4], ti[4];
#pragma unroll
                for (int r = 0; r < 4; ++r) { const int a = 16 * mt + 4 * fq + r, ix = (d * a) & 4095; const float cs = twl[ix * 2], sn = twl[ix * 2 + 1];
                    const float re = dre[mt][r], im = dim[mt][r]; tr[r] = re * cs + im * sn; ti[r] = im * cs - re * sn; }
                pr[mt][0] = pk2(tr[0], tr[1]); pr[mt][1] = pk2(tr[2], tr[3]); pi[mt][0] = pk2(ti[0], ti[1]); pi[mt][1] = pk2(ti[2], ti[3]); }
            u32x4 f0, f1, f2, f3;
            f0.x = pr[0][0]; f0.y = pr[0][1]; f0.z = pr[1][0]; f0.w = pr[1][1];
            f1.x = pr[2][0]; f1.y = pr[2][1]; f1.z = pr[3][0]; f1.w = pr[3][1];
            f2.x = pi[0][0]; f2.y = pi[0][1]; f2.z = pi[1][0]; f2.w = pi[1][1];
            f3.x = pi[2][0]; f3.y = pi[2][1]; f3.z = pi[3][0]; f3.w = pi[3][1];
            bf16x8 frag[4];
            frag[0] = __builtin_bit_cast(bf16x8, f0); frag[1] = __builtin_bit_cast(bf16x8, f1); frag[2] = __builtin_bit_cast(bf16x8, f2); frag[3] = __builtin_bit_cast(bf16x8, f3);
            f32x4 z[4];
#pragma unroll
            for (int n = 0; n < 4; ++n) z[n] = (f32x4){0.f, 0.f, 0.f, 0.f};
#pragma unroll
            for (int s2 = 0; s2 < 4; ++s2)
#pragma unroll
                for (int n2 = 0; n2 < 4; ++n2) { const bf16x8 bfr = *(const bf16x8*)(lds + FF_W2_OFF + ((s2 * 64 + n2 * 16 + fr) * FF_W2P) + fq * 16);
                    z[n2] = __builtin_amdgcn_mfma_f32_16x16x32_bf16(frag[s2], bfr, z[n2], 0, 0, 0); }
#pragma unroll
            for (int n2 = 0; n2 < 4; ++n2) { const int cf = 16 * n2 + fr; u32x2 w; w.x = pk2(z[n2][0], z[n2][1]); w.y = pk2(z[n2][2], z[n2][3]);
                *(u32x2*)(ft + 64 * cf + 16 * nt + 4 * fq) = w; }
        }
    }
}
DI void phase3_glu(const Params& p, unsigned char* lds, int bid, int nb) {
    const int tid = threadIdx.x, lane = tid & 63, wid = tid >> 6, wm = wid >> 1, wn = wid & 1, fr = lane & 15, fq = lane >> 4, srow = tid >> 3, sck = tid & 7;
    const bf16* yact = (const bf16*)(p.ws + WS_R4); const bf16* Wg = (const bf16*)(p.ws + WS_WGLUT); bf16* merged = (bf16*)(p.ws + WS_R1);
    for (int item = bid; item < 128 * 4; item += nb) {
        const int m0 = (item >> 2) * 256, n0 = (item & 3) * 128;
        f32x4 acc[4][4]; zero_acc<4>(acc);
        const bf16* ap[4]; int as[4]; const bf16* bp[2];
#pragma unroll
        for (int i = 0; i < 4; ++i) { ap[i] = yact + (size_t)(m0 + 64 * i + srow) * 512 + sck * 8; as[i] = 64; }
#pragma unroll
        for (int i = 0; i < 2; ++i) bp[i] = Wg + (size_t)(n0 + 64 * i + srow) * 512 + sck * 8;
        gemm_loop<4>(acc, ap, as, bp, 8, lds);
#pragma unroll
        for (int mt = 0; mt < 4; ++mt) { const int row = m0 + wm * 64 + mt * 16 + fr;
#pragma unroll
            for (int nt = 0; nt < 4; ++nt) { const int col = n0 + wn * 64 + nt * 16 + 4 * fq;
                const u32x2 yy = *(const u32x2*)(yact + (size_t)row * 512 + col);
                const float y0 = __uint_as_float(yy.x << 16) * sigmoidf_(acc[mt][nt][0]), y1 = __uint_as_float(yy.x & 0xffff0000u) * sigmoidf_(acc[mt][nt][1]);
                const float y2 = __uint_as_float(yy.y << 16) * sigmoidf_(acc[mt][nt][2]), y3 = __uint_as_float(yy.y & 0xffff0000u) * sigmoidf_(acc[mt][nt][3]);
                u32x2 w; w.x = pk2(y0, y1); w.y = pk2(y2, y3); *(u32x2*)(merged + (size_t)row * 1024 + col) = w; } }
    }
}
constexpr int FM_PITCH = 132, FM_LDS = 512 * FM_PITCH;
DI void phase3_fin(const Params& p, unsigned char* lds, int bid, int nb) {
    const int tid = threadIdx.x, lane = tid & 63, wid = tid >> 6;
    const bf16* FT = (const bf16*)(p.ws + WS_R5); bf16* merged = (bf16*)(p.ws + WS_R1);
    for (int item = bid; item < 512; item += nb) {
        const int b = item >> 6, k0 = (item & 63) * 64;
        for (int i = tid; i < 512 * 8; i += NT) { const int ch = i >> 3, c = i & 7; const u32x4 v = *(const u32x4*)(FT + ((size_t)(b * 512 + ch) * 4096 + k0 + c * 8));
            unsigned* d = (unsigned*)(lds + ch * FM_PITCH + c * 16); d[0] = v.x; d[1] = v.y; d[2] = v.z; d[3] = v.w; }
        __syncthreads();
        for (int t = wid * 8; t < wid * 8 + 8; ++t) {
            const size_t row = (size_t)b * 4096 + k0 + t;
            float f[8]; float s = 0.f;
#pragma unroll
            for (int j = 0; j < 8; ++j) { f[j] = bf2f(*(const bf16*)(lds + (lane + 64 * j) * FM_PITCH + t * 2)); s += f[j] * f[j]; }
            const float rs = rsqrtf(wave_sum(s) * (1.f / 512.f) + EPS);
#pragma unroll
            for (int j = 0; j < 8; ++j) merged[row * 1024 + 512 + lane + 64 * j] = (bf16)(pk2(f[j] * rs * p.g_f[lane + 64 * j], 0.f) & 0xffffu);
            u32x4 yv = *(const u32x4*)(merged + row * 1024 + lane * 8);
            float y[8]; y[0] = __uint_as_float(yv.x << 16); y[1] = __uint_as_float(yv.x & 0xffff0000u); y[2] = __uint_as_float(yv.y << 16); y[3] = __uint_as_float(yv.y & 0xffff0000u);
            y[4] = __uint_as_float(yv.z << 16); y[5] = __uint_as_float(yv.z & 0xffff0000u); y[6] = __uint_as_float(yv.w << 16); y[7] = __uint_as_float(yv.w & 0xffff0000u);
            float s2 = 0.f;
#pragma unroll
            for (int j = 0; j < 8; ++j) s2 += y[j] * y[j];
            const float rs2 = rsqrtf(wave_sum(s2) * (1.f / 512.f) + EPS);
            const f32x4 g0 = *(const f32x4*)(p.g_s + lane * 8), g1 = *(const f32x4*)(p.g_s + lane * 8 + 4);
            u32x4 o; o.x = pk2(y[0] * rs2 * g0.x, y[1] * rs2 * g0.y); o.y = pk2(y[2] * rs2 * g0.z, y[3] * rs2 * g0.w); o.z = pk2(y[4] * rs2 * g1.x, y[5] * rs2 * g1.y); o.w = pk2(y[6] * rs2 * g1.z, y[7] * rs2 * g1.w);
            *(u32x4*)(merged + row * 1024 + lane * 8) = o;
        }
        __syncthreads();
    }
}
DI void phase4_out(const Params& p, unsigned char* lds, int bid, int nb) {
    const int tid = threadIdx.x, lane = tid & 63, wid = tid >> 6, wm = wid >> 1, wn = wid & 1, fr = lane & 15, fq = lane >> 4, srow = tid >> 3, sck = tid & 7;
    const bf16* merged = (const bf16*)(p.ws + WS_R1); const bf16* Wo = (const bf16*)(p.ws + WS_WOUTT); const float* mod = (const float*)(p.ws + WS_MOD);
    float* rsq = (float*)(p.ws + WS_CTL + CTL_RSQ1);
    for (int item = bid; item < 128 * 8; item += nb) {
        const int m0 = (item >> 3) * 256, n0 = (item & 7) * 128;
        f32x4 acc[4][4]; zero_acc<4>(acc);
        const bf16* ap[4]; int as[4]; const bf16* bp[2];
#pragma unroll
        for (int i = 0; i < 4; ++i) { ap[i] = merged + (size_t)(m0 + 64 * i + srow) * 1024 + sck * 8; as[i] = 64; }
#pragma unroll
        for (int i = 0; i < 2; ++i) bp[i] = Wo + (size_t)(n0 + 64 * i + srow) * 1024 + sck * 8;
        gemm_loop<4>(acc, ap, as, bp, 16, lds);
#pragma unroll
        for (int mt = 0; mt < 4; ++mt) { const int row = m0 + wm * 64 + mt * 16 + fr, b = row >> 12; float s = 0.f;
#pragma unroll
            for (int nt = 0; nt < 4; ++nt) { const int col = n0 + wn * 64 + nt * 16 + 4 * fq;
                const f32x4 xv = *(const f32x4*)(p.x + (size_t)row * D + col), gv = *(const f32x4*)(mod + b * 6144 + 2048 + col);
                const f32x4 o = xv + gv * acc[mt][nt]; *(f32x4*)(p.out + (size_t)row * D + col) = o; s += o.x * o.x + o.y * o.y + o.z * o.z + o.w * o.w; }
            s += __shfl_xor(s, 16); s += __shfl_xor(s, 32);
            if (fq == 0) atomicAdd(rsq + row, s); }
    }
}
DI int pair_index(int lo, int hi) { return 7 * lo - (lo * (lo - 1)) / 2 + (hi - lo - 1); }
constexpr int RT_LDS = 1024 * 36 * 4;
DI void phase5_route(const Params& p, unsigned char* lds, int bid, int nb) {
    const int tid = threadIdx.x, lane = tid & 63, wid = tid >> 6;
    float* wr = (float*)lds;
    for (int i = tid; i < 1024 * 36; i += NT) { const int k = i / 36, o = i % 36; wr[i] = o < 4 ? p.w_group[k * 4 + o] : p.w_router[k * 32 + (o - 4)]; }
    __syncthreads();
    const float* mod = (const float*)(p.ws + WS_MOD); const float* rsq = (const float*)(p.ws + WS_CTL + CTL_RSQ1);
    bf16* A2 = (bf16*)(p.ws + WS_R2); float* gw = (float*)(p.ws + WS_GW);
    unsigned* ecnt = (unsigned*)(p.ws + WS_CTL + CTL_ECNT); unsigned* pcnt = (unsigned*)(p.ws + WS_CTL + CTL_PCNT);
    unsigned* elist = (unsigned*)(p.ws + WS_ELIST); unsigned* plist = (unsigned*)(p.ws + WS_PLIST);
    for (int row = bid * 8 + wid; row < NTOK; row += nb * 8) {
        const int b = row >> 12; const float rs = rsqrtf(rsq[row] * (1.f / D) + EPS);
        float acc[36];
#pragma unroll
        for (int o = 0; o < 36; ++o) acc[o] = 0.f;
#pragma unroll 1
        for (int j = 0; j < 4; ++j) { const int k = lane * 4 + 256 * j;
            const f32x4 xv = *(const f32x4*)(p.out + (size_t)row * D + k), g = *(const f32x4*)(p.norm2_g + k), sh = *(const f32x4*)(mod + b * 6144 + 3072 + k), sc = *(const f32x4*)(mod + b * 6144 + 4096 + k);
            const f32x4 t = xv * rs * g * (sc + 1.f) + sh;
            u32x2 w; w.x = pk2(t.x, t.y); w.y = pk2(t.z, t.w); *(u32x2*)(A2 + (size_t)row * D + k) = w;
#pragma unroll 1
            for (int e = 0; e < 4; ++e) { const float tv = e == 0 ? t.x : (e == 1 ? t.y : (e == 2 ? t.z : t.w)); const f32x4* wp = (const f32x4*)(wr + (k + e) * 36);
#pragma unroll
                for (int o4 = 0; o4 < 9; ++o4) { const f32x4 wv = wp[o4]; acc[o4 * 4] += tv * wv.x; acc[o4 * 4 + 1] += tv * wv.y; acc[o4 * 4 + 2] += tv * wv.z; acc[o4 * 4 + 3] += tv * wv.w; } } }
#pragma unroll
        for (int o = 0; o < 36; ++o) acc[o] = wave_sum(acc[o]);
        if (lane == 0) {
            float gl[4];
#pragma unroll
            for (int o = 0; o < 4; ++o) gl[o] = acc[o] + p.b_group[o];
            float gmax = gl[0]; int gi = 0;
#pragma unroll
            for (int o = 1; o < 4; ++o) if (gl[o] > gmax) { gmax = gl[o]; gi = o; }
            float se = 0.f;
#pragma unroll
            for (int o = 0; o < 4; ++o) se += __expf(gl[o] - gmax);
            const float g_w = 1.f / se;
            float ev[8];
#pragma unroll
            for (int o = 0; o < 8; ++o) { float v = 0.f;
#pragma unroll
                for (int q = 0; q < 4; ++q) v = (q == gi) ? acc[4 + q * 8 + o] + p.b_router[q * 8 + o] : v;
                ev[o] = v; }
            float v1 = ev[0]; int i1 = 0;
#pragma unroll
            for (int o = 1; o < 8; ++o) if (ev[o] > v1) { v1 = ev[o]; i1 = o; }
            float v2 = -3.0e38f; int i2 = -1;
#pragma unroll
            for (int o = 0; o < 8; ++o) if (o != i1 && ev[o] > v2) { v2 = ev[o]; i2 = o; }
            const float w1 = g_w / (1.f + __expf(v2 - v1)), w2 = g_w - w1;
            const int lo = i1 < i2 ? i1 : i2, hi = i1 < i2 ? i2 : i1; const int pos1 = i1 < i2 ? 0 : 1;
            gw[row * 2 + pos1] = w1; gw[row * 2 + (1 - pos1)] = w2;
            const int e1 = gi * 8 + i1, e2 = gi * 8 + i2;
            const unsigned q1 = atomicAdd(ecnt + e1, 1u); elist[(size_t)e1 * 32768 + q1] = (unsigned)row * 2u + (unsigned)pos1;
            const unsigned q2 = atomicAdd(ecnt + e2, 1u); elist[(size_t)e2 * 32768 + q2] = (unsigned)row * 2u + (unsigned)(1 - pos1);
            const int cls = gi * 28 + pair_index(lo, hi);
            const unsigned q3 = atomicAdd(pcnt + cls, 1u); plist[(size_t)cls * 32768 + q3] = (unsigned)row;
        }
    }
}
constexpr int TB_OFF = 98304, TB_BYTES = (64 + 2048) * 4;
DI void build_tiles(const Params& p, unsigned char* lds) {
    if (threadIdx.x == 0) {
        int* tb = (int*)(lds + TB_OFF); const unsigned* ecnt = (const unsigned*)(p.ws + WS_CTL + CTL_ECNT); const unsigned* pcnt = (const unsigned*)(p.ws + WS_CTL + CTL_PCNT);
        int n = 0;
        for (int e = 0; e < 32; ++e) { const int c = (int)ecnt[e]; for (int r0 = 0; r0 < c; r0 += 256) { tb[64 + n] = e; tb[64 + 512 + n] = r0; ++n; } }
        tb[0] = n; n = 0;
        for (int c2 = 0; c2 < 112; ++c2) { const int c = (int)pcnt[c2]; for (int r0 = 0; r0 < c; r0 += 256) { tb[64 + 1024 + n] = c2; tb[64 + 1536 + n] = r0; ++n; } }
        tb[1] = n;
    }
    __syncthreads();
}
DI void phase6_gateup(const Params& p, unsigned char* lds, int bid, int nb) {
    const int tid = threadIdx.x, lane = tid & 63, wid = tid >> 6, wm = wid >> 1, wn = wid & 1, fr = lane & 15, fq = lane >> 4, srow = tid >> 3, sck = tid & 7;
    const int* tb = (const int*)(lds + TB_OFF); const int n_et = tb[0];
    const bf16* A2 = (const bf16*)(p.ws + WS_R2); const bf16* Wgu = (const bf16*)(p.ws + WS_WGUT); bf16* Hb = (bf16*)(p.ws + WS_R3);
    const bf16* zero = (const bf16*)(p.ws + WS_CTL + CTL_ZERO); const float* gw = (const float*)(p.ws + WS_GW);
    const unsigned* ecnt = (const unsigned*)(p.ws + WS_CTL + CTL_ECNT); const unsigned* elist = (const unsigned*)(p.ws + WS_ELIST);
    for (int item = bid; item < n_et * 4; item += nb) {
        const int tile = item >> 2, blk = item & 3, e = tb[64 + tile], r0 = tb[64 + 512 + tile], cnt = (int)ecnt[e];
        f32x4 acc[4][4]; zero_acc<4>(acc);
        const bf16* ap[4]; int as[4]; const bf16* bp[2];
#pragma unroll
        for (int i = 0; i < 4; ++i) { const int r = r0 + 64 * i + srow;
            if (r < cnt) { const unsigned ent = elist[(size_t)e * 32768 + r]; ap[i] = A2 + (size_t)(ent >> 1) * D + sck * 8; as[i] = 64; } else { ap[i] = zero; as[i] = 0; } }
#pragma unroll
        for (int i = 0; i < 2; ++i) bp[i] = Wgu + ((size_t)e * 512 + blk * 128 + 64 * i + srow) * D + sck * 8;
        gemm_loop<4>(acc, ap, as, bp, 16, lds);
#pragma unroll
        for (int mt = 0; mt < 4; ++mt) { const int r = r0 + wm * 64 + mt * 16 + fr;
            if (r < cnt) { const unsigned ent = elist[(size_t)e * 32768 + r]; const float w = gw[ent];
#pragma unroll
                for (int nt = 0; nt < 2; ++nt) { const int hid = blk * 64 + wn * 32 + nt * 16 + 4 * fq;
                    const float h0 = siluf_(acc[mt][nt][0]) * acc[mt][nt + 2][0] * w, h1 = siluf_(acc[mt][nt][1]) * acc[mt][nt + 2][1] * w;
                    const float h2 = siluf_(acc[mt][nt][2]) * acc[mt][nt + 2][2] * w, h3 = siluf_(acc[mt][nt][3]) * acc[mt][nt + 2][3] * w;
                    u32x2 o; o.x = pk2(h0, h1); o.y = pk2(h2, h3); *(u32x2*)(Hb + (size_t)ent * 256 + hid) = o; } } }
    }
}
DI void phase7_down(const Params& p, unsigned char* lds, int bid, int nb) {
    const int tid = threadIdx.x, lane = tid & 63, wid = tid >> 6, wm = wid >> 1, wn = wid & 1, fr = lane & 15, fq = lane >> 4, srow = tid >> 3, sck = tid & 7;
    const int* tb = (const int*)(lds + TB_OFF); const int n_pt = tb[1];
    const bf16* Hb = (const bf16*)(p.ws + WS_R3); const bf16* Wd = (const bf16*)(p.ws + WS_WDT);
    const bf16* zero = (const bf16*)(p.ws + WS_CTL + CTL_ZERO); const float* mod = (const float*)(p.ws + WS_MOD);
    const unsigned* pcnt = (const unsigned*)(p.ws + WS_CTL + CTL_PCNT); const unsigned* plist = (const unsigned*)(p.ws + WS_PLIST);
    float* rsq = (float*)(p.ws + WS_CTL + CTL_RSQ2);
    for (int item = bid; item < n_pt * 8; item += nb) {
        const int tile = item >> 3, n0 = (item & 7) * 128, cls = tb[64 + 1024 + tile], r0 = tb[64 + 1536 + tile], cnt = (int)pcnt[cls];
        const int gi = cls / 28, pi = cls % 28; int lo = 0, rem = pi;
        while (rem >= 7 - lo) { rem -= 7 - lo; ++lo; }
        const int hi = lo + 1 + rem, elo = gi * 8 + lo, ehi = gi * 8 + hi;
        f32x4 acc[4][4]; zero_acc<4>(acc);
        const bf16* ap[4]; int as[4]; const bf16* bp[2];
#pragma unroll
        for (int i = 0; i < 4; ++i) { const int r = r0 + 64 * i + srow;
            if (r < cnt) { const unsigned tok = plist[(size_t)cls * 32768 + r]; ap[i] = Hb + (size_t)tok * 512 + sck * 8; as[i] = 64; } else { ap[i] = zero; as[i] = 0; } }
#pragma unroll
        for (int i = 0; i < 2; ++i) bp[i] = Wd + ((size_t)elo * 1024 + n0 + 64 * i + srow) * 256 + sck * 8;
        gemm_loop<4>(acc, ap, as, bp, 4, lds);
#pragma unroll
        for (int i = 0; i < 4; ++i) if (as[i]) ap[i] += 256;
#pragma unroll
        for (int i = 0; i < 2; ++i) bp[i] = Wd + ((size_t)ehi * 1024 + n0 + 64 * i + srow) * 256 + sck * 8;
        gemm_loop<4>(acc, ap, as, bp, 4, lds);
#pragma unroll
        for (int mt = 0; mt < 4; ++mt) { const int r = r0 + wm * 64 + mt * 16 + fr; float s = 0.f; unsigned tok = 0;
            if (r < cnt) { tok = plist[(size_t)cls * 32768 + r]; const int b = tok >> 12;
#pragma unroll
                for (int nt = 0; nt < 4; ++nt) { const int col = n0 + wn * 64 + nt * 16 + 4 * fq;
                    float* xp = p.out + (size_t)tok * D + col; const f32x4 xv = *(const f32x4*)xp, gv = *(const f32x4*)(mod + b * 6144 + 5120 + col);
                    const f32x4 o = xv + gv * acc[mt][nt]; *(f32x4*)xp = o; s += o.x * o.x + o.y * o.y + o.z * o.z + o.w * o.w; } }
            s += __shfl_xor(s, 16); s += __shfl_xor(s, 32);
            if (fq == 0 && r < cnt) atomicAdd(rsq + tok, s); }
    }
}
DI void phase8_final(const Params& p, int bid, int nb) {
    const int lane = threadIdx.x & 63, wave = threadIdx.x >> 6;
    const float* rsq = (const float*)(p.ws + WS_CTL + CTL_RSQ2);
    for (int r = bid * 8 + wave; r < NTOK; r += nb * 8) {
        const float rs = rsqrtf(rsq[r] * (1.f / D) + EPS);
        f32x4* xr = (f32x4*)(p.out + (size_t)r * D) + lane;
#pragma unroll
        for (int j = 0; j < 4; ++j) { const f32x4 g = *(const f32x4*)(p.final_g + lane * 4 + 256 * j); xr[64 * j] = xr[64 * j] * rs * g; }
    }
}

#define XB_TMO      128
#define XB_XCNT(j)  (256  + 64 * (j))
#define XB_XSUB(j)  (1280 + 64 * (j))
#define XB_XGEN(j)  (2304 + 64 * (j))
#define XB_TOP      3328
#define XB_TOPGEN   3392
#define XCD_BAR_WORDS 3456
#define XB_SPIN_CAP (1u << 18)
#define LAS __attribute__((address_space(3)))
DI unsigned xb_ld(unsigned* p)              { return __hip_atomic_load(p, __ATOMIC_RELAXED, __HIP_MEMORY_SCOPE_AGENT); }
DI unsigned xb_add(unsigned* p, unsigned v) { return __hip_atomic_fetch_add(p, v, __ATOMIC_RELAXED, __HIP_MEMORY_SCOPE_AGENT); }
DI unsigned xb_xcc_id() { return (unsigned)__builtin_amdgcn_s_getreg((3 << 11) | 20) & 0xFu; }
#define XB_SPIN(cond, bar) do { unsigned _sp = 0; while (cond) { __builtin_amdgcn_s_sleep(1); \
    if ((++_sp & 255u) == 0u) { if (xb_ld(&(bar)[XB_TMO])) break; if (_sp > XB_SPIN_CAP) { atomicAdd(&(bar)[XB_TMO], 1u); break; } } } } while (0)
struct XcdBarrier { unsigned* bar; unsigned x; volatile LAS unsigned* st; };
DI XcdBarrier xcd_barrier_post(unsigned* bar, volatile LAS unsigned* st) {
    XcdBarrier b; b.bar = bar; b.x = xb_xcc_id(); b.st = st;
    if (threadIdx.x == 0) (void)xb_add(&bar[XB_XCNT(b.x)], 1u);
    return b;
}
DI void xcd_barrier_complete(unsigned* bar, unsigned x, unsigned& nloc, unsigned& nx) {
    const unsigned G = gridDim.x * gridDim.y * gridDim.z;
    unsigned sum, cnt, mine, sp = 0u;
    for (;;) {
        sum = 0u; cnt = 0u; mine = 0u;
#pragma unroll
        for (unsigned j = 0; j < 16; ++j) { const unsigned c = xb_ld(&bar[XB_XCNT(j)]); sum += c; cnt += (c > 0u) ? 1u : 0u; mine = (j == x) ? c : mine; }
        if (sum == G) break;
        __builtin_amdgcn_s_sleep(1);
        if ((++sp & 255u) == 0u) { if (xb_ld(&bar[XB_TMO])) break; if (sp > XB_SPIN_CAP) { atomicAdd(&bar[XB_TMO], 1u); break; } }
    }
    nloc = mine > 0u ? mine : 1u; nx = cnt > 0u ? cnt : 1u;
}
DI void xcd_barrier(const XcdBarrier& b) {
    asm volatile("s_waitcnt vmcnt(0)" ::: "memory");
    __syncthreads();
    if (threadIdx.x == 0) {
        unsigned* bar = b.bar;
        __builtin_amdgcn_s_waitcnt(0);
        unsigned nloc = b.st[0], nx = b.st[1];
        if (nloc == 0u) { xcd_barrier_complete(bar, b.x, nloc, nx); b.st[0] = nloc; b.st[1] = nx; }
        const unsigned old = xb_add(&bar[XB_XSUB(b.x)], 1u);
        const unsigned gen = old / nloc;
        if (old + 1u == (gen + 1u) * nloc) {
            __builtin_amdgcn_fence(__ATOMIC_RELEASE, "agent");
            asm volatile("s_waitcnt vmcnt(0)" ::: "memory");
            const unsigned og = xb_add(&bar[XB_TOP], 1u);
            const unsigned tg = og / nx;
            if (og + 1u == (tg + 1u) * nx) xb_add(&bar[XB_TOPGEN], 1u);
            else XB_SPIN(xb_ld(&bar[XB_TOPGEN]) == tg, bar);
            __builtin_amdgcn_fence(__ATOMIC_ACQUIRE, "agent");
            xb_add(&bar[XB_XGEN(b.x)], 1u);
            asm volatile("s_waitcnt vmcnt(0)" ::: "memory");
        } else {
            XB_SPIN(xb_ld(&bar[XB_XGEN(b.x)]) == gen, bar);
            __builtin_amdgcn_fence(__ATOMIC_ACQUIRE, "agent");
            asm volatile("s_waitcnt vmcnt(0)" ::: "memory");
        }
    }
    __syncthreads();
}

constexpr int CTL_BAR = 16384;
constexpr int MK_LDS = 163840;
constexpr int MK_ST_OFF = MK_LDS - 16;
static_assert(S5_LDS <= MK_ST_OFF && FF_LDS <= MK_ST_OFF && RT_LDS <= MK_ST_OFF && TB_OFF + TB_BYTES <= MK_ST_OFF && TB_OFF >= GC<4>::LDS, "LDS map");
static_assert(4 * (4096 + 4096 + 8448 + 16384) <= MK_ST_OFF, "prep LDS");
#ifndef MK_REP
#define MK_REP -1
#endif
#define RUNPH(k, body) do { body; if (MK_REP == (k)) { xcd_barrier(bar); body; } } while (0)
__global__ void __launch_bounds__(NT, 2) mega_kernel(Params p) {
    extern __shared__ __attribute__((aligned(16))) unsigned char lds[];
    const int bid = blockIdx.x, nb = gridDim.x;
    if (threadIdx.x < 4) ((unsigned*)(lds + MK_ST_OFF))[threadIdx.x] = 0u;
    __syncthreads();
    XcdBarrier bar = xcd_barrier_post((unsigned*)(p.ws + WS_CTL + CTL_BAR), (volatile LAS unsigned*)(lds + MK_ST_OFF));
    RUNPH(0, phase0(p, lds, bid, nb));            xcd_barrier(bar);
    RUNPH(1, phase1a(p, bid, nb));                xcd_barrier(bar);
    RUNPH(2, phase1b(p, lds, bid, nb));           xcd_barrier(bar);
    RUNPH(3, phase2_s5(p, lds, bid, nb));
    RUNPH(4, phase2_fft(p, lds, bid, nb));        xcd_barrier(bar);
    RUNPH(5, phase3_glu(p, lds, bid, nb));        xcd_barrier(bar);
    RUNPH(6, phase3_fin(p, lds, bid, nb));        xcd_barrier(bar);
    phase4_out(p, lds, bid, nb);                  xcd_barrier(bar);
    phase5_route(p, lds, bid, nb);                xcd_barrier(bar);
    build_tiles(p, lds);
    RUNPH(10, phase6_gateup(p, lds, bid, nb));    xcd_barrier(bar);
    phase7_down(p, lds, bid, nb);                 xcd_barrier(bar);
    phase8_final(p, bid, nb);
}

extern "C" void kernel_launch(void* const* d_in, const int* in_sizes, int n_in, void* d_out, int out_size, void* d_ws, size_t ws_size, hipStream_t stream) {
    static int grid = 0;
    if (grid == 0) {
        if (n_in != 30 || ws_size < WS_END || out_size != NTOK * D) { fprintf(stderr, "kernel_launch: unexpected inputs (n_in %d, ws %zu, out %d)\n", n_in, ws_size, out_size); grid = -1; return; }
        int dev = 0, cus = 0, per_cu = 0;
        if (hipGetDevice(&dev) != hipSuccess || hipDeviceGetAttribute(&cus, hipDeviceAttributeMultiprocessorCount, dev) != hipSuccess) { grid = -1; return; }
        if (hipFuncSetAttribute((const void*)mega_kernel, hipFuncAttributeMaxDynamicSharedMemorySize, MK_LDS) != hipSuccess) { fprintf(stderr, "kernel_launch: hipFuncSetAttribute failed\n"); grid = -1; return; }
        if (hipOccupancyMaxActiveBlocksPerMultiprocessor(&per_cu, (const void*)mega_kernel, NT, MK_LDS) != hipSuccess || per_cu < 1) { fprintf(stderr, "kernel_launch: occupancy query says %d blocks/CU\n", per_cu); (void)hipGetLastError(); grid = -1; return; }
        grid = cus;
    }
    if (grid < 0) return;
    Params p{};
    const float** f = (const float**)&p;
    for (int i = 0; i < 30; ++i) f[i] = (const float*)d_in[i];
    p.out = (float*)d_out; p.ws = (unsigned char*)d_ws;
    (void)hipMemsetAsync((char*)d_ws + WS_CTL, 0, CTL_BYTES, stream);
    hipLaunchKernelGGL(mega_kernel, dim3(grid), dim3(NT), MK_LDS, stream, p);
}
```

```cpp
#include <hip/hip_runtime.h>
#include <cstdio>
#include <cstdint>

typedef unsigned short bf16;
typedef short bf16x8 __attribute__((ext_vector_type(8)));
typedef short bf16x4 __attribute__((ext_vector_type(4)));
typedef float f32x4 __attribute__((ext_vector_type(4)));
typedef unsigned u32x4 __attribute__((ext_vector_type(4)));
typedef unsigned u32x2 __attribute__((ext_vector_type(2)));
typedef __bf16 bf16v2 __attribute__((ext_vector_type(2)));
#define DI __device__ __forceinline__

constexpr int D = 1024, NB = 8, L = 4096, CTX = 256, NTOK = NB * L, NCTX = NB * CTX, NROWS1 = NTOK + NCTX;
constexpr int NEXP = 32, DE = 256;
constexpr float EPS = 1e-6f;
constexpr int NT = 512;

constexpr size_t MiB = 1u << 20;
constexpr size_t WS_CTL = 0;
constexpr size_t CTL_BYTES = 1 * MiB;
constexpr size_t CTL_ZERO = 4096;
constexpr size_t CTL_ECNT = 8192;
constexpr size_t CTL_PCNT = 8192 + 256;
constexpr size_t CTL_RSQ1 = 256 * 1024;
constexpr size_t CTL_RSQ2 = 384 * 1024;
constexpr size_t WS_MOD = 1 * MiB;
constexpr size_t WS_TILES = WS_MOD + 256 * 1024;
constexpr size_t WS_ABART = WS_TILES + 64 * 1024;
constexpr size_t WS_FFTC = 2 * MiB;
constexpr size_t WS_GW = 3 * MiB;
constexpr size_t WS_WINT = 4 * MiB;
constexpr size_t WS_WGLUT = 7 * MiB;
constexpr size_t WS_WOUTT = 8 * MiB;
constexpr size_t WS_WGUT = 10 * MiB;
constexpr size_t WS_WDT = 42 * MiB;
constexpr size_t WS_MG = 58 * MiB;
constexpr size_t WS_WST = 74 * MiB;
constexpr size_t WS_WOS = 82 * MiB;
constexpr size_t WS_ELIST = 90 * MiB;
constexpr size_t WS_PLIST = 94 * MiB;
constexpr size_t WS_R1 = 108 * MiB;
constexpr size_t WS_R2 = 176 * MiB;
constexpr size_t WS_R3 = 240 * MiB;
constexpr size_t WS_R4 = 274 * MiB;
constexpr size_t WS_R5 = 306 * MiB;
constexpr size_t WS_RSQP1 = 338 * MiB;
constexpr size_t WS_RSQP2 = 340 * MiB;
constexpr size_t WS_WRT = 342 * MiB;
constexpr size_t WS_END = 343 * MiB;

struct Params {
    const float *x, *c, *ctx, *c_ctx, *w_ada, *b_ada, *norm1_g, *norm2_g, *w_in;
    const float *lam_re, *lam_im, *b_re, *b_im, *c_re, *c_im, *log_step, *s5_d, *w_glu, *fourier_w, *g_s, *g_f, *w_out;
    const float *w_group, *b_group, *w_router, *b_router, *w_gate, *w_up, *w_down, *final_g;
    float* out; unsigned char* ws;
};

DI unsigned pk2(float lo, float hi) { bf16v2 v; v.x = (__bf16)lo; v.y = (__bf16)hi; return __builtin_bit_cast(unsigned, v); }
DI float bf2f(unsigned short b) { return __uint_as_float(((unsigned)b) << 16); }
DI float wave_sum(float v) {
#pragma unroll
    for (int o = 1; o < 64; o <<= 1) v += __shfl_xor(v, o);
    return v;
}
DI float sigmoidf_(float x) { return 1.f / (1.f + __expf(-x)); }
DI float siluf_(float x) { return x / (1.f + __expf(-x)); }
DI float geluf_(float x) { const float u = 0.7978845608028654f * (x + 0.044715f * x * x * x); return x / (1.f + __expf(-2.f * u)); }

template <int MT> struct GC {
    static constexpr int BM = 64 * MT, PA = MT, ABYTES = BM * 128, BBYTES = 128 * 128, BUF = ABYTES + BBYTES, LDS = 2 * BUF;
};
template <int MT>
DI void gemm_loop(f32x4 (&acc)[MT][4], const bf16* (&ap)[MT], const int (&as)[MT], const bf16* (&bp)[2], int nk, unsigned char* lds) {
    typedef GC<MT> G;
    const int tid = threadIdx.x, lane = tid & 63, wid = tid >> 6, wm = wid >> 1, wn = wid & 1, fr = lane & 15, fq = lane >> 4;
    const int srow = tid >> 3, sck = tid & 7;
    const int soff = srow * 128 + ((sck ^ (srow & 7)) << 4);
    u32x4 ra[MT], rb[2];
#pragma unroll
    for (int i = 0; i < MT; ++i) ra[i] = *(const u32x4*)(ap[i]);
#pragma unroll
    for (int i = 0; i < 2; ++i) rb[i] = *(const u32x4*)(bp[i]);
#pragma unroll
    for (int i = 0; i < MT; ++i) *(u32x4*)(lds + i * 8192 + soff) = ra[i];
#pragma unroll
    for (int i = 0; i < 2; ++i) *(u32x4*)(lds + G::ABYTES + i * 8192 + soff) = rb[i];
    __syncthreads();
    const int aro = (wm * MT * 16 + fr) * 128, bro = (wn * 64 + fr) * 128;
    const int sw0 = ((0 + fq) ^ (fr & 7)) << 4, sw1 = ((4 + fq) ^ (fr & 7)) << 4;
    for (int kt = 0; kt < nk; ++kt) {
        const bool more = kt + 1 < nk;
        if (more) {
#pragma unroll
            for (int i = 0; i < MT; ++i) ra[i] = *(const u32x4*)(ap[i] + (size_t)(kt + 1) * as[i]);
#pragma unroll
            for (int i = 0; i < 2; ++i) rb[i] = *(const u32x4*)(bp[i] + (size_t)(kt + 1) * 64);
        }
        const unsigned char* Ab = lds + (kt & 1) * G::BUF; const unsigned char* Bb = Ab + G::ABYTES;
#pragma unroll
        for (int kk = 0; kk < 2; ++kk) {
            const int sw = kk ? sw1 : sw0;
            bf16x8 af[MT], bfr[4];
#pragma unroll
            for (int mt = 0; mt < MT; ++mt) af[mt] = *(const bf16x8*)(Ab + aro + mt * 2048 + sw);
#pragma unroll
            for (int nt = 0; nt < 4; ++nt) bfr[nt] = *(const bf16x8*)(Bb + bro + nt * 2048 + sw);
#pragma unroll
            for (int mt = 0; mt < MT; ++mt)
#pragma unroll
                for (int nt = 0; nt < 4; ++nt) acc[mt][nt] = __builtin_amdgcn_mfma_f32_16x16x32_bf16(bfr[nt], af[mt], acc[mt][nt], 0, 0, 0);
        }
        if (more) {
            unsigned char* nb = lds + ((kt + 1) & 1) * G::BUF;
#pragma unroll
            for (int i = 0; i < MT; ++i) *(u32x4*)(nb + i * 8192 + soff) = ra[i];
#pragma unroll
            for (int i = 0; i < 2; ++i) *(u32x4*)(nb + G::ABYTES + i * 8192 + soff) = rb[i];
        }
        __syncthreads();
    }
}
template <int MT>
DI void gemm_loop_alds(f32x4 (&acc)[MT][4], const unsigned char* abase, int apitch, const bf16* (&bp)[2], int nk, unsigned char* lds) {
    typedef GC<MT> G;
    const int tid = threadIdx.x, lane = tid & 63, wid = tid >> 6, wm = wid >> 1, wn = wid & 1, fr = lane & 15, fq = lane >> 4;
    const int srow = tid >> 3, sck = tid & 7;
    const int soff = srow * 128 + ((sck ^ (srow & 7)) << 4);
    u32x4 rb[2];
#pragma unroll
    for (int i = 0; i < 2; ++i) rb[i] = *(const u32x4*)(bp[i]);
#pragma unroll
    for (int i = 0; i < 2; ++i) *(u32x4*)(lds + G::ABYTES + i * 8192 + soff) = rb[i];
    __syncthreads();
    const int bro = (wn * 64 + fr) * 128;
    const int sw0 = ((0 + fq) ^ (fr & 7)) << 4, sw1 = ((4 + fq) ^ (fr & 7)) << 4;
    const unsigned char* arow = abase + (size_t)(wm * MT * 16 + fr) * apitch + fq * 16;
    for (int kt = 0; kt < nk; ++kt) {
        const bool more = kt + 1 < nk;
        if (more) {
#pragma unroll
            for (int i = 0; i < 2; ++i) rb[i] = *(const u32x4*)(bp[i] + (size_t)(kt + 1) * 64);
        }
        const unsigned char* Bb = lds + (kt & 1) * G::BUF + G::ABYTES;
#pragma unroll
        for (int kk = 0; kk < 2; ++kk) {
            const int sw = kk ? sw1 : sw0;
            bf16x8 af[MT], bfr[4];
#pragma unroll
            for (int mt = 0; mt < MT; ++mt) af[mt] = *(const bf16x8*)(arow + (size_t)mt * 16 * apitch + kt * 128 + kk * 64);
#pragma unroll
            for (int nt = 0; nt < 4; ++nt) bfr[nt] = *(const bf16x8*)(Bb + bro + nt * 2048 + sw);
#pragma unroll
            for (int mt = 0; mt < MT; ++mt)
#pragma unroll
                for (int nt = 0; nt < 4; ++nt) acc[mt][nt] = __builtin_amdgcn_mfma_f32_16x16x32_bf16(bfr[nt], af[mt], acc[mt][nt], 0, 0, 0);
        }
        if (more) {
            unsigned char* nb = lds + ((kt + 1) & 1) * G::BUF;
#pragma unroll
            for (int i = 0; i < 2; ++i) *(u32x4*)(nb + G::ABYTES + i * 8192 + soff) = rb[i];
        }
        __syncthreads();
    }
}
template <int MT> DI void zero_acc(f32x4 (&acc)[MT][4]) {
#pragma unroll
    for (int m = 0; m < MT; ++m)
#pragma unroll
        for (int n = 0; n < 4; ++n) acc[m][n] = (f32x4){0.f, 0.f, 0.f, 0.f};
}

DI void adaln_item(const Params& p, unsigned char* lds, int item) {
    float* scond = (float*)lds;
    float* red = scond + 9 * 1024;
    const int tid = threadIdx.x;
    for (int i = tid; i < 9 * 1024; i += NT) { const int r = i >> 10, k = i & 1023; const float v = r < 8 ? p.c[r * 1024 + k] : p.c_ctx[k]; scond[i] = v / (1.f + __expf(-v)); }
    __syncthreads();
    const int cc = tid & 63, ks = tid >> 6, col = item * 64 + cc;
    float a[9];
#pragma unroll
    for (int r = 0; r < 9; ++r) a[r] = 0.f;
#pragma unroll 1
    for (int kb = 0; kb < 8; ++kb) {
        const int kbase = ks * 128 + kb * 16; float w[16];
#pragma unroll
        for (int u = 0; u < 16; ++u) w[u] = p.w_ada[(size_t)(kbase + u) * 6144 + col];
#pragma unroll
        for (int u = 0; u < 16; ++u)
#pragma unroll
            for (int r = 0; r < 9; ++r) a[r] += scond[r * 1024 + kbase + u] * w[u];
    }
#pragma unroll
    for (int r = 0; r < 9; ++r) red[(ks * 9 + r) * 64 + cc] = a[r];
    __syncthreads();
    float* mod = (float*)(p.ws + WS_MOD);
    for (int o = tid; o < 9 * 64; o += NT) { const int r = o >> 6, c2 = o & 63; float s = 0.f;
#pragma unroll
        for (int q = 0; q < 8; ++q) s += red[(q * 9 + r) * 64 + c2];
        mod[r * 6144 + item * 64 + c2] = s + p.b_ada[item * 64 + c2]; }
    __syncthreads();
}
DI void tp_tile(const float* src, int ld, int k0, int n0, unsigned char* lds, bf16* dst, int jobkind, int e) {
    const int lane = threadIdx.x & 63, wid = threadIdx.x >> 6;
    float* tile = (float*)lds + wid * (64 * 65);
    { float v[64];
#pragma unroll
      for (int kk = 0; kk < 64; ++kk) v[kk] = src[(size_t)(k0 + kk) * ld + n0 + lane];
#pragma unroll
      for (int kk = 0; kk < 64; ++kk) tile[kk * 65 + lane] = v[kk]; }
    asm volatile("s_waitcnt lgkmcnt(0)" ::: "memory");
    const int kc = lane & 7;
#pragma unroll
    for (int j = 0; j < 8; ++j) { const int n = (lane >> 3) + 8 * j, ng = n0 + n;
      u32x4 o;
      o.x = pk2(tile[(kc * 8 + 0) * 65 + n], tile[(kc * 8 + 1) * 65 + n]); o.y = pk2(tile[(kc * 8 + 2) * 65 + n], tile[(kc * 8 + 3) * 65 + n]);
      o.z = pk2(tile[(kc * 8 + 4) * 65 + n], tile[(kc * 8 + 5) * 65 + n]); o.w = pk2(tile[(kc * 8 + 6) * 65 + n], tile[(kc * 8 + 7) * 65 + n]);
      size_t drow; int K;
      switch (jobkind) {
        case 0: drow = ng; K = 1024; break;
        case 1: drow = ng; K = 512; break;
        case 2: drow = ng; K = 1024; break;
        case 3: case 4: { const int h = ng, R = (h >> 6) * 128 + ((h >> 5) & 1) * 64 + (h & 31) + (jobkind == 4 ? 32 : 0); drow = (size_t)e * 512 + R; K = 1024; } break;
        default: drow = (size_t)e * 1024 + ng; K = 256; break;
      }
      *(u32x4*)(dst + drow * K + k0 + kc * 8) = o; }
    asm volatile("s_waitcnt lgkmcnt(0)" ::: "memory");
}
constexpr int TP_J0 = 16 * 8, TP_J1 = 8 * 8, TP_J2 = 16 * 16, TP_J3 = 32 * 16 * 4, TP_J4 = TP_J3, TP_J5 = 32 * 4 * 16;
constexpr int TP_ITEMS = TP_J0 + TP_J1 + TP_J2 + TP_J3 + TP_J4 + TP_J5;
DI void tp_item(const Params& p, unsigned char* lds, int it) {
    unsigned char* ws = p.ws;
    if (it < TP_J0) { tp_tile(p.w_in, 1024, (it >> 3) * 64, (it & 7) * 64, lds, (bf16*)(ws + WS_WINT), 0, 0); return; } it -= TP_J0;
    if (it < TP_J1) { tp_tile(p.w_glu, 512, (it >> 3) * 64, (it & 7) * 64, lds, (bf16*)(ws + WS_WGLUT), 1, 0); return; } it -= TP_J1;
    if (it < TP_J2) { tp_tile(p.w_out, 1024, (it >> 4) * 64, (it & 15) * 64, lds, (bf16*)(ws + WS_WOUTT), 2, 0); return; } it -= TP_J2;
    if (it < TP_J3) { const int e = it >> 6, r = it & 63; tp_tile(p.w_gate + (size_t)e * 1024 * 256, 256, (r >> 2) * 64, (r & 3) * 64, lds, (bf16*)(ws + WS_WGUT), 3, e); return; } it -= TP_J3;
    if (it < TP_J4) { const int e = it >> 6, r = it & 63; tp_tile(p.w_up + (size_t)e * 1024 * 256, 256, (r >> 2) * 64, (r & 3) * 64, lds, (bf16*)(ws + WS_WGUT), 4, e); return; } it -= TP_J4;
    { const int e = it >> 6, r = it & 63; tp_tile(p.w_down + (size_t)e * 256 * 1024, 1024, (r >> 4) * 64, (r & 15) * 64, lds, (bf16*)(ws + WS_WDT), 5, e); }
}
DI void gfold_item(const Params& p, unsigned char* lds, int item) {
    const int q = item >> 6, k0 = (item & 63) * 16, tid = threadIdx.x;
    float* wv = (float*)lds;
    float* T = wv + 16 * 128;
    float* fw = T + 16 * 2 * 128;
    float* cs = fw + 128 * 128;
    float* sn = cs + 128;
    for (int i = tid; i < 16 * 128; i += NT) wv[i] = p.w_in[(size_t)(k0 + (i >> 7)) * 1024 + 512 + 128 * q + (i & 127)];
    for (int i = tid; i < 128 * 128; i += NT) fw[i] = p.fourier_w[(size_t)q * 128 * 128 + i];
    if (tid < 128) { double s, c; sincospi((double)tid / 64.0, &s, &c); cs[tid] = (float)c; sn[tid] = (float)s; }
    __syncthreads();
    for (int o = tid; o < 16 * 128; o += NT) { const int r = o >> 7, n = o & 127; float sr = 0.f, si = 0.f;
        for (int m = 0; m < 128; ++m) { const float w = wv[r * 128 + m]; const int ix = (n * m) & 127; sr += w * cs[ix]; si -= w * sn[ix]; }
        T[(r * 2 + 0) * 128 + n] = sr; T[(r * 2 + 1) * 128 + n] = si; }
    __syncthreads();
    bf16* WinT = (bf16*)(p.ws + WS_WINT);
    const float scale = 1.0f / 724.0773439350247f;
    for (int o = tid; o < 16 * 2 * 128; o += NT) { const int r = o & 15, c = (o >> 4) & 1, j = o >> 5; float s = 0.f;
        for (int n = 0; n < 128; ++n) s += T[(r * 2 + c) * 128 + n] * fw[n * 128 + j];
        WinT[(size_t)(512 + c * 512 + q * 128 + j) * 1024 + k0 + r] = (bf16)(pk2(s * scale, 0.f) & 0xffffu); }
    __syncthreads();
}
DI void s5mats_item(const Params& p, unsigned char* lds, int item) {
    const int g = item >> 2, part = item & 3;
    const int tid = threadIdx.x;
    float* Bb = (float*)lds;
    float* Cc = Bb + 4096;
    float* pw = Cc + 4096;
    float* Kt = pw + 8448;
    for (int idx = tid; idx < 2 * 64 * 33; idx += NT) { const int d = idx / (64 * 33), rem = idx % (64 * 33), pp = rem / 33, k = rem % 33;
        const double dt = exp((double)p.log_step[d * 32 + g]); const double lr = p.lam_re[(d * 32 + g) * 64 + pp], li = p.lam_im[(d * 32 + g) * 64 + pp];
        const double mag = exp(lr * dt * k); double tt = li * dt * k / 3.14159265358979323846; tt -= 2.0 * floor(tt * 0.5);
        double s, c; sincospi(tt, &s, &c); pw[idx * 2] = (float)(mag * c); pw[idx * 2 + 1] = (float)(mag * s); }
    for (int idx = tid; idx < 2 * 64 * 16; idx += NT) { const int d = idx >> 10, pp = (idx >> 4) & 63, h = idx & 15;
        const double dt = exp((double)p.log_step[d * 32 + g]); const double lr = p.lam_re[(d * 32 + g) * 64 + pp], li = p.lam_im[(d * 32 + g) * 64 + pp];
        const double mag = exp(lr * dt); double tt = li * dt / 3.14159265358979323846; tt -= 2.0 * floor(tt * 0.5);
        double s, c; sincospi(tt, &s, &c); const double nr = mag * c - 1.0, ni = mag * s, den = lr * lr + li * li;
        const double qr = (nr * lr + ni * li) / den, qi = (ni * lr - nr * li) / den;
        const double br = p.b_re[((size_t)(d * 32 + g) * 64 + pp) * 16 + h], bi = p.b_im[((size_t)(d * 32 + g) * 64 + pp) * 16 + h];
        Bb[idx * 2] = (float)(qr * br - qi * bi); Bb[idx * 2 + 1] = (float)(qr * bi + qi * br); }
    for (int idx = tid; idx < 2 * 16 * 64; idx += NT) { const int d = idx >> 10, i = (idx >> 6) & 15, pp = idx & 63;
        Cc[idx * 2] = p.c_re[((size_t)(d * 32 + g) * 16 + i) * 64 + pp]; Cc[idx * 2 + 1] = p.c_im[((size_t)(d * 32 + g) * 16 + i) * 64 + pp]; }
    __syncthreads();
    for (int id4 = tid; id4 < 4096; id4 += NT) { const int d = id4 >> 11, k = (id4 >> 6) & 31, i = part * 4 + ((id4 >> 4) & 3), h = id4 & 15; const int idx = ((d * 32 + k) * 16 + i) * 16 + h; float s = 0.f;
        for (int pp = 0; pp < 64; ++pp) { const float cr = Cc[((d * 16 + i) * 64 + pp) * 2], ci = Cc[((d * 16 + i) * 64 + pp) * 2 + 1];
            const float wr = pw[((d * 64 + pp) * 33 + k) * 2], wi = pw[((d * 64 + pp) * 33 + k) * 2 + 1];
            const float xr = cr * wr - ci * wi, xi = cr * wi + ci * wr;
            s += xr * Bb[((d * 64 + pp) * 16 + h) * 2] - xi * Bb[((d * 64 + pp) * 16 + h) * 2 + 1]; }
        Kt[idx] = s; }
    __syncthreads();
    bf16* Mg = (bf16*)(p.ws + WS_MG) + (size_t)g * 512 * 512;
    for (int c4 = tid; c4 < 128 * 64; c4 += NT) { const int rq = c4 >> 6, c8 = c4 & 63, j = rq >> 2, i = part * 4 + (rq & 3), row = j * 16 + i, s = c8 >> 1, h0 = (c8 & 1) * 8; float v[8];
#pragma unroll
        for (int t = 0; t < 8; ++t) { float a = 0.f; if (s <= j) a += Kt[((0 * 32 + (j - s)) * 16 + i) * 16 + h0 + t]; if (s >= j) a += Kt[((1 * 32 + (s - j)) * 16 + i) * 16 + h0 + t]; v[t] = a; }
        u32x4 o; o.x = pk2(v[0], v[1]); o.y = pk2(v[2], v[3]); o.z = pk2(v[4], v[5]); o.w = pk2(v[6], v[7]);
        *(u32x4*)(Mg + (size_t)row * 512 + c8 * 8) = o; }
    bf16* Wst = (bf16*)(p.ws + WS_WST) + (size_t)g * 256 * 512;
    for (int c4 = tid; c4 < 64 * 64; c4 += NT) { const int r = part * 64 + (c4 >> 6), c8 = c4 & 63, s = c8 >> 1, h0 = (c8 & 1) * 8, d = r >> 7, c = (r >> 6) & 1, pp = r & 63;
        const int e = d == 0 ? 31 - s : s; const float wr = pw[((d * 64 + pp) * 33 + e) * 2], wi = pw[((d * 64 + pp) * 33 + e) * 2 + 1]; float v[8];
#pragma unroll
        for (int t = 0; t < 8; ++t) { const float br = Bb[((d * 64 + pp) * 16 + h0 + t) * 2], bi = Bb[((d * 64 + pp) * 16 + h0 + t) * 2 + 1]; v[t] = c == 0 ? wr * br - wi * bi : wr * bi + wi * br; }
        u32x4 o; o.x = pk2(v[0], v[1]); o.y = pk2(v[2], v[3]); o.z = pk2(v[4], v[5]); o.w = pk2(v[6], v[7]);
        *(u32x4*)(Wst + (size_t)r * 512 + c8 * 8) = o; }
    bf16* Wos = (bf16*)(p.ws + WS_WOS) + (size_t)g * 512 * 256;
    for (int c4 = tid; c4 < 128 * 32; c4 += NT) { const int rq = c4 >> 5, c8 = c4 & 31, j = rq >> 2, i = part * 4 + (rq & 3), row = j * 16 + i, col0 = c8 * 8, d = col0 >> 7, c = (col0 >> 6) & 1, p0 = col0 & 63;
        const int e = d == 0 ? j + 1 : 32 - j; float v[8];
#pragma unroll
        for (int t = 0; t < 8; ++t) { const int pp = p0 + t; const float cr = Cc[((d * 16 + i) * 64 + pp) * 2], ci = Cc[((d * 16 + i) * 64 + pp) * 2 + 1];
            const float wr = pw[((d * 64 + pp) * 33 + e) * 2], wi = pw[((d * 64 + pp) * 33 + e) * 2 + 1]; v[t] = c == 0 ? cr * wr - ci * wi : -(cr * wi + ci * wr); }
        u32x4 o; o.x = pk2(v[0], v[1]); o.y = pk2(v[2], v[3]); o.z = pk2(v[4], v[5]); o.w = pk2(v[6], v[7]);
        *(u32x4*)(Wos + (size_t)row * 256 + c8 * 8) = o; }
    float* aT = (float*)(p.ws + WS_ABART) + g * 256;
    if (part == 0 && tid < 128) { const int d = tid >> 6, pp = tid & 63; aT[tid * 2] = pw[((d * 64 + pp) * 33 + 32) * 2]; aT[tid * 2 + 1] = pw[((d * 64 + pp) * 33 + 32) * 2 + 1]; }
    __syncthreads();
}
DI void fftc_item(const Params& p, int item) {
    const int tid = threadIdx.x;
    bf16* W1 = (bf16*)(p.ws + WS_FFTC);
    bf16* W2 = W1 + 128 * 128;
    float* tw = (float*)(p.ws + WS_FFTC + 32768 + 16384);
    for (int idx = item * NT + tid; idx < 128 * 128 + 4 * 64 * 32 + 4096; idx += 8 * NT) {
        if (idx < 16384) { const int n = idx >> 7, k = idx & 127, co = n >> 6, d = n & 63, ci = k >> 6, bq = k & 63; double s, c; sincospi((double)((d * bq) & 63) / 32.0, &s, &c);
            const float v = (ci == co) ? (float)c : (ci == 1 ? (float)s : (float)(-s)); W1[idx] = (bf16)(pk2(v, 0.f) & 0xffffu); }
        else if (idx < 16384 + 8192) { const int i2 = idx - 16384, s_ = i2 >> 11, cf = (i2 >> 5) & 63, slot = i2 & 31, gq = slot >> 3, jp = slot & 7;
            const int a = 16 * (2 * (s_ & 1) + (jp >> 2)) + 4 * gq + (jp & 3); double s, c; sincospi((double)((cf * a) & 63) / 32.0, &s, &c);
            W2[i2] = (bf16)(pk2((s_ >> 1) == 0 ? (float)c : (float)s, 0.f) & 0xffffu); }
        else { const int i3 = idx - 16384 - 8192; double s, c; sincospi((double)i3 / 2048.0, &s, &c); tw[i3 * 2] = (float)c; tw[i3 * 2 + 1] = (float)s; }
    }
}
constexpr int P0_S5 = 128, P0_GF = 256, P0_ADA = 96, P0_FC = 8, P0_RW = 1;
constexpr int P0_ITEMS = P0_S5 + P0_GF + P0_ADA + P0_FC + P0_RW;
DI void rw_item(const Params& p) {
    bf16* W = (bf16*)(p.ws + WS_WRT);
    for (int i = threadIdx.x; i < 48 * 1024; i += NT) { const int n = i >> 10, k = i & 1023; const float v = n < 4 ? p.w_group[k * 4 + n] : (n < 36 ? p.w_router[k * 32 + (n - 4)] : 0.f); W[i] = (bf16)(pk2(v, 0.f) & 0xffffu); }
}
DI void phase0(const Params& p, unsigned char* lds, int bid, int nb) {
    for (int it = bid; it < P0_ITEMS; it += nb) {
        int r = it;
        if (r < P0_S5) { s5mats_item(p, lds, r); continue; } r -= P0_S5;
        if (r < P0_GF) { gfold_item(p, lds, r); continue; } r -= P0_GF;
        if (r < P0_ADA) { adaln_item(p, lds, r); continue; } r -= P0_ADA;
        if (r < P0_FC) { fftc_item(p, r); continue; } r -= P0_FC;
        rw_item(p);
    }
    __syncthreads();
    const int wid = threadIdx.x >> 6;
    for (int it = bid * 8 + wid; it < TP_ITEMS; it += nb * 8) tp_item(p, lds, it);
}

DI void phase1a(const Params& p, int bid, int nb) {
    const int lane = threadIdx.x & 63, wave = threadIdx.x >> 6;
    const float* mod = (const float*)(p.ws + WS_MOD);
    bf16* A1 = (bf16*)(p.ws + WS_R1);
    for (int r = bid * 8 + wave; r < NROWS1; r += nb * 8) {
        const float* src = r < NTOK ? p.x + (size_t)r * D : p.ctx + (size_t)(r - NTOK) * D;
        const int mr = r < NTOK ? (r >> 12) : 8;
        const f32x4* xr = (const f32x4*)src + lane;
        f32x4 v[4]; float s = 0.f;
#pragma unroll
        for (int j = 0; j < 4; ++j) { v[j] = xr[64 * j]; s += v[j].x * v[j].x + v[j].y * v[j].y + v[j].z * v[j].z + v[j].w * v[j].w; }
        const float rs = rsqrtf(wave_sum(s) * (1.f / D) + EPS);
        u32x2* o = (u32x2*)(A1 + (size_t)r * D) + lane;
#pragma unroll
        for (int j = 0; j < 4; ++j) { const int k = lane * 4 + 256 * j;
            const f32x4 g = *(const f32x4*)(p.norm1_g + k), sh = *(const f32x4*)(mod + mr * 6144 + k), sc = *(const f32x4*)(mod + mr * 6144 + 1024 + k);
            const f32x4 h = v[j] * rs * g * (sc + 1.f) + sh; u32x2 w; w.x = pk2(h.x, h.y); w.y = pk2(h.z, h.w); o[64 * j] = w; }
    }
}
DI void phase1b(const Params& p, unsigned char* lds, int bid, int nb) {
    const int tid = threadIdx.x, lane = tid & 63, wid = tid >> 6, wm = wid >> 1, wn = wid & 1, fr = lane & 15, fq = lane >> 4, srow = tid >> 3, sck = tid & 7;
    const bf16* A1 = (const bf16*)(p.ws + WS_R1); const bf16* WinT = (const bf16*)(p.ws + WS_WINT);
    bf16* Ul = (bf16*)(p.ws + WS_R3); bf16* Uc = Ul + (size_t)32 * 8 * 4096 * 16; bf16* GT = (bf16*)(p.ws + WS_R2);
    constexpr int NU = 136 * 4, NG = 256 * 4;
    for (int item = bid; item < NU + NG; item += nb) {
        f32x4 acc[4][4]; zero_acc<4>(acc);
        const bf16* ap[4]; int as[4]; const bf16* bp[2];
        if (item < NU) {
            const int m0 = (item >> 2) * 256, n0 = (item & 3) * 128;
#pragma unroll
            for (int i = 0; i < 4; ++i) { ap[i] = A1 + (size_t)(m0 + 64 * i + srow) * D + sck * 8; as[i] = 64; }
#pragma unroll
            for (int i = 0; i < 2; ++i) bp[i] = WinT + (size_t)(n0 + 64 * i + srow) * D + sck * 8;
            gemm_loop<4>(acc, ap, as, bp, 16, lds);
#pragma unroll
            for (int mt = 0; mt < 4; ++mt) { const int row = m0 + wm * 64 + mt * 16 + fr;
#pragma unroll
                for (int nt = 0; nt < 4; ++nt) { const int col = n0 + wn * 64 + nt * 16 + 4 * fq, g = col >> 4, h = col & 15;
                    u32x2 w; w.x = pk2(acc[mt][nt][0], acc[mt][nt][1]); w.y = pk2(acc[mt][nt][2], acc[mt][nt][3]);
                    bf16* dst = row < NTOK ? Ul + (((size_t)(g * 8 + (row >> 12)) * 4096 + (row & 4095)) * 16 + h)
                                           : Uc + (((size_t)(g * 8 + ((row - NTOK) >> 8)) * 256 + ((row - NTOK) & 255)) * 16 + h);
                    *(u32x2*)dst = w; } }
        } else {
            const int it2 = item - NU, ct = it2 & 3, tt = it2 >> 2, b = tt >> 5, a0 = (tt & 31) * 2;
#pragma unroll
            for (int i = 0; i < 4; ++i) { ap[i] = WinT + (size_t)(512 + ct * 256 + 64 * i + srow) * D + sck * 8; as[i] = 64; }
#pragma unroll
            for (int i = 0; i < 2; ++i) bp[i] = A1 + (size_t)(b * 4096 + srow * 64 + a0 + i) * D + sck * 8;
            gemm_loop<4>(acc, ap, as, bp, 16, lds);
#pragma unroll
            for (int mt = 0; mt < 4; ++mt) { const int m = ct * 256 + wm * 64 + mt * 16 + fr, c = m >> 9, ch = m & 511;
#pragma unroll
                for (int nt = 0; nt < 4; ++nt) { const int a = a0 + wn, bq = nt * 16 + 4 * fq;
                    u32x2 w; w.x = pk2(acc[mt][nt][0], acc[mt][nt][1]); w.y = pk2(acc[mt][nt][2], acc[mt][nt][3]);
                    *(u32x2*)(GT + ((size_t)((b * 512 + ch) * 2 + c) * 4096 + a * 64 + bq)) = w; } }
        }
    }
}
constexpr int S5_SB_OFF = GC<2>::LDS, S5_PITCH = 528, S5_LDS = S5_SB_OFF + 144 * S5_PITCH;
DI void phase2_s5(const Params& p, unsigned char* lds, int bid, int nb) {
    const int tid = threadIdx.x, lane = tid & 63, wid = tid >> 6, wm = wid >> 1, wn = wid & 1, fr = lane & 15, fq = lane >> 4, srow = tid >> 3, sck = tid & 7;
    const bf16* zero = (const bf16*)(p.ws + WS_CTL + CTL_ZERO);
    unsigned char* Sb = lds + S5_SB_OFF;
    for (int item = bid; item < 256; item += nb) {
        const int g = item >> 3, b = item & 7;
        const bf16* Ul = (const bf16*)(p.ws + WS_R3) + (size_t)(g * 8 + b) * 4096 * 16;
        const bf16* Uc = (const bf16*)(p.ws + WS_R3) + (size_t)32 * 8 * 4096 * 16 + (size_t)(g * 8 + b) * 256 * 16;
        const bf16* Wst = (const bf16*)(p.ws + WS_WST) + (size_t)g * 256 * 512;
        const bf16* Mg = (const bf16*)(p.ws + WS_MG) + (size_t)g * 512 * 512;
        const bf16* Wos = (const bf16*)(p.ws + WS_WOS) + (size_t)g * 512 * 256;
        for (int pass = 0; pass < 4; ++pass) {
            const int n0 = (pass & 1) * 128, isctx = pass >> 1;
            f32x4 acc[2][4]; zero_acc<2>(acc);
            const bf16* ap[2]; int as[2]; const bf16* bp[2];
#pragma unroll
            for (int i = 0; i < 2; ++i) { const int r = 64 * i + srow;
                if (!isctx) { ap[i] = Ul + (size_t)r * 512 + sck * 8; as[i] = 64; }
                else if (r < 8) { ap[i] = Uc + (size_t)r * 512 + sck * 8; as[i] = 64; }
                else { ap[i] = zero; as[i] = 0; }
                bp[i] = Wst + (size_t)(n0 + r) * 512 + sck * 8; }
            gemm_loop<2>(acc, ap, as, bp, 8, lds);
#pragma unroll
            for (int mt = 0; mt < 2; ++mt) { const int row = wm * 32 + mt * 16 + fr;
                if (!isctx || row < 8) {
#pragma unroll
                    for (int nt = 0; nt < 4; ++nt) { const int col = n0 + wn * 64 + nt * 16 + 4 * fq;
                        u32x2 w; w.x = pk2(acc[mt][nt][0], acc[mt][nt][1]); w.y = pk2(acc[mt][nt][2], acc[mt][nt][3]);
                        *(u32x2*)(Sb + (size_t)((isctx ? 128 : 0) + row) * S5_PITCH + col * 2) = w; } } }
        }
        __syncthreads();
        if (tid < 128) {
            const int d = tid >> 6, pp = tid & 63; const float* aT = (const float*)(p.ws + WS_ABART) + g * 256 + tid * 2; const float ar = aT[0], ai = aT[1];
            bf16* colr = (bf16*)Sb + d * 128 + pp; bf16* coli = colr + 64; constexpr int RP = S5_PITCH / 2;
            float hr = 0.f, hi = 0.f;
            if (d == 0) {
                for (int c = 0; c < 8; ++c) { const float sr = bf2f(colr[(128 + c) * RP]), si = bf2f(coli[(128 + c) * RP]); const float nr = ar * hr - ai * hi + sr, ni = ar * hi + ai * hr + si; hr = nr; hi = ni; }
                for (int c = 0; c < 128; ++c) { const float sr = bf2f(colr[c * RP]), si = bf2f(coli[c * RP]); const unsigned w = pk2(hr, hi); colr[c * RP] = (bf16)(w & 0xffffu); coli[c * RP] = (bf16)(w >> 16);
                    const float nr = ar * hr - ai * hi + sr, ni = ar * hi + ai * hr + si; hr = nr; hi = ni; }
            } else {
                for (int c = 7; c >= 0; --c) { const float sr = bf2f(colr[(128 + c) * RP]), si = bf2f(coli[(128 + c) * RP]); const float nr = ar * hr - ai * hi + sr, ni = ar * hi + ai * hr + si; hr = nr; hi = ni; }
                for (int c = 127; c >= 0; --c) { const float sr = bf2f(colr[c * RP]), si = bf2f(coli[c * RP]); const unsigned w = pk2(hr, hi); colr[c * RP] = (bf16)(w & 0xffffu); coli[c * RP] = (bf16)(w >> 16);
                    const float nr = ar * hr - ai * hi + sr, ni = ar * hi + ai * hr + si; hr = nr; hi = ni; }
            }
        }
        __syncthreads();
        bf16* yact = (bf16*)(p.ws + WS_R4);
        for (int pass = 0; pass < 4; ++pass) {
            const int n0 = pass * 128;
            f32x4 acc[2][4]; zero_acc<2>(acc);
            const bf16* ap[2]; int as[2]; const bf16* bp[2];
#pragma unroll
            for (int i = 0; i < 2; ++i) { const int r = 64 * i + srow; ap[i] = Ul + (size_t)r * 512 + sck * 8; as[i] = 64; bp[i] = Mg + (size_t)(n0 + r) * 512 + sck * 8; }
            gemm_loop<2>(acc, ap, as, bp, 8, lds);
#pragma unroll
            for (int i = 0; i < 2; ++i) bp[i] = Wos + (size_t)(n0 + 64 * i + srow) * 256 + sck * 8;
            gemm_loop_alds<2>(acc, Sb, S5_PITCH, bp, 4, lds);
#pragma unroll
            for (int mt = 0; mt < 2; ++mt) { const int c = wm * 32 + mt * 16 + fr;
#pragma unroll
                for (int nt = 0; nt < 4; ++nt) { const int col = n0 + wn * 64 + nt * 16 + 4 * fq, j = col >> 4, i0 = col & 15, l = 32 * c + j;
                    const u32x2 uu = *(const u32x2*)(Ul + (size_t)l * 16 + i0); const f32x4 dd = *(const f32x4*)(p.s5_d + g * 16 + i0);
                    const float y0 = geluf_(acc[mt][nt][0] + dd.x * __uint_as_float(uu.x << 16)), y1 = geluf_(acc[mt][nt][1] + dd.y * __uint_as_float(uu.x & 0xffff0000u));
                    const float y2 = geluf_(acc[mt][nt][2] + dd.z * __uint_as_float(uu.y << 16)), y3 = geluf_(acc[mt][nt][3] + dd.w * __uint_as_float(uu.y & 0xffff0000u));
                    u32x2 w; w.x = pk2(y0, y1); w.y = pk2(y2, y3);
                    *(u32x2*)(yact + ((size_t)(b * 4096 + l) * 512 + g * 16 + i0)) = w; } }
        }
        __syncthreads();
    }
}
constexpr int FF_W1P = 272, FF_W2P = 80, FF_W1_OFF = 0, FF_W2_OFF = 128 * FF_W1P, FF_TW_OFF = FF_W2_OFF + 4 * 64 * FF_W2P, FF_LDS = FF_TW_OFF + 32768;
DI void phase2_fft(const Params& p, unsigned char* lds, int bid, int nb) {
    const int tid = threadIdx.x, lane = tid & 63, wid = tid >> 6, fr = lane & 15, fq = lane >> 4;
    { const bf16* W1 = (const bf16*)(p.ws + WS_FFTC); const bf16* W2 = W1 + 128 * 128; const float* tw = (const float*)(p.ws + WS_FFTC + 32768 + 16384);
      for (int i = tid; i < 128 * 16; i += NT) { const int n = i >> 4, c = i & 15; *(u32x4*)(lds + FF_W1_OFF + n * FF_W1P + c * 16) = *(const u32x4*)(W1 + n * 128 + c * 8); }
      for (int i = tid; i < 256 * 4; i += NT) { const int r = i >> 2, c = i & 3; *(u32x4*)(lds + FF_W2_OFF + r * FF_W2P + c * 16) = *(const u32x4*)(W2 + r * 32 + c * 8); }
      for (int i = tid; i < 2048; i += NT) *(u32x4*)(lds + FF_TW_OFF + i * 16) = *(const u32x4*)(tw + i * 4);
      __syncthreads(); }
    const bf16* GT = (const bf16*)(p.ws + WS_R2); bf16* FT = (bf16*)(p.ws + WS_R5);
    const float* twl = (const float*)(lds + FF_TW_OFF);
    for (int cidx = bid * 8 + wid; cidx < 4096; cidx += nb * 8) {
        const bf16* gt = GT + (size_t)cidx * 2 * 4096;
        bf16* ft = FT + (size_t)cidx * 4096;
#pragma unroll 1
        for (int nt = 0; nt < 4; ++nt) {
            f32x4 dre[4], dim[4];
#pragma unroll
            for (int m = 0; m < 4; ++m) { dre[m] = (f32x4){0.f, 0.f, 0.f, 0.f}; dim[m] = (f32x4){0.f, 0.f, 0.f, 0.f}; }
#pragma unroll
            for (int ks = 0; ks < 4; ++ks) {
                bf16x8 afr[4];
#pragma unroll
                for (int mt = 0; mt < 4; ++mt) afr[mt] = *(const bf16x8*)(gt + (ks >> 1) * 4096 + (16 * mt + fr) * 64 + 32 * (ks & 1) + 8 * fq);
                const bf16x8 bre = *(const bf16x8*)(lds + FF_W1_OFF + (nt * 16 + fr) * FF_W1P + (ks * 32 + fq * 8) * 2);
                const bf16x8 bim = *(const bf16x8*)(lds + FF_W1_OFF + (64 + nt * 16 + fr) * FF_W1P + (ks * 32 + fq * 8) * 2);
#pragma unroll
                for (int mt = 0; mt < 4; ++mt) { dre[mt] = __builtin_amdgcn_mfma_f32_16x16x32_bf16(afr[mt], bre, dre[mt], 0, 0, 0);
                                                 dim[mt] = __builtin_amdgcn_mfma_f32_16x16x32_bf16(afr[mt], bim, dim[mt], 0, 0, 0); }
            }
            const int d = 16 * nt + fr; unsigned pr[4][2], pi[4][2];
#pragma unroll
            for (int mt = 0; mt < 4; ++mt) { float tr[4], ti[4];
#pragma unroll
                for (int r = 0; r < 4; ++r) { const int a = 16 * mt + 4 * fq + r, ix = (d * a) & 4095; const float cs = twl[ix * 2], sn = twl[ix * 2 + 1];
                    const float re = dre[mt][r], im = dim[mt][r]; tr[r] = re * cs + im * sn; ti[r] = im * cs - re * sn; }
                pr[mt][0] = pk2(tr[0], tr[1]); pr[mt][1] = pk2(tr[2], tr[3]); pi[mt][0] = pk2(ti[0], ti[1]); pi[mt][1] = pk2(ti[2], ti[3]); }
            u32x4 f0, f1, f2, f3;
            f0.x = pr[0][0]; f0.y = pr[0][1]; f0.z = pr[1][0]; f0.w = pr[1][1];
            f1.x = pr[2][0]; f1.y = pr[2][1]; f1.z = pr[3][0]; f1.w = pr[3][1];
            f2.x = pi[0][0]; f2.y = pi[0][1]; f2.z = pi[1][0]; f2.w = pi[1][1];
            f3.x = pi[2][0]; f3.y = pi[2][1]; f3.z = pi[3][0]; f3.w = pi[3][1];
            bf16x8 frag[4];
            frag[0] = __builtin_bit_cast(bf16x8, f0); frag[1] = __builtin_bit_cast(bf16x8, f1); frag[2] = __builtin_bit_cast(bf16x8, f2); frag[3] = __builtin_bit_cast(bf16x8, f3);
            f32x4 z[4];
#pragma unroll
            for (int n = 0; n < 4; ++n) z[n] = (f32x4){0.f, 0.f, 0.f, 0.f};
#pragma unroll
            for (int s2 = 0; s2 < 4; ++s2)
#pragma unroll
                for (int n2 = 0; n2 < 4; ++n2) { const bf16x8 bfr = *(const bf16x8*)(lds + FF_W2_OFF + ((s2 * 64 + n2 * 16 + fr) * FF_W2P) + fq * 16);
                    z[n2] = __builtin_amdgcn_mfma_f32_16x16x32_bf16(frag[s2], bfr, z[n2], 0, 0, 0); }
#pragma unroll
            for (int n2 = 0; n2 < 4; ++n2) { const int cf = 16 * n2 + fr; u32x2 w; w.x = pk2(z[n2][0], z[n2][1]); w.y = pk2(z[n2][2], z[n2][3]);
                *(u32x2*)(ft + 64 * cf + 16 * nt + 4 * fq) = w; }
        }
    }
}
DI void phase3_glu(const Params& p, unsigned char* lds, int bid, int nb) {
    const int tid = threadIdx.x, lane = tid & 63, wid = tid >> 6, wm = wid >> 1, wn = wid & 1, fr = lane & 15, fq = lane >> 4, srow = tid >> 3, sck = tid & 7;
    const bf16* yact = (const bf16*)(p.ws + WS_R4); const bf16* Wg = (const bf16*)(p.ws + WS_WGLUT); bf16* merged = (bf16*)(p.ws + WS_R1);
    for (int item = bid; item < 128 * 4; item += nb) {
        const int m0 = (item >> 2) * 256, n0 = (item & 3) * 128;
        f32x4 acc[4][4]; zero_acc<4>(acc);
        const bf16* ap[4]; int as[4]; const bf16* bp[2];
#pragma unroll
        for (int i = 0; i < 4; ++i) { ap[i] = yact + (size_t)(m0 + 64 * i + srow) * 512 + sck * 8; as[i] = 64; }
#pragma unroll
        for (int i = 0; i < 2; ++i) bp[i] = Wg + (size_t)(n0 + 64 * i + srow) * 512 + sck * 8;
        gemm_loop<4>(acc, ap, as, bp, 8, lds);
#pragma unroll
        for (int mt = 0; mt < 4; ++mt) { const int row = m0 + wm * 64 + mt * 16 + fr;
#pragma unroll
            for (int nt = 0; nt < 4; ++nt) { const int col = n0 + wn * 64 + nt * 16 + 4 * fq;
                const u32x2 yy = *(const u32x2*)(yact + (size_t)row * 512 + col);
                const float y0 = __uint_as_float(yy.x << 16) * sigmoidf_(acc[mt][nt][0]), y1 = __uint_as_float(yy.x & 0xffff0000u) * sigmoidf_(acc[mt][nt][1]);
                const float y2 = __uint_as_float(yy.y << 16) * sigmoidf_(acc[mt][nt][2]), y3 = __uint_as_float(yy.y & 0xffff0000u) * sigmoidf_(acc[mt][nt][3]);
                u32x2 w; w.x = pk2(y0, y1); w.y = pk2(y2, y3); *(u32x2*)(merged + (size_t)row * 1024 + col) = w; } }
    }
}
constexpr int FM_PITCH = 132, FM_LDS = 512 * FM_PITCH;
DI void phase3_fin(const Params& p, unsigned char* lds, int bid, int nb) {
    const int tid = threadIdx.x, lane = tid & 63, wid = tid >> 6;
    const bf16* FT = (const bf16*)(p.ws + WS_R5); bf16* merged = (bf16*)(p.ws + WS_R1);
    for (int item = bid; item < 512; item += nb) {
        const int b = item >> 6, k0 = (item & 63) * 64;
        for (int i = tid; i < 512 * 8; i += NT) { const int ch = i >> 3, c = i & 7; const u32x4 v = *(const u32x4*)(FT + ((size_t)(b * 512 + ch) * 4096 + k0 + c * 8));
            unsigned* d = (unsigned*)(lds + ch * FM_PITCH + c * 16); d[0] = v.x; d[1] = v.y; d[2] = v.z; d[3] = v.w; }
        __syncthreads();
        for (int t = wid * 8; t < wid * 8 + 8; ++t) {
            const size_t row = (size_t)b * 4096 + k0 + t;
            float f[8]; float s = 0.f;
#pragma unroll
            for (int j = 0; j < 8; ++j) { f[j] = bf2f(*(const bf16*)(lds + (lane + 64 * j) * FM_PITCH + t * 2)); s += f[j] * f[j]; }
            const float rs = rsqrtf(wave_sum(s) * (1.f / 512.f) + EPS);
#pragma unroll
            for (int j = 0; j < 8; ++j) merged[row * 1024 + 512 + lane + 64 * j] = (bf16)(pk2(f[j] * rs * p.g_f[lane + 64 * j], 0.f) & 0xffffu);
            u32x4 yv = *(const u32x4*)(merged + row * 1024 + lane * 8);
            float y[8]; y[0] = __uint_as_float(yv.x << 16); y[1] = __uint_as_float(yv.x & 0xffff0000u); y[2] = __uint_as_float(yv.y << 16); y[3] = __uint_as_float(yv.y & 0xffff0000u);
            y[4] = __uint_as_float(yv.z << 16); y[5] = __uint_as_float(yv.z & 0xffff0000u); y[6] = __uint_as_float(yv.w << 16); y[7] = __uint_as_float(yv.w & 0xffff0000u);
            float s2 = 0.f;
#pragma unroll
            for (int j = 0; j < 8; ++j) s2 += y[j] * y[j];
            const float rs2 = rsqrtf(wave_sum(s2) * (1.f / 512.f) + EPS);
            const f32x4 g0 = *(const f32x4*)(p.g_s + lane * 8), g1 = *(const f32x4*)(p.g_s + lane * 8 + 4);
            u32x4 o; o.x = pk2(y[0] * rs2 * g0.x, y[1] * rs2 * g0.y); o.y = pk2(y[2] * rs2 * g0.z, y[3] * rs2 * g0.w); o.z = pk2(y[4] * rs2 * g1.x, y[5] * rs2 * g1.y); o.w = pk2(y[6] * rs2 * g1.z, y[7] * rs2 * g1.w);
            *(u32x4*)(merged + row * 1024 + lane * 8) = o;
        }
        __syncthreads();
    }
}
DI void phase4_out(const Params& p, unsigned char* lds, int bid, int nb) {
    const int tid = threadIdx.x, lane = tid & 63, wid = tid >> 6, wm = wid >> 1, wn = wid & 1, fr = lane & 15, fq = lane >> 4, srow = tid >> 3, sck = tid & 7;
    const bf16* merged = (const bf16*)(p.ws + WS_R1); const bf16* Wo = (const bf16*)(p.ws + WS_WOUTT); const float* mod = (const float*)(p.ws + WS_MOD);
    float* rsqp = (float*)(p.ws + WS_RSQP1);
    for (int item = bid; item < 128 * 8; item += nb) {
        const int m0 = (item >> 3) * 256, n0 = (item & 7) * 128;
        f32x4 acc[4][4]; zero_acc<4>(acc);
        const bf16* ap[4]; int as[4]; const bf16* bp[2];
#pragma unroll
        for (int i = 0; i < 4; ++i) { ap[i] = merged + (size_t)(m0 + 64 * i + srow) * 1024 + sck * 8; as[i] = 64; }
#pragma unroll
        for (int i = 0; i < 2; ++i) bp[i] = Wo + (size_t)(n0 + 64 * i + srow) * 1024 + sck * 8;
        gemm_loop<4>(acc, ap, as, bp, 16, lds);
#pragma unroll
        for (int mt = 0; mt < 4; ++mt) { const int row = m0 + wm * 64 + mt * 16 + fr, b = row >> 12; float s = 0.f;
#pragma unroll
            for (int nt = 0; nt < 4; ++nt) { const int col = n0 + wn * 64 + nt * 16 + 4 * fq;
                const f32x4 xv = *(const f32x4*)(p.x + (size_t)row * D + col), gv = *(const f32x4*)(mod + b * 6144 + 2048 + col);
                const f32x4 o = xv + gv * acc[mt][nt]; *(f32x4*)(p.out + (size_t)row * D + col) = o; s += o.x * o.x + o.y * o.y + o.z * o.z + o.w * o.w; }
            s += __shfl_xor(s, 16); s += __shfl_xor(s, 32);
            if (fq == 0) rsqp[(size_t)row * 16 + (item & 7) * 2 + wn] = s; }
    }
}
DI int pair_index(int lo, int hi) { return 7 * lo - (lo * (lo - 1)) / 2 + (hi - lo - 1); }
constexpr int RT_WP = 2064, RT_GM_OFF = 48 * RT_WP, RT_SH_OFF = RT_GM_OFF + 4096, RT_SC_OFF = RT_SH_OFF + 4096, RT_LDS = RT_SC_OFF + 8 * 16 * 48 * 4;
DI void phase5_route(const Params& p, unsigned char* lds, int bid, int nb) {
    const int tid = threadIdx.x, lane = tid & 63, wid = tid >> 6, fr = lane & 15, fq = lane >> 4;
    { const bf16* W = (const bf16*)(p.ws + WS_WRT);
      for (int i = tid; i < 48 * 128; i += NT) { const int n = i >> 7, c = i & 127; *(u32x4*)(lds + n * RT_WP + c * 16) = *(const u32x4*)(W + n * 1024 + c * 8); } }
    const float* mod = (const float*)(p.ws + WS_MOD); const float* rsqp = (const float*)(p.ws + WS_RSQP1);
    bf16* A2 = (bf16*)(p.ws + WS_R2); float* gw = (float*)(p.ws + WS_GW);
    unsigned* ecnt = (unsigned*)(p.ws + WS_CTL + CTL_ECNT); unsigned* pcnt = (unsigned*)(p.ws + WS_CTL + CTL_PCNT);
    unsigned* elist = (unsigned*)(p.ws + WS_ELIST); unsigned* plist = (unsigned*)(p.ws + WS_PLIST);
    float* gm = (float*)(lds + RT_GM_OFF); float* shv = (float*)(lds + RT_SH_OFF); float* scr = (float*)(lds + RT_SC_OFF) + wid * 16 * 48;
    for (int t128 = bid; t128 < NTOK / 128; t128 += nb) {
        const int b = t128 >> 5;
        __syncthreads();
        for (int k = tid; k < 1024; k += NT) { gm[k] = p.norm2_g[k] * (1.f + mod[b * 6144 + 4096 + k]); shv[k] = mod[b * 6144 + 3072 + k]; }
        __syncthreads();
        const int row0 = t128 * 128 + wid * 16, row = row0 + fr;
        float rs;
        { const f32x4* pp = (const f32x4*)(rsqp + (size_t)row * 16); const f32x4 q0 = pp[0], q1 = pp[1], q2 = pp[2], q3 = pp[3];
          const float rsum = (((q0.x + q0.y) + (q0.z + q0.w)) + ((q1.x + q1.y) + (q1.z + q1.w))) + (((q2.x + q2.y) + (q2.z + q2.w)) + ((q3.x + q3.y) + (q3.z + q3.w)));
          rs = rsqrtf(rsum * (1.f / D) + EPS); }
        f32x4 acc[3];
#pragma unroll
        for (int n = 0; n < 3; ++n) acc[n] = (f32x4){0.f, 0.f, 0.f, 0.f};
        const float* xr = p.out + (size_t)row * D + fq * 8; bf16* ar = A2 + (size_t)row * D + fq * 8;
#pragma unroll 2
        for (int ks = 0; ks < 32; ++ks) {
            const int k0 = ks * 32 + fq * 8;
            const f32x4 x0 = *(const f32x4*)(xr + ks * 32), x1 = *(const f32x4*)(xr + ks * 32 + 4);
            const f32x4 g0 = *(const f32x4*)(gm + k0), g1 = *(const f32x4*)(gm + k0 + 4), s0 = *(const f32x4*)(shv + k0), s1 = *(const f32x4*)(shv + k0 + 4);
            const f32x4 t0 = x0 * rs * g0 + s0, t1 = x1 * rs * g1 + s1;
            u32x4 hi; hi.x = pk2(t0.x, t0.y); hi.y = pk2(t0.z, t0.w); hi.z = pk2(t1.x, t1.y); hi.w = pk2(t1.z, t1.w);
            *(u32x4*)(ar + ks * 32) = hi;
            u32x4 lo;
            lo.x = pk2(t0.x - __uint_as_float(hi.x << 16), t0.y - __uint_as_float(hi.x & 0xffff0000u)); lo.y = pk2(t0.z - __uint_as_float(hi.y << 16), t0.w - __uint_as_float(hi.y & 0xffff0000u));
            lo.z = pk2(t1.x - __uint_as_float(hi.z << 16), t1.y - __uint_as_float(hi.z & 0xffff0000u)); lo.w = pk2(t1.z - __uint_as_float(hi.w << 16), t1.w - __uint_as_float(hi.w & 0xffff0000u));
            const bf16x8 ah = __builtin_bit_cast(bf16x8, hi), al = __builtin_bit_cast(bf16x8, lo);
#pragma unroll
            for (int nt = 0; nt < 3; ++nt) { const bf16x8 bw = *(const bf16x8*)(lds + (16 * nt + fr) * RT_WP + k0 * 2);
                acc[nt] = __builtin_amdgcn_mfma_f32_16x16x32_bf16(ah, bw, acc[nt], 0, 0, 0); acc[nt] = __builtin_amdgcn_mfma_f32_16x16x32_bf16(al, bw, acc[nt], 0, 0, 0); }
        }
#pragma unroll
        for (int nt = 0; nt < 3; ++nt)
#pragma unroll
            for (int r = 0; r < 4; ++r) scr[(4 * fq + r) * 48 + 16 * nt + fr] = acc[nt][r];
        __syncthreads();
        if (lane < 16) {
            const int rrow = row0 + lane; const float* lg = scr + lane * 48;
            float gl[4];
#pragma unroll
            for (int o = 0; o < 4; ++o) gl[o] = lg[o] + p.b_group[o];
            float gmax = gl[0]; int gi = 0;
#pragma unroll
            for (int o = 1; o < 4; ++o) if (gl[o] > gmax) { gmax = gl[o]; gi = o; }
            float se = 0.f;
#pragma unroll
            for (int o = 0; o < 4; ++o) se += __expf(gl[o] - gmax);
            const float g_w = 1.f / se;
            float ev[8];
#pragma unroll
            for (int o = 0; o < 8; ++o) ev[o] = lg[4 + gi * 8 + o] + p.b_router[gi * 8 + o];
            float v1 = ev[0]; int i1 = 0;
#pragma unroll
            for (int o = 1; o < 8; ++o) if (ev[o] > v1) { v1 = ev[o]; i1 = o; }
            float v2 = -3.0e38f; int i2 = -1;
#pragma unroll
            for (int o = 0; o < 8; ++o) if (o != i1 && ev[o] > v2) { v2 = ev[o]; i2 = o; }
            const float w1 = g_w / (1.f + __expf(v2 - v1)), w2 = g_w - w1;
            const int lo = i1 < i2 ? i1 : i2, hi = i1 < i2 ? i2 : i1; const int pos1 = i1 < i2 ? 0 : 1;
            gw[rrow * 2 + pos1] = w1; gw[rrow * 2 + (1 - pos1)] = w2;
            const int e1 = gi * 8 + i1, e2 = gi * 8 + i2;
            const unsigned q1 = atomicAdd(ecnt + e1, 1u); elist[(size_t)e1 * 32768 + q1] = (unsigned)rrow * 2u + (unsigned)pos1;
            const unsigned q2 = atomicAdd(ecnt + e2, 1u); elist[(size_t)e2 * 32768 + q2] = (unsigned)rrow * 2u + (unsigned)(1 - pos1);
            const int cls = gi * 28 + pair_index(lo, hi);
            const unsigned q3 = atomicAdd(pcnt + cls, 1u); plist[(size_t)cls * 32768 + q3] = (unsigned)rrow;
        }
    }
    __syncthreads();
}
constexpr int TB_OFF = 98304, TB_BYTES = (64 + 2048) * 4;
DI void build_tiles(const Params& p, unsigned char* lds) {
    if (threadIdx.x == 0) {
        int* tb = (int*)(lds + TB_OFF); const unsigned* ecnt = (const unsigned*)(p.ws + WS_CTL + CTL_ECNT); const unsigned* pcnt = (const unsigned*)(p.ws + WS_CTL + CTL_PCNT);
        int n = 0;
        for (int e = 0; e < 32; ++e) { const int c = (int)ecnt[e]; for (int r0 = 0; r0 < c; r0 += 256) { tb[64 + n] = e; tb[64 + 512 + n] = r0; ++n; } }
        tb[0] = n; n = 0;
        for (int c2 = 0; c2 < 112; ++c2) { const int c = (int)pcnt[c2]; for (int r0 = 0; r0 < c; r0 += 256) { tb[64 + 1024 + n] = c2; tb[64 + 1536 + n] = r0; ++n; } }
        tb[1] = n;
    }
    __syncthreads();
}
DI void phase6_gateup(const Params& p, unsigned char* lds, int bid, int nb) {
    const int tid = threadIdx.x, lane = tid & 63, wid = tid >> 6, wm = wid >> 1, wn = wid & 1, fr = lane & 15, fq = lane >> 4, srow = tid >> 3, sck = tid & 7;
    const int* tb = (const int*)(lds + TB_OFF); const int n_et = tb[0];
    const bf16* A2 = (const bf16*)(p.ws + WS_R2); const bf16* Wgu = (const bf16*)(p.ws + WS_WGUT); bf16* Hb = (bf16*)(p.ws + WS_R3);
    const bf16* zero = (const bf16*)(p.ws + WS_CTL + CTL_ZERO); const float* gw = (const float*)(p.ws + WS_GW);
    const unsigned* ecnt = (const unsigned*)(p.ws + WS_CTL + CTL_ECNT); const unsigned* elist = (const unsigned*)(p.ws + WS_ELIST);
    for (int item = bid; item < n_et * 4; item += nb) {
        const int tile = item >> 2, blk = item & 3, e = tb[64 + tile], r0 = tb[64 + 512 + tile], cnt = (int)ecnt[e];
        f32x4 acc[4][4]; zero_acc<4>(acc);
        const bf16* ap[4]; int as[4]; const bf16* bp[2];
#pragma unroll
        for (int i = 0; i < 4; ++i) { const int r = r0 + 64 * i + srow;
            if (r < cnt) { const unsigned ent = elist[(size_t)e * 32768 + r]; ap[i] = A2 + (size_t)(ent >> 1) * D + sck * 8; as[i] = 64; } else { ap[i] = zero; as[i] = 0; } }
#pragma unroll
        for (int i = 0; i < 2; ++i) bp[i] = Wgu + ((size_t)e * 512 + blk * 128 + 64 * i + srow) * D + sck * 8;
        gemm_loop<4>(acc, ap, as, bp, 16, lds);
#pragma unroll
        for (int mt = 0; mt < 4; ++mt) { const int r = r0 + wm * 64 + mt * 16 + fr;
            if (r < cnt) { const unsigned ent = elist[(size_t)e * 32768 + r]; const float w = gw[ent];
#pragma unroll
                for (int nt = 0; nt < 2; ++nt) { const int hid = blk * 64 + wn * 32 + nt * 16 + 4 * fq;
                    const float h0 = siluf_(acc[mt][nt][0]) * acc[mt][nt + 2][0] * w, h1 = siluf_(acc[mt][nt][1]) * acc[mt][nt + 2][1] * w;
                    const float h2 = siluf_(acc[mt][nt][2]) * acc[mt][nt + 2][2] * w, h3 = siluf_(acc[mt][nt][3]) * acc[mt][nt + 2][3] * w;
                    u32x2 o; o.x = pk2(h0, h1); o.y = pk2(h2, h3); *(u32x2*)(Hb + (size_t)ent * 256 + hid) = o; } } }
    }
}
DI void phase7_down(const Params& p, unsigned char* lds, int bid, int nb) {
    const int tid = threadIdx.x, lane = tid & 63, wid = tid >> 6, wm = wid >> 1, wn = wid & 1, fr = lane & 15, fq = lane >> 4, srow = tid >> 3, sck = tid & 7;
    const int* tb = (const int*)(lds + TB_OFF); const int n_pt = tb[1];
    const bf16* Hb = (const bf16*)(p.ws + WS_R3); const bf16* Wd = (const bf16*)(p.ws + WS_WDT);
    const bf16* zero = (const bf16*)(p.ws + WS_CTL + CTL_ZERO); const float* mod = (const float*)(p.ws + WS_MOD);
    const unsigned* pcnt = (const unsigned*)(p.ws + WS_CTL + CTL_PCNT); const unsigned* plist = (const unsigned*)(p.ws + WS_PLIST);
    float* rsqp = (float*)(p.ws + WS_RSQP2);
    for (int item = bid; item < n_pt * 8; item += nb) {
        const int tile = item >> 3, n0 = (item & 7) * 128, cls = tb[64 + 1024 + tile], r0 = tb[64 + 1536 + tile], cnt = (int)pcnt[cls];
        const int gi = cls / 28, pi = cls % 28; int lo = 0, rem = pi;
        while (rem >= 7 - lo) { rem -= 7 - lo; ++lo; }
        const int hi = lo + 1 + rem, elo = gi * 8 + lo, ehi = gi * 8 + hi;
        f32x4 acc[4][4]; zero_acc<4>(acc);
        const bf16* ap[4]; int as[4]; const bf16* bp[2];
#pragma unroll
        for (int i = 0; i < 4; ++i) { const int r = r0 + 64 * i + srow;
            if (r < cnt) { const unsigned tok = plist[(size_t)cls * 32768 + r]; ap[i] = Hb + (size_t)tok * 512 + sck * 8; as[i] = 64; } else { ap[i] = zero; as[i] = 0; } }
#pragma unroll
        for (int i = 0; i < 2; ++i) bp[i] = Wd + ((size_t)elo * 1024 + n0 + 64 * i + srow) * 256 + sck * 8;
        gemm_loop<4>(acc, ap, as, bp, 4, lds);
#pragma unroll
        for (int i = 0; i < 4; ++i) if (as[i]) ap[i] += 256;
#pragma unroll
        for (int i = 0; i < 2; ++i) bp[i] = Wd + ((size_t)ehi * 1024 + n0 + 64 * i + srow) * 256 + sck * 8;
        gemm_loop<4>(acc, ap, as, bp, 4, lds);
#pragma unroll
        for (int mt = 0; mt < 4; ++mt) { const int r = r0 + wm * 64 + mt * 16 + fr; float s = 0.f; unsigned tok = 0;
            if (r < cnt) { tok = plist[(size_t)cls * 32768 + r]; const int b = tok >> 12;
#pragma unroll
                for (int nt = 0; nt < 4; ++nt) { const int col = n0 + wn * 64 + nt * 16 + 4 * fq;
                    float* xp = p.out + (size_t)tok * D + col; const f32x4 xv = *(const f32x4*)xp, gv = *(const f32x4*)(mod + b * 6144 + 5120 + col);
                    const f32x4 o = xv + gv * acc[mt][nt]; *(f32x4*)xp = o; s += o.x * o.x + o.y * o.y + o.z * o.z + o.w * o.w; } }
            s += __shfl_xor(s, 16); s += __shfl_xor(s, 32);
            if (fq == 0 && r < cnt) rsqp[(size_t)tok * 16 + (item & 7) * 2 + wn] = s; }
    }
}
DI void phase8_final(const Params& p, int bid, int nb) {
    const int lane = threadIdx.x & 63, wave = threadIdx.x >> 6;
    const float* rsqp = (const float*)(p.ws + WS_RSQP2);
    for (int r = bid * 8 + wave; r < NTOK; r += nb * 8) {
        const f32x4* pp = (const f32x4*)(rsqp + (size_t)r * 16); const f32x4 q0 = pp[0], q1 = pp[1], q2 = pp[2], q3 = pp[3];
        const float rsum = (((q0.x + q0.y) + (q0.z + q0.w)) + ((q1.x + q1.y) + (q1.z + q1.w))) + (((q2.x + q2.y) + (q2.z + q2.w)) + ((q3.x + q3.y) + (q3.z + q3.w)));
        const float rs = rsqrtf(rsum * (1.f / D) + EPS);
        f32x4* xr = (f32x4*)(p.out + (size_t)r * D) + lane;
#pragma unroll
        for (int j = 0; j < 4; ++j) { const f32x4 g = *(const f32x4*)(p.final_g + lane * 4 + 256 * j); xr[64 * j] = xr[64 * j] * rs * g; }
    }
}

#define XB_TMO      128
#define XB_XCNT(j)  (256  + 64 * (j))
#define XB_XSUB(j)  (1280 + 64 * (j))
#define XB_XGEN(j)  (2304 + 64 * (j))
#define XB_TOP      3328
#define XB_TOPGEN   3392
#define XCD_BAR_WORDS 3456
#define XB_SPIN_CAP (1u << 18)
#define LAS __attribute__((address_space(3)))
DI unsigned xb_ld(unsigned* p)              { return __hip_atomic_load(p, __ATOMIC_RELAXED, __HIP_MEMORY_SCOPE_AGENT); }
DI unsigned xb_add(unsigned* p, unsigned v) { return __hip_atomic_fetch_add(p, v, __ATOMIC_RELAXED, __HIP_MEMORY_SCOPE_AGENT); }
DI unsigned xb_xcc_id() { return (unsigned)__builtin_amdgcn_s_getreg((3 << 11) | 20) & 0xFu; }
#define XB_SPIN(cond, bar) do { unsigned _sp = 0; while (cond) { __builtin_amdgcn_s_sleep(1); \
    if ((++_sp & 255u) == 0u) { if (xb_ld(&(bar)[XB_TMO])) break; if (_sp > XB_SPIN_CAP) { atomicAdd(&(bar)[XB_TMO], 1u); break; } } } } while (0)
struct XcdBarrier { unsigned* bar; unsigned x; volatile LAS unsigned* st; };
DI XcdBarrier xcd_barrier_post(unsigned* bar, volatile LAS unsigned* st) {
    XcdBarrier b; b.bar = bar; b.x = xb_xcc_id(); b.st = st;
    if (threadIdx.x == 0) (void)xb_add(&bar[XB_XCNT(b.x)], 1u);
    return b;
}
DI void xcd_barrier_complete(unsigned* bar, unsigned x, unsigned& nloc, unsigned& nx) {
    const unsigned G = gridDim.x * gridDim.y * gridDim.z;
    unsigned sum, cnt, mine, sp = 0u;
    for (;;) {
        sum = 0u; cnt = 0u; mine = 0u;
#pragma unroll
        for (unsigned j = 0; j < 16; ++j) { const unsigned c = xb_ld(&bar[XB_XCNT(j)]); sum += c; cnt += (c > 0u) ? 1u : 0u; mine = (j == x) ? c : mine; }
        if (sum == G) break;
        __builtin_amdgcn_s_sleep(1);
        if ((++sp & 255u) == 0u) { if (xb_ld(&bar[XB_TMO])) break; if (sp > XB_SPIN_CAP) { atomicAdd(&bar[XB_TMO], 1u); break; } }
    }
    nloc = mine > 0u ? mine : 1u; nx = cnt > 0u ? cnt : 1u;
}
DI void xcd_barrier(const XcdBarrier& b) {
    asm volatile("s_waitcnt vmcnt(0)" ::: "memory");
    __syncthreads();
    if (threadIdx.x == 0) {
        unsigned* bar = b.bar;
        __builtin_amdgcn_s_waitcnt(0);
        unsigned nloc = b.st[0], nx = b.st[1];
        if (nloc == 0u) { xcd_barrier_complete(bar, b.x, nloc, nx); b.st[0] = nloc; b.st[1] = nx; }
        const unsigned old = xb_add(&bar[XB_XSUB(b.x)], 1u);
        const unsigned gen = old / nloc;
        if (old + 1u == (gen + 1u) * nloc) {
            __builtin_amdgcn_fence(__ATOMIC_RELEASE, "agent");
            asm volatile("s_waitcnt vmcnt(0)" ::: "memory");
            const unsigned og = xb_add(&bar[XB_TOP], 1u);
            const unsigned tg = og / nx;
            if (og + 1u == (tg + 1u) * nx) xb_add(&bar[XB_TOPGEN], 1u);
            else XB_SPIN(xb_ld(&bar[XB_TOPGEN]) == tg, bar);
            __builtin_amdgcn_fence(__ATOMIC_ACQUIRE, "agent");
            xb_add(&bar[XB_XGEN(b.x)], 1u);
            asm volatile("s_waitcnt vmcnt(0)" ::: "memory");
        } else {
            XB_SPIN(xb_ld(&bar[XB_XGEN(b.x)]) == gen, bar);
            __builtin_amdgcn_fence(__ATOMIC_ACQUIRE, "agent");
            asm volatile("s_waitcnt vmcnt(0)" ::: "memory");
        }
    }
    __syncthreads();
}

constexpr int CTL_BAR = 16384;
constexpr int MK_LDS = 163840;
constexpr int MK_ST_OFF = MK_LDS - 16;
static_assert(S5_LDS <= MK_ST_OFF && FF_LDS <= MK_ST_OFF && RT_LDS <= MK_ST_OFF && TB_OFF + TB_BYTES <= MK_ST_OFF && TB_OFF >= GC<4>::LDS, "LDS map");
static_assert(4 * (4096 + 4096 + 8448 + 16384) <= MK_ST_OFF, "prep LDS");
#ifndef MK_REP
#define MK_REP -1
#endif
#define RUNPH(k, body) do { body; if (MK_REP == (k)) { xcd_barrier(bar); body; } } while (0)
__global__ void __launch_bounds__(NT, 2) mega_kernel(Params p) {
    extern __shared__ __attribute__((aligned(16))) unsigned char lds[];
    const int bid = blockIdx.x, nb = gridDim.x;
    if (threadIdx.x < 4) ((unsigned*)(lds + MK_ST_OFF))[threadIdx.x] = 0u;
    __syncthreads();
    XcdBarrier bar = xcd_barrier_post((unsigned*)(p.ws + WS_CTL + CTL_BAR), (volatile LAS unsigned*)(lds + MK_ST_OFF));
    RUNPH(0, phase0(p, lds, bid, nb));            xcd_barrier(bar);
    RUNPH(1, phase1a(p, bid, nb));                xcd_barrier(bar);
    RUNPH(2, phase1b(p, lds, bid, nb));           xcd_barrier(bar);
    RUNPH(3, phase2_s5(p, lds, bid, nb));
    RUNPH(4, phase2_fft(p, lds, bid, nb));        xcd_barrier(bar);
    RUNPH(5, phase3_glu(p, lds, bid, nb));        xcd_barrier(bar);
    RUNPH(6, phase3_fin(p, lds, bid, nb));        xcd_barrier(bar);
    phase4_out(p, lds, bid, nb);                  xcd_barrier(bar);
    phase5_route(p, lds, bid, nb);                xcd_barrier(bar);
    build_tiles(p, lds);
    RUNPH(10, phase6_gateup(p, lds, bid, nb));    xcd_barrier(bar);
    phase7_down(p, lds, bid, nb);                 xcd_barrier(bar);
    phase8_final(p, bid, nb);
}

extern "C" void kernel_launch(void* const* d_in, const int* in_sizes, int n_in, void* d_out, int out_size, void* d_ws, size_t ws_size, hipStream_t stream) {
    static int grid = 0;
    if (grid == 0) {
        if (n_in != 30 || ws_size < WS_END || out_size != NTOK * D) { fprintf(stderr, "kernel_launch: unexpected inputs (n_in %d, ws %zu, out %d)\n", n_in, ws_size, out_size); grid = -1; return; }
        int dev = 0, cus = 0, per_cu = 0;
        if (hipGetDevice(&dev) != hipSuccess || hipDeviceGetAttribute(&cus, hipDeviceAttributeMultiprocessorCount, dev) != hipSuccess) { grid = -1; return; }
        if (hipFuncSetAttribute((const void*)mega_kernel, hipFuncAttributeMaxDynamicSharedMemorySize, MK_LDS) != hipSuccess) { fprintf(stderr, "kernel_launch: hipFuncSetAttribute failed\n"); grid = -1; return; }
        if (hipOccupancyMaxActiveBlocksPerMultiprocessor(&per_cu, (const void*)mega_kernel, NT, MK_LDS) != hipSuccess || per_cu < 1) { fprintf(stderr, "kernel_launch: occupancy query says %d blocks/CU\n", per_cu); (void)hipGetLastError(); grid = -1; return; }
        grid = cus;
    }
    if (grid < 0) return;
    Params p{};
    const float** f = (const float**)&p;
    for (int i = 0; i < 30; ++i) f[i] = (const float*)d_in[i];
    p.out = (float*)d_out; p.ws = (unsigned char*)d_ws;
    (void)hipMemsetAsync((char*)d_ws + WS_CTL, 0, CTL_BYTES, stream);
    hipLaunchKernelGGL(mega_kernel, dim3(grid), dim3(NT), MK_LDS, stream, p);
}
```

```cpp
#include <hip/hip_runtime.h>
#include <cstdio>
#include <cstdint>

typedef unsigned short bf16;
typedef short bf16x8 __attribute__((ext_vector_type(8)));
typedef short bf16x4 __attribute__((ext_vector_type(4)));
typedef float f32x4 __attribute__((ext_vector_type(4)));
typedef unsigned u32x4 __attribute__((ext_vector_type(4)));
typedef unsigned u32x2 __attribute__((ext_vector_type(2)));
typedef __bf16 bf16v2 __attribute__((ext_vector_type(2)));
#define DI __device__ __forceinline__

constexpr int D = 1024, NB = 8, L = 4096, CTX = 256, NTOK = NB * L, NCTX = NB * CTX, NROWS1 = NTOK + NCTX;
constexpr int NEXP = 32, DE = 256;
constexpr float EPS = 1e-6f;
constexpr int NT = 512;

constexpr size_t MiB = 1u << 20;
constexpr size_t WS_CTL = 0;
constexpr size_t CTL_BYTES = 1 * MiB;
constexpr size_t CTL_ZERO = 4096;
constexpr size_t CTL_ECNT = 8192;
constexpr size_t CTL_PCNT = 8192 + 256;
constexpr size_t CTL_RSQ1 = 256 * 1024;
constexpr size_t CTL_RSQ2 = 384 * 1024;
constexpr size_t WS_MOD = 1 * MiB;
constexpr size_t WS_TILES = WS_MOD + 256 * 1024;
constexpr size_t WS_ABART = WS_TILES + 64 * 1024;
constexpr size_t WS_FFTC = 2 * MiB;
constexpr size_t WS_GW = 3 * MiB;
constexpr size_t WS_WINT = 4 * MiB;
constexpr size_t WS_WGLUT = 7 * MiB;
constexpr size_t WS_WOUTT = 8 * MiB;
constexpr size_t WS_WGUT = 10 * MiB;
constexpr size_t WS_WDT = 42 * MiB;
constexpr size_t WS_MG = 58 * MiB;
constexpr size_t WS_WST = 74 * MiB;
constexpr size_t WS_WOS = 82 * MiB;
constexpr size_t WS_ELIST = 90 * MiB;
constexpr size_t WS_ELCP = 94 * MiB;
constexpr size_t WS_ELW = 98 * MiB;
constexpr size_t WS_TCP = 102 * MiB;
constexpr size_t WS_R1 = 108 * MiB;
constexpr size_t WS_R2 = 176 * MiB;
constexpr size_t WS_R3 = 240 * MiB;
constexpr size_t WS_R4 = 274 * MiB;
constexpr size_t WS_R5 = 306 * MiB;
constexpr size_t WS_RSQP1 = 338 * MiB;
constexpr size_t WS_RSQP2 = 340 * MiB;
constexpr size_t WS_WRT = 342 * MiB;
constexpr size_t WS_END = 343 * MiB;

struct Params {
    const float *x, *c, *ctx, *c_ctx, *w_ada, *b_ada, *norm1_g, *norm2_g, *w_in;
    const float *lam_re, *lam_im, *b_re, *b_im, *c_re, *c_im, *log_step, *s5_d, *w_glu, *fourier_w, *g_s, *g_f, *w_out;
    const float *w_group, *b_group, *w_router, *b_router, *w_gate, *w_up, *w_down, *final_g;
    float* out; unsigned char* ws;
};

DI int tidx() { int t = threadIdx.x; asm volatile("" : "+v"(t)); return t; }
DI unsigned pk2(float lo, float hi) { bf16v2 v; v.x = (__bf16)lo; v.y = (__bf16)hi; return __builtin_bit_cast(unsigned, v); }
DI float bf2f(unsigned short b) { return __uint_as_float(((unsigned)b) << 16); }
DI float wave_sum(float v) {
#pragma unroll
    for (int o = 1; o < 64; o <<= 1) v += __shfl_xor(v, o);
    return v;
}
DI float sigmoidf_(float x) { return 1.f / (1.f + __expf(-x)); }
DI float siluf_(float x) { return x / (1.f + __expf(-x)); }
DI float geluf_(float x) { const float u = 0.7978845608028654f * (x + 0.044715f * x * x * x); return x / (1.f + __expf(-2.f * u)); }

template <int MT> struct GC {
    static constexpr int BM = 64 * MT, PA = MT, ABYTES = BM * 128, BBYTES = 128 * 128, BUF = ABYTES + BBYTES, LDS = 2 * BUF;
};
template <int MT>
DI void gemm_loop(f32x4 (&acc)[MT][4], const bf16* (&ap)[MT], const int (&as)[MT], const bf16* (&bp)[2], int nk, unsigned char* lds) {
    typedef GC<MT> G;
    const int tid = tidx(), lane = tid & 63, wid = tid >> 6, wm = wid >> 1, wn = wid & 1, fr = lane & 15, fq = lane >> 4;
    const int srow = tid >> 3, sck = tid & 7;
    const int soff = srow * 128 + ((sck ^ (srow & 7)) << 4);
    u32x4 ra[MT], rb[2];
#pragma unroll
    for (int i = 0; i < MT; ++i) ra[i] = *(const u32x4*)(ap[i]);
#pragma unroll
    for (int i = 0; i < 2; ++i) rb[i] = *(const u32x4*)(bp[i]);
#pragma unroll
    for (int i = 0; i < MT; ++i) *(u32x4*)(lds + i * 8192 + soff) = ra[i];
#pragma unroll
    for (int i = 0; i < 2; ++i) *(u32x4*)(lds + G::ABYTES + i * 8192 + soff) = rb[i];
    __syncthreads();
    const int aro = (wm * MT * 16 + fr) * 128, bro = (wn * 64 + fr) * 128;
    const int sw0 = ((0 + fq) ^ (fr & 7)) << 4, sw1 = ((4 + fq) ^ (fr & 7)) << 4;
    for (int kt = 0; kt < nk; ++kt) {
        const bool more = kt + 1 < nk;
        if (more) {
#pragma unroll
            for (int i = 0; i < MT; ++i) ra[i] = *(const u32x4*)(ap[i] + (size_t)(kt + 1) * as[i]);
#pragma unroll
            for (int i = 0; i < 2; ++i) rb[i] = *(const u32x4*)(bp[i] + (size_t)(kt + 1) * 64);
        }
        const unsigned char* Ab = lds + (kt & 1) * G::BUF; const unsigned char* Bb = Ab + G::ABYTES;
#pragma unroll
        for (int kk = 0; kk < 2; ++kk) {
            const int sw = kk ? sw1 : sw0;
            bf16x8 af[MT], bfr[4];
#pragma unroll
            for (int mt = 0; mt < MT; ++mt) af[mt] = *(const bf16x8*)(Ab + aro + mt * 2048 + sw);
#pragma unroll
            for (int nt = 0; nt < 4; ++nt) bfr[nt] = *(const bf16x8*)(Bb + bro + nt * 2048 + sw);
#pragma unroll
            for (int mt = 0; mt < MT; ++mt)
#pragma unroll
                for (int nt = 0; nt < 4; ++nt) acc[mt][nt] = __builtin_amdgcn_mfma_f32_16x16x32_bf16(bfr[nt], af[mt], acc[mt][nt], 0, 0, 0);
        }
        if (more) {
            unsigned char* nb = lds + ((kt + 1) & 1) * G::BUF;
#pragma unroll
            for (int i = 0; i < MT; ++i) *(u32x4*)(nb + i * 8192 + soff) = ra[i];
#pragma unroll
            for (int i = 0; i < 2; ++i) *(u32x4*)(nb + G::ABYTES + i * 8192 + soff) = rb[i];
        }
        __syncthreads();
    }
}
template <int MT>
DI void gemm_loop_alds(f32x4 (&acc)[MT][4], const unsigned char* abase, int apitch, const bf16* (&bp)[2], int nk, unsigned char* lds) {
    typedef GC<MT> G;
    const int tid = tidx(), lane = tid & 63, wid = tid >> 6, wm = wid >> 1, wn = wid & 1, fr = lane & 15, fq = lane >> 4;
    const int srow = tid >> 3, sck = tid & 7;
    const int soff = srow * 128 + ((sck ^ (srow & 7)) << 4);
    u32x4 rb[2];
#pragma unroll
    for (int i = 0; i < 2; ++i) rb[i] = *(const u32x4*)(bp[i]);
#pragma unroll
    for (int i = 0; i < 2; ++i) *(u32x4*)(lds + G::ABYTES + i * 8192 + soff) = rb[i];
    __syncthreads();
    const int bro = (wn * 64 + fr) * 128;
    const int sw0 = ((0 + fq) ^ (fr & 7)) << 4, sw1 = ((4 + fq) ^ (fr & 7)) << 4;
    const unsigned char* arow = abase + (size_t)(wm * MT * 16 + fr) * apitch + fq * 16;
    for (int kt = 0; kt < nk; ++kt) {
        const bool more = kt + 1 < nk;
        if (more) {
#pragma unroll
            for (int i = 0; i < 2; ++i) rb[i] = *(const u32x4*)(bp[i] + (size_t)(kt + 1) * 64);
        }
        const unsigned char* Bb = lds + (kt & 1) * G::BUF + G::ABYTES;
#pragma unroll
        for (int kk = 0; kk < 2; ++kk) {
            const int sw = kk ? sw1 : sw0;
            bf16x8 af[MT], bfr[4];
#pragma unroll
            for (int mt = 0; mt < MT; ++mt) af[mt] = *(const bf16x8*)(arow + (size_t)mt * 16 * apitch + kt * 128 + kk * 64);
#pragma unroll
            for (int nt = 0; nt < 4; ++nt) bfr[nt] = *(const bf16x8*)(Bb + bro + nt * 2048 + sw);
#pragma unroll
            for (int mt = 0; mt < MT; ++mt)
#pragma unroll
                for (int nt = 0; nt < 4; ++nt) acc[mt][nt] = __builtin_amdgcn_mfma_f32_16x16x32_bf16(bfr[nt], af[mt], acc[mt][nt], 0, 0, 0);
        }
        if (more) {
            unsigned char* nb = lds + ((kt + 1) & 1) * G::BUF;
#pragma unroll
            for (int i = 0; i < 2; ++i) *(u32x4*)(nb + G::ABYTES + i * 8192 + soff) = rb[i];
        }
        __syncthreads();
    }
}
template <int MT> DI void zero_acc(f32x4 (&acc)[MT][4]) {
#pragma unroll
    for (int m = 0; m < MT; ++m)
#pragma unroll
        for (int n = 0; n < 4; ++n) acc[m][n] = (f32x4){0.f, 0.f, 0.f, 0.f};
}

namespace pg8 {
#define PG8_LAS __attribute__((address_space(3)))
constexpr int BM = 256, BK = 64, HALF = 128, HTB = HALF * BK * 2, STAGE_BYTES = 8 * HTB;
DI int lds_byte(int r, int c) { const int st = (r >> 4) * 2 + (c >> 5), rr = r & 15, cc = c & 31, ob = rr * 64 + cc * 2; return st * 1024 + (ob ^ (((ob >> 9) & 1) << 5)); }
DI void stage_rc(int b, int& R, int& C) { const int st = b / 1024, sb = b % 1024, swz = sb ^ (((sb >> 9) & 1) << 5); R = (st >> 1) * 16 + swz / 64; C = (st & 1) * 32 + (swz % 64) / 2; }
struct UPtr { const char *a0, *a1, *b0, *b1, *c0, *c1; };
template <class Pol, class Epi, bool ALIGN_EPI>
DI void gemm_phase(PG8_LAS unsigned char* lds, const Pol& P, const Epi& E) {
    typedef typename Pol::Unit Unit;
    const int tid = tidx(), wid = __builtin_amdgcn_readfirstlane(tid >> 6), lane = tid & 63, wr = wid >> 2, wc = wid & 3, fr = lane & 15, fq = lane >> 4;
    const int nt = P.K / BK, ksplit = P.ksplit;
    constexpr int NG = Pol::GATHER ? 2 : 1;
    int Rr[2], Cc[2]; unsigned voffB[2]; unsigned vAc[NG][2], vAn[NG][2];
#pragma unroll
    for (int i = 0; i < 2; ++i) { stage_rc(tid * 16 + i * 8192, Rr[i], Cc[i]); voffB[i] = (unsigned)(P.brow(Rr[i]) * P.ldb + Cc[i]) * 2u;
#pragma unroll
        for (int h = 0; h < NG; ++h) vAc[h][i] = vAn[h][i] = (unsigned)(Rr[i] * P.lda + Cc[i]) * 2u; }
#define PG8_VC(h) vAc[Pol::GATHER ? (h) : 0]
#define PG8_V2(h) v2[Pol::GATHER ? (h) : 0]
    const size_t kstep = (size_t)(BK * 2);
    const unsigned ldsw = (unsigned)wid * 1024u;
    const int aoff = lds_byte(wr * 64 + fr, fq * 8), boff = lds_byte(wc * 32 + fr, fq * 8);
#define PG8_SA(b, h) (((b) * 2 + (h)) * HTB)
#define PG8_SB(b, h) ((4 + (b) * 2 + (h)) * HTB)
#define PG8_STAGE(bufoff, gbase, voff) do { _Pragma("unroll") for (int _i = 0; _i < 2; ++_i) \
        __builtin_amdgcn_global_load_lds((const unsigned*)((const char*)(gbase) + (voff)[_i]), (PG8_LAS unsigned*)(lds + (bufoff) + ldsw + _i * 8192), 16, 0, 0); } while (0)
#define PG8_LDA(dst, b, h) do { _Pragma("unroll") for (int m = 0; m < 4; ++m) _Pragma("unroll") for (int k = 0; k < 2; ++k) dst[m][k] = *(const PG8_LAS bf16x8*)(lds + PG8_SA(b, h) + aoff + m * 2048 + k * 1024); } while (0)
#define PG8_LDB(dst, b, h) do { _Pragma("unroll") for (int n = 0; n < 2; ++n) _Pragma("unroll") for (int k = 0; k < 2; ++k) dst[n][k] = *(const PG8_LAS bf16x8*)(lds + PG8_SB(b, h) + boff + n * 2048 + k * 1024); } while (0)
#define PG8_MMA(ai, bj, At, Bt) do { __builtin_amdgcn_s_setprio(1); _Pragma("unroll") for (int m = 0; m < 4; ++m) _Pragma("unroll") for (int n = 0; n < 2; ++n) _Pragma("unroll") for (int k = 0; k < 2; ++k) \
        acc[ai][bj][m][n] = __builtin_amdgcn_mfma_f32_16x16x32_bf16(Bt[n][k], At[m][k], acc[ai][bj][m][n], 0, 0, 0); __builtin_amdgcn_s_setprio(0); } while (0)
#define PG8_WAIT_V(n) asm volatile("s_waitcnt vmcnt(" #n ")" ::: "memory")
#define PG8_WAIT_L(n) asm volatile("s_waitcnt lgkmcnt(" #n ")" ::: "memory")
#define PG8_BAR __builtin_amdgcn_s_barrier()
#define PG8_SCHED __builtin_amdgcn_sched_barrier(0)
#define PG8_BSEL(q, tk, h) ((tk) < ksplit ? (q).b##h + (size_t)(tk) * kstep : (q).c##h + (size_t)((tk) - ksplit) * kstep)
    Unit cur, nxt; UPtr cp, np_; int ui = 0;
    if (!P.next(0, cur)) return;
    P.ptrs(cur, cp);
    if constexpr (Pol::GATHER) P.gather(cur, Rr, Cc, vAc);
    f32x4 acc[2][2][4][2];
#pragma unroll
    for (int a = 0; a < 2; ++a)
#pragma unroll
        for (int b = 0; b < 2; ++b)
#pragma unroll
            for (int m = 0; m < 4; ++m)
#pragma unroll
                for (int n = 0; n < 2; ++n) acc[a][b][m][n] = (f32x4){0.f, 0.f, 0.f, 0.f};
    bf16x8 At[4][2], B0[2][2], B1[2][2];
    PG8_STAGE(PG8_SB(0, 0), cp.b0, voffB); PG8_STAGE(PG8_SB(0, 1), cp.b1, voffB); PG8_STAGE(PG8_SA(0, 0), cp.a0, PG8_VC(0)); PG8_STAGE(PG8_SA(0, 1), cp.a1, PG8_VC(1));
    if (wr == 1) PG8_BAR;
    PG8_WAIT_V(2); PG8_BAR;
    PG8_STAGE(PG8_SB(1, 0), cp.b0 + kstep, voffB); PG8_STAGE(PG8_SA(1, 0), cp.a0 + kstep, PG8_VC(0)); PG8_STAGE(PG8_SB(1, 1), cp.b1 + kstep, voffB);
    PG8_WAIT_V(6); PG8_BAR;
    for (;;) {
        const bool has_next = P.next(ui + 1, nxt);
        if (has_next) { P.ptrs(nxt, np_); if constexpr (Pol::GATHER) P.gather(nxt, Rr, Cc, vAn); }
        else { np_ = cp; if constexpr (Pol::GATHER) {
#pragma unroll
            for (int h = 0; h < 2; ++h)
#pragma unroll
                for (int i = 0; i < 2; ++i) vAn[h][i] = vAc[h][i]; } }
#pragma unroll 1
        for (int t = 0; t < nt; t += 2) {
            const bool last = (t == nt - 2);
            const char* a1_1 = cp.a1 + (size_t)(t + 1) * kstep;
            const char *a2_0, *a2_1, *a3_0, *b2_0, *b2_1, *b3_0, *b3_1;
            unsigned v2[NG][2];
            if (!last) { a2_0 = cp.a0 + (size_t)(t + 2) * kstep; a2_1 = cp.a1 + (size_t)(t + 2) * kstep; a3_0 = cp.a0 + (size_t)(t + 3) * kstep;
                         b2_0 = PG8_BSEL(cp, t + 2, 0); b2_1 = PG8_BSEL(cp, t + 2, 1); b3_0 = PG8_BSEL(cp, t + 3, 0); b3_1 = PG8_BSEL(cp, t + 3, 1); }
            else { a2_0 = np_.a0; a2_1 = np_.a1; a3_0 = np_.a0 + kstep; b2_0 = np_.b0; b2_1 = np_.b1; b3_0 = np_.b0 + kstep; b3_1 = np_.b1 + kstep; }
#pragma unroll
            for (int h = 0; h < NG; ++h)
#pragma unroll
                for (int i = 0; i < 2; ++i) v2[h][i] = (Pol::GATHER && last) ? vAn[h][i] : vAc[h][i];
            PG8_LDB(B0, 0, 0); PG8_LDB(B1, 0, 1); PG8_SCHED; PG8_LDA(At, 0, 0); PG8_STAGE(PG8_SA(1, 1), a1_1, PG8_VC(1));
            PG8_WAIT_V(8); PG8_WAIT_L(0); PG8_BAR; PG8_MMA(0, 0, At, B0); PG8_MMA(0, 1, At, B1); PG8_BAR; PG8_SCHED;
            PG8_LDA(At, 0, 1); PG8_STAGE(PG8_SB(0, 0), b2_0, voffB); PG8_STAGE(PG8_SB(0, 1), b2_1, voffB); PG8_STAGE(PG8_SA(0, 0), a2_0, PG8_V2(0));
            PG8_WAIT_V(8); PG8_WAIT_L(0); PG8_BAR; PG8_MMA(1, 0, At, B0); PG8_MMA(1, 1, At, B1); PG8_BAR; PG8_SCHED;
            PG8_LDB(B0, 1, 0); PG8_LDB(B1, 1, 1); PG8_SCHED; PG8_LDA(At, 1, 0); PG8_STAGE(PG8_SA(0, 1), a2_1, PG8_V2(1));
            PG8_WAIT_V(8); PG8_WAIT_L(0); PG8_BAR; PG8_MMA(0, 0, At, B0); PG8_MMA(0, 1, At, B1); PG8_BAR; PG8_SCHED;
            PG8_LDA(At, 1, 1); PG8_STAGE(PG8_SB(1, 0), b3_0, voffB); PG8_STAGE(PG8_SB(1, 1), b3_1, voffB); PG8_STAGE(PG8_SA(1, 0), a3_0, PG8_V2(0));
            PG8_WAIT_V(8); PG8_WAIT_L(0); PG8_BAR; PG8_MMA(1, 0, At, B0); PG8_MMA(1, 1, At, B1); PG8_BAR; PG8_SCHED;
        }
        if constexpr (ALIGN_EPI) { if (wr == 0) PG8_BAR; }
        E(acc, cur, wr, wc, fr, fq);
        if (!has_next) break;
#pragma unroll
        for (int a = 0; a < 2; ++a)
#pragma unroll
            for (int b = 0; b < 2; ++b)
#pragma unroll
                for (int m = 0; m < 4; ++m)
#pragma unroll
                    for (int n = 0; n < 2; ++n) acc[a][b][m][n] = (f32x4){0.f, 0.f, 0.f, 0.f};
        cur = nxt; cp = np_; ++ui;
        if constexpr (Pol::GATHER) {
#pragma unroll
            for (int h = 0; h < 2; ++h)
#pragma unroll
                for (int i = 0; i < 2; ++i) vAc[h][i] = vAn[h][i]; }
        if constexpr (ALIGN_EPI) { if (wr == 1) PG8_BAR; }
    }
    PG8_WAIT_V(0);
    if constexpr (!ALIGN_EPI) { if (wr == 0) PG8_BAR; }
    PG8_BAR;
#undef PG8_SA
#undef PG8_SB
#undef PG8_STAGE
#undef PG8_LDA
#undef PG8_LDB
#undef PG8_MMA
#undef PG8_WAIT_V
#undef PG8_WAIT_L
#undef PG8_BAR
#undef PG8_SCHED
#undef PG8_BSEL
#undef PG8_VC
#undef PG8_V2
}
struct DenseOrder {
    int nM, nN, nwg, G, c;
    DI void init(int nM_, int nN_, int G_, int c_) { nM = nM_; nN = nN_; nwg = nM * nN; G = G_; c = c_; }
    DI bool get(int i, int& pm, int& pn) const {
        const long L = (long)i * G + c; if (L >= nwg) return false;
        int wgid = (int)L; { const int q = nwg / 8, r = nwg % 8, xcd = wgid % 8, off = wgid / 8; wgid = (xcd < r ? xcd * (q + 1) : r * (q + 1) + (xcd - r) * q) + off; }
        const int nig = 8 * nN, gid = wgid / nig, fm = gid * 8, gsz = (nM - fm) < 8 ? (nM - fm) : 8;
        pm = fm + ((wgid % nig) % gsz); pn = (wgid % nig) / gsz; return true;
    }
};
}

DI void adaln_item(const Params& p, unsigned char* lds, int item) {
    float* scond = (float*)lds;
    float* red = scond + 9 * 1024;
    const int tid = tidx();
    for (int i = tid; i < 9 * 1024; i += NT) { const int r = i >> 10, k = i & 1023; const float v = r < 8 ? p.c[r * 1024 + k] : p.c_ctx[k]; scond[i] = v / (1.f + __expf(-v)); }
    __syncthreads();
    const int cc = tid & 63, ks = tid >> 6, col = item * 64 + cc;
    float a[9];
#pragma unroll
    for (int r = 0; r < 9; ++r) a[r] = 0.f;
#pragma unroll 1
    for (int kb = 0; kb < 8; ++kb) {
        const int kbase = ks * 128 + kb * 16; float w[16];
#pragma unroll
        for (int u = 0; u < 16; ++u) w[u] = p.w_ada[(size_t)(kbase + u) * 6144 + col];
#pragma unroll
        for (int u = 0; u < 16; ++u)
#pragma unroll
            for (int r = 0; r < 9; ++r) a[r] += scond[r * 1024 + kbase + u] * w[u];
    }
#pragma unroll
    for (int r = 0; r < 9; ++r) red[(ks * 9 + r) * 64 + cc] = a[r];
    __syncthreads();
    float* mod = (float*)(p.ws + WS_MOD);
    for (int o = tid; o < 9 * 64; o += NT) { const int r = o >> 6, c2 = o & 63; float s = 0.f;
#pragma unroll
        for (int q = 0; q < 8; ++q) s += red[(q * 9 + r) * 64 + c2];
        mod[r * 6144 + item * 64 + c2] = s + p.b_ada[item * 64 + c2]; }
    __syncthreads();
}
DI void tp_tile(const float* src, int ld, int k0, int n0, unsigned char* lds, bf16* dst, int jobkind, int e) {
    const int lane = tidx() & 63, wid = tidx() >> 6;
    float* tile = (float*)lds + wid * (64 * 65);
    { float v[64];
#pragma unroll
      for (int kk = 0; kk < 64; ++kk) v[kk] = src[(size_t)(k0 + kk) * ld + n0 + lane];
#pragma unroll
      for (int kk = 0; kk < 64; ++kk) tile[kk * 65 + lane] = v[kk]; }
    asm volatile("s_waitcnt lgkmcnt(0)" ::: "memory");
    const int kc = lane & 7;
#pragma unroll
    for (int j = 0; j < 8; ++j) { const int n = (lane >> 3) + 8 * j, ng = n0 + n;
      u32x4 o;
      o.x = pk2(tile[(kc * 8 + 0) * 65 + n], tile[(kc * 8 + 1) * 65 + n]); o.y = pk2(tile[(kc * 8 + 2) * 65 + n], tile[(kc * 8 + 3) * 65 + n]);
      o.z = pk2(tile[(kc * 8 + 4) * 65 + n], tile[(kc * 8 + 5) * 65 + n]); o.w = pk2(tile[(kc * 8 + 6) * 65 + n], tile[(kc * 8 + 7) * 65 + n]);
      size_t drow; int K;
      switch (jobkind) {
        case 0: drow = ng; K = 1024; break;
        case 1: drow = ng; K = 512; break;
        case 2: drow = ng; K = 1024; break;
        case 3: case 4: { const int h = ng, R = (h >> 7) * 256 + (jobkind == 4 ? 128 : 0) + (h & 127); drow = (size_t)e * 512 + R; K = 1024; } break;
        default: drow = (size_t)e * 1024 + ng; K = 256; break;
      }
      *(u32x4*)(dst + drow * K + k0 + kc * 8) = o; }
    asm volatile("s_waitcnt lgkmcnt(0)" ::: "memory");
}
constexpr int TP_J0 = 16 * 8, TP_J1 = 8 * 8, TP_J2 = 16 * 16, TP_J3 = 32 * 16 * 4, TP_J4 = TP_J3, TP_J5 = 32 * 4 * 16;
constexpr int TP_ITEMS = TP_J0 + TP_J1 + TP_J2 + TP_J3 + TP_J4 + TP_J5;
DI void tp_item(const Params& p, unsigned char* lds, int it) {
    unsigned char* ws = p.ws;
    if (it < TP_J0) { tp_tile(p.w_in, 1024, (it >> 3) * 64, (it & 7) * 64, lds, (bf16*)(ws + WS_WINT), 0, 0); return; } it -= TP_J0;
    if (it < TP_J1) { tp_tile(p.w_glu, 512, (it >> 3) * 64, (it & 7) * 64, lds, (bf16*)(ws + WS_WGLUT), 1, 0); return; } it -= TP_J1;
    if (it < TP_J2) { tp_tile(p.w_out, 1024, (it >> 4) * 64, (it & 15) * 64, lds, (bf16*)(ws + WS_WOUTT), 2, 0); return; } it -= TP_J2;
    if (it < TP_J3) { const int e = it >> 6, r = it & 63; tp_tile(p.w_gate + (size_t)e * 1024 * 256, 256, (r >> 2) * 64, (r & 3) * 64, lds, (bf16*)(ws + WS_WGUT), 3, e); return; } it -= TP_J3;
    if (it < TP_J4) { const int e = it >> 6, r = it & 63; tp_tile(p.w_up + (size_t)e * 1024 * 256, 256, (r >> 2) * 64, (r & 3) * 64, lds, (bf16*)(ws + WS_WGUT), 4, e); return; } it -= TP_J4;
    { const int e = it >> 6, r = it & 63; tp_tile(p.w_down + (size_t)e * 256 * 1024, 1024, (r >> 4) * 64, (r & 15) * 64, lds, (bf16*)(ws + WS_WDT), 5, e); }
}
DI void gfold_item(const Params& p, unsigned char* lds, int item) {
    const int q = item >> 6, k0 = (item & 63) * 16, tid = tidx();
    float* wv = (float*)lds;
    float* T = wv + 16 * 128;
    float* fw = T + 16 * 2 * 128;
    float* cs = fw + 128 * 128;
    float* sn = cs + 128;
    for (int i = tid; i < 16 * 128; i += NT) wv[i] = p.w_in[(size_t)(k0 + (i >> 7)) * 1024 + 512 + 128 * q + (i & 127)];
    for (int i = tid; i < 128 * 128; i += NT) fw[i] = p.fourier_w[(size_t)q * 128 * 128 + i];
    if (tid < 128) { double s, c; sincospi((double)tid / 64.0, &s, &c); cs[tid] = (float)c; sn[tid] = (float)s; }
    __syncthreads();
    for (int o = tid; o < 16 * 128; o += NT) { const int r = o >> 7, n = o & 127; float sr = 0.f, si = 0.f;
        for (int m = 0; m < 128; ++m) { const float w = wv[r * 128 + m]; const int ix = (n * m) & 127; sr += w * cs[ix]; si -= w * sn[ix]; }
        T[(r * 2 + 0) * 128 + n] = sr; T[(r * 2 + 1) * 128 + n] = si; }
    __syncthreads();
    bf16* WinT = (bf16*)(p.ws + WS_WINT);
    const float scale = 1.0f / 724.0773439350247f;
    for (int o = tid; o < 16 * 2 * 128; o += NT) { const int r = o & 15, c = (o >> 4) & 1, j = o >> 5; float s = 0.f;
        for (int n = 0; n < 128; ++n) s += T[(r * 2 + c) * 128 + n] * fw[n * 128 + j];
        WinT[(size_t)(512 + c * 512 + q * 128 + j) * 1024 + k0 + r] = (bf16)(pk2(s * scale, 0.f) & 0xffffu); }
    __syncthreads();
}
DI void s5mats_item(const Params& p, unsigned char* lds, int item) {
    const int g = item >> 2, part = item & 3;
    const int tid = tidx();
    float* Bb = (float*)lds;
    float* Cc = Bb + 4096;
    float* pw = Cc + 4096;
    float* Kt = pw + 8448;
    for (int idx = tid; idx < 2 * 64 * 33; idx += NT) { const int d = idx / (64 * 33), rem = idx % (64 * 33), pp = rem / 33, k = rem % 33;
        const double dt = exp((double)p.log_step[d * 32 + g]); const double lr = p.lam_re[(d * 32 + g) * 64 + pp], li = p.lam_im[(d * 32 + g) * 64 + pp];
        const double mag = exp(lr * dt * k); double tt = li * dt * k / 3.14159265358979323846; tt -= 2.0 * floor(tt * 0.5);
        double s, c; sincospi(tt, &s, &c); pw[idx * 2] = (float)(mag * c); pw[idx * 2 + 1] = (float)(mag * s); }
    for (int idx = tid; idx < 2 * 64 * 16; idx += NT) { const int d = idx >> 10, pp = (idx >> 4) & 63, h = idx & 15;
        const double dt = exp((double)p.log_step[d * 32 + g]); const double lr = p.lam_re[(d * 32 + g) * 64 + pp], li = p.lam_im[(d * 32 + g) * 64 + pp];
        const double mag = exp(lr * dt); double tt = li * dt / 3.14159265358979323846; tt -= 2.0 * floor(tt * 0.5);
        double s, c; sincospi(tt, &s, &c); const double nr = mag * c - 1.0, ni = mag * s, den = lr * lr + li * li;
        const double qr = (nr * lr + ni * li) / den, qi = (ni * lr - nr * li) / den;
        const double br = p.b_re[((size_t)(d * 32 + g) * 64 + pp) * 16 + h], bi = p.b_im[((size_t)(d * 32 + g) * 64 + pp) * 16 + h];
        Bb[idx * 2] = (float)(qr * br - qi * bi); Bb[idx * 2 + 1] = (float)(qr * bi + qi * br); }
    for (int idx = tid; idx < 2 * 16 * 64; idx += NT) { const int d = idx >> 10, i = (idx >> 6) & 15, pp = idx & 63;
        Cc[idx * 2] = p.c_re[((size_t)(d * 32 + g) * 16 + i) * 64 + pp]; Cc[idx * 2 + 1] = p.c_im[((size_t)(d * 32 + g) * 16 + i) * 64 + pp]; }
    __syncthreads();
    for (int id4 = tid; id4 < 4096; id4 += NT) { const int d = id4 >> 11, k = (id4 >> 6) & 31, i = part * 4 + ((id4 >> 4) & 3), h = id4 & 15; const int idx = ((d * 32 + k) * 16 + i) * 16 + h; float s = 0.f;
        for (int pp = 0; pp < 64; ++pp) { const float cr = Cc[((d * 16 + i) * 64 + pp) * 2], ci = Cc[((d * 16 + i) * 64 + pp) * 2 + 1];
            const float wr = pw[((d * 64 + pp) * 33 + k) * 2], wi = pw[((d * 64 + pp) * 33 + k) * 2 + 1];
            const float xr = cr * wr - ci * wi, xi = cr * wi + ci * wr;
            s += xr * Bb[((d * 64 + pp) * 16 + h) * 2] - xi * Bb[((d * 64 + pp) * 16 + h) * 2 + 1]; }
        Kt[idx] = s; }
    __syncthreads();
    bf16* Mg = (bf16*)(p.ws + WS_MG) + (size_t)g * 512 * 512;
    for (int c4 = tid; c4 < 128 * 64; c4 += NT) { const int rq = c4 >> 6, c8 = c4 & 63, j = rq >> 2, i = part * 4 + (rq & 3), row = j * 16 + i, s = c8 >> 1, h0 = (c8 & 1) * 8; float v[8];
#pragma unroll
        for (int t = 0; t < 8; ++t) { float a = 0.f; if (s <= j) a += Kt[((0 * 32 + (j - s)) * 16 + i) * 16 + h0 + t]; if (s >= j) a += Kt[((1 * 32 + (s - j)) * 16 + i) * 16 + h0 + t]; v[t] = a; }
        u32x4 o; o.x = pk2(v[0], v[1]); o.y = pk2(v[2], v[3]); o.z = pk2(v[4], v[5]); o.w = pk2(v[6], v[7]);
        *(u32x4*)(Mg + (size_t)row * 512 + c8 * 8) = o; }
    bf16* Wst = (bf16*)(p.ws + WS_WST) + (size_t)g * 256 * 512;
    for (int c4 = tid; c4 < 64 * 64; c4 += NT) { const int r = part * 64 + (c4 >> 6), c8 = c4 & 63, s = c8 >> 1, h0 = (c8 & 1) * 8, d = r >> 7, c = (r >> 6) & 1, pp = r & 63;
        const int e = d == 0 ? 31 - s : s; const float wr = pw[((d * 64 + pp) * 33 + e) * 2], wi = pw[((d * 64 + pp) * 33 + e) * 2 + 1]; float v[8];
#pragma unroll
        for (int t = 0; t < 8; ++t) { const float br = Bb[((d * 64 + pp) * 16 + h0 + t) * 2], bi = Bb[((d * 64 + pp) * 16 + h0 + t) * 2 + 1]; v[t] = c == 0 ? wr * br - wi * bi : wr * bi + wi * br; }
        u32x4 o; o.x = pk2(v[0], v[1]); o.y = pk2(v[2], v[3]); o.z = pk2(v[4], v[5]); o.w = pk2(v[6], v[7]);
        *(u32x4*)(Wst + (size_t)r * 512 + c8 * 8) = o; }
    bf16* Wos = (bf16*)(p.ws + WS_WOS) + (size_t)g * 512 * 256;
    for (int c4 = tid; c4 < 128 * 32; c4 += NT) { const int rq = c4 >> 5, c8 = c4 & 31, j = rq >> 2, i = part * 4 + (rq & 3), row = j * 16 + i, col0 = c8 * 8, d = col0 >> 7, c = (col0 >> 6) & 1, p0 = col0 & 63;
        const int e = d == 0 ? j + 1 : 32 - j; float v[8];
#pragma unroll
        for (int t = 0; t < 8; ++t) { const int pp = p0 + t; const float cr = Cc[((d * 16 + i) * 64 + pp) * 2], ci = Cc[((d * 16 + i) * 64 + pp) * 2 + 1];
            const float wr = pw[((d * 64 + pp) * 33 + e) * 2], wi = pw[((d * 64 + pp) * 33 + e) * 2 + 1]; v[t] = c == 0 ? cr * wr - ci * wi : -(cr * wi + ci * wr); }
        u32x4 o; o.x = pk2(v[0], v[1]); o.y = pk2(v[2], v[3]); o.z = pk2(v[4], v[5]); o.w = pk2(v[6], v[7]);
        *(u32x4*)(Wos + (size_t)row * 256 + c8 * 8) = o; }
    float* aT = (float*)(p.ws + WS_ABART) + g * 256;
    if (part == 0 && tid < 128) { const int d = tid >> 6, pp = tid & 63; aT[tid * 2] = pw[((d * 64 + pp) * 33 + 32) * 2]; aT[tid * 2 + 1] = pw[((d * 64 + pp) * 33 + 32) * 2 + 1]; }
    __syncthreads();
}
DI void fftc_item(const Params& p, int item) {
    const int tid = tidx();
    bf16* W1 = (bf16*)(p.ws + WS_FFTC);
    bf16* W2 = W1 + 128 * 128;
    float* tw = (float*)(p.ws + WS_FFTC + 32768 + 16384);
    for (int idx = item * NT + tid; idx < 128 * 128 + 4 * 64 * 32 + 4096; idx += 8 * NT) {
        if (idx < 16384) { const int n = idx >> 7, k = idx & 127, co = n >> 6, d = n & 63, ci = k >> 6, bq = k & 63; double s, c; sincospi((double)((d * bq) & 63) / 32.0, &s, &c);
            const float v = (ci == co) ? (float)c : (ci == 1 ? (float)s : (float)(-s)); W1[idx] = (bf16)(pk2(v, 0.f) & 0xffffu); }
        else if (idx < 16384 + 8192) { const int i2 = idx - 16384, s_ = i2 >> 11, cf = (i2 >> 5) & 63, slot = i2 & 31, gq = slot >> 3, jp = slot & 7;
            const int a = 16 * (2 * (s_ & 1) + (jp >> 2)) + 4 * gq + (jp & 3); double s, c; sincospi((double)((cf * a) & 63) / 32.0, &s, &c);
            W2[i2] = (bf16)(pk2((s_ >> 1) == 0 ? (float)c : (float)s, 0.f) & 0xffffu); }
        else { const int i3 = idx - 16384 - 8192; double s, c; sincospi((double)i3 / 2048.0, &s, &c); tw[i3 * 2] = (float)c; tw[i3 * 2 + 1] = (float)s; }
    }
}
constexpr int P0_S5 = 128, P0_GF = 256, P0_ADA = 96, P0_FC = 8, P0_RW = 1;
constexpr int P0_ITEMS = P0_S5 + P0_GF + P0_ADA + P0_FC + P0_RW;
DI void rw_item(const Params& p) {
    bf16* W = (bf16*)(p.ws + WS_WRT);
    for (int i = tidx(); i < 48 * 1024; i += NT) { const int n = i >> 10, k = i & 1023; const float v = n < 4 ? p.w_group[k * 4 + n] : (n < 36 ? p.w_router[k * 32 + (n - 4)] : 0.f); W[i] = (bf16)(pk2(v, 0.f) & 0xffffu); }
}
DI void phase0(const Params& p, unsigned char* lds, int bid, int nb) {
    for (int it = bid; it < P0_ITEMS; it += nb) {
        int r = it;
        if (r < P0_S5) { s5mats_item(p, lds, r); continue; } r -= P0_S5;
        if (r < P0_GF) { gfold_item(p, lds, r); continue; } r -= P0_GF;
        if (r < P0_ADA) { adaln_item(p, lds, r); continue; } r -= P0_ADA;
        if (r < P0_FC) { fftc_item(p, r); continue; } r -= P0_FC;
        rw_item(p);
    }
    __syncthreads();
    const int wid = tidx() >> 6;
    for (int it = bid * 8 + wid; it < TP_ITEMS; it += nb * 8) tp_item(p, lds, it);
}

DI void phase1a(const Params& p, int bid, int nb) {
    const int lane = tidx() & 63, wave = tidx() >> 6;
    const float* mod = (const float*)(p.ws + WS_MOD);
    bf16* A1 = (bf16*)(p.ws + WS_R1);
    for (int r = bid * 8 + wave; r < NROWS1; r += nb * 8) {
        const float* src = r < NTOK ? p.x + (size_t)r * D : p.ctx + (size_t)(r - NTOK) * D;
        const int mr = r < NTOK ? (r >> 12) : 8;
        const f32x4* xr = (const f32x4*)src + lane;
        f32x4 v[4]; float s = 0.f;
#pragma unroll
        for (int j = 0; j < 4; ++j) { v[j] = xr[64 * j]; s += v[j].x * v[j].x + v[j].y * v[j].y + v[j].z * v[j].z + v[j].w * v[j].w; }
        const float rs = rsqrtf(wave_sum(s) * (1.f / D) + EPS);
        u32x2* o = (u32x2*)(A1 + (size_t)r * D) + lane;
#pragma unroll
        for (int j = 0; j < 4; ++j) { const int k = lane * 4 + 256 * j;
            const f32x4 g = *(const f32x4*)(p.norm1_g + k), sh = *(const f32x4*)(mod + mr * 6144 + k), sc = *(const f32x4*)(mod + mr * 6144 + 1024 + k);
            const f32x4 h = v[j] * rs * g * (sc + 1.f) + sh; u32x2 w; w.x = pk2(h.x, h.y); w.y = pk2(h.z, h.w); o[64 * j] = w; }
    }
}
struct G1uPol {
    struct Unit { int pm, pn; };
    static constexpr bool GATHER = false;
    pg8::DenseOrder ord; const char* A; const char* B; int K, ksplit, lda, ldb;
    DI bool next(int i, Unit& u) const { return ord.get(i, u.pm, u.pn); }
    DI void ptrs(const Unit& u, pg8::UPtr& q) const { q.a0 = A + (size_t)u.pm * 256 * lda * 2; q.a1 = q.a0 + (size_t)128 * lda * 2; q.b0 = B + (size_t)u.pn * 256 * ldb * 2; q.b1 = q.b0 + (size_t)128 * ldb * 2; q.c0 = q.b0; q.c1 = q.b1; }
    DI int brow(int R) const { return R; }
    DI void gather(const Unit&, int (&)[2], int (&)[2], unsigned (&)[2][2]) const {}
};
struct G1uEpi {
    bf16* Ul;
    DI void operator()(const f32x4 (&acc)[2][2][4][2], const G1uPol::Unit& u, int wr, int wc, int fr, int fq) const {
#pragma unroll
        for (int ai = 0; ai < 2; ++ai)
#pragma unroll
            for (int m = 0; m < 4; ++m) { const int row = u.pm * 256 + ai * 128 + wr * 64 + m * 16 + fr, b = row >> 12, l = row & 4095;
#pragma unroll
                for (int bj = 0; bj < 2; ++bj)
#pragma unroll
                    for (int n = 0; n < 2; ++n) { const int g = (u.pn * 256 + bj * 128 + wc * 32 + n * 16) >> 4;
                        u32x2 w; w.x = pk2(acc[ai][bj][m][n][0], acc[ai][bj][m][n][1]); w.y = pk2(acc[ai][bj][m][n][2], acc[ai][bj][m][n][3]);
                        *(u32x2*)(Ul + (((size_t)(g * 8 + b) * 4096 + l) * 16 + 4 * fq)) = w; } }
    }
};
struct G1gPol {
    struct Unit { int pm, pn; };
    static constexpr bool GATHER = false;
    pg8::DenseOrder ord; const char* A; const char* B; int K, ksplit, lda, ldb;
    DI bool next(int i, Unit& u) const { return ord.get(i, u.pm, u.pn); }
    DI void ptrs(const Unit& u, pg8::UPtr& q) const { q.a0 = A + (size_t)u.pm * 256 * lda * 2; q.a1 = q.a0 + (size_t)128 * lda * 2;
        const int b = u.pn >> 4, a0 = (u.pn & 15) * 4; q.b0 = B + (size_t)(b * 4096 + a0) * ldb * 2; q.b1 = q.b0 + (size_t)2 * ldb * 2; q.c0 = q.b0; q.c1 = q.b1; }
    DI int brow(int R) const { return (R & 63) * 64 + (R >> 6); }
    DI void gather(const Unit&, int (&)[2], int (&)[2], unsigned (&)[2][2]) const {}
};
struct G1gEpi {
    bf16* GT;
    DI void operator()(const f32x4 (&acc)[2][2][4][2], const G1gPol::Unit& u, int wr, int wc, int fr, int fq) const {
        const int b = u.pn >> 4, a0 = (u.pn & 15) * 4;
#pragma unroll
        for (int ai = 0; ai < 2; ++ai)
#pragma unroll
            for (int m = 0; m < 4; ++m) { const int mm = u.pm * 256 + ai * 128 + wr * 64 + m * 16 + fr, c = mm >> 9, ch = mm & 511;
                bf16* base = GT + (size_t)((b * 512 + ch) * 2 + c) * 4096;
#pragma unroll
                for (int bj = 0; bj < 2; ++bj)
#pragma unroll
                    for (int n = 0; n < 2; ++n) { const int a = a0 + 2 * bj + (wc >> 1), bq = 32 * (wc & 1) + 16 * n + 4 * fq;
                        u32x2 w; w.x = pk2(acc[ai][bj][m][n][0], acc[ai][bj][m][n][1]); w.y = pk2(acc[ai][bj][m][n][2], acc[ai][bj][m][n][3]);
                        *(u32x2*)(base + a * 64 + bq) = w; } }
    }
};
DI void phase1b(const Params& p, unsigned char* lds, int bid, int nb) {
    { G1gPol P; P.ord.init(4, NTOK / 256, nb, bid); P.A = (const char*)(p.ws + WS_WINT) + (size_t)512 * 2048; P.B = (const char*)(p.ws + WS_R1); P.K = 1024; P.ksplit = 16; P.lda = 1024; P.ldb = 1024;
      G1gEpi E{(bf16*)(p.ws + WS_R2)};
      pg8::gemm_phase<G1gPol, G1gEpi, true>((PG8_LAS unsigned char*)lds, P, E); }
    { G1uPol P; P.ord.init(NTOK / 256, 2, nb, bid); P.A = (const char*)(p.ws + WS_R1); P.B = (const char*)(p.ws + WS_WINT); P.K = 1024; P.ksplit = 16; P.lda = 1024; P.ldb = 1024;
      G1uEpi E{(bf16*)(p.ws + WS_R3)};
      pg8::gemm_phase<G1uPol, G1uEpi, true>((PG8_LAS unsigned char*)lds, P, E); }
}
constexpr int S5_SB_OFF = GC<2>::LDS, S5_PITCH = 528, S5_LDS = S5_SB_OFF + 144 * S5_PITCH;
DI void phase2_s5(const Params& p, unsigned char* lds, int bid, int nb) {
    const int tid = tidx(), lane = tid & 63, wid = tid >> 6, wm = wid >> 1, wn = wid & 1, fr = lane & 15, fq = lane >> 4, srow = tid >> 3, sck = tid & 7;
    const bf16* zero = (const bf16*)(p.ws + WS_CTL + CTL_ZERO);
    unsigned char* Sb = lds + S5_SB_OFF;
    for (int item = bid; item < 256; item += nb) {
        const int g = item >> 3, b = item & 7;
        const bf16* Ul = (const bf16*)(p.ws + WS_R3) + (size_t)(g * 8 + b) * 4096 * 16;
        const bf16* Uc = (const bf16*)(p.ws + WS_R3) + (size_t)32 * 8 * 4096 * 16 + (size_t)(g * 8 + b) * 256 * 16;
        const bf16* Wst = (const bf16*)(p.ws + WS_WST) + (size_t)g * 256 * 512;
        const bf16* Mg = (const bf16*)(p.ws + WS_MG) + (size_t)g * 512 * 512;
        const bf16* Wos = (const bf16*)(p.ws + WS_WOS) + (size_t)g * 512 * 256;
        { const bf16* A1c = (const bf16*)(p.ws + WS_R1) + (size_t)(NTOK + b * 256 + wid * 32) * D; const bf16* Wg = (const bf16*)(p.ws + WS_WINT) + (size_t)(g * 16) * D;
          f32x4 ca[2] = {(f32x4){0.f, 0.f, 0.f, 0.f}, (f32x4){0.f, 0.f, 0.f, 0.f}};
#pragma unroll 4
          for (int ks = 0; ks < 32; ++ks) { const bf16x8 bw = *(const bf16x8*)(Wg + (size_t)fr * D + ks * 32 + fq * 8);
              const bf16x8 a0 = *(const bf16x8*)(A1c + (size_t)fr * D + ks * 32 + fq * 8), a1 = *(const bf16x8*)(A1c + (size_t)(16 + fr) * D + ks * 32 + fq * 8);
              ca[0] = __builtin_amdgcn_mfma_f32_16x16x32_bf16(bw, a0, ca[0], 0, 0, 0); ca[1] = __builtin_amdgcn_mfma_f32_16x16x32_bf16(bw, a1, ca[1], 0, 0, 0); }
          bf16* Ucw = (bf16*)(p.ws + WS_R3) + (size_t)32 * 8 * 4096 * 16 + (size_t)(g * 8 + b) * 256 * 16;
#pragma unroll
          for (int mt = 0; mt < 2; ++mt) { u32x2 w; w.x = pk2(ca[mt][0], ca[mt][1]); w.y = pk2(ca[mt][2], ca[mt][3]); *(u32x2*)(Ucw + (size_t)(wid * 32 + mt * 16 + fr) * 16 + 4 * fq) = w; }
          asm volatile("s_waitcnt vmcnt(0)" ::: "memory");
          __syncthreads(); }
        for (int pass = 0; pass < 4; ++pass) {
            const int n0 = (pass & 1) * 128, isctx = pass >> 1;
            f32x4 acc[2][4]; zero_acc<2>(acc);
            const bf16* ap[2]; int as[2]; const bf16* bp[2];
#pragma unroll
            for (int i = 0; i < 2; ++i) { const int r = 64 * i + srow;
                if (!isctx) { ap[i] = Ul + (size_t)r * 512 + sck * 8; as[i] = 64; }
                else if (r < 8) { ap[i] = Uc + (size_t)r * 512 + sck * 8; as[i] = 64; }
                else { ap[i] = zero; as[i] = 0; }
                bp[i] = Wst + (size_t)(n0 + r) * 512 + sck * 8; }
            gemm_loop<2>(acc, ap, as, bp, 8, lds);
#pragma unroll
            for (int mt = 0; mt < 2; ++mt) { const int row = wm * 32 + mt * 16 + fr;
                if (!isctx || row < 8) {
#pragma unroll
                    for (int nt = 0; nt < 4; ++nt) { const int col = n0 + wn * 64 + nt * 16 + 4 * fq;
                        u32x2 w; w.x = pk2(acc[mt][nt][0], acc[mt][nt][1]); w.y = pk2(acc[mt][nt][2], acc[mt][nt][3]);
                        *(u32x2*)(Sb + (size_t)((isctx ? 128 : 0) + row) * S5_PITCH + col * 2) = w; } } }
        }
        __syncthreads();
        if (tid < 128) {
            const int d = tid >> 6, pp = tid & 63; const float* aT = (const float*)(p.ws + WS_ABART) + g * 256 + tid * 2; const float ar = aT[0], ai = aT[1];
            bf16* colr = (bf16*)Sb + d * 128 + pp; bf16* coli = colr + 64; constexpr int RP = S5_PITCH / 2;
            float hr = 0.f, hi = 0.f;
            if (d == 0) {
                for (int c = 0; c < 8; ++c) { const float sr = bf2f(colr[(128 + c) * RP]), si = bf2f(coli[(128 + c) * RP]); const float nr = ar * hr - ai * hi + sr, ni = ar * hi + ai * hr + si; hr = nr; hi = ni; }
                for (int c = 0; c < 128; ++c) { const float sr = bf2f(colr[c * RP]), si = bf2f(coli[c * RP]); const unsigned w = pk2(hr, hi); colr[c * RP] = (bf16)(w & 0xffffu); coli[c * RP] = (bf16)(w >> 16);
                    const float nr = ar * hr - ai * hi + sr, ni = ar * hi + ai * hr + si; hr = nr; hi = ni; }
            } else {
                for (int c = 7; c >= 0; --c) { const float sr = bf2f(colr[(128 + c) * RP]), si = bf2f(coli[(128 + c) * RP]); const float nr = ar * hr - ai * hi + sr, ni = ar * hi + ai * hr + si; hr = nr; hi = ni; }
                for (int c = 127; c >= 0; --c) { const float sr = bf2f(colr[c * RP]), si = bf2f(coli[c * RP]); const unsigned w = pk2(hr, hi); colr[c * RP] = (bf16)(w & 0xffffu); coli[c * RP] = (bf16)(w >> 16);
                    const float nr = ar * hr - ai * hi + sr, ni = ar * hi + ai * hr + si; hr = nr; hi = ni; }
            }
        }
        __syncthreads();
        bf16* yact = (bf16*)(p.ws + WS_R4);
        for (int pass = 0; pass < 4; ++pass) {
            const int n0 = pass * 128;
            f32x4 acc[2][4]; zero_acc<2>(acc);
            const bf16* ap[2]; int as[2]; const bf16* bp[2];
#pragma unroll
            for (int i = 0; i < 2; ++i) { const int r = 64 * i + srow; ap[i] = Ul + (size_t)r * 512 + sck * 8; as[i] = 64; bp[i] = Mg + (size_t)(n0 + r) * 512 + sck * 8; }
            gemm_loop<2>(acc, ap, as, bp, 8, lds);
#pragma unroll
            for (int i = 0; i < 2; ++i) bp[i] = Wos + (size_t)(n0 + 64 * i + srow) * 256 + sck * 8;
            gemm_loop_alds<2>(acc, Sb, S5_PITCH, bp, 4, lds);
#pragma unroll
            for (int mt = 0; mt < 2; ++mt) { const int c = wm * 32 + mt * 16 + fr;
#pragma unroll
                for (int nt = 0; nt < 4; ++nt) { const int col = n0 + wn * 64 + nt * 16 + 4 * fq, j = col >> 4, i0 = col & 15, l = 32 * c + j;
                    const u32x2 uu = *(const u32x2*)(Ul + (size_t)l * 16 + i0); const f32x4 dd = *(const f32x4*)(p.s5_d + g * 16 + i0);
                    const float y0 = geluf_(acc[mt][nt][0] + dd.x * __uint_as_float(uu.x << 16)), y1 = geluf_(acc[mt][nt][1] + dd.y * __uint_as_float(uu.x & 0xffff0000u));
                    const float y2 = geluf_(acc[mt][nt][2] + dd.z * __uint_as_float(uu.y << 16)), y3 = geluf_(acc[mt][nt][3] + dd.w * __uint_as_float(uu.y & 0xffff0000u));
                    u32x2 w; w.x = pk2(y0, y1); w.y = pk2(y2, y3);
                    *(u32x2*)(yact + ((size_t)(b * 4096 + l) * 512 + g * 16 + i0)) = w; } }
        }
        __syncthreads();
    }
}
constexpr int FF_W1P = 272, FF_W2P = 80, FF_W1_OFF = 0, FF_W2_OFF = 128 * FF_W1P, FF_TW_OFF = FF_W2_OFF + 4 * 64 * FF_W2P, FF_LDS = FF_TW_OFF + 32768;
DI void phase2_fft(const Params& p, unsigned char* lds, int bid, int nb) {
    const int tid = tidx(), lane = tid & 63, wid = tid >> 6, fr = lane & 15, fq = lane >> 4;
    { const bf16* W1 = (const bf16*)(p.ws + WS_FFTC); const bf16* W2 = W1 + 128 * 128; const float* tw = (const float*)(p.ws + WS_FFTC + 32768 + 16384);
      for (int i = tid; i < 128 * 16; i += NT) { const int n = i >> 4, c = i & 15; *(u32x4*)(lds + FF_W1_OFF + n * FF_W1P + c * 16) = *(const u32x4*)(W1 + n * 128 + c * 8); }
      for (int i = tid; i < 256 * 4; i += NT) { const int r = i >> 2, c = i & 3; *(u32x4*)(lds + FF_W2_OFF + r * FF_W2P + c * 16) = *(const u32x4*)(W2 + r * 32 + c * 8); }
      for (int i = tid; i < 2048; i += NT) *(u32x4*)(lds + FF_TW_OFF + i * 16) = *(const u32x4*)(tw + i * 4);
      __syncthreads(); }
    const bf16* GT = (const bf16*)(p.ws + WS_R2); bf16* FT = (bf16*)(p.ws + WS_R5);
    const float* twl = (const float*)(lds + FF_TW_OFF);
    for (int cidx = bid * 8 + wid; cidx < 4096; cidx += nb * 8) {
        const bf16* gt = GT + (size_t)cidx * 2 * 4096;
        bf16* ft = FT + (size_t)cidx * 4096;
#pragma unroll 1
        for (int nt = 0; nt < 4; ++nt) {
            f32x4 dre[4], dim[4];
#pragma unroll
            for (int m = 0; m < 4; ++m) { dre[m] = (f32x4){0.f, 0.f, 0.f, 0.f}; dim[m] = (f32x4){0.f, 0.f, 0.f, 0.f}; }
#pragma unroll
            for (int ks = 0; ks < 4; ++ks) {
                bf16x8 afr[4];
#pragma unroll
                for (int mt = 0; mt < 4; ++mt) afr[mt] = *(const bf16x8*)(gt + (ks >> 1) * 4096 + (16 * mt + fr) * 64 + 32 * (ks & 1) + 8 * fq);
                const bf16x8 bre = *(const bf16x8*)(lds + FF_W1_OFF + (nt * 16 + fr) * FF_W1P + (ks * 32 + fq * 8) * 2);
                const bf16x8 bim = *(const bf16x8*)(lds + FF_W1_OFF + (64 + nt * 16 + fr) * FF_W1P + (ks * 32 + fq * 8) * 2);
#pragma unroll
                for (int mt = 0; mt < 4; ++mt) { dre[mt] = __builtin_amdgcn_mfma_f32_16x16x32_bf16(afr[mt], bre, dre[mt], 0, 0, 0);
                                                 dim[mt] = __builtin_amdgcn_mfma_f32_16x16x32_bf16(afr[mt], bim, dim[mt], 0, 0, 0); }
            }
            const int d = 16 * nt + fr; unsigned pr[4][2], pi[4][2];
#pragma unroll
            for (int mt = 0; mt < 4; ++mt) { float tr[4], ti[4];
#pragma unroll
                for (int r = 0; r < 4; ++r) { const int a = 16 * mt + 4 * fq + r, ix = (d * a) & 4095; const float cs = twl[ix * 2], sn = twl[ix * 2 + 1];
                    const float re = dre[mt][r], im = dim[mt][r]; tr[r] = re * cs + im * sn; ti[r] = im * cs - re * sn; }
                pr[mt][0] = pk2(tr[0], tr[1]); pr[mt][1] = pk2(tr[2], tr[3]); pi[mt][0] = pk2(ti[0], ti[1]); pi[mt][1] = pk2(ti[2], ti[3]); }
            u32x4 f0, f1, f2, f3;
            f0.x = pr[0][0]; f0.y = pr[0][1]; f0.z = pr[1][0]; f0.w = pr[1][1];
            f1.x = pr[2][0]; f1.y = pr[2][1]; f1.z = pr[3][0]; f1.w = pr[3][1];
            f2.x = pi[0][0]; f2.y = pi[0][1]; f2.z = pi[1][0]; f2.w = pi[1][1];
            f3.x = pi[2][0]; f3.y = pi[2][1]; f3.z = pi[3][0]; f3.w = pi[3][1];
            bf16x8 frag[4];
            frag[0] = __builtin_bit_cast(bf16x8, f0); frag[1] = __builtin_bit_cast(bf16x8, f1); frag[2] = __builtin_bit_cast(bf16x8, f2); frag[3] = __builtin_bit_cast(bf16x8, f3);
            f32x4 z[4];
#pragma unroll
            for (int n = 0; n < 4; ++n) z[n] = (f32x4){0.f, 0.f, 0.f, 0.f};
#pragma unroll
            for (int s2 = 0; s2 < 4; ++s2)
#pragma unroll
                for (int n2 = 0; n2 < 4; ++n2) { const bf16x8 bfr = *(const bf16x8*)(lds + FF_W2_OFF + ((s2 * 64 + n2 * 16 + fr) * FF_W2P) + fq * 16);
                    z[n2] = __builtin_amdgcn_mfma_f32_16x16x32_bf16(frag[s2], bfr, z[n2], 0, 0, 0); }
#pragma unroll
            for (int n2 = 0; n2 < 4; ++n2) { const int cf = 16 * n2 + fr; u32x2 w; w.x = pk2(z[n2][0], z[n2][1]); w.y = pk2(z[n2][2], z[n2][3]);
                *(u32x2*)(ft + 64 * cf + 16 * nt + 4 * fq) = w; }
        }
    }
}
struct GluEpi {
    const bf16* yact; bf16* merged;
    DI void operator()(const f32x4 (&acc)[2][2][4][2], const G1uPol::Unit& u, int wr, int wc, int fr, int fq) const {
        const int col0 = u.pn * 256 + wc * 32 + 4 * fq;
        u32x2 yy[2][4][2][2];
#pragma unroll
        for (int ai = 0; ai < 2; ++ai)
#pragma unroll
            for (int m = 0; m < 4; ++m) { const int row = u.pm * 256 + ai * 128 + wr * 64 + m * 16 + fr;
#pragma unroll
                for (int bj = 0; bj < 2; ++bj)
#pragma unroll
                    for (int n = 0; n < 2; ++n) yy[ai][m][bj][n] = *(const u32x2*)(yact + (size_t)row * 512 + col0 + bj * 128 + n * 16); }
#pragma unroll
        for (int ai = 0; ai < 2; ++ai)
#pragma unroll
            for (int m = 0; m < 4; ++m) { const int row = u.pm * 256 + ai * 128 + wr * 64 + m * 16 + fr;
#pragma unroll
                for (int bj = 0; bj < 2; ++bj)
#pragma unroll
                    for (int n = 0; n < 2; ++n) { const u32x2 y = yy[ai][m][bj][n]; const f32x4 a = acc[ai][bj][m][n];
                        const float y0 = __uint_as_float(y.x << 16) * sigmoidf_(a[0]), y1 = __uint_as_float(y.x & 0xffff0000u) * sigmoidf_(a[1]);
                        const float y2 = __uint_as_float(y.y << 16) * sigmoidf_(a[2]), y3 = __uint_as_float(y.y & 0xffff0000u) * sigmoidf_(a[3]);
                        u32x2 w; w.x = pk2(y0, y1); w.y = pk2(y2, y3); *(u32x2*)(merged + (size_t)row * 1024 + col0 + bj * 128 + n * 16) = w; } }
    }
};
DI void phase3_glu(const Params& p, unsigned char* lds, int bid, int nb) {
    G1uPol P; P.ord.init(NTOK / 256, 2, nb, bid); P.A = (const char*)(p.ws + WS_R4); P.B = (const char*)(p.ws + WS_WGLUT); P.K = 512; P.ksplit = 8; P.lda = 512; P.ldb = 512;
    GluEpi E{(const bf16*)(p.ws + WS_R4), (bf16*)(p.ws + WS_R1)};
    pg8::gemm_phase<G1uPol, GluEpi, true>((PG8_LAS unsigned char*)lds, P, E);
}
constexpr int FM_PITCH = 132, FM_LDS = 512 * FM_PITCH;
DI void phase3_fin(const Params& p, unsigned char* lds, int bid, int nb) {
    const int tid = tidx(), lane = tid & 63, wid = tid >> 6;
    const bf16* FT = (const bf16*)(p.ws + WS_R5); bf16* merged = (bf16*)(p.ws + WS_R1);
    for (int item = bid; item < 512; item += nb) {
        const int b = item >> 6, k0 = (item & 63) * 64;
        for (int i = tid; i < 512 * 8; i += NT) { const int ch = i >> 3, c = i & 7; const u32x4 v = *(const u32x4*)(FT + ((size_t)(b * 512 + ch) * 4096 + k0 + c * 8));
            unsigned* d = (unsigned*)(lds + ch * FM_PITCH + c * 16); d[0] = v.x; d[1] = v.y; d[2] = v.z; d[3] = v.w; }
        __syncthreads();
        for (int t = wid * 8; t < wid * 8 + 8; ++t) {
            const size_t row = (size_t)b * 4096 + k0 + t;
            float f[8]; float s = 0.f;
#pragma unroll
            for (int j = 0; j < 8; ++j) { f[j] = bf2f(*(const bf16*)(lds + (lane + 64 * j) * FM_PITCH + t * 2)); s += f[j] * f[j]; }
            const float rs = rsqrtf(wave_sum(s) * (1.f / 512.f) + EPS);
#pragma unroll
            for (int j = 0; j < 8; ++j) merged[row * 1024 + 512 + lane + 64 * j] = (bf16)(pk2(f[j] * rs * p.g_f[lane + 64 * j], 0.f) & 0xffffu);
            u32x4 yv = *(const u32x4*)(merged + row * 1024 + lane * 8);
            float y[8]; y[0] = __uint_as_float(yv.x << 16); y[1] = __uint_as_float(yv.x & 0xffff0000u); y[2] = __uint_as_float(yv.y << 16); y[3] = __uint_as_float(yv.y & 0xffff0000u);
            y[4] = __uint_as_float(yv.z << 16); y[5] = __uint_as_float(yv.z & 0xffff0000u); y[6] = __uint_as_float(yv.w << 16); y[7] = __uint_as_float(yv.w & 0xffff0000u);
            float s2 = 0.f;
#pragma unroll
            for (int j = 0; j < 8; ++j) s2 += y[j] * y[j];
            const float rs2 = rsqrtf(wave_sum(s2) * (1.f / 512.f) + EPS);
            const f32x4 g0 = *(const f32x4*)(p.g_s + lane * 8), g1 = *(const f32x4*)(p.g_s + lane * 8 + 4);
            u32x4 o; o.x = pk2(y[0] * rs2 * g0.x, y[1] * rs2 * g0.y); o.y = pk2(y[2] * rs2 * g0.z, y[3] * rs2 * g0.w); o.z = pk2(y[4] * rs2 * g1.x, y[5] * rs2 * g1.y); o.w = pk2(y[6] * rs2 * g1.z, y[7] * rs2 * g1.w);
            *(u32x4*)(merged + row * 1024 + lane * 8) = o;
        }
        __syncthreads();
    }
}
struct P4Pol {
    struct Unit { int pm, pn; };
    static constexpr bool GATHER = false;
    pg8::DenseOrder ord; const char* A; const char* B; int K, ksplit, lda, ldb;
    DI bool next(int i, Unit& u) const { return ord.get(i, u.pm, u.pn); }
    DI void ptrs(const Unit& u, pg8::UPtr& q) const { q.a0 = A + (size_t)u.pm * 256 * lda * 2; q.a1 = q.a0 + (size_t)128 * lda * 2; q.b0 = B + (size_t)u.pn * 256 * ldb * 2; q.b1 = q.b0 + (size_t)128 * ldb * 2; q.c0 = q.b0; q.c1 = q.b1; }
    DI int brow(int R) const { return R; }
    DI void gather(const Unit&, int (&)[2], int (&)[2], unsigned (&)[2][2]) const {}
};
struct P4Epi {
    const float* x; float* out; const float* mod; float* rsqp;
    DI void operator()(const f32x4 (&acc)[2][2][4][2], const P4Pol::Unit& u, int wr, int wc, int fr, int fq) const {
        const int col0 = u.pn * 256 + wc * 32 + 4 * fq, b = (u.pm * 256) >> 12;
        f32x4 gv[2][2];
#pragma unroll
        for (int bj = 0; bj < 2; ++bj)
#pragma unroll
            for (int n = 0; n < 2; ++n) gv[bj][n] = *(const f32x4*)(mod + b * 6144 + 2048 + col0 + bj * 128 + n * 16);
#pragma unroll
        for (int q = 0; q < 4; ++q) { const int ai = q >> 1, mb = (q & 1) * 2;
            f32x4 xv[2][2][2];
#pragma unroll
            for (int m2 = 0; m2 < 2; ++m2) { const int row = u.pm * 256 + ai * 128 + wr * 64 + (mb + m2) * 16 + fr;
#pragma unroll
                for (int bj = 0; bj < 2; ++bj)
#pragma unroll
                    for (int n = 0; n < 2; ++n) xv[m2][bj][n] = *(const f32x4*)(x + (size_t)row * D + col0 + bj * 128 + n * 16); }
#pragma unroll
            for (int m2 = 0; m2 < 2; ++m2) { const int m = mb + m2, row = u.pm * 256 + ai * 128 + wr * 64 + m * 16 + fr; float s = 0.f;
#pragma unroll
                for (int bj = 0; bj < 2; ++bj)
#pragma unroll
                    for (int n = 0; n < 2; ++n) { const f32x4 o = xv[m2][bj][n] + gv[bj][n] * acc[ai][bj][m][n]; *(f32x4*)(out + (size_t)row * D + col0 + bj * 128 + n * 16) = o; s += (o.x * o.x + o.y * o.y) + (o.z * o.z + o.w * o.w); }
                s += __shfl_xor(s, 16); s += __shfl_xor(s, 32);
                if (fq == 0) rsqp[(size_t)row * 16 + u.pn * 4 + wc] = s; }
            asm volatile("" ::: "memory");
        }
    }
};
DI void phase4_out(const Params& p, unsigned char* lds, int bid, int nb) {
    P4Pol P; P.ord.init(NTOK / 256, D / 256, nb, bid); P.A = (const char*)(p.ws + WS_R1); P.B = (const char*)(p.ws + WS_WOUTT); P.K = 1024; P.ksplit = 16; P.lda = 1024; P.ldb = 1024;
    P4Epi E{p.x, p.out, (const float*)(p.ws + WS_MOD), (float*)(p.ws + WS_RSQP1)};
    pg8::gemm_phase<P4Pol, P4Epi, true>((PG8_LAS unsigned char*)lds, P, E);
}
DI int pair_index(int lo, int hi) { return 7 * lo - (lo * (lo - 1)) / 2 + (hi - lo - 1); }
constexpr int RT_WP = 2064, RT_GM_OFF = 48 * RT_WP, RT_SH_OFF = RT_GM_OFF + 4096, RT_SC_OFF = RT_SH_OFF + 4096, RT_LDS = RT_SC_OFF + 8 * 16 * 48 * 4;
DI void phase5_route(const Params& p, unsigned char* lds, int bid, int nb) {
    const int tid = tidx(), lane = tid & 63, wid = tid >> 6, fr = lane & 15, fq = lane >> 4;
    { const bf16* W = (const bf16*)(p.ws + WS_WRT);
      for (int i = tid; i < 48 * 128; i += NT) { const int n = i >> 7, c = i & 127; *(u32x4*)(lds + n * RT_WP + c * 16) = *(const u32x4*)(W + n * 1024 + c * 8); } }
    const float* mod = (const float*)(p.ws + WS_MOD); const float* rsqp = (const float*)(p.ws + WS_RSQP1);
    bf16* A2 = (bf16*)(p.ws + WS_R2); unsigned* elcp = (unsigned*)(p.ws + WS_ELCP); float* elw = (float*)(p.ws + WS_ELW); unsigned* tcp = (unsigned*)(p.ws + WS_TCP);
    unsigned* ecnt = (unsigned*)(p.ws + WS_CTL + CTL_ECNT); unsigned* pcnt = (unsigned*)(p.ws + WS_CTL + CTL_PCNT);
    unsigned* elist = (unsigned*)(p.ws + WS_ELIST);
    float* gm = (float*)(lds + RT_GM_OFF); float* shv = (float*)(lds + RT_SH_OFF); float* scr = (float*)(lds + RT_SC_OFF) + wid * 16 * 48;
    for (int t128 = bid; t128 < NTOK / 128; t128 += nb) {
        const int b = t128 >> 5;
        __syncthreads();
        for (int k = tid; k < 1024; k += NT) { gm[k] = p.norm2_g[k] * (1.f + mod[b * 6144 + 4096 + k]); shv[k] = mod[b * 6144 + 3072 + k]; }
        __syncthreads();
        const int row0 = t128 * 128 + wid * 16, row = row0 + fr;
        float rs;
        { const f32x4* pp = (const f32x4*)(rsqp + (size_t)row * 16); const f32x4 q0 = pp[0], q1 = pp[1], q2 = pp[2], q3 = pp[3];
          const float rsum = (((q0.x + q0.y) + (q0.z + q0.w)) + ((q1.x + q1.y) + (q1.z + q1.w))) + (((q2.x + q2.y) + (q2.z + q2.w)) + ((q3.x + q3.y) + (q3.z + q3.w)));
          rs = rsqrtf(rsum * (1.f / D) + EPS); }
        f32x4 acc[3];
#pragma unroll
        for (int n = 0; n < 3; ++n) acc[n] = (f32x4){0.f, 0.f, 0.f, 0.f};
        const float* xr = p.out + (size_t)row * D + fq * 8; bf16* ar = A2 + (size_t)row * D + fq * 8;
#pragma unroll 2
        for (int ks = 0; ks < 32; ++ks) {
            const int k0 = ks * 32 + fq * 8;
            const f32x4 x0 = *(const f32x4*)(xr + ks * 32), x1 = *(const f32x4*)(xr + ks * 32 + 4);
            const f32x4 g0 = *(const f32x4*)(gm + k0), g1 = *(const f32x4*)(gm + k0 + 4), s0 = *(const f32x4*)(shv + k0), s1 = *(const f32x4*)(shv + k0 + 4);
            const f32x4 t0 = x0 * rs * g0 + s0, t1 = x1 * rs * g1 + s1;
            u32x4 hi; hi.x = pk2(t0.x, t0.y); hi.y = pk2(t0.z, t0.w); hi.z = pk2(t1.x, t1.y); hi.w = pk2(t1.z, t1.w);
            *(u32x4*)(ar + ks * 32) = hi;
            u32x4 lo;
            lo.x = pk2(t0.x - __uint_as_float(hi.x << 16), t0.y - __uint_as_float(hi.x & 0xffff0000u)); lo.y = pk2(t0.z - __uint_as_float(hi.y << 16), t0.w - __uint_as_float(hi.y & 0xffff0000u));
            lo.z = pk2(t1.x - __uint_as_float(hi.z << 16), t1.y - __uint_as_float(hi.z & 0xffff0000u)); lo.w = pk2(t1.z - __uint_as_float(hi.w << 16), t1.w - __uint_as_float(hi.w & 0xffff0000u));
            const bf16x8 ah = __builtin_bit_cast(bf16x8, hi), al = __builtin_bit_cast(bf16x8, lo);
#pragma unroll
            for (int nt = 0; nt < 3; ++nt) { const bf16x8 bw = *(const bf16x8*)(lds + (16 * nt + fr) * RT_WP + k0 * 2);
                acc[nt] = __builtin_amdgcn_mfma_f32_16x16x32_bf16(ah, bw, acc[nt], 0, 0, 0); acc[nt] = __builtin_amdgcn_mfma_f32_16x16x32_bf16(al, bw, acc[nt], 0, 0, 0); }
        }
#pragma unroll
        for (int nt = 0; nt < 3; ++nt)
#pragma unroll
            for (int r = 0; r < 4; ++r) scr[(4 * fq + r) * 48 + 16 * nt + fr] = acc[nt][r];
        __syncthreads();
        if (lane < 16) {
            const int rrow = row0 + lane; const float* lg = scr + lane * 48;
            float gl[4];
#pragma unroll
            for (int o = 0; o < 4; ++o) gl[o] = lg[o] + p.b_group[o];
            float gmax = gl[0]; int gi = 0;
#pragma unroll
            for (int o = 1; o < 4; ++o) if (gl[o] > gmax) { gmax = gl[o]; gi = o; }
            float se = 0.f;
#pragma unroll
            for (int o = 0; o < 4; ++o) se += __expf(gl[o] - gmax);
            const float g_w = 1.f / se;
            float ev[8];
#pragma unroll
            for (int o = 0; o < 8; ++o) ev[o] = lg[4 + gi * 8 + o] + p.b_router[gi * 8 + o];
            float v1 = ev[0]; int i1 = 0;
#pragma unroll
            for (int o = 1; o < 8; ++o) if (ev[o] > v1) { v1 = ev[o]; i1 = o; }
            float v2 = -3.0e38f; int i2 = -1;
#pragma unroll
            for (int o = 0; o < 8; ++o) if (o != i1 && ev[o] > v2) { v2 = ev[o]; i2 = o; }
            const float w1 = g_w / (1.f + __expf(v2 - v1)), w2 = g_w - w1;
            const int lo = i1 < i2 ? i1 : i2, hi = i1 < i2 ? i2 : i1; const int pos1 = i1 < i2 ? 0 : 1;
            const int e1 = gi * 8 + i1, e2 = gi * 8 + i2;
            const int cls = gi * 28 + pair_index(lo, hi);
            const unsigned q3 = atomicAdd(pcnt + cls, 1u); const unsigned cp = ((unsigned)cls << 16) | q3;
            tcp[rrow] = cp;
            const unsigned q1 = atomicAdd(ecnt + e1, 1u); elist[(size_t)e1 * 32768 + q1] = (unsigned)rrow * 2u + (unsigned)pos1; elcp[(size_t)e1 * 32768 + q1] = cp; elw[(size_t)e1 * 32768 + q1] = w1;
            const unsigned q2 = atomicAdd(ecnt + e2, 1u); elist[(size_t)e2 * 32768 + q2] = (unsigned)rrow * 2u + (unsigned)(1 - pos1); elcp[(size_t)e2 * 32768 + q2] = cp; elw[(size_t)e2 * 32768 + q2] = w2;
        }
    }
    __syncthreads();
}
constexpr int TB_OFF = 131072, TB_ETE = 64, TB_ETR = 64 + 320, TB_ETC = 64 + 640, TB_PTC = 64 + 960, TB_PTS = 64 + 1280, TB_COFF = 64 + 1600, TB_BYTES = (64 + 1600 + 128) * 4;
DI void build_tiles(const Params& p, unsigned char* lds) {
    if (tidx() == 0) {
        int* tb = (int*)(lds + TB_OFF); const unsigned* ecnt = (const unsigned*)(p.ws + WS_CTL + CTL_ECNT); const unsigned* pcnt = (const unsigned*)(p.ws + WS_CTL + CTL_PCNT);
        int n = 0;
        for (int e = 0; e < 32; ++e) { const int c = (int)ecnt[e]; for (int r0 = 0; r0 < c; r0 += 256) { tb[TB_ETE + n] = e; tb[TB_ETR + n] = r0; tb[TB_ETC + n] = c; ++n; } }
        tb[0] = n; n = 0; int off = 0;
        for (int c2 = 0; c2 < 112; ++c2) { const int c = (int)pcnt[c2]; tb[TB_COFF + c2] = off; for (int r0 = 0; r0 < c; r0 += 256) { tb[TB_PTC + n] = c2; tb[TB_PTS + n] = off + r0; ++n; } off += ((c + 255) >> 8) << 8; }
        tb[1] = n;
    }
    __syncthreads();
}
struct GUPol {
    struct Unit { int e, r0, cnt, hh; };
    static constexpr bool GATHER = true;
    const int* tb; int G, c; const char* A; const char* B; const unsigned* elist; int K, ksplit, lda, ldb;
    DI bool next(int i, Unit& u) const { const int L = i * G + c; if (L >= __builtin_amdgcn_readfirstlane(tb[0]) * 2) return false; const int t = L >> 1; u.hh = L & 1;
        u.e = __builtin_amdgcn_readfirstlane(tb[TB_ETE + t]); u.r0 = __builtin_amdgcn_readfirstlane(tb[TB_ETR + t]); u.cnt = __builtin_amdgcn_readfirstlane(tb[TB_ETC + t]); return true; }
    DI void ptrs(const Unit& u, pg8::UPtr& q) const { q.a0 = A; q.a1 = A; q.b0 = B + (size_t)((u.e * 2 + u.hh) * 256) * ldb * 2; q.b1 = q.b0 + (size_t)128 * ldb * 2; q.c0 = q.b0; q.c1 = q.b1; }
    DI int brow(int R) const { return R; }
    DI void gather(const Unit& u, int (&R)[2], int (&C)[2], unsigned (&va)[2][2]) const {
#pragma unroll
        for (int h = 0; h < 2; ++h)
#pragma unroll
            for (int i = 0; i < 2; ++i) { const int r = u.r0 + h * 128 + R[i]; const unsigned ent = elist[(size_t)u.e * 32768 + (r < u.cnt ? r : u.r0)]; va[h][i] = ((ent >> 1) * 1024u + (unsigned)C[i]) * 2u; }
    }
};
struct GUEpi {
    const unsigned* elist; const unsigned* elcp; const float* elw; bf16* Hs; const int* tb;
    DI void operator()(const f32x4 (&acc)[2][2][4][2], const GUPol::Unit& u, int wr, int wc, int fr, int fq) const {
        unsigned ent[2][4], cp[2][4]; float w[2][4];
#pragma unroll
        for (int ai = 0; ai < 2; ++ai)
#pragma unroll
            for (int m = 0; m < 4; ++m) { const int r = u.r0 + ai * 128 + wr * 64 + m * 16 + fr; const size_t ix = (size_t)u.e * 32768 + (r < u.cnt ? r : u.r0);
                ent[ai][m] = elist[ix]; cp[ai][m] = elcp[ix]; w[ai][m] = elw[ix]; }
#pragma unroll
        for (int ai = 0; ai < 2; ++ai)
#pragma unroll
            for (int m = 0; m < 4; ++m) { const int r = u.r0 + ai * 128 + wr * 64 + m * 16 + fr;
                if (r < u.cnt) { const int srow = tb[TB_COFF + (cp[ai][m] >> 16)] + (int)(cp[ai][m] & 0xffffu); const float ww = w[ai][m];
                    bf16* dst = Hs + (size_t)srow * 512 + (ent[ai][m] & 1u) * 256 + u.hh * 128 + wc * 32 + 4 * fq;
#pragma unroll
                    for (int n = 0; n < 2; ++n) { const f32x4 gt = acc[ai][0][m][n], up = acc[ai][1][m][n];
                        u32x2 o; o.x = pk2(siluf_(gt[0]) * up[0] * ww, siluf_(gt[1]) * up[1] * ww); o.y = pk2(siluf_(gt[2]) * up[2] * ww, siluf_(gt[3]) * up[3] * ww);
                        *(u32x2*)(dst + n * 16) = o; } } }
    }
};
DI void phase6_gateup(const Params& p, unsigned char* lds, int bid, int nb) {
    GUPol P; P.tb = (const int*)(lds + TB_OFF); P.G = nb; P.c = bid; P.A = (const char*)(p.ws + WS_R2); P.B = (const char*)(p.ws + WS_WGUT); P.elist = (const unsigned*)(p.ws + WS_ELIST); P.K = 1024; P.ksplit = 16; P.lda = 1024; P.ldb = 1024;
    GUEpi E{(const unsigned*)(p.ws + WS_ELIST), (const unsigned*)(p.ws + WS_ELCP), (const float*)(p.ws + WS_ELW), (bf16*)(p.ws + WS_R3), (const int*)(lds + TB_OFF)};
    pg8::gemm_phase<GUPol, GUEpi, true>((PG8_LAS unsigned char*)lds, P, E);
}
struct DnPol {
    struct Unit { int s0, cls, pn; };
    static constexpr bool GATHER = false;
    const int* tb; int G, c; const char* A; const char* B; int K, ksplit, lda, ldb;
    DI bool next(int i, Unit& u) const { const int L = i * G + c; if (L >= __builtin_amdgcn_readfirstlane(tb[1]) * 4) return false; const int t = L >> 2; u.pn = L & 3;
        u.cls = __builtin_amdgcn_readfirstlane(tb[TB_PTC + t]); u.s0 = __builtin_amdgcn_readfirstlane(tb[TB_PTS + t]); return true; }
    DI void ptrs(const Unit& u, pg8::UPtr& q) const {
        const int gi = u.cls / 28; int lo = 0, rem = u.cls % 28;
        while (rem >= 7 - lo) { rem -= 7 - lo; ++lo; }
        const int hi = lo + 1 + rem, elo = gi * 8 + lo, ehi = gi * 8 + hi;
        q.a0 = A + (size_t)u.s0 * lda * 2; q.a1 = q.a0 + (size_t)128 * lda * 2;
        q.b0 = B + ((size_t)elo * 1024 + u.pn * 256) * ldb * 2; q.b1 = q.b0 + (size_t)128 * ldb * 2;
        q.c0 = B + ((size_t)ehi * 1024 + u.pn * 256) * ldb * 2; q.c1 = q.c0 + (size_t)128 * ldb * 2; }
    DI int brow(int R) const { return R; }
    DI void gather(const Unit&, int (&)[2], int (&)[2], unsigned (&)[2][2]) const {}
};
struct DnEpi {
    bf16* moe;
    DI void operator()(const f32x4 (&acc)[2][2][4][2], const DnPol::Unit& u, int wr, int wc, int fr, int fq) const {
#pragma unroll
        for (int ai = 0; ai < 2; ++ai)
#pragma unroll
            for (int m = 0; m < 4; ++m) { bf16* dst = moe + (size_t)(u.s0 + ai * 128 + wr * 64 + m * 16 + fr) * 1024 + u.pn * 256 + wc * 32 + 4 * fq;
#pragma unroll
                for (int bj = 0; bj < 2; ++bj)
#pragma unroll
                    for (int n = 0; n < 2; ++n) { u32x2 w; w.x = pk2(acc[ai][bj][m][n][0], acc[ai][bj][m][n][1]); w.y = pk2(acc[ai][bj][m][n][2], acc[ai][bj][m][n][3]);
                        *(u32x2*)(dst + bj * 128 + n * 16) = w; } }
    }
};
DI void phase7_down(const Params& p, unsigned char* lds, int bid, int nb) {
    DnPol P; P.tb = (const int*)(lds + TB_OFF); P.G = nb; P.c = bid; P.A = (const char*)(p.ws + WS_R3); P.B = (const char*)(p.ws + WS_WDT); P.K = 512; P.ksplit = 4; P.lda = 512; P.ldb = 256;
    DnEpi E{(bf16*)(p.ws + WS_R1)};
    pg8::gemm_phase<DnPol, DnEpi, true>((PG8_LAS unsigned char*)lds, P, E);
}
DI void phase8_final(const Params& p, unsigned char* lds, int bid, int nb) {
    const int lane = tidx() & 63, wave = tidx() >> 6;
    const float* mod = (const float*)(p.ws + WS_MOD); const unsigned* tcp = (const unsigned*)(p.ws + WS_TCP); const bf16* moe = (const bf16*)(p.ws + WS_R1); const int* tb = (const int*)(lds + TB_OFF);
    for (int r = bid * 8 + wave; r < NTOK; r += nb * 8) {
        const unsigned cp = tcp[r]; const int srow = tb[TB_COFF + (cp >> 16)] + (int)(cp & 0xffffu), b = r >> 12;
        f32x4* xr = (f32x4*)(p.out + (size_t)r * D) + lane; const u32x2* mr = (const u32x2*)(moe + (size_t)srow * D) + lane;
        f32x4 v[4]; float s = 0.f;
#pragma unroll
        for (int j = 0; j < 4; ++j) { const f32x4 x1 = xr[64 * j]; const u32x2 mm = mr[64 * j]; const f32x4 g2 = *(const f32x4*)(mod + b * 6144 + 5120 + lane * 4 + 256 * j);
            f32x4 mv; mv.x = __uint_as_float(mm.x << 16); mv.y = __uint_as_float(mm.x & 0xffff0000u); mv.z = __uint_as_float(mm.y << 16); mv.w = __uint_as_float(mm.y & 0xffff0000u);
            v[j] = x1 + g2 * mv; s += (v[j].x * v[j].x + v[j].y * v[j].y) + (v[j].z * v[j].z + v[j].w * v[j].w); }
        const float rs = rsqrtf(wave_sum(s) * (1.f / D) + EPS);
#pragma unroll
        for (int j = 0; j < 4; ++j) { const f32x4 g = *(const f32x4*)(p.final_g + lane * 4 + 256 * j); xr[64 * j] = v[j] * rs * g; }
    }
}

#define XB_TMO      128
#define XB_XCNT(j)  (256  + 64 * (j))
#define XB_XSUB(j)  (1280 + 64 * (j))
#define XB_XGEN(j)  (2304 + 64 * (j))
#define XB_TOP      3328
#define XB_TOPGEN   3392
#define XCD_BAR_WORDS 3456
#define XB_SPIN_CAP (1u << 18)
#define LAS __attribute__((address_space(3)))
DI unsigned xb_ld(unsigned* p)              { return __hip_atomic_load(p, __ATOMIC_RELAXED, __HIP_MEMORY_SCOPE_AGENT); }
DI unsigned xb_add(unsigned* p, unsigned v) { return __hip_atomic_fetch_add(p, v, __ATOMIC_RELAXED, __HIP_MEMORY_SCOPE_AGENT); }
DI unsigned xb_xcc_id() { return (unsigned)__builtin_amdgcn_s_getreg((3 << 11) | 20) & 0xFu; }
#define XB_SPIN(cond, bar) do { unsigned _sp = 0; while (cond) { __builtin_amdgcn_s_sleep(1); \
    if ((++_sp & 255u) == 0u) { if (xb_ld(&(bar)[XB_TMO])) break; if (_sp > XB_SPIN_CAP) { atomicAdd(&(bar)[XB_TMO], 1u); break; } } } } while (0)
struct XcdBarrier { unsigned* bar; unsigned x; volatile LAS unsigned* st; };
DI XcdBarrier xcd_barrier_post(unsigned* bar, volatile LAS unsigned* st) {
    XcdBarrier b; b.bar = bar; b.x = xb_xcc_id(); b.st = st;
    if (tidx() == 0) (void)xb_add(&bar[XB_XCNT(b.x)], 1u);
    return b;
}
DI void xcd_barrier_complete(unsigned* bar, unsigned x, unsigned& nloc, unsigned& nx) {
    const unsigned G = gridDim.x * gridDim.y * gridDim.z;
    unsigned sum, cnt, mine, sp = 0u;
    for (;;) {
        sum = 0u; cnt = 0u; mine = 0u;
#pragma unroll
        for (unsigned j = 0; j < 16; ++j) { const unsigned c = xb_ld(&bar[XB_XCNT(j)]); sum += c; cnt += (c > 0u) ? 1u : 0u; mine = (j == x) ? c : mine; }
        if (sum == G) break;
        __builtin_amdgcn_s_sleep(1);
        if ((++sp & 255u) == 0u) { if (xb_ld(&bar[XB_TMO])) break; if (sp > XB_SPIN_CAP) { atomicAdd(&bar[XB_TMO], 1u); break; } }
    }
    nloc = mine > 0u ? mine : 1u; nx = cnt > 0u ? cnt : 1u;
}
DI void xcd_barrier(const XcdBarrier& b) {
    asm volatile("s_waitcnt vmcnt(0)" ::: "memory");
    __syncthreads();
    if (tidx() == 0) {
        unsigned* bar = b.bar;
        __builtin_amdgcn_s_waitcnt(0);
        unsigned nloc = b.st[0], nx = b.st[1];
        if (nloc == 0u) { xcd_barrier_complete(bar, b.x, nloc, nx); b.st[0] = nloc; b.st[1] = nx; }
        const unsigned old = xb_add(&bar[XB_XSUB(b.x)], 1u);
        const unsigned gen = old / nloc;
        if (old + 1u == (gen + 1u) * nloc) {
            __builtin_amdgcn_fence(__ATOMIC_RELEASE, "agent");
            asm volatile("s_waitcnt vmcnt(0)" ::: "memory");
            const unsigned og = xb_add(&bar[XB_TOP], 1u);
            const unsigned tg = og / nx;
            if (og + 1u == (tg + 1u) * nx) xb_add(&bar[XB_TOPGEN], 1u);
            else XB_SPIN(xb_ld(&bar[XB_TOPGEN]) == tg, bar);
            __builtin_amdgcn_fence(__ATOMIC_ACQUIRE, "agent");
            xb_add(&bar[XB_XGEN(b.x)], 1u);
            asm volatile("s_waitcnt vmcnt(0)" ::: "memory");
        } else {
            XB_SPIN(xb_ld(&bar[XB_XGEN(b.x)]) == gen, bar);
            __builtin_amdgcn_fence(__ATOMIC_ACQUIRE, "agent");
            asm volatile("s_waitcnt vmcnt(0)" ::: "memory");
        }
    }
    __syncthreads();
}

constexpr int CTL_BAR = 16384;
constexpr int MK_LDS = 163840;
constexpr int MK_ST_OFF = MK_LDS - 16;
static_assert(S5_LDS <= MK_ST_OFF && FF_LDS <= MK_ST_OFF && RT_LDS <= MK_ST_OFF && TB_OFF + TB_BYTES <= MK_ST_OFF && TB_OFF >= pg8::STAGE_BYTES, "LDS map");
static_assert(4 * (4096 + 4096 + 8448 + 16384) <= MK_ST_OFF, "prep LDS");
#ifndef MK_REP
#define MK_REP -1
#endif
constexpr int MK_PT_OFF = MK_ST_OFF - 256;
static_assert(S5_LDS <= MK_PT_OFF && RT_LDS <= MK_PT_OFF && TB_OFF + TB_BYTES <= MK_PT_OFF, "LDS map (pointer table)");
DI Params ldp(const unsigned char* lds) {
    Params p; unsigned long long* d = (unsigned long long*)&p; const unsigned* t = (const unsigned*)(lds + MK_PT_OFF);
#pragma unroll
    for (int i = 0; i < 32; ++i) { const unsigned lo = __builtin_amdgcn_readfirstlane(t[2 * i]), hi = __builtin_amdgcn_readfirstlane(t[2 * i + 1]); d[i] = ((unsigned long long)hi << 32) | lo; }
    return p;
}
#define RUNPH(k, body) do { { const Params p = ldp(lds); body; } if (MK_REP == (k)) { xcd_barrier(bar); { const Params p = ldp(lds); body; } } } while (0)
__global__ void __launch_bounds__(NT, 2) mega_kernel(Params pk) {
    extern __shared__ __attribute__((aligned(16))) unsigned char lds[];
    const int bid = blockIdx.x, nb = gridDim.x;
    static_assert(sizeof(Params) == 256, "Params = 32 pointers");
    if (tidx() < 64) ((unsigned*)(lds + MK_PT_OFF))[tidx()] = ((const unsigned*)&pk)[tidx()];
    if (tidx() < 4) ((unsigned*)(lds + MK_ST_OFF))[tidx()] = 0u;
    __syncthreads();
    XcdBarrier bar;
    { const Params p = ldp(lds); bar = xcd_barrier_post((unsigned*)(p.ws + WS_CTL + CTL_BAR), (volatile LAS unsigned*)(lds + MK_ST_OFF)); }
    RUNPH(0, phase0(p, lds, bid, nb));            xcd_barrier(bar);
    RUNPH(1, phase1a(p, bid, nb));                xcd_barrier(bar);
    RUNPH(2, phase1b(p, lds, bid, nb));           xcd_barrier(bar);
    RUNPH(3, phase2_s5(p, lds, bid, nb));
    RUNPH(4, phase2_fft(p, lds, bid, nb));        xcd_barrier(bar);
    RUNPH(5, phase3_glu(p, lds, bid, nb));        xcd_barrier(bar);
    RUNPH(6, phase3_fin(p, lds, bid, nb));        xcd_barrier(bar);
    RUNPH(7, phase4_out(p, lds, bid, nb));        xcd_barrier(bar);
    RUNPH(-2, phase5_route(p, lds, bid, nb));     xcd_barrier(bar);
    RUNPH(-2, build_tiles(p, lds));
    RUNPH(10, phase6_gateup(p, lds, bid, nb));    xcd_barrier(bar);
    RUNPH(11, phase7_down(p, lds, bid, nb));      xcd_barrier(bar);
    RUNPH(-2, phase8_final(p, lds, bid, nb));
}

extern "C" void kernel_launch(void* const* d_in, const int* in_sizes, int n_in, void* d_out, int out_size, void* d_ws, size_t ws_size, hipStream_t stream) {
    static int grid = 0;
    if (grid == 0) {
        if (n_in != 30 || ws_size < WS_END || out_size != NTOK * D) { fprintf(stderr, "kernel_launch: unexpected inputs (n_in %d, ws %zu, out %d)\n", n_in, ws_size, out_size); grid = -1; return; }
        int dev = 0, cus = 0, per_cu = 0;
        if (hipGetDevice(&dev) != hipSuccess || hipDeviceGetAttribute(&cus, hipDeviceAttributeMultiprocessorCount, dev) != hipSuccess) { grid = -1; return; }
        if (hipFuncSetAttribute((const void*)mega_kernel, hipFuncAttributeMaxDynamicSharedMemorySize, MK_LDS) != hipSuccess) { fprintf(stderr, "kernel_launch: hipFuncSetAttribute failed\n"); grid = -1; return; }
        if (hipOccupancyMaxActiveBlocksPerMultiprocessor(&per_cu, (const void*)mega_kernel, NT, MK_LDS) != hipSuccess || per_cu < 1) { fprintf(stderr, "kernel_launch: occupancy query says %d blocks/CU\n", per_cu); (void)hipGetLastError(); grid = -1; return; }
        grid = cus;
    }
    if (grid < 0) return;
    Params p{};
    const float** f = (const float**)&p;
    for (int i = 0; i < 30; ++i) f[i] = (const float*)d_in[i];
    p.out = (float*)d_out; p.ws = (unsigned char*)d_ws;
    (void)hipMemsetAsync((char*)d_ws + WS_CTL, 0, CTL_BYTES, stream);
    hipLaunchKernelGGL(mega_kernel, dim3(grid), dim3(NT), MK_LDS, stream, p);
}
```

```cpp
#include <hip/hip_runtime.h>
#include <cstdio>
#include <cstdint>

typedef unsigned short bf16;
typedef short bf16x8 __attribute__((ext_vector_type(8)));
typedef short bf16x4 __attribute__((ext_vector_type(4)));
typedef float f32x4 __attribute__((ext_vector_type(4)));
typedef unsigned u32x4 __attribute__((ext_vector_type(4)));
typedef unsigned u32x2 __attribute__((ext_vector_type(2)));
typedef __bf16 bf16v2 __attribute__((ext_vector_type(2)));
#define DI __device__ __forceinline__

constexpr int D = 1024, NB = 8, L = 4096, CTX = 256, NTOK = NB * L, NCTX = NB * CTX, NROWS1 = NTOK + NCTX;
constexpr int NEXP = 32, DE = 256;
constexpr float EPS = 1e-6f;
constexpr int NT = 512;

constexpr size_t MiB = 1u << 20;
constexpr size_t WS_CTL = 0;
constexpr size_t CTL_BYTES = 1 * MiB;
constexpr size_t CTL_ZERO = 4096;
#ifndef MK_TS1
#define MK_TS1 -1
#endif
#ifndef MK_TS2
#define MK_TS2 -1
#endif
constexpr size_t CTL_TS = 12288;
constexpr size_t CTL_ECNT = 8192;
constexpr size_t CTL_PCNT = 8192 + 256;
constexpr size_t CTL_RSQ1 = 256 * 1024;
constexpr size_t CTL_RSQ2 = 384 * 1024;
constexpr size_t WS_MOD = 1 * MiB;
constexpr size_t WS_TILES = WS_MOD + 256 * 1024;
constexpr size_t WS_ABART = WS_TILES + 64 * 1024;
constexpr size_t WS_FFTC = 2 * MiB;
constexpr size_t WS_GW = 3 * MiB;
constexpr size_t WS_WINT = 4 * MiB;
constexpr size_t WS_WGLUT = 7 * MiB;
constexpr size_t WS_WOUTT = 8 * MiB;
constexpr size_t WS_WGUT = 10 * MiB;
constexpr size_t WS_WDT = 42 * MiB;
constexpr size_t WS_WST = 58 * MiB;
constexpr size_t WS_MGW = 66 * MiB;
constexpr size_t WS_ELIST = 90 * MiB;
constexpr size_t WS_ELCP = 94 * MiB;
constexpr size_t WS_ELW = 98 * MiB;
constexpr size_t WS_TCP = 102 * MiB;
constexpr size_t WS_R1 = 108 * MiB;
constexpr size_t WS_R2 = 176 * MiB;
constexpr size_t WS_R3 = 240 * MiB;
constexpr size_t WS_UCTX = 288 * MiB;
constexpr size_t WS_R4 = 290 * MiB;
constexpr size_t WS_R5 = 322 * MiB;
constexpr size_t WS_X1B = 290 * MiB;
constexpr size_t WS_A2 = 108 * MiB;
constexpr size_t WS_HS = 228 * MiB;
constexpr size_t WS_MOE = 108 * MiB;
constexpr size_t WS_RSQP1 = 354 * MiB;
constexpr size_t WS_RSQS = 356 * MiB;
constexpr size_t WS_RSS = 357 * MiB;
constexpr size_t WS_WRT = 358 * MiB;
constexpr size_t WS_END = 359 * MiB;

struct Params {
    const float *x, *c, *ctx, *c_ctx, *w_ada, *b_ada, *norm1_g, *norm2_g, *w_in;
    const float *lam_re, *lam_im, *b_re, *b_im, *c_re, *c_im, *log_step, *s5_d, *w_glu, *fourier_w, *g_s, *g_f, *w_out;
    const float *w_group, *b_group, *w_router, *b_router, *w_gate, *w_up, *w_down, *final_g;
    float* out; unsigned char* ws;
};

DI int tidx() { int t = threadIdx.x; asm volatile("" : "+v"(t)); return t; }
DI unsigned pk2(float lo, float hi) { bf16v2 v; v.x = (__bf16)lo; v.y = (__bf16)hi; return __builtin_bit_cast(unsigned, v); }
DI float bf2f(unsigned short b) { return __uint_as_float(((unsigned)b) << 16); }
DI float wave_sum(float v) {
#pragma unroll
    for (int o = 1; o < 64; o <<= 1) v += __shfl_xor(v, o);
    return v;
}
DI float sigmoidf_(float x) { return 1.f / (1.f + __expf(-x)); }
DI float siluf_(float x) { return x / (1.f + __expf(-x)); }
DI float geluf_(float x) { const float u = 0.7978845608028654f * (x + 0.044715f * x * x * x); return x / (1.f + __expf(-2.f * u)); }

template <int MT> struct GC {
    static constexpr int BM = 64 * MT, PA = MT, ABYTES = BM * 128, BBYTES = 128 * 128, BUF = ABYTES + BBYTES, LDS = 2 * BUF;
};
template <int MT>
DI void gemm_loop(f32x4 (&acc)[MT][4], const bf16* (&ap)[MT], const int (&as)[MT], const bf16* (&bp)[2], int nk, unsigned char* lds) {
    typedef GC<MT> G;
    const int tid = tidx(), lane = tid & 63, wid = tid >> 6, wm = wid >> 1, wn = wid & 1, fr = lane & 15, fq = lane >> 4;
    const int srow = tid >> 3, sck = tid & 7;
    const int soff = srow * 128 + ((sck ^ (srow & 7)) << 4);
    u32x4 ra[MT], rb[2];
#pragma unroll
    for (int i = 0; i < MT; ++i) ra[i] = *(const u32x4*)(ap[i]);
#pragma unroll
    for (int i = 0; i < 2; ++i) rb[i] = *(const u32x4*)(bp[i]);
#pragma unroll
    for (int i = 0; i < MT; ++i) *(u32x4*)(lds + i * 8192 + soff) = ra[i];
#pragma unroll
    for (int i = 0; i < 2; ++i) *(u32x4*)(lds + G::ABYTES + i * 8192 + soff) = rb[i];
    __syncthreads();
    const int aro = (wm * MT * 16 + fr) * 128, bro = (wn * 64 + fr) * 128;
    const int sw0 = ((0 + fq) ^ (fr & 7)) << 4, sw1 = ((4 + fq) ^ (fr & 7)) << 4;
    for (int kt = 0; kt < nk; ++kt) {
        const bool more = kt + 1 < nk;
        if (more) {
#pragma unroll
            for (int i = 0; i < MT; ++i) ra[i] = *(const u32x4*)(ap[i] + (size_t)(kt + 1) * as[i]);
#pragma unroll
            for (int i = 0; i < 2; ++i) rb[i] = *(const u32x4*)(bp[i] + (size_t)(kt + 1) * 64);
        }
        const unsigned char* Ab = lds + (kt & 1) * G::BUF; const unsigned char* Bb = Ab + G::ABYTES;
#pragma unroll
        for (int kk = 0; kk < 2; ++kk) {
            const int sw = kk ? sw1 : sw0;
            bf16x8 af[MT], bfr[4];
#pragma unroll
            for (int mt = 0; mt < MT; ++mt) af[mt] = *(const bf16x8*)(Ab + aro + mt * 2048 + sw);
#pragma unroll
            for (int nt = 0; nt < 4; ++nt) bfr[nt] = *(const bf16x8*)(Bb + bro + nt * 2048 + sw);
#pragma unroll
            for (int mt = 0; mt < MT; ++mt)
#pragma unroll
                for (int nt = 0; nt < 4; ++nt) acc[mt][nt] = __builtin_amdgcn_mfma_f32_16x16x32_bf16(bfr[nt], af[mt], acc[mt][nt], 0, 0, 0);
        }
        if (more) {
            unsigned char* nb = lds + ((kt + 1) & 1) * G::BUF;
#pragma unroll
            for (int i = 0; i < MT; ++i) *(u32x4*)(nb + i * 8192 + soff) = ra[i];
#pragma unroll
            for (int i = 0; i < 2; ++i) *(u32x4*)(nb + G::ABYTES + i * 8192 + soff) = rb[i];
        }
        __syncthreads();
    }
}
template <int MT>
DI void gemm_loop_alds(f32x4 (&acc)[MT][4], const unsigned char* abase, int apitch, const bf16* (&bp)[2], int nk, unsigned char* lds) {
    typedef GC<MT> G;
    const int tid = tidx(), lane = tid & 63, wid = tid >> 6, wm = wid >> 1, wn = wid & 1, fr = lane & 15, fq = lane >> 4;
    const int srow = tid >> 3, sck = tid & 7;
    const int soff = srow * 128 + ((sck ^ (srow & 7)) << 4);
    u32x4 rb[2];
#pragma unroll
    for (int i = 0; i < 2; ++i) rb[i] = *(const u32x4*)(bp[i]);
#pragma unroll
    for (int i = 0; i < 2; ++i) *(u32x4*)(lds + G::ABYTES + i * 8192 + soff) = rb[i];
    __syncthreads();
    const int bro = (wn * 64 + fr) * 128;
    const int sw0 = ((0 + fq) ^ (fr & 7)) << 4, sw1 = ((4 + fq) ^ (fr & 7)) << 4;
    const unsigned char* arow = abase + (size_t)(wm * MT * 16 + fr) * apitch + fq * 16;
    for (int kt = 0; kt < nk; ++kt) {
        const bool more = kt + 1 < nk;
        if (more) {
#pragma unroll
            for (int i = 0; i < 2; ++i) rb[i] = *(const u32x4*)(bp[i] + (size_t)(kt + 1) * 64);
        }
        const unsigned char* Bb = lds + (kt & 1) * G::BUF + G::ABYTES;
#pragma unroll
        for (int kk = 0; kk < 2; ++kk) {
            const int sw = kk ? sw1 : sw0;
            bf16x8 af[MT], bfr[4];
#pragma unroll
            for (int mt = 0; mt < MT; ++mt) af[mt] = *(const bf16x8*)(arow + (size_t)mt * 16 * apitch + kt * 128 + kk * 64);
#pragma unroll
            for (int nt = 0; nt < 4; ++nt) bfr[nt] = *(const bf16x8*)(Bb + bro + nt * 2048 + sw);
#pragma unroll
            for (int mt = 0; mt < MT; ++mt)
#pragma unroll
                for (int nt = 0; nt < 4; ++nt) acc[mt][nt] = __builtin_amdgcn_mfma_f32_16x16x32_bf16(bfr[nt], af[mt], acc[mt][nt], 0, 0, 0);
        }
        if (more) {
            unsigned char* nb = lds + ((kt + 1) & 1) * G::BUF;
#pragma unroll
            for (int i = 0; i < 2; ++i) *(u32x4*)(nb + G::ABYTES + i * 8192 + soff) = rb[i];
        }
        __syncthreads();
    }
}
template <int MT> DI void zero_acc(f32x4 (&acc)[MT][4]) {
#pragma unroll
    for (int m = 0; m < MT; ++m)
#pragma unroll
        for (int n = 0; n < 4; ++n) acc[m][n] = (f32x4){0.f, 0.f, 0.f, 0.f};
}

namespace pg8 {
#define PG8_LAS __attribute__((address_space(3)))
constexpr int BM = 256, BK = 64, HALF = 128, HTB = HALF * BK * 2, STAGE_BYTES = 8 * HTB;
DI int lds_byte(int r, int c) { const int st = (r >> 4) * 2 + (c >> 5), rr = r & 15, cc = c & 31, ob = rr * 64 + cc * 2; return st * 1024 + (ob ^ (((ob >> 9) & 1) << 5)); }
DI void stage_rc(int b, int& R, int& C) { const int st = b / 1024, sb = b % 1024, swz = sb ^ (((sb >> 9) & 1) << 5); R = (st >> 1) * 16 + swz / 64; C = (st & 1) * 32 + (swz % 64) / 2; }
struct UPtr { const char *a0, *a1, *b0, *b1, *c0, *c1; };
template <class Pol, class Epi, bool ALIGN_EPI>
DI void gemm_phase(PG8_LAS unsigned char* lds, const Pol& P, const Epi& E) {
    typedef typename Pol::Unit Unit;
    const int tid = tidx(), wid = __builtin_amdgcn_readfirstlane(tid >> 6), lane = tid & 63, wr = wid >> 2, wc = wid & 3, fr = lane & 15, fq = lane >> 4;
    const int nt = P.K / BK, ksplit = P.ksplit;
    constexpr int NG = Pol::GATHER ? 2 : 1;
    int Rr[2], Cc[2]; unsigned voffB[2]; unsigned vAc[NG][2], vAn[NG][2];
#pragma unroll
    for (int i = 0; i < 2; ++i) { stage_rc(tid * 16 + i * 8192, Rr[i], Cc[i]); voffB[i] = (unsigned)(P.brow(Rr[i]) * P.ldb + Cc[i]) * 2u;
#pragma unroll
        for (int h = 0; h < NG; ++h) vAc[h][i] = vAn[h][i] = (unsigned)(Rr[i] * P.lda + Cc[i]) * 2u; }
#define PG8_VC(h) vAc[Pol::GATHER ? (h) : 0]
#define PG8_V2(h) v2[Pol::GATHER ? (h) : 0]
    const size_t kstep = (size_t)(BK * 2);
    const unsigned ldsw = (unsigned)wid * 1024u;
    const int aoff = lds_byte(wr * 64 + fr, fq * 8), boff = lds_byte(wc * 32 + fr, fq * 8);
#define PG8_SA(b, h) (((b) * 2 + (h)) * HTB)
#define PG8_SB(b, h) ((4 + (b) * 2 + (h)) * HTB)
#define PG8_STAGE(bufoff, gbase, voff) do { _Pragma("unroll") for (int _i = 0; _i < 2; ++_i) \
        __builtin_amdgcn_global_load_lds((const unsigned*)((const char*)(gbase) + (voff)[_i]), (PG8_LAS unsigned*)(lds + (bufoff) + ldsw + _i * 8192), 16, 0, 0); } while (0)
#define PG8_LDA(dst, b, h) do { _Pragma("unroll") for (int m = 0; m < 4; ++m) _Pragma("unroll") for (int k = 0; k < 2; ++k) dst[m][k] = *(const PG8_LAS bf16x8*)(lds + PG8_SA(b, h) + aoff + m * 2048 + k * 1024); } while (0)
#define PG8_LDB(dst, b, h) do { _Pragma("unroll") for (int n = 0; n < 2; ++n) _Pragma("unroll") for (int k = 0; k < 2; ++k) dst[n][k] = *(const PG8_LAS bf16x8*)(lds + PG8_SB(b, h) + boff + n * 2048 + k * 1024); } while (0)
#define PG8_MMA(ai, bj, At, Bt) do { __builtin_amdgcn_s_setprio(1); _Pragma("unroll") for (int m = 0; m < 4; ++m) _Pragma("unroll") for (int n = 0; n < 2; ++n) _Pragma("unroll") for (int k = 0; k < 2; ++k) \
        acc[ai][bj][m][n] = __builtin_amdgcn_mfma_f32_16x16x32_bf16(Bt[n][k], At[m][k], acc[ai][bj][m][n], 0, 0, 0); __builtin_amdgcn_s_setprio(0); } while (0)
#define PG8_WAIT_V(n) asm volatile("s_waitcnt vmcnt(" #n ")" ::: "memory")
#define PG8_WAIT_L(n) asm volatile("s_waitcnt lgkmcnt(" #n ")" ::: "memory")
#define PG8_BAR __builtin_amdgcn_s_barrier()
#define PG8_SCHED __builtin_amdgcn_sched_barrier(0)
#define PG8_BSEL(q, tk, h) ((tk) < ksplit ? (q).b##h + (size_t)(tk) * kstep : (q).c##h + (size_t)((tk) - ksplit) * kstep)
    Unit cur, nxt; UPtr cp, np_; int ui = 0;
    if (!P.next(0, cur)) return;
    P.ptrs(cur, cp);
    if constexpr (Pol::GATHER) P.gather(cur, Rr, Cc, vAc);
    f32x4 acc[2][2][4][2];
#pragma unroll
    for (int a = 0; a < 2; ++a)
#pragma unroll
        for (int b = 0; b < 2; ++b)
#pragma unroll
            for (int m = 0; m < 4; ++m)
#pragma unroll
                for (int n = 0; n < 2; ++n) acc[a][b][m][n] = (f32x4){0.f, 0.f, 0.f, 0.f};
    bf16x8 At[4][2], B0[2][2], B1[2][2];
    PG8_STAGE(PG8_SB(0, 0), cp.b0, voffB); PG8_STAGE(PG8_SB(0, 1), cp.b1, voffB); PG8_STAGE(PG8_SA(0, 0), cp.a0, PG8_VC(0)); PG8_STAGE(PG8_SA(0, 1), cp.a1, PG8_VC(1));
    if (wr == 1) PG8_BAR;
    PG8_WAIT_V(2); PG8_BAR;
    PG8_STAGE(PG8_SB(1, 0), cp.b0 + kstep, voffB); PG8_STAGE(PG8_SA(1, 0), cp.a0 + kstep, PG8_VC(0)); PG8_STAGE(PG8_SB(1, 1), cp.b1 + kstep, voffB);
    PG8_WAIT_V(6); PG8_BAR;
    for (;;) {
        const bool has_next = P.next(ui + 1, nxt);
        if (has_next) { P.ptrs(nxt, np_); if constexpr (Pol::GATHER) P.gather(nxt, Rr, Cc, vAn); }
        else { np_ = cp; if constexpr (Pol::GATHER) {
#pragma unroll
            for (int h = 0; h < 2; ++h)
#pragma unroll
                for (int i = 0; i < 2; ++i) vAn[h][i] = vAc[h][i]; } }
#pragma unroll 1
        for (int t = 0; t < nt; t += 2) {
            const bool last = (t == nt - 2);
            if constexpr (Epi::MIDK_T >= 0) { if (t == Epi::MIDK_T) E.midk(acc, cur, wr, wc, fr, fq); }
            const char* a1_1 = cp.a1 + (size_t)(t + 1) * kstep;
            const char *a2_0, *a2_1, *a3_0, *b2_0, *b2_1, *b3_0, *b3_1;
            unsigned v2[NG][2];
            if (!last) { a2_0 = cp.a0 + (size_t)(t + 2) * kstep; a2_1 = cp.a1 + (size_t)(t + 2) * kstep; a3_0 = cp.a0 + (size_t)(t + 3) * kstep;
                         b2_0 = PG8_BSEL(cp, t + 2, 0); b2_1 = PG8_BSEL(cp, t + 2, 1); b3_0 = PG8_BSEL(cp, t + 3, 0); b3_1 = PG8_BSEL(cp, t + 3, 1); }
            else { a2_0 = np_.a0; a2_1 = np_.a1; a3_0 = np_.a0 + kstep; b2_0 = np_.b0; b2_1 = np_.b1; b3_0 = np_.b0 + kstep; b3_1 = np_.b1 + kstep; }
#pragma unroll
            for (int h = 0; h < NG; ++h)
#pragma unroll
                for (int i = 0; i < 2; ++i) v2[h][i] = (Pol::GATHER && last) ? vAn[h][i] : vAc[h][i];
            PG8_LDB(B0, 0, 0); PG8_LDB(B1, 0, 1); PG8_SCHED; PG8_LDA(At, 0, 0); PG8_STAGE(PG8_SA(1, 1), a1_1, PG8_VC(1));
            PG8_WAIT_V(8); PG8_WAIT_L(0); PG8_BAR; PG8_MMA(0, 0, At, B0); PG8_MMA(0, 1, At, B1); PG8_BAR; PG8_SCHED;
            PG8_LDA(At, 0, 1); PG8_STAGE(PG8_SB(0, 0), b2_0, voffB); PG8_STAGE(PG8_SB(0, 1), b2_1, voffB); PG8_STAGE(PG8_SA(0, 0), a2_0, PG8_V2(0));
            PG8_WAIT_V(8); PG8_WAIT_L(0); PG8_BAR; PG8_MMA(1, 0, At, B0); PG8_MMA(1, 1, At, B1); PG8_BAR; PG8_SCHED;
            PG8_LDB(B0, 1, 0); PG8_LDB(B1, 1, 1); PG8_SCHED; PG8_LDA(At, 1, 0); PG8_STAGE(PG8_SA(0, 1), a2_1, PG8_V2(1));
            PG8_WAIT_V(8); PG8_WAIT_L(0); PG8_BAR; PG8_MMA(0, 0, At, B0); PG8_MMA(0, 1, At, B1); PG8_BAR; PG8_SCHED;
            PG8_LDA(At, 1, 1); PG8_STAGE(PG8_SB(1, 0), b3_0, voffB); PG8_STAGE(PG8_SB(1, 1), b3_1, voffB); PG8_STAGE(PG8_SA(1, 0), a3_0, PG8_V2(0));
            PG8_WAIT_V(8); PG8_WAIT_L(0); PG8_BAR; PG8_MMA(1, 0, At, B0); PG8_MMA(1, 1, At, B1); PG8_BAR; PG8_SCHED;
        }
        if constexpr (ALIGN_EPI) { if (wr == 0) PG8_BAR; }
        E(acc, cur, wr, wc, fr, fq);
        if (!has_next) break;
#pragma unroll
        for (int a = 0; a < 2; ++a)
#pragma unroll
            for (int b = 0; b < 2; ++b)
#pragma unroll
                for (int m = 0; m < 4; ++m)
#pragma unroll
                    for (int n = 0; n < 2; ++n) acc[a][b][m][n] = (f32x4){0.f, 0.f, 0.f, 0.f};
        cur = nxt; cp = np_; ++ui;
        if constexpr (Pol::GATHER) {
#pragma unroll
            for (int h = 0; h < 2; ++h)
#pragma unroll
                for (int i = 0; i < 2; ++i) vAc[h][i] = vAn[h][i]; }
        if constexpr (ALIGN_EPI) { if (wr == 1) PG8_BAR; }
    }
    PG8_WAIT_V(0);
    if constexpr (!ALIGN_EPI) { if (wr == 0) PG8_BAR; }
    PG8_BAR;
#undef PG8_SA
#undef PG8_SB
#undef PG8_STAGE
#undef PG8_LDA
#undef PG8_LDB
#undef PG8_MMA
#undef PG8_WAIT_V
#undef PG8_WAIT_L
#undef PG8_BAR
#undef PG8_SCHED
#undef PG8_BSEL
#undef PG8_VC
#undef PG8_V2
}
struct DenseOrder {
    int nM, nN, nwg, G, c;
    DI void init(int nM_, int nN_, int G_, int c_) { nM = nM_; nN = nN_; nwg = nM * nN; G = G_; c = c_; }
    DI bool get(int i, int& pm, int& pn) const {
        const long L = (long)i * G + c; if (L >= nwg) return false;
        int wgid = (int)L; { const int q = nwg / 8, r = nwg % 8, xcd = wgid % 8, off = wgid / 8; wgid = (xcd < r ? xcd * (q + 1) : r * (q + 1) + (xcd - r) * q) + off; }
        const int nig = 8 * nN, gid = wgid / nig, fm = gid * 8, gsz = (nM - fm) < 8 ? (nM - fm) : 8;
        pm = fm + ((wgid % nig) % gsz); pn = (wgid % nig) / gsz; return true;
    }
};
}

DI void adaln_item(const Params& p, unsigned char* lds, int item) {
    float* scond = (float*)lds;
    float* red = scond + 9 * 1024;
    const int tid = tidx();
    for (int i = tid; i < 9 * 1024; i += NT) { const int r = i >> 10, k = i & 1023; const float v = r < 8 ? p.c[r * 1024 + k] : p.c_ctx[k]; scond[i] = v / (1.f + __expf(-v)); }
    __syncthreads();
    const int cc = tid & 63, ks = tid >> 6, col = item * 64 + cc;
    float a[9];
#pragma unroll
    for (int r = 0; r < 9; ++r) a[r] = 0.f;
#pragma unroll 1
    for (int kb = 0; kb < 8; ++kb) {
        const int kbase = ks * 128 + kb * 16; float w[16];
#pragma unroll
        for (int u = 0; u < 16; ++u) w[u] = p.w_ada[(size_t)(kbase + u) * 6144 + col];
#pragma unroll
        for (int u = 0; u < 16; ++u)
#pragma unroll
            for (int r = 0; r < 9; ++r) a[r] += scond[r * 1024 + kbase + u] * w[u];
    }
#pragma unroll
    for (int r = 0; r < 9; ++r) red[(ks * 9 + r) * 64 + cc] = a[r];
    __syncthreads();
    float* mod = (float*)(p.ws + WS_MOD);
    for (int o = tid; o < 9 * 64; o += NT) { const int r = o >> 6, c2 = o & 63; float s = 0.f;
#pragma unroll
        for (int q = 0; q < 8; ++q) s += red[(q * 9 + r) * 64 + c2];
        mod[r * 6144 + item * 64 + c2] = s + p.b_ada[item * 64 + c2]; }
    __syncthreads();
}
DI void tp_tile(const float* src, int ld, int k0, int n0, unsigned char* lds, bf16* dst, int jobkind, int e, const float* kscale = nullptr) {
    const int lane = tidx() & 63, wid = tidx() >> 6;
    float* tile = (float*)lds + wid * (64 * 65);
    { float v[64];
#pragma unroll
      for (int kk = 0; kk < 64; ++kk) v[kk] = src[(size_t)(k0 + kk) * ld + n0 + lane];
#pragma unroll
      for (int kk = 0; kk < 64; ++kk) tile[kk * 65 + lane] = kscale ? v[kk] * kscale[k0 + kk] : v[kk]; }
    asm volatile("s_waitcnt lgkmcnt(0)" ::: "memory");
    const int kc = lane & 7;
#pragma unroll
    for (int j = 0; j < 8; ++j) { const int n = (lane >> 3) + 8 * j, ng = n0 + n;
      u32x4 o;
      o.x = pk2(tile[(kc * 8 + 0) * 65 + n], tile[(kc * 8 + 1) * 65 + n]); o.y = pk2(tile[(kc * 8 + 2) * 65 + n], tile[(kc * 8 + 3) * 65 + n]);
      o.z = pk2(tile[(kc * 8 + 4) * 65 + n], tile[(kc * 8 + 5) * 65 + n]); o.w = pk2(tile[(kc * 8 + 6) * 65 + n], tile[(kc * 8 + 7) * 65 + n]);
      size_t drow; int K;
      switch (jobkind) {
        case 0: drow = ng; K = 1024; break;
        case 1: drow = ng; K = 512; break;
        case 2: drow = ng; K = 1024; break;
        case 3: case 4: { const int h = ng, R = (h >> 7) * 256 + (jobkind == 4 ? 128 : 0) + (h & 127); drow = (size_t)e * 512 + R; K = 1024; } break;
        default: drow = (size_t)e * 1024 + ng; K = 256; break;
      }
      *(u32x4*)(dst + drow * K + k0 + kc * 8) = o; }
    asm volatile("s_waitcnt lgkmcnt(0)" ::: "memory");
}
constexpr int TP_J0 = 16 * 8, TP_J1 = 8 * 8, TP_J2 = 16 * 16, TP_J3 = 32 * 16 * 4, TP_J4 = TP_J3, TP_J5 = 32 * 4 * 16;
constexpr int TP_ITEMS = TP_J0 + TP_J1 + TP_J2 + TP_J3 + TP_J4 + TP_J5;
DI void tp_item(const Params& p, unsigned char* lds, int it) {
    unsigned char* ws = p.ws;
    if (it < TP_J0) { tp_tile(p.w_in, 1024, (it >> 3) * 64, (it & 7) * 64, lds, (bf16*)(ws + WS_WINT), 0, 0); return; } it -= TP_J0;
    if (it < TP_J1) { tp_tile(p.w_glu, 512, (it >> 3) * 64, (it & 7) * 64, lds, (bf16*)(ws + WS_WGLUT), 1, 0); return; } it -= TP_J1;
    if (it < TP_J2) { tp_tile(p.w_out, 1024, (it >> 4) * 64, (it & 15) * 64, lds, (bf16*)(ws + WS_WOUTT), 2, 0, (it >> 4) * 64 < 512 ? p.g_s : nullptr); return; } it -= TP_J2;
    if (it < TP_J3) { const int e = it >> 6, r = it & 63; tp_tile(p.w_gate + (size_t)e * 1024 * 256, 256, (r >> 2) * 64, (r & 3) * 64, lds, (bf16*)(ws + WS_WGUT), 3, e); return; } it -= TP_J3;
    if (it < TP_J4) { const int e = it >> 6, r = it & 63; tp_tile(p.w_up + (size_t)e * 1024 * 256, 256, (r >> 2) * 64, (r & 3) * 64, lds, (bf16*)(ws + WS_WGUT), 4, e); return; } it -= TP_J4;
    { const int e = it >> 6, r = it & 63; tp_tile(p.w_down + (size_t)e * 256 * 1024, 1024, (r >> 4) * 64, (r & 15) * 64, lds, (bf16*)(ws + WS_WDT), 5, e); }
}
DI void gfold_item(const Params& p, unsigned char* lds, int item) {
    const int q = item >> 6, k0 = (item & 63) * 16, tid = tidx();
    constexpr int TP = 129;
    float* wv = (float*)lds;
    float* T = wv + 16 * 128;
    float* fw = T + 32 * TP;
    float* cs = fw + 128 * 128;
    float* sn = cs + 128;
    for (int i = tid; i < 16 * 128; i += NT) wv[i] = p.w_in[(size_t)(k0 + (i >> 7)) * 1024 + 512 + 128 * q + (i & 127)];
    for (int i = tid; i < 128 * 128; i += NT) fw[i] = p.fourier_w[(size_t)q * 128 * 128 + i];
    if (tid < 128) { double s, c; sincospi((double)tid / 64.0, &s, &c); cs[tid] = (float)c; sn[tid] = (float)s; }
    __syncthreads();
    { const int n = tid & 127, r0 = (tid >> 7) * 4;
      float sr[4] = {0.f, 0.f, 0.f, 0.f}, si[4] = {0.f, 0.f, 0.f, 0.f};
      for (int m = 0; m < 128; ++m) { const int ix = (n * m) & 127; const float c = cs[ix], sv = sn[ix];
#pragma unroll
          for (int r = 0; r < 4; ++r) { const float w = wv[(r0 + r) * 128 + m]; sr[r] += w * c; si[r] -= w * sv; } }
#pragma unroll
      for (int r = 0; r < 4; ++r) { T[((r0 + r) * 2 + 0) * TP + n] = sr[r]; T[((r0 + r) * 2 + 1) * TP + n] = si[r]; } }
    __syncthreads();
    bf16* WinT = (bf16*)(p.ws + WS_WINT);
    const float scale = 1.0f / 724.0773439350247f;
    for (int o = tid; o < 16 * 2 * 128; o += NT) { const int r = o & 15, c = (o >> 4) & 1, j = o >> 5; float s = 0.f;
        for (int n = 0; n < 128; ++n) s += T[(r * 2 + c) * TP + n] * fw[n * 128 + j];
        WinT[(size_t)(512 + c * 512 + q * 128 + j) * 1024 + k0 + r] = (bf16)(pk2(s * scale, 0.f) & 0xffffu); }
    __syncthreads();
}
DI void s5mats_item(const Params& p, unsigned char* lds, int item) {
    const int g = item >> 2, part = item & 3;
    const int tid = tidx();
    float* Bb = (float*)lds;
    float* Cc = Bb + 4096;
    float* pw = Cc + 4096;
    float* Kt = pw + 8448;
    for (int idx = tid; idx < 2 * 64 * 33; idx += NT) { const int d = idx / (64 * 33), rem = idx % (64 * 33), pp = rem / 33, k = rem % 33;
        const double dt = exp((double)p.log_step[d * 32 + g]); const double lr = p.lam_re[(d * 32 + g) * 64 + pp], li = p.lam_im[(d * 32 + g) * 64 + pp];
        const double mag = exp(lr * dt * k); double tt = li * dt * k / 3.14159265358979323846; tt -= 2.0 * floor(tt * 0.5);
        double s, c; sincospi(tt, &s, &c); pw[idx * 2] = (float)(mag * c); pw[idx * 2 + 1] = (float)(mag * s); }
    for (int idx = tid; idx < 2 * 64 * 16; idx += NT) { const int d = idx >> 10, pp = (idx >> 4) & 63, h = idx & 15;
        const double dt = exp((double)p.log_step[d * 32 + g]); const double lr = p.lam_re[(d * 32 + g) * 64 + pp], li = p.lam_im[(d * 32 + g) * 64 + pp];
        const double mag = exp(lr * dt); double tt = li * dt / 3.14159265358979323846; tt -= 2.0 * floor(tt * 0.5);
        double s, c; sincospi(tt, &s, &c); const double nr = mag * c - 1.0, ni = mag * s, den = lr * lr + li * li;
        const double qr = (nr * lr + ni * li) / den, qi = (ni * lr - nr * li) / den;
        const double br = p.b_re[((size_t)(d * 32 + g) * 64 + pp) * 16 + h], bi = p.b_im[((size_t)(d * 32 + g) * 64 + pp) * 16 + h];
        Bb[idx * 2] = (float)(qr * br - qi * bi); Bb[idx * 2 + 1] = (float)(qr * bi + qi * br); }
    for (int idx = tid; idx < 2 * 16 * 64; idx += NT) { const int d = idx >> 10, i = (idx >> 6) & 15, pp = idx & 63;
        Cc[idx * 2] = p.c_re[((size_t)(d * 32 + g) * 16 + i) * 64 + pp]; Cc[idx * 2 + 1] = p.c_im[((size_t)(d * 32 + g) * 16 + i) * 64 + pp]; }
    __syncthreads();
    for (int id4 = tid; id4 < 4096; id4 += NT) { const int d = id4 >> 11, k = (id4 >> 6) & 31, i = part * 4 + ((id4 >> 4) & 3), h = id4 & 15; const int idx = ((d * 32 + k) * 16 + i) * 16 + h; float s = 0.f;
        for (int pp = 0; pp < 64; ++pp) { const float cr = Cc[((d * 16 + i) * 64 + pp) * 2], ci = Cc[((d * 16 + i) * 64 + pp) * 2 + 1];
            const float wr = pw[((d * 64 + pp) * 33 + k) * 2], wi = pw[((d * 64 + pp) * 33 + k) * 2 + 1];
            const float xr = cr * wr - ci * wi, xi = cr * wi + ci * wr;
            s += xr * Bb[((d * 64 + pp) * 16 + h) * 2] - xi * Bb[((d * 64 + pp) * 16 + h) * 2 + 1]; }
        Kt[idx] = s; }
    __syncthreads();
    bf16* Mg = (bf16*)(p.ws + WS_MGW) + (size_t)g * 512 * 768;
    for (int c4 = tid; c4 < 128 * 64; c4 += NT) { const int rq = c4 >> 6, c8 = c4 & 63, j = rq >> 2, i = part * 4 + (rq & 3), row = j * 16 + i, s = c8 >> 1, h0 = (c8 & 1) * 8; float v[8];
#pragma unroll
        for (int t = 0; t < 8; ++t) { float a = 0.f; if (s <= j) a += Kt[((0 * 32 + (j - s)) * 16 + i) * 16 + h0 + t]; if (s >= j) a += Kt[((1 * 32 + (s - j)) * 16 + i) * 16 + h0 + t]; v[t] = a; }
        u32x4 o; o.x = pk2(v[0], v[1]); o.y = pk2(v[2], v[3]); o.z = pk2(v[4], v[5]); o.w = pk2(v[6], v[7]);
        *(u32x4*)(Mg + (size_t)row * 768 + c8 * 8) = o; }
    bf16* Wst = (bf16*)(p.ws + WS_WST) + (size_t)g * 256 * 512;
    for (int c4 = tid; c4 < 64 * 64; c4 += NT) { const int r = part * 64 + (c4 >> 6), c8 = c4 & 63, s = c8 >> 1, h0 = (c8 & 1) * 8, d = r >> 7, c = (r >> 6) & 1, pp = r & 63;
        const int e = d == 0 ? 31 - s : s; const float wr = pw[((d * 64 + pp) * 33 + e) * 2], wi = pw[((d * 64 + pp) * 33 + e) * 2 + 1]; float v[8];
#pragma unroll
        for (int t = 0; t < 8; ++t) { const float br = Bb[((d * 64 + pp) * 16 + h0 + t) * 2], bi = Bb[((d * 64 + pp) * 16 + h0 + t) * 2 + 1]; v[t] = c == 0 ? wr * br - wi * bi : wr * bi + wi * br; }
        u32x4 o; o.x = pk2(v[0], v[1]); o.y = pk2(v[2], v[3]); o.z = pk2(v[4], v[5]); o.w = pk2(v[6], v[7]);
        *(u32x4*)(Wst + (size_t)r * 512 + c8 * 8) = o; }
    bf16* Wos = (bf16*)(p.ws + WS_MGW) + (size_t)g * 512 * 768 + 512;
    for (int c4 = tid; c4 < 128 * 32; c4 += NT) { const int rq = c4 >> 5, c8 = c4 & 31, j = rq >> 2, i = part * 4 + (rq & 3), row = j * 16 + i, col0 = c8 * 8, d = col0 >> 7, c = (col0 >> 6) & 1, p0 = col0 & 63;
        const int e = d == 0 ? j + 1 : 32 - j; float v[8];
#pragma unroll
        for (int t = 0; t < 8; ++t) { const int pp = p0 + t; const float cr = Cc[((d * 16 + i) * 64 + pp) * 2], ci = Cc[((d * 16 + i) * 64 + pp) * 2 + 1];
            const float wr = pw[((d * 64 + pp) * 33 + e) * 2], wi = pw[((d * 64 + pp) * 33 + e) * 2 + 1]; v[t] = c == 0 ? cr * wr - ci * wi : -(cr * wi + ci * wr); }
        u32x4 o; o.x = pk2(v[0], v[1]); o.y = pk2(v[2], v[3]); o.z = pk2(v[4], v[5]); o.w = pk2(v[6], v[7]);
        *(u32x4*)(Wos + (size_t)row * 768 + c8 * 8) = o; }
    float* aT = (float*)(p.ws + WS_ABART) + g * 256;
    if (part == 0 && tid < 128) { const int d = tid >> 6, pp = tid & 63; aT[tid * 2] = pw[((d * 64 + pp) * 33 + 32) * 2]; aT[tid * 2 + 1] = pw[((d * 64 + pp) * 33 + 32) * 2 + 1]; }
    __syncthreads();
}
DI void fftc_item(const Params& p, int item) {
    const int tid = tidx();
    bf16* W1 = (bf16*)(p.ws + WS_FFTC);
    bf16* W2 = W1 + 128 * 128;
    float* tw = (float*)(p.ws + WS_FFTC + 32768 + 16384);
    for (int idx = item * NT + tid; idx < 128 * 128 + 4 * 64 * 32 + 4096; idx += 8 * NT) {
        if (idx < 16384) { const int n = idx >> 7, k = idx & 127, co = n >> 6, d = n & 63, ci = k >> 6, bq = k & 63; double s, c; sincospi((double)((d * bq) & 63) / 32.0, &s, &c);
            const float v = (ci == co) ? (float)c : (ci == 1 ? (float)s : (float)(-s)); W1[idx] = (bf16)(pk2(v, 0.f) & 0xffffu); }
        else if (idx < 16384 + 8192) { const int i2 = idx - 16384, s_ = i2 >> 11, cf = (i2 >> 5) & 63, slot = i2 & 31, gq = slot >> 3, jp = slot & 7;
            const int a = 16 * (2 * (s_ & 1) + (jp >> 2)) + 4 * gq + (jp & 3); double s, c; sincospi((double)((cf * a) & 63) / 32.0, &s, &c);
            W2[i2] = (bf16)(pk2((s_ >> 1) == 0 ? (float)c : (float)s, 0.f) & 0xffffu); }
        else { const int i3 = idx - 16384 - 8192, ln = i3 & 63, r = (i3 >> 6) & 3, mt = (i3 >> 8) & 3, nt = i3 >> 10; const int d = 16 * nt + (ln & 15), a = 16 * mt + 4 * (ln >> 4) + r;
            double s, c; sincospi((double)((d * a) & 4095) / 2048.0, &s, &c); tw[i3 * 2] = (float)c; tw[i3 * 2 + 1] = (float)s; }
    }
}
constexpr int P0_S5 = 128, P0_GF = 256, P0_ADA = 96, P0_FC = 8, P0_RW = 1;
constexpr int P0_ITEMS = P0_S5 + P0_GF + P0_ADA + P0_FC + P0_RW;
DI void rw_item(const Params& p) {
    bf16* W = (bf16*)(p.ws + WS_WRT);
    for (int i = tidx(); i < 48 * 1024; i += NT) { const int n = i >> 10, k = i & 1023; const float v = n < 4 ? p.w_group[k * 4 + n] : (n < 36 ? p.w_router[k * 32 + (n - 4)] : 0.f); W[i] = (bf16)(pk2(v, 0.f) & 0xffffu); }
}
DI void phase0(const Params& p, unsigned char* lds, int bid, int nb) {
    for (int it = bid; it < P0_ITEMS; it += nb) {
        int r = it;
        if (r < P0_S5) { s5mats_item(p, lds, r); continue; } r -= P0_S5;
        if (r < P0_GF) { gfold_item(p, lds, r); continue; } r -= P0_GF;
        if (r < P0_ADA) { adaln_item(p, lds, r); continue; } r -= P0_ADA;
        if (r < P0_FC) { fftc_item(p, r); continue; } r -= P0_FC;
        rw_item(p);
    }
    __syncthreads();
    const int wid = tidx() >> 6;
    for (int it = bid * 8 + wid; it < TP_ITEMS; it += nb * 8) tp_item(p, lds, it);
}

DI void phase1a(const Params& p, int bid, int nb) {
    const int lane = tidx() & 63, wave = tidx() >> 6;
    const float* mod = (const float*)(p.ws + WS_MOD);
    bf16* A1 = (bf16*)(p.ws + WS_R1);
    constexpr int RW = 4;
    for (int r0 = (bid * 8 + wave) * RW; r0 < NROWS1; r0 += nb * 8 * RW) {
        const float* src = r0 < NTOK ? p.x + (size_t)r0 * D : p.ctx + (size_t)(r0 - NTOK) * D;
        const int mr = r0 < NTOK ? (r0 >> 12) : 8;
        f32x4 v[RW][4]; float s[RW];
#pragma unroll
        for (int q = 0; q < RW; ++q)
#pragma unroll
            for (int j = 0; j < 4; ++j) v[q][j] = ((const f32x4*)(src + (size_t)q * D) + lane)[64 * j];
        f32x4 gm[4], sh[4];
#pragma unroll
        for (int j = 0; j < 4; ++j) { const int k = lane * 4 + 256 * j; gm[j] = *(const f32x4*)(p.norm1_g + k) * (*(const f32x4*)(mod + mr * 6144 + 1024 + k) + 1.f); sh[j] = *(const f32x4*)(mod + mr * 6144 + k); }
#pragma unroll
        for (int q = 0; q < RW; ++q) { float t = 0.f;
#pragma unroll
            for (int j = 0; j < 4; ++j) t += (v[q][j].x * v[q][j].x + v[q][j].y * v[q][j].y) + (v[q][j].z * v[q][j].z + v[q][j].w * v[q][j].w);
            s[q] = t; }
#pragma unroll
        for (int o = 1; o < 64; o <<= 1) {
#pragma unroll
            for (int q = 0; q < RW; ++q) s[q] += __shfl_xor(s[q], o); }
#pragma unroll
        for (int q = 0; q < RW; ++q) { const float rs = rsqrtf(s[q] * (1.f / D) + EPS); u32x2* o = (u32x2*)(A1 + (size_t)(r0 + q) * D) + lane;
#pragma unroll
            for (int j = 0; j < 4; ++j) { const f32x4 h = v[q][j] * rs * gm[j] + sh[j]; u32x2 w; w.x = pk2(h.x, h.y); w.y = pk2(h.z, h.w); o[64 * j] = w; } }
    }
}
struct G1uPol {
    struct Unit { int pm, pn; };
    static constexpr bool GATHER = false;
    pg8::DenseOrder ord; const char* A; const char* B; int K, ksplit, lda, ldb;
    DI bool next(int i, Unit& u) const { return ord.get(i, u.pm, u.pn); }
    DI void ptrs(const Unit& u, pg8::UPtr& q) const { q.a0 = A + (size_t)u.pm * 256 * lda * 2; q.a1 = q.a0 + (size_t)128 * lda * 2; q.b0 = B + (size_t)u.pn * 256 * ldb * 2; q.b1 = q.b0 + (size_t)128 * ldb * 2; q.c0 = q.b0; q.c1 = q.b1; }
    DI int brow(int R) const { return R; }
    DI void gather(const Unit&, int (&)[2], int (&)[2], unsigned (&)[2][2]) const {}
};
struct G1uEpi {
    static constexpr int MIDK_T = -1;
    bf16* Ul;
    DI void operator()(const f32x4 (&acc)[2][2][4][2], const G1uPol::Unit& u, int wr, int wc, int fr, int fq) const {
#pragma unroll
        for (int ai = 0; ai < 2; ++ai)
#pragma unroll
            for (int m = 0; m < 4; ++m) { const int row = u.pm * 256 + ai * 128 + wr * 64 + m * 16 + fr, b = row >> 12, l = row & 4095;
#pragma unroll
                for (int bj = 0; bj < 2; ++bj)
#pragma unroll
                    for (int n = 0; n < 2; ++n) { const int g = (u.pn * 256 + bj * 128 + wc * 32 + n * 16) >> 4;
                        u32x2 w; w.x = pk2(acc[ai][bj][m][n][0], acc[ai][bj][m][n][1]); w.y = pk2(acc[ai][bj][m][n][2], acc[ai][bj][m][n][3]);
                        *(u32x2*)(Ul + (((size_t)g * 1024 + b * 128 + (l >> 5)) * 768 + (l & 31) * 16 + 4 * fq)) = w; } }
    }
};
struct G1gPol {
    struct Unit { int pm, pn; };
    static constexpr bool GATHER = false;
    pg8::DenseOrder ord; const char* A; const char* B; int K, ksplit, lda, ldb;
    DI bool next(int i, Unit& u) const { return ord.get(i, u.pm, u.pn); }
    DI void ptrs(const Unit& u, pg8::UPtr& q) const { q.a0 = A + (size_t)u.pm * 256 * lda * 2; q.a1 = q.a0 + (size_t)128 * lda * 2;
        const int b = u.pn >> 4, a0 = (u.pn & 15) * 4; q.b0 = B + (size_t)(b * 4096 + a0) * ldb * 2; q.b1 = q.b0 + (size_t)2 * ldb * 2; q.c0 = q.b0; q.c1 = q.b1; }
    DI int brow(int R) const { return (R & 63) * 64 + (R >> 6); }
    DI void gather(const Unit&, int (&)[2], int (&)[2], unsigned (&)[2][2]) const {}
};
struct G1gEpi {
    static constexpr int MIDK_T = -1;
    bf16* GT;
    DI void operator()(const f32x4 (&acc)[2][2][4][2], const G1gPol::Unit& u, int wr, int wc, int fr, int fq) const {
        const int b = u.pn >> 4, a0 = (u.pn & 15) * 4;
#pragma unroll
        for (int ai = 0; ai < 2; ++ai)
#pragma unroll
            for (int m = 0; m < 4; ++m) { const int mm = u.pm * 256 + ai * 128 + wr * 64 + m * 16 + fr, c = mm >> 9, ch = mm & 511;
                bf16* base = GT + (size_t)((b * 512 + ch) * 2 + c) * 4096;
#pragma unroll
                for (int bj = 0; bj < 2; ++bj)
#pragma unroll
                    for (int n = 0; n < 2; ++n) { const int a = a0 + 2 * bj + (wc >> 1), bq = 32 * (wc & 1) + 16 * n + 4 * fq;
                        u32x2 w; w.x = pk2(acc[ai][bj][m][n][0], acc[ai][bj][m][n][1]); w.y = pk2(acc[ai][bj][m][n][2], acc[ai][bj][m][n][3]);
                        *(u32x2*)(base + a * 64 + bq) = w; } }
    }
};
DI void phase1b(const Params& p, unsigned char* lds, int bid, int nb) {
    { G1gPol P; P.ord.init(4, NTOK / 256, nb, bid); P.A = (const char*)(p.ws + WS_WINT) + (size_t)512 * 2048; P.B = (const char*)(p.ws + WS_R1); P.K = 1024; P.ksplit = 16; P.lda = 1024; P.ldb = 1024;
      G1gEpi E{(bf16*)(p.ws + WS_R2)};
      pg8::gemm_phase<G1gPol, G1gEpi, true>((PG8_LAS unsigned char*)lds, P, E); }
    { G1uPol P; P.ord.init(NTOK / 256, 2, nb, bid); P.A = (const char*)(p.ws + WS_R1); P.B = (const char*)(p.ws + WS_WINT); P.K = 1024; P.ksplit = 16; P.lda = 1024; P.ldb = 1024;
      G1uEpi E{(bf16*)(p.ws + WS_R3)};
      pg8::gemm_phase<G1uPol, G1uEpi, true>((PG8_LAS unsigned char*)lds, P, E); }
    { const int tid = tidx(), lane = tid & 63, wid = tid >> 6, fr = lane & 15, fq = lane >> 4;
      for (int item = bid; item < 256; item += nb) { const int g = item >> 3, b = item & 7;
          const bf16* A1c = (const bf16*)(p.ws + WS_R1) + (size_t)(NTOK + b * 256 + wid * 32) * D; const bf16* Wg = (const bf16*)(p.ws + WS_WINT) + (size_t)(g * 16) * D;
          f32x4 ca[2] = {(f32x4){0.f, 0.f, 0.f, 0.f}, (f32x4){0.f, 0.f, 0.f, 0.f}};
#pragma unroll 8
          for (int ks = 0; ks < 32; ++ks) { const bf16x8 bw = *(const bf16x8*)(Wg + (size_t)fr * D + ks * 32 + fq * 8);
              const bf16x8 a0 = *(const bf16x8*)(A1c + (size_t)fr * D + ks * 32 + fq * 8), a1 = *(const bf16x8*)(A1c + (size_t)(16 + fr) * D + ks * 32 + fq * 8);
              ca[0] = __builtin_amdgcn_mfma_f32_16x16x32_bf16(bw, a0, ca[0], 0, 0, 0); ca[1] = __builtin_amdgcn_mfma_f32_16x16x32_bf16(bw, a1, ca[1], 0, 0, 0); }
          bf16* Ucw = (bf16*)(p.ws + WS_UCTX) + (size_t)(g * 8 + b) * 256 * 16;
#pragma unroll
          for (int mt = 0; mt < 2; ++mt) { u32x2 w; w.x = pk2(ca[mt][0], ca[mt][1]); w.y = pk2(ca[mt][2], ca[mt][3]); *(u32x2*)(Ucw + (size_t)(wid * 32 + mt * 16 + fr) * 16 + 4 * fq) = w; } } }
}
constexpr int S5_SB_OFF = GC<2>::LDS, S5_PITCH = 528, S5_LDS = S5_SB_OFF + 144 * S5_PITCH;
DI void phase2_s5(const Params& p, unsigned char* lds, int bid, int nb) {
    const int tid = tidx(), lane = tid & 63, wid = tid >> 6, wm = wid >> 1, wn = wid & 1, fr = lane & 15, fq = lane >> 4, srow = tid >> 3, sck = tid & 7;
    const bf16* zero = (const bf16*)(p.ws + WS_CTL + CTL_ZERO);
    unsigned char* Sb = lds + S5_SB_OFF;
    for (int item = bid; item < 256; item += nb) {
        const int g = item >> 3, b = item & 7;
        bf16* Ucat = (bf16*)(p.ws + WS_R3) + ((size_t)g * 1024 + b * 128) * 768;
        const bf16* Uc = (const bf16*)(p.ws + WS_UCTX) + (size_t)(g * 8 + b) * 256 * 16;
        const bf16* Wst = (const bf16*)(p.ws + WS_WST) + (size_t)g * 256 * 512;
        for (int pass = 0; pass < 4; ++pass) {
            const int n0 = (pass & 1) * 128, isctx = pass >> 1;
            f32x4 acc[2][4]; zero_acc<2>(acc);
            const bf16* ap[2]; int as[2]; const bf16* bp[2];
#pragma unroll
            for (int i = 0; i < 2; ++i) { const int r = 64 * i + srow;
                if (!isctx) { ap[i] = Ucat + (size_t)r * 768 + sck * 8; as[i] = 64; }
                else if (r < 8) { ap[i] = Uc + (size_t)r * 512 + sck * 8; as[i] = 64; }
                else { ap[i] = zero; as[i] = 0; }
                bp[i] = Wst + (size_t)(n0 + r) * 512 + sck * 8; }
            gemm_loop<2>(acc, ap, as, bp, 8, lds);
#pragma unroll
            for (int mt = 0; mt < 2; ++mt) { const int row = wm * 32 + mt * 16 + fr;
                if (!isctx || row < 8) {
#pragma unroll
                    for (int nt = 0; nt < 4; ++nt) { const int col = n0 + wn * 64 + nt * 16 + 4 * fq;
                        u32x2 w; w.x = pk2(acc[mt][nt][0], acc[mt][nt][1]); w.y = pk2(acc[mt][nt][2], acc[mt][nt][3]);
                        *(u32x2*)(Sb + (size_t)((isctx ? 128 : 0) + row) * S5_PITCH + col * 2) = w; } } }
        }
        __syncthreads();
        if (tid < 128) {
            const int d = tid >> 6, pp = tid & 63; const float* aT = (const float*)(p.ws + WS_ABART) + g * 256 + tid * 2; const float ar = aT[0], ai = aT[1];
            const bf16* colr = (const bf16*)Sb + d * 128 + pp; const bf16* coli = colr + 64; constexpr int RP = S5_PITCH / 2;
            bf16* outr = Ucat + 512 + d * 128 + pp; bf16* outi = outr + 64;
            float hr = 0.f, hi = 0.f;
            { float sr[8], si[8];
#pragma unroll
              for (int j = 0; j < 8; ++j) { const int c = d == 0 ? j : 7 - j; sr[j] = bf2f(colr[(128 + c) * RP]); si[j] = bf2f(coli[(128 + c) * RP]); }
#pragma unroll
              for (int j = 0; j < 8; ++j) { const float nr = ar * hr - ai * hi + sr[j], ni = ar * hi + ai * hr + si[j]; hr = nr; hi = ni; } }
#pragma unroll 1
            for (int cb = 0; cb < 128; cb += 16) { float sr[16], si[16];
#pragma unroll
                for (int j = 0; j < 16; ++j) { const int c = d == 0 ? cb + j : 127 - cb - j; sr[j] = bf2f(colr[c * RP]); si[j] = bf2f(coli[c * RP]); }
#pragma unroll
                for (int j = 0; j < 16; ++j) { const int c = d == 0 ? cb + j : 127 - cb - j; const unsigned w = pk2(hr, hi);
                    outr[(size_t)c * 768] = (bf16)(w & 0xffffu); outi[(size_t)c * 768] = (bf16)(w >> 16);
                    const float nr = ar * hr - ai * hi + sr[j], ni = ar * hi + ai * hr + si[j]; hr = nr; hi = ni; } }
        }
        __syncthreads();
    }
}
struct S5cPol {
    struct Unit { int g, mt, pn; };
    static constexpr bool GATHER = false;
    int G, c; const char* A; const char* B; int K, ksplit, lda, ldb;
    DI bool next(int i, Unit& u) const { const int L = i * G + c; if (L >= 256) return false; u.g = L >> 3; u.mt = (L >> 1) & 3; u.pn = L & 1; return true; }
    DI void ptrs(const Unit& u, pg8::UPtr& q) const { q.a0 = A + ((size_t)u.g * 1024 + u.mt * 256) * lda * 2; q.a1 = q.a0 + (size_t)128 * lda * 2; q.b0 = B + ((size_t)u.g * 512 + u.pn * 256) * ldb * 2; q.b1 = q.b0 + (size_t)128 * ldb * 2; q.c0 = q.b0; q.c1 = q.b1; }
    DI int brow(int R) const { return R; }
    DI void gather(const Unit&, int (&)[2], int (&)[2], unsigned (&)[2][2]) const {}
};
struct S5cEpi {
    static constexpr int MIDK_T = -1;
    const bf16* Ucat; const float* s5d; bf16* yact;
    DI void operator()(const f32x4 (&acc)[2][2][4][2], const S5cPol::Unit& u, int wr, int wc, int fr, int fq) const {
        const int n0 = u.pn * 256 + wc * 32 + 4 * fq;
        const f32x4 dd = *(const f32x4*)(s5d + u.g * 16 + 4 * fq);
        u32x2 uu[2][4][2][2];
#pragma unroll
        for (int ai = 0; ai < 2; ++ai)
#pragma unroll
            for (int m = 0; m < 4; ++m) { const int row = u.mt * 256 + ai * 128 + wr * 64 + m * 16 + fr;
#pragma unroll
                for (int bj = 0; bj < 2; ++bj)
#pragma unroll
                    for (int n = 0; n < 2; ++n) uu[ai][m][bj][n] = *(const u32x2*)(Ucat + ((size_t)u.g * 1024 + row) * 768 + n0 + bj * 128 + n * 16); }
#pragma unroll
        for (int ai = 0; ai < 2; ++ai)
#pragma unroll
            for (int m = 0; m < 4; ++m) { const int row = u.mt * 256 + ai * 128 + wr * 64 + m * 16 + fr, b = row >> 7, c = row & 127;
#pragma unroll
                for (int bj = 0; bj < 2; ++bj)
#pragma unroll
                    for (int n = 0; n < 2; ++n) { const int col = n0 + bj * 128 + n * 16, l = 32 * c + (col >> 4); const u32x2 v = uu[ai][m][bj][n]; const f32x4 a = acc[ai][bj][m][n];
                        const float y0 = geluf_(a[0] + dd.x * __uint_as_float(v.x << 16)), y1 = geluf_(a[1] + dd.y * __uint_as_float(v.x & 0xffff0000u));
                        const float y2 = geluf_(a[2] + dd.z * __uint_as_float(v.y << 16)), y3 = geluf_(a[3] + dd.w * __uint_as_float(v.y & 0xffff0000u));
                        u32x2 w; w.x = pk2(y0, y1); w.y = pk2(y2, y3);
                        *(u32x2*)(yact + ((size_t)(b * 4096 + l) * 512 + u.g * 16 + 4 * fq)) = w; } }
    }
};
DI void phase2c_s5out(const Params& p, unsigned char* lds, int bid, int nb) {
    S5cPol P; P.G = nb; P.c = bid; P.A = (const char*)(p.ws + WS_R3); P.B = (const char*)(p.ws + WS_MGW); P.K = 768; P.ksplit = 12; P.lda = 768; P.ldb = 768;
    S5cEpi E{(const bf16*)(p.ws + WS_R3), p.s5_d, (bf16*)(p.ws + WS_R4)};
    pg8::gemm_phase<S5cPol, S5cEpi, true>((PG8_LAS unsigned char*)lds, P, E);
}
constexpr int FF_W1P = 272, FF_W2P = 80, FF_W1_OFF = 0, FF_W2_OFF = 128 * FF_W1P, FF_TW_OFF = FF_W2_OFF + 4 * 64 * FF_W2P, FF_LDS = FF_TW_OFF + 32768;
DI void phase2_fft(const Params& p, unsigned char* lds, int bid, int nb) {
    const int tid = tidx(), lane = tid & 63, wid = tid >> 6, fr = lane & 15, fq = lane >> 4;
    { const bf16* W1 = (const bf16*)(p.ws + WS_FFTC); const bf16* W2 = W1 + 128 * 128; const float* tw = (const float*)(p.ws + WS_FFTC + 32768 + 16384);
      for (int i = tid; i < 128 * 16; i += NT) { const int n = i >> 4, c = i & 15; *(u32x4*)(lds + FF_W1_OFF + n * FF_W1P + c * 16) = *(const u32x4*)(W1 + n * 128 + c * 8); }
      for (int i = tid; i < 256 * 4; i += NT) { const int r = i >> 2, c = i & 3; *(u32x4*)(lds + FF_W2_OFF + r * FF_W2P + c * 16) = *(const u32x4*)(W2 + r * 32 + c * 8); }
      for (int i = tid; i < 2048; i += NT) *(u32x4*)(lds + FF_TW_OFF + i * 16) = *(const u32x4*)(tw + i * 4);
      __syncthreads(); }
    const bf16* GT = (const bf16*)(p.ws + WS_R2); bf16* FT = (bf16*)(p.ws + WS_R5);
    const float* twl = (const float*)(lds + FF_TW_OFF) + lane * 2;
    for (int cidx = bid * 8 + wid; cidx < 4096; cidx += nb * 8) {
        const bf16* gt = GT + (size_t)cidx * 2 * 4096;
        bf16* ft = FT + (size_t)cidx * 4096;
        bf16x8 afr[4][4];
#pragma unroll
        for (int ks = 0; ks < 4; ++ks)
#pragma unroll
            for (int mt = 0; mt < 4; ++mt) afr[ks][mt] = *(const bf16x8*)(gt + (ks >> 1) * 4096 + (16 * mt + fr) * 64 + 32 * (ks & 1) + 8 * fq);
        f32x4 d1[4][8];
#pragma unroll
        for (int m = 0; m < 4; ++m)
#pragma unroll
            for (int n = 0; n < 8; ++n) d1[m][n] = (f32x4){0.f, 0.f, 0.f, 0.f};
#pragma unroll
        for (int ks = 0; ks < 4; ++ks) {
#pragma unroll
            for (int nt = 0; nt < 8; ++nt) { const bf16x8 bfr = *(const bf16x8*)(lds + FF_W1_OFF + (nt * 16 + fr) * FF_W1P + (ks * 32 + fq * 8) * 2);
#pragma unroll
                for (int mt = 0; mt < 4; ++mt) d1[mt][nt] = __builtin_amdgcn_mfma_f32_16x16x32_bf16(afr[ks][mt], bfr, d1[mt][nt], 0, 0, 0); }
        }
#pragma unroll
        for (int nt = 0; nt < 4; ++nt) {
            unsigned pr[4][2], pi[4][2];
#pragma unroll
            for (int mt = 0; mt < 4; ++mt) { float tr[4], ti[4];
#pragma unroll
                for (int r = 0; r < 4; ++r) { const float cs = twl[((nt * 4 + mt) * 4 + r) * 128], sn = twl[((nt * 4 + mt) * 4 + r) * 128 + 1];
                    const float re = d1[mt][nt][r], im = d1[mt][nt + 4][r]; tr[r] = re * cs + im * sn; ti[r] = im * cs - re * sn; }
                pr[mt][0] = pk2(tr[0], tr[1]); pr[mt][1] = pk2(tr[2], tr[3]); pi[mt][0] = pk2(ti[0], ti[1]); pi[mt][1] = pk2(ti[2], ti[3]); }
            u32x4 f0, f1, f2, f3;
            f0.x = pr[0][0]; f0.y = pr[0][1]; f0.z = pr[1][0]; f0.w = pr[1][1];
            f1.x = pr[2][0]; f1.y = pr[2][1]; f1.z = pr[3][0]; f1.w = pr[3][1];
            f2.x = pi[0][0]; f2.y = pi[0][1]; f2.z = pi[1][0]; f2.w = pi[1][1];
            f3.x = pi[2][0]; f3.y = pi[2][1]; f3.z = pi[3][0]; f3.w = pi[3][1];
            bf16x8 frag[4];
            frag[0] = __builtin_bit_cast(bf16x8, f0); frag[1] = __builtin_bit_cast(bf16x8, f1); frag[2] = __builtin_bit_cast(bf16x8, f2); frag[3] = __builtin_bit_cast(bf16x8, f3);
            f32x4 z[4];
#pragma unroll
            for (int n = 0; n < 4; ++n) z[n] = (f32x4){0.f, 0.f, 0.f, 0.f};
#pragma unroll
            for (int s2 = 0; s2 < 4; ++s2)
#pragma unroll
                for (int n2 = 0; n2 < 4; ++n2) { const bf16x8 bfr = *(const bf16x8*)(lds + FF_W2_OFF + ((s2 * 64 + n2 * 16 + fr) * FF_W2P) + fq * 16);
                    z[n2] = __builtin_amdgcn_mfma_f32_16x16x32_bf16(frag[s2], bfr, z[n2], 0, 0, 0); }
#pragma unroll
            for (int n2 = 0; n2 < 4; ++n2) { const int cf = 16 * n2 + fr; u32x2 w; w.x = pk2(z[n2][0], z[n2][1]); w.y = pk2(z[n2][2], z[n2][3]);
                *(u32x2*)(ft + 64 * cf + 16 * nt + 4 * fq) = w; }
            __builtin_amdgcn_sched_barrier(0);
        }
    }
}
struct GluEpi {
    static constexpr int MIDK_T = -1;
    const bf16* yact; bf16* merged; float* rsqs;
    DI void operator()(const f32x4 (&acc)[2][2][4][2], const G1uPol::Unit& u, int wr, int wc, int fr, int fq) const {
        const int col0 = u.pn * 256 + wc * 32 + 4 * fq;
        u32x2 yy[2][4][2][2];
#pragma unroll
        for (int ai = 0; ai < 2; ++ai)
#pragma unroll
            for (int m = 0; m < 4; ++m) { const int row = u.pm * 256 + ai * 128 + wr * 64 + m * 16 + fr;
#pragma unroll
                for (int bj = 0; bj < 2; ++bj)
#pragma unroll
                    for (int n = 0; n < 2; ++n) yy[ai][m][bj][n] = *(const u32x2*)(yact + (size_t)row * 512 + col0 + bj * 128 + n * 16); }
#pragma unroll
        for (int ai = 0; ai < 2; ++ai)
#pragma unroll
            for (int m = 0; m < 4; ++m) { const int row = u.pm * 256 + ai * 128 + wr * 64 + m * 16 + fr; float sq = 0.f;
#pragma unroll
                for (int bj = 0; bj < 2; ++bj)
#pragma unroll
                    for (int n = 0; n < 2; ++n) { const u32x2 y = yy[ai][m][bj][n]; const f32x4 a = acc[ai][bj][m][n];
                        const float y0 = __uint_as_float(y.x << 16) * sigmoidf_(a[0]), y1 = __uint_as_float(y.x & 0xffff0000u) * sigmoidf_(a[1]);
                        const float y2 = __uint_as_float(y.y << 16) * sigmoidf_(a[2]), y3 = __uint_as_float(y.y & 0xffff0000u) * sigmoidf_(a[3]);
                        u32x2 w; w.x = pk2(y0, y1); w.y = pk2(y2, y3); *(u32x2*)(merged + (size_t)row * 1024 + col0 + bj * 128 + n * 16) = w; sq += (y0 * y0 + y1 * y1) + (y2 * y2 + y3 * y3); }
                sq += __shfl_xor(sq, 16); sq += __shfl_xor(sq, 32);
                if (fq == 0) rsqs[(size_t)row * 8 + u.pn * 4 + wc] = sq; }
    }
};
DI void phase3_glu(const Params& p, unsigned char* lds, int bid, int nb) {
    G1uPol P; P.ord.init(NTOK / 256, 2, nb, bid); P.A = (const char*)(p.ws + WS_R4); P.B = (const char*)(p.ws + WS_WGLUT); P.K = 512; P.ksplit = 8; P.lda = 512; P.ldb = 512;
    GluEpi E{(const bf16*)(p.ws + WS_R4), (bf16*)(p.ws + WS_R1), (float*)(p.ws + WS_RSQS)};
    pg8::gemm_phase<G1uPol, GluEpi, true>((PG8_LAS unsigned char*)lds, P, E);
}
constexpr int FM_PITCH = 132, FM_LDS = 512 * FM_PITCH;
DI void phase3_fin(const Params& p, unsigned char* lds, int bid, int nb) {
    const int tid = tidx(), lane = tid & 63, wid = tid >> 6;
    const bf16* FT = (const bf16*)(p.ws + WS_R5); bf16* merged = (bf16*)(p.ws + WS_R1);
    float gf[8];
#pragma unroll
    for (int j = 0; j < 8; ++j) gf[j] = p.g_f[lane + 64 * j];
    for (int item = bid; item < 512; item += nb) {
        const int b = item >> 6, k0 = (item & 63) * 64;
        { u32x4 v[8];
#pragma unroll
          for (int i = 0; i < 8; ++i) { const int ix = tid + NT * i, ch = ix >> 3, c = ix & 7; v[i] = *(const u32x4*)(FT + ((size_t)(b * 512 + ch) * 4096 + k0 + c * 8)); }
#pragma unroll
          for (int i = 0; i < 8; ++i) { const int ix = tid + NT * i, ch = ix >> 3, c = ix & 7; unsigned* d = (unsigned*)(lds + ch * FM_PITCH + c * 16); d[0] = v[i].x; d[1] = v[i].y; d[2] = v[i].z; d[3] = v[i].w; } }
        if (tid < 64) { const size_t row = (size_t)b * 4096 + k0 + tid; const f32x4* q = (const f32x4*)((const float*)(p.ws + WS_RSQS) + row * 8); const f32x4 q0 = q[0], q1 = q[1];
            ((float*)(p.ws + WS_RSS))[row] = rsqrtf((((q0.x + q0.y) + (q0.z + q0.w)) + ((q1.x + q1.y) + (q1.z + q1.w))) * (1.f / 512.f) + EPS); }
        __syncthreads();
        float f[8][8], s[8];
#pragma unroll
        for (int t = 0; t < 8; ++t)
#pragma unroll
            for (int j = 0; j < 8; ++j) f[t][j] = bf2f(*(const bf16*)(lds + (lane + 64 * j) * FM_PITCH + (wid * 8 + t) * 2));
#pragma unroll
        for (int t = 0; t < 8; ++t) { float a = 0.f;
#pragma unroll
            for (int j = 0; j < 8; ++j) a += f[t][j] * f[t][j];
            s[t] = a; }
#pragma unroll
        for (int o = 1; o < 64; o <<= 1) {
#pragma unroll
            for (int t = 0; t < 8; ++t) s[t] += __shfl_xor(s[t], o); }
#pragma unroll
        for (int t = 0; t < 8; ++t) { const size_t row = (size_t)b * 4096 + k0 + wid * 8 + t; const float rs = rsqrtf(s[t] * (1.f / 512.f) + EPS);
#pragma unroll
            for (int j = 0; j < 8; ++j) merged[row * 1024 + 512 + lane + 64 * j] = (bf16)(pk2(f[t][j] * rs * gf[j], 0.f) & 0xffffu); }
        __syncthreads();
    }
}
struct P4Pol {
    struct Unit { int pm, pn; };
    static constexpr bool GATHER = false;
    pg8::DenseOrder ord; const char* A; const char* B; int K, ksplit, lda, ldb;
    DI bool next(int i, Unit& u) const { return ord.get(i, u.pm, u.pn); }
    DI void ptrs(const Unit& u, pg8::UPtr& q) const { q.a0 = A + (size_t)u.pm * 256 * lda * 2; q.a1 = q.a0 + (size_t)128 * lda * 2; q.b0 = B + (size_t)u.pn * 256 * ldb * 2; q.b1 = q.b0 + (size_t)128 * ldb * 2; q.c0 = q.b0; q.c1 = q.b1; }
    DI int brow(int R) const { return R; }
    DI void gather(const Unit&, int (&)[2], int (&)[2], unsigned (&)[2][2]) const {}
};
struct P4Epi {
    static constexpr int MIDK_T = 8;
    const float* x; bf16* x1b; const float* mod; float* rsqp; const float* rss;
    DI void midk(f32x4 (&acc)[2][2][4][2], const P4Pol::Unit& u, int wr, int wc, int fr, int fq) const {
        float r[2][4];
#pragma unroll
        for (int ai = 0; ai < 2; ++ai)
#pragma unroll
            for (int m = 0; m < 4; ++m) r[ai][m] = rss[u.pm * 256 + ai * 128 + wr * 64 + m * 16 + fr];
#pragma unroll
        for (int ai = 0; ai < 2; ++ai)
#pragma unroll
            for (int m = 0; m < 4; ++m)
#pragma unroll
                for (int bj = 0; bj < 2; ++bj)
#pragma unroll
                    for (int n = 0; n < 2; ++n) acc[ai][bj][m][n] = acc[ai][bj][m][n] * r[ai][m];
    }
    DI void operator()(const f32x4 (&acc)[2][2][4][2], const P4Pol::Unit& u, int wr, int wc, int fr, int fq) const {
        const int col0 = u.pn * 256 + wc * 32 + 4 * fq, b = (u.pm * 256) >> 12;
        f32x4 gv[2][2];
#pragma unroll
        for (int bj = 0; bj < 2; ++bj)
#pragma unroll
            for (int n = 0; n < 2; ++n) gv[bj][n] = *(const f32x4*)(mod + b * 6144 + 2048 + col0 + bj * 128 + n * 16);
#pragma unroll
        for (int q = 0; q < 4; ++q) { const int ai = q >> 1, mb = (q & 1) * 2;
            f32x4 xv[2][2][2];
#pragma unroll
            for (int m2 = 0; m2 < 2; ++m2) { const int row = u.pm * 256 + ai * 128 + wr * 64 + (mb + m2) * 16 + fr;
#pragma unroll
                for (int bj = 0; bj < 2; ++bj)
#pragma unroll
                    for (int n = 0; n < 2; ++n) xv[m2][bj][n] = *(const f32x4*)(x + (size_t)row * D + col0 + bj * 128 + n * 16); }
#pragma unroll
            for (int m2 = 0; m2 < 2; ++m2) { const int m = mb + m2, row = u.pm * 256 + ai * 128 + wr * 64 + m * 16 + fr; float s = 0.f;
#pragma unroll
                for (int bj = 0; bj < 2; ++bj)
#pragma unroll
                    for (int n = 0; n < 2; ++n) { const f32x4 o = xv[m2][bj][n] + gv[bj][n] * acc[ai][bj][m][n]; u32x2 w; w.x = pk2(o.x, o.y); w.y = pk2(o.z, o.w); *(u32x2*)(x1b + (size_t)row * D + col0 + bj * 128 + n * 16) = w; s += (o.x * o.x + o.y * o.y) + (o.z * o.z + o.w * o.w); }
                s += __shfl_xor(s, 16); s += __shfl_xor(s, 32);
                if (fq == 0) rsqp[(size_t)row * 16 + u.pn * 4 + wc] = s; }
            asm volatile("" ::: "memory");
        }
    }
};
DI void phase4_out(const Params& p, unsigned char* lds, int bid, int nb) {
    P4Pol P; P.ord.init(NTOK / 256, D / 256, nb, bid); P.A = (const char*)(p.ws + WS_R1); P.B = (const char*)(p.ws + WS_WOUTT); P.K = 1024; P.ksplit = 16; P.lda = 1024; P.ldb = 1024;
    P4Epi E{p.x, (bf16*)(p.ws + WS_X1B), (const float*)(p.ws + WS_MOD), (float*)(p.ws + WS_RSQP1), (const float*)(p.ws + WS_RSS)};
    pg8::gemm_phase<P4Pol, P4Epi, true>((PG8_LAS unsigned char*)lds, P, E);
}
DI int pair_index(int lo, int hi) { return 7 * lo - (lo * (lo - 1)) / 2 + (hi - lo - 1); }
constexpr int RT_WP = 2064, RT_GM_OFF = 48 * RT_WP, RT_SH_OFF = RT_GM_OFF + 4096, RT_SC_OFF = RT_SH_OFF + 4096, RT_LDS = RT_SC_OFF + 8 * 16 * 48 * 4;
DI void phase5_route(const Params& p, unsigned char* lds, int bid, int nb, bool commit = true) {
    const int tid = tidx(), lane = tid & 63, wid = tid >> 6, fr = lane & 15, fq = lane >> 4;
    { const bf16* W = (const bf16*)(p.ws + WS_WRT);
      for (int i = tid; i < 48 * 128; i += NT) { const int n = i >> 7, c = i & 127; *(u32x4*)(lds + n * RT_WP + c * 16) = *(const u32x4*)(W + n * 1024 + c * 8); } }
    const float* mod = (const float*)(p.ws + WS_MOD); const float* rsqp = (const float*)(p.ws + WS_RSQP1);
    bf16* A2 = (bf16*)(p.ws + WS_A2); unsigned* elcp = (unsigned*)(p.ws + WS_ELCP); float* elw = (float*)(p.ws + WS_ELW); unsigned* tcp = (unsigned*)(p.ws + WS_TCP);
    unsigned* ecnt = (unsigned*)(p.ws + WS_CTL + CTL_ECNT); unsigned* pcnt = (unsigned*)(p.ws + WS_CTL + CTL_PCNT);
    unsigned* elist = (unsigned*)(p.ws + WS_ELIST);
    float* gm = (float*)(lds + RT_GM_OFF); float* shv = (float*)(lds + RT_SH_OFF); float* scr = (float*)(lds + RT_SC_OFF) + wid * 16 * 48;
    for (int t128 = bid; t128 < NTOK / 128; t128 += nb) {
        const int b = t128 >> 5;
        __syncthreads();
        for (int k = tid; k < 1024; k += NT) { gm[k] = p.norm2_g[k] * (1.f + mod[b * 6144 + 4096 + k]); shv[k] = mod[b * 6144 + 3072 + k]; }
        __syncthreads();
        const int row0 = t128 * 128 + wid * 16, row = row0 + fr;
        float rs;
        { const f32x4* pp = (const f32x4*)(rsqp + (size_t)row * 16); const f32x4 q0 = pp[0], q1 = pp[1], q2 = pp[2], q3 = pp[3];
          const float rsum = (((q0.x + q0.y) + (q0.z + q0.w)) + ((q1.x + q1.y) + (q1.z + q1.w))) + (((q2.x + q2.y) + (q2.z + q2.w)) + ((q3.x + q3.y) + (q3.z + q3.w)));
          rs = rsqrtf(rsum * (1.f / D) + EPS); }
        f32x4 acc[3];
#pragma unroll
        for (int n = 0; n < 3; ++n) acc[n] = (f32x4){0.f, 0.f, 0.f, 0.f};
        const bf16* xr = (const bf16*)(p.ws + WS_X1B) + (size_t)row * D + fq * 8; bf16* ar = A2 + (size_t)row * D + fq * 8;
        u32x4 xa[8], xb[8];
#pragma unroll
        for (int i = 0; i < 8; ++i) xa[i] = *(const u32x4*)(xr + i * 32);
#pragma unroll 1
        for (int kc = 0; kc < 4; kc += 2) {
#pragma unroll
            for (int i = 0; i < 8; ++i) xb[i] = *(const u32x4*)(xr + (kc + 1) * 256 + i * 32);
#pragma unroll
            for (int half = 0; half < 2; ++half) {
#pragma unroll
                for (int i = 0; i < 8; ++i) {
                    const int ks = (kc + half) * 8 + i, k0 = ks * 32 + fq * 8;
                    const u32x4 xx = half ? xb[i] : xa[i];
                    f32x4 x0, x1; x0.x = __uint_as_float(xx.x << 16); x0.y = __uint_as_float(xx.x & 0xffff0000u); x0.z = __uint_as_float(xx.y << 16); x0.w = __uint_as_float(xx.y & 0xffff0000u);
                    x1.x = __uint_as_float(xx.z << 16); x1.y = __uint_as_float(xx.z & 0xffff0000u); x1.z = __uint_as_float(xx.w << 16); x1.w = __uint_as_float(xx.w & 0xffff0000u);
                    const f32x4 g0 = *(const f32x4*)(gm + k0), g1 = *(const f32x4*)(gm + k0 + 4), s0 = *(const f32x4*)(shv + k0), s1 = *(const f32x4*)(shv + k0 + 4);
                    const f32x4 t0 = x0 * rs * g0 + s0, t1 = x1 * rs * g1 + s1;
                    u32x4 hi; hi.x = pk2(t0.x, t0.y); hi.y = pk2(t0.z, t0.w); hi.z = pk2(t1.x, t1.y); hi.w = pk2(t1.z, t1.w);
                    *(u32x4*)(ar + ks * 32) = hi;
                    u32x4 lo;
                    lo.x = pk2(t0.x - __uint_as_float(hi.x << 16), t0.y - __uint_as_float(hi.x & 0xffff0000u)); lo.y = pk2(t0.z - __uint_as_float(hi.y << 16), t0.w - __uint_as_float(hi.y & 0xffff0000u));
                    lo.z = pk2(t1.x - __uint_as_float(hi.z << 16), t1.y - __uint_as_float(hi.z & 0xffff0000u)); lo.w = pk2(t1.z - __uint_as_float(hi.w << 16), t1.w - __uint_as_float(hi.w & 0xffff0000u));
                    const bf16x8 ah = __builtin_bit_cast(bf16x8, hi), al = __builtin_bit_cast(bf16x8, lo);
#pragma unroll
                    for (int nt = 0; nt < 3; ++nt) { const bf16x8 bw = *(const bf16x8*)(lds + (16 * nt + fr) * RT_WP + k0 * 2);
                        acc[nt] = __builtin_amdgcn_mfma_f32_16x16x32_bf16(ah, bw, acc[nt], 0, 0, 0); acc[nt] = __builtin_amdgcn_mfma_f32_16x16x32_bf16(al, bw, acc[nt], 0, 0, 0); }
                }
                if (half == 0 && kc + 2 < 4) {
#pragma unroll
                    for (int i = 0; i < 8; ++i) xa[i] = *(const u32x4*)(xr + (kc + 2) * 256 + i * 32);
                }
            }
        }
#pragma unroll
        for (int nt = 0; nt < 3; ++nt)
#pragma unroll
            for (int r = 0; r < 4; ++r) scr[(4 * fq + r) * 48 + 16 * nt + fr] = acc[nt][r];
        __syncthreads();
        if (lane < 16 && commit) {
            const int rrow = row0 + lane; const float* lg = scr + lane * 48;
            float gl[4];
#pragma unroll
            for (int o = 0; o < 4; ++o) gl[o] = lg[o] + p.b_group[o];
            float gmax = gl[0]; int gi = 0;
#pragma unroll
            for (int o = 1; o < 4; ++o) if (gl[o] > gmax) { gmax = gl[o]; gi = o; }
            float se = 0.f;
#pragma unroll
            for (int o = 0; o < 4; ++o) se += __expf(gl[o] - gmax);
            const float g_w = 1.f / se;
            float ev[8];
#pragma unroll
            for (int o = 0; o < 8; ++o) ev[o] = lg[4 + gi * 8 + o] + p.b_router[gi * 8 + o];
            float v1 = ev[0]; int i1 = 0;
#pragma unroll
            for (int o = 1; o < 8; ++o) if (ev[o] > v1) { v1 = ev[o]; i1 = o; }
            float v2 = -3.0e38f; int i2 = -1;
#pragma unroll
            for (int o = 0; o < 8; ++o) if (o != i1 && ev[o] > v2) { v2 = ev[o]; i2 = o; }
            const float w1 = g_w / (1.f + __expf(v2 - v1)), w2 = g_w - w1;
            const int lo = i1 < i2 ? i1 : i2, hi = i1 < i2 ? i2 : i1; const int pos1 = i1 < i2 ? 0 : 1;
            const int e1 = gi * 8 + i1, e2 = gi * 8 + i2;
            const int cls = gi * 28 + pair_index(lo, hi);
            const unsigned q3 = atomicAdd(pcnt + cls, 1u); const unsigned cp = ((unsigned)cls << 16) | q3;
            tcp[rrow] = cp;
            const unsigned q1 = atomicAdd(ecnt + e1, 1u); elist[(size_t)e1 * 32768 + q1] = (unsigned)rrow * 2u + (unsigned)pos1; elcp[(size_t)e1 * 32768 + q1] = cp; elw[(size_t)e1 * 32768 + q1] = w1;
            const unsigned q2 = atomicAdd(ecnt + e2, 1u); elist[(size_t)e2 * 32768 + q2] = (unsigned)rrow * 2u + (unsigned)(1 - pos1); elcp[(size_t)e2 * 32768 + q2] = cp; elw[(size_t)e2 * 32768 + q2] = w2;
        }
    }
    __syncthreads();
}
constexpr int TB_OFF = 131072, TB_ETE = 64, TB_ETR = 64 + 320, TB_ETC = 64 + 640, TB_PTC = 64 + 960, TB_PTS = 64 + 1280, TB_COFF = 64 + 1600, TB_BYTES = (64 + 1600 + 128 + 160) * 4;
DI void build_tiles(const Params& p, unsigned char* lds) {
    int* tb = (int*)(lds + TB_OFF); int* cnts = tb + TB_COFF + 112;
    const int tid = tidx();
    if (tid < 144) cnts[tid] = tid < 32 ? (int)((const unsigned*)(p.ws + WS_CTL + CTL_ECNT))[tid] : (int)((const unsigned*)(p.ws + WS_CTL + CTL_PCNT))[tid - 32];
    __syncthreads();
    if (tid == 0) {
        int n = 0;
        for (int e = 0; e < 32; ++e) { const int c = cnts[e]; for (int r0 = 0; r0 < c; r0 += 256) { tb[TB_ETE + n] = e; tb[TB_ETR + n] = r0; tb[TB_ETC + n] = c; ++n; } }
        tb[0] = n;
    }
    if (tid == 64) {
        int n = 0, off = 0;
        for (int c2 = 0; c2 < 112; ++c2) { const int c = cnts[32 + c2]; tb[TB_COFF + c2] = off; for (int r0 = 0; r0 < c; r0 += 256) { tb[TB_PTC + n] = c2; tb[TB_PTS + n] = off + r0; ++n; } off += ((c + 255) >> 8) << 8; }
        tb[1] = n;
    }
    __syncthreads();
}
struct GUPol {
    struct Unit { int e, r0, cnt, hh; };
    static constexpr bool GATHER = true;
    const int* tb; int G, c; const char* A; const char* B; const unsigned* elist; int K, ksplit, lda, ldb;
    DI bool next(int i, Unit& u) const { const int L = i * G + c; if (L >= __builtin_amdgcn_readfirstlane(tb[0]) * 2) return false; const int t = L >> 1; u.hh = L & 1;
        u.e = __builtin_amdgcn_readfirstlane(tb[TB_ETE + t]); u.r0 = __builtin_amdgcn_readfirstlane(tb[TB_ETR + t]); u.cnt = __builtin_amdgcn_readfirstlane(tb[TB_ETC + t]); return true; }
    DI void ptrs(const Unit& u, pg8::UPtr& q) const { q.a0 = A; q.a1 = A; q.b0 = B + (size_t)((u.e * 2 + u.hh) * 256) * ldb * 2; q.b1 = q.b0 + (size_t)128 * ldb * 2; q.c0 = q.b0; q.c1 = q.b1; }
    DI int brow(int R) const { return R; }
    DI void gather(const Unit& u, int (&R)[2], int (&C)[2], unsigned (&va)[2][2]) const {
#pragma unroll
        for (int h = 0; h < 2; ++h)
#pragma unroll
            for (int i = 0; i < 2; ++i) { const int r = u.r0 + h * 128 + R[i]; const unsigned ent = elist[(size_t)u.e * 32768 + (r < u.cnt ? r : u.r0)]; va[h][i] = ((ent >> 1) * 1024u + (unsigned)C[i]) * 2u; }
    }
};
struct GUEpi {
    static constexpr int MIDK_T = -1;
    const unsigned* elist; const unsigned* elcp; const float* elw; bf16* Hs; const int* tb;
    DI void operator()(const f32x4 (&acc)[2][2][4][2], const GUPol::Unit& u, int wr, int wc, int fr, int fq) const {
        unsigned ent[2][4], cp[2][4]; float w[2][4];
#pragma unroll
        for (int ai = 0; ai < 2; ++ai)
#pragma unroll
            for (int m = 0; m < 4; ++m) { const int r = u.r0 + ai * 128 + wr * 64 + m * 16 + fr; const size_t ix = (size_t)u.e * 32768 + (r < u.cnt ? r : u.r0);
                ent[ai][m] = elist[ix]; cp[ai][m] = elcp[ix]; w[ai][m] = elw[ix]; }
#pragma unroll
        for (int ai = 0; ai < 2; ++ai)
#pragma unroll
            for (int m = 0; m < 4; ++m) { const int r = u.r0 + ai * 128 + wr * 64 + m * 16 + fr;
                if (r < u.cnt) { const int srow = tb[TB_COFF + (cp[ai][m] >> 16)] + (int)(cp[ai][m] & 0xffffu); const float ww = w[ai][m];
                    bf16* dst = Hs + (size_t)srow * 512 + (ent[ai][m] & 1u) * 256 + u.hh * 128 + wc * 32 + 4 * fq;
#pragma unroll
                    for (int n = 0; n < 2; ++n) { const f32x4 gt = acc[ai][0][m][n], up = acc[ai][1][m][n];
                        u32x2 o; o.x = pk2(siluf_(gt[0]) * up[0] * ww, siluf_(gt[1]) * up[1] * ww); o.y = pk2(siluf_(gt[2]) * up[2] * ww, siluf_(gt[3]) * up[3] * ww);
                        *(u32x2*)(dst + n * 16) = o; } } }
    }
};
DI void phase6_gateup(const Params& p, unsigned char* lds, int bid, int nb) {
    GUPol P; P.tb = (const int*)(lds + TB_OFF); P.G = nb; P.c = bid; P.A = (const char*)(p.ws + WS_A2); P.B = (const char*)(p.ws + WS_WGUT); P.elist = (const unsigned*)(p.ws + WS_ELIST); P.K = 1024; P.ksplit = 16; P.lda = 1024; P.ldb = 1024;
    GUEpi E{(const unsigned*)(p.ws + WS_ELIST), (const unsigned*)(p.ws + WS_ELCP), (const float*)(p.ws + WS_ELW), (bf16*)(p.ws + WS_HS), (const int*)(lds + TB_OFF)};
    pg8::gemm_phase<GUPol, GUEpi, true>((PG8_LAS unsigned char*)lds, P, E);
}
struct DnPol {
    struct Unit { int s0, cls, pn; };
    static constexpr bool GATHER = false;
    const int* tb; int G, c; const char* A; const char* B; int K, ksplit, lda, ldb;
    DI bool next(int i, Unit& u) const { const int L = i * G + c; if (L >= __builtin_amdgcn_readfirstlane(tb[1]) * 4) return false; const int t = L >> 2; u.pn = L & 3;
        u.cls = __builtin_amdgcn_readfirstlane(tb[TB_PTC + t]); u.s0 = __builtin_amdgcn_readfirstlane(tb[TB_PTS + t]); return true; }
    DI void ptrs(const Unit& u, pg8::UPtr& q) const {
        const int gi = u.cls / 28; int lo = 0, rem = u.cls % 28;
        while (rem >= 7 - lo) { rem -= 7 - lo; ++lo; }
        const int hi = lo + 1 + rem, elo = gi * 8 + lo, ehi = gi * 8 + hi;
        q.a0 = A + (size_t)u.s0 * lda * 2; q.a1 = q.a0 + (size_t)128 * lda * 2;
        q.b0 = B + ((size_t)elo * 1024 + u.pn * 256) * ldb * 2; q.b1 = q.b0 + (size_t)128 * ldb * 2;
        q.c0 = B + ((size_t)ehi * 1024 + u.pn * 256) * ldb * 2; q.c1 = q.c0 + (size_t)128 * ldb * 2; }
    DI int brow(int R) const { return R; }
    DI void gather(const Unit&, int (&)[2], int (&)[2], unsigned (&)[2][2]) const {}
};
struct DnEpi {
    static constexpr int MIDK_T = -1;
    bf16* moe;
    DI void operator()(const f32x4 (&acc)[2][2][4][2], const DnPol::Unit& u, int wr, int wc, int fr, int fq) const {
#pragma unroll
        for (int ai = 0; ai < 2; ++ai)
#pragma unroll
            for (int m = 0; m < 4; ++m) { bf16* dst = moe + (size_t)(u.s0 + ai * 128 + wr * 64 + m * 16 + fr) * 1024 + u.pn * 256 + wc * 32 + 4 * fq;
#pragma unroll
                for (int bj = 0; bj < 2; ++bj)
#pragma unroll
                    for (int n = 0; n < 2; ++n) { u32x2 w; w.x = pk2(acc[ai][bj][m][n][0], acc[ai][bj][m][n][1]); w.y = pk2(acc[ai][bj][m][n][2], acc[ai][bj][m][n][3]);
                        *(u32x2*)(dst + bj * 128 + n * 16) = w; } }
    }
};
DI void phase7_down(const Params& p, unsigned char* lds, int bid, int nb) {
    DnPol P; P.tb = (const int*)(lds + TB_OFF); P.G = nb; P.c = bid; P.A = (const char*)(p.ws + WS_HS); P.B = (const char*)(p.ws + WS_WDT); P.K = 512; P.ksplit = 4; P.lda = 512; P.ldb = 256;
    DnEpi E{(bf16*)(p.ws + WS_MOE)};
    pg8::gemm_phase<DnPol, DnEpi, true>((PG8_LAS unsigned char*)lds, P, E);
}
DI void phase8_final(const Params& p, unsigned char* lds, int bid, int nb) {
    const int lane = tidx() & 63, wave = tidx() >> 6;
    const float* mod = (const float*)(p.ws + WS_MOD); const unsigned* tcp = (const unsigned*)(p.ws + WS_TCP); const bf16* moe = (const bf16*)(p.ws + WS_MOE); const bf16* x1b = (const bf16*)(p.ws + WS_X1B); const int* tb = (const int*)(lds + TB_OFF);
    constexpr int RW = 4;
    for (int r0 = (bid * 8 + wave) * RW; r0 < NTOK; r0 += nb * 8 * RW) {
        const int b = r0 >> 12; unsigned cp[RW]; u32x2 xx[RW][4], mm[RW][4];
#pragma unroll
        for (int q = 0; q < RW; ++q) cp[q] = tcp[r0 + q];
#pragma unroll
        for (int q = 0; q < RW; ++q)
#pragma unroll
            for (int j = 0; j < 4; ++j) xx[q][j] = ((const u32x2*)(x1b + (size_t)(r0 + q) * D) + lane)[64 * j];
#pragma unroll
        for (int q = 0; q < RW; ++q) { const int srow = tb[TB_COFF + (cp[q] >> 16)] + (int)(cp[q] & 0xffffu);
#pragma unroll
            for (int j = 0; j < 4; ++j) mm[q][j] = ((const u32x2*)(moe + (size_t)srow * D) + lane)[64 * j]; }
        f32x4 g2[4], fg[4];
#pragma unroll
        for (int j = 0; j < 4; ++j) { g2[j] = *(const f32x4*)(mod + b * 6144 + 5120 + lane * 4 + 256 * j); fg[j] = *(const f32x4*)(p.final_g + lane * 4 + 256 * j); }
        f32x4 v[RW][4]; float s[RW];
#pragma unroll
        for (int q = 0; q < RW; ++q) { float t = 0.f;
#pragma unroll
            for (int j = 0; j < 4; ++j) { f32x4 x1, mv; x1.x = __uint_as_float(xx[q][j].x << 16); x1.y = __uint_as_float(xx[q][j].x & 0xffff0000u); x1.z = __uint_as_float(xx[q][j].y << 16); x1.w = __uint_as_float(xx[q][j].y & 0xffff0000u);
                mv.x = __uint_as_float(mm[q][j].x << 16); mv.y = __uint_as_float(mm[q][j].x & 0xffff0000u); mv.z = __uint_as_float(mm[q][j].y << 16); mv.w = __uint_as_float(mm[q][j].y & 0xffff0000u);
                v[q][j] = x1 + g2[j] * mv; t += (v[q][j].x * v[q][j].x + v[q][j].y * v[q][j].y) + (v[q][j].z * v[q][j].z + v[q][j].w * v[q][j].w); }
            s[q] = t; }
#pragma unroll
        for (int o = 1; o < 64; o <<= 1) {
#pragma unroll
            for (int q = 0; q < RW; ++q) s[q] += __shfl_xor(s[q], o); }
#pragma unroll
        for (int q = 0; q < RW; ++q) { const float rs = rsqrtf(s[q] * (1.f / D) + EPS); f32x4* orow = (f32x4*)(p.out + (size_t)(r0 + q) * D) + lane;
#pragma unroll
            for (int j = 0; j < 4; ++j) { f32x4 o = v[q][j] * rs * fg[j];
                if (MK_TS1 >= 0) { const unsigned* tsv = (const unsigned*)(p.ws + WS_CTL + CTL_TS); o = o * (1.f + (float)(tsv[0] / 1000u) * 0.01f); }
                orow[64 * j] = o; } }
    }
}

#define XB_TMO      128
#define XB_XCNT(j)  (256  + 64 * (j))
#define XB_XSUB(j)  (1280 + 64 * (j))
#define XB_XGEN(j)  (2304 + 64 * (j))
#define XB_TOP      3328
#define XB_TOPGEN   3392
#define XCD_BAR_WORDS 3456
#define XB_SPIN_CAP (1u << 18)
#define LAS __attribute__((address_space(3)))
DI unsigned xb_ld(unsigned* p)              { return __hip_atomic_load(p, __ATOMIC_RELAXED, __HIP_MEMORY_SCOPE_AGENT); }
DI unsigned xb_add(unsigned* p, unsigned v) { return __hip_atomic_fetch_add(p, v, __ATOMIC_RELAXED, __HIP_MEMORY_SCOPE_AGENT); }
DI unsigned xb_xcc_id() { return (unsigned)__builtin_amdgcn_s_getreg((3 << 11) | 20) & 0xFu; }
#define XB_SPIN(cond, bar) do { unsigned _sp = 0; while (cond) { __builtin_amdgcn_s_sleep(1); \
    if ((++_sp & 255u) == 0u) { if (xb_ld(&(bar)[XB_TMO])) break; if (_sp > XB_SPIN_CAP) { atomicAdd(&(bar)[XB_TMO], 1u); break; } } } } while (0)
struct XcdBarrier { unsigned* bar; unsigned x; volatile LAS unsigned* st; };
DI XcdBarrier xcd_barrier_post(unsigned* bar, volatile LAS unsigned* st) {
    XcdBarrier b; b.bar = bar; b.x = xb_xcc_id(); b.st = st;
    if (tidx() == 0) (void)xb_add(&bar[XB_XCNT(b.x)], 1u);
    return b;
}
DI void xcd_barrier_complete(unsigned* bar, unsigned x, unsigned& nloc, unsigned& nx) {
    const unsigned G = gridDim.x * gridDim.y * gridDim.z;
    unsigned sum, cnt, mine, sp = 0u;
    for (;;) {
        sum = 0u; cnt = 0u; mine = 0u;
#pragma unroll
        for (unsigned j = 0; j < 16; ++j) { const unsigned c = xb_ld(&bar[XB_XCNT(j)]); sum += c; cnt += (c > 0u) ? 1u : 0u; mine = (j == x) ? c : mine; }
        if (sum == G) break;
        __builtin_amdgcn_s_sleep(1);
        if ((++sp & 255u) == 0u) { if (xb_ld(&bar[XB_TMO])) break; if (sp > XB_SPIN_CAP) { atomicAdd(&bar[XB_TMO], 1u); break; } }
    }
    nloc = mine > 0u ? mine : 1u; nx = cnt > 0u ? cnt : 1u;
}
DI void xcd_barrier(const XcdBarrier& b) {
    asm volatile("s_waitcnt vmcnt(0)" ::: "memory");
    __syncthreads();
    if (tidx() == 0) {
        unsigned* bar = b.bar;
        __builtin_amdgcn_s_waitcnt(0);
        unsigned nloc = b.st[0], nx = b.st[1];
        if (nloc == 0u) { xcd_barrier_complete(bar, b.x, nloc, nx); b.st[0] = nloc; b.st[1] = nx; }
        const unsigned old = xb_add(&bar[XB_XSUB(b.x)], 1u);
        const unsigned gen = old / nloc;
        if (old + 1u == (gen + 1u) * nloc) {
            __builtin_amdgcn_fence(__ATOMIC_RELEASE, "agent");
            asm volatile("s_waitcnt vmcnt(0)" ::: "memory");
            const unsigned og = xb_add(&bar[XB_TOP], 1u);
            const unsigned tg = og / nx;
            if (og + 1u == (tg + 1u) * nx) xb_add(&bar[XB_TOPGEN], 1u);
            else XB_SPIN(xb_ld(&bar[XB_TOPGEN]) == tg, bar);
            __builtin_amdgcn_fence(__ATOMIC_ACQUIRE, "agent");
            xb_add(&bar[XB_XGEN(b.x)], 1u);
            asm volatile("s_waitcnt vmcnt(0)" ::: "memory");
        } else {
            XB_SPIN(xb_ld(&bar[XB_XGEN(b.x)]) == gen, bar);
            __builtin_amdgcn_fence(__ATOMIC_ACQUIRE, "agent");
            asm volatile("s_waitcnt vmcnt(0)" ::: "memory");
        }
    }
    __syncthreads();
}

constexpr int CTL_BAR = 16384;
constexpr int MK_LDS = 163840;
constexpr int MK_ST_OFF = MK_LDS - 16;
static_assert(S5_LDS <= MK_ST_OFF && FF_LDS <= MK_ST_OFF && RT_LDS <= MK_ST_OFF && TB_OFF + TB_BYTES <= MK_ST_OFF && TB_OFF >= pg8::STAGE_BYTES, "LDS map");
static_assert(4 * (4096 + 4096 + 8448 + 16384) <= MK_ST_OFF, "prep LDS");
#ifndef MK_REP
#define MK_REP -1
#endif
constexpr int MK_PT_OFF = MK_ST_OFF - 256;
static_assert(S5_LDS <= MK_PT_OFF && RT_LDS <= MK_PT_OFF && TB_OFF + TB_BYTES <= MK_PT_OFF, "LDS map (pointer table)");
DI Params ldp(const unsigned char* lds) {
    Params p; unsigned long long* d = (unsigned long long*)&p; const unsigned* t = (const unsigned*)(lds + MK_PT_OFF);
#pragma unroll
    for (int i = 0; i < 32; ++i) { const unsigned lo = __builtin_amdgcn_readfirstlane(t[2 * i]), hi = __builtin_amdgcn_readfirstlane(t[2 * i + 1]); d[i] = ((unsigned long long)hi << 32) | lo; }
    return p;
}
#define TSTAMP(i) do { if (MK_TS1 >= 0 && bid == 0 && tidx() == 0) ((unsigned long long*)(lds + MK_PT_OFF - 256))[i] = __builtin_amdgcn_s_memrealtime(); } while (0)
#define RUNPH(k, body) do { { const Params p = ldp(lds); body; } if (MK_REP == (k)) { xcd_barrier(bar); { const Params p = ldp(lds); body; } } } while (0)
__global__ void __launch_bounds__(NT, 2) mega_kernel(Params pk) {
    extern __shared__ __attribute__((aligned(16))) unsigned char lds[];
    const int bid = blockIdx.x, nb = gridDim.x;
    static_assert(sizeof(Params) == 256, "Params = 32 pointers");
    if (tidx() < 64) ((unsigned*)(lds + MK_PT_OFF))[tidx()] = ((const unsigned*)&pk)[tidx()];
    if (tidx() < 4) ((unsigned*)(lds + MK_ST_OFF))[tidx()] = 0u;
    __syncthreads();
    XcdBarrier bar;
    { const Params p = ldp(lds); bar = xcd_barrier_post((unsigned*)(p.ws + WS_CTL + CTL_BAR), (volatile LAS unsigned*)(lds + MK_ST_OFF)); }
    TSTAMP(0);
    RUNPH(0, phase0(p, lds, bid, nb));            xcd_barrier(bar); TSTAMP(1);
    RUNPH(1, phase1a(p, bid, nb));                xcd_barrier(bar); TSTAMP(2);
    RUNPH(2, phase1b(p, lds, bid, nb));           xcd_barrier(bar); TSTAMP(3);
    RUNPH(3, phase2_s5(p, lds, bid, nb));
    RUNPH(4, phase2_fft(p, lds, bid, nb));        xcd_barrier(bar); TSTAMP(4);
    RUNPH(9, phase2c_s5out(p, lds, bid, nb));     xcd_barrier(bar); TSTAMP(5);
    RUNPH(5, phase3_glu(p, lds, bid, nb));        xcd_barrier(bar); TSTAMP(6);
    RUNPH(6, phase3_fin(p, lds, bid, nb));        xcd_barrier(bar); TSTAMP(7);
    RUNPH(7, phase4_out(p, lds, bid, nb));        xcd_barrier(bar); TSTAMP(8);
    RUNPH(-2, phase5_route(p, lds, bid, nb));     xcd_barrier(bar); TSTAMP(9);
    if (MK_REP == 8) { { const Params p = ldp(lds); phase5_route(p, lds, bid, nb, false); } xcd_barrier(bar); }
    if (MK_REP == 20) { xcd_barrier(bar); xcd_barrier(bar); xcd_barrier(bar); xcd_barrier(bar); }
    RUNPH(-2, build_tiles(p, lds));
    RUNPH(10, phase6_gateup(p, lds, bid, nb));    xcd_barrier(bar); TSTAMP(10);
    RUNPH(11, phase7_down(p, lds, bid, nb));      xcd_barrier(bar); TSTAMP(11);
    if (MK_TS1 >= 0) { if (bid == 0 && tidx() == 0) { const unsigned long long* ts = (const unsigned long long*)(lds + MK_PT_OFF - 256); const Params p = ldp(lds); unsigned* o = (unsigned*)(p.ws + WS_CTL + CTL_TS);
            o[0] = (unsigned)(ts[MK_TS1 + 1] - ts[MK_TS1]); o[1] = MK_TS2 >= 0 ? (unsigned)(ts[MK_TS2 + 1] - ts[MK_TS2]) : 0u; } xcd_barrier(bar); }
    RUNPH(-2, phase8_final(p, lds, bid, nb));
}

extern "C" void kernel_launch(void* const* d_in, const int* in_sizes, int n_in, void* d_out, int out_size, void* d_ws, size_t ws_size, hipStream_t stream) {
    static int grid = 0;
    if (grid == 0) {
        if (n_in != 30 || ws_size < WS_END || out_size != NTOK * D) { fprintf(stderr, "kernel_launch: unexpected inputs (n_in %d, ws %zu, out %d)\n", n_in, ws_size, out_size); grid = -1; return; }
        int dev = 0, cus = 0, per_cu = 0;
        if (hipGetDevice(&dev) != hipSuccess || hipDeviceGetAttribute(&cus, hipDeviceAttributeMultiprocessorCount, dev) != hipSuccess) { grid = -1; return; }
        if (hipFuncSetAttribute((const void*)mega_kernel, hipFuncAttributeMaxDynamicSharedMemorySize, MK_LDS) != hipSuccess) { fprintf(stderr, "kernel_launch: hipFuncSetAttribute failed\n"); grid = -1; return; }
        if (hipOccupancyMaxActiveBlocksPerMultiprocessor(&per_cu, (const void*)mega_kernel, NT, MK_LDS) != hipSuccess || per_cu < 1) { fprintf(stderr, "kernel_launch: occupancy query says %d blocks/CU\n", per_cu); (void)hipGetLastError(); grid = -1; return; }
        grid = cus;
    }
    if (grid < 0) return;
    Params p{};
    const float** f = (const float**)&p;
    for (int i = 0; i < 30; ++i) f[i] = (const float*)d_in[i];
    p.out = (float*)d_out; p.ws = (unsigned char*)d_ws;
    (void)hipMemsetAsync((char*)d_ws + WS_CTL, 0, CTL_BYTES, stream);
    hipLaunchKernelGGL(mega_kernel, dim3(grid), dim3(NT), MK_LDS, stream, p);
}
```

```cpp
#include <hip/hip_runtime.h>
#include <cstdio>
#include <cstdint>

typedef unsigned short bf16;
typedef short bf16x8 __attribute__((ext_vector_type(8)));
typedef short bf16x4 __attribute__((ext_vector_type(4)));
typedef float f32x4 __attribute__((ext_vector_type(4)));
typedef unsigned u32x4 __attribute__((ext_vector_type(4)));
typedef unsigned u32x2 __attribute__((ext_vector_type(2)));
typedef __bf16 bf16v2 __attribute__((ext_vector_type(2)));
#define DI __device__ __forceinline__

constexpr int D = 1024, NB = 8, L = 4096, CTX = 256, NTOK = NB * L, NCTX = NB * CTX, NROWS1 = NTOK + NCTX;
constexpr int NEXP = 32, DE = 256;
constexpr float EPS = 1e-6f;
constexpr int NT = 512;

constexpr size_t MiB = 1u << 20;
constexpr size_t WS_CTL = 0;
constexpr size_t CTL_BYTES = 1 * MiB;
constexpr size_t CTL_ZERO = 4096;
#ifndef MK_TS1
#define MK_TS1 -1
#endif
#ifndef MK_TS2
#define MK_TS2 -1
#endif
constexpr size_t CTL_TS = 12288;
constexpr size_t CTL_WQ = 12544;
constexpr size_t CTL_ECNT = 8192;
constexpr size_t CTL_PCNT = 8192 + 256;
constexpr size_t CTL_RSQ1 = 256 * 1024;
constexpr size_t CTL_RSQ2 = 384 * 1024;
constexpr size_t WS_MOD = 1 * MiB;
constexpr size_t WS_TILES = WS_MOD + 256 * 1024;
constexpr size_t WS_ABART = WS_TILES + 64 * 1024;
constexpr size_t WS_FFTC = 2 * MiB;
constexpr size_t WS_GW = 3 * MiB;
constexpr size_t WS_WINT = 4 * MiB;
constexpr size_t WS_WGLUT = 7 * MiB;
constexpr size_t WS_WOUTT = 8 * MiB;
constexpr size_t WS_WGUT = 10 * MiB;
constexpr size_t WS_WDT = 42 * MiB;
constexpr size_t WS_WST = 58 * MiB;
constexpr size_t WS_MGW = 66 * MiB;
constexpr size_t WS_ELIST = 90 * MiB;
constexpr size_t WS_ELCP = 94 * MiB;
constexpr size_t WS_ELW = 98 * MiB;
constexpr size_t WS_TCP = 102 * MiB;
constexpr size_t WS_R1 = 108 * MiB;
constexpr size_t WS_R2 = 176 * MiB;
constexpr size_t WS_R3 = 240 * MiB;
constexpr size_t WS_UCTX = 288 * MiB;
constexpr size_t WS_R4 = 290 * MiB;
constexpr size_t WS_R5 = 322 * MiB;
constexpr size_t WS_X1B = 290 * MiB;
constexpr size_t WS_A2 = 108 * MiB;
constexpr size_t WS_HS = 228 * MiB;
constexpr size_t WS_MOE = 108 * MiB;
constexpr size_t WS_RSQP1 = 354 * MiB;
constexpr size_t WS_RSQS = 356 * MiB;
constexpr size_t WS_RSS = 357 * MiB;
constexpr size_t WS_WRT = 358 * MiB;
constexpr size_t WS_END = 359 * MiB;

struct Params {
    const float *x, *c, *ctx, *c_ctx, *w_ada, *b_ada, *norm1_g, *norm2_g, *w_in;
    const float *lam_re, *lam_im, *b_re, *b_im, *c_re, *c_im, *log_step, *s5_d, *w_glu, *fourier_w, *g_s, *g_f, *w_out;
    const float *w_group, *b_group, *w_router, *b_router, *w_gate, *w_up, *w_down, *final_g;
    float* out; unsigned char* ws;
};

DI int tidx() { int t = threadIdx.x; asm volatile("" : "+v"(t)); return t; }
DI unsigned pk2(float lo, float hi) { bf16v2 v; v.x = (__bf16)lo; v.y = (__bf16)hi; return __builtin_bit_cast(unsigned, v); }
DI float bf2f(unsigned short b) { return __uint_as_float(((unsigned)b) << 16); }
DI float wave_sum(float v) {
#pragma unroll
    for (int o = 1; o < 64; o <<= 1) v += __shfl_xor(v, o);
    return v;
}
DI float sigmoidf_(float x) { return 1.f / (1.f + __expf(-x)); }
DI float siluf_(float x) { return x / (1.f + __expf(-x)); }
DI float geluf_(float x) { const float u = 0.7978845608028654f * (x + 0.044715f * x * x * x); return x / (1.f + __expf(-2.f * u)); }

template <int MT> struct GC {
    static constexpr int BM = 64 * MT, PA = MT, ABYTES = BM * 128, BBYTES = 128 * 128, BUF = ABYTES + BBYTES, LDS = 2 * BUF;
};
template <int MT>
DI void gemm_loop(f32x4 (&acc)[MT][4], const bf16* (&ap)[MT], const int (&as)[MT], const bf16* (&bp)[2], int nk, unsigned char* lds) {
    typedef GC<MT> G;
    const int tid = tidx(), lane = tid & 63, wid = tid >> 6, wm = wid >> 1, wn = wid & 1, fr = lane & 15, fq = lane >> 4;
    const int srow = tid >> 3, sck = tid & 7;
    const int soff = srow * 128 + ((sck ^ (srow & 7)) << 4);
    u32x4 ra[MT], rb[2];
#pragma unroll
    for (int i = 0; i < MT; ++i) ra[i] = *(const u32x4*)(ap[i]);
#pragma unroll
    for (int i = 0; i < 2; ++i) rb[i] = *(const u32x4*)(bp[i]);
#pragma unroll
    for (int i = 0; i < MT; ++i) *(u32x4*)(lds + i * 8192 + soff) = ra[i];
#pragma unroll
    for (int i = 0; i < 2; ++i) *(u32x4*)(lds + G::ABYTES + i * 8192 + soff) = rb[i];
    __syncthreads();
    const int aro = (wm * MT * 16 + fr) * 128, bro = (wn * 64 + fr) * 128;
    const int sw0 = ((0 + fq) ^ (fr & 7)) << 4, sw1 = ((4 + fq) ^ (fr & 7)) << 4;
    for (int kt = 0; kt < nk; ++kt) {
        const bool more = kt + 1 < nk;
        if (more) {
#pragma unroll
            for (int i = 0; i < MT; ++i) ra[i] = *(const u32x4*)(ap[i] + (size_t)(kt + 1) * as[i]);
#pragma unroll
            for (int i = 0; i < 2; ++i) rb[i] = *(const u32x4*)(bp[i] + (size_t)(kt + 1) * 64);
        }
        const unsigned char* Ab = lds + (kt & 1) * G::BUF; const unsigned char* Bb = Ab + G::ABYTES;
#pragma unroll
        for (int kk = 0; kk < 2; ++kk) {
            const int sw = kk ? sw1 : sw0;
            bf16x8 af[MT], bfr[4];
#pragma unroll
            for (int mt = 0; mt < MT; ++mt) af[mt] = *(const bf16x8*)(Ab + aro + mt * 2048 + sw);
#pragma unroll
            for (int nt = 0; nt < 4; ++nt) bfr[nt] = *(const bf16x8*)(Bb + bro + nt * 2048 + sw);
#pragma unroll
            for (int mt = 0; mt < MT; ++mt)
#pragma unroll
                for (int nt = 0; nt < 4; ++nt) acc[mt][nt] = __builtin_amdgcn_mfma_f32_16x16x32_bf16(bfr[nt], af[mt], acc[mt][nt], 0, 0, 0);
        }
        if (more) {
            unsigned char* nb = lds + ((kt + 1) & 1) * G::BUF;
#pragma unroll
            for (int i = 0; i < MT; ++i) *(u32x4*)(nb + i * 8192 + soff) = ra[i];
#pragma unroll
            for (int i = 0; i < 2; ++i) *(u32x4*)(nb + G::ABYTES + i * 8192 + soff) = rb[i];
        }
        __syncthreads();
    }
}
template <int MT>
DI void gemm_loop_alds(f32x4 (&acc)[MT][4], const unsigned char* abase, int apitch, const bf16* (&bp)[2], int nk, unsigned char* lds) {
    typedef GC<MT> G;
    const int tid = tidx(), lane = tid & 63, wid = tid >> 6, wm = wid >> 1, wn = wid & 1, fr = lane & 15, fq = lane >> 4;
    const int srow = tid >> 3, sck = tid & 7;
    const int soff = srow * 128 + ((sck ^ (srow & 7)) << 4);
    u32x4 rb[2];
#pragma unroll
    for (int i = 0; i < 2; ++i) rb[i] = *(const u32x4*)(bp[i]);
#pragma unroll
    for (int i = 0; i < 2; ++i) *(u32x4*)(lds + G::ABYTES + i * 8192 + soff) = rb[i];
    __syncthreads();
    const int bro = (wn * 64 + fr) * 128;
    const int sw0 = ((0 + fq) ^ (fr & 7)) << 4, sw1 = ((4 + fq) ^ (fr & 7)) << 4;
    const unsigned char* arow = abase + (size_t)(wm * MT * 16 + fr) * apitch + fq * 16;
    for (int kt = 0; kt < nk; ++kt) {
        const bool more = kt + 1 < nk;
        if (more) {
#pragma unroll
            for (int i = 0; i < 2; ++i) rb[i] = *(const u32x4*)(bp[i] + (size_t)(kt + 1) * 64);
        }
        const unsigned char* Bb = lds + (kt & 1) * G::BUF + G::ABYTES;
#pragma unroll
        for (int kk = 0; kk < 2; ++kk) {
            const int sw = kk ? sw1 : sw0;
            bf16x8 af[MT], bfr[4];
#pragma unroll
            for (int mt = 0; mt < MT; ++mt) af[mt] = *(const bf16x8*)(arow + (size_t)mt * 16 * apitch + kt * 128 + kk * 64);
#pragma unroll
            for (int nt = 0; nt < 4; ++nt) bfr[nt] = *(const bf16x8*)(Bb + bro + nt * 2048 + sw);
#pragma unroll
            for (int mt = 0; mt < MT; ++mt)
#pragma unroll
                for (int nt = 0; nt < 4; ++nt) acc[mt][nt] = __builtin_amdgcn_mfma_f32_16x16x32_bf16(bfr[nt], af[mt], acc[mt][nt], 0, 0, 0);
        }
        if (more) {
            unsigned char* nb = lds + ((kt + 1) & 1) * G::BUF;
#pragma unroll
            for (int i = 0; i < 2; ++i) *(u32x4*)(nb + G::ABYTES + i * 8192 + soff) = rb[i];
        }
        __syncthreads();
    }
}
template <int MT> DI void zero_acc(f32x4 (&acc)[MT][4]) {
#pragma unroll
    for (int m = 0; m < MT; ++m)
#pragma unroll
        for (int n = 0; n < 4; ++n) acc[m][n] = (f32x4){0.f, 0.f, 0.f, 0.f};
}

namespace pg8 {
#define PG8_LAS __attribute__((address_space(3)))
constexpr int BM = 256, BK = 64, HALF = 128, HTB = HALF * BK * 2, STAGE_BYTES = 8 * HTB;
DI int lds_byte(int r, int c) { const int st = (r >> 4) * 2 + (c >> 5), rr = r & 15, cc = c & 31, ob = rr * 64 + cc * 2; return st * 1024 + (ob ^ (((ob >> 9) & 1) << 5)); }
DI int perm32(int rho) { const int n = rho >> 4, i = rho & 15; return 8 * (i >> 2) + 4 * n + (i & 3); }
DI void stage_rc(int b, int& R, int& C) { const int st = b / 1024, sb = b % 1024, swz = sb ^ (((sb >> 9) & 1) << 5); R = (st >> 1) * 16 + swz / 64; C = (st & 1) * 32 + (swz % 64) / 2; }
struct UPtr { const char *a0, *a1, *b0, *b1, *c0, *c1; };
template <class Pol, class Epi, bool ALIGN_EPI>
DI void gemm_phase(PG8_LAS unsigned char* lds, const Pol& P, const Epi& E) {
    typedef typename Pol::Unit Unit;
    const int tid = tidx(), wid = __builtin_amdgcn_readfirstlane(tid >> 6), lane = tid & 63, wr = wid >> 2, wc = wid & 3, fr = lane & 15, fq = lane >> 4;
    const int nt = P.K / BK, ksplit = P.ksplit;
    constexpr int NG = Pol::GATHER ? 2 : 1;
    int Rr[2], Cc[2]; unsigned voffB[2]; unsigned vAc[NG][2], vAn[NG][2];
#pragma unroll
    for (int i = 0; i < 2; ++i) { stage_rc(tid * 16 + i * 8192, Rr[i], Cc[i]); voffB[i] = (unsigned)(P.brow((Rr[i] & ~31) + perm32(Rr[i] & 31)) * P.ldb + Cc[i]) * 2u;
#pragma unroll
        for (int h = 0; h < NG; ++h) vAc[h][i] = vAn[h][i] = P.aoff(Rr[i], Cc[i]); }
#define PG8_VC(h) vAc[Pol::GATHER ? (h) : 0]
#define PG8_V2(h) v2[Pol::GATHER ? (h) : 0]
    const size_t kstep = (size_t)(BK * 2);
    const size_t kstepA = Pol::KSTEP_A ? (size_t)Pol::KSTEP_A : kstep;
    const unsigned ldsw = (unsigned)wid * 1024u;
    const int aoff = lds_byte(wr * 64 + fr, fq * 8), boff = lds_byte(wc * 32 + fr, fq * 8);
#define PG8_SA(b, h) (((b) * 2 + (h)) * HTB)
#define PG8_SB(b, h) ((4 + (b) * 2 + (h)) * HTB)
#define PG8_STAGE(bufoff, gbase, voff) do { _Pragma("unroll") for (int _i = 0; _i < 2; ++_i) \
        __builtin_amdgcn_global_load_lds((const unsigned*)((const char*)(gbase) + (voff)[_i]), (PG8_LAS unsigned*)(lds + (bufoff) + ldsw + _i * 8192), 16, 0, 0); } while (0)
#define PG8_LDA(dst, b, h) do { _Pragma("unroll") for (int m = 0; m < 4; ++m) _Pragma("unroll") for (int k = 0; k < 2; ++k) dst[m][k] = *(const PG8_LAS bf16x8*)(lds + PG8_SA(b, h) + aoff + m * 2048 + k * 1024); } while (0)
#define PG8_LDB(dst, b, h) do { _Pragma("unroll") for (int n = 0; n < 2; ++n) _Pragma("unroll") for (int k = 0; k < 2; ++k) dst[n][k] = *(const PG8_LAS bf16x8*)(lds + PG8_SB(b, h) + boff + n * 2048 + k * 1024); } while (0)
#define PG8_MMA(ai, bj, At, Bt) do { __builtin_amdgcn_s_setprio(1); _Pragma("unroll") for (int m = 0; m < 4; ++m) _Pragma("unroll") for (int n = 0; n < 2; ++n) _Pragma("unroll") for (int k = 0; k < 2; ++k) \
        acc[ai][bj][m][n] = __builtin_amdgcn_mfma_f32_16x16x32_bf16(Bt[n][k], At[m][k], acc[ai][bj][m][n], 0, 0, 0); __builtin_amdgcn_s_setprio(0); } while (0)
#define PG8_WAIT_V(n) asm volatile("s_waitcnt vmcnt(" #n ")" ::: "memory")
#define PG8_WAIT_L(n) asm volatile("s_waitcnt lgkmcnt(" #n ")" ::: "memory")
#define PG8_BAR __builtin_amdgcn_s_barrier()
#define PG8_SCHED __builtin_amdgcn_sched_barrier(0)
#define PG8_BSEL(q, tk, h) ((tk) < ksplit ? (q).b##h + (size_t)(tk) * kstep : (q).c##h + (size_t)((tk) - ksplit) * kstep)
    Unit cur, nxt; UPtr cp, np_; int ui = 0;
    if (!P.next(0, cur)) return;
    P.ptrs(cur, cp);
    if constexpr (Pol::GATHER) P.gather(cur, Rr, Cc, vAc);
    f32x4 acc[2][2][4][2];
#pragma unroll
    for (int a = 0; a < 2; ++a)
#pragma unroll
        for (int b = 0; b < 2; ++b)
#pragma unroll
            for (int m = 0; m < 4; ++m)
#pragma unroll
                for (int n = 0; n < 2; ++n) acc[a][b][m][n] = (f32x4){0.f, 0.f, 0.f, 0.f};
    bf16x8 At[4][2], B0[2][2], B1[2][2];
    PG8_STAGE(PG8_SB(0, 0), cp.b0, voffB); PG8_STAGE(PG8_SB(0, 1), cp.b1, voffB); PG8_STAGE(PG8_SA(0, 0), cp.a0, PG8_VC(0)); PG8_STAGE(PG8_SA(0, 1), cp.a1, PG8_VC(1));
    if (wr == 1) PG8_BAR;
    PG8_WAIT_V(2); PG8_BAR;
    PG8_STAGE(PG8_SB(1, 0), cp.b0 + kstep, voffB); PG8_STAGE(PG8_SA(1, 0), cp.a0 + kstepA, PG8_VC(0)); PG8_STAGE(PG8_SB(1, 1), cp.b1 + kstep, voffB);
    PG8_WAIT_V(6); PG8_BAR;
    for (;;) {
        const bool has_next = P.next(ui + 1, nxt);
        if (has_next) { P.ptrs(nxt, np_); if constexpr (Pol::GATHER) P.gather(nxt, Rr, Cc, vAn); }
        else { np_ = cp; if constexpr (Pol::GATHER) {
#pragma unroll
            for (int h = 0; h < 2; ++h)
#pragma unroll
                for (int i = 0; i < 2; ++i) vAn[h][i] = vAc[h][i]; } }
#pragma unroll 1
        for (int t = 0; t < nt; t += 2) {
            const bool last = (t == nt - 2);
            if constexpr (Epi::MIDK_T >= 0) { if (t == Epi::MIDK_T) E.midk(acc, cur, wr, wc, fr, fq); }
            const char* a1_1 = cp.a1 + (size_t)(t + 1) * kstepA;
            const char *a2_0, *a2_1, *a3_0, *b2_0, *b2_1, *b3_0, *b3_1;
            unsigned v2[NG][2];
            if (!last) { a2_0 = cp.a0 + (size_t)(t + 2) * kstepA; a2_1 = cp.a1 + (size_t)(t + 2) * kstepA; a3_0 = cp.a0 + (size_t)(t + 3) * kstepA;
                         b2_0 = PG8_BSEL(cp, t + 2, 0); b2_1 = PG8_BSEL(cp, t + 2, 1); b3_0 = PG8_BSEL(cp, t + 3, 0); b3_1 = PG8_BSEL(cp, t + 3, 1); }
            else { a2_0 = np_.a0; a2_1 = np_.a1; a3_0 = np_.a0 + kstepA; b2_0 = np_.b0; b2_1 = np_.b1; b3_0 = np_.b0 + kstep; b3_1 = np_.b1 + kstep; }
#pragma unroll
            for (int h = 0; h < NG; ++h)
#pragma unroll
                for (int i = 0; i < 2; ++i) v2[h][i] = (Pol::GATHER && last) ? vAn[h][i] : vAc[h][i];
            PG8_LDB(B0, 0, 0); PG8_LDB(B1, 0, 1); PG8_SCHED; PG8_LDA(At, 0, 0); PG8_STAGE(PG8_SA(1, 1), a1_1, PG8_VC(1));
            PG8_WAIT_V(8); PG8_WAIT_L(0); PG8_BAR; PG8_MMA(0, 0, At, B0); PG8_MMA(0, 1, At, B1); PG8_BAR; PG8_SCHED;
            PG8_LDA(At, 0, 1); PG8_STAGE(PG8_SB(0, 0), b2_0, voffB); PG8_STAGE(PG8_SB(0, 1), b2_1, voffB); PG8_STAGE(PG8_SA(0, 0), a2_0, PG8_V2(0));
            PG8_WAIT_V(8); PG8_WAIT_L(0); PG8_BAR; PG8_MMA(1, 0, At, B0); PG8_MMA(1, 1, At, B1); PG8_BAR; PG8_SCHED;
            PG8_LDB(B0, 1, 0); PG8_LDB(B1, 1, 1); PG8_SCHED; PG8_LDA(At, 1, 0); PG8_STAGE(PG8_SA(0, 1), a2_1, PG8_V2(1));
            PG8_WAIT_V(8); PG8_WAIT_L(0); PG8_BAR; PG8_MMA(0, 0, At, B0); PG8_MMA(0, 1, At, B1); PG8_BAR; PG8_SCHED;
            PG8_LDA(At, 1, 1); PG8_STAGE(PG8_SB(1, 0), b3_0, voffB); PG8_STAGE(PG8_SB(1, 1), b3_1, voffB); PG8_STAGE(PG8_SA(1, 0), a3_0, PG8_V2(0));
            PG8_WAIT_V(8); PG8_WAIT_L(0); PG8_BAR; PG8_MMA(1, 0, At, B0); PG8_MMA(1, 1, At, B1); PG8_BAR; PG8_SCHED;
        }
        if constexpr (ALIGN_EPI) { if (wr == 0) PG8_BAR; }
        E(acc, cur, wr, wc, fr, fq);
        if (!has_next) break;
#pragma unroll
        for (int a = 0; a < 2; ++a)
#pragma unroll
            for (int b = 0; b < 2; ++b)
#pragma unroll
                for (int m = 0; m < 4; ++m)
#pragma unroll
                    for (int n = 0; n < 2; ++n) acc[a][b][m][n] = (f32x4){0.f, 0.f, 0.f, 0.f};
        cur = nxt; cp = np_; ++ui;
        if constexpr (Pol::GATHER) {
#pragma unroll
            for (int h = 0; h < 2; ++h)
#pragma unroll
                for (int i = 0; i < 2; ++i) vAc[h][i] = vAn[h][i]; }
        if constexpr (ALIGN_EPI) { if (wr == 1) PG8_BAR; }
    }
    PG8_WAIT_V(0);
    if constexpr (!ALIGN_EPI) { if (wr == 0) PG8_BAR; }
    PG8_BAR;
#undef PG8_SA
#undef PG8_SB
#undef PG8_STAGE
#undef PG8_LDA
#undef PG8_LDB
#undef PG8_MMA
#undef PG8_WAIT_V
#undef PG8_WAIT_L
#undef PG8_BAR
#undef PG8_SCHED
#undef PG8_BSEL
#undef PG8_VC
#undef PG8_V2
}
struct DenseOrder {
    int nM, nN, nwg, G, c;
    DI void init(int nM_, int nN_, int G_, int c_) { nM = nM_; nN = nN_; nwg = nM * nN; G = G_; c = c_; }
    DI bool get(int i, int& pm, int& pn) const {
        const long L = (long)i * G + c; if (L >= nwg) return false;
        int wgid = (int)L; { const int q = nwg / 8, r = nwg % 8, xcd = wgid % 8, off = wgid / 8; wgid = (xcd < r ? xcd * (q + 1) : r * (q + 1) + (xcd - r) * q) + off; }
        const int nig = 8 * nN, gid = wgid / nig, fm = gid * 8, gsz = (nM - fm) < 8 ? (nM - fm) : 8;
        pm = fm + ((wgid % nig) % gsz); pn = (wgid % nig) / gsz; return true;
    }
};
}

DI void adaln_item(const Params& p, unsigned char* lds, int item) {
    float* scond = (float*)lds;
    float* red = scond + 9 * 1024;
    const int tid = tidx();
    for (int i = tid; i < 9 * 1024; i += NT) { const int r = i >> 10, k = i & 1023; const float v = r < 8 ? p.c[r * 1024 + k] : p.c_ctx[k]; scond[i] = v / (1.f + __expf(-v)); }
    __syncthreads();
    const int cc = tid & 31, ks = tid >> 5, col = item * 32 + cc;
    float a[9];
#pragma unroll
    for (int r = 0; r < 9; ++r) a[r] = 0.f;
#pragma unroll 1
    for (int kb = 0; kb < 4; ++kb) {
        const int kbase = ks * 64 + kb * 16; float w[16];
#pragma unroll
        for (int u = 0; u < 16; ++u) w[u] = p.w_ada[(size_t)(kbase + u) * 6144 + col];
#pragma unroll
        for (int u = 0; u < 16; ++u)
#pragma unroll
            for (int r = 0; r < 9; ++r) a[r] += scond[r * 1024 + kbase + u] * w[u];
    }
#pragma unroll
    for (int r = 0; r < 9; ++r) red[(ks * 9 + r) * 32 + cc] = a[r];
    __syncthreads();
    float* mod = (float*)(p.ws + WS_MOD);
    for (int o = tid; o < 9 * 32; o += NT) { const int r = o >> 5, c2 = o & 31; float s = 0.f;
#pragma unroll
        for (int q = 0; q < 16; ++q) s += red[(q * 9 + r) * 32 + c2];
        mod[r * 6144 + item * 32 + c2] = s + p.b_ada[item * 32 + c2]; }
    __syncthreads();
}
DI void tp_tile(const float* src, int ld, int k0, int n0, unsigned char* lds, bf16* dst, int jobkind, int e, const float* kscale = nullptr) {
    const int lane = tidx() & 63, q = lane >> 4, c = lane & 15;
    f32x4 v[16];
#pragma unroll
    for (int i = 0; i < 16; ++i) v[i] = *(const f32x4*)(src + (size_t)(k0 + 16 * q + i) * ld + n0 + 4 * c);
    if (kscale) {
#pragma unroll
        for (int i = 0; i < 16; ++i) v[i] = v[i] * kscale[k0 + 16 * q + i]; }
#pragma unroll
    for (int j = 0; j < 4; ++j) { const int ng = n0 + 4 * c + j;
        u32x4 o0, o1;
        o0.x = pk2(v[0][j], v[1][j]); o0.y = pk2(v[2][j], v[3][j]); o0.z = pk2(v[4][j], v[5][j]); o0.w = pk2(v[6][j], v[7][j]);
        o1.x = pk2(v[8][j], v[9][j]); o1.y = pk2(v[10][j], v[11][j]); o1.z = pk2(v[12][j], v[13][j]); o1.w = pk2(v[14][j], v[15][j]);
        size_t drow; int K;
        switch (jobkind) {
          case 0: drow = ng; K = 1024; break;
          case 1: drow = ng; K = 512; break;
          case 2: drow = ng; K = 1024; break;
          case 3: case 4: { const int h = ng, R = (h >> 7) * 256 + (jobkind == 4 ? 128 : 0) + (h & 127); drow = (size_t)e * 512 + R; K = 1024; } break;
          default: drow = (size_t)e * 1024 + ng; K = 256; break;
        }
        bf16* d = dst + drow * K + k0 + 16 * q;
        *(u32x4*)d = o0; *(u32x4*)(d + 8) = o1; }
}
constexpr int TP_J0 = 16 * 8, TP_J1 = 8 * 8, TP_J2 = 16 * 16, TP_J3 = 32 * 16 * 4, TP_J4 = TP_J3, TP_J5 = 32 * 4 * 16;
constexpr int TP_ITEMS = TP_J0 + TP_J1 + TP_J2 + TP_J3 + TP_J4 + TP_J5;
DI void tp_item(const Params& p, unsigned char* lds, int it) {
    unsigned char* ws = p.ws;
    if (it < TP_J0) { tp_tile(p.w_in, 1024, (it >> 3) * 64, (it & 7) * 64, lds, (bf16*)(ws + WS_WINT), 0, 0); return; } it -= TP_J0;
    if (it < TP_J1) { tp_tile(p.w_glu, 512, (it >> 3) * 64, (it & 7) * 64, lds, (bf16*)(ws + WS_WGLUT), 1, 0); return; } it -= TP_J1;
    if (it < TP_J2) { tp_tile(p.w_out, 1024, (it >> 4) * 64, (it & 15) * 64, lds, (bf16*)(ws + WS_WOUTT), 2, 0, (it >> 4) * 64 < 512 ? p.g_s : nullptr); return; } it -= TP_J2;
    if (it < TP_J3) { const int e = it >> 6, r = it & 63; tp_tile(p.w_gate + (size_t)e * 1024 * 256, 256, (r >> 2) * 64, (r & 3) * 64, lds, (bf16*)(ws + WS_WGUT), 3, e); return; } it -= TP_J3;
    if (it < TP_J4) { const int e = it >> 6, r = it & 63; tp_tile(p.w_up + (size_t)e * 1024 * 256, 256, (r >> 2) * 64, (r & 3) * 64, lds, (bf16*)(ws + WS_WGUT), 4, e); return; } it -= TP_J4;
    { const int e = it >> 6, r = it & 63; tp_tile(p.w_down + (size_t)e * 256 * 1024, 1024, (r >> 4) * 64, (r & 15) * 64, lds, (bf16*)(ws + WS_WDT), 5, e); }
}
DI void gfold_item(const Params& p, unsigned char* lds, int item) {
    const int q = item >> 6, k0 = (item & 63) * 16, tid = tidx();
    constexpr int TP = 132;
    float* wv = (float*)lds;
    float* T = wv + 16 * 128;
    float* fw = T + 32 * TP;
    float* cs2 = fw + 128 * 128;
    for (int i = tid; i < 16 * 32; i += NT) *(f32x4*)(wv + i * 4) = *(const f32x4*)(p.w_in + (size_t)(k0 + (i >> 5)) * 1024 + 512 + 128 * q + (i & 31) * 4);
    for (int i = tid; i < 128 * 32; i += NT) *(f32x4*)(fw + i * 4) = *(const f32x4*)(p.fourier_w + (size_t)q * 128 * 128 + i * 4);
    if (tid < 128) { double s, c; sincospi((double)tid / 64.0, &s, &c); cs2[tid * 2] = (float)c; cs2[tid * 2 + 1] = (float)s; }
    __syncthreads();
    { const int n = tid & 127, r0 = (tid >> 7) * 4;
      float sr[4] = {0.f, 0.f, 0.f, 0.f}, si[4] = {0.f, 0.f, 0.f, 0.f};
      for (int m = 0; m < 128; m += 4) { f32x4 w[4]; float c[4], sv[4];
#pragma unroll
          for (int r = 0; r < 4; ++r) w[r] = *(const f32x4*)(wv + (r0 + r) * 128 + m);
#pragma unroll
          for (int u = 0; u < 4; ++u) { const int ix = (n * (m + u)) & 127; c[u] = cs2[ix * 2]; sv[u] = cs2[ix * 2 + 1]; }
#pragma unroll
          for (int r = 0; r < 4; ++r)
#pragma unroll
              for (int u = 0; u < 4; ++u) { sr[r] += w[r][u] * c[u]; si[r] -= w[r][u] * sv[u]; } }
#pragma unroll
      for (int r = 0; r < 4; ++r) { T[((r0 + r) * 2 + 0) * TP + n] = sr[r]; T[((r0 + r) * 2 + 1) * TP + n] = si[r]; } }
    __syncthreads();
    bf16* WinT = (bf16*)(p.ws + WS_WINT);
    const float scale = 1.0f / 724.0773439350247f;
    { const int j = tid & 127, rc0 = (tid >> 7) * 8;
      float acc[8] = {0.f, 0.f, 0.f, 0.f, 0.f, 0.f, 0.f, 0.f};
      for (int n = 0; n < 128; n += 4) { float f[4]; f32x4 t[8];
#pragma unroll
          for (int u = 0; u < 4; ++u) f[u] = fw[(n + u) * 128 + j];
#pragma unroll
          for (int e = 0; e < 8; ++e) t[e] = *(const f32x4*)(T + (rc0 + e) * TP + n);
#pragma unroll
          for (int e = 0; e < 8; ++e)
#pragma unroll
              for (int u = 0; u < 4; ++u) acc[e] += t[e][u] * f[u]; }
#pragma unroll
      for (int e = 0; e < 8; ++e) { const int rc = rc0 + e, r = rc >> 1, c = rc & 1;
          WinT[(size_t)(512 + c * 512 + q * 128 + j) * 1024 + k0 + r] = (bf16)(pk2(acc[e] * scale, 0.f) & 0xffffu); } }
    __syncthreads();
}
DI void s5mats_item(const Params& p, unsigned char* lds, int item) {
    const int g = item >> 3, part = item & 7;
    const int tid = tidx();
    float* Bb = (float*)lds;
    float* Cc = Bb + 4096;
    float* pw = Cc + 4096;
    float* Kt = pw + 8448;
    float* qv = Kt;
    if (tid < 128) { const int d = tid >> 6, pp = tid & 63;
        const double dt = exp((double)p.log_step[d * 32 + g]); const double lr = p.lam_re[(d * 32 + g) * 64 + pp], li = p.lam_im[(d * 32 + g) * 64 + pp];
        const double mag = exp(lr * dt); double tt = li * dt / 3.14159265358979323846; tt -= 2.0 * floor(tt * 0.5);
        double sn, cs; sincospi(tt, &sn, &cs); const double ar = mag * cs, ai = mag * sn;
        const double nr = ar - 1.0, ni = ai, den = lr * lr + li * li;
        qv[tid * 2] = (float)((nr * lr + ni * li) / den); qv[tid * 2 + 1] = (float)((ni * lr - nr * li) / den);
        double pr = 1.0, pi = 0.0;
        for (int k = 0; k < 33; ++k) { pw[(tid * 33 + k) * 2] = (float)pr; pw[(tid * 33 + k) * 2 + 1] = (float)pi; const double t2 = pr * ar - pi * ai; pi = pr * ai + pi * ar; pr = t2; } }
    __syncthreads();
    for (int idx = tid; idx < 2 * 64 * 16; idx += NT) { const int dp = idx >> 4, h = idx & 15; const float qr = qv[dp * 2], qi = qv[dp * 2 + 1];
        const int d = dp >> 6, pp = dp & 63;
        const float br = p.b_re[((size_t)(d * 32 + g) * 64 + pp) * 16 + h], bi = p.b_im[((size_t)(d * 32 + g) * 64 + pp) * 16 + h];
        Bb[idx * 2] = qr * br - qi * bi; Bb[idx * 2 + 1] = qr * bi + qi * br; }
    for (int idx = tid; idx < 2 * 16 * 64; idx += NT) { const int d = idx >> 10, i = (idx >> 6) & 15, pp = idx & 63;
        Cc[idx * 2] = p.c_re[((size_t)(d * 32 + g) * 16 + i) * 64 + pp]; Cc[idx * 2 + 1] = p.c_im[((size_t)(d * 32 + g) * 16 + i) * 64 + pp]; }
    __syncthreads();
    { const int t3 = tid >> 2, pq = tid & 3, d = t3 >> 6, k = (t3 >> 1) & 31, i = part * 2 + (t3 & 1);
      float acc[16];
#pragma unroll
      for (int h = 0; h < 16; ++h) acc[h] = 0.f;
      for (int pp = pq * 16; pp < pq * 16 + 16; ++pp) {
          const float cr = Cc[((d * 16 + i) * 64 + pp) * 2], ci = Cc[((d * 16 + i) * 64 + pp) * 2 + 1];
          const float wr = pw[((d * 64 + pp) * 33 + k) * 2], wi = pw[((d * 64 + pp) * 33 + k) * 2 + 1];
          const float xr = cr * wr - ci * wi, xi = cr * wi + ci * wr;
          const f32x4* bb = (const f32x4*)(Bb + (d * 64 + pp) * 32);
#pragma unroll
          for (int h2 = 0; h2 < 8; ++h2) { const f32x4 b2 = bb[h2]; acc[2 * h2] += xr * b2.x - xi * b2.y; acc[2 * h2 + 1] += xr * b2.z - xi * b2.w; } }
#pragma unroll
      for (int h = 0; h < 16; ++h) { acc[h] += __shfl_xor(acc[h], 1); acc[h] += __shfl_xor(acc[h], 2); }
      if (pq == 0) {
#pragma unroll
          for (int h4 = 0; h4 < 4; ++h4) *(f32x4*)(Kt + ((d * 32 + k) * 16 + i) * 16 + h4 * 4) = (f32x4){acc[h4 * 4], acc[h4 * 4 + 1], acc[h4 * 4 + 2], acc[h4 * 4 + 3]}; } }
    __syncthreads();
    bf16* Mg = (bf16*)(p.ws + WS_MGW) + (size_t)g * 512 * 768;
    for (int c4 = tid; c4 < 64 * 64; c4 += NT) { const int rq = c4 >> 6, c8 = c4 & 63, j = rq >> 1, i = part * 2 + (rq & 1), row = j * 16 + i, s = c8 >> 1, h0 = (c8 & 1) * 8; float v[8];
#pragma unroll
        for (int t = 0; t < 8; ++t) { float a = 0.f; if (s <= j) a += Kt[((0 * 32 + (j - s)) * 16 + i) * 16 + h0 + t]; if (s >= j) a += Kt[((1 * 32 + (s - j)) * 16 + i) * 16 + h0 + t]; v[t] = a; }
        u32x4 o; o.x = pk2(v[0], v[1]); o.y = pk2(v[2], v[3]); o.z = pk2(v[4], v[5]); o.w = pk2(v[6], v[7]);
        *(u32x4*)(Mg + (size_t)row * 768 + c8 * 8) = o; }
    bf16* Wst = (bf16*)(p.ws + WS_WST) + (size_t)g * 256 * 512;
    for (int c4 = tid; c4 < 32 * 64; c4 += NT) { const int r = part * 32 + (c4 >> 6), c8 = c4 & 63, s = c8 >> 1, h0 = (c8 & 1) * 8, d = r >> 7, c = (r >> 6) & 1, pp = r & 63;
        const int e = d == 0 ? 31 - s : s; const float wr = pw[((d * 64 + pp) * 33 + e) * 2], wi = pw[((d * 64 + pp) * 33 + e) * 2 + 1]; float v[8];
#pragma unroll
        for (int t = 0; t < 8; ++t) { const float br = Bb[((d * 64 + pp) * 16 + h0 + t) * 2], bi = Bb[((d * 64 + pp) * 16 + h0 + t) * 2 + 1]; v[t] = c == 0 ? wr * br - wi * bi : wr * bi + wi * br; }
        u32x4 o; o.x = pk2(v[0], v[1]); o.y = pk2(v[2], v[3]); o.z = pk2(v[4], v[5]); o.w = pk2(v[6], v[7]);
        *(u32x4*)(Wst + (size_t)r * 512 + c8 * 8) = o; }
    bf16* Wos = (bf16*)(p.ws + WS_MGW) + (size_t)g * 512 * 768 + 512;
    for (int c4 = tid; c4 < 64 * 32; c4 += NT) { const int rq = c4 >> 5, c8 = c4 & 31, j = rq >> 1, i = part * 2 + (rq & 1), row = j * 16 + i, col0 = c8 * 8, d = col0 >> 7, c = (col0 >> 6) & 1, p0 = col0 & 63;
        const int e = d == 0 ? j + 1 : 32 - j; float v[8];
#pragma unroll
        for (int t = 0; t < 8; ++t) { const int pp = p0 + t; const float cr = Cc[((d * 16 + i) * 64 + pp) * 2], ci = Cc[((d * 16 + i) * 64 + pp) * 2 + 1];
            const float wr = pw[((d * 64 + pp) * 33 + e) * 2], wi = pw[((d * 64 + pp) * 33 + e) * 2 + 1]; v[t] = c == 0 ? cr * wr - ci * wi : -(cr * wi + ci * wr); }
        u32x4 o; o.x = pk2(v[0], v[1]); o.y = pk2(v[2], v[3]); o.z = pk2(v[4], v[5]); o.w = pk2(v[6], v[7]);
        *(u32x4*)(Wos + (size_t)row * 768 + c8 * 8) = o; }
    float* aT = (float*)(p.ws + WS_ABART) + g * 256;
    if (part == 0 && tid < 128) { const int d = tid >> 6, pp = tid & 63; aT[tid * 2] = pw[((d * 64 + pp) * 33 + 32) * 2]; aT[tid * 2 + 1] = pw[((d * 64 + pp) * 33 + 32) * 2 + 1]; }
    __syncthreads();
}
DI void fftc_item(const Params& p, int item) {
    const int tid = tidx();
    bf16* W1 = (bf16*)(p.ws + WS_FFTC);
    bf16* W2 = W1 + 128 * 128;
    float* tw = (float*)(p.ws + WS_FFTC + 32768 + 16384);
    for (int idx = item * NT + tid; idx < 128 * 128 + 4 * 64 * 32 + 4096; idx += 8 * NT) {
        if (idx < 16384) { const int n = idx >> 7, k = idx & 127, co = n >> 6, d = n & 63, ci = k >> 6, bq = k & 63; double s, c; sincospi((double)((d * bq) & 63) / 32.0, &s, &c);
            const float v = (ci == co) ? (float)c : (ci == 1 ? (float)s : (float)(-s)); W1[idx] = (bf16)(pk2(v, 0.f) & 0xffffu); }
        else if (idx < 16384 + 8192) { const int i2 = idx - 16384, s_ = i2 >> 11, cf = (i2 >> 5) & 63, slot = i2 & 31, gq = slot >> 3, jp = slot & 7;
            const int a = 16 * (2 * (s_ & 1) + (jp >> 2)) + 4 * gq + (jp & 3); double s, c; sincospi((double)((cf * a) & 63) / 32.0, &s, &c);
            W2[i2] = (bf16)(pk2((s_ >> 1) == 0 ? (float)c : (float)s, 0.f) & 0xffffu); }
        else { const int i3 = idx - 16384 - 8192, ln = i3 & 63, r = (i3 >> 6) & 3, mt = (i3 >> 8) & 3, nt = i3 >> 10; const int d = 16 * nt + (ln & 15), a = 16 * mt + 4 * (ln >> 4) + r;
            double s, c; sincospi((double)((d * a) & 4095) / 2048.0, &s, &c); tw[i3 * 2] = (float)c; tw[i3 * 2 + 1] = (float)s; }
    }
}
constexpr int P0_S5 = 256, P0_GF = 256, P0_FC = 8, P0_RW = 1;
constexpr int P0_ITEMS = P0_S5 + P0_GF + P0_FC + P0_RW;
DI void rw_item(const Params& p) {
    bf16* W = (bf16*)(p.ws + WS_WRT);
    for (int i = tidx(); i < 48 * 1024; i += NT) { const int n = i >> 10, k = i & 1023; const float v = n < 4 ? p.w_group[k * 4 + n] : (n < 36 ? p.w_router[k * 32 + (n - 4)] : 0.f); W[i] = (bf16)(pk2(v, 0.f) & 0xffffu); }
}
DI void phaseA_adaln(const Params& p, unsigned char* lds, int bid, int nb) {
    for (int it = bid; it < 192; it += nb) adaln_item(p, lds, it);
}
DI void a1_item(const Params& p, int r0) {
    const int lane = tidx() & 63;
    const float* mod = (const float*)(p.ws + WS_MOD);
    bf16* A1 = (bf16*)(p.ws + WS_R1);
    constexpr int RW = 4;
    const float* src = r0 < NTOK ? p.x + (size_t)r0 * D : p.ctx + (size_t)(r0 - NTOK) * D;
    const int mr = r0 < NTOK ? (r0 >> 12) : 8;
    f32x4 v[RW][4]; float s[RW];
#pragma unroll
    for (int q = 0; q < RW; ++q)
#pragma unroll
        for (int j = 0; j < 4; ++j) v[q][j] = ((const f32x4*)(src + (size_t)q * D) + lane)[64 * j];
    f32x4 gm[4], sh[4];
#pragma unroll
    for (int j = 0; j < 4; ++j) { const int k = lane * 4 + 256 * j; gm[j] = *(const f32x4*)(p.norm1_g + k) * (*(const f32x4*)(mod + mr * 6144 + 1024 + k) + 1.f); sh[j] = *(const f32x4*)(mod + mr * 6144 + k); }
#pragma unroll
    for (int q = 0; q < RW; ++q) { float t = 0.f;
#pragma unroll
        for (int j = 0; j < 4; ++j) t += (v[q][j].x * v[q][j].x + v[q][j].y * v[q][j].y) + (v[q][j].z * v[q][j].z + v[q][j].w * v[q][j].w);
        s[q] = t; }
#pragma unroll
    for (int o = 1; o < 64; o <<= 1) {
#pragma unroll
        for (int q = 0; q < RW; ++q) s[q] += __shfl_xor(s[q], o); }
#pragma unroll
    for (int q = 0; q < RW; ++q) { const float rs = rsqrtf(s[q] * (1.f / D) + EPS); u32x2* o = (u32x2*)(A1 + (size_t)(r0 + q) * D) + lane;
#pragma unroll
        for (int j = 0; j < 4; ++j) { const f32x4 h = v[q][j] * rs * gm[j] + sh[j]; u32x2 w; w.x = pk2(h.x, h.y); w.y = pk2(h.z, h.w); o[64 * j] = w; } }
}
constexpr int WI_A1 = NROWS1 / 4, WI_ALL = WI_A1 + TP_ITEMS;
DI void phaseB_prep(const Params& p, unsigned char* lds, int bid, int nb) {
    for (int it = bid; it < P0_ITEMS; it += nb) {
        int r = it;
        if (r < P0_S5) { s5mats_item(p, lds, r); continue; } r -= P0_S5;
        if (r < P0_GF) { gfold_item(p, lds, r); continue; } r -= P0_GF;
        if (r < P0_FC) { fftc_item(p, r); continue; } r -= P0_FC;
        rw_item(p);
    }
    __syncthreads();
    const int wid = tidx() >> 6;
    for (int it = bid * 8 + wid; it < WI_ALL; it += nb * 8) {
        if (it < WI_A1) a1_item(p, it * 4); else tp_item(p, lds, it - WI_A1);
    }
}

struct G1uPol {
    static constexpr long KSTEP_A = 0;
    DI unsigned aoff(int R, int C) const { return (unsigned)(R * lda + C) * 2u; }
    struct Unit { int pm, pn; };
    static constexpr bool GATHER = false;
    pg8::DenseOrder ord; const char* A; const char* B; int K, ksplit, lda, ldb;
    DI bool next(int i, Unit& u) const { return ord.get(i, u.pm, u.pn); }
    DI void ptrs(const Unit& u, pg8::UPtr& q) const { q.a0 = A + (size_t)u.pm * 256 * lda * 2; q.a1 = q.a0 + (size_t)128 * lda * 2; q.b0 = B + (size_t)u.pn * 256 * ldb * 2; q.b1 = q.b0 + (size_t)128 * ldb * 2; q.c0 = q.b0; q.c1 = q.b1; }
    DI int brow(int R) const { return R; }
    DI void gather(const Unit&, int (&)[2], int (&)[2], unsigned (&)[2][2]) const {}
};
struct G1uEpi {
    static constexpr int MIDK_T = -1;
    bf16* Ul;
    DI void operator()(const f32x4 (&acc)[2][2][4][2], const G1uPol::Unit& u, int wr, int wc, int fr, int fq) const {
#pragma unroll
        for (int ai = 0; ai < 2; ++ai)
#pragma unroll
            for (int m = 0; m < 4; ++m) { const int row = u.pm * 256 + ai * 128 + wr * 64 + m * 16 + fr, b = row >> 12, l = row & 4095;
#pragma unroll
                for (int bj = 0; bj < 2; ++bj) { const int c0 = u.pn * 256 + bj * 128 + wc * 32 + 8 * fq, g = c0 >> 4, h0 = c0 & 15;
                    const f32x4 a0 = acc[ai][bj][m][0], a1 = acc[ai][bj][m][1];
                    u32x4 w; w.x = pk2(a0[0], a0[1]); w.y = pk2(a0[2], a0[3]); w.z = pk2(a1[0], a1[1]); w.w = pk2(a1[2], a1[3]);
                    *(u32x4*)(Ul + (((size_t)g * 1024 + b * 128 + (l >> 5)) * 768 + (l & 31) * 16 + h0)) = w; } }
    }
};
struct G1gPol {
    static constexpr long KSTEP_A = 0;
    DI unsigned aoff(int R, int C) const { return (unsigned)(R * lda + C) * 2u; }
    struct Unit { int pm, pn; };
    static constexpr bool GATHER = false;
    pg8::DenseOrder ord; const char* A; const char* B; int K, ksplit, lda, ldb;
    DI bool next(int i, Unit& u) const { return ord.get(i, u.pm, u.pn); }
    DI void ptrs(const Unit& u, pg8::UPtr& q) const { q.a0 = A + (size_t)u.pm * 256 * lda * 2; q.a1 = q.a0 + (size_t)128 * lda * 2;
        const int b = u.pn >> 4, a0 = (u.pn & 15) * 4; q.b0 = B + (size_t)(b * 4096 + a0) * ldb * 2; q.b1 = q.b0 + (size_t)2 * ldb * 2; q.c0 = q.b0; q.c1 = q.b1; }
    DI int brow(int R) const { return (R & 63) * 64 + (R >> 6); }
    DI void gather(const Unit&, int (&)[2], int (&)[2], unsigned (&)[2][2]) const {}
};
struct G1gEpi {
    static constexpr int MIDK_T = -1;
    bf16* GT;
    DI void operator()(const f32x4 (&acc)[2][2][4][2], const G1gPol::Unit& u, int wr, int wc, int fr, int fq) const {
        const int b = u.pn >> 4, a0 = (u.pn & 15) * 4;
#pragma unroll
        for (int ai = 0; ai < 2; ++ai)
#pragma unroll
            for (int m = 0; m < 4; ++m) { const int mm = u.pm * 256 + ai * 128 + wr * 64 + m * 16 + fr, c = mm >> 9, ch = mm & 511;
                bf16* base = GT + (size_t)((b * 512 + ch) * 2 + c) * 4096;
#pragma unroll
                for (int bj = 0; bj < 2; ++bj) { const int a = a0 + 2 * bj + (wc >> 1), bq = 32 * (wc & 1) + 8 * fq;
                    const f32x4 v0 = acc[ai][bj][m][0], v1 = acc[ai][bj][m][1];
                    u32x4 w; w.x = pk2(v0[0], v0[1]); w.y = pk2(v0[2], v0[3]); w.z = pk2(v1[0], v1[1]); w.w = pk2(v1[2], v1[3]);
                    *(u32x4*)(base + a * 64 + bq) = w; } }
    }
};
DI void phase1b(const Params& p, unsigned char* lds, int bid, int nb) {
    { G1gPol P; P.ord.init(4, NTOK / 256, nb, bid); P.A = (const char*)(p.ws + WS_WINT) + (size_t)512 * 2048; P.B = (const char*)(p.ws + WS_R1); P.K = 1024; P.ksplit = 16; P.lda = 1024; P.ldb = 1024;
      G1gEpi E{(bf16*)(p.ws + WS_R2)};
      pg8::gemm_phase<G1gPol, G1gEpi, true>((PG8_LAS unsigned char*)lds, P, E); }
    { G1uPol P; P.ord.init(NTOK / 256, 2, nb, bid); P.A = (const char*)(p.ws + WS_R1); P.B = (const char*)(p.ws + WS_WINT); P.K = 1024; P.ksplit = 16; P.lda = 1024; P.ldb = 1024;
      G1uEpi E{(bf16*)(p.ws + WS_R3)};
      pg8::gemm_phase<G1uPol, G1uEpi, true>((PG8_LAS unsigned char*)lds, P, E); }
    { const int tid = tidx(), lane = tid & 63, wid = tid >> 6, fr = lane & 15, fq = lane >> 4;
      for (int item = bid; item < 256; item += nb) { const int g = item >> 3, b = item & 7;
          const bf16* A1c = (const bf16*)(p.ws + WS_R1) + (size_t)(NTOK + b * 256 + wid * 32) * D; const bf16* Wg = (const bf16*)(p.ws + WS_WINT) + (size_t)(g * 16) * D;
          f32x4 ca[2] = {(f32x4){0.f, 0.f, 0.f, 0.f}, (f32x4){0.f, 0.f, 0.f, 0.f}};
#pragma unroll 8
          for (int ks = 0; ks < 32; ++ks) { const bf16x8 bw = *(const bf16x8*)(Wg + (size_t)fr * D + ks * 32 + fq * 8);
              const bf16x8 a0 = *(const bf16x8*)(A1c + (size_t)fr * D + ks * 32 + fq * 8), a1 = *(const bf16x8*)(A1c + (size_t)(16 + fr) * D + ks * 32 + fq * 8);
              ca[0] = __builtin_amdgcn_mfma_f32_16x16x32_bf16(bw, a0, ca[0], 0, 0, 0); ca[1] = __builtin_amdgcn_mfma_f32_16x16x32_bf16(bw, a1, ca[1], 0, 0, 0); }
          bf16* Ucw = (bf16*)(p.ws + WS_UCTX) + (size_t)(g * 8 + b) * 256 * 16;
#pragma unroll
          for (int mt = 0; mt < 2; ++mt) { u32x2 w; w.x = pk2(ca[mt][0], ca[mt][1]); w.y = pk2(ca[mt][2], ca[mt][3]); *(u32x2*)(Ucw + (size_t)(wid * 32 + mt * 16 + fr) * 16 + 4 * fq) = w; } } }
}
constexpr int S5_SB_OFF = GC<2>::LDS, S5_PITCH = 528, S5_LDS = S5_SB_OFF + 144 * S5_PITCH;
DI void phase2_s5(const Params& p, unsigned char* lds, int bid, int nb) {
    const int tid = tidx(), lane = tid & 63, wid = tid >> 6, wm = wid >> 1, wn = wid & 1, fr = lane & 15, fq = lane >> 4, srow = tid >> 3, sck = tid & 7;
    const bf16* zero = (const bf16*)(p.ws + WS_CTL + CTL_ZERO);
    unsigned char* Sb = lds + S5_SB_OFF;
    for (int item = bid; item < 256; item += nb) {
        const int g = item >> 3, b = item & 7;
        bf16* Ucat = (bf16*)(p.ws + WS_R3) + ((size_t)g * 1024 + b * 128) * 768;
        const bf16* Uc = (const bf16*)(p.ws + WS_UCTX) + (size_t)(g * 8 + b) * 256 * 16;
        const bf16* Wst = (const bf16*)(p.ws + WS_WST) + (size_t)g * 256 * 512;
        for (int pass = 0; pass < 4; ++pass) {
            const int n0 = (pass & 1) * 128, isctx = pass >> 1;
            f32x4 acc[2][4]; zero_acc<2>(acc);
            const bf16* ap[2]; int as[2]; const bf16* bp[2];
#pragma unroll
            for (int i = 0; i < 2; ++i) { const int r = 64 * i + srow;
                if (!isctx) { ap[i] = Ucat + (size_t)r * 768 + sck * 8; as[i] = 64; }
                else if (r < 8) { ap[i] = Uc + (size_t)r * 512 + sck * 8; as[i] = 64; }
                else { ap[i] = zero; as[i] = 0; }
                bp[i] = Wst + (size_t)(n0 + r) * 512 + sck * 8; }
            gemm_loop<2>(acc, ap, as, bp, 8, lds);
#pragma unroll
            for (int mt = 0; mt < 2; ++mt) { const int row = wm * 32 + mt * 16 + fr;
                if (!isctx || row < 8) {
#pragma unroll
                    for (int nt = 0; nt < 4; ++nt) { const int col = n0 + wn * 64 + nt * 16 + 4 * fq;
                        u32x2 w; w.x = pk2(acc[mt][nt][0], acc[mt][nt][1]); w.y = pk2(acc[mt][nt][2], acc[mt][nt][3]);
                        *(u32x2*)(Sb + (size_t)((isctx ? 128 : 0) + row) * S5_PITCH + col * 2) = w; } } }
        }
        __syncthreads();
        if (tid < 128) {
            const int d = tid >> 6, pp = tid & 63; const float* aT = (const float*)(p.ws + WS_ABART) + g * 256 + tid * 2; const float ar = aT[0], ai = aT[1];
            const bf16* colr = (const bf16*)Sb + d * 128 + pp; const bf16* coli = colr + 64; constexpr int RP = S5_PITCH / 2;
            bf16* outr = Ucat + 512 + d * 128 + pp; bf16* outi = outr + 64;
            float hr = 0.f, hi = 0.f;
            { float sr[8], si[8];
#pragma unroll
              for (int j = 0; j < 8; ++j) { const int c = d == 0 ? j : 7 - j; sr[j] = bf2f(colr[(128 + c) * RP]); si[j] = bf2f(coli[(128 + c) * RP]); }
#pragma unroll
              for (int j = 0; j < 8; ++j) { const float nr = ar * hr - ai * hi + sr[j], ni = ar * hi + ai * hr + si[j]; hr = nr; hi = ni; } }
#pragma unroll 1
            for (int cb = 0; cb < 128; cb += 16) { float sr[16], si[16];
#pragma unroll
                for (int j = 0; j < 16; ++j) { const int c = d == 0 ? cb + j : 127 - cb - j; sr[j] = bf2f(colr[c * RP]); si[j] = bf2f(coli[c * RP]); }
#pragma unroll
                for (int j = 0; j < 16; ++j) { const int c = d == 0 ? cb + j : 127 - cb - j; const unsigned w = pk2(hr, hi);
                    outr[(size_t)c * 768] = (bf16)(w & 0xffffu); outi[(size_t)c * 768] = (bf16)(w >> 16);
                    const float nr = ar * hr - ai * hi + sr[j], ni = ar * hi + ai * hr + si[j]; hr = nr; hi = ni; } }
        }
        __syncthreads();
    }
}
struct S5cPol {
    static constexpr long KSTEP_A = 0;
    DI unsigned aoff(int R, int C) const { return (unsigned)(R * lda + C) * 2u; }
    struct Unit { int g, mt, pn; };
    static constexpr bool GATHER = false;
    int G, c; const char* A; const char* B; int K, ksplit, lda, ldb;
    DI bool next(int i, Unit& u) const { const int L = i * G + c; if (L >= 256) return false; u.g = L >> 3; u.mt = (L >> 1) & 3; u.pn = L & 1; return true; }
    DI void ptrs(const Unit& u, pg8::UPtr& q) const { q.a0 = A + ((size_t)u.g * 1024 + u.mt * 256) * lda * 2; q.a1 = q.a0 + (size_t)128 * lda * 2; q.b0 = B + ((size_t)u.g * 512 + u.pn * 256) * ldb * 2; q.b1 = q.b0 + (size_t)128 * ldb * 2; q.c0 = q.b0; q.c1 = q.b1; }
    DI int brow(int R) const { return R; }
    DI void gather(const Unit&, int (&)[2], int (&)[2], unsigned (&)[2][2]) const {}
};
struct S5cEpi {
    static constexpr int MIDK_T = -1;
    const bf16* Ucat; const float* s5d; bf16* yact;
    DI void operator()(const f32x4 (&acc)[2][2][4][2], const S5cPol::Unit& u, int wr, int wc, int fr, int fq) const {
        const int n0 = u.pn * 256 + wc * 32 + 8 * fq, i0 = n0 & 15;
        const f32x4 d0 = *(const f32x4*)(s5d + u.g * 16 + i0), d1 = *(const f32x4*)(s5d + u.g * 16 + i0 + 4);
        u32x4 uu[2][4][2];
#pragma unroll
        for (int ai = 0; ai < 2; ++ai)
#pragma unroll
            for (int m = 0; m < 4; ++m) { const int row = u.mt * 256 + ai * 128 + wr * 64 + m * 16 + fr;
#pragma unroll
                for (int bj = 0; bj < 2; ++bj) uu[ai][m][bj] = *(const u32x4*)(Ucat + ((size_t)u.g * 1024 + row) * 768 + n0 + bj * 128); }
#pragma unroll
        for (int ai = 0; ai < 2; ++ai)
#pragma unroll
            for (int m = 0; m < 4; ++m) { const int row = u.mt * 256 + ai * 128 + wr * 64 + m * 16 + fr, b = row >> 7, c = row & 127;
#pragma unroll
                for (int bj = 0; bj < 2; ++bj) { const int col = n0 + bj * 128, l = 32 * c + (col >> 4); const u32x4 v = uu[ai][m][bj]; const f32x4 a0 = acc[ai][bj][m][0], a1 = acc[ai][bj][m][1];
                    const float y0 = geluf_(a0[0] + d0.x * __uint_as_float(v.x << 16)), y1 = geluf_(a0[1] + d0.y * __uint_as_float(v.x & 0xffff0000u));
                    const float y2 = geluf_(a0[2] + d0.z * __uint_as_float(v.y << 16)), y3 = geluf_(a0[3] + d0.w * __uint_as_float(v.y & 0xffff0000u));
                    const float y4 = geluf_(a1[0] + d1.x * __uint_as_float(v.z << 16)), y5 = geluf_(a1[1] + d1.y * __uint_as_float(v.z & 0xffff0000u));
                    const float y6 = geluf_(a1[2] + d1.z * __uint_as_float(v.w << 16)), y7 = geluf_(a1[3] + d1.w * __uint_as_float(v.w & 0xffff0000u));
                    u32x4 w; w.x = pk2(y0, y1); w.y = pk2(y2, y3); w.z = pk2(y4, y5); w.w = pk2(y6, y7);
                    *(u32x4*)(yact + (((size_t)u.g * NTOK + b * 4096 + l) * 16 + i0)) = w; } }
    }
};
DI void phase2c_s5out(const Params& p, unsigned char* lds, int bid, int nb) {
    S5cPol P; P.G = nb; P.c = (nb % 8 == 0) ? (bid % 8) * (nb / 8) + bid / 8 : bid; P.A = (const char*)(p.ws + WS_R3); P.B = (const char*)(p.ws + WS_MGW); P.K = 768; P.ksplit = 12; P.lda = 768; P.ldb = 768;
    S5cEpi E{(const bf16*)(p.ws + WS_R3), p.s5_d, (bf16*)(p.ws + WS_R4)};
    pg8::gemm_phase<S5cPol, S5cEpi, true>((PG8_LAS unsigned char*)lds, P, E);
}
constexpr int FF_W1P = 272, FF_W2P = 80, FF_W1_OFF = 0, FF_W2_OFF = 128 * FF_W1P, FF_TW_OFF = FF_W2_OFF + 4 * 64 * FF_W2P, FF_LDS = FF_TW_OFF + 32768;
DI void phase2_fft(const Params& p, unsigned char* lds, int bid, int nb) {
    const int tid = tidx(), lane = tid & 63, wid = tid >> 6, fr = lane & 15, fq = lane >> 4;
    { const bf16* W1 = (const bf16*)(p.ws + WS_FFTC); const bf16* W2 = W1 + 128 * 128; const float* tw = (const float*)(p.ws + WS_FFTC + 32768 + 16384);
      for (int i = tid; i < 128 * 16; i += NT) { const int n = i >> 4, c = i & 15; *(u32x4*)(lds + FF_W1_OFF + n * FF_W1P + c * 16) = *(const u32x4*)(W1 + n * 128 + c * 8); }
      for (int i = tid; i < 256 * 4; i += NT) { const int r = i >> 2, c = i & 3; *(u32x4*)(lds + FF_W2_OFF + r * FF_W2P + c * 16) = *(const u32x4*)(W2 + r * 32 + c * 8); }
      for (int i = tid; i < 2048; i += NT) *(u32x4*)(lds + FF_TW_OFF + i * 16) = *(const u32x4*)(tw + i * 4);
      __syncthreads(); }
    const bf16* GT = (const bf16*)(p.ws + WS_R2); bf16* FT = (bf16*)(p.ws + WS_R5);
    const float* twl = (const float*)(lds + FF_TW_OFF) + lane * 2;
    for (int cidx = bid * 8 + wid; cidx < 4096; cidx += nb * 8) {
        const bf16* gt = GT + (size_t)cidx * 2 * 4096;
        bf16* ft = FT + (size_t)cidx * 4096;
        bf16x8 afr[4][4];
#pragma unroll
        for (int ks = 0; ks < 4; ++ks)
#pragma unroll
            for (int mt = 0; mt < 4; ++mt) afr[ks][mt] = *(const bf16x8*)(gt + (ks >> 1) * 4096 + (16 * mt + fr) * 64 + 32 * (ks & 1) + 8 * fq);
        f32x4 d1[4][8];
#pragma unroll
        for (int m = 0; m < 4; ++m)
#pragma unroll
            for (int n = 0; n < 8; ++n) d1[m][n] = (f32x4){0.f, 0.f, 0.f, 0.f};
#pragma unroll
        for (int ks = 0; ks < 4; ++ks) {
#pragma unroll
            for (int nt = 0; nt < 8; ++nt) { const bf16x8 bfr = *(const bf16x8*)(lds + FF_W1_OFF + (nt * 16 + fr) * FF_W1P + (ks * 32 + fq * 8) * 2);
#pragma unroll
                for (int mt = 0; mt < 4; ++mt) d1[mt][nt] = __builtin_amdgcn_mfma_f32_16x16x32_bf16(afr[ks][mt], bfr, d1[mt][nt], 0, 0, 0); }
        }
#pragma unroll
        for (int nt = 0; nt < 4; ++nt) {
            unsigned pr[4][2], pi[4][2];
#pragma unroll
            for (int mt = 0; mt < 4; ++mt) { float tr[4], ti[4];
#pragma unroll
                for (int r = 0; r < 4; ++r) { const float cs = twl[((nt * 4 + mt) * 4 + r) * 128], sn = twl[((nt * 4 + mt) * 4 + r) * 128 + 1];
                    const float re = d1[mt][nt][r], im = d1[mt][nt + 4][r]; tr[r] = re * cs + im * sn; ti[r] = im * cs - re * sn; }
                pr[mt][0] = pk2(tr[0], tr[1]); pr[mt][1] = pk2(tr[2], tr[3]); pi[mt][0] = pk2(ti[0], ti[1]); pi[mt][1] = pk2(ti[2], ti[3]); }
            u32x4 f0, f1, f2, f3;
            f0.x = pr[0][0]; f0.y = pr[0][1]; f0.z = pr[1][0]; f0.w = pr[1][1];
            f1.x = pr[2][0]; f1.y = pr[2][1]; f1.z = pr[3][0]; f1.w = pr[3][1];
            f2.x = pi[0][0]; f2.y = pi[0][1]; f2.z = pi[1][0]; f2.w = pi[1][1];
            f3.x = pi[2][0]; f3.y = pi[2][1]; f3.z = pi[3][0]; f3.w = pi[3][1];
            bf16x8 frag[4];
            frag[0] = __builtin_bit_cast(bf16x8, f0); frag[1] = __builtin_bit_cast(bf16x8, f1); frag[2] = __builtin_bit_cast(bf16x8, f2); frag[3] = __builtin_bit_cast(bf16x8, f3);
            f32x4 z[4];
#pragma unroll
            for (int n = 0; n < 4; ++n) z[n] = (f32x4){0.f, 0.f, 0.f, 0.f};
#pragma unroll
            for (int s2 = 0; s2 < 4; ++s2)
#pragma unroll
                for (int n2 = 0; n2 < 4; ++n2) { const bf16x8 bfr = *(const bf16x8*)(lds + FF_W2_OFF + ((s2 * 64 + n2 * 16 + fr) * FF_W2P) + fq * 16);
                    z[n2] = __builtin_amdgcn_mfma_f32_16x16x32_bf16(frag[s2], bfr, z[n2], 0, 0, 0); }
#pragma unroll
            for (int n2 = 0; n2 < 4; ++n2) { const int cf = 16 * n2 + fr; u32x2 w; w.x = pk2(z[n2][0], z[n2][1]); w.y = pk2(z[n2][2], z[n2][3]);
                *(u32x2*)(ft + 64 * cf + 16 * nt + 4 * fq) = w; }
            __builtin_amdgcn_sched_barrier(0);
        }
    }
}
struct GluPol {
    struct Unit { int pm, pn; };
    static constexpr bool GATHER = false;
    static constexpr long KSTEP_A = 4L * NTOK * 16 * 2;
    pg8::DenseOrder ord; const char* A; const char* B; int K, ksplit, lda, ldb;
    DI unsigned aoff(int R, int C) const { return (unsigned)(((C >> 4) * NTOK + R) * 16 + (C & 15)) * 2u; }
    DI bool next(int i, Unit& u) const { return ord.get(i, u.pm, u.pn); }
    DI void ptrs(const Unit& u, pg8::UPtr& q) const { q.a0 = A + (size_t)u.pm * 256 * 32; q.a1 = q.a0 + (size_t)128 * 32; q.b0 = B + (size_t)u.pn * 256 * ldb * 2; q.b1 = q.b0 + (size_t)128 * ldb * 2; q.c0 = q.b0; q.c1 = q.b1; }
    DI int brow(int R) const { return R; }
    DI void gather(const Unit&, int (&)[2], int (&)[2], unsigned (&)[2][2]) const {}
};
struct GluEpi {
    static constexpr int MIDK_T = -1;
    const bf16* yact; bf16* merged; float* rsqs;
    DI void operator()(const f32x4 (&acc)[2][2][4][2], const GluPol::Unit& u, int wr, int wc, int fr, int fq) const {
        const int col0 = u.pn * 256 + wc * 32 + 8 * fq;
        u32x4 yy[2][4][2];
#pragma unroll
        for (int ai = 0; ai < 2; ++ai)
#pragma unroll
            for (int m = 0; m < 4; ++m) { const int row = u.pm * 256 + ai * 128 + wr * 64 + m * 16 + fr;
#pragma unroll
                for (int bj = 0; bj < 2; ++bj) { const int col = col0 + bj * 128; yy[ai][m][bj] = *(const u32x4*)(yact + ((size_t)(col >> 4) * NTOK + row) * 16 + (col & 15)); } }
#pragma unroll
        for (int ai = 0; ai < 2; ++ai)
#pragma unroll
            for (int m = 0; m < 4; ++m) { const int row = u.pm * 256 + ai * 128 + wr * 64 + m * 16 + fr; float sq = 0.f;
#pragma unroll
                for (int bj = 0; bj < 2; ++bj) { const u32x4 y = yy[ai][m][bj]; const f32x4 a0 = acc[ai][bj][m][0], a1 = acc[ai][bj][m][1];
                    const float y0 = __uint_as_float(y.x << 16) * sigmoidf_(a0[0]), y1 = __uint_as_float(y.x & 0xffff0000u) * sigmoidf_(a0[1]);
                    const float y2 = __uint_as_float(y.y << 16) * sigmoidf_(a0[2]), y3 = __uint_as_float(y.y & 0xffff0000u) * sigmoidf_(a0[3]);
                    const float y4 = __uint_as_float(y.z << 16) * sigmoidf_(a1[0]), y5 = __uint_as_float(y.z & 0xffff0000u) * sigmoidf_(a1[1]);
                    const float y6 = __uint_as_float(y.w << 16) * sigmoidf_(a1[2]), y7 = __uint_as_float(y.w & 0xffff0000u) * sigmoidf_(a1[3]);
                    u32x4 w; w.x = pk2(y0, y1); w.y = pk2(y2, y3); w.z = pk2(y4, y5); w.w = pk2(y6, y7); *(u32x4*)(merged + (size_t)row * 1024 + col0 + bj * 128) = w;
                    sq += ((y0 * y0 + y1 * y1) + (y2 * y2 + y3 * y3)) + ((y4 * y4 + y5 * y5) + (y6 * y6 + y7 * y7)); }
                sq += __shfl_xor(sq, 16); sq += __shfl_xor(sq, 32);
                if (fq == 0) rsqs[(size_t)row * 8 + u.pn * 4 + wc] = sq; }
    }
};
DI void phase3_glu(const Params& p, unsigned char* lds, int bid, int nb) {
    GluPol P; P.ord.init(NTOK / 256, 2, nb, bid); P.A = (const char*)(p.ws + WS_R4); P.B = (const char*)(p.ws + WS_WGLUT); P.K = 512; P.ksplit = 8; P.lda = 512; P.ldb = 512;
    GluEpi E{(const bf16*)(p.ws + WS_R4), (bf16*)(p.ws + WS_R1), (float*)(p.ws + WS_RSQS)};
    pg8::gemm_phase<GluPol, GluEpi, true>((PG8_LAS unsigned char*)lds, P, E);
}
constexpr int FM_PITCH = 132, FM_LDS = 512 * FM_PITCH;
DI void phase3_fin(const Params& p, unsigned char* lds, int bid, int nb) {
    const int tid = tidx(), lane = tid & 63, wid = tid >> 6;
    const bf16* FT = (const bf16*)(p.ws + WS_R5); bf16* merged = (bf16*)(p.ws + WS_R1);
    float gf[8];
#pragma unroll
    for (int j = 0; j < 8; ++j) gf[j] = p.g_f[lane + 64 * j];
    for (int item = bid; item < 512; item += nb) {
        const int b = item >> 6, k0 = (item & 63) * 64;
        { u32x4 v[8];
#pragma unroll
          for (int i = 0; i < 8; ++i) { const int ix = tid + NT * i, ch = ix >> 3, c = ix & 7; v[i] = *(const u32x4*)(FT + ((size_t)(b * 512 + ch) * 4096 + k0 + c * 8)); }
#pragma unroll
          for (int i = 0; i < 8; ++i) { const int ix = tid + NT * i, ch = ix >> 3, c = ix & 7; unsigned* d = (unsigned*)(lds + ch * FM_PITCH + c * 16); d[0] = v[i].x; d[1] = v[i].y; d[2] = v[i].z; d[3] = v[i].w; } }
        if (tid < 64) { const size_t row = (size_t)b * 4096 + k0 + tid; const f32x4* q = (const f32x4*)((const float*)(p.ws + WS_RSQS) + row * 8); const f32x4 q0 = q[0], q1 = q[1];
            ((float*)(p.ws + WS_RSS))[row] = rsqrtf((((q0.x + q0.y) + (q0.z + q0.w)) + ((q1.x + q1.y) + (q1.z + q1.w))) * (1.f / 512.f) + EPS); }
        __syncthreads();
        float f[8][8], s[8];
#pragma unroll
        for (int t = 0; t < 8; ++t)
#pragma unroll
            for (int j = 0; j < 8; ++j) f[t][j] = bf2f(*(const bf16*)(lds + (lane + 64 * j) * FM_PITCH + (wid * 8 + t) * 2));
#pragma unroll
        for (int t = 0; t < 8; ++t) { float a = 0.f;
#pragma unroll
            for (int j = 0; j < 8; ++j) a += f[t][j] * f[t][j];
            s[t] = a; }
#pragma unroll
        for (int o = 1; o < 64; o <<= 1) {
#pragma unroll
            for (int t = 0; t < 8; ++t) s[t] += __shfl_xor(s[t], o); }
#pragma unroll
        for (int t = 0; t < 8; ++t) { const size_t row = (size_t)b * 4096 + k0 + wid * 8 + t; const float rs = rsqrtf(s[t] * (1.f / 512.f) + EPS);
#pragma unroll
            for (int j = 0; j < 8; ++j) merged[row * 1024 + 512 + lane + 64 * j] = (bf16)(pk2(f[t][j] * rs * gf[j], 0.f) & 0xffffu); }
        __syncthreads();
    }
}
struct P4Pol {
    static constexpr long KSTEP_A = 0;
    DI unsigned aoff(int R, int C) const { return (unsigned)(R * lda + C) * 2u; }
    struct Unit { int pm, pn; };
    static constexpr bool GATHER = false;
    pg8::DenseOrder ord; const char* A; const char* B; int K, ksplit, lda, ldb;
    DI bool next(int i, Unit& u) const { return ord.get(i, u.pm, u.pn); }
    DI void ptrs(const Unit& u, pg8::UPtr& q) const { q.a0 = A + (size_t)u.pm * 256 * lda * 2; q.a1 = q.a0 + (size_t)128 * lda * 2; q.b0 = B + (size_t)u.pn * 256 * ldb * 2; q.b1 = q.b0 + (size_t)128 * ldb * 2; q.c0 = q.b0; q.c1 = q.b1; }
    DI int brow(int R) const { return R; }
    DI void gather(const Unit&, int (&)[2], int (&)[2], unsigned (&)[2][2]) const {}
};
struct P4Epi {
    static constexpr int MIDK_T = 8;
    const float* x; bf16* x1b; const float* mod; float* rsqp; const float* rss;
    DI void midk(f32x4 (&acc)[2][2][4][2], const P4Pol::Unit& u, int wr, int wc, int fr, int fq) const {
        float r[2][4];
#pragma unroll
        for (int ai = 0; ai < 2; ++ai)
#pragma unroll
            for (int m = 0; m < 4; ++m) r[ai][m] = rss[u.pm * 256 + ai * 128 + wr * 64 + m * 16 + fr];
#pragma unroll
        for (int ai = 0; ai < 2; ++ai)
#pragma unroll
            for (int m = 0; m < 4; ++m)
#pragma unroll
                for (int bj = 0; bj < 2; ++bj)
#pragma unroll
                    for (int n = 0; n < 2; ++n) acc[ai][bj][m][n] = acc[ai][bj][m][n] * r[ai][m];
    }
    DI void operator()(const f32x4 (&acc)[2][2][4][2], const P4Pol::Unit& u, int wr, int wc, int fr, int fq) const {
        const int col0 = u.pn * 256 + wc * 32 + 8 * fq, b = (u.pm * 256) >> 12;
        f32x4 gv[2][2];
#pragma unroll
        for (int bj = 0; bj < 2; ++bj)
#pragma unroll
            for (int n = 0; n < 2; ++n) gv[bj][n] = *(const f32x4*)(mod + b * 6144 + 2048 + col0 + bj * 128 + n * 4);
        f32x4 xa[2][2][2], xb[2][2][2];
#define P4_LOAD(dst, q_) do { const int ai_ = (q_) >> 1, mb_ = ((q_) & 1) * 2; _Pragma("unroll") for (int m2 = 0; m2 < 2; ++m2) { const int row_ = u.pm * 256 + ai_ * 128 + wr * 64 + (mb_ + m2) * 16 + fr; \
            _Pragma("unroll") for (int bj = 0; bj < 2; ++bj) _Pragma("unroll") for (int n = 0; n < 2; ++n) dst[m2][bj][n] = *(const f32x4*)(x + (size_t)row_ * D + col0 + bj * 128 + n * 4); } } while (0)
#define P4_DO(src, q_) do { const int ai_ = (q_) >> 1, mb_ = ((q_) & 1) * 2; _Pragma("unroll") for (int m2 = 0; m2 < 2; ++m2) { const int m_ = mb_ + m2, row_ = u.pm * 256 + ai_ * 128 + wr * 64 + m_ * 16 + fr; float s_ = 0.f; \
            _Pragma("unroll") for (int bj = 0; bj < 2; ++bj) { const f32x4 o0 = src[m2][bj][0] + gv[bj][0] * acc[ai_][bj][m_][0], o1 = src[m2][bj][1] + gv[bj][1] * acc[ai_][bj][m_][1]; \
                u32x4 w; w.x = pk2(o0.x, o0.y); w.y = pk2(o0.z, o0.w); w.z = pk2(o1.x, o1.y); w.w = pk2(o1.z, o1.w); *(u32x4*)(x1b + (size_t)row_ * D + col0 + bj * 128) = w; \
                s_ += ((o0.x * o0.x + o0.y * o0.y) + (o0.z * o0.z + o0.w * o0.w)) + ((o1.x * o1.x + o1.y * o1.y) + (o1.z * o1.z + o1.w * o1.w)); } \
            s_ += __shfl_xor(s_, 16); s_ += __shfl_xor(s_, 32); if (fq == 0) rsqp[(size_t)row_ * 16 + u.pn * 4 + wc] = s_; } } while (0)
        P4_LOAD(xa, 0); P4_LOAD(xb, 1);
        P4_DO(xa, 0); asm volatile("" ::: "memory"); P4_LOAD(xa, 2);
        P4_DO(xb, 1); asm volatile("" ::: "memory"); P4_LOAD(xb, 3);
        P4_DO(xa, 2); asm volatile("" ::: "memory");
        P4_DO(xb, 3);
#undef P4_LOAD
#undef P4_DO
    }
};
DI void phase4_out(const Params& p, unsigned char* lds, int bid, int nb) {
    P4Pol P; P.ord.init(NTOK / 256, D / 256, nb, bid); P.A = (const char*)(p.ws + WS_R1); P.B = (const char*)(p.ws + WS_WOUTT); P.K = 1024; P.ksplit = 16; P.lda = 1024; P.ldb = 1024;
    P4Epi E{p.x, (bf16*)(p.ws + WS_X1B), (const float*)(p.ws + WS_MOD), (float*)(p.ws + WS_RSQP1), (const float*)(p.ws + WS_RSS)};
    pg8::gemm_phase<P4Pol, P4Epi, true>((PG8_LAS unsigned char*)lds, P, E);
}
DI int pair_index(int lo, int hi) { return 7 * lo - (lo * (lo - 1)) / 2 + (hi - lo - 1); }
constexpr int RT_WP = 2064, RT_GM_OFF = 48 * RT_WP, RT_SH_OFF = RT_GM_OFF + 4096, RT_SC_OFF = RT_SH_OFF + 4096, RT_LDS = RT_SC_OFF + 8 * 16 * 48 * 4;
DI void phase5_route(const Params& p, unsigned char* lds, int bid, int nb, bool commit = true) {
    const int tid = tidx(), lane = tid & 63, wid = tid >> 6, fr = lane & 15, fq = lane >> 4;
    { const bf16* W = (const bf16*)(p.ws + WS_WRT);
      for (int i = tid; i < 48 * 128; i += NT) { const int n = i >> 7, c = i & 127; *(u32x4*)(lds + n * RT_WP + c * 16) = *(const u32x4*)(W + n * 1024 + c * 8); } }
    const float* mod = (const float*)(p.ws + WS_MOD); const float* rsqp = (const float*)(p.ws + WS_RSQP1);
    bf16* A2 = (bf16*)(p.ws + WS_A2); unsigned* elcp = (unsigned*)(p.ws + WS_ELCP); float* elw = (float*)(p.ws + WS_ELW); unsigned* tcp = (unsigned*)(p.ws + WS_TCP);
    unsigned* ecnt = (unsigned*)(p.ws + WS_CTL + CTL_ECNT); unsigned* pcnt = (unsigned*)(p.ws + WS_CTL + CTL_PCNT);
    unsigned* elist = (unsigned*)(p.ws + WS_ELIST);
    float* gm = (float*)(lds + RT_GM_OFF); float* shv = (float*)(lds + RT_SH_OFF); float* scr = (float*)(lds + RT_SC_OFF) + wid * 16 * 48;
    for (int t128 = bid; t128 < NTOK / 128; t128 += nb) {
        const int b = t128 >> 5;
        __syncthreads();
        for (int k = tid; k < 1024; k += NT) { gm[k] = p.norm2_g[k] * (1.f + mod[b * 6144 + 4096 + k]); shv[k] = mod[b * 6144 + 3072 + k]; }
        __syncthreads();
        const int row0 = t128 * 128 + wid * 16, row = row0 + fr;
        float rs;
        { const f32x4* pp = (const f32x4*)(rsqp + (size_t)row * 16); const f32x4 q0 = pp[0], q1 = pp[1], q2 = pp[2], q3 = pp[3];
          const float rsum = (((q0.x + q0.y) + (q0.z + q0.w)) + ((q1.x + q1.y) + (q1.z + q1.w))) + (((q2.x + q2.y) + (q2.z + q2.w)) + ((q3.x + q3.y) + (q3.z + q3.w)));
          rs = rsqrtf(rsum * (1.f / D) + EPS); }
        f32x4 acc[3];
#pragma unroll
        for (int n = 0; n < 3; ++n) acc[n] = (f32x4){0.f, 0.f, 0.f, 0.f};
        const bf16* xr = (const bf16*)(p.ws + WS_X1B) + (size_t)row * D + fq * 8; bf16* ar = A2 + (size_t)row * D + fq * 8;
        u32x4 xa[8], xb[8];
#pragma unroll
        for (int i = 0; i < 8; ++i) xa[i] = *(const u32x4*)(xr + i * 32);
#pragma unroll 1
        for (int kc = 0; kc < 4; kc += 2) {
#pragma unroll
            for (int i = 0; i < 8; ++i) xb[i] = *(const u32x4*)(xr + (kc + 1) * 256 + i * 32);
#pragma unroll
            for (int half = 0; half < 2; ++half) {
#pragma unroll
                for (int i = 0; i < 8; ++i) {
                    const int ks = (kc + half) * 8 + i, k0 = ks * 32 + fq * 8;
                    const u32x4 xx = half ? xb[i] : xa[i];
                    f32x4 x0, x1; x0.x = __uint_as_float(xx.x << 16); x0.y = __uint_as_float(xx.x & 0xffff0000u); x0.z = __uint_as_float(xx.y << 16); x0.w = __uint_as_float(xx.y & 0xffff0000u);
                    x1.x = __uint_as_float(xx.z << 16); x1.y = __uint_as_float(xx.z & 0xffff0000u); x1.z = __uint_as_float(xx.w << 16); x1.w = __uint_as_float(xx.w & 0xffff0000u);
                    const f32x4 g0 = *(const f32x4*)(gm + k0), g1 = *(const f32x4*)(gm + k0 + 4), s0 = *(const f32x4*)(shv + k0), s1 = *(const f32x4*)(shv + k0 + 4);
                    const f32x4 t0 = x0 * rs * g0 + s0, t1 = x1 * rs * g1 + s1;
                    u32x4 hi; hi.x = pk2(t0.x, t0.y); hi.y = pk2(t0.z, t0.w); hi.z = pk2(t1.x, t1.y); hi.w = pk2(t1.z, t1.w);
                    *(u32x4*)(ar + ks * 32) = hi;
                    u32x4 lo;
                    lo.x = pk2(t0.x - __uint_as_float(hi.x << 16), t0.y - __uint_as_float(hi.x & 0xffff0000u)); lo.y = pk2(t0.z - __uint_as_float(hi.y << 16), t0.w - __uint_as_float(hi.y & 0xffff0000u));
                    lo.z = pk2(t1.x - __uint_as_float(hi.z << 16), t1.y - __uint_as_float(hi.z & 0xffff0000u)); lo.w = pk2(t1.z - __uint_as_float(hi.w << 16), t1.w - __uint_as_float(hi.w & 0xffff0000u));
                    const bf16x8 ah = __builtin_bit_cast(bf16x8, hi), al = __builtin_bit_cast(bf16x8, lo);
#pragma unroll
                    for (int nt = 0; nt < 3; ++nt) { const bf16x8 bw = *(const bf16x8*)(lds + (16 * nt + fr) * RT_WP + k0 * 2);
                        acc[nt] = __builtin_amdgcn_mfma_f32_16x16x32_bf16(ah, bw, acc[nt], 0, 0, 0); acc[nt] = __builtin_amdgcn_mfma_f32_16x16x32_bf16(al, bw, acc[nt], 0, 0, 0); }
                }
                if (half == 0 && kc + 2 < 4) {
#pragma unroll
                    for (int i = 0; i < 8; ++i) xa[i] = *(const u32x4*)(xr + (kc + 2) * 256 + i * 32);
                }
            }
        }
#pragma unroll
        for (int nt = 0; nt < 3; ++nt)
#pragma unroll
            for (int r = 0; r < 4; ++r) scr[(4 * fq + r) * 48 + 16 * nt + fr] = acc[nt][r];
        __syncthreads();
        if (lane < 16 && commit) {
            const int rrow = row0 + lane; const float* lg = scr + lane * 48;
            float gl[4];
#pragma unroll
            for (int o = 0; o < 4; ++o) gl[o] = lg[o] + p.b_group[o];
            float gmax = gl[0]; int gi = 0;
#pragma unroll
            for (int o = 1; o < 4; ++o) if (gl[o] > gmax) { gmax = gl[o]; gi = o; }
            float se = 0.f;
#pragma unroll
            for (int o = 0; o < 4; ++o) se += __expf(gl[o] - gmax);
            const float g_w = 1.f / se;
            float ev[8];
#pragma unroll
            for (int o = 0; o < 8; ++o) ev[o] = lg[4 + gi * 8 + o] + p.b_router[gi * 8 + o];
            float v1 = ev[0]; int i1 = 0;
#pragma unroll
            for (int o = 1; o < 8; ++o) if (ev[o] > v1) { v1 = ev[o]; i1 = o; }
            float v2 = -3.0e38f; int i2 = -1;
#pragma unroll
            for (int o = 0; o < 8; ++o) if (o != i1 && ev[o] > v2) { v2 = ev[o]; i2 = o; }
            const float w1 = g_w / (1.f + __expf(v2 - v1)), w2 = g_w - w1;
            const int lo = i1 < i2 ? i1 : i2, hi = i1 < i2 ? i2 : i1; const int pos1 = i1 < i2 ? 0 : 1;
            const int e1 = gi * 8 + i1, e2 = gi * 8 + i2;
            const int cls = gi * 28 + pair_index(lo, hi);
            const unsigned q3 = atomicAdd(pcnt + cls, 1u); const unsigned cp = ((unsigned)cls << 16) | q3;
            tcp[rrow] = cp;
            const unsigned q1 = atomicAdd(ecnt + e1, 1u); elist[(size_t)e1 * 32768 + q1] = (unsigned)rrow * 2u + (unsigned)pos1; elcp[(size_t)e1 * 32768 + q1] = cp; elw[(size_t)e1 * 32768 + q1] = w1;
            const unsigned q2 = atomicAdd(ecnt + e2, 1u); elist[(size_t)e2 * 32768 + q2] = (unsigned)rrow * 2u + (unsigned)(1 - pos1); elcp[(size_t)e2 * 32768 + q2] = cp; elw[(size_t)e2 * 32768 + q2] = w2;
        }
    }
    __syncthreads();
}
constexpr int TB_OFF = 131072, TB_ETE = 64, TB_ETR = 64 + 320, TB_ETC = 64 + 640, TB_PTC = 64 + 960, TB_PTS = 64 + 1280, TB_COFF = 64 + 1600, TB_BYTES = (64 + 1600 + 128 + 160) * 4;
DI void build_tiles(const Params& p, unsigned char* lds) {
    int* tb = (int*)(lds + TB_OFF); int* cnts = tb + TB_COFF + 112;
    const int tid = tidx();
    if (tid < 144) cnts[tid] = tid < 32 ? (int)((const unsigned*)(p.ws + WS_CTL + CTL_ECNT))[tid] : (int)((const unsigned*)(p.ws + WS_CTL + CTL_PCNT))[tid - 32];
    __syncthreads();
    if (tid == 0) {
        int n = 0;
        for (int e = 0; e < 32; ++e) { const int c = cnts[e]; for (int r0 = 0; r0 < c; r0 += 256) { tb[TB_ETE + n] = e; tb[TB_ETR + n] = r0; tb[TB_ETC + n] = c; ++n; } }
        tb[0] = n;
    }
    if (tid == 64) {
        int n = 0, off = 0;
        for (int c2 = 0; c2 < 112; ++c2) { const int c = cnts[32 + c2]; tb[TB_COFF + c2] = off; for (int r0 = 0; r0 < c; r0 += 256) { tb[TB_PTC + n] = c2; tb[TB_PTS + n] = off + r0; ++n; } off += ((c + 255) >> 8) << 8; }
        tb[1] = n;
    }
    __syncthreads();
}
struct GUPol {
    static constexpr long KSTEP_A = 0;
    DI unsigned aoff(int R, int C) const { return (unsigned)(R * lda + C) * 2u; }
    struct Unit { int e, r0, cnt, hh; };
    static constexpr bool GATHER = true;
    const int* tb; int G, c; const char* A; const char* B; const unsigned* elist; int K, ksplit, lda, ldb;
    DI bool next(int i, Unit& u) const { const int L = i * G + c; if (L >= __builtin_amdgcn_readfirstlane(tb[0]) * 2) return false; const int t = L >> 1; u.hh = L & 1;
        u.e = __builtin_amdgcn_readfirstlane(tb[TB_ETE + t]); u.r0 = __builtin_amdgcn_readfirstlane(tb[TB_ETR + t]); u.cnt = __builtin_amdgcn_readfirstlane(tb[TB_ETC + t]); return true; }
    DI void ptrs(const Unit& u, pg8::UPtr& q) const { q.a0 = A; q.a1 = A; q.b0 = B + (size_t)((u.e * 2 + u.hh) * 256) * ldb * 2; q.b1 = q.b0 + (size_t)128 * ldb * 2; q.c0 = q.b0; q.c1 = q.b1; }
    DI int brow(int R) const { return R; }
    DI void gather(const Unit& u, int (&R)[2], int (&C)[2], unsigned (&va)[2][2]) const {
#pragma unroll
        for (int h = 0; h < 2; ++h)
#pragma unroll
            for (int i = 0; i < 2; ++i) { const int r = u.r0 + h * 128 + R[i]; const unsigned ent = elist[(size_t)u.e * 32768 + (r < u.cnt ? r : u.r0)]; va[h][i] = ((ent >> 1) * 1024u + (unsigned)C[i]) * 2u; }
    }
};
struct GUEpi {
    static constexpr int MIDK_T = -1;
    const unsigned* elist; const unsigned* elcp; const float* elw; bf16* Hs; const int* tb;
    DI void operator()(const f32x4 (&acc)[2][2][4][2], const GUPol::Unit& u, int wr, int wc, int fr, int fq) const {
        unsigned ent[2][4], cp[2][4]; float w[2][4];
#pragma unroll
        for (int ai = 0; ai < 2; ++ai)
#pragma unroll
            for (int m = 0; m < 4; ++m) { const int r = u.r0 + ai * 128 + wr * 64 + m * 16 + fr; const size_t ix = (size_t)u.e * 32768 + (r < u.cnt ? r : u.r0);
                ent[ai][m] = elist[ix]; cp[ai][m] = elcp[ix]; w[ai][m] = elw[ix]; }
#pragma unroll
        for (int ai = 0; ai < 2; ++ai)
#pragma unroll
            for (int m = 0; m < 4; ++m) { const int r = u.r0 + ai * 128 + wr * 64 + m * 16 + fr;
                if (r < u.cnt) { const int srow = tb[TB_COFF + (cp[ai][m] >> 16)] + (int)(cp[ai][m] & 0xffffu); const float ww = w[ai][m];
                    bf16* dst = Hs + (size_t)srow * 512 + (ent[ai][m] & 1u) * 256 + u.hh * 128 + wc * 32 + 8 * fq;
                    const f32x4 g0 = acc[ai][0][m][0], g1 = acc[ai][0][m][1], u0 = acc[ai][1][m][0], u1 = acc[ai][1][m][1];
                    u32x4 o; o.x = pk2(siluf_(g0[0]) * u0[0] * ww, siluf_(g0[1]) * u0[1] * ww); o.y = pk2(siluf_(g0[2]) * u0[2] * ww, siluf_(g0[3]) * u0[3] * ww);
                    o.z = pk2(siluf_(g1[0]) * u1[0] * ww, siluf_(g1[1]) * u1[1] * ww); o.w = pk2(siluf_(g1[2]) * u1[2] * ww, siluf_(g1[3]) * u1[3] * ww);
                    *(u32x4*)dst = o; } }
    }
};
DI void phase6_gateup(const Params& p, unsigned char* lds, int bid, int nb) {
    GUPol P; P.tb = (const int*)(lds + TB_OFF); P.G = nb; P.c = (nb % 8 == 0) ? (bid % 8) * (nb / 8) + bid / 8 : bid; P.A = (const char*)(p.ws + WS_A2); P.B = (const char*)(p.ws + WS_WGUT); P.elist = (const unsigned*)(p.ws + WS_ELIST); P.K = 1024; P.ksplit = 16; P.lda = 1024; P.ldb = 1024;
    GUEpi E{(const unsigned*)(p.ws + WS_ELIST), (const unsigned*)(p.ws + WS_ELCP), (const float*)(p.ws + WS_ELW), (bf16*)(p.ws + WS_HS), (const int*)(lds + TB_OFF)};
    pg8::gemm_phase<GUPol, GUEpi, true>((PG8_LAS unsigned char*)lds, P, E);
}
struct DnPol {
    static constexpr long KSTEP_A = 0;
    DI unsigned aoff(int R, int C) const { return (unsigned)(R * lda + C) * 2u; }
    struct Unit { int s0, cls, pn; };
    static constexpr bool GATHER = false;
    const int* tb; int G, c; const char* A; const char* B; int K, ksplit, lda, ldb;
    DI bool next(int i, Unit& u) const { const int L = i * G + c; if (L >= __builtin_amdgcn_readfirstlane(tb[1]) * 4) return false; const int t = L >> 2; u.pn = L & 3;
        u.cls = __builtin_amdgcn_readfirstlane(tb[TB_PTC + t]); u.s0 = __builtin_amdgcn_readfirstlane(tb[TB_PTS + t]); return true; }
    DI void ptrs(const Unit& u, pg8::UPtr& q) const {
        const int gi = u.cls / 28; int lo = 0, rem = u.cls % 28;
        while (rem >= 7 - lo) { rem -= 7 - lo; ++lo; }
        const int hi = lo + 1 + rem, elo = gi * 8 + lo, ehi = gi * 8 + hi;
        q.a0 = A + (size_t)u.s0 * lda * 2; q.a1 = q.a0 + (size_t)128 * lda * 2;
        q.b0 = B + ((size_t)elo * 1024 + u.pn * 256) * ldb * 2; q.b1 = q.b0 + (size_t)128 * ldb * 2;
        q.c0 = B + ((size_t)ehi * 1024 + u.pn * 256) * ldb * 2; q.c1 = q.c0 + (size_t)128 * ldb * 2; }
    DI int brow(int R) const { return R; }
    DI void gather(const Unit&, int (&)[2], int (&)[2], unsigned (&)[2][2]) const {}
};
struct DnEpi {
    static constexpr int MIDK_T = -1;
    bf16* moe;
    DI void operator()(const f32x4 (&acc)[2][2][4][2], const DnPol::Unit& u, int wr, int wc, int fr, int fq) const {
#pragma unroll
        for (int ai = 0; ai < 2; ++ai)
#pragma unroll
            for (int m = 0; m < 4; ++m) { bf16* dst = moe + (size_t)(u.s0 + ai * 128 + wr * 64 + m * 16 + fr) * 1024 + u.pn * 256 + wc * 32 + 8 * fq;
#pragma unroll
                for (int bj = 0; bj < 2; ++bj) { const f32x4 v0 = acc[ai][bj][m][0], v1 = acc[ai][bj][m][1];
                    u32x4 w; w.x = pk2(v0[0], v0[1]); w.y = pk2(v0[2], v0[3]); w.z = pk2(v1[0], v1[1]); w.w = pk2(v1[2], v1[3]);
                    *(u32x4*)(dst + bj * 128) = w; } }
    }
};
DI void phase7_down(const Params& p, unsigned char* lds, int bid, int nb) {
    DnPol P; P.tb = (const int*)(lds + TB_OFF); P.G = nb; P.c = (nb % 8 == 0) ? (bid % 8) * (nb / 8) + bid / 8 : bid; P.A = (const char*)(p.ws + WS_HS); P.B = (const char*)(p.ws + WS_WDT); P.K = 512; P.ksplit = 4; P.lda = 512; P.ldb = 256;
    DnEpi E{(bf16*)(p.ws + WS_MOE)};
    pg8::gemm_phase<DnPol, DnEpi, true>((PG8_LAS unsigned char*)lds, P, E);
}
DI void phase8_final(const Params& p, unsigned char* lds, int bid, int nb) {
    const int lane = tidx() & 63, wave = tidx() >> 6;
    const float* mod = (const float*)(p.ws + WS_MOD); const unsigned* tcp = (const unsigned*)(p.ws + WS_TCP); const bf16* moe = (const bf16*)(p.ws + WS_MOE); const bf16* x1b = (const bf16*)(p.ws + WS_X1B); const int* tb = (const int*)(lds + TB_OFF);
    constexpr int RW = 4;
    for (int r0 = (bid * 8 + wave) * RW; r0 < NTOK; r0 += nb * 8 * RW) {
        const int b = r0 >> 12; unsigned cp[RW]; u32x2 xx[RW][4], mm[RW][4];
#pragma unroll
        for (int q = 0; q < RW; ++q) cp[q] = tcp[r0 + q];
#pragma unroll
        for (int q = 0; q < RW; ++q)
#pragma unroll
            for (int j = 0; j < 4; ++j) xx[q][j] = ((const u32x2*)(x1b + (size_t)(r0 + q) * D) + lane)[64 * j];
#pragma unroll
        for (int q = 0; q < RW; ++q) { const int srow = tb[TB_COFF + (cp[q] >> 16)] + (int)(cp[q] & 0xffffu);
#pragma unroll
            for (int j = 0; j < 4; ++j) mm[q][j] = ((const u32x2*)(moe + (size_t)srow * D) + lane)[64 * j]; }
        f32x4 g2[4], fg[4];
#pragma unroll
        for (int j = 0; j < 4; ++j) { g2[j] = *(const f32x4*)(mod + b * 6144 + 5120 + lane * 4 + 256 * j); fg[j] = *(const f32x4*)(p.final_g + lane * 4 + 256 * j); }
        f32x4 v[RW][4]; float s[RW];
#pragma unroll
        for (int q = 0; q < RW; ++q) { float t = 0.f;
#pragma unroll
            for (int j = 0; j < 4; ++j) { f32x4 x1, mv; x1.x = __uint_as_float(xx[q][j].x << 16); x1.y = __uint_as_float(xx[q][j].x & 0xffff0000u); x1.z = __uint_as_float(xx[q][j].y << 16); x1.w = __uint_as_float(xx[q][j].y & 0xffff0000u);
                mv.x = __uint_as_float(mm[q][j].x << 16); mv.y = __uint_as_float(mm[q][j].x & 0xffff0000u); mv.z = __uint_as_float(mm[q][j].y << 16); mv.w = __uint_as_float(mm[q][j].y & 0xffff0000u);
                v[q][j] = x1 + g2[j] * mv; t += (v[q][j].x * v[q][j].x + v[q][j].y * v[q][j].y) + (v[q][j].z * v[q][j].z + v[q][j].w * v[q][j].w); }
            s[q] = t; }
#pragma unroll
        for (int o = 1; o < 64; o <<= 1) {
#pragma unroll
            for (int q = 0; q < RW; ++q) s[q] += __shfl_xor(s[q], o); }
#pragma unroll
        for (int q = 0; q < RW; ++q) { const float rs = rsqrtf(s[q] * (1.f / D) + EPS); f32x4* orow = (f32x4*)(p.out + (size_t)(r0 + q) * D) + lane;
#pragma unroll
            for (int j = 0; j < 4; ++j) { f32x4 o = v[q][j] * rs * fg[j];
                if (MK_TS1 >= 0) { const unsigned* tsv = (const unsigned*)(p.ws + WS_CTL + CTL_TS); o = o * (1.f + (float)(tsv[0] / 1000u) * 0.01f); }
                orow[64 * j] = o; } }
    }
}

#define XB_TMO      128
#define XB_XCNT(j)  (256  + 64 * (j))
#define XB_XSUB(j)  (1280 + 64 * (j))
#define XB_XGEN(j)  (2304 + 64 * (j))
#define XB_TOP      3328
#define XB_TOPGEN   3392
#define XCD_BAR_WORDS 3456
#define XB_SPIN_CAP (1u << 18)
#define LAS __attribute__((address_space(3)))
DI unsigned xb_ld(unsigned* p)              { return __hip_atomic_load(p, __ATOMIC_RELAXED, __HIP_MEMORY_SCOPE_AGENT); }
DI unsigned xb_add(unsigned* p, unsigned v) { return __hip_atomic_fetch_add(p, v, __ATOMIC_RELAXED, __HIP_MEMORY_SCOPE_AGENT); }
DI unsigned xb_xcc_id() { return (unsigned)__builtin_amdgcn_s_getreg((3 << 11) | 20) & 0xFu; }
#define XB_SPIN(cond, bar) do { unsigned _sp = 0; while (cond) { __builtin_amdgcn_s_sleep(1); \
    if ((++_sp & 255u) == 0u) { if (xb_ld(&(bar)[XB_TMO])) break; if (_sp > XB_SPIN_CAP) { atomicAdd(&(bar)[XB_TMO], 1u); break; } } } } while (0)
struct XcdBarrier { unsigned* bar; unsigned x; volatile LAS unsigned* st; };
DI XcdBarrier xcd_barrier_post(unsigned* bar, volatile LAS unsigned* st) {
    XcdBarrier b; b.bar = bar; b.x = xb_xcc_id(); b.st = st;
    if (tidx() == 0) (void)xb_add(&bar[XB_XCNT(b.x)], 1u);
    return b;
}
DI void xcd_barrier_complete(unsigned* bar, unsigned x, unsigned& nloc, unsigned& nx) {
    const unsigned G = gridDim.x * gridDim.y * gridDim.z;
    unsigned sum, cnt, mine, sp = 0u;
    for (;;) {
        sum = 0u; cnt = 0u; mine = 0u;
#pragma unroll
        for (unsigned j = 0; j < 16; ++j) { const unsigned c = xb_ld(&bar[XB_XCNT(j)]); sum += c; cnt += (c > 0u) ? 1u : 0u; mine = (j == x) ? c : mine; }
        if (sum == G) break;
        __builtin_amdgcn_s_sleep(1);
        if ((++sp & 255u) == 0u) { if (xb_ld(&bar[XB_TMO])) break; if (sp > XB_SPIN_CAP) { atomicAdd(&bar[XB_TMO], 1u); break; } }
    }
    nloc = mine > 0u ? mine : 1u; nx = cnt > 0u ? cnt : 1u;
}
DI void xcd_barrier(const XcdBarrier& b) {
    asm volatile("s_waitcnt vmcnt(0)" ::: "memory");
    __syncthreads();
    if (tidx() == 0) {
        unsigned* bar = b.bar;
        __builtin_amdgcn_s_waitcnt(0);
        unsigned nloc = b.st[0], nx = b.st[1];
        if (nloc == 0u) { xcd_barrier_complete(bar, b.x, nloc, nx); b.st[0] = nloc; b.st[1] = nx; }
        const unsigned old = xb_add(&bar[XB_XSUB(b.x)], 1u);
        const unsigned gen = old / nloc;
        if (old + 1u == (gen + 1u) * nloc) {
            __builtin_amdgcn_fence(__ATOMIC_RELEASE, "agent");
            asm volatile("s_waitcnt vmcnt(0)" ::: "memory");
            const unsigned og = xb_add(&bar[XB_TOP], 1u);
            const unsigned tg = og / nx;
            if (og + 1u == (tg + 1u) * nx) xb_add(&bar[XB_TOPGEN], 1u);
            else XB_SPIN(xb_ld(&bar[XB_TOPGEN]) == tg, bar);
            __builtin_amdgcn_fence(__ATOMIC_ACQUIRE, "agent");
            xb_add(&bar[XB_XGEN(b.x)], 1u);
            asm volatile("s_waitcnt vmcnt(0)" ::: "memory");
        } else {
            XB_SPIN(xb_ld(&bar[XB_XGEN(b.x)]) == gen, bar);
            __builtin_amdgcn_fence(__ATOMIC_ACQUIRE, "agent");
            asm volatile("s_waitcnt vmcnt(0)" ::: "memory");
        }
    }
    __syncthreads();
}

constexpr int CTL_BAR = 16384;
constexpr int MK_LDS = 163840;
constexpr int MK_ST_OFF = MK_LDS - 16;
static_assert(S5_LDS <= MK_ST_OFF && FF_LDS <= MK_ST_OFF && RT_LDS <= MK_ST_OFF && TB_OFF + TB_BYTES <= MK_ST_OFF && TB_OFF >= pg8::STAGE_BYTES, "LDS map");
static_assert(4 * (4096 + 4096 + 8448 + 16384) <= MK_ST_OFF, "prep LDS");
#ifndef MK_REP
#define MK_REP -1
#endif
constexpr int MK_PT_OFF = MK_ST_OFF - 256;
static_assert(S5_LDS <= MK_PT_OFF && RT_LDS <= MK_PT_OFF && TB_OFF + TB_BYTES <= MK_PT_OFF, "LDS map (pointer table)");
DI Params ldp(const unsigned char* lds) {
    Params p; unsigned long long* d = (unsigned long long*)&p; const unsigned* t = (const unsigned*)(lds + MK_PT_OFF);
#pragma unroll
    for (int i = 0; i < 32; ++i) { const unsigned lo = __builtin_amdgcn_readfirstlane(t[2 * i]), hi = __builtin_amdgcn_readfirstlane(t[2 * i + 1]); d[i] = ((unsigned long long)hi << 32) | lo; }
    return p;
}
#define TSTAMP(i) do { if (MK_TS1 >= 0 && bid == 0 && tidx() == 0) ((unsigned long long*)(lds + MK_PT_OFF - 256))[i] = __builtin_amdgcn_s_memrealtime(); } while (0)
#define RUNPH(k, body) do { { const Params p = ldp(lds); body; } if (MK_REP == (k)) { xcd_barrier(bar); { const Params p = ldp(lds); body; } } } while (0)
__global__ void __launch_bounds__(NT, 2) mega_kernel(Params pk) {
    extern __shared__ __attribute__((aligned(16))) unsigned char lds[];
    const int bid = blockIdx.x, nb = gridDim.x;
    static_assert(sizeof(Params) == 256, "Params = 32 pointers");
    if (tidx() < 64) ((unsigned*)(lds + MK_PT_OFF))[tidx()] = ((const unsigned*)&pk)[tidx()];
    if (tidx() < 4) ((unsigned*)(lds + MK_ST_OFF))[tidx()] = 0u;
    __syncthreads();
    XcdBarrier bar;
    { const Params p = ldp(lds); bar = xcd_barrier_post((unsigned*)(p.ws + WS_CTL + CTL_BAR), (volatile LAS unsigned*)(lds + MK_ST_OFF)); }
    TSTAMP(0);
    RUNPH(0, phaseA_adaln(p, lds, bid, nb));      xcd_barrier(bar); TSTAMP(1);
    RUNPH(-2, phaseB_prep(p, lds, bid, nb));      xcd_barrier(bar); TSTAMP(2);
    RUNPH(2, phase1b(p, lds, bid, nb));           xcd_barrier(bar); TSTAMP(3);
    RUNPH(3, phase2_s5(p, lds, bid, nb));
    RUNPH(4, phase2_fft(p, lds, bid, nb));        xcd_barrier(bar); TSTAMP(4);
    RUNPH(9, phase2c_s5out(p, lds, bid, nb));     xcd_barrier(bar); TSTAMP(5);
    RUNPH(5, phase3_glu(p, lds, bid, nb));        xcd_barrier(bar); TSTAMP(6);
    RUNPH(6, phase3_fin(p, lds, bid, nb));        xcd_barrier(bar); TSTAMP(7);
    RUNPH(7, phase4_out(p, lds, bid, nb));        xcd_barrier(bar); TSTAMP(8);
    RUNPH(-2, phase5_route(p, lds, bid, nb));     xcd_barrier(bar); TSTAMP(9);
    if (MK_REP == 8) { { const Params p = ldp(lds); phase5_route(p, lds, bid, nb, false); } xcd_barrier(bar); }
    if (MK_REP == 20) { xcd_barrier(bar); xcd_barrier(bar); xcd_barrier(bar); xcd_barrier(bar); }
    RUNPH(-2, build_tiles(p, lds));
    RUNPH(10, phase6_gateup(p, lds, bid, nb));    xcd_barrier(bar); TSTAMP(10);
    RUNPH(11, phase7_down(p, lds, bid, nb));      xcd_barrier(bar); TSTAMP(11);
    if (MK_TS1 >= 0) { if (bid == 0 && tidx() == 0) { const unsigned long long* ts = (const unsigned long long*)(lds + MK_PT_OFF - 256); const Params p = ldp(lds); unsigned* o = (unsigned*)(p.ws + WS_CTL + CTL_TS);
            o[0] = (unsigned)(ts[MK_TS1 + 1] - ts[MK_TS1]); o[1] = MK_TS2 >= 0 ? (unsigned)(ts[MK_TS2 + 1] - ts[MK_TS2]) : 0u; } xcd_barrier(bar); }
    RUNPH(-2, phase8_final(p, lds, bid, nb));
}

extern "C" void kernel_launch(void* const* d_in, const int* in_sizes, int n_in, void* d_out, int out_size, void* d_ws, size_t ws_size, hipStream_t stream) {
    static int grid = 0;
    if (grid == 0) {
        if (n_in != 30 || ws_size < WS_END || out_size != NTOK * D) { fprintf(stderr, "kernel_launch: unexpected inputs (n_in %d, ws %zu, out %d)\n", n_in, ws_size, out_size); grid = -1; return; }
        int dev = 0, cus = 0, per_cu = 0;
        if (hipGetDevice(&dev) != hipSuccess || hipDeviceGetAttribute(&cus, hipDeviceAttributeMultiprocessorCount, dev) != hipSuccess) { grid = -1; return; }
        if (hipFuncSetAttribute((const void*)mega_kernel, hipFuncAttributeMaxDynamicSharedMemorySize, MK_LDS) != hipSuccess) { fprintf(stderr, "kernel_launch: hipFuncSetAttribute failed\n"); grid = -1; return; }
        if (hipOccupancyMaxActiveBlocksPerMultiprocessor(&per_cu, (const void*)mega_kernel, NT, MK_LDS) != hipSuccess || per_cu < 1) { fprintf(stderr, "kernel_launch: occupancy query says %d blocks/CU\n", per_cu); (void)hipGetLastError(); grid = -1; return; }
        grid = cus;
    }
    if (grid < 0) return;
    Params p{};
    const float** f = (const float**)&p;
    for (int i = 0; i < 30; ++i) f[i] = (const float*)d_in[i];
    p.out = (float*)d_out; p.ws = (unsigned char*)d_ws;
    (void)hipMemsetAsync((char*)d_ws + WS_CTL, 0, CTL_BYTES, stream);
    hipLaunchKernelGGL(mega_kernel, dim3(grid), dim3(NT), MK_LDS, stream, p);
}
```

```cpp
#include <hip/hip_runtime.h>
#include <cstdio>
#include <cstdint>

typedef unsigned short bf16;
typedef short bf16x8 __attribute__((ext_vector_type(8)));
typedef short bf16x4 __attribute__((ext_vector_type(4)));
typedef float f32x4 __attribute__((ext_vector_type(4)));
typedef unsigned u32x4 __attribute__((ext_vector_type(4)));
typedef unsigned u32x2 __attribute__((ext_vector_type(2)));
typedef __bf16 bf16v2 __attribute__((ext_vector_type(2)));
#define DI __device__ __forceinline__

constexpr int D = 1024, NB = 8, L = 4096, CTX = 256, NTOK = NB * L, NCTX = NB * CTX, NROWS1 = NTOK + NCTX;
constexpr int NEXP = 32, DE = 256;
constexpr float EPS = 1e-6f;
constexpr int NT = 512;

constexpr size_t MiB = 1u << 20;
constexpr size_t WS_CTL = 0;
constexpr size_t CTL_BYTES = 1 * MiB;
constexpr size_t CTL_ZERO = 4096;
#ifndef MK_TS1
#define MK_TS1 -1
#endif
#ifndef MK_TS2
#define MK_TS2 -1
#endif
constexpr size_t CTL_TS = 12288;
constexpr size_t CTL_FLAGA = 12800;
constexpr size_t CTL_WQ = 12544;
constexpr size_t CTL_ECNT = 8192;
constexpr size_t CTL_PCNT = 8192 + 256;
constexpr size_t CTL_RSQ1 = 256 * 1024;
constexpr size_t CTL_RSQ2 = 384 * 1024;
constexpr size_t WS_MOD = 1 * MiB;
constexpr size_t WS_TILES = WS_MOD + 256 * 1024;
constexpr size_t WS_ABART = WS_TILES + 64 * 1024;
constexpr size_t WS_FFTC = 2 * MiB;
constexpr size_t WS_GW = 3 * MiB;
constexpr size_t WS_WINT = 4 * MiB;
constexpr size_t WS_WGLUT = 7 * MiB;
constexpr size_t WS_WOUTT = 8 * MiB;
constexpr size_t WS_WGUT = 10 * MiB;
constexpr size_t WS_WDT = 42 * MiB;
constexpr size_t WS_WST = 58 * MiB;
constexpr size_t WS_MGW = 66 * MiB;
constexpr size_t WS_ELIST = 90 * MiB;
constexpr size_t WS_ELCP = 94 * MiB;
constexpr size_t WS_ELW = 98 * MiB;
constexpr size_t WS_TCP = 102 * MiB;
constexpr size_t WS_R1 = 108 * MiB;
constexpr size_t WS_R2 = 176 * MiB;
constexpr size_t WS_R3 = 240 * MiB;
constexpr size_t WS_UCTX = 288 * MiB;
constexpr size_t WS_R4 = 290 * MiB;
constexpr size_t WS_R5 = 322 * MiB;
constexpr size_t WS_X1B = 290 * MiB;
constexpr size_t WS_A2 = 108 * MiB;
constexpr size_t WS_HS = 228 * MiB;
constexpr size_t WS_MOE = 108 * MiB;
constexpr size_t WS_RSQP1 = 354 * MiB;
constexpr size_t WS_RSQS = 356 * MiB;
constexpr size_t WS_RSS = 357 * MiB;
constexpr size_t WS_ETAB = 357 * MiB + 512 * 1024;
constexpr size_t WS_WRT = 358 * MiB;
constexpr size_t WS_END = 359 * MiB;

struct Params {
    const float *x, *c, *ctx, *c_ctx, *w_ada, *b_ada, *norm1_g, *norm2_g, *w_in;
    const float *lam_re, *lam_im, *b_re, *b_im, *c_re, *c_im, *log_step, *s5_d, *w_glu, *fourier_w, *g_s, *g_f, *w_out;
    const float *w_group, *b_group, *w_router, *b_router, *w_gate, *w_up, *w_down, *final_g;
    float* out; unsigned char* ws;
};

DI int tidx() { int t = threadIdx.x; asm volatile("" : "+v"(t)); return t; }
DI unsigned pk2(float lo, float hi) { bf16v2 v; v.x = (__bf16)lo; v.y = (__bf16)hi; return __builtin_bit_cast(unsigned, v); }
DI float bf2f(unsigned short b) { return __uint_as_float(((unsigned)b) << 16); }
DI float wave_sum(float v) {
#pragma unroll
    for (int o = 1; o < 64; o <<= 1) v += __shfl_xor(v, o);
    return v;
}
DI float sigmoidf_(float x) { return 1.f / (1.f + __expf(-x)); }
DI float siluf_(float x) { return x / (1.f + __expf(-x)); }
DI float geluf_(float x) { const float u = 0.7978845608028654f * (x + 0.044715f * x * x * x); return x / (1.f + __expf(-2.f * u)); }

template <int MT> struct GC {
    static constexpr int BM = 64 * MT, PA = MT, ABYTES = BM * 128, BBYTES = 128 * 128, BUF = ABYTES + BBYTES, LDS = 2 * BUF;
};
template <int MT>
DI void gemm_loop(f32x4 (&acc)[MT][4], const bf16* (&ap)[MT], const int (&as)[MT], const bf16* (&bp)[2], int nk, unsigned char* lds) {
    typedef GC<MT> G;
    const int tid = tidx(), lane = tid & 63, wid = tid >> 6, wm = wid >> 1, wn = wid & 1, fr = lane & 15, fq = lane >> 4;
    const int srow = tid >> 3, sck = tid & 7;
    const int soff = srow * 128 + ((sck ^ (srow & 7)) << 4);
    u32x4 ra[MT], rb[2];
#pragma unroll
    for (int i = 0; i < MT; ++i) ra[i] = *(const u32x4*)(ap[i]);
#pragma unroll
    for (int i = 0; i < 2; ++i) rb[i] = *(const u32x4*)(bp[i]);
#pragma unroll
    for (int i = 0; i < MT; ++i) *(u32x4*)(lds + i * 8192 + soff) = ra[i];
#pragma unroll
    for (int i = 0; i < 2; ++i) *(u32x4*)(lds + G::ABYTES + i * 8192 + soff) = rb[i];
    __syncthreads();
    const int aro = (wm * MT * 16 + fr) * 128, bro = (wn * 64 + fr) * 128;
    const int sw0 = ((0 + fq) ^ (fr & 7)) << 4, sw1 = ((4 + fq) ^ (fr & 7)) << 4;
    for (int kt = 0; kt < nk; ++kt) {
        const bool more = kt + 1 < nk;
        if (more) {
#pragma unroll
            for (int i = 0; i < MT; ++i) ra[i] = *(const u32x4*)(ap[i] + (size_t)(kt + 1) * as[i]);
#pragma unroll
            for (int i = 0; i < 2; ++i) rb[i] = *(const u32x4*)(bp[i] + (size_t)(kt + 1) * 64);
        }
        const unsigned char* Ab = lds + (kt & 1) * G::BUF; const unsigned char* Bb = Ab + G::ABYTES;
#pragma unroll
        for (int kk = 0; kk < 2; ++kk) {
            const int sw = kk ? sw1 : sw0;
            bf16x8 af[MT], bfr[4];
#pragma unroll
            for (int mt = 0; mt < MT; ++mt) af[mt] = *(const bf16x8*)(Ab + aro + mt * 2048 + sw);
#pragma unroll
            for (int nt = 0; nt < 4; ++nt) bfr[nt] = *(const bf16x8*)(Bb + bro + nt * 2048 + sw);
#pragma unroll
            for (int mt = 0; mt < MT; ++mt)
#pragma unroll
                for (int nt = 0; nt < 4; ++nt) acc[mt][nt] = __builtin_amdgcn_mfma_f32_16x16x32_bf16(bfr[nt], af[mt], acc[mt][nt], 0, 0, 0);
        }
        if (more) {
            unsigned char* nb = lds + ((kt + 1) & 1) * G::BUF;
#pragma unroll
            for (int i = 0; i < MT; ++i) *(u32x4*)(nb + i * 8192 + soff) = ra[i];
#pragma unroll
            for (int i = 0; i < 2; ++i) *(u32x4*)(nb + G::ABYTES + i * 8192 + soff) = rb[i];
        }
        __syncthreads();
    }
}
template <int MT>
DI void gemm_loop_alds(f32x4 (&acc)[MT][4], const unsigned char* abase, int apitch, const bf16* (&bp)[2], int nk, unsigned char* lds) {
    typedef GC<MT> G;
    const int tid = tidx(), lane = tid & 63, wid = tid >> 6, wm = wid >> 1, wn = wid & 1, fr = lane & 15, fq = lane >> 4;
    const int srow = tid >> 3, sck = tid & 7;
    const int soff = srow * 128 + ((sck ^ (srow & 7)) << 4);
    u32x4 rb[2];
#pragma unroll
    for (int i = 0; i < 2; ++i) rb[i] = *(const u32x4*)(bp[i]);
#pragma unroll
    for (int i = 0; i < 2; ++i) *(u32x4*)(lds + G::ABYTES + i * 8192 + soff) = rb[i];
    __syncthreads();
    const int bro = (wn * 64 + fr) * 128;
    const int sw0 = ((0 + fq) ^ (fr & 7)) << 4, sw1 = ((4 + fq) ^ (fr & 7)) << 4;
    const unsigned char* arow = abase + (size_t)(wm * MT * 16 + fr) * apitch + fq * 16;
    for (int kt = 0; kt < nk; ++kt) {
        const bool more = kt + 1 < nk;
        if (more) {
#pragma unroll
            for (int i = 0; i < 2; ++i) rb[i] = *(const u32x4*)(bp[i] + (size_t)(kt + 1) * 64);
        }
        const unsigned char* Bb = lds + (kt & 1) * G::BUF + G::ABYTES;
#pragma unroll
        for (int kk = 0; kk < 2; ++kk) {
            const int sw = kk ? sw1 : sw0;
            bf16x8 af[MT], bfr[4];
#pragma unroll
            for (int mt = 0; mt < MT; ++mt) af[mt] = *(const bf16x8*)(arow + (size_t)mt * 16 * apitch + kt * 128 + kk * 64);
#pragma unroll
            for (int nt = 0; nt < 4; ++nt) bfr[nt] = *(const bf16x8*)(Bb + bro + nt * 2048 + sw);
#pragma unroll
            for (int mt = 0; mt < MT; ++mt)
#pragma unroll
                for (int nt = 0; nt < 4; ++nt) acc[mt][nt] = __builtin_amdgcn_mfma_f32_16x16x32_bf16(bfr[nt], af[mt], acc[mt][nt], 0, 0, 0);
        }
        if (more) {
            unsigned char* nb = lds + ((kt + 1) & 1) * G::BUF;
#pragma unroll
            for (int i = 0; i < 2; ++i) *(u32x4*)(nb + G::ABYTES + i * 8192 + soff) = rb[i];
        }
        __syncthreads();
    }
}
template <int MT> DI void zero_acc(f32x4 (&acc)[MT][4]) {
#pragma unroll
    for (int m = 0; m < MT; ++m)
#pragma unroll
        for (int n = 0; n < 4; ++n) acc[m][n] = (f32x4){0.f, 0.f, 0.f, 0.f};
}

namespace pg8 {
#define PG8_LAS __attribute__((address_space(3)))
constexpr int BM = 256, BK = 64, HALF = 128, HTB = HALF * BK * 2, STAGE_BYTES = 8 * HTB;
DI int lds_byte(int r, int c) { const int st = (r >> 4) * 2 + (c >> 5), rr = r & 15, cc = c & 31, ob = rr * 64 + cc * 2; return st * 1024 + (ob ^ (((ob >> 9) & 1) << 5)); }
DI int perm32(int rho) { const int n = rho >> 4, i = rho & 15; return 8 * (i >> 2) + 4 * n + (i & 3); }
DI void stage_rc(int b, int& R, int& C) { const int st = b / 1024, sb = b % 1024, swz = sb ^ (((sb >> 9) & 1) << 5); R = (st >> 1) * 16 + swz / 64; C = (st & 1) * 32 + (swz % 64) / 2; }
struct UPtr { const char *a0, *a1, *b0, *b1, *c0, *c1; };
template <class Pol, class Epi, bool ALIGN_EPI>
DI void gemm_phase(PG8_LAS unsigned char* lds, const Pol& P, const Epi& E) {
    typedef typename Pol::Unit Unit;
    const int tid = tidx(), wid = __builtin_amdgcn_readfirstlane(tid >> 6), lane = tid & 63, wr = wid >> 2, wc = wid & 3, fr = lane & 15, fq = lane >> 4;
    const int nt = P.K / BK, ksplit = P.ksplit;
    constexpr int NG = Pol::GATHER ? 2 : 1;
    int Rr[2], Cc[2]; unsigned voffB[2]; unsigned vAc[NG][2], vAn[NG][2];
#pragma unroll
    for (int i = 0; i < 2; ++i) { stage_rc(tid * 16 + i * 8192, Rr[i], Cc[i]); voffB[i] = (unsigned)(P.brow((Rr[i] & ~31) + perm32(Rr[i] & 31)) * P.ldb + Cc[i]) * 2u;
#pragma unroll
        for (int h = 0; h < NG; ++h) vAc[h][i] = vAn[h][i] = P.aoff(Rr[i], Cc[i]); }
#define PG8_VC(h) vAc[Pol::GATHER ? (h) : 0]
#define PG8_V2(h) v2[Pol::GATHER ? (h) : 0]
    const size_t kstep = (size_t)(BK * 2);
    const size_t kstepA = Pol::KSTEP_A ? (size_t)Pol::KSTEP_A : kstep;
    const unsigned ldsw = (unsigned)wid * 1024u;
    const int aoff = lds_byte(wr * 64 + fr, fq * 8), boff = lds_byte(wc * 32 + fr, fq * 8);
#define PG8_SA(b, h) (((b) * 2 + (h)) * HTB)
#define PG8_SB(b, h) ((4 + (b) * 2 + (h)) * HTB)
#define PG8_STAGE(bufoff, gbase, voff) do { _Pragma("unroll") for (int _i = 0; _i < 2; ++_i) \
        __builtin_amdgcn_global_load_lds((const unsigned*)((const char*)(gbase) + (voff)[_i]), (PG8_LAS unsigned*)(lds + (bufoff) + ldsw + _i * 8192), 16, 0, 0); } while (0)
#define PG8_LDA(dst, b, h) do { _Pragma("unroll") for (int m = 0; m < 4; ++m) _Pragma("unroll") for (int k = 0; k < 2; ++k) dst[m][k] = *(const PG8_LAS bf16x8*)(lds + PG8_SA(b, h) + aoff + m * 2048 + k * 1024); } while (0)
#define PG8_LDB(dst, b, h) do { _Pragma("unroll") for (int n = 0; n < 2; ++n) _Pragma("unroll") for (int k = 0; k < 2; ++k) dst[n][k] = *(const PG8_LAS bf16x8*)(lds + PG8_SB(b, h) + boff + n * 2048 + k * 1024); } while (0)
#define PG8_MMA(ai, bj, At, Bt) do { __builtin_amdgcn_s_setprio(1); _Pragma("unroll") for (int m = 0; m < 4; ++m) _Pragma("unroll") for (int n = 0; n < 2; ++n) _Pragma("unroll") for (int k = 0; k < 2; ++k) \
        acc[ai][bj][m][n] = __builtin_amdgcn_mfma_f32_16x16x32_bf16(Bt[n][k], At[m][k], acc[ai][bj][m][n], 0, 0, 0); __builtin_amdgcn_s_setprio(0); } while (0)
#define PG8_WAIT_V(n) asm volatile("s_waitcnt vmcnt(" #n ")" ::: "memory")
#define PG8_WAIT_L(n) asm volatile("s_waitcnt lgkmcnt(" #n ")" ::: "memory")
#define PG8_BAR __builtin_amdgcn_s_barrier()
#define PG8_SCHED __builtin_amdgcn_sched_barrier(0)
#define PG8_BSEL(q, tk, h) ((tk) < ksplit ? (q).b##h + (size_t)(tk) * kstep : (q).c##h + (size_t)((tk) - ksplit) * kstep)
    Unit cur, nxt; UPtr cp, np_; int ui = 0;
    if (!P.next(0, cur)) return;
    P.ptrs(cur, cp);
    if constexpr (Pol::GATHER) P.gather(cur, Rr, Cc, vAc);
    f32x4 acc[2][2][4][2];
#pragma unroll
    for (int a = 0; a < 2; ++a)
#pragma unroll
        for (int b = 0; b < 2; ++b)
#pragma unroll
            for (int m = 0; m < 4; ++m)
#pragma unroll
                for (int n = 0; n < 2; ++n) acc[a][b][m][n] = (f32x4){0.f, 0.f, 0.f, 0.f};
    bf16x8 At[4][2], B0[2][2], B1[2][2];
    PG8_STAGE(PG8_SB(0, 0), cp.b0, voffB); PG8_STAGE(PG8_SB(0, 1), cp.b1, voffB); PG8_STAGE(PG8_SA(0, 0), cp.a0, PG8_VC(0)); PG8_STAGE(PG8_SA(0, 1), cp.a1, PG8_VC(1));
    if (wr == 1) PG8_BAR;
    PG8_WAIT_V(2); PG8_BAR;
    PG8_STAGE(PG8_SB(1, 0), cp.b0 + kstep, voffB); PG8_STAGE(PG8_SA(1, 0), cp.a0 + kstepA, PG8_VC(0)); PG8_STAGE(PG8_SB(1, 1), cp.b1 + kstep, voffB);
    PG8_WAIT_V(6); PG8_BAR;
    for (;;) {
        const bool has_next = P.next(ui + 1, nxt);
        if (has_next) { P.ptrs(nxt, np_); if constexpr (Pol::GATHER) P.gather(nxt, Rr, Cc, vAn); }
        else { np_ = cp; if constexpr (Pol::GATHER) {
#pragma unroll
            for (int h = 0; h < 2; ++h)
#pragma unroll
                for (int i = 0; i < 2; ++i) vAn[h][i] = vAc[h][i]; } }
#pragma unroll 1
        for (int t = 0; t < nt; t += 2) {
            const bool last = (t == nt - 2);
            if constexpr (Epi::MIDK_T >= 0) { if (t == Epi::MIDK_T) E.midk(acc, cur, wr, wc, fr, fq); }
            const char* a1_1 = cp.a1 + (size_t)(t + 1) * kstepA;
            const char *a2_0, *a2_1, *a3_0, *b2_0, *b2_1, *b3_0, *b3_1;
            unsigned v2[NG][2];
            if (!last) { a2_0 = cp.a0 + (size_t)(t + 2) * kstepA; a2_1 = cp.a1 + (size_t)(t + 2) * kstepA; a3_0 = cp.a0 + (size_t)(t + 3) * kstepA;
                         b2_0 = PG8_BSEL(cp, t + 2, 0); b2_1 = PG8_BSEL(cp, t + 2, 1); b3_0 = PG8_BSEL(cp, t + 3, 0); b3_1 = PG8_BSEL(cp, t + 3, 1); }
            else { a2_0 = np_.a0; a2_1 = np_.a1; a3_0 = np_.a0 + kstepA; b2_0 = np_.b0; b2_1 = np_.b1; b3_0 = np_.b0 + kstep; b3_1 = np_.b1 + kstep; }
#pragma unroll
            for (int h = 0; h < NG; ++h)
#pragma unroll
                for (int i = 0; i < 2; ++i) v2[h][i] = (Pol::GATHER && last) ? vAn[h][i] : vAc[h][i];
            PG8_LDB(B0, 0, 0); PG8_LDB(B1, 0, 1); PG8_SCHED; PG8_LDA(At, 0, 0); PG8_STAGE(PG8_SA(1, 1), a1_1, PG8_VC(1));
            PG8_WAIT_V(8); PG8_WAIT_L(0); PG8_BAR; PG8_MMA(0, 0, At, B0); PG8_MMA(0, 1, At, B1); PG8_BAR; PG8_SCHED;
            PG8_LDA(At, 0, 1); PG8_STAGE(PG8_SB(0, 0), b2_0, voffB); PG8_STAGE(PG8_SB(0, 1), b2_1, voffB); PG8_STAGE(PG8_SA(0, 0), a2_0, PG8_V2(0));
            PG8_WAIT_V(8); PG8_WAIT_L(0); PG8_BAR; PG8_MMA(1, 0, At, B0); PG8_MMA(1, 1, At, B1); PG8_BAR; PG8_SCHED;
            PG8_LDB(B0, 1, 0); PG8_LDB(B1, 1, 1); PG8_SCHED; PG8_LDA(At, 1, 0); PG8_STAGE(PG8_SA(0, 1), a2_1, PG8_V2(1));
            PG8_WAIT_V(8); PG8_WAIT_L(0); PG8_BAR; PG8_MMA(0, 0, At, B0); PG8_MMA(0, 1, At, B1); PG8_BAR; PG8_SCHED;
            PG8_LDA(At, 1, 1); PG8_STAGE(PG8_SB(1, 0), b3_0, voffB); PG8_STAGE(PG8_SB(1, 1), b3_1, voffB); PG8_STAGE(PG8_SA(1, 0), a3_0, PG8_V2(0));
            PG8_WAIT_V(8); PG8_WAIT_L(0); PG8_BAR; PG8_MMA(1, 0, At, B0); PG8_MMA(1, 1, At, B1); PG8_BAR; PG8_SCHED;
        }
        if constexpr (ALIGN_EPI) { if (wr == 0) PG8_BAR; }
        E(acc, cur, wr, wc, fr, fq);
        if (!has_next) break;
#pragma unroll
        for (int a = 0; a < 2; ++a)
#pragma unroll
            for (int b = 0; b < 2; ++b)
#pragma unroll
                for (int m = 0; m < 4; ++m)
#pragma unroll
                    for (int n = 0; n < 2; ++n) acc[a][b][m][n] = (f32x4){0.f, 0.f, 0.f, 0.f};
        cur = nxt; cp = np_; ++ui;
        if constexpr (Pol::GATHER) {
#pragma unroll
            for (int h = 0; h < 2; ++h)
#pragma unroll
                for (int i = 0; i < 2; ++i) vAc[h][i] = vAn[h][i]; }
        if constexpr (ALIGN_EPI) { if (wr == 1) PG8_BAR; }
    }
    PG8_WAIT_V(0);
    if constexpr (!ALIGN_EPI) { if (wr == 0) PG8_BAR; }
    PG8_BAR;
#undef PG8_SA
#undef PG8_SB
#undef PG8_STAGE
#undef PG8_LDA
#undef PG8_LDB
#undef PG8_MMA
#undef PG8_WAIT_V
#undef PG8_WAIT_L
#undef PG8_BAR
#undef PG8_SCHED
#undef PG8_BSEL
#undef PG8_VC
#undef PG8_V2
}
struct DenseOrder {
    int nM, nN, nwg, G, c;
    DI void init(int nM_, int nN_, int G_, int c_) { nM = nM_; nN = nN_; nwg = nM * nN; G = G_; c = c_; }
    DI bool get(int i, int& pm, int& pn) const {
        const long L = (long)i * G + c; if (L >= nwg) return false;
        int wgid = (int)L; { const int q = nwg / 8, r = nwg % 8, xcd = wgid % 8, off = wgid / 8; wgid = (xcd < r ? xcd * (q + 1) : r * (q + 1) + (xcd - r) * q) + off; }
        const int nig = 8 * nN, gid = wgid / nig, fm = gid * 8, gsz = (nM - fm) < 8 ? (nM - fm) : 8;
        pm = fm + ((wgid % nig) % gsz); pn = (wgid % nig) / gsz; return true;
    }
};
}

DI void adaln_item(const Params& p, unsigned char* lds, int item) {
    float* scond = (float*)lds;
    float* red = scond + 9 * 1024;
    const int tid = tidx();
    for (int i = tid; i < 9 * 1024; i += NT) { const int r = i >> 10, k = i & 1023; const float v = r < 8 ? p.c[r * 1024 + k] : p.c_ctx[k]; scond[i] = v / (1.f + __expf(-v)); }
    __syncthreads();
    const int cc = tid & 31, ks = tid >> 5, col = item * 32 + cc;
    float a[9];
#pragma unroll
    for (int r = 0; r < 9; ++r) a[r] = 0.f;
#pragma unroll 1
    for (int kb = 0; kb < 4; ++kb) {
        const int kbase = ks * 64 + kb * 16; float w[16];
#pragma unroll
        for (int u = 0; u < 16; ++u) w[u] = p.w_ada[(size_t)(kbase + u) * 6144 + col];
#pragma unroll
        for (int u = 0; u < 16; ++u)
#pragma unroll
            for (int r = 0; r < 9; ++r) a[r] += scond[r * 1024 + kbase + u] * w[u];
    }
#pragma unroll
    for (int r = 0; r < 9; ++r) red[(ks * 9 + r) * 32 + cc] = a[r];
    __syncthreads();
    float* mod = (float*)(p.ws + WS_MOD);
    for (int o = tid; o < 9 * 32; o += NT) { const int r = o >> 5, c2 = o & 31; float s = 0.f;
#pragma unroll
        for (int q = 0; q < 16; ++q) s += red[(q * 9 + r) * 32 + c2];
        mod[r * 6144 + item * 32 + c2] = s + p.b_ada[item * 32 + c2]; }
    __syncthreads();
}
DI void tp_tile(const float* src, int ld, int k0, int n0, unsigned char* lds, bf16* dst, int jobkind, int e, const float* kscale = nullptr) {
    const int lane = tidx() & 63, q = lane >> 4, c = lane & 15;
    f32x4 v[16];
#pragma unroll
    for (int i = 0; i < 16; ++i) v[i] = *(const f32x4*)(src + (size_t)(k0 + 16 * q + i) * ld + n0 + 4 * c);
    if (kscale) {
#pragma unroll
        for (int i = 0; i < 16; ++i) v[i] = v[i] * kscale[k0 + 16 * q + i]; }
#pragma unroll
    for (int j = 0; j < 4; ++j) { const int ng = n0 + 4 * c + j;
        u32x4 o0, o1;
        o0.x = pk2(v[0][j], v[1][j]); o0.y = pk2(v[2][j], v[3][j]); o0.z = pk2(v[4][j], v[5][j]); o0.w = pk2(v[6][j], v[7][j]);
        o1.x = pk2(v[8][j], v[9][j]); o1.y = pk2(v[10][j], v[11][j]); o1.z = pk2(v[12][j], v[13][j]); o1.w = pk2(v[14][j], v[15][j]);
        size_t drow; int K;
        switch (jobkind) {
          case 0: drow = ng; K = 1024; break;
          case 1: drow = ng; K = 512; break;
          case 2: drow = ng; K = 1024; break;
          case 3: case 4: { const int h = ng, R = (h >> 7) * 256 + (jobkind == 4 ? 128 : 0) + (h & 127); drow = (size_t)e * 512 + R; K = 1024; } break;
          default: drow = (size_t)e * 1024 + ng; K = 256; break;
        }
        bf16* d = dst + drow * K + k0 + 16 * q;
        *(u32x4*)d = o0; *(u32x4*)(d + 8) = o1; }
}
constexpr int TP_J0 = 16 * 8, TP_J1 = 8 * 8, TP_J2 = 16 * 16, TP_J3 = 32 * 16 * 4, TP_J4 = TP_J3, TP_J5 = 32 * 4 * 16;
constexpr int TP_ITEMS = TP_J0 + TP_J1 + TP_J2 + TP_J3 + TP_J4 + TP_J5;
DI void tp_item(const Params& p, unsigned char* lds, int it) {
    unsigned char* ws = p.ws;
    if (it < TP_J0) { tp_tile(p.w_in, 1024, (it >> 3) * 64, (it & 7) * 64, lds, (bf16*)(ws + WS_WINT), 0, 0); return; } it -= TP_J0;
    if (it < TP_J1) { tp_tile(p.w_glu, 512, (it >> 3) * 64, (it & 7) * 64, lds, (bf16*)(ws + WS_WGLUT), 1, 0); return; } it -= TP_J1;
    if (it < TP_J2) { tp_tile(p.w_out, 1024, (it >> 4) * 64, (it & 15) * 64, lds, (bf16*)(ws + WS_WOUTT), 2, 0, (it >> 4) * 64 < 512 ? p.g_s : nullptr); return; } it -= TP_J2;
    if (it < TP_J3) { const int e = it >> 6, r = it & 63; tp_tile(p.w_gate + (size_t)e * 1024 * 256, 256, (r >> 2) * 64, (r & 3) * 64, lds, (bf16*)(ws + WS_WGUT), 3, e); return; } it -= TP_J3;
    if (it < TP_J4) { const int e = it >> 6, r = it & 63; tp_tile(p.w_up + (size_t)e * 1024 * 256, 256, (r >> 2) * 64, (r & 3) * 64, lds, (bf16*)(ws + WS_WGUT), 4, e); return; } it -= TP_J4;
    { const int e = it >> 6, r = it & 63; tp_tile(p.w_down + (size_t)e * 256 * 1024, 1024, (r >> 4) * 64, (r & 15) * 64, lds, (bf16*)(ws + WS_WDT), 5, e); }
}
DI void gfold_item(const Params& p, unsigned char* lds, int item) {
    const int q = item >> 6, k0 = (item & 63) * 16, tid = tidx(), lane = tid & 63, wid = tid >> 6, fr = lane & 15, fq = lane >> 4;
    const bf16* E = (const bf16*)(p.ws + WS_ETAB); const bf16* fwT = E + 256 * 128 + (size_t)q * 128 * 128;
    bf16* Tl = (bf16*)lds;
    bf16x8 af[4];
#pragma unroll
    for (int ks = 0; ks < 4; ++ks) { const float* wp = p.w_in + (size_t)(k0 + fr) * 1024 + 512 + 128 * q + ks * 32 + 8 * fq; const f32x4 w0 = *(const f32x4*)wp, w1 = *(const f32x4*)(wp + 4);
        u32x4 t; t.x = pk2(w0.x, w0.y); t.y = pk2(w0.z, w0.w); t.z = pk2(w1.x, w1.y); t.w = pk2(w1.z, w1.w); af[ks] = __builtin_bit_cast(bf16x8, t); }
#pragma unroll
    for (int t2 = 0; t2 < 2; ++t2) { const int nt = wid * 2 + t2, c = nt >> 3; f32x4 d = (f32x4){0.f, 0.f, 0.f, 0.f};
#pragma unroll
        for (int ks = 0; ks < 4; ++ks) { const bf16x8 bfr = *(const bf16x8*)(E + (size_t)(nt * 16 + fr) * 128 + ks * 32 + 8 * fq); d = __builtin_amdgcn_mfma_f32_16x16x32_bf16(af[ks], bfr, d, 0, 0, 0); }
#pragma unroll
        for (int r = 0; r < 4; ++r) Tl[(c * 16 + 4 * fq + r) * 136 + (nt & 7) * 16 + fr] = (bf16)(pk2(d[r], 0.f) & 0xffffu); }
    __syncthreads();
    bf16* WinT = (bf16*)(p.ws + WS_WINT);
    const float scale = 1.0f / 724.0773439350247f;
    { const int c = wid >> 2;
      bf16x8 a2[4];
#pragma unroll
      for (int ks = 0; ks < 4; ++ks) a2[ks] = *(const bf16x8*)(Tl + (c * 16 + fr) * 136 + ks * 32 + 8 * fq);
#pragma unroll
      for (int t2 = 0; t2 < 2; ++t2) { const int jt = (wid & 3) * 2 + t2; f32x4 d = (f32x4){0.f, 0.f, 0.f, 0.f};
#pragma unroll
          for (int ks = 0; ks < 4; ++ks) { const bf16x8 bfr = *(const bf16x8*)(fwT + (size_t)(jt * 16 + fr) * 128 + ks * 32 + 8 * fq); d = __builtin_amdgcn_mfma_f32_16x16x32_bf16(bfr, a2[ks], d, 0, 0, 0); }
#pragma unroll
          for (int r = 0; r < 4; ++r) WinT[(size_t)(512 + c * 512 + q * 128 + jt * 16 + 4 * fq + r) * 1024 + k0 + fr] = (bf16)(pk2(d[r] * scale, 0.f) & 0xffffu); } }
    __syncthreads();
}
DI void s5mats_item(const Params& p, unsigned char* lds, int item) {
    const int g = item >> 3, part = item & 7;
    const int tid = tidx();
    float* Bb = (float*)lds;
    float* Cc = Bb + 4096;
    float* pw = Cc + 4096;
    float* Kt = pw + 8448;
    float* qv = Kt;
    if (tid < 128) { const int d = tid >> 6, pp = tid & 63;
        const double dt = exp((double)p.log_step[d * 32 + g]); const double lr = p.lam_re[(d * 32 + g) * 64 + pp], li = p.lam_im[(d * 32 + g) * 64 + pp];
        const double mag = exp(lr * dt); double tt = li * dt / 3.14159265358979323846; tt -= 2.0 * floor(tt * 0.5);
        double sn, cs; sincospi(tt, &sn, &cs); const double ar = mag * cs, ai = mag * sn;
        const double nr = ar - 1.0, ni = ai, den = lr * lr + li * li;
        qv[tid * 2] = (float)((nr * lr + ni * li) / den); qv[tid * 2 + 1] = (float)((ni * lr - nr * li) / den);
        double pr = 1.0, pi = 0.0;
        for (int k = 0; k < 33; ++k) { pw[(tid * 33 + k) * 2] = (float)pr; pw[(tid * 33 + k) * 2 + 1] = (float)pi; const double t2 = pr * ar - pi * ai; pi = pr * ai + pi * ar; pr = t2; } }
    __syncthreads();
    for (int idx = tid; idx < 2 * 64 * 16; idx += NT) { const int dp = idx >> 4, h = idx & 15; const float qr = qv[dp * 2], qi = qv[dp * 2 + 1];
        const int d = dp >> 6, pp = dp & 63;
        const float br = p.b_re[((size_t)(d * 32 + g) * 64 + pp) * 16 + h], bi = p.b_im[((size_t)(d * 32 + g) * 64 + pp) * 16 + h];
        Bb[idx * 2] = qr * br - qi * bi; Bb[idx * 2 + 1] = qr * bi + qi * br; }
    for (int idx = tid; idx < 2 * 16 * 64; idx += NT) { const int d = idx >> 10, i = (idx >> 6) & 15, pp = idx & 63;
        Cc[idx * 2] = p.c_re[((size_t)(d * 32 + g) * 16 + i) * 64 + pp]; Cc[idx * 2 + 1] = p.c_im[((size_t)(d * 32 + g) * 16 + i) * 64 + pp]; }
    __syncthreads();
    { const int t3 = tid >> 2, pq = tid & 3, d = t3 >> 6, k = (t3 >> 1) & 31, i = part * 2 + (t3 & 1);
      float acc[16];
#pragma unroll
      for (int h = 0; h < 16; ++h) acc[h] = 0.f;
      for (int pp = pq * 16; pp < pq * 16 + 16; ++pp) {
          const float cr = Cc[((d * 16 + i) * 64 + pp) * 2], ci = Cc[((d * 16 + i) * 64 + pp) * 2 + 1];
          const float wr = pw[((d * 64 + pp) * 33 + k) * 2], wi = pw[((d * 64 + pp) * 33 + k) * 2 + 1];
          const float xr = cr * wr - ci * wi, xi = cr * wi + ci * wr;
          const f32x4* bb = (const f32x4*)(Bb + (d * 64 + pp) * 32);
#pragma unroll
          for (int h2 = 0; h2 < 8; ++h2) { const f32x4 b2 = bb[h2]; acc[2 * h2] += xr * b2.x - xi * b2.y; acc[2 * h2 + 1] += xr * b2.z - xi * b2.w; } }
#pragma unroll
      for (int h = 0; h < 16; ++h) { acc[h] += __shfl_xor(acc[h], 1); acc[h] += __shfl_xor(acc[h], 2); }
      if (pq == 0) {
#pragma unroll
          for (int h4 = 0; h4 < 4; ++h4) *(f32x4*)(Kt + ((d * 32 + k) * 16 + i) * 16 + h4 * 4) = (f32x4){acc[h4 * 4], acc[h4 * 4 + 1], acc[h4 * 4 + 2], acc[h4 * 4 + 3]}; } }
    __syncthreads();
    bf16* Mg = (bf16*)(p.ws + WS_MGW) + (size_t)g * 512 * 768;
    for (int c4 = tid; c4 < 64 * 64; c4 += NT) { const int rq = c4 >> 6, c8 = c4 & 63, j = rq >> 1, i = part * 2 + (rq & 1), row = j * 16 + i, s = c8 >> 1, h0 = (c8 & 1) * 8; float v[8];
#pragma unroll
        for (int t = 0; t < 8; ++t) { float a = 0.f; if (s <= j) a += Kt[((0 * 32 + (j - s)) * 16 + i) * 16 + h0 + t]; if (s >= j) a += Kt[((1 * 32 + (s - j)) * 16 + i) * 16 + h0 + t]; v[t] = a; }
        u32x4 o; o.x = pk2(v[0], v[1]); o.y = pk2(v[2], v[3]); o.z = pk2(v[4], v[5]); o.w = pk2(v[6], v[7]);
        *(u32x4*)(Mg + (size_t)row * 768 + c8 * 8) = o; }
    bf16* Wst = (bf16*)(p.ws + WS_WST) + (size_t)g * 256 * 512;
    for (int c4 = tid; c4 < 32 * 64; c4 += NT) { const int r = part * 32 + (c4 >> 6), c8 = c4 & 63, s = c8 >> 1, h0 = (c8 & 1) * 8, d = r >> 7, c = r & 1, pp = (r >> 1) & 63;
        const int e = d == 0 ? 31 - s : s; const float wr = pw[((d * 64 + pp) * 33 + e) * 2], wi = pw[((d * 64 + pp) * 33 + e) * 2 + 1]; float v[8];
#pragma unroll
        for (int t = 0; t < 8; ++t) { const float br = Bb[((d * 64 + pp) * 16 + h0 + t) * 2], bi = Bb[((d * 64 + pp) * 16 + h0 + t) * 2 + 1]; v[t] = c == 0 ? wr * br - wi * bi : wr * bi + wi * br; }
        u32x4 o; o.x = pk2(v[0], v[1]); o.y = pk2(v[2], v[3]); o.z = pk2(v[4], v[5]); o.w = pk2(v[6], v[7]);
        *(u32x4*)(Wst + (size_t)r * 512 + c8 * 8) = o; }
    bf16* Wos = (bf16*)(p.ws + WS_MGW) + (size_t)g * 512 * 768 + 512;
    for (int c4 = tid; c4 < 64 * 32; c4 += NT) { const int rq = c4 >> 5, c8 = c4 & 31, j = rq >> 1, i = part * 2 + (rq & 1), row = j * 16 + i, col0 = c8 * 8, d = col0 >> 7, p0 = (col0 >> 1) & 63;
        const int e = d == 0 ? j + 1 : 32 - j; float v[8];
#pragma unroll
        for (int t = 0; t < 8; ++t) { const int pp = p0 + (t >> 1), c = t & 1; const float cr = Cc[((d * 16 + i) * 64 + pp) * 2], ci = Cc[((d * 16 + i) * 64 + pp) * 2 + 1];
            const float wr = pw[((d * 64 + pp) * 33 + e) * 2], wi = pw[((d * 64 + pp) * 33 + e) * 2 + 1]; v[t] = c == 0 ? cr * wr - ci * wi : -(cr * wi + ci * wr); }
        u32x4 o; o.x = pk2(v[0], v[1]); o.y = pk2(v[2], v[3]); o.z = pk2(v[4], v[5]); o.w = pk2(v[6], v[7]);
        *(u32x4*)(Wos + (size_t)row * 768 + c8 * 8) = o; }
    float* aT = (float*)(p.ws + WS_ABART) + g * 256;
    if (part == 0 && tid < 128) { const int d = tid >> 6, pp = tid & 63; aT[tid * 2] = pw[((d * 64 + pp) * 33 + 32) * 2]; aT[tid * 2 + 1] = pw[((d * 64 + pp) * 33 + 32) * 2 + 1]; }
    __syncthreads();
}
DI void fftc_item(const Params& p, int item, int nitems) {
    const int tid = tidx();
    bf16* W1 = (bf16*)(p.ws + WS_FFTC);
    bf16* W2 = W1 + 128 * 128;
    float* tw = (float*)(p.ws + WS_FFTC + 32768 + 16384);
    for (int idx = item * NT + tid; idx < 128 * 128 + 4 * 64 * 32 + 4096; idx += nitems * NT) {
        if (idx < 16384) { const int n = idx >> 7, k = idx & 127, co = n >> 6, d = n & 63, ci = k >> 6, bq = k & 63; double s, c; sincospi((double)((d * bq) & 63) / 32.0, &s, &c);
            const float v = (ci == co) ? (float)c : (ci == 1 ? (float)s : (float)(-s)); W1[idx] = (bf16)(pk2(v, 0.f) & 0xffffu); }
        else if (idx < 16384 + 8192) { const int i2 = idx - 16384, s_ = i2 >> 11, cf = (i2 >> 5) & 63, slot = i2 & 31, gq = slot >> 3, jp = slot & 7;
            const int a = 16 * (2 * (s_ & 1) + (jp >> 2)) + 4 * gq + (jp & 3); double s, c; sincospi((double)((cf * a) & 63) / 32.0, &s, &c);
            W2[i2] = (bf16)(pk2((s_ >> 1) == 0 ? (float)c : (float)s, 0.f) & 0xffffu); }
        else { const int i3 = idx - 16384 - 8192, ln = i3 & 63, r = (i3 >> 6) & 3, mt = (i3 >> 8) & 3, nt = i3 >> 10; const int d = 16 * nt + (ln & 15), a = 16 * mt + 4 * (ln >> 4) + r;
            double s, c; sincospi((double)((d * a) & 4095) / 2048.0, &s, &c); tw[i3 * 2] = (float)c; tw[i3 * 2 + 1] = (float)s; }
    }
}
constexpr int P0_S5 = 256, P0_GF = 256;
constexpr int P0_ITEMS = P0_S5 + P0_GF;
DI void rw_item(const Params& p, int item, int nitems) {
    bf16* W = (bf16*)(p.ws + WS_WRT);
    for (int i = item * NT + tidx(); i < 48 * 1024; i += nitems * NT) { const int n = i >> 10, k = i & 1023; const float v = n < 4 ? p.w_group[k * 4 + n] : (n < 36 ? p.w_router[k * 32 + (n - 4)] : 0.f); W[i] = (bf16)(pk2(v, 0.f) & 0xffffu); }
}
DI void phaseA_adaln(const Params& p, unsigned char* lds, int bid, int nb) {
    for (int it = bid; it < 192 + 64; it += nb) {
        if (it < 192) { adaln_item(p, lds, it); continue; }
        const int t = it - 192, tid = tidx();
        bf16* E = (bf16*)(p.ws + WS_ETAB); bf16* fwT = E + 256 * 128;
        for (int i = t * NT + tid; i < 256 * 128; i += 64 * NT) { const int cn = i >> 7, m = i & 127, c = cn >> 7, n = cn & 127; double sv, cv; sincospi((double)((n * m) & 127) / 64.0, &sv, &cv);
            E[i] = (bf16)(pk2(c == 0 ? (float)cv : (float)(-sv), 0.f) & 0xffffu); }
        for (int i = t * NT + tid; i < 4 * 128 * 128; i += 64 * NT) { const int q = i >> 14, j = (i >> 7) & 127, n = i & 127; fwT[i] = (bf16)(pk2(p.fourier_w[((size_t)q * 128 + n) * 128 + j], 0.f) & 0xffffu); }
        fftc_item(p, t, 64); rw_item(p, t, 64);
    }
}
DI void a1_item(const Params& p, int r0) {
    const int lane = tidx() & 63;
    const float* mod = (const float*)(p.ws + WS_MOD);
    bf16* A1 = (bf16*)(p.ws + WS_R1);
    constexpr int RW = 4;
    const float* src = r0 < NTOK ? p.x + (size_t)r0 * D : p.ctx + (size_t)(r0 - NTOK) * D;
    const int mr = r0 < NTOK ? (r0 >> 12) : 8;
    f32x4 v[RW][4]; float s[RW];
#pragma unroll
    for (int q = 0; q < RW; ++q)
#pragma unroll
        for (int j = 0; j < 4; ++j) v[q][j] = ((const f32x4*)(src + (size_t)q * D) + lane)[64 * j];
    f32x4 gm[4], sh[4];
#pragma unroll
    for (int j = 0; j < 4; ++j) { const int k = lane * 4 + 256 * j; gm[j] = *(const f32x4*)(p.norm1_g + k) * (*(const f32x4*)(mod + mr * 6144 + 1024 + k) + 1.f); sh[j] = *(const f32x4*)(mod + mr * 6144 + k); }
#pragma unroll
    for (int q = 0; q < RW; ++q) { float t = 0.f;
#pragma unroll
        for (int j = 0; j < 4; ++j) t += (v[q][j].x * v[q][j].x + v[q][j].y * v[q][j].y) + (v[q][j].z * v[q][j].z + v[q][j].w * v[q][j].w);
        s[q] = t; }
#pragma unroll
    for (int o = 1; o < 64; o <<= 1) {
#pragma unroll
        for (int q = 0; q < RW; ++q) s[q] += __shfl_xor(s[q], o); }
#pragma unroll
    for (int q = 0; q < RW; ++q) { const float rs = rsqrtf(s[q] * (1.f / D) + EPS); u32x2* o = (u32x2*)(A1 + (size_t)(r0 + q) * D) + lane;
#pragma unroll
        for (int j = 0; j < 4; ++j) { const f32x4 h = v[q][j] * rs * gm[j] + sh[j]; u32x2 w; w.x = pk2(h.x, h.y); w.y = pk2(h.z, h.w); o[64 * j] = w; } }
}
constexpr int WI_A1 = NROWS1 / 4, WI_ALL = WI_A1 + TP_ITEMS;
DI void phaseAB_prep(const Params& p, unsigned char* lds, int bid, int nb) {
    phaseA_adaln(p, lds, bid, nb);
    unsigned* flag = (unsigned*)(p.ws + WS_CTL + CTL_FLAGA);
    asm volatile("s_waitcnt vmcnt(0)" ::: "memory");
    __syncthreads();
    if (tidx() == 0) { __builtin_amdgcn_fence(__ATOMIC_RELEASE, "agent"); asm volatile("s_waitcnt vmcnt(0)" ::: "memory"); (void)__hip_atomic_fetch_add(flag, 1u, __ATOMIC_RELAXED, __HIP_MEMORY_SCOPE_AGENT); }
    for (int it = bid; it < P0_S5; it += nb) s5mats_item(p, lds, it);
    if (tidx() == 0) { unsigned sp = 0; while (__hip_atomic_load(flag, __ATOMIC_RELAXED, __HIP_MEMORY_SCOPE_AGENT) < (unsigned)nb) { __builtin_amdgcn_s_sleep(2); if (++sp > (1u << 22)) break; }
        __builtin_amdgcn_fence(__ATOMIC_ACQUIRE, "agent"); asm volatile("s_waitcnt vmcnt(0)" ::: "memory"); }
    __syncthreads();
    for (int it = bid; it < P0_GF; it += nb) gfold_item(p, lds, it);
    __syncthreads();
    const int wid = tidx() >> 6;
    for (int it = bid * 8 + wid; it < WI_ALL; it += nb * 8) {
        if (it < WI_A1) a1_item(p, it * 4); else tp_item(p, lds, it - WI_A1);
    }
}

struct G1uPol {
    static constexpr long KSTEP_A = 0;
    DI unsigned aoff(int R, int C) const { return (unsigned)(R * lda + C) * 2u; }
    struct Unit { int pm, pn; };
    static constexpr bool GATHER = false;
    pg8::DenseOrder ord; const char* A; const char* B; int K, ksplit, lda, ldb;
    DI bool next(int i, Unit& u) const { return ord.get(i, u.pm, u.pn); }
    DI void ptrs(const Unit& u, pg8::UPtr& q) const { q.a0 = A + (size_t)u.pm * 256 * lda * 2; q.a1 = q.a0 + (size_t)128 * lda * 2; q.b0 = B + (size_t)u.pn * 256 * ldb * 2; q.b1 = q.b0 + (size_t)128 * ldb * 2; q.c0 = q.b0; q.c1 = q.b1; }
    DI int brow(int R) const { return R; }
    DI void gather(const Unit&, int (&)[2], int (&)[2], unsigned (&)[2][2]) const {}
};
struct G1uEpi {
    static constexpr int MIDK_T = -1;
    bf16* Ul;
    DI void operator()(const f32x4 (&acc)[2][2][4][2], const G1uPol::Unit& u, int wr, int wc, int fr, int fq) const {
#pragma unroll
        for (int ai = 0; ai < 2; ++ai)
#pragma unroll
            for (int m = 0; m < 4; ++m) { const int row = u.pm * 256 + ai * 128 + wr * 64 + m * 16 + fr, b = row >> 12, l = row & 4095;
#pragma unroll
                for (int bj = 0; bj < 2; ++bj) { const int c0 = u.pn * 256 + bj * 128 + wc * 32 + 8 * fq, g = c0 >> 4, h0 = c0 & 15;
                    const f32x4 a0 = acc[ai][bj][m][0], a1 = acc[ai][bj][m][1];
                    u32x4 w; w.x = pk2(a0[0], a0[1]); w.y = pk2(a0[2], a0[3]); w.z = pk2(a1[0], a1[1]); w.w = pk2(a1[2], a1[3]);
                    *(u32x4*)(Ul + (((size_t)g * 1024 + b * 128 + (l >> 5)) * 768 + (l & 31) * 16 + h0)) = w; } }
    }
};
struct G1gPol {
    static constexpr long KSTEP_A = 0;
    DI unsigned aoff(int R, int C) const { return (unsigned)(R * lda + C) * 2u; }
    struct Unit { int pm, pn; };
    static constexpr bool GATHER = false;
    pg8::DenseOrder ord; const char* A; const char* B; int K, ksplit, lda, ldb;
    DI bool next(int i, Unit& u) const { return ord.get(i, u.pm, u.pn); }
    DI void ptrs(const Unit& u, pg8::UPtr& q) const { q.a0 = A + (size_t)u.pm * 256 * lda * 2; q.a1 = q.a0 + (size_t)128 * lda * 2;
        const int b = u.pn >> 4, a0 = (u.pn & 15) * 4; q.b0 = B + (size_t)(b * 4096 + a0) * ldb * 2; q.b1 = q.b0 + (size_t)2 * ldb * 2; q.c0 = q.b0; q.c1 = q.b1; }
    DI int brow(int R) const { return (R & 63) * 64 + (R >> 6); }
    DI void gather(const Unit&, int (&)[2], int (&)[2], unsigned (&)[2][2]) const {}
};
struct G1gEpi {
    static constexpr int MIDK_T = -1;
    bf16* GT;
    DI void operator()(const f32x4 (&acc)[2][2][4][2], const G1gPol::Unit& u, int wr, int wc, int fr, int fq) const {
        const int b = u.pn >> 4, a0 = (u.pn & 15) * 4;
#pragma unroll
        for (int ai = 0; ai < 2; ++ai)
#pragma unroll
            for (int m = 0; m < 4; ++m) { const int mm = u.pm * 256 + ai * 128 + wr * 64 + m * 16 + fr, c = mm >> 9, ch = mm & 511;
                bf16* base = GT + (size_t)((b * 512 + ch) * 2 + c) * 4096;
#pragma unroll
                for (int bj = 0; bj < 2; ++bj) { const int a = a0 + 2 * bj + (wc >> 1), bq = 32 * (wc & 1) + 8 * fq;
                    const f32x4 v0 = acc[ai][bj][m][0], v1 = acc[ai][bj][m][1];
                    u32x4 w; w.x = pk2(v0[0], v0[1]); w.y = pk2(v0[2], v0[3]); w.z = pk2(v1[0], v1[1]); w.w = pk2(v1[2], v1[3]);
                    *(u32x4*)(base + a * 64 + bq) = w; } }
    }
};
DI void phase1b(const Params& p, unsigned char* lds, int bid, int nb) {
    { G1gPol P; P.ord.init(4, NTOK / 256, nb, bid); P.A = (const char*)(p.ws + WS_WINT) + (size_t)512 * 2048; P.B = (const char*)(p.ws + WS_R1); P.K = 1024; P.ksplit = 16; P.lda = 1024; P.ldb = 1024;
      G1gEpi E{(bf16*)(p.ws + WS_R2)};
      pg8::gemm_phase<G1gPol, G1gEpi, true>((PG8_LAS unsigned char*)lds, P, E); }
    { G1uPol P; P.ord.init(NTOK / 256, 2, nb, bid); P.A = (const char*)(p.ws + WS_R1); P.B = (const char*)(p.ws + WS_WINT); P.K = 1024; P.ksplit = 16; P.lda = 1024; P.ldb = 1024;
      G1uEpi E{(bf16*)(p.ws + WS_R3)};
      pg8::gemm_phase<G1uPol, G1uEpi, true>((PG8_LAS unsigned char*)lds, P, E); }
    { const int tid = tidx(), lane = tid & 63, wid = tid >> 6, fr = lane & 15, fq = lane >> 4;
      for (int item = bid; item < 256; item += nb) { const int g = item >> 3, b = item & 7;
          const bf16* A1c = (const bf16*)(p.ws + WS_R1) + (size_t)(NTOK + b * 256 + wid * 32) * D; const bf16* Wg = (const bf16*)(p.ws + WS_WINT) + (size_t)(g * 16) * D;
          f32x4 ca[2] = {(f32x4){0.f, 0.f, 0.f, 0.f}, (f32x4){0.f, 0.f, 0.f, 0.f}};
#pragma unroll 8
          for (int ks = 0; ks < 32; ++ks) { const bf16x8 bw = *(const bf16x8*)(Wg + (size_t)fr * D + ks * 32 + fq * 8);
              const bf16x8 a0 = *(const bf16x8*)(A1c + (size_t)fr * D + ks * 32 + fq * 8), a1 = *(const bf16x8*)(A1c + (size_t)(16 + fr) * D + ks * 32 + fq * 8);
              ca[0] = __builtin_amdgcn_mfma_f32_16x16x32_bf16(bw, a0, ca[0], 0, 0, 0); ca[1] = __builtin_amdgcn_mfma_f32_16x16x32_bf16(bw, a1, ca[1], 0, 0, 0); }
          bf16* Ucw = (bf16*)(p.ws + WS_R4) + ((size_t)g * 256 + b * 8 + wid) * 768;
#pragma unroll
          for (int mt = 0; mt < 2; ++mt) { u32x2 w; w.x = pk2(ca[mt][0], ca[mt][1]); w.y = pk2(ca[mt][2], ca[mt][3]); *(u32x2*)(Ucw + (size_t)(mt * 16 + fr) * 16 + 4 * fq) = w; } } }
}
struct S5aPol {
    struct Unit { int g, mt; };
    static constexpr bool GATHER = false;
    static constexpr long KSTEP_A = 0;
    int G, c; const char* A; const char* Ac; const char* B; int K, ksplit, lda, ldb;
    DI unsigned aoff(int R, int C) const { return (unsigned)(R * lda + C) * 2u; }
    DI bool next(int i, Unit& u) const { const int L = i * G + c; if (L >= 160) return false; u.g = L / 5; u.mt = L % 5; return true; }
    DI void ptrs(const Unit& u, pg8::UPtr& q) const { q.a0 = u.mt < 4 ? A + ((size_t)u.g * 1024 + u.mt * 256) * lda * 2 : Ac + (size_t)u.g * 256 * lda * 2; q.a1 = q.a0 + (size_t)128 * lda * 2;
        q.b0 = B + (size_t)u.g * 256 * ldb * 2; q.b1 = q.b0 + (size_t)128 * ldb * 2; q.c0 = q.b0; q.c1 = q.b1; }
    DI int brow(int R) const { return R; }
    DI void gather(const Unit&, int (&)[2], int (&)[2], unsigned (&)[2][2]) const {}
};
struct S5aEpi {
    static constexpr int MIDK_T = -1;
    bf16* S;
    DI void operator()(const f32x4 (&acc)[2][2][4][2], const S5aPol::Unit& u, int wr, int wc, int fr, int fq) const {
#pragma unroll
        for (int ai = 0; ai < 2; ++ai)
#pragma unroll
            for (int m = 0; m < 4; ++m) { bf16* dst = S + ((size_t)u.g * 1280 + u.mt * 256 + ai * 128 + wr * 64 + m * 16 + fr) * 256 + wc * 32 + 8 * fq;
#pragma unroll
                for (int bj = 0; bj < 2; ++bj) { const f32x4 v0 = acc[ai][bj][m][0], v1 = acc[ai][bj][m][1];
                    u32x4 w; w.x = pk2(v0[0], v0[1]); w.y = pk2(v0[2], v0[3]); w.z = pk2(v1[0], v1[1]); w.w = pk2(v1[2], v1[3]);
                    *(u32x4*)(dst + bj * 128) = w; } }
    }
};
DI void phase2a_s5states(const Params& p, unsigned char* lds, int bid, int nb) {
    S5aPol P; P.G = nb; P.c = bid; P.A = (const char*)(p.ws + WS_R3); P.Ac = (const char*)(p.ws + WS_R4); P.B = (const char*)(p.ws + WS_WST); P.K = 512; P.ksplit = 8; P.lda = 768; P.ldb = 512;
    S5aEpi E{(bf16*)(p.ws + WS_R1)};
    pg8::gemm_phase<S5aPol, S5aEpi, true>((PG8_LAS unsigned char*)lds, P, E);
}
DI void phase2b_scan(const Params& p, int bid, int nb) {
    const int lane = tidx() & 63, wid = tidx() >> 6;
    for (int item = bid + wid * nb; item < 512; item += nb * 8) {
        const int d = item & 1, gb = item >> 1, g = gb >> 3, b = gb & 7;
        const float* aT = (const float*)(p.ws + WS_ABART) + g * 256 + (d * 64 + lane) * 2; const float ar = aT[0], ai = aT[1];
        const unsigned* Sg = (const unsigned*)((const bf16*)(p.ws + WS_R1) + (size_t)g * 1280 * 256 + d * 128) + lane;
        unsigned* Hout = (unsigned*)((bf16*)(p.ws + WS_R3) + ((size_t)g * 1024 + b * 128) * 768 + 512 + d * 128) + lane;
        float hr = 0.f, hi = 0.f;
        { unsigned sv[8];
#pragma unroll
          for (int j = 0; j < 8; ++j) { const int c = d == 0 ? j : 7 - j; sv[j] = Sg[(size_t)(1024 + b * 8 + c) * 128]; }
#pragma unroll
          for (int j = 0; j < 8; ++j) { const float sr = __uint_as_float(sv[j] << 16), si = __uint_as_float(sv[j] & 0xffff0000u); const float nr = ar * hr - ai * hi + sr, ni = ar * hi + ai * hr + si; hr = nr; hi = ni; } }
#pragma unroll 1
        for (int cb = 0; cb < 128; cb += 32) { unsigned sv[32];
#pragma unroll
            for (int j = 0; j < 32; ++j) { const int c = d == 0 ? cb + j : 127 - cb - j; sv[j] = Sg[(size_t)(b * 128 + c) * 128]; }
#pragma unroll
            for (int j = 0; j < 32; ++j) { const int c = d == 0 ? cb + j : 127 - cb - j; Hout[(size_t)c * 384] = pk2(hr, hi);
                const float sr = __uint_as_float(sv[j] << 16), si = __uint_as_float(sv[j] & 0xffff0000u); const float nr = ar * hr - ai * hi + sr, ni = ar * hi + ai * hr + si; hr = nr; hi = ni; } }
    }
}
struct S5cPol {
    static constexpr long KSTEP_A = 0;
    DI unsigned aoff(int R, int C) const { return (unsigned)(R * lda + C) * 2u; }
    struct Unit { int g, mt, pn; };
    static constexpr bool GATHER = false;
    int G, c; const char* A; const char* B; int K, ksplit, lda, ldb;
    DI bool next(int i, Unit& u) const { const int L = i * G + c; if (L >= 256) return false; u.g = L >> 3; u.mt = (L >> 1) & 3; u.pn = L & 1; return true; }
    DI void ptrs(const Unit& u, pg8::UPtr& q) const { q.a0 = A + ((size_t)u.g * 1024 + u.mt * 256) * lda * 2; q.a1 = q.a0 + (size_t)128 * lda * 2; q.b0 = B + ((size_t)u.g * 512 + u.pn * 256) * ldb * 2; q.b1 = q.b0 + (size_t)128 * ldb * 2; q.c0 = q.b0; q.c1 = q.b1; }
    DI int brow(int R) const { return R; }
    DI void gather(const Unit&, int (&)[2], int (&)[2], unsigned (&)[2][2]) const {}
};
struct S5cEpi {
    static constexpr int MIDK_T = -1;
    const bf16* Ucat; const float* s5d; bf16* yact;
    DI void operator()(const f32x4 (&acc)[2][2][4][2], const S5cPol::Unit& u, int wr, int wc, int fr, int fq) const {
        const int n0 = u.pn * 256 + wc * 32 + 8 * fq, i0 = n0 & 15;
        const f32x4 d0 = *(const f32x4*)(s5d + u.g * 16 + i0), d1 = *(const f32x4*)(s5d + u.g * 16 + i0 + 4);
        u32x4 uu[2][4][2];
#pragma unroll
        for (int ai = 0; ai < 2; ++ai)
#pragma unroll
            for (int m = 0; m < 4; ++m) { const int row = u.mt * 256 + ai * 128 + wr * 64 + m * 16 + fr;
#pragma unroll
                for (int bj = 0; bj < 2; ++bj) uu[ai][m][bj] = *(const u32x4*)(Ucat + ((size_t)u.g * 1024 + row) * 768 + n0 + bj * 128); }
#pragma unroll
        for (int ai = 0; ai < 2; ++ai)
#pragma unroll
            for (int m = 0; m < 4; ++m) { const int row = u.mt * 256 + ai * 128 + wr * 64 + m * 16 + fr, b = row >> 7, c = row & 127;
#pragma unroll
                for (int bj = 0; bj < 2; ++bj) { const int col = n0 + bj * 128, l = 32 * c + (col >> 4); const u32x4 v = uu[ai][m][bj]; const f32x4 a0 = acc[ai][bj][m][0], a1 = acc[ai][bj][m][1];
                    const float y0 = geluf_(a0[0] + d0.x * __uint_as_float(v.x << 16)), y1 = geluf_(a0[1] + d0.y * __uint_as_float(v.x & 0xffff0000u));
                    const float y2 = geluf_(a0[2] + d0.z * __uint_as_float(v.y << 16)), y3 = geluf_(a0[3] + d0.w * __uint_as_float(v.y & 0xffff0000u));
                    const float y4 = geluf_(a1[0] + d1.x * __uint_as_float(v.z << 16)), y5 = geluf_(a1[1] + d1.y * __uint_as_float(v.z & 0xffff0000u));
                    const float y6 = geluf_(a1[2] + d1.z * __uint_as_float(v.w << 16)), y7 = geluf_(a1[3] + d1.w * __uint_as_float(v.w & 0xffff0000u));
                    u32x4 w; w.x = pk2(y0, y1); w.y = pk2(y2, y3); w.z = pk2(y4, y5); w.w = pk2(y6, y7);
                    *(u32x4*)(yact + (((size_t)u.g * NTOK + b * 4096 + l) * 16 + i0)) = w; } }
    }
};
DI void phase2c_s5out(const Params& p, unsigned char* lds, int bid, int nb) {
    S5cPol P; P.G = nb; P.c = (nb % 8 == 0) ? (bid % 8) * (nb / 8) + bid / 8 : bid; P.A = (const char*)(p.ws + WS_R3); P.B = (const char*)(p.ws + WS_MGW); P.K = 768; P.ksplit = 12; P.lda = 768; P.ldb = 768;
    S5cEpi E{(const bf16*)(p.ws + WS_R3), p.s5_d, (bf16*)(p.ws + WS_R4)};
    pg8::gemm_phase<S5cPol, S5cEpi, true>((PG8_LAS unsigned char*)lds, P, E);
}
constexpr int FF_W1P = 272, FF_W2P = 80, FF_W1_OFF = 0, FF_W2_OFF = 128 * FF_W1P, FF_TW_OFF = FF_W2_OFF + 4 * 64 * FF_W2P, FF_LDS = FF_TW_OFF + 32768;
DI void phase2_fft(const Params& p, unsigned char* lds, int bid, int nb) {
    const int tid = tidx(), lane = tid & 63, wid = tid >> 6, fr = lane & 15, fq = lane >> 4;
    { const bf16* W1 = (const bf16*)(p.ws + WS_FFTC); const bf16* W2 = W1 + 128 * 128; const float* tw = (const float*)(p.ws + WS_FFTC + 32768 + 16384);
      for (int i = tid; i < 128 * 16; i += NT) { const int n = i >> 4, c = i & 15; *(u32x4*)(lds + FF_W1_OFF + n * FF_W1P + c * 16) = *(const u32x4*)(W1 + n * 128 + c * 8); }
      for (int i = tid; i < 256 * 4; i += NT) { const int r = i >> 2, c = i & 3; *(u32x4*)(lds + FF_W2_OFF + r * FF_W2P + c * 16) = *(const u32x4*)(W2 + r * 32 + c * 8); }
      for (int i = tid; i < 2048; i += NT) *(u32x4*)(lds + FF_TW_OFF + i * 16) = *(const u32x4*)(tw + i * 4);
      __syncthreads(); }
    const bf16* GT = (const bf16*)(p.ws + WS_R2); bf16* FT = (bf16*)(p.ws + WS_R5);
    const float* twl = (const float*)(lds + FF_TW_OFF) + lane * 2;
    for (int cidx = bid * 8 + wid; cidx < 4096; cidx += nb * 8) {
        const bf16* gt = GT + (size_t)cidx * 2 * 4096;
        bf16* ft = FT + (size_t)cidx * 4096;
        bf16x8 afr[4][4];
#pragma unroll
        for (int ks = 0; ks < 4; ++ks)
#pragma unroll
            for (int mt = 0; mt < 4; ++mt) afr[ks][mt] = *(const bf16x8*)(gt + (ks >> 1) * 4096 + (16 * mt + fr) * 64 + 32 * (ks & 1) + 8 * fq);
        f32x4 d1[4][8];
#pragma unroll
        for (int m = 0; m < 4; ++m)
#pragma unroll
            for (int n = 0; n < 8; ++n) d1[m][n] = (f32x4){0.f, 0.f, 0.f, 0.f};
#pragma unroll
        for (int ks = 0; ks < 4; ++ks) {
#pragma unroll
            for (int nt = 0; nt < 8; ++nt) { const bf16x8 bfr = *(const bf16x8*)(lds + FF_W1_OFF + (nt * 16 + fr) * FF_W1P + (ks * 32 + fq * 8) * 2);
#pragma unroll
                for (int mt = 0; mt < 4; ++mt) d1[mt][nt] = __builtin_amdgcn_mfma_f32_16x16x32_bf16(afr[ks][mt], bfr, d1[mt][nt], 0, 0, 0); }
        }
#pragma unroll
        for (int nt = 0; nt < 4; ++nt) {
            unsigned pr[4][2], pi[4][2];
#pragma unroll
            for (int mt = 0; mt < 4; ++mt) { float tr[4], ti[4];
#pragma unroll
                for (int r = 0; r < 4; ++r) { const float cs = twl[((nt * 4 + mt) * 4 + r) * 128], sn = twl[((nt * 4 + mt) * 4 + r) * 128 + 1];
                    const float re = d1[mt][nt][r], im = d1[mt][nt + 4][r]; tr[r] = re * cs + im * sn; ti[r] = im * cs - re * sn; }
                pr[mt][0] = pk2(tr[0], tr[1]); pr[mt][1] = pk2(tr[2], tr[3]); pi[mt][0] = pk2(ti[0], ti[1]); pi[mt][1] = pk2(ti[2], ti[3]); }
            u32x4 f0, f1, f2, f3;
            f0.x = pr[0][0]; f0.y = pr[0][1]; f0.z = pr[1][0]; f0.w = pr[1][1];
            f1.x = pr[2][0]; f1.y = pr[2][1]; f1.z = pr[3][0]; f1.w = pr[3][1];
            f2.x = pi[0][0]; f2.y = pi[0][1]; f2.z = pi[1][0]; f2.w = pi[1][1];
            f3.x = pi[2][0]; f3.y = pi[2][1]; f3.z = pi[3][0]; f3.w = pi[3][1];
            bf16x8 frag[4];
            frag[0] = __builtin_bit_cast(bf16x8, f0); frag[1] = __builtin_bit_cast(bf16x8, f1); frag[2] = __builtin_bit_cast(bf16x8, f2); frag[3] = __builtin_bit_cast(bf16x8, f3);
            f32x4 z[4];
#pragma unroll
            for (int n = 0; n < 4; ++n) z[n] = (f32x4){0.f, 0.f, 0.f, 0.f};
#pragma unroll
            for (int s2 = 0; s2 < 4; ++s2)
#pragma unroll
                for (int n2 = 0; n2 < 4; ++n2) { const bf16x8 bfr = *(const bf16x8*)(lds + FF_W2_OFF + ((s2 * 64 + n2 * 16 + fr) * FF_W2P) + fq * 16);
                    z[n2] = __builtin_amdgcn_mfma_f32_16x16x32_bf16(frag[s2], bfr, z[n2], 0, 0, 0); }
#pragma unroll
            for (int n2 = 0; n2 < 4; ++n2) { const int cf = 16 * n2 + fr; u32x2 w; w.x = pk2(z[n2][0], z[n2][1]); w.y = pk2(z[n2][2], z[n2][3]);
                *(u32x2*)(ft + 64 * cf + 16 * nt + 4 * fq) = w; }
            __builtin_amdgcn_sched_barrier(0);
        }
    }
}
struct GluPol {
    struct Unit { int pm, pn; };
    static constexpr bool GATHER = false;
    static constexpr long KSTEP_A = 4L * NTOK * 16 * 2;
    pg8::DenseOrder ord; const char* A; const char* B; int K, ksplit, lda, ldb;
    DI unsigned aoff(int R, int C) const { return (unsigned)(((C >> 4) * NTOK + R) * 16 + (C & 15)) * 2u; }
    DI bool next(int i, Unit& u) const { return ord.get(i, u.pm, u.pn); }
    DI void ptrs(const Unit& u, pg8::UPtr& q) const { q.a0 = A + (size_t)u.pm * 256 * 32; q.a1 = q.a0 + (size_t)128 * 32; q.b0 = B + (size_t)u.pn * 256 * ldb * 2; q.b1 = q.b0 + (size_t)128 * ldb * 2; q.c0 = q.b0; q.c1 = q.b1; }
    DI int brow(int R) const { return R; }
    DI void gather(const Unit&, int (&)[2], int (&)[2], unsigned (&)[2][2]) const {}
};
struct GluEpi {
    static constexpr int MIDK_T = -1;
    const bf16* yact; bf16* merged; float* rsqs;
    DI void operator()(const f32x4 (&acc)[2][2][4][2], const GluPol::Unit& u, int wr, int wc, int fr, int fq) const {
        const int col0 = u.pn * 256 + wc * 32 + 8 * fq;
        u32x4 yy[2][4][2];
#pragma unroll
        for (int ai = 0; ai < 2; ++ai)
#pragma unroll
            for (int m = 0; m < 4; ++m) { const int row = u.pm * 256 + ai * 128 + wr * 64 + m * 16 + fr;
#pragma unroll
                for (int bj = 0; bj < 2; ++bj) { const int col = col0 + bj * 128; yy[ai][m][bj] = *(const u32x4*)(yact + ((size_t)(col >> 4) * NTOK + row) * 16 + (col & 15)); } }
#pragma unroll
        for (int ai = 0; ai < 2; ++ai)
#pragma unroll
            for (int m = 0; m < 4; ++m) { const int row = u.pm * 256 + ai * 128 + wr * 64 + m * 16 + fr; float sq = 0.f;
#pragma unroll
                for (int bj = 0; bj < 2; ++bj) { const u32x4 y = yy[ai][m][bj]; const f32x4 a0 = acc[ai][bj][m][0], a1 = acc[ai][bj][m][1];
                    const float y0 = __uint_as_float(y.x << 16) * sigmoidf_(a0[0]), y1 = __uint_as_float(y.x & 0xffff0000u) * sigmoidf_(a0[1]);
                    const float y2 = __uint_as_float(y.y << 16) * sigmoidf_(a0[2]), y3 = __uint_as_float(y.y & 0xffff0000u) * sigmoidf_(a0[3]);
                    const float y4 = __uint_as_float(y.z << 16) * sigmoidf_(a1[0]), y5 = __uint_as_float(y.z & 0xffff0000u) * sigmoidf_(a1[1]);
                    const float y6 = __uint_as_float(y.w << 16) * sigmoidf_(a1[2]), y7 = __uint_as_float(y.w & 0xffff0000u) * sigmoidf_(a1[3]);
                    u32x4 w; w.x = pk2(y0, y1); w.y = pk2(y2, y3); w.z = pk2(y4, y5); w.w = pk2(y6, y7); *(u32x4*)(merged + (size_t)row * 1024 + col0 + bj * 128) = w;
                    sq += ((y0 * y0 + y1 * y1) + (y2 * y2 + y3 * y3)) + ((y4 * y4 + y5 * y5) + (y6 * y6 + y7 * y7)); }
                sq += __shfl_xor(sq, 16); sq += __shfl_xor(sq, 32);
                if (fq == 0) rsqs[(size_t)row * 8 + u.pn * 4 + wc] = sq; }
    }
};
DI void phase3_glu(const Params& p, unsigned char* lds, int bid, int nb) {
    GluPol P; P.ord.init(NTOK / 256, 2, nb, bid); P.A = (const char*)(p.ws + WS_R4); P.B = (const char*)(p.ws + WS_WGLUT); P.K = 512; P.ksplit = 8; P.lda = 512; P.ldb = 512;
    GluEpi E{(const bf16*)(p.ws + WS_R4), (bf16*)(p.ws + WS_R1), (float*)(p.ws + WS_RSQS)};
    pg8::gemm_phase<GluPol, GluEpi, true>((PG8_LAS unsigned char*)lds, P, E);
}
constexpr int FM_PITCH = 132, FM_LDS = 512 * FM_PITCH;
DI void phase3_fin(const Params& p, unsigned char* lds, int bid, int nb) {
    const int tid = tidx(), lane = tid & 63, wid = tid >> 6;
    const bf16* FT = (const bf16*)(p.ws + WS_R5); bf16* merged = (bf16*)(p.ws + WS_R1);
    float gf[8];
#pragma unroll
    for (int j = 0; j < 8; ++j) gf[j] = p.g_f[lane + 64 * j];
    for (int item = bid; item < 512; item += nb) {
        const int b = item >> 6, k0 = (item & 63) * 64;
        { u32x4 v[8];
#pragma unroll
          for (int i = 0; i < 8; ++i) { const int ix = tid + NT * i, ch = ix >> 3, c = ix & 7; v[i] = *(const u32x4*)(FT + ((size_t)(b * 512 + ch) * 4096 + k0 + c * 8)); }
#pragma unroll
          for (int i = 0; i < 8; ++i) { const int ix = tid + NT * i, ch = ix >> 3, c = ix & 7; unsigned* d = (unsigned*)(lds + ch * FM_PITCH + c * 16); d[0] = v[i].x; d[1] = v[i].y; d[2] = v[i].z; d[3] = v[i].w; } }
        __syncthreads();
        float f[8][8], s[8];
#pragma unroll
        for (int t = 0; t < 8; ++t)
#pragma unroll
            for (int j = 0; j < 8; ++j) f[t][j] = bf2f(*(const bf16*)(lds + (lane + 64 * j) * FM_PITCH + (wid * 8 + t) * 2));
#pragma unroll
        for (int t = 0; t < 8; ++t) { float a = 0.f;
#pragma unroll
            for (int j = 0; j < 8; ++j) a += f[t][j] * f[t][j];
            s[t] = a; }
#pragma unroll
        for (int o = 1; o < 64; o <<= 1) {
#pragma unroll
            for (int t = 0; t < 8; ++t) s[t] += __shfl_xor(s[t], o); }
#pragma unroll
        for (int t = 0; t < 8; ++t) { const size_t row = (size_t)b * 4096 + k0 + wid * 8 + t; const float rs = rsqrtf(s[t] * (1.f / 512.f) + EPS);
#pragma unroll
            for (int j = 0; j < 8; ++j) merged[row * 1024 + 512 + lane + 64 * j] = (bf16)(pk2(f[t][j] * rs * gf[j], 0.f) & 0xffffu); }
        __syncthreads();
    }
}
struct P4Pol {
    static constexpr long KSTEP_A = 0;
    DI unsigned aoff(int R, int C) const { return (unsigned)(R * lda + C) * 2u; }
    struct Unit { int pm, pn; };
    static constexpr bool GATHER = false;
    pg8::DenseOrder ord; const char* A; const char* B; int K, ksplit, lda, ldb;
    DI bool next(int i, Unit& u) const { return ord.get(i, u.pm, u.pn); }
    DI void ptrs(const Unit& u, pg8::UPtr& q) const { q.a0 = A + (size_t)u.pm * 256 * lda * 2; q.a1 = q.a0 + (size_t)128 * lda * 2; q.b0 = B + (size_t)u.pn * 256 * ldb * 2; q.b1 = q.b0 + (size_t)128 * ldb * 2; q.c0 = q.b0; q.c1 = q.b1; }
    DI int brow(int R) const { return R; }
    DI void gather(const Unit&, int (&)[2], int (&)[2], unsigned (&)[2][2]) const {}
};
struct P4Epi {
    static constexpr int MIDK_T = 8;
    const float* x; bf16* x1b; const float* mod; float* rsqp; const float* rss;
    DI void midk(f32x4 (&acc)[2][2][4][2], const P4Pol::Unit& u, int wr, int wc, int fr, int fq) const {
        float r[2][4]; f32x4 q0[2][4], q1[2][4];
#pragma unroll
        for (int ai = 0; ai < 2; ++ai)
#pragma unroll
            for (int m = 0; m < 4; ++m) { const f32x4* q = (const f32x4*)(rss + (size_t)(u.pm * 256 + ai * 128 + wr * 64 + m * 16 + fr) * 8); q0[ai][m] = q[0]; q1[ai][m] = q[1]; }
#pragma unroll
        for (int ai = 0; ai < 2; ++ai)
#pragma unroll
            for (int m = 0; m < 4; ++m) r[ai][m] = rsqrtf((((q0[ai][m].x + q0[ai][m].y) + (q0[ai][m].z + q0[ai][m].w)) + ((q1[ai][m].x + q1[ai][m].y) + (q1[ai][m].z + q1[ai][m].w))) * (1.f / 512.f) + EPS);
#pragma unroll
        for (int ai = 0; ai < 2; ++ai)
#pragma unroll
            for (int m = 0; m < 4; ++m)
#pragma unroll
                for (int bj = 0; bj < 2; ++bj)
#pragma unroll
                    for (int n = 0; n < 2; ++n) acc[ai][bj][m][n] = acc[ai][bj][m][n] * r[ai][m];
    }
    DI void operator()(const f32x4 (&acc)[2][2][4][2], const P4Pol::Unit& u, int wr, int wc, int fr, int fq) const {
        const int col0 = u.pn * 256 + wc * 32 + 8 * fq, b = (u.pm * 256) >> 12;
        f32x4 gv[2][2];
#pragma unroll
        for (int bj = 0; bj < 2; ++bj)
#pragma unroll
            for (int n = 0; n < 2; ++n) gv[bj][n] = *(const f32x4*)(mod + b * 6144 + 2048 + col0 + bj * 128 + n * 4);
        f32x4 xa[2][2][2], xb[2][2][2];
#define P4_LOAD(dst, q_) do { const int ai_ = (q_) >> 1, mb_ = ((q_) & 1) * 2; _Pragma("unroll") for (int m2 = 0; m2 < 2; ++m2) { const int row_ = u.pm * 256 + ai_ * 128 + wr * 64 + (mb_ + m2) * 16 + fr; \
            _Pragma("unroll") for (int bj = 0; bj < 2; ++bj) _Pragma("unroll") for (int n = 0; n < 2; ++n) dst[m2][bj][n] = *(const f32x4*)(x + (size_t)row_ * D + col0 + bj * 128 + n * 4); } } while (0)
#define P4_DO(src, q_) do { const int ai_ = (q_) >> 1, mb_ = ((q_) & 1) * 2; _Pragma("unroll") for (int m2 = 0; m2 < 2; ++m2) { const int m_ = mb_ + m2, row_ = u.pm * 256 + ai_ * 128 + wr * 64 + m_ * 16 + fr; float s_ = 0.f; \
            _Pragma("unroll") for (int bj = 0; bj < 2; ++bj) { const f32x4 o0 = src[m2][bj][0] + gv[bj][0] * acc[ai_][bj][m_][0], o1 = src[m2][bj][1] + gv[bj][1] * acc[ai_][bj][m_][1]; \
                u32x4 w; w.x = pk2(o0.x, o0.y); w.y = pk2(o0.z, o0.w); w.z = pk2(o1.x, o1.y); w.w = pk2(o1.z, o1.w); *(u32x4*)(x1b + (size_t)row_ * D + col0 + bj * 128) = w; \
                s_ += ((o0.x * o0.x + o0.y * o0.y) + (o0.z * o0.z + o0.w * o0.w)) + ((o1.x * o1.x + o1.y * o1.y) + (o1.z * o1.z + o1.w * o1.w)); } \
            s_ += __shfl_xor(s_, 16); s_ += __shfl_xor(s_, 32); if (fq == 0) rsqp[(size_t)row_ * 16 + u.pn * 4 + wc] = s_; } } while (0)
        P4_LOAD(xa, 0); P4_LOAD(xb, 1);
        P4_DO(xa, 0); asm volatile("" ::: "memory"); P4_LOAD(xa, 2);
        P4_DO(xb, 1); asm volatile("" ::: "memory"); P4_LOAD(xb, 3);
        P4_DO(xa, 2); asm volatile("" ::: "memory");
        P4_DO(xb, 3);
#undef P4_LOAD
#undef P4_DO
    }
};
DI void phase4_out(const Params& p, unsigned char* lds, int bid, int nb) {
    P4Pol P; P.ord.init(NTOK / 256, D / 256, nb, bid); P.A = (const char*)(p.ws + WS_R1); P.B = (const char*)(p.ws + WS_WOUTT); P.K = 1024; P.ksplit = 16; P.lda = 1024; P.ldb = 1024;
    P4Epi E{p.x, (bf16*)(p.ws + WS_X1B), (const float*)(p.ws + WS_MOD), (float*)(p.ws + WS_RSQP1), (const float*)(p.ws + WS_RSQS)};
    pg8::gemm_phase<P4Pol, P4Epi, true>((PG8_LAS unsigned char*)lds, P, E);
}
DI int pair_index(int lo, int hi) { return 7 * lo - (lo * (lo - 1)) / 2 + (hi - lo - 1); }
constexpr int RT_WP = 2064, RT_GM_OFF = 48 * RT_WP, RT_SH_OFF = RT_GM_OFF + 4096, RT_SC_OFF = RT_SH_OFF + 4096, RT_LDS = RT_SC_OFF + 8 * 16 * 48 * 4;
DI void phase5_route(const Params& p, unsigned char* lds, int bid, int nb, bool commit = true) {
    const int tid = tidx(), lane = tid & 63, wid = tid >> 6, fr = lane & 15, fq = lane >> 4;
    { const bf16* W = (const bf16*)(p.ws + WS_WRT);
      for (int i = tid; i < 48 * 128; i += NT) { const int n = i >> 7, c = i & 127; *(u32x4*)(lds + n * RT_WP + c * 16) = *(const u32x4*)(W + n * 1024 + c * 8); } }
    const float* mod = (const float*)(p.ws + WS_MOD); const float* rsqp = (const float*)(p.ws + WS_RSQP1);
    bf16* A2 = (bf16*)(p.ws + WS_A2); unsigned* elcp = (unsigned*)(p.ws + WS_ELCP); float* elw = (float*)(p.ws + WS_ELW); unsigned* tcp = (unsigned*)(p.ws + WS_TCP);
    unsigned* ecnt = (unsigned*)(p.ws + WS_CTL + CTL_ECNT); unsigned* pcnt = (unsigned*)(p.ws + WS_CTL + CTL_PCNT);
    unsigned* elist = (unsigned*)(p.ws + WS_ELIST);
    float* gm = (float*)(lds + RT_GM_OFF); float* shv = (float*)(lds + RT_SH_OFF); float* scr = (float*)(lds + RT_SC_OFF) + wid * 16 * 48;
    for (int t128 = bid; t128 < NTOK / 128; t128 += nb) {
        const int b = t128 >> 5;
        __syncthreads();
        for (int k = tid; k < 1024; k += NT) { gm[k] = p.norm2_g[k] * (1.f + mod[b * 6144 + 4096 + k]); shv[k] = mod[b * 6144 + 3072 + k]; }
        __syncthreads();
        const int row0 = t128 * 128 + wid * 16, row = row0 + fr;
        float rs;
        { const f32x4* pp = (const f32x4*)(rsqp + (size_t)row * 16); const f32x4 q0 = pp[0], q1 = pp[1], q2 = pp[2], q3 = pp[3];
          const float rsum = (((q0.x + q0.y) + (q0.z + q0.w)) + ((q1.x + q1.y) + (q1.z + q1.w))) + (((q2.x + q2.y) + (q2.z + q2.w)) + ((q3.x + q3.y) + (q3.z + q3.w)));
          rs = rsqrtf(rsum * (1.f / D) + EPS); }
        f32x4 acc[3];
#pragma unroll
        for (int n = 0; n < 3; ++n) acc[n] = (f32x4){0.f, 0.f, 0.f, 0.f};
        const bf16* xr = (const bf16*)(p.ws + WS_X1B) + (size_t)row * D + fq * 8; bf16* ar = A2 + (size_t)row * D + fq * 8;
        u32x4 xa[8], xb[8];
#pragma unroll
        for (int i = 0; i < 8; ++i) xa[i] = *(const u32x4*)(xr + i * 32);
#pragma unroll 1
        for (int kc = 0; kc < 4; kc += 2) {
#pragma unroll
            for (int i = 0; i < 8; ++i) xb[i] = *(const u32x4*)(xr + (kc + 1) * 256 + i * 32);
#pragma unroll
            for (int half = 0; half < 2; ++half) {
#pragma unroll
                for (int i = 0; i < 8; ++i) {
                    const int ks = (kc + half) * 8 + i, k0 = ks * 32 + fq * 8;
                    const u32x4 xx = half ? xb[i] : xa[i];
                    f32x4 x0, x1; x0.x = __uint_as_float(xx.x << 16); x0.y = __uint_as_float(xx.x & 0xffff0000u); x0.z = __uint_as_float(xx.y << 16); x0.w = __uint_as_float(xx.y & 0xffff0000u);
                    x1.x = __uint_as_float(xx.z << 16); x1.y = __uint_as_float(xx.z & 0xffff0000u); x1.z = __uint_as_float(xx.w << 16); x1.w = __uint_as_float(xx.w & 0xffff0000u);
                    const f32x4 g0 = *(const f32x4*)(gm + k0), g1 = *(const f32x4*)(gm + k0 + 4), s0 = *(const f32x4*)(shv + k0), s1 = *(const f32x4*)(shv + k0 + 4);
                    const f32x4 t0 = x0 * rs * g0 + s0, t1 = x1 * rs * g1 + s1;
                    u32x4 hi; hi.x = pk2(t0.x, t0.y); hi.y = pk2(t0.z, t0.w); hi.z = pk2(t1.x, t1.y); hi.w = pk2(t1.z, t1.w);
                    *(u32x4*)(ar + ks * 32) = hi;
                    u32x4 lo;
                    lo.x = pk2(t0.x - __uint_as_float(hi.x << 16), t0.y - __uint_as_float(hi.x & 0xffff0000u)); lo.y = pk2(t0.z - __uint_as_float(hi.y << 16), t0.w - __uint_as_float(hi.y & 0xffff0000u));
                    lo.z = pk2(t1.x - __uint_as_float(hi.z << 16), t1.y - __uint_as_float(hi.z & 0xffff0000u)); lo.w = pk2(t1.z - __uint_as_float(hi.w << 16), t1.w - __uint_as_float(hi.w & 0xffff0000u));
                    const bf16x8 ah = __builtin_bit_cast(bf16x8, hi), al = __builtin_bit_cast(bf16x8, lo);
#pragma unroll
                    for (int nt = 0; nt < 3; ++nt) { const bf16x8 bw = *(const bf16x8*)(lds + (16 * nt + fr) * RT_WP + k0 * 2);
                        acc[nt] = __builtin_amdgcn_mfma_f32_16x16x32_bf16(ah, bw, acc[nt], 0, 0, 0); acc[nt] = __builtin_amdgcn_mfma_f32_16x16x32_bf16(al, bw, acc[nt], 0, 0, 0); }
                }
                if (half == 0 && kc + 2 < 4) {
#pragma unroll
                    for (int i = 0; i < 8; ++i) xa[i] = *(const u32x4*)(xr + (kc + 2) * 256 + i * 32);
                }
            }
        }
#pragma unroll
        for (int nt = 0; nt < 3; ++nt)
#pragma unroll
            for (int r = 0; r < 4; ++r) scr[(4 * fq + r) * 48 + 16 * nt + fr] = acc[nt][r];
        __syncthreads();
        if (lane < 16 && commit) {
            const int rrow = row0 + lane; const float* lg = scr + lane * 48;
            float gl[4];
#pragma unroll
            for (int o = 0; o < 4; ++o) gl[o] = lg[o] + p.b_group[o];
            float gmax = gl[0]; int gi = 0;
#pragma unroll
            for (int o = 1; o < 4; ++o) if (gl[o] > gmax) { gmax = gl[o]; gi = o; }
            float se = 0.f;
#pragma unroll
            for (int o = 0; o < 4; ++o) se += __expf(gl[o] - gmax);
            const float g_w = 1.f / se;
            float ev[8];
#pragma unroll
            for (int o = 0; o < 8; ++o) ev[o] = lg[4 + gi * 8 + o] + p.b_router[gi * 8 + o];
            float v1 = ev[0]; int i1 = 0;
#pragma unroll
            for (int o = 1; o < 8; ++o) if (ev[o] > v1) { v1 = ev[o]; i1 = o; }
            float v2 = -3.0e38f; int i2 = -1;
#pragma unroll
            for (int o = 0; o < 8; ++o) if (o != i1 && ev[o] > v2) { v2 = ev[o]; i2 = o; }
            const float w1 = g_w / (1.f + __expf(v2 - v1)), w2 = g_w - w1;
            const int lo = i1 < i2 ? i1 : i2, hi = i1 < i2 ? i2 : i1; const int pos1 = i1 < i2 ? 0 : 1;
            const int e1 = gi * 8 + i1, e2 = gi * 8 + i2;
            const int cls = gi * 28 + pair_index(lo, hi);
            const unsigned q3 = atomicAdd(pcnt + cls, 1u); const unsigned cp = ((unsigned)cls << 16) | q3;
            tcp[rrow] = cp;
            const unsigned q1 = atomicAdd(ecnt + e1, 1u); elist[(size_t)e1 * 32768 + q1] = (unsigned)rrow * 2u + (unsigned)pos1; elcp[(size_t)e1 * 32768 + q1] = cp; elw[(size_t)e1 * 32768 + q1] = w1;
            const unsigned q2 = atomicAdd(ecnt + e2, 1u); elist[(size_t)e2 * 32768 + q2] = (unsigned)rrow * 2u + (unsigned)(1 - pos1); elcp[(size_t)e2 * 32768 + q2] = cp; elw[(size_t)e2 * 32768 + q2] = w2;
        }
    }
    __syncthreads();
}
constexpr int TB_OFF = 131072, TB_ETE = 64, TB_ETR = 64 + 320, TB_ETC = 64 + 640, TB_PTC = 64 + 960, TB_PTS = 64 + 1280, TB_COFF = 64 + 1600, TB_BYTES = (64 + 1600 + 128 + 160) * 4;
DI void build_tiles(const Params& p, unsigned char* lds) {
    int* tb = (int*)(lds + TB_OFF); int* cnts = tb + TB_COFF + 112;
    const int tid = tidx();
    if (tid < 144) cnts[tid] = tid < 32 ? (int)((const unsigned*)(p.ws + WS_CTL + CTL_ECNT))[tid] : (int)((const unsigned*)(p.ws + WS_CTL + CTL_PCNT))[tid - 32];
    __syncthreads();
    if (tid == 0) {
        int n = 0;
        for (int e = 0; e < 32; ++e) { const int c = cnts[e]; for (int r0 = 0; r0 < c; r0 += 256) { tb[TB_ETE + n] = e; tb[TB_ETR + n] = r0; tb[TB_ETC + n] = c; ++n; } }
        tb[0] = n;
    }
    if (tid == 64) {
        int n = 0, off = 0;
        for (int c2 = 0; c2 < 112; ++c2) { const int c = cnts[32 + c2]; tb[TB_COFF + c2] = off; for (int r0 = 0; r0 < c; r0 += 256) { tb[TB_PTC + n] = c2; tb[TB_PTS + n] = off + r0; ++n; } off += ((c + 255) >> 8) << 8; }
        tb[1] = n;
    }
    __syncthreads();
}
struct GUPol {
    static constexpr long KSTEP_A = 0;
    DI unsigned aoff(int R, int C) const { return (unsigned)(R * lda + C) * 2u; }
    struct Unit { int e, r0, cnt, hh; };
    static constexpr bool GATHER = true;
    const int* tb; int G, c; const char* A; const char* B; const unsigned* elist; int K, ksplit, lda, ldb;
    DI bool next(int i, Unit& u) const { const int L = i * G + c; if (L >= __builtin_amdgcn_readfirstlane(tb[0]) * 2) return false; const int t = L >> 1; u.hh = L & 1;
        u.e = __builtin_amdgcn_readfirstlane(tb[TB_ETE + t]); u.r0 = __builtin_amdgcn_readfirstlane(tb[TB_ETR + t]); u.cnt = __builtin_amdgcn_readfirstlane(tb[TB_ETC + t]); return true; }
    DI void ptrs(const Unit& u, pg8::UPtr& q) const { q.a0 = A; q.a1 = A; q.b0 = B + (size_t)((u.e * 2 + u.hh) * 256) * ldb * 2; q.b1 = q.b0 + (size_t)128 * ldb * 2; q.c0 = q.b0; q.c1 = q.b1; }
    DI int brow(int R) const { return R; }
    DI void gather(const Unit& u, int (&R)[2], int (&C)[2], unsigned (&va)[2][2]) const {
#pragma unroll
        for (int h = 0; h < 2; ++h)
#pragma unroll
            for (int i = 0; i < 2; ++i) { const int r = u.r0 + h * 128 + R[i]; const unsigned ent = elist[(size_t)u.e * 32768 + (r < u.cnt ? r : u.r0)]; va[h][i] = ((ent >> 1) * 1024u + (unsigned)C[i]) * 2u; }
    }
};
struct GUEpi {
    static constexpr int MIDK_T = -1;
    const unsigned* elist; const unsigned* elcp; const float* elw; bf16* Hs; const int* tb;
    DI void operator()(const f32x4 (&acc)[2][2][4][2], const GUPol::Unit& u, int wr, int wc, int fr, int fq) const {
        unsigned ent[2][4], cp[2][4]; float w[2][4];
#pragma unroll
        for (int ai = 0; ai < 2; ++ai)
#pragma unroll
            for (int m = 0; m < 4; ++m) { const int r = u.r0 + ai * 128 + wr * 64 + m * 16 + fr; const size_t ix = (size_t)u.e * 32768 + (r < u.cnt ? r : u.r0);
                ent[ai][m] = elist[ix]; cp[ai][m] = elcp[ix]; w[ai][m] = elw[ix]; }
#pragma unroll
        for (int ai = 0; ai < 2; ++ai)
#pragma unroll
            for (int m = 0; m < 4; ++m) { const int r = u.r0 + ai * 128 + wr * 64 + m * 16 + fr;
                if (r < u.cnt) { const int srow = tb[TB_COFF + (cp[ai][m] >> 16)] + (int)(cp[ai][m] & 0xffffu); const float ww = w[ai][m];
                    bf16* dst = Hs + (size_t)srow * 512 + (ent[ai][m] & 1u) * 256 + u.hh * 128 + wc * 32 + 8 * fq;
                    const f32x4 g0 = acc[ai][0][m][0], g1 = acc[ai][0][m][1], u0 = acc[ai][1][m][0], u1 = acc[ai][1][m][1];
                    u32x4 o; o.x = pk2(siluf_(g0[0]) * u0[0] * ww, siluf_(g0[1]) * u0[1] * ww); o.y = pk2(siluf_(g0[2]) * u0[2] * ww, siluf_(g0[3]) * u0[3] * ww);
                    o.z = pk2(siluf_(g1[0]) * u1[0] * ww, siluf_(g1[1]) * u1[1] * ww); o.w = pk2(siluf_(g1[2]) * u1[2] * ww, siluf_(g1[3]) * u1[3] * ww);
                    *(u32x4*)dst = o; } }
    }
};
DI void phase6_gateup(const Params& p, unsigned char* lds, int bid, int nb) {
    GUPol P; P.tb = (const int*)(lds + TB_OFF); P.G = nb; P.c = (nb % 8 == 0) ? (bid % 8) * (nb / 8) + bid / 8 : bid; P.A = (const char*)(p.ws + WS_A2); P.B = (const char*)(p.ws + WS_WGUT); P.elist = (const unsigned*)(p.ws + WS_ELIST); P.K = 1024; P.ksplit = 16; P.lda = 1024; P.ldb = 1024;
    GUEpi E{(const unsigned*)(p.ws + WS_ELIST), (const unsigned*)(p.ws + WS_ELCP), (const float*)(p.ws + WS_ELW), (bf16*)(p.ws + WS_HS), (const int*)(lds + TB_OFF)};
    pg8::gemm_phase<GUPol, GUEpi, true>((PG8_LAS unsigned char*)lds, P, E);
}
struct DnPol {
    static constexpr long KSTEP_A = 0;
    DI unsigned aoff(int R, int C) const { return (unsigned)(R * lda + C) * 2u; }
    struct Unit { int s0, cls, pn; };
    static constexpr bool GATHER = false;
    const int* tb; int G, c; const char* A; const char* B; int K, ksplit, lda, ldb;
    DI bool next(int i, Unit& u) const { const int L = i * G + c; if (L >= __builtin_amdgcn_readfirstlane(tb[1]) * 4) return false; const int t = L >> 2; u.pn = L & 3;
        u.cls = __builtin_amdgcn_readfirstlane(tb[TB_PTC + t]); u.s0 = __builtin_amdgcn_readfirstlane(tb[TB_PTS + t]); return true; }
    DI void ptrs(const Unit& u, pg8::UPtr& q) const {
        const int gi = u.cls / 28; int lo = 0, rem = u.cls % 28;
        while (rem >= 7 - lo) { rem -= 7 - lo; ++lo; }
        const int hi = lo + 1 + rem, elo = gi * 8 + lo, ehi = gi * 8 + hi;
        q.a0 = A + (size_t)u.s0 * lda * 2; q.a1 = q.a0 + (size_t)128 * lda * 2;
        q.b0 = B + ((size_t)elo * 1024 + u.pn * 256) * ldb * 2; q.b1 = q.b0 + (size_t)128 * ldb * 2;
        q.c0 = B + ((size_t)ehi * 1024 + u.pn * 256) * ldb * 2; q.c1 = q.c0 + (size_t)128 * ldb * 2; }
    DI int brow(int R) const { return R; }
    DI void gather(const Unit&, int (&)[2], int (&)[2], unsigned (&)[2][2]) const {}
};
struct DnEpi {
    static constexpr int MIDK_T = -1;
    bf16* moe;
    DI void operator()(const f32x4 (&acc)[2][2][4][2], const DnPol::Unit& u, int wr, int wc, int fr, int fq) const {
#pragma unroll
        for (int ai = 0; ai < 2; ++ai)
#pragma unroll
            for (int m = 0; m < 4; ++m) { bf16* dst = moe + (size_t)(u.s0 + ai * 128 + wr * 64 + m * 16 + fr) * 1024 + u.pn * 256 + wc * 32 + 8 * fq;
#pragma unroll
                for (int bj = 0; bj < 2; ++bj) { const f32x4 v0 = acc[ai][bj][m][0], v1 = acc[ai][bj][m][1];
                    u32x4 w; w.x = pk2(v0[0], v0[1]); w.y = pk2(v0[2], v0[3]); w.z = pk2(v1[0], v1[1]); w.w = pk2(v1[2], v1[3]);
                    *(u32x4*)(dst + bj * 128) = w; } }
    }
};
DI void phase7_down(const Params& p, unsigned char* lds, int bid, int nb) {
    DnPol P; P.tb = (const int*)(lds + TB_OFF); P.G = nb; P.c = (nb % 8 == 0) ? (bid % 8) * (nb / 8) + bid / 8 : bid; P.A = (const char*)(p.ws + WS_HS); P.B = (const char*)(p.ws + WS_WDT); P.K = 512; P.ksplit = 4; P.lda = 512; P.ldb = 256;
    DnEpi E{(bf16*)(p.ws + WS_MOE)};
    pg8::gemm_phase<DnPol, DnEpi, true>((PG8_LAS unsigned char*)lds, P, E);
}
DI void phase8_final(const Params& p, unsigned char* lds, int bid, int nb) {
    const int lane = tidx() & 63, wave = tidx() >> 6;
    const float* mod = (const float*)(p.ws + WS_MOD); const unsigned* tcp = (const unsigned*)(p.ws + WS_TCP); const bf16* moe = (const bf16*)(p.ws + WS_MOE); const bf16* x1b = (const bf16*)(p.ws + WS_X1B); const int* tb = (const int*)(lds + TB_OFF);
    constexpr int RW = 4;
    for (int r0 = (bid * 8 + wave) * RW; r0 < NTOK; r0 += nb * 8 * RW) {
        const int b = r0 >> 12; unsigned cp[RW]; u32x2 xx[RW][4], mm[RW][4];
#pragma unroll
        for (int q = 0; q < RW; ++q) cp[q] = tcp[r0 + q];
#pragma unroll
        for (int q = 0; q < RW; ++q)
#pragma unroll
            for (int j = 0; j < 4; ++j) xx[q][j] = ((const u32x2*)(x1b + (size_t)(r0 + q) * D) + lane)[64 * j];
#pragma unroll
        for (int q = 0; q < RW; ++q) { const int srow = tb[TB_COFF + (cp[q] >> 16)] + (int)(cp[q] & 0xffffu);
#pragma unroll
            for (int j = 0; j < 4; ++j) mm[q][j] = ((const u32x2*)(moe + (size_t)srow * D) + lane)[64 * j]; }
        f32x4 g2[4], fg[4];
#pragma unroll
        for (int j = 0; j < 4; ++j) { g2[j] = *(const f32x4*)(mod + b * 6144 + 5120 + lane * 4 + 256 * j); fg[j] = *(const f32x4*)(p.final_g + lane * 4 + 256 * j); }
        f32x4 v[RW][4]; float s[RW];
#pragma unroll
        for (int q = 0; q < RW; ++q) { float t = 0.f;
#pragma unroll
            for (int j = 0; j < 4; ++j) { f32x4 x1, mv; x1.x = __uint_as_float(xx[q][j].x << 16); x1.y = __uint_as_float(xx[q][j].x & 0xffff0000u); x1.z = __uint_as_float(xx[q][j].y << 16); x1.w = __uint_as_float(xx[q][j].y & 0xffff0000u);
                mv.x = __uint_as_float(mm[q][j].x << 16); mv.y = __uint_as_float(mm[q][j].x & 0xffff0000u); mv.z = __uint_as_float(mm[q][j].y << 16); mv.w = __uint_as_float(mm[q][j].y & 0xffff0000u);
                v[q][j] = x1 + g2[j] * mv; t += (v[q][j].x * v[q][j].x + v[q][j].y * v[q][j].y) + (v[q][j].z * v[q][j].z + v[q][j].w * v[q][j].w); }
            s[q] = t; }
#pragma unroll
        for (int o = 1; o < 64; o <<= 1) {
#pragma unroll
            for (int q = 0; q < RW; ++q) s[q] += __shfl_xor(s[q], o); }
#pragma unroll
        for (int q = 0; q < RW; ++q) { const float rs = rsqrtf(s[q] * (1.f / D) + EPS); f32x4* orow = (f32x4*)(p.out + (size_t)(r0 + q) * D) + lane;
#pragma unroll
            for (int j = 0; j < 4; ++j) { f32x4 o = v[q][j] * rs * fg[j];
                if (MK_TS1 >= 0) { const unsigned* tsv = (const unsigned*)(p.ws + WS_CTL + CTL_TS); o = o * (1.f + (float)(tsv[0] / 1000u) * 0.01f); }
                orow[64 * j] = o; } }
    }
}

#define XB_TMO      128
#define XB_XCNT(j)  (256  + 64 * (j))
#define XB_XSUB(j)  (1280 + 64 * (j))
#define XB_XGEN(j)  (2304 + 64 * (j))
#define XB_TOP      3328
#define XB_TOPGEN   3392
#define XCD_BAR_WORDS 3456
#define XB_SPIN_CAP (1u << 18)
#define LAS __attribute__((address_space(3)))
DI unsigned xb_ld(unsigned* p)              { return __hip_atomic_load(p, __ATOMIC_RELAXED, __HIP_MEMORY_SCOPE_AGENT); }
DI unsigned xb_add(unsigned* p, unsigned v) { return __hip_atomic_fetch_add(p, v, __ATOMIC_RELAXED, __HIP_MEMORY_SCOPE_AGENT); }
DI unsigned xb_xcc_id() { return (unsigned)__builtin_amdgcn_s_getreg((3 << 11) | 20) & 0xFu; }
#define XB_SPIN(cond, bar) do { unsigned _sp = 0; while (cond) { __builtin_amdgcn_s_sleep(1); \
    if ((++_sp & 255u) == 0u) { if (xb_ld(&(bar)[XB_TMO])) break; if (_sp > XB_SPIN_CAP) { atomicAdd(&(bar)[XB_TMO], 1u); break; } } } } while (0)
struct XcdBarrier { unsigned* bar; unsigned x; volatile LAS unsigned* st; };
DI XcdBarrier xcd_barrier_post(unsigned* bar, volatile LAS unsigned* st) {
    XcdBarrier b; b.bar = bar; b.x = xb_xcc_id(); b.st = st;
    if (tidx() == 0) (void)xb_add(&bar[XB_XCNT(b.x)], 1u);
    return b;
}
DI void xcd_barrier_complete(unsigned* bar, unsigned x, unsigned& nloc, unsigned& nx) {
    const unsigned G = gridDim.x * gridDim.y * gridDim.z;
    unsigned sum, cnt, mine, sp = 0u;
    for (;;) {
        sum = 0u; cnt = 0u; mine = 0u;
#pragma unroll
        for (unsigned j = 0; j < 16; ++j) { const unsigned c = xb_ld(&bar[XB_XCNT(j)]); sum += c; cnt += (c > 0u) ? 1u : 0u; mine = (j == x) ? c : mine; }
        if (sum == G) break;
        __builtin_amdgcn_s_sleep(1);
        if ((++sp & 255u) == 0u) { if (xb_ld(&bar[XB_TMO])) break; if (sp > XB_SPIN_CAP) { atomicAdd(&bar[XB_TMO], 1u); break; } }
    }
    nloc = mine > 0u ? mine : 1u; nx = cnt > 0u ? cnt : 1u;
}
DI void xcd_barrier(const XcdBarrier& b) {
    asm volatile("s_waitcnt vmcnt(0)" ::: "memory");
    __syncthreads();
    if (tidx() == 0) {
        unsigned* bar = b.bar;
        __builtin_amdgcn_s_waitcnt(0);
        unsigned nloc = b.st[0], nx = b.st[1];
        if (nloc == 0u) { xcd_barrier_complete(bar, b.x, nloc, nx); b.st[0] = nloc; b.st[1] = nx; }
        const unsigned old = xb_add(&bar[XB_XSUB(b.x)], 1u);
        const unsigned gen = old / nloc;
        if (old + 1u == (gen + 1u) * nloc) {
            __builtin_amdgcn_fence(__ATOMIC_RELEASE, "agent");
            asm volatile("s_waitcnt vmcnt(0)" ::: "memory");
            const unsigned og = xb_add(&bar[XB_TOP], 1u);
            const unsigned tg = og / nx;
            if (og + 1u == (tg + 1u) * nx) xb_add(&bar[XB_TOPGEN], 1u);
            else XB_SPIN(xb_ld(&bar[XB_TOPGEN]) == tg, bar);
            __builtin_amdgcn_fence(__ATOMIC_ACQUIRE, "agent");
            xb_add(&bar[XB_XGEN(b.x)], 1u);
            asm volatile("s_waitcnt vmcnt(0)" ::: "memory");
        } else {
            XB_SPIN(xb_ld(&bar[XB_XGEN(b.x)]) == gen, bar);
            __builtin_amdgcn_fence(__ATOMIC_ACQUIRE, "agent");
            asm volatile("s_waitcnt vmcnt(0)" ::: "memory");
        }
    }
    __syncthreads();
}

constexpr int CTL_BAR = 16384;
constexpr int MK_LDS = 163840;
constexpr int MK_ST_OFF = MK_LDS - 16;
static_assert(FF_LDS <= MK_ST_OFF && RT_LDS <= MK_ST_OFF && TB_OFF + TB_BYTES <= MK_ST_OFF && TB_OFF >= pg8::STAGE_BYTES, "LDS map");
static_assert(4 * (4096 + 4096 + 8448 + 16384) <= MK_ST_OFF, "prep LDS");
#ifndef MK_REP
#define MK_REP -1
#endif
constexpr int MK_PT_OFF = MK_ST_OFF - 256;
static_assert(RT_LDS <= MK_PT_OFF && TB_OFF + TB_BYTES <= MK_PT_OFF, "LDS map (pointer table)");
DI Params ldp(const unsigned char* lds) {
    Params p; unsigned long long* d = (unsigned long long*)&p; const unsigned* t = (const unsigned*)(lds + MK_PT_OFF);
#pragma unroll
    for (int i = 0; i < 32; ++i) { const unsigned lo = __builtin_amdgcn_readfirstlane(t[2 * i]), hi = __builtin_amdgcn_readfirstlane(t[2 * i + 1]); d[i] = ((unsigned long long)hi << 32) | lo; }
    return p;
}
#define TSTAMP(i) do { if (MK_TS1 >= 0 && bid == 0 && tidx() == 0) ((unsigned long long*)(lds + MK_PT_OFF - 256))[i] = __builtin_amdgcn_s_memrealtime(); } while (0)
#define RUNPH(k, body) do { { const Params p = ldp(lds); body; } if (MK_REP == (k)) { xcd_barrier(bar); { const Params p = ldp(lds); body; } } } while (0)
__global__ void __launch_bounds__(NT, 2) mega_kernel(Params pk) {
    extern __shared__ __attribute__((aligned(16))) unsigned char lds[];
    const int bid = blockIdx.x, nb = gridDim.x;
    static_assert(sizeof(Params) == 256, "Params = 32 pointers");
    if (tidx() < 64) ((unsigned*)(lds + MK_PT_OFF))[tidx()] = ((const unsigned*)&pk)[tidx()];
    if (tidx() < 4) ((unsigned*)(lds + MK_ST_OFF))[tidx()] = 0u;
    __syncthreads();
    XcdBarrier bar;
    { const Params p = ldp(lds); bar = xcd_barrier_post((unsigned*)(p.ws + WS_CTL + CTL_BAR), (volatile LAS unsigned*)(lds + MK_ST_OFF)); }
    TSTAMP(0);
    TSTAMP(1);
    RUNPH(-2, phaseAB_prep(p, lds, bid, nb));     xcd_barrier(bar); TSTAMP(2);
    RUNPH(2, phase1b(p, lds, bid, nb));           xcd_barrier(bar); TSTAMP(3);
    RUNPH(3, phase2a_s5states(p, lds, bid, nb));  xcd_barrier(bar);
    RUNPH(13, phase2b_scan(p, bid, nb));
    RUNPH(4, phase2_fft(p, lds, bid, nb));        xcd_barrier(bar); TSTAMP(4);
    RUNPH(9, phase2c_s5out(p, lds, bid, nb));     xcd_barrier(bar); TSTAMP(5);
    RUNPH(6, phase3_fin(p, lds, bid, nb));
    RUNPH(5, phase3_glu(p, lds, bid, nb));        xcd_barrier(bar); TSTAMP(6); TSTAMP(7);
    RUNPH(7, phase4_out(p, lds, bid, nb));        xcd_barrier(bar); TSTAMP(8);
    RUNPH(-2, phase5_route(p, lds, bid, nb));     xcd_barrier(bar); TSTAMP(9);
    if (MK_REP == 8) { { const Params p = ldp(lds); phase5_route(p, lds, bid, nb, false); } xcd_barrier(bar); }
    if (MK_REP == 20) { xcd_barrier(bar); xcd_barrier(bar); xcd_barrier(bar); xcd_barrier(bar); }
    RUNPH(-2, build_tiles(p, lds));
    RUNPH(10, phase6_gateup(p, lds, bid, nb));    xcd_barrier(bar); TSTAMP(10);
    RUNPH(11, phase7_down(p, lds, bid, nb));      xcd_barrier(bar); TSTAMP(11);
    if (MK_TS1 >= 0) { if (bid == 0 && tidx() == 0) { const unsigned long long* ts = (const unsigned long long*)(lds + MK_PT_OFF - 256); const Params p = ldp(lds); unsigned* o = (unsigned*)(p.ws + WS_CTL + CTL_TS);
            o[0] = (unsigned)(ts[MK_TS1 + 1] - ts[MK_TS1]); o[1] = MK_TS2 >= 0 ? (unsigned)(ts[MK_TS2 + 1] - ts[MK_TS2]) : 0u; } xcd_barrier(bar); }
    RUNPH(-2, phase8_final(p, lds, bid, nb));
}

extern "C" void kernel_launch(void* const* d_in, const int* in_sizes, int n_in, void* d_out, int out_size, void* d_ws, size_t ws_size, hipStream_t stream) {
    static int grid = 0;
    if (grid == 0) {
        if (n_in != 30 || ws_size < WS_END || out_size != NTOK * D) { fprintf(stderr, "kernel_launch: unexpected inputs (n_in %d, ws %zu, out %d)\n", n_in, ws_size, out_size); grid = -1; return; }
        int dev = 0, cus = 0, per_cu = 0;
        if (hipGetDevice(&dev) != hipSuccess || hipDeviceGetAttribute(&cus, hipDeviceAttributeMultiprocessorCount, dev) != hipSuccess) { grid = -1; return; }
        if (hipFuncSetAttribute((const void*)mega_kernel, hipFuncAttributeMaxDynamicSharedMemorySize, MK_LDS) != hipSuccess) { fprintf(stderr, "kernel_launch: hipFuncSetAttribute failed\n"); grid = -1; return; }
        if (hipOccupancyMaxActiveBlocksPerMultiprocessor(&per_cu, (const void*)mega_kernel, NT, MK_LDS) != hipSuccess || per_cu < 1) { fprintf(stderr, "kernel_launch: occupancy query says %d blocks/CU\n", per_cu); (void)hipGetLastError(); grid = -1; return; }
        grid = cus;
    }
    if (grid < 0) return;
    Params p{};
    const float** f = (const float**)&p;
    for (int i = 0; i < 30; ++i) f[i] = (const float*)d_in[i];
    p.out = (float*)d_out; p.ws = (unsigned char*)d_ws;
    (void)hipMemsetAsync((char*)d_ws + WS_CTL, 0, CTL_BYTES, stream);
    hipLaunchKernelGGL(mega_kernel, dim3(grid), dim3(NT), MK_LDS, stream, p);
}
```

```cpp
#include <hip/hip_runtime.h>
#include <cstdio>
#include <cstdint>

typedef unsigned short bf16;
typedef short bf16x8 __attribute__((ext_vector_type(8)));
typedef short bf16x4 __attribute__((ext_vector_type(4)));
typedef float f32x4 __attribute__((ext_vector_type(4)));
typedef unsigned u32x4 __attribute__((ext_vector_type(4)));
typedef unsigned u32x2 __attribute__((ext_vector_type(2)));
typedef __bf16 bf16v2 __attribute__((ext_vector_type(2)));
#define DI __device__ __forceinline__

constexpr int D = 1024, NB = 8, L = 4096, CTX = 256, NTOK = NB * L, NCTX = NB * CTX, NROWS1 = NTOK + NCTX;
constexpr int NEXP = 32, DE = 256;
constexpr float EPS = 1e-6f;
constexpr int NT = 512;

constexpr size_t MiB = 1u << 20;
constexpr size_t WS_CTL = 0;
constexpr size_t CTL_BYTES = 1 * MiB;
constexpr size_t CTL_ZERO = 4096;
#ifndef MK_TS1
#define MK_TS1 -1
#endif
#ifndef MK_TS2
#define MK_TS2 -1
#endif
constexpr size_t CTL_TS = 12288;
constexpr size_t CTL_FLAGA = 12800;
constexpr size_t CTL_WQ = 12544;
constexpr size_t CTL_ECNT = 8192;
constexpr size_t CTL_PCNT = 8192 + 256;
constexpr size_t CTL_RSQ1 = 256 * 1024;
constexpr size_t CTL_RSQ2 = 384 * 1024;
constexpr size_t WS_MOD = 1 * MiB;
constexpr size_t WS_TILES = WS_MOD + 256 * 1024;
constexpr size_t WS_ABART = WS_TILES + 64 * 1024;
constexpr size_t WS_FFTC = 2 * MiB;
constexpr size_t WS_GW = 3 * MiB;
constexpr size_t WS_WINT = 4 * MiB;
constexpr size_t WS_WGLUT = 7 * MiB;
constexpr size_t WS_WOUTT = 8 * MiB;
constexpr size_t WS_WGUT = 10 * MiB;
constexpr size_t WS_WDT = 42 * MiB;
constexpr size_t WS_WST = 58 * MiB;
constexpr size_t WS_MGW = 66 * MiB;
constexpr size_t WS_ELIST = 90 * MiB;
constexpr size_t WS_ELCP = 94 * MiB;
constexpr size_t WS_ELW = 98 * MiB;
constexpr size_t WS_TCP = 102 * MiB;
constexpr size_t WS_R1 = 108 * MiB;
constexpr size_t WS_R2 = 176 * MiB;
constexpr size_t WS_R3 = 240 * MiB;
constexpr size_t WS_UCTX = 288 * MiB;
constexpr size_t WS_R4 = 290 * MiB;
constexpr size_t WS_R5 = 322 * MiB;
constexpr size_t WS_X1B = 290 * MiB;
constexpr size_t WS_A2 = 108 * MiB;
constexpr size_t WS_HS = 228 * MiB;
constexpr size_t WS_MOE = 108 * MiB;
constexpr size_t WS_RSQP1 = 354 * MiB;
constexpr size_t WS_RSQS = 356 * MiB;
constexpr size_t WS_RSS = 357 * MiB;
constexpr size_t WS_ETAB = 357 * MiB + 512 * 1024;
constexpr size_t WS_WRT = 358 * MiB;
constexpr size_t WS_END = 359 * MiB;

struct Params {
    const float *x, *c, *ctx, *c_ctx, *w_ada, *b_ada, *norm1_g, *norm2_g, *w_in;
    const float *lam_re, *lam_im, *b_re, *b_im, *c_re, *c_im, *log_step, *s5_d, *w_glu, *fourier_w, *g_s, *g_f, *w_out;
    const float *w_group, *b_group, *w_router, *b_router, *w_gate, *w_up, *w_down, *final_g;
    float* out; unsigned char* ws;
};

DI int tidx() { int t = threadIdx.x; asm volatile("" : "+v"(t)); return t; }
DI unsigned pk2(float lo, float hi) { bf16v2 v; v.x = (__bf16)lo; v.y = (__bf16)hi; return __builtin_bit_cast(unsigned, v); }
DI float bf2f(unsigned short b) { return __uint_as_float(((unsigned)b) << 16); }
DI float wave_sum(float v) {
#pragma unroll
    for (int o = 1; o < 64; o <<= 1) v += __shfl_xor(v, o);
    return v;
}
DI float sigmoidf_(float x) { return 1.f / (1.f + __expf(-x)); }
DI float siluf_(float x) { return x / (1.f + __expf(-x)); }
DI float geluf_(float x) { const float u = 0.7978845608028654f * (x + 0.044715f * x * x * x); return x / (1.f + __expf(-2.f * u)); }

template <int MT> struct GC {
    static constexpr int BM = 64 * MT, PA = MT, ABYTES = BM * 128, BBYTES = 128 * 128, BUF = ABYTES + BBYTES, LDS = 2 * BUF;
};
template <int MT>
DI void gemm_loop(f32x4 (&acc)[MT][4], const bf16* (&ap)[MT], const int (&as)[MT], const bf16* (&bp)[2], int nk, unsigned char* lds) {
    typedef GC<MT> G;
    const int tid = tidx(), lane = tid & 63, wid = tid >> 6, wm = wid >> 1, wn = wid & 1, fr = lane & 15, fq = lane >> 4;
    const int srow = tid >> 3, sck = tid & 7;
    const int soff = srow * 128 + ((sck ^ (srow & 7)) << 4);
    u32x4 ra[MT], rb[2];
#pragma unroll
    for (int i = 0; i < MT; ++i) ra[i] = *(const u32x4*)(ap[i]);
#pragma unroll
    for (int i = 0; i < 2; ++i) rb[i] = *(const u32x4*)(bp[i]);
#pragma unroll
    for (int i = 0; i < MT; ++i) *(u32x4*)(lds + i * 8192 + soff) = ra[i];
#pragma unroll
    for (int i = 0; i < 2; ++i) *(u32x4*)(lds + G::ABYTES + i * 8192 + soff) = rb[i];
    __syncthreads();
    const int aro = (wm * MT * 16 + fr) * 128, bro = (wn * 64 + fr) * 128;
    const int sw0 = ((0 + fq) ^ (fr & 7)) << 4, sw1 = ((4 + fq) ^ (fr & 7)) << 4;
    for (int kt = 0; kt < nk; ++kt) {
        const bool more = kt + 1 < nk;
        if (more) {
#pragma unroll
            for (int i = 0; i < MT; ++i) ra[i] = *(const u32x4*)(ap[i] + (size_t)(kt + 1) * as[i]);
#pragma unroll
            for (int i = 0; i < 2; ++i) rb[i] = *(const u32x4*)(bp[i] + (size_t)(kt + 1) * 64);
        }
        const unsigned char* Ab = lds + (kt & 1) * G::BUF; const unsigned char* Bb = Ab + G::ABYTES;
#pragma unroll
        for (int kk = 0; kk < 2; ++kk) {
            const int sw = kk ? sw1 : sw0;
            bf16x8 af[MT], bfr[4];
#pragma unroll
            for (int mt = 0; mt < MT; ++mt) af[mt] = *(const bf16x8*)(Ab + aro + mt * 2048 + sw);
#pragma unroll
            for (int nt = 0; nt < 4; ++nt) bfr[nt] = *(const bf16x8*)(Bb + bro + nt * 2048 + sw);
#pragma unroll
            for (int mt = 0; mt < MT; ++mt)
#pragma unroll
                for (int nt = 0; nt < 4; ++nt) acc[mt][nt] = __builtin_amdgcn_mfma_f32_16x16x32_bf16(bfr[nt], af[mt], acc[mt][nt], 0, 0, 0);
        }
        if (more) {
            unsigned char* nb = lds + ((kt + 1) & 1) * G::BUF;
#pragma unroll
            for (int i = 0; i < MT; ++i) *(u32x4*)(nb + i * 8192 + soff) = ra[i];
#pragma unroll
            for (int i = 0; i < 2; ++i) *(u32x4*)(nb + G::ABYTES + i * 8192 + soff) = rb[i];
        }
        __syncthreads();
    }
}
template <int MT>
DI void gemm_loop_alds(f32x4 (&acc)[MT][4], const unsigned char* abase, int apitch, const bf16* (&bp)[2], int nk, unsigned char* lds) {
    typedef GC<MT> G;
    const int tid = tidx(), lane = tid & 63, wid = tid >> 6, wm = wid >> 1, wn = wid & 1, fr = lane & 15, fq = lane >> 4;
    const int srow = tid >> 3, sck = tid & 7;
    const int soff = srow * 128 + ((sck ^ (srow & 7)) << 4);
    u32x4 rb[2];
#pragma unroll
    for (int i = 0; i < 2; ++i) rb[i] = *(const u32x4*)(bp[i]);
#pragma unroll
    for (int i = 0; i < 2; ++i) *(u32x4*)(lds + G::ABYTES + i * 8192 + soff) = rb[i];
    __syncthreads();
    const int bro = (wn * 64 + fr) * 128;
    const int sw0 = ((0 + fq) ^ (fr & 7)) << 4, sw1 = ((4 + fq) ^ (fr & 7)) << 4;
    const unsigned char* arow = abase + (size_t)(wm * MT * 16 + fr) * apitch + fq * 16;
    for (int kt = 0; kt < nk; ++kt) {
        const bool more = kt + 1 < nk;
        if (more) {
#pragma unroll
            for (int i = 0; i < 2; ++i) rb[i] = *(const u32x4*)(bp[i] + (size_t)(kt + 1) * 64);
        }
        const unsigned char* Bb = lds + (kt & 1) * G::BUF + G::ABYTES;
#pragma unroll
        for (int kk = 0; kk < 2; ++kk) {
            const int sw = kk ? sw1 : sw0;
            bf16x8 af[MT], bfr[4];
#pragma unroll
            for (int mt = 0; mt < MT; ++mt) af[mt] = *(const bf16x8*)(arow + (size_t)mt * 16 * apitch + kt * 128 + kk * 64);
#pragma unroll
            for (int nt = 0; nt < 4; ++nt) bfr[nt] = *(const bf16x8*)(Bb + bro + nt * 2048 + sw);
#pragma unroll
            for (int mt = 0; mt < MT; ++mt)
#pragma unroll
                for (int nt = 0; nt < 4; ++nt) acc[mt][nt] = __builtin_amdgcn_mfma_f32_16x16x32_bf16(bfr[nt], af[mt], acc[mt][nt], 0, 0, 0);
        }
        if (more) {
            unsigned char* nb = lds + ((kt + 1) & 1) * G::BUF;
#pragma unroll
            for (int i = 0; i < 2; ++i) *(u32x4*)(nb + G::ABYTES + i * 8192 + soff) = rb[i];
        }
        __syncthreads();
    }
}
template <int MT> DI void zero_acc(f32x4 (&acc)[MT][4]) {
#pragma unroll
    for (int m = 0; m < MT; ++m)
#pragma unroll
        for (int n = 0; n < 4; ++n) acc[m][n] = (f32x4){0.f, 0.f, 0.f, 0.f};
}

namespace pg8 {
#define PG8_LAS __attribute__((address_space(3)))
constexpr int BM = 256, BK = 64, HALF = 128, HTB = HALF * BK * 2, STAGE_BYTES = 8 * HTB;
DI int lds_byte(int r, int c) { const int st = (r >> 4) * 2 + (c >> 5), rr = r & 15, cc = c & 31, ob = rr * 64 + cc * 2; return st * 1024 + (ob ^ (((ob >> 9) & 1) << 5)); }
DI int perm32(int rho) { const int n = rho >> 4, i = rho & 15; return 8 * (i >> 2) + 4 * n + (i & 3); }
DI void stage_rc(int b, int& R, int& C) { const int st = b / 1024, sb = b % 1024, swz = sb ^ (((sb >> 9) & 1) << 5); R = (st >> 1) * 16 + swz / 64; C = (st & 1) * 32 + (swz % 64) / 2; }
struct UPtr { const char *a0, *a1, *b0, *b1, *c0, *c1; };
template <class Pol, class Epi, bool ALIGN_EPI>
DI void gemm_phase(PG8_LAS unsigned char* lds, const Pol& P, const Epi& E) {
    typedef typename Pol::Unit Unit;
    const int tid = tidx(), wid = __builtin_amdgcn_readfirstlane(tid >> 6), lane = tid & 63, wr = wid >> 2, wc = wid & 3, fr = lane & 15, fq = lane >> 4;
    const int nt = P.K / BK, ksplit = P.ksplit;
    int Rr[2], Cc[2]; unsigned voffB[2];
#pragma unroll
    for (int i = 0; i < 2; ++i) { stage_rc(tid * 16 + i * 8192, Rr[i], Cc[i]); voffB[i] = (unsigned)(P.brow((Rr[i] & ~31) + perm32(Rr[i] & 31)) * P.ldb + Cc[i]) * 2u; }
    unsigned c00 = P.aoff(Rr[0], Cc[0]), c01 = P.aoff(Rr[1], Cc[1]), c10 = c00, c11 = c01, n00 = c00, n01 = c01, n10 = c00, n11 = c01;
#define PG8_STAGE2(bufoff, gbase, o0, o1) do { \
        __builtin_amdgcn_global_load_lds((const unsigned*)((const char*)(gbase) + (o0)), (PG8_LAS unsigned*)(lds + (bufoff) + ldsw), 16, 0, 0); \
        __builtin_amdgcn_global_load_lds((const unsigned*)((const char*)(gbase) + (o1)), (PG8_LAS unsigned*)(lds + (bufoff) + ldsw + 8192), 16, 0, 0); } while (0)
    const size_t kstep = (size_t)(BK * 2);
    const size_t kstepA = Pol::KSTEP_A ? (size_t)Pol::KSTEP_A : kstep;
    const unsigned ldsw = (unsigned)wid * 1024u;
    const int aoff = lds_byte(wr * 64 + fr, fq * 8), boff = lds_byte(wc * 32 + fr, fq * 8);
#define PG8_SA(b, h) (((b) * 2 + (h)) * HTB)
#define PG8_SB(b, h) ((4 + (b) * 2 + (h)) * HTB)
#define PG8_STAGE(bufoff, gbase, voff) do { _Pragma("unroll") for (int _i = 0; _i < 2; ++_i) \
        __builtin_amdgcn_global_load_lds((const unsigned*)((const char*)(gbase) + (voff)[_i]), (PG8_LAS unsigned*)(lds + (bufoff) + ldsw + _i * 8192), 16, 0, 0); } while (0)
#define PG8_LDA(dst, b, h) do { _Pragma("unroll") for (int m = 0; m < 4; ++m) _Pragma("unroll") for (int k = 0; k < 2; ++k) dst[m][k] = *(const PG8_LAS bf16x8*)(lds + PG8_SA(b, h) + aoff + m * 2048 + k * 1024); } while (0)
#define PG8_LDB(dst, b, h) do { _Pragma("unroll") for (int n = 0; n < 2; ++n) _Pragma("unroll") for (int k = 0; k < 2; ++k) dst[n][k] = *(const PG8_LAS bf16x8*)(lds + PG8_SB(b, h) + boff + n * 2048 + k * 1024); } while (0)
#define PG8_MMA(ai, bj, At, Bt) do { __builtin_amdgcn_s_setprio(1); _Pragma("unroll") for (int m = 0; m < 4; ++m) _Pragma("unroll") for (int n = 0; n < 2; ++n) _Pragma("unroll") for (int k = 0; k < 2; ++k) \
        acc[ai][bj][m][n] = __builtin_amdgcn_mfma_f32_16x16x32_bf16(Bt[n][k], At[m][k], acc[ai][bj][m][n], 0, 0, 0); __builtin_amdgcn_s_setprio(0); } while (0)
#define PG8_WAIT_V(n) asm volatile("s_waitcnt vmcnt(" #n ")" ::: "memory")
#define PG8_WAIT_L(n) asm volatile("s_waitcnt lgkmcnt(" #n ")" ::: "memory")
#define PG8_BAR __builtin_amdgcn_s_barrier()
#define PG8_SCHED __builtin_amdgcn_sched_barrier(0)
#define PG8_BSEL(q, tk, h) ((tk) < ksplit ? (q).b##h + (size_t)(tk) * kstep : (q).c##h + (size_t)((tk) - ksplit) * kstep)
    Unit cur, nxt; UPtr cp, np_; int ui = 0;
    if (!P.next(0, cur)) return;
    P.ptrs(cur, cp);
    if constexpr (Pol::GATHER) P.gather(cur, Rr, Cc, c00, c01, c10, c11);
    f32x4 acc[2][2][4][2];
#pragma unroll
    for (int a = 0; a < 2; ++a)
#pragma unroll
        for (int b = 0; b < 2; ++b)
#pragma unroll
            for (int m = 0; m < 4; ++m)
#pragma unroll
                for (int n = 0; n < 2; ++n) acc[a][b][m][n] = (f32x4){0.f, 0.f, 0.f, 0.f};
    bf16x8 At[4][2], B0[2][2], B1[2][2];
    PG8_STAGE(PG8_SB(0, 0), cp.b0, voffB); PG8_STAGE(PG8_SB(0, 1), cp.b1, voffB); PG8_STAGE2(PG8_SA(0, 0), cp.a0, c00, c01); PG8_STAGE2(PG8_SA(0, 1), cp.a1, c10, c11);
    if (wr == 1) PG8_BAR;
    PG8_WAIT_V(2); PG8_BAR;
    PG8_STAGE(PG8_SB(1, 0), cp.b0 + kstep, voffB); PG8_STAGE2(PG8_SA(1, 0), cp.a0 + kstepA, c00, c01); PG8_STAGE(PG8_SB(1, 1), cp.b1 + kstep, voffB);
    PG8_WAIT_V(6); PG8_BAR;
    for (;;) {
        const bool has_next = P.next(ui + 1, nxt);
        if (has_next) { P.ptrs(nxt, np_); if constexpr (Pol::GATHER) P.gather(nxt, Rr, Cc, n00, n01, n10, n11); }
        else { np_ = cp; if constexpr (Pol::GATHER) { n00 = c00; n01 = c01; n10 = c10; n11 = c11; } }
#pragma unroll 1
        for (int t = 0; t < nt; t += 2) {
            const bool last = (t == nt - 2);
            int hf = __builtin_amdgcn_readfirstlane(P.half(cur) ? 1 : 0); asm volatile("" : "+s"(hf));
            if constexpr (Epi::MIDK_T >= 0) { if (t == Epi::MIDK_T) E.midk(acc, cur, wr, wc, fr, fq); }
            const char* a1_1 = cp.a1 + (size_t)(t + 1) * kstepA;
            const char *a2_0, *a2_1, *a3_0, *b2_0, *b2_1, *b3_0, *b3_1;
            if (!last) { a2_0 = cp.a0 + (size_t)(t + 2) * kstepA; a2_1 = cp.a1 + (size_t)(t + 2) * kstepA; a3_0 = cp.a0 + (size_t)(t + 3) * kstepA;
                         b2_0 = PG8_BSEL(cp, t + 2, 0); b2_1 = PG8_BSEL(cp, t + 2, 1); b3_0 = PG8_BSEL(cp, t + 3, 0); b3_1 = PG8_BSEL(cp, t + 3, 1); }
            else { a2_0 = np_.a0; a2_1 = np_.a1; a3_0 = np_.a0 + kstepA; b2_0 = np_.b0; b2_1 = np_.b1; b3_0 = np_.b0 + kstep; b3_1 = np_.b1 + kstep; }
            const unsigned s00 = (Pol::GATHER && last) ? n00 : c00, s01 = (Pol::GATHER && last) ? n01 : c01, s10 = (Pol::GATHER && last) ? n10 : c10, s11 = (Pol::GATHER && last) ? n11 : c11;
            PG8_LDB(B0, 0, 0); PG8_LDB(B1, 0, 1); PG8_SCHED; PG8_LDA(At, 0, 0); PG8_STAGE2(PG8_SA(1, 1), a1_1, c10, c11);
            PG8_WAIT_V(8); PG8_WAIT_L(0); PG8_BAR; PG8_MMA(0, 0, At, B0); PG8_MMA(0, 1, At, B1); PG8_BAR; PG8_SCHED;
            if (!hf) PG8_LDA(At, 0, 1); PG8_STAGE(PG8_SB(0, 0), b2_0, voffB); PG8_STAGE(PG8_SB(0, 1), b2_1, voffB); PG8_STAGE2(PG8_SA(0, 0), a2_0, s00, s01);
            PG8_WAIT_V(8); PG8_WAIT_L(0); PG8_BAR; if (!hf) { PG8_MMA(1, 0, At, B0); PG8_MMA(1, 1, At, B1); } PG8_BAR; PG8_SCHED;
            PG8_LDB(B0, 1, 0); PG8_LDB(B1, 1, 1); PG8_SCHED; PG8_LDA(At, 1, 0); PG8_STAGE2(PG8_SA(0, 1), a2_1, s10, s11);
            PG8_WAIT_V(8); PG8_WAIT_L(0); PG8_BAR; PG8_MMA(0, 0, At, B0); PG8_MMA(0, 1, At, B1); PG8_BAR; PG8_SCHED;
            if (!hf) PG8_LDA(At, 1, 1); PG8_STAGE(PG8_SB(1, 0), b3_0, voffB); PG8_STAGE(PG8_SB(1, 1), b3_1, voffB); PG8_STAGE2(PG8_SA(1, 0), a3_0, s00, s01);
            PG8_WAIT_V(8); PG8_WAIT_L(0); PG8_BAR; if (!hf) { PG8_MMA(1, 0, At, B0); PG8_MMA(1, 1, At, B1); } PG8_BAR; PG8_SCHED;
        }
        if constexpr (ALIGN_EPI) { if (wr == 0) PG8_BAR; }
        E(acc, cur, wr, wc, fr, fq);
        if (!has_next) break;
#pragma unroll
        for (int a = 0; a < 2; ++a)
#pragma unroll
            for (int b = 0; b < 2; ++b)
#pragma unroll
                for (int m = 0; m < 4; ++m)
#pragma unroll
                    for (int n = 0; n < 2; ++n) acc[a][b][m][n] = (f32x4){0.f, 0.f, 0.f, 0.f};
        cur = nxt; cp = np_; ++ui;
        if constexpr (Pol::GATHER) { c00 = n00; c01 = n01; c10 = n10; c11 = n11; }
        if constexpr (ALIGN_EPI) { if (wr == 1) PG8_BAR; }
    }
    PG8_WAIT_V(0);
    if constexpr (!ALIGN_EPI) { if (wr == 0) PG8_BAR; }
    PG8_BAR;
#undef PG8_SA
#undef PG8_SB
#undef PG8_STAGE
#undef PG8_STAGE2
#undef PG8_LDA
#undef PG8_LDB
#undef PG8_MMA
#undef PG8_WAIT_V
#undef PG8_WAIT_L
#undef PG8_BAR
#undef PG8_SCHED
#undef PG8_BSEL
}
struct DenseOrder {
    int nM, nN, nwg, G, c;
    DI void init(int nM_, int nN_, int G_, int c_) { nM = nM_; nN = nN_; nwg = nM * nN; G = G_; c = c_; }
    DI bool get(int i, int& pm, int& pn) const {
        const long L = (long)i * G + c; if (L >= nwg) return false;
        int wgid = (int)L; { const int q = nwg / 8, r = nwg % 8, xcd = wgid % 8, off = wgid / 8; wgid = (xcd < r ? xcd * (q + 1) : r * (q + 1) + (xcd - r) * q) + off; }
        const int nig = 8 * nN, gid = wgid / nig, fm = gid * 8, gsz = (nM - fm) < 8 ? (nM - fm) : 8;
        pm = fm + ((wgid % nig) % gsz); pn = (wgid % nig) / gsz; return true;
    }
};
}

DI void adaln_item(const Params& p, unsigned char* lds, int item) {
    float* scond = (float*)lds;
    float* red = scond + 9 * 1024;
    const int tid = tidx();
    for (int i = tid; i < 9 * 1024; i += NT) { const int r = i >> 10, k = i & 1023; const float v = r < 8 ? p.c[r * 1024 + k] : p.c_ctx[k]; scond[i] = v / (1.f + __expf(-v)); }
    __syncthreads();
    const int cc = tid & 31, ks = tid >> 5, col = item * 32 + cc;
    float a[9];
#pragma unroll
    for (int r = 0; r < 9; ++r) a[r] = 0.f;
#pragma unroll 1
    for (int kb = 0; kb < 4; ++kb) {
        const int kbase = ks * 64 + kb * 16; float w[16];
#pragma unroll
        for (int u = 0; u < 16; ++u) w[u] = p.w_ada[(size_t)(kbase + u) * 6144 + col];
#pragma unroll
        for (int u = 0; u < 16; ++u)
#pragma unroll
            for (int r = 0; r < 9; ++r) a[r] += scond[r * 1024 + kbase + u] * w[u];
    }
#pragma unroll
    for (int r = 0; r < 9; ++r) red[(ks * 9 + r) * 32 + cc] = a[r];
    __syncthreads();
    float* mod = (float*)(p.ws + WS_MOD);
    for (int o = tid; o < 9 * 32; o += NT) { const int r = o >> 5, c2 = o & 31; float s = 0.f;
#pragma unroll
        for (int q = 0; q < 16; ++q) s += red[(q * 9 + r) * 32 + c2];
        mod[r * 6144 + item * 32 + c2] = s + p.b_ada[item * 32 + c2]; }
    __syncthreads();
}
DI void tp_tile(const float* src, int ld, int k0, int n0, unsigned char* lds, bf16* dst, int jobkind, int e, const float* kscale = nullptr) {
    const int lane = tidx() & 63, q = lane >> 4, c = lane & 15;
    f32x4 v[16];
#pragma unroll
    for (int i = 0; i < 16; ++i) v[i] = *(const f32x4*)(src + (size_t)(k0 + 16 * q + i) * ld + n0 + 4 * c);
    if (kscale) {
#pragma unroll
        for (int i = 0; i < 16; ++i) v[i] = v[i] * kscale[k0 + 16 * q + i]; }
#pragma unroll
    for (int j = 0; j < 4; ++j) { const int ng = n0 + 4 * c + j;
        u32x4 o0, o1;
        o0.x = pk2(v[0][j], v[1][j]); o0.y = pk2(v[2][j], v[3][j]); o0.z = pk2(v[4][j], v[5][j]); o0.w = pk2(v[6][j], v[7][j]);
        o1.x = pk2(v[8][j], v[9][j]); o1.y = pk2(v[10][j], v[11][j]); o1.z = pk2(v[12][j], v[13][j]); o1.w = pk2(v[14][j], v[15][j]);
        size_t drow; int K;
        switch (jobkind) {
          case 0: drow = ng; K = 1024; break;
          case 1: drow = ng; K = 512; break;
          case 2: drow = ng; K = 1024; break;
          case 3: case 4: { const int h = ng, R = (h >> 7) * 256 + (jobkind == 4 ? 128 : 0) + (h & 127); drow = (size_t)e * 512 + R; K = 1024; } break;
          default: drow = (size_t)e * 1024 + ng; K = 256; break;
        }
        bf16* d = dst + drow * K + k0 + 16 * q;
        *(u32x4*)d = o0; *(u32x4*)(d + 8) = o1; }
}
constexpr int TP_J0 = 16 * 8, TP_J1 = 8 * 8, TP_J2 = 16 * 16, TP_J3 = 32 * 16 * 4, TP_J4 = TP_J3, TP_J5 = 32 * 4 * 16;
constexpr int TP_ITEMS = TP_J0 + TP_J1 + TP_J2 + TP_J3 + TP_J4 + TP_J5;
DI void tp_item(const Params& p, unsigned char* lds, int it) {
    unsigned char* ws = p.ws;
    if (it < TP_J0) { tp_tile(p.w_in, 1024, (it >> 3) * 64, (it & 7) * 64, lds, (bf16*)(ws + WS_WINT), 0, 0); return; } it -= TP_J0;
    if (it < TP_J1) { tp_tile(p.w_glu, 512, (it >> 3) * 64, (it & 7) * 64, lds, (bf16*)(ws + WS_WGLUT), 1, 0); return; } it -= TP_J1;
    if (it < TP_J2) { tp_tile(p.w_out, 1024, (it >> 4) * 64, (it & 15) * 64, lds, (bf16*)(ws + WS_WOUTT), 2, 0, (it >> 4) * 64 < 512 ? p.g_s : nullptr); return; } it -= TP_J2;
    if (it < TP_J3) { const int e = it >> 6, r = it & 63; tp_tile(p.w_gate + (size_t)e * 1024 * 256, 256, (r >> 2) * 64, (r & 3) * 64, lds, (bf16*)(ws + WS_WGUT), 3, e); return; } it -= TP_J3;
    if (it < TP_J4) { const int e = it >> 6, r = it & 63; tp_tile(p.w_up + (size_t)e * 1024 * 256, 256, (r >> 2) * 64, (r & 3) * 64, lds, (bf16*)(ws + WS_WGUT), 4, e); return; } it -= TP_J4;
    { const int e = it >> 6, r = it & 63; tp_tile(p.w_down + (size_t)e * 256 * 1024, 1024, (r >> 4) * 64, (r & 15) * 64, lds, (bf16*)(ws + WS_WDT), 5, e); }
}
DI void gfold_item(const Params& p, unsigned char* lds, int item) {
    const int q = item >> 6, k0 = (item & 63) * 16, tid = tidx(), lane = tid & 63, wid = tid >> 6, fr = lane & 15, fq = lane >> 4;
    const bf16* E = (const bf16*)(p.ws + WS_ETAB); const bf16* fwT = E + 256 * 128 + (size_t)q * 128 * 128;
    bf16* Tl = (bf16*)lds;
    bf16x8 af[4];
#pragma unroll
    for (int ks = 0; ks < 4; ++ks) { const float* wp = p.w_in + (size_t)(k0 + fr) * 1024 + 512 + 128 * q + ks * 32 + 8 * fq; const f32x4 w0 = *(const f32x4*)wp, w1 = *(const f32x4*)(wp + 4);
        u32x4 t; t.x = pk2(w0.x, w0.y); t.y = pk2(w0.z, w0.w); t.z = pk2(w1.x, w1.y); t.w = pk2(w1.z, w1.w); af[ks] = __builtin_bit_cast(bf16x8, t); }
#pragma unroll
    for (int t2 = 0; t2 < 2; ++t2) { const int nt = wid * 2 + t2, c = nt >> 3; f32x4 d = (f32x4){0.f, 0.f, 0.f, 0.f};
#pragma unroll
        for (int ks = 0; ks < 4; ++ks) { const bf16x8 bfr = *(const bf16x8*)(E + (size_t)(nt * 16 + fr) * 128 + ks * 32 + 8 * fq); d = __builtin_amdgcn_mfma_f32_16x16x32_bf16(af[ks], bfr, d, 0, 0, 0); }
#pragma unroll
        for (int r = 0; r < 4; ++r) Tl[(c * 16 + 4 * fq + r) * 136 + (nt & 7) * 16 + fr] = (bf16)(pk2(d[r], 0.f) & 0xffffu); }
    __syncthreads();
    bf16* WinT = (bf16*)(p.ws + WS_WINT);
    const float scale = 1.0f / 724.0773439350247f;
    { const int c = wid >> 2;
      bf16x8 a2[4];
#pragma unroll
      for (int ks = 0; ks < 4; ++ks) a2[ks] = *(const bf16x8*)(Tl + (c * 16 + fr) * 136 + ks * 32 + 8 * fq);
#pragma unroll
      for (int t2 = 0; t2 < 2; ++t2) { const int jt = (wid & 3) * 2 + t2; f32x4 d = (f32x4){0.f, 0.f, 0.f, 0.f};
#pragma unroll
          for (int ks = 0; ks < 4; ++ks) { const bf16x8 bfr = *(const bf16x8*)(fwT + (size_t)(jt * 16 + fr) * 128 + ks * 32 + 8 * fq); d = __builtin_amdgcn_mfma_f32_16x16x32_bf16(bfr, a2[ks], d, 0, 0, 0); }
#pragma unroll
          for (int r = 0; r < 4; ++r) WinT[(size_t)(512 + c * 512 + q * 128 + jt * 16 + 4 * fq + r) * 1024 + k0 + fr] = (bf16)(pk2(d[r] * scale, 0.f) & 0xffffu); } }
    __syncthreads();
}
DI void s5mats_item(const Params& p, unsigned char* lds, int item) {
    const int g = item >> 3, part = item & 7;
    const int tid = tidx();
    float* Bb = (float*)lds;
    float* Cc = Bb + 4096;
    float* pw = Cc + 4096;
    float* Kt = pw + 8448;
    float* qv = Kt;
    if (tid < 128) { const int d = tid >> 6, pp = tid & 63;
        const double dt = exp((double)p.log_step[d * 32 + g]); const double lr = p.lam_re[(d * 32 + g) * 64 + pp], li = p.lam_im[(d * 32 + g) * 64 + pp];
        const double mag = exp(lr * dt); double tt = li * dt / 3.14159265358979323846; tt -= 2.0 * floor(tt * 0.5);
        double sn, cs; sincospi(tt, &sn, &cs); const double ar = mag * cs, ai = mag * sn;
        const double nr = ar - 1.0, ni = ai, den = lr * lr + li * li;
        qv[tid * 2] = (float)((nr * lr + ni * li) / den); qv[tid * 2 + 1] = (float)((ni * lr - nr * li) / den);
        double pr = 1.0, pi = 0.0;
        for (int k = 0; k < 33; ++k) { pw[(tid * 33 + k) * 2] = (float)pr; pw[(tid * 33 + k) * 2 + 1] = (float)pi; const double t2 = pr * ar - pi * ai; pi = pr * ai + pi * ar; pr = t2; } }
    __syncthreads();
    for (int idx = tid; idx < 2 * 64 * 16; idx += NT) { const int dp = idx >> 4, h = idx & 15; const float qr = qv[dp * 2], qi = qv[dp * 2 + 1];
        const int d = dp >> 6, pp = dp & 63;
        const float br = p.b_re[((size_t)(d * 32 + g) * 64 + pp) * 16 + h], bi = p.b_im[((size_t)(d * 32 + g) * 64 + pp) * 16 + h];
        Bb[idx * 2] = qr * br - qi * bi; Bb[idx * 2 + 1] = qr * bi + qi * br; }
    for (int idx = tid; idx < 2 * 16 * 64; idx += NT) { const int d = idx >> 10, i = (idx >> 6) & 15, pp = idx & 63;
        Cc[idx * 2] = p.c_re[((size_t)(d * 32 + g) * 16 + i) * 64 + pp]; Cc[idx * 2 + 1] = p.c_im[((size_t)(d * 32 + g) * 16 + i) * 64 + pp]; }
    __syncthreads();
    { const int t3 = tid >> 2, pq = tid & 3, d = t3 >> 6, k = (t3 >> 1) & 31, i = part * 2 + (t3 & 1);
      float acc[16];
#pragma unroll
      for (int h = 0; h < 16; ++h) acc[h] = 0.f;
      for (int pp = pq * 16; pp < pq * 16 + 16; ++pp) {
          const float cr = Cc[((d * 16 + i) * 64 + pp) * 2], ci = Cc[((d * 16 + i) * 64 + pp) * 2 + 1];
          const float wr = pw[((d * 64 + pp) * 33 + k) * 2], wi = pw[((d * 64 + pp) * 33 + k) * 2 + 1];
          const float xr = cr * wr - ci * wi, xi = cr * wi + ci * wr;
          const f32x4* bb = (const f32x4*)(Bb + (d * 64 + pp) * 32);
#pragma unroll
          for (int h2 = 0; h2 < 8; ++h2) { const f32x4 b2 = bb[h2]; acc[2 * h2] += xr * b2.x - xi * b2.y; acc[2 * h2 + 1] += xr * b2.z - xi * b2.w; } }
#pragma unroll
      for (int h = 0; h < 16; ++h) { acc[h] += __shfl_xor(acc[h], 1); acc[h] += __shfl_xor(acc[h], 2); }
      if (pq == 0) {
#pragma unroll
          for (int h4 = 0; h4 < 4; ++h4) *(f32x4*)(Kt + ((d * 32 + k) * 16 + i) * 16 + h4 * 4) = (f32x4){acc[h4 * 4], acc[h4 * 4 + 1], acc[h4 * 4 + 2], acc[h4 * 4 + 3]}; } }
    __syncthreads();
    bf16* Mg = (bf16*)(p.ws + WS_MGW) + (size_t)g * 512 * 768;
    for (int c4 = tid; c4 < 64 * 64; c4 += NT) { const int rq = c4 >> 6, c8 = c4 & 63, j = rq >> 1, i = part * 2 + (rq & 1), row = j * 16 + i, s = c8 >> 1, h0 = (c8 & 1) * 8; float v[8];
#pragma unroll
        for (int t = 0; t < 8; ++t) { float a = 0.f; if (s <= j) a += Kt[((0 * 32 + (j - s)) * 16 + i) * 16 + h0 + t]; if (s >= j) a += Kt[((1 * 32 + (s - j)) * 16 + i) * 16 + h0 + t]; v[t] = a; }
        u32x4 o; o.x = pk2(v[0], v[1]); o.y = pk2(v[2], v[3]); o.z = pk2(v[4], v[5]); o.w = pk2(v[6], v[7]);
        *(u32x4*)(Mg + (size_t)row * 768 + c8 * 8) = o; }
    bf16* Wst = (bf16*)(p.ws + WS_WST) + (size_t)g * 256 * 512;
    for (int c4 = tid; c4 < 32 * 64; c4 += NT) { const int r = part * 32 + (c4 >> 6), c8 = c4 & 63, s = c8 >> 1, h0 = (c8 & 1) * 8, d = r >> 7, c = r & 1, pp = (r >> 1) & 63;
        const int e = d == 0 ? 31 - s : s; const float wr = pw[((d * 64 + pp) * 33 + e) * 2], wi = pw[((d * 64 + pp) * 33 + e) * 2 + 1]; float v[8];
#pragma unroll
        for (int t = 0; t < 8; ++t) { const float br = Bb[((d * 64 + pp) * 16 + h0 + t) * 2], bi = Bb[((d * 64 + pp) * 16 + h0 + t) * 2 + 1]; v[t] = c == 0 ? wr * br - wi * bi : wr * bi + wi * br; }
        u32x4 o; o.x = pk2(v[0], v[1]); o.y = pk2(v[2], v[3]); o.z = pk2(v[4], v[5]); o.w = pk2(v[6], v[7]);
        *(u32x4*)(Wst + (size_t)r * 512 + c8 * 8) = o; }
    bf16* Wos = (bf16*)(p.ws + WS_MGW) + (size_t)g * 512 * 768 + 512;
    for (int c4 = tid; c4 < 64 * 32; c4 += NT) { const int rq = c4 >> 5, c8 = c4 & 31, j = rq >> 1, i = part * 2 + (rq & 1), row = j * 16 + i, col0 = c8 * 8, d = col0 >> 7, p0 = (col0 >> 1) & 63;
        const int e = d == 0 ? j + 1 : 32 - j; float v[8];
#pragma unroll
        for (int t = 0; t < 8; ++t) { const int pp = p0 + (t >> 1), c = t & 1; const float cr = Cc[((d * 16 + i) * 64 + pp) * 2], ci = Cc[((d * 16 + i) * 64 + pp) * 2 + 1];
            const float wr = pw[((d * 64 + pp) * 33 + e) * 2], wi = pw[((d * 64 + pp) * 33 + e) * 2 + 1]; v[t] = c == 0 ? cr * wr - ci * wi : -(cr * wi + ci * wr); }
        u32x4 o; o.x = pk2(v[0], v[1]); o.y = pk2(v[2], v[3]); o.z = pk2(v[4], v[5]); o.w = pk2(v[6], v[7]);
        *(u32x4*)(Wos + (size_t)row * 768 + c8 * 8) = o; }
    float* aT = (float*)(p.ws + WS_ABART) + g * 256;
    if (part == 0 && tid < 128) { const int d = tid >> 6, pp = tid & 63; aT[tid * 2] = pw[((d * 64 + pp) * 33 + 32) * 2]; aT[tid * 2 + 1] = pw[((d * 64 + pp) * 33 + 32) * 2 + 1]; }
    __syncthreads();
}
DI void fftc_item(const Params& p, int item, int nitems) {
    const int tid = tidx();
    bf16* W1 = (bf16*)(p.ws + WS_FFTC);
    bf16* W2 = W1 + 128 * 128;
    float* tw = (float*)(p.ws + WS_FFTC + 32768 + 16384);
    for (int idx = item * NT + tid; idx < 128 * 128 + 4 * 64 * 32 + 4096; idx += nitems * NT) {
        if (idx < 16384) { const int n = idx >> 7, k = idx & 127, co = n >> 6, d = n & 63, ci = k >> 6, bq = k & 63; double s, c; sincospi((double)((d * bq) & 63) / 32.0, &s, &c);
            const float v = (ci == co) ? (float)c : (ci == 1 ? (float)s : (float)(-s)); W1[idx] = (bf16)(pk2(v, 0.f) & 0xffffu); }
        else if (idx < 16384 + 8192) { const int i2 = idx - 16384, s_ = i2 >> 11, cf = (i2 >> 5) & 63, slot = i2 & 31, gq = slot >> 3, jp = slot & 7;
            const int a = 16 * (2 * (s_ & 1) + (jp >> 2)) + 4 * gq + (jp & 3); double s, c; sincospi((double)((cf * a) & 63) / 32.0, &s, &c);
            W2[i2] = (bf16)(pk2((s_ >> 1) == 0 ? (float)c : (float)s, 0.f) & 0xffffu); }
        else { const int i3 = idx - 16384 - 8192, ln = i3 & 63, r = (i3 >> 6) & 3, mt = (i3 >> 8) & 3, nt = i3 >> 10; const int d = 16 * nt + (ln & 15), a = 16 * mt + 4 * (ln >> 4) + r;
            double s, c; sincospi((double)((d * a) & 4095) / 2048.0, &s, &c); tw[i3 * 2] = (float)c; tw[i3 * 2 + 1] = (float)s; }
    }
}
constexpr int P0_S5 = 256, P0_GF = 256;
constexpr int P0_ITEMS = P0_S5 + P0_GF;
DI void rw_item(const Params& p, int item, int nitems) {
    bf16* W = (bf16*)(p.ws + WS_WRT);
    for (int i = item * NT + tidx(); i < 48 * 1024; i += nitems * NT) { const int n = i >> 10, k = i & 1023; const float v = n < 4 ? p.w_group[k * 4 + n] : (n < 36 ? p.w_router[k * 32 + (n - 4)] : 0.f); W[i] = (bf16)(pk2(v, 0.f) & 0xffffu); }
}
DI void phaseA_adaln(const Params& p, unsigned char* lds, int bid, int nb) {
    for (int it = bid; it < 192 + 64; it += nb) {
        if (it < 192) { adaln_item(p, lds, it); continue; }
        const int t = it - 192, tid = tidx();
        bf16* E = (bf16*)(p.ws + WS_ETAB); bf16* fwT = E + 256 * 128;
        for (int i = t * NT + tid; i < 256 * 128; i += 64 * NT) { const int cn = i >> 7, m = i & 127, c = cn >> 7, n = cn & 127; double sv, cv; sincospi((double)((n * m) & 127) / 64.0, &sv, &cv);
            E[i] = (bf16)(pk2(c == 0 ? (float)cv : (float)(-sv), 0.f) & 0xffffu); }
        for (int i = t * NT + tid; i < 4 * 128 * 128; i += 64 * NT) { const int q = i >> 14, j = (i >> 7) & 127, n = i & 127; fwT[i] = (bf16)(pk2(p.fourier_w[((size_t)q * 128 + n) * 128 + j], 0.f) & 0xffffu); }
        fftc_item(p, t, 64); rw_item(p, t, 64);
    }
}
DI void a1_item(const Params& p, int r0) {
    const int lane = tidx() & 63;
    const float* mod = (const float*)(p.ws + WS_MOD);
    bf16* A1 = (bf16*)(p.ws + WS_R1);
    constexpr int RW = 4;
    const float* src = r0 < NTOK ? p.x + (size_t)r0 * D : p.ctx + (size_t)(r0 - NTOK) * D;
    const int mr = r0 < NTOK ? (r0 >> 12) : 8;
    f32x4 v[RW][4]; float s[RW];
#pragma unroll
    for (int q = 0; q < RW; ++q)
#pragma unroll
        for (int j = 0; j < 4; ++j) v[q][j] = ((const f32x4*)(src + (size_t)q * D) + lane)[64 * j];
    f32x4 gm[4], sh[4];
#pragma unroll
    for (int j = 0; j < 4; ++j) { const int k = lane * 4 + 256 * j; gm[j] = *(const f32x4*)(p.norm1_g + k) * (*(const f32x4*)(mod + mr * 6144 + 1024 + k) + 1.f); sh[j] = *(const f32x4*)(mod + mr * 6144 + k); }
#pragma unroll
    for (int q = 0; q < RW; ++q) { float t = 0.f;
#pragma unroll
        for (int j = 0; j < 4; ++j) t += (v[q][j].x * v[q][j].x + v[q][j].y * v[q][j].y) + (v[q][j].z * v[q][j].z + v[q][j].w * v[q][j].w);
        s[q] = t; }
#pragma unroll
    for (int o = 1; o < 64; o <<= 1) {
#pragma unroll
        for (int q = 0; q < RW; ++q) s[q] += __shfl_xor(s[q], o); }
#pragma unroll
    for (int q = 0; q < RW; ++q) { const float rs = rsqrtf(s[q] * (1.f / D) + EPS); u32x2* o = (u32x2*)(A1 + (size_t)(r0 + q) * D) + lane;
#pragma unroll
        for (int j = 0; j < 4; ++j) { const f32x4 h = v[q][j] * rs * gm[j] + sh[j]; u32x2 w; w.x = pk2(h.x, h.y); w.y = pk2(h.z, h.w); o[64 * j] = w; } }
}
constexpr int WI_A1 = NROWS1 / 4, WI_ALL = WI_A1 + TP_ITEMS;
DI void phaseAB_prep(const Params& p, unsigned char* lds, int bid, int nb) {
    phaseA_adaln(p, lds, bid, nb);
    unsigned* flag = (unsigned*)(p.ws + WS_CTL + CTL_FLAGA);
    asm volatile("s_waitcnt vmcnt(0)" ::: "memory");
    __syncthreads();
    if (tidx() == 0) { __builtin_amdgcn_fence(__ATOMIC_RELEASE, "agent"); asm volatile("s_waitcnt vmcnt(0)" ::: "memory"); (void)__hip_atomic_fetch_add(flag, 1u, __ATOMIC_RELAXED, __HIP_MEMORY_SCOPE_AGENT); }
    for (int it = bid; it < P0_S5; it += nb) s5mats_item(p, lds, it);
    if (tidx() == 0) { unsigned sp = 0; while (__hip_atomic_load(flag, __ATOMIC_RELAXED, __HIP_MEMORY_SCOPE_AGENT) < (unsigned)nb) { __builtin_amdgcn_s_sleep(2); if (++sp > (1u << 22)) break; }
        __builtin_amdgcn_fence(__ATOMIC_ACQUIRE, "agent"); asm volatile("s_waitcnt vmcnt(0)" ::: "memory"); }
    __syncthreads();
    for (int it = bid; it < P0_GF; it += nb) gfold_item(p, lds, it);
    __syncthreads();
    const int wid = tidx() >> 6;
    for (int it = bid * 8 + wid; it < WI_ALL; it += nb * 8) {
        if (it < WI_A1) a1_item(p, it * 4); else tp_item(p, lds, it - WI_A1);
    }
}

struct G1uPol {
    template <class U> DI bool half(const U&) const { return false; }
    static constexpr long KSTEP_A = 0;
    DI unsigned aoff(int R, int C) const { return (unsigned)(R * lda + C) * 2u; }
    struct Unit { int pm, pn; };
    static constexpr bool GATHER = false;
    pg8::DenseOrder ord; const char* A; const char* B; int K, ksplit, lda, ldb;
    DI bool next(int i, Unit& u) const { return ord.get(i, u.pm, u.pn); }
    DI void ptrs(const Unit& u, pg8::UPtr& q) const { q.a0 = A + (size_t)u.pm * 256 * lda * 2; q.a1 = q.a0 + (size_t)128 * lda * 2; q.b0 = B + (size_t)u.pn * 256 * ldb * 2; q.b1 = q.b0 + (size_t)128 * ldb * 2; q.c0 = q.b0; q.c1 = q.b1; }
    DI int brow(int R) const { return R; }
    DI void gather(const Unit&, int (&)[2], int (&)[2], unsigned&, unsigned&, unsigned&, unsigned&) const {}
};
struct G1uEpi {
    static constexpr int MIDK_T = -1;
    bf16* Ul;
    DI void operator()(const f32x4 (&acc)[2][2][4][2], const G1uPol::Unit& u, int wr, int wc, int fr, int fq) const {
#pragma unroll
        for (int ai = 0; ai < 2; ++ai)
#pragma unroll
            for (int m = 0; m < 4; ++m) { const int row = u.pm * 256 + ai * 128 + wr * 64 + m * 16 + fr, b = row >> 12, l = row & 4095;
#pragma unroll
                for (int bj = 0; bj < 2; ++bj) { const int c0 = u.pn * 256 + bj * 128 + wc * 32 + 8 * fq, g = c0 >> 4, h0 = c0 & 15;
                    const f32x4 a0 = acc[ai][bj][m][0], a1 = acc[ai][bj][m][1];
                    u32x4 w; w.x = pk2(a0[0], a0[1]); w.y = pk2(a0[2], a0[3]); w.z = pk2(a1[0], a1[1]); w.w = pk2(a1[2], a1[3]);
                    *(u32x4*)(Ul + (((size_t)g * 1024 + b * 128 + (l >> 5)) * 768 + (l & 31) * 16 + h0)) = w; } }
    }
};
struct G1gPol {
    template <class U> DI bool half(const U&) const { return false; }
    static constexpr long KSTEP_A = 0;
    DI unsigned aoff(int R, int C) const { return (unsigned)(R * lda + C) * 2u; }
    struct Unit { int pm, pn; };
    static constexpr bool GATHER = false;
    pg8::DenseOrder ord; const char* A; const char* B; int K, ksplit, lda, ldb;
    DI bool next(int i, Unit& u) const { return ord.get(i, u.pm, u.pn); }
    DI void ptrs(const Unit& u, pg8::UPtr& q) const { q.a0 = A + (size_t)u.pm * 256 * lda * 2; q.a1 = q.a0 + (size_t)128 * lda * 2;
        const int b = u.pn >> 4, a0 = (u.pn & 15) * 4; q.b0 = B + (size_t)(b * 4096 + a0) * ldb * 2; q.b1 = q.b0 + (size_t)2 * ldb * 2; q.c0 = q.b0; q.c1 = q.b1; }
    DI int brow(int R) const { return (R & 63) * 64 + (R >> 6); }
    DI void gather(const Unit&, int (&)[2], int (&)[2], unsigned&, unsigned&, unsigned&, unsigned&) const {}
};
struct G1gEpi {
    static constexpr int MIDK_T = -1;
    bf16* GT;
    DI void operator()(const f32x4 (&acc)[2][2][4][2], const G1gPol::Unit& u, int wr, int wc, int fr, int fq) const {
        const int b = u.pn >> 4, a0 = (u.pn & 15) * 4;
#pragma unroll
        for (int ai = 0; ai < 2; ++ai)
#pragma unroll
            for (int m = 0; m < 4; ++m) { const int mm = u.pm * 256 + ai * 128 + wr * 64 + m * 16 + fr, c = mm >> 9, ch = mm & 511;
                bf16* base = GT + (size_t)((b * 512 + ch) * 2 + c) * 4096;
#pragma unroll
                for (int bj = 0; bj < 2; ++bj) { const int a = a0 + 2 * bj + (wc >> 1), bq = 32 * (wc & 1) + 8 * fq;
                    const f32x4 v0 = acc[ai][bj][m][0], v1 = acc[ai][bj][m][1];
                    u32x4 w; w.x = pk2(v0[0], v0[1]); w.y = pk2(v0[2], v0[3]); w.z = pk2(v1[0], v1[1]); w.w = pk2(v1[2], v1[3]);
                    *(u32x4*)(base + a * 64 + bq) = w; } }
    }
};
DI void phase1b(const Params& p, unsigned char* lds, int bid, int nb) {
    { G1gPol P; P.ord.init(4, NTOK / 256, nb, bid); P.A = (const char*)(p.ws + WS_WINT) + (size_t)512 * 2048; P.B = (const char*)(p.ws + WS_R1); P.K = 1024; P.ksplit = 16; P.lda = 1024; P.ldb = 1024;
      G1gEpi E{(bf16*)(p.ws + WS_R2)};
      pg8::gemm_phase<G1gPol, G1gEpi, true>((PG8_LAS unsigned char*)lds, P, E); }
    { G1uPol P; P.ord.init(NTOK / 256, 2, nb, bid); P.A = (const char*)(p.ws + WS_R1); P.B = (const char*)(p.ws + WS_WINT); P.K = 1024; P.ksplit = 16; P.lda = 1024; P.ldb = 1024;
      G1uEpi E{(bf16*)(p.ws + WS_R3)};
      pg8::gemm_phase<G1uPol, G1uEpi, true>((PG8_LAS unsigned char*)lds, P, E); }
    { const int tid = tidx(), lane = tid & 63, wid = tid >> 6, fr = lane & 15, fq = lane >> 4;
      for (int item = bid; item < 256; item += nb) { const int g = item >> 3, b = item & 7;
          const bf16* A1c = (const bf16*)(p.ws + WS_R1) + (size_t)(NTOK + b * 256 + wid * 32) * D; const bf16* Wg = (const bf16*)(p.ws + WS_WINT) + (size_t)(g * 16) * D;
          f32x4 ca[2] = {(f32x4){0.f, 0.f, 0.f, 0.f}, (f32x4){0.f, 0.f, 0.f, 0.f}};
#pragma unroll 8
          for (int ks = 0; ks < 32; ++ks) { const bf16x8 bw = *(const bf16x8*)(Wg + (size_t)fr * D + ks * 32 + fq * 8);
              const bf16x8 a0 = *(const bf16x8*)(A1c + (size_t)fr * D + ks * 32 + fq * 8), a1 = *(const bf16x8*)(A1c + (size_t)(16 + fr) * D + ks * 32 + fq * 8);
              ca[0] = __builtin_amdgcn_mfma_f32_16x16x32_bf16(bw, a0, ca[0], 0, 0, 0); ca[1] = __builtin_amdgcn_mfma_f32_16x16x32_bf16(bw, a1, ca[1], 0, 0, 0); }
          bf16* Ucw = (bf16*)(p.ws + WS_R4) + ((size_t)g * 256 + b * 8 + wid) * 768;
#pragma unroll
          for (int mt = 0; mt < 2; ++mt) { u32x2 w; w.x = pk2(ca[mt][0], ca[mt][1]); w.y = pk2(ca[mt][2], ca[mt][3]); *(u32x2*)(Ucw + (size_t)(mt * 16 + fr) * 16 + 4 * fq) = w; } } }
}
struct S5aPol {
    template <class U> DI bool half(const U&) const { return false; }
    struct Unit { int g, mt; };
    static constexpr bool GATHER = false;
    static constexpr long KSTEP_A = 0;
    int G, c; const char* A; const char* Ac; const char* B; int K, ksplit, lda, ldb;
    DI unsigned aoff(int R, int C) const { return (unsigned)(R * lda + C) * 2u; }
    DI bool next(int i, Unit& u) const { const int L = i * G + c; if (L >= 160) return false; u.g = L / 5; u.mt = L % 5; return true; }
    DI void ptrs(const Unit& u, pg8::UPtr& q) const { q.a0 = u.mt < 4 ? A + ((size_t)u.g * 1024 + u.mt * 256) * lda * 2 : Ac + (size_t)u.g * 256 * lda * 2; q.a1 = q.a0 + (size_t)128 * lda * 2;
        q.b0 = B + (size_t)u.g * 256 * ldb * 2; q.b1 = q.b0 + (size_t)128 * ldb * 2; q.c0 = q.b0; q.c1 = q.b1; }
    DI int brow(int R) const { return R; }
    DI void gather(const Unit&, int (&)[2], int (&)[2], unsigned&, unsigned&, unsigned&, unsigned&) const {}
};
struct S5aEpi {
    static constexpr int MIDK_T = -1;
    bf16* S;
    DI void operator()(const f32x4 (&acc)[2][2][4][2], const S5aPol::Unit& u, int wr, int wc, int fr, int fq) const {
#pragma unroll
        for (int ai = 0; ai < 2; ++ai)
#pragma unroll
            for (int m = 0; m < 4; ++m) { bf16* dst = S + ((size_t)u.g * 1280 + u.mt * 256 + ai * 128 + wr * 64 + m * 16 + fr) * 256 + wc * 32 + 8 * fq;
#pragma unroll
                for (int bj = 0; bj < 2; ++bj) { const f32x4 v0 = acc[ai][bj][m][0], v1 = acc[ai][bj][m][1];
                    u32x4 w; w.x = pk2(v0[0], v0[1]); w.y = pk2(v0[2], v0[3]); w.z = pk2(v1[0], v1[1]); w.w = pk2(v1[2], v1[3]);
                    *(u32x4*)(dst + bj * 128) = w; } }
    }
};
DI void phase2a_s5states(const Params& p, unsigned char* lds, int bid, int nb) {
    S5aPol P; P.G = nb; P.c = bid; P.A = (const char*)(p.ws + WS_R3); P.Ac = (const char*)(p.ws + WS_R4); P.B = (const char*)(p.ws + WS_WST); P.K = 512; P.ksplit = 8; P.lda = 768; P.ldb = 512;
    S5aEpi E{(bf16*)(p.ws + WS_R1)};
    pg8::gemm_phase<S5aPol, S5aEpi, true>((PG8_LAS unsigned char*)lds, P, E);
}
DI void phase2b_scan(const Params& p, int bid, int nb) {
    const int lane = tidx() & 63, wid = tidx() >> 6;
    for (int item = bid + wid * nb; item < 512; item += nb * 8) {
        const int d = item & 1, gb = item >> 1, g = gb >> 3, b = gb & 7;
        const float* aT = (const float*)(p.ws + WS_ABART) + g * 256 + (d * 64 + lane) * 2; const float ar = aT[0], ai = aT[1];
        const unsigned* Sg = (const unsigned*)((const bf16*)(p.ws + WS_R1) + (size_t)g * 1280 * 256 + d * 128) + lane;
        unsigned* Hout = (unsigned*)((bf16*)(p.ws + WS_R3) + ((size_t)g * 1024 + b * 128) * 768 + 512 + d * 128) + lane;
        float hr = 0.f, hi = 0.f;
        { unsigned sv[8];
#pragma unroll
          for (int j = 0; j < 8; ++j) { const int c = d == 0 ? j : 7 - j; sv[j] = Sg[(size_t)(1024 + b * 8 + c) * 128]; }
#pragma unroll
          for (int j = 0; j < 8; ++j) { const float sr = __uint_as_float(sv[j] << 16), si = __uint_as_float(sv[j] & 0xffff0000u); const float nr = ar * hr - ai * hi + sr, ni = ar * hi + ai * hr + si; hr = nr; hi = ni; } }
#pragma unroll 1
        for (int cb = 0; cb < 128; cb += 32) { unsigned sv[32];
#pragma unroll
            for (int j = 0; j < 32; ++j) { const int c = d == 0 ? cb + j : 127 - cb - j; sv[j] = Sg[(size_t)(b * 128 + c) * 128]; }
#pragma unroll
            for (int j = 0; j < 32; ++j) { const int c = d == 0 ? cb + j : 127 - cb - j; Hout[(size_t)c * 384] = pk2(hr, hi);
                const float sr = __uint_as_float(sv[j] << 16), si = __uint_as_float(sv[j] & 0xffff0000u); const float nr = ar * hr - ai * hi + sr, ni = ar * hi + ai * hr + si; hr = nr; hi = ni; } }
    }
}
struct S5cPol {
    template <class U> DI bool half(const U&) const { return false; }
    static constexpr long KSTEP_A = 0;
    DI unsigned aoff(int R, int C) const { return (unsigned)(R * lda + C) * 2u; }
    struct Unit { int g, mt, pn; };
    static constexpr bool GATHER = false;
    int G, c; const char* A; const char* B; int K, ksplit, lda, ldb;
    DI bool next(int i, Unit& u) const { const int L = i * G + c; if (L >= 256) return false; u.g = L >> 3; u.mt = (L >> 1) & 3; u.pn = L & 1; return true; }
    DI void ptrs(const Unit& u, pg8::UPtr& q) const { q.a0 = A + ((size_t)u.g * 1024 + u.mt * 256) * lda * 2; q.a1 = q.a0 + (size_t)128 * lda * 2; q.b0 = B + ((size_t)u.g * 512 + u.pn * 256) * ldb * 2; q.b1 = q.b0 + (size_t)128 * ldb * 2; q.c0 = q.b0; q.c1 = q.b1; }
    DI int brow(int R) const { return R; }
    DI void gather(const Unit&, int (&)[2], int (&)[2], unsigned&, unsigned&, unsigned&, unsigned&) const {}
};
struct S5cEpi {
    static constexpr int MIDK_T = -1;
    const bf16* Ucat; const float* s5d; bf16* yact;
    DI void operator()(const f32x4 (&acc)[2][2][4][2], const S5cPol::Unit& u, int wr, int wc, int fr, int fq) const {
        const int n0 = u.pn * 256 + wc * 32 + 8 * fq, i0 = n0 & 15;
        const f32x4 d0 = *(const f32x4*)(s5d + u.g * 16 + i0), d1 = *(const f32x4*)(s5d + u.g * 16 + i0 + 4);
#pragma unroll
        for (int ai = 0; ai < 2; ++ai) {
            u32x4 uu[4][2];
#pragma unroll
            for (int m = 0; m < 4; ++m) { const int row = u.mt * 256 + ai * 128 + wr * 64 + m * 16 + fr;
#pragma unroll
                for (int bj = 0; bj < 2; ++bj) uu[m][bj] = *(const u32x4*)(Ucat + ((size_t)u.g * 1024 + row) * 768 + n0 + bj * 128); }
#pragma unroll
            for (int m = 0; m < 4; ++m) { const int row = u.mt * 256 + ai * 128 + wr * 64 + m * 16 + fr, b = row >> 7, c = row & 127;
#pragma unroll
                for (int bj = 0; bj < 2; ++bj) { const int col = n0 + bj * 128, l = 32 * c + (col >> 4); const u32x4 v = uu[m][bj]; const f32x4 a0 = acc[ai][bj][m][0], a1 = acc[ai][bj][m][1];
                    const float y0 = geluf_(a0[0] + d0.x * __uint_as_float(v.x << 16)), y1 = geluf_(a0[1] + d0.y * __uint_as_float(v.x & 0xffff0000u));
                    const float y2 = geluf_(a0[2] + d0.z * __uint_as_float(v.y << 16)), y3 = geluf_(a0[3] + d0.w * __uint_as_float(v.y & 0xffff0000u));
                    const float y4 = geluf_(a1[0] + d1.x * __uint_as_float(v.z << 16)), y5 = geluf_(a1[1] + d1.y * __uint_as_float(v.z & 0xffff0000u));
                    const float y6 = geluf_(a1[2] + d1.z * __uint_as_float(v.w << 16)), y7 = geluf_(a1[3] + d1.w * __uint_as_float(v.w & 0xffff0000u));
                    u32x4 w; w.x = pk2(y0, y1); w.y = pk2(y2, y3); w.z = pk2(y4, y5); w.w = pk2(y6, y7);
                    *(u32x4*)(yact + (((size_t)u.g * NTOK + b * 4096 + l) * 16 + i0)) = w; } }
            asm volatile("" ::: "memory");
        }
    }
};
DI void phase2c_s5out(const Params& p, unsigned char* lds, int bid, int nb) {
    S5cPol P; P.G = nb; P.c = (nb % 8 == 0) ? (bid % 8) * (nb / 8) + bid / 8 : bid; P.A = (const char*)(p.ws + WS_R3); P.B = (const char*)(p.ws + WS_MGW); P.K = 768; P.ksplit = 12; P.lda = 768; P.ldb = 768;
    S5cEpi E{(const bf16*)(p.ws + WS_R3), p.s5_d, (bf16*)(p.ws + WS_R4)};
    pg8::gemm_phase<S5cPol, S5cEpi, true>((PG8_LAS unsigned char*)lds, P, E);
}
constexpr int FF_W1P = 272, FF_W2P = 80, FF_W1_OFF = 0, FF_W2_OFF = 128 * FF_W1P, FF_TW_OFF = FF_W2_OFF + 4 * 64 * FF_W2P, FF_LDS = FF_TW_OFF + 32768;
DI void phase2_fft(const Params& p, unsigned char* lds, int bid, int nb) {
    const int tid = tidx(), lane = tid & 63, wid = tid >> 6, fr = lane & 15, fq = lane >> 4;
    { const bf16* W1 = (const bf16*)(p.ws + WS_FFTC); const bf16* W2 = W1 + 128 * 128; const float* tw = (const float*)(p.ws + WS_FFTC + 32768 + 16384);
      for (int i = tid; i < 128 * 16; i += NT) { const int n = i >> 4, c = i & 15; *(u32x4*)(lds + FF_W1_OFF + n * FF_W1P + c * 16) = *(const u32x4*)(W1 + n * 128 + c * 8); }
      for (int i = tid; i < 256 * 4; i += NT) { const int r = i >> 2, c = i & 3; *(u32x4*)(lds + FF_W2_OFF + r * FF_W2P + c * 16) = *(const u32x4*)(W2 + r * 32 + c * 8); }
      for (int i = tid; i < 2048; i += NT) *(u32x4*)(lds + FF_TW_OFF + i * 16) = *(const u32x4*)(tw + i * 4);
      __syncthreads(); }
    const bf16* GT = (const bf16*)(p.ws + WS_R2); bf16* FT = (bf16*)(p.ws + WS_R5);
    const float* twl = (const float*)(lds + FF_TW_OFF) + lane * 2;
    for (int cidx = bid * 8 + wid; cidx < 4096; cidx += nb * 8) {
        const bf16* gt = GT + (size_t)cidx * 2 * 4096;
        bf16* ft = FT + (size_t)cidx * 4096;
        bf16x8 afr[4][4];
#pragma unroll
        for (int ks = 0; ks < 4; ++ks)
#pragma unroll
            for (int mt = 0; mt < 4; ++mt) afr[ks][mt] = *(const bf16x8*)(gt + (ks >> 1) * 4096 + (16 * mt + fr) * 64 + 32 * (ks & 1) + 8 * fq);
        bf16x8 frag[4][4];
        __builtin_amdgcn_sched_barrier(0);
#pragma unroll
        for (int mh = 0; mh < 2; ++mh) {
            f32x4 d1[2][8];
#pragma unroll
            for (int m = 0; m < 2; ++m)
#pragma unroll
                for (int n = 0; n < 8; ++n) d1[m][n] = (f32x4){0.f, 0.f, 0.f, 0.f};
#pragma unroll
            for (int ks = 0; ks < 4; ++ks) {
#pragma unroll
                for (int nt = 0; nt < 8; ++nt) { const bf16x8 bfr = *(const bf16x8*)(lds + FF_W1_OFF + (nt * 16 + fr) * FF_W1P + (ks * 32 + fq * 8) * 2);
#pragma unroll
                    for (int m = 0; m < 2; ++m) d1[m][nt] = __builtin_amdgcn_mfma_f32_16x16x32_bf16(afr[ks][2 * mh + m], bfr, d1[m][nt], 0, 0, 0); }
                __builtin_amdgcn_sched_barrier(0);
            }
#pragma unroll
            for (int nt = 0; nt < 4; ++nt) { unsigned pr[2][2], pi[2][2];
#pragma unroll
                for (int m = 0; m < 2; ++m) { const int mt = 2 * mh + m; float tr[4], ti[4];
#pragma unroll
                    for (int r = 0; r < 4; ++r) { const float cs = twl[((nt * 4 + mt) * 4 + r) * 128], sn = twl[((nt * 4 + mt) * 4 + r) * 128 + 1];
                        const float re = d1[m][nt][r], im = d1[m][nt + 4][r]; tr[r] = re * cs + im * sn; ti[r] = im * cs - re * sn; }
                    pr[m][0] = pk2(tr[0], tr[1]); pr[m][1] = pk2(tr[2], tr[3]); pi[m][0] = pk2(ti[0], ti[1]); pi[m][1] = pk2(ti[2], ti[3]); }
                u32x4 f0, f2;
                f0.x = pr[0][0]; f0.y = pr[0][1]; f0.z = pr[1][0]; f0.w = pr[1][1];
                f2.x = pi[0][0]; f2.y = pi[0][1]; f2.z = pi[1][0]; f2.w = pi[1][1];
                frag[nt][mh] = __builtin_bit_cast(bf16x8, f0); frag[nt][2 + mh] = __builtin_bit_cast(bf16x8, f2);
                __builtin_amdgcn_sched_barrier(0); }
        }
#pragma unroll
        for (int nt = 0; nt < 4; ++nt) {
            f32x4 z[4];
#pragma unroll
            for (int n = 0; n < 4; ++n) z[n] = (f32x4){0.f, 0.f, 0.f, 0.f};
#pragma unroll
            for (int s2 = 0; s2 < 4; ++s2)
#pragma unroll
                for (int n2 = 0; n2 < 4; ++n2) { const bf16x8 bfr = *(const bf16x8*)(lds + FF_W2_OFF + ((s2 * 64 + n2 * 16 + fr) * FF_W2P) + fq * 16);
                    z[n2] = __builtin_amdgcn_mfma_f32_16x16x32_bf16(frag[nt][s2], bfr, z[n2], 0, 0, 0); }
#pragma unroll
            for (int n2 = 0; n2 < 4; ++n2) { const int cf = 16 * n2 + fr; u32x2 w; w.x = pk2(z[n2][0], z[n2][1]); w.y = pk2(z[n2][2], z[n2][3]);
                *(u32x2*)(ft + 64 * cf + 16 * nt + 4 * fq) = w; }
            __builtin_amdgcn_sched_barrier(0);
        }
    }
}
struct GluPol {
    template <class U> DI bool half(const U&) const { return false; }
    struct Unit { int pm, pn; };
    static constexpr bool GATHER = false;
    static constexpr long KSTEP_A = 4L * NTOK * 16 * 2;
    pg8::DenseOrder ord; const char* A; const char* B; int K, ksplit, lda, ldb;
    DI unsigned aoff(int R, int C) const { return (unsigned)(((C >> 4) * NTOK + R) * 16 + (C & 15)) * 2u; }
    DI bool next(int i, Unit& u) const { return ord.get(i, u.pm, u.pn); }
    DI void ptrs(const Unit& u, pg8::UPtr& q) const { q.a0 = A + (size_t)u.pm * 256 * 32; q.a1 = q.a0 + (size_t)128 * 32; q.b0 = B + (size_t)u.pn * 256 * ldb * 2; q.b1 = q.b0 + (size_t)128 * ldb * 2; q.c0 = q.b0; q.c1 = q.b1; }
    DI int brow(int R) const { return R; }
    DI void gather(const Unit&, int (&)[2], int (&)[2], unsigned&, unsigned&, unsigned&, unsigned&) const {}
};
struct GluEpi {
    static constexpr int MIDK_T = -1;
    const bf16* yact; bf16* merged; float* rsqs;
    DI void operator()(const f32x4 (&acc)[2][2][4][2], const GluPol::Unit& u, int wr, int wc, int fr, int fq) const {
        const int col0 = u.pn * 256 + wc * 32 + 8 * fq;
#pragma unroll
        for (int ai = 0; ai < 2; ++ai) {
            u32x4 yy[4][2];
#pragma unroll
            for (int m = 0; m < 4; ++m) { const int row = u.pm * 256 + ai * 128 + wr * 64 + m * 16 + fr;
#pragma unroll
                for (int bj = 0; bj < 2; ++bj) { const int col = col0 + bj * 128; yy[m][bj] = *(const u32x4*)(yact + ((size_t)(col >> 4) * NTOK + row) * 16 + (col & 15)); } }
#pragma unroll
            for (int m = 0; m < 4; ++m) { const int row = u.pm * 256 + ai * 128 + wr * 64 + m * 16 + fr; float sq = 0.f;
#pragma unroll
                for (int bj = 0; bj < 2; ++bj) { const u32x4 y = yy[m][bj]; const f32x4 a0 = acc[ai][bj][m][0], a1 = acc[ai][bj][m][1];
                    const float y0 = __uint_as_float(y.x << 16) * sigmoidf_(a0[0]), y1 = __uint_as_float(y.x & 0xffff0000u) * sigmoidf_(a0[1]);
                    const float y2 = __uint_as_float(y.y << 16) * sigmoidf_(a0[2]), y3 = __uint_as_float(y.y & 0xffff0000u) * sigmoidf_(a0[3]);
                    const float y4 = __uint_as_float(y.z << 16) * sigmoidf_(a1[0]), y5 = __uint_as_float(y.z & 0xffff0000u) * sigmoidf_(a1[1]);
                    const float y6 = __uint_as_float(y.w << 16) * sigmoidf_(a1[2]), y7 = __uint_as_float(y.w & 0xffff0000u) * sigmoidf_(a1[3]);
                    u32x4 w; w.x = pk2(y0, y1); w.y = pk2(y2, y3); w.z = pk2(y4, y5); w.w = pk2(y6, y7); *(u32x4*)(merged + (size_t)row * 1024 + col0 + bj * 128) = w;
                    sq += ((y0 * y0 + y1 * y1) + (y2 * y2 + y3 * y3)) + ((y4 * y4 + y5 * y5) + (y6 * y6 + y7 * y7)); }
                sq += __shfl_xor(sq, 16); sq += __shfl_xor(sq, 32);
                if (fq == 0) rsqs[(size_t)row * 8 + u.pn * 4 + wc] = sq; }
            asm volatile("" ::: "memory");
        }
    }
};
DI void phase3_glu(const Params& p, unsigned char* lds, int bid, int nb) {
    GluPol P; P.ord.init(NTOK / 256, 2, nb, bid); P.A = (const char*)(p.ws + WS_R4); P.B = (const char*)(p.ws + WS_WGLUT); P.K = 512; P.ksplit = 8; P.lda = 512; P.ldb = 512;
    GluEpi E{(const bf16*)(p.ws + WS_R4), (bf16*)(p.ws + WS_R1), (float*)(p.ws + WS_RSQS)};
    pg8::gemm_phase<GluPol, GluEpi, true>((PG8_LAS unsigned char*)lds, P, E);
}
constexpr int FM_PITCH = 132, FM_LDS = 512 * FM_PITCH;
DI void phase3_fin(const Params& p, unsigned char* lds, int bid, int nb) {
    const int tid = tidx(), lane = tid & 63, wid = tid >> 6;
    const bf16* FT = (const bf16*)(p.ws + WS_R5); bf16* merged = (bf16*)(p.ws + WS_R1);
    float gf[8];
#pragma unroll
    for (int j = 0; j < 8; ++j) gf[j] = p.g_f[lane + 64 * j];
    for (int item = bid; item < 512; item += nb) {
        const int b = item >> 6, k0 = (item & 63) * 64;
        { u32x4 v[8];
#pragma unroll
          for (int i = 0; i < 8; ++i) { const int ix = tid + NT * i, ch = ix >> 3, c = ix & 7; v[i] = *(const u32x4*)(FT + ((size_t)(b * 512 + ch) * 4096 + k0 + c * 8)); }
#pragma unroll
          for (int i = 0; i < 8; ++i) { const int ix = tid + NT * i, ch = ix >> 3, c = ix & 7; unsigned* d = (unsigned*)(lds + ch * FM_PITCH + c * 16); d[0] = v[i].x; d[1] = v[i].y; d[2] = v[i].z; d[3] = v[i].w; } }
        __syncthreads();
        float f[8][8], s[8];
#pragma unroll
        for (int t = 0; t < 8; ++t)
#pragma unroll
            for (int j = 0; j < 8; ++j) f[t][j] = bf2f(*(const bf16*)(lds + (lane + 64 * j) * FM_PITCH + (wid * 8 + t) * 2));
#pragma unroll
        for (int t = 0; t < 8; ++t) { float a = 0.f;
#pragma unroll
            for (int j = 0; j < 8; ++j) a += f[t][j] * f[t][j];
            s[t] = a; }
#pragma unroll
        for (int o = 1; o < 64; o <<= 1) {
#pragma unroll
            for (int t = 0; t < 8; ++t) s[t] += __shfl_xor(s[t], o); }
#pragma unroll
        for (int t = 0; t < 8; ++t) { const size_t row = (size_t)b * 4096 + k0 + wid * 8 + t; const float rs = rsqrtf(s[t] * (1.f / 512.f) + EPS);
#pragma unroll
            for (int j = 0; j < 8; ++j) merged[row * 1024 + 512 + lane + 64 * j] = (bf16)(pk2(f[t][j] * rs * gf[j], 0.f) & 0xffffu); }
        __syncthreads();
    }
}
struct P4Pol {
    template <class U> DI bool half(const U&) const { return false; }
    static constexpr long KSTEP_A = 0;
    DI unsigned aoff(int R, int C) const { return (unsigned)(R * lda + C) * 2u; }
    struct Unit { int pm, pn; };
    static constexpr bool GATHER = false;
    pg8::DenseOrder ord; const char* A; const char* B; int K, ksplit, lda, ldb;
    DI bool next(int i, Unit& u) const { return ord.get(i, u.pm, u.pn); }
    DI void ptrs(const Unit& u, pg8::UPtr& q) const { q.a0 = A + (size_t)u.pm * 256 * lda * 2; q.a1 = q.a0 + (size_t)128 * lda * 2; q.b0 = B + (size_t)u.pn * 256 * ldb * 2; q.b1 = q.b0 + (size_t)128 * ldb * 2; q.c0 = q.b0; q.c1 = q.b1; }
    DI int brow(int R) const { return R; }
    DI void gather(const Unit&, int (&)[2], int (&)[2], unsigned&, unsigned&, unsigned&, unsigned&) const {}
};
struct P4Epi {
    static constexpr int MIDK_T = 8;
    const float* x; bf16* x1b; const float* mod; float* rsqp; const float* rss;
    DI void midk(f32x4 (&acc)[2][2][4][2], const P4Pol::Unit& u, int wr, int wc, int fr, int fq) const {
        float r[2][4]; f32x4 q0[2][4], q1[2][4];
#pragma unroll
        for (int ai = 0; ai < 2; ++ai)
#pragma unroll
            for (int m = 0; m < 4; ++m) { const f32x4* q = (const f32x4*)(rss + (size_t)(u.pm * 256 + ai * 128 + wr * 64 + m * 16 + fr) * 8); q0[ai][m] = q[0]; q1[ai][m] = q[1]; }
#pragma unroll
        for (int ai = 0; ai < 2; ++ai)
#pragma unroll
            for (int m = 0; m < 4; ++m) r[ai][m] = rsqrtf((((q0[ai][m].x + q0[ai][m].y) + (q0[ai][m].z + q0[ai][m].w)) + ((q1[ai][m].x + q1[ai][m].y) + (q1[ai][m].z + q1[ai][m].w))) * (1.f / 512.f) + EPS);
#pragma unroll
        for (int ai = 0; ai < 2; ++ai)
#pragma unroll
            for (int m = 0; m < 4; ++m)
#pragma unroll
                for (int bj = 0; bj < 2; ++bj)
#pragma unroll
                    for (int n = 0; n < 2; ++n) acc[ai][bj][m][n] = acc[ai][bj][m][n] * r[ai][m];
    }
    DI void operator()(const f32x4 (&acc)[2][2][4][2], const P4Pol::Unit& u, int wr, int wc, int fr, int fq) const {
        const int col0 = u.pn * 256 + wc * 32 + 8 * fq, b = (u.pm * 256) >> 12;
        f32x4 gv[2][2];
#pragma unroll
        for (int bj = 0; bj < 2; ++bj)
#pragma unroll
            for (int n = 0; n < 2; ++n) gv[bj][n] = *(const f32x4*)(mod + b * 6144 + 2048 + col0 + bj * 128 + n * 4);
        f32x4 xa[2][2][2], xb[2][2][2];
#define P4_LOAD(dst, q_) do { const int ai_ = (q_) >> 1, mb_ = ((q_) & 1) * 2; _Pragma("unroll") for (int m2 = 0; m2 < 2; ++m2) { const int row_ = u.pm * 256 + ai_ * 128 + wr * 64 + (mb_ + m2) * 16 + fr; \
            _Pragma("unroll") for (int bj = 0; bj < 2; ++bj) _Pragma("unroll") for (int n = 0; n < 2; ++n) dst[m2][bj][n] = *(const f32x4*)(x + (size_t)row_ * D + col0 + bj * 128 + n * 4); } } while (0)
#define P4_DO(src, q_) do { const int ai_ = (q_) >> 1, mb_ = ((q_) & 1) * 2; _Pragma("unroll") for (int m2 = 0; m2 < 2; ++m2) { const int m_ = mb_ + m2, row_ = u.pm * 256 + ai_ * 128 + wr * 64 + m_ * 16 + fr; float s_ = 0.f; \
            _Pragma("unroll") for (int bj = 0; bj < 2; ++bj) { const f32x4 o0 = src[m2][bj][0] + gv[bj][0] * acc[ai_][bj][m_][0], o1 = src[m2][bj][1] + gv[bj][1] * acc[ai_][bj][m_][1]; \
                u32x4 w; w.x = pk2(o0.x, o0.y); w.y = pk2(o0.z, o0.w); w.z = pk2(o1.x, o1.y); w.w = pk2(o1.z, o1.w); *(u32x4*)(x1b + (size_t)row_ * D + col0 + bj * 128) = w; \
                s_ += ((o0.x * o0.x + o0.y * o0.y) + (o0.z * o0.z + o0.w * o0.w)) + ((o1.x * o1.x + o1.y * o1.y) + (o1.z * o1.z + o1.w * o1.w)); } \
            s_ += __shfl_xor(s_, 16); s_ += __shfl_xor(s_, 32); if (fq == 0) rsqp[(size_t)row_ * 16 + u.pn * 4 + wc] = s_; } } while (0)
        P4_LOAD(xa, 0); P4_LOAD(xb, 1);
        P4_DO(xa, 0); asm volatile("" ::: "memory"); P4_LOAD(xa, 2);
        P4_DO(xb, 1); asm volatile("" ::: "memory"); P4_LOAD(xb, 3);
        P4_DO(xa, 2); asm volatile("" ::: "memory");
        P4_DO(xb, 3);
#undef P4_LOAD
#undef P4_DO
    }
};
DI void phase4_out(const Params& p, unsigned char* lds, int bid, int nb) {
    P4Pol P; P.ord.init(NTOK / 256, D / 256, nb, bid); P.A = (const char*)(p.ws + WS_R1); P.B = (const char*)(p.ws + WS_WOUTT); P.K = 1024; P.ksplit = 16; P.lda = 1024; P.ldb = 1024;
    P4Epi E{p.x, (bf16*)(p.ws + WS_X1B), (const float*)(p.ws + WS_MOD), (float*)(p.ws + WS_RSQP1), (const float*)(p.ws + WS_RSQS)};
    pg8::gemm_phase<P4Pol, P4Epi, true>((PG8_LAS unsigned char*)lds, P, E);
}
DI int pair_index(int lo, int hi) { return 7 * lo - (lo * (lo - 1)) / 2 + (hi - lo - 1); }
constexpr int RT_WP = 2064, RT_GM_OFF = 48 * RT_WP, RT_SH_OFF = RT_GM_OFF + 4096, RT_SC_OFF = RT_SH_OFF + 4096, RT_LDS = RT_SC_OFF + 8 * 16 * 48 * 4;
DI void phase5_route(const Params& p, unsigned char* lds, int bid, int nb, bool commit = true) {
    const int tid = tidx(), lane = tid & 63, wid = tid >> 6, fr = lane & 15, fq = lane >> 4;
    { const bf16* W = (const bf16*)(p.ws + WS_WRT);
      for (int i = tid; i < 48 * 128; i += NT) { const int n = i >> 7, c = i & 127; *(u32x4*)(lds + n * RT_WP + c * 16) = *(const u32x4*)(W + n * 1024 + c * 8); } }
    const float* mod = (const float*)(p.ws + WS_MOD); const float* rsqp = (const float*)(p.ws + WS_RSQP1);
    bf16* A2 = (bf16*)(p.ws + WS_A2); unsigned* elcp = (unsigned*)(p.ws + WS_ELCP); float* elw = (float*)(p.ws + WS_ELW); unsigned* tcp = (unsigned*)(p.ws + WS_TCP);
    unsigned* ecnt = (unsigned*)(p.ws + WS_CTL + CTL_ECNT); unsigned* pcnt = (unsigned*)(p.ws + WS_CTL + CTL_PCNT);
    unsigned* elist = (unsigned*)(p.ws + WS_ELIST);
    float* gm = (float*)(lds + RT_GM_OFF); float* shv = (float*)(lds + RT_SH_OFF); float* scr = (float*)(lds + RT_SC_OFF) + wid * 16 * 48;
    for (int t128 = bid; t128 < NTOK / 128; t128 += nb) {
        const int b = t128 >> 5;
        __syncthreads();
        for (int k = tid; k < 1024; k += NT) { gm[k] = p.norm2_g[k] * (1.f + mod[b * 6144 + 4096 + k]); shv[k] = mod[b * 6144 + 3072 + k]; }
        __syncthreads();
        const int row0 = t128 * 128 + wid * 16, row = row0 + fr;
        float rs;
        { const f32x4* pp = (const f32x4*)(rsqp + (size_t)row * 16); const f32x4 q0 = pp[0], q1 = pp[1], q2 = pp[2], q3 = pp[3];
          const float rsum = (((q0.x + q0.y) + (q0.z + q0.w)) + ((q1.x + q1.y) + (q1.z + q1.w))) + (((q2.x + q2.y) + (q2.z + q2.w)) + ((q3.x + q3.y) + (q3.z + q3.w)));
          rs = rsqrtf(rsum * (1.f / D) + EPS); }
        f32x4 acc[3];
#pragma unroll
        for (int n = 0; n < 3; ++n) acc[n] = (f32x4){0.f, 0.f, 0.f, 0.f};
        const bf16* xr = (const bf16*)(p.ws + WS_X1B) + (size_t)row * D + fq * 8; bf16* ar = A2 + (size_t)row * D + fq * 8;
        u32x4 xa[8], xb[8];
#pragma unroll
        for (int i = 0; i < 8; ++i) xa[i] = *(const u32x4*)(xr + i * 32);
#pragma unroll 1
        for (int kc = 0; kc < 4; kc += 2) {
#pragma unroll
            for (int i = 0; i < 8; ++i) xb[i] = *(const u32x4*)(xr + (kc + 1) * 256 + i * 32);
#pragma unroll
            for (int half = 0; half < 2; ++half) {
#pragma unroll
                for (int i = 0; i < 8; ++i) {
                    const int ks = (kc + half) * 8 + i, k0 = ks * 32 + fq * 8;
                    const u32x4 xx = half ? xb[i] : xa[i];
                    f32x4 x0, x1; x0.x = __uint_as_float(xx.x << 16); x0.y = __uint_as_float(xx.x & 0xffff0000u); x0.z = __uint_as_float(xx.y << 16); x0.w = __uint_as_float(xx.y & 0xffff0000u);
                    x1.x = __uint_as_float(xx.z << 16); x1.y = __uint_as_float(xx.z & 0xffff0000u); x1.z = __uint_as_float(xx.w << 16); x1.w = __uint_as_float(xx.w & 0xffff0000u);
                    const f32x4 g0 = *(const f32x4*)(gm + k0), g1 = *(const f32x4*)(gm + k0 + 4), s0 = *(const f32x4*)(shv + k0), s1 = *(const f32x4*)(shv + k0 + 4);
                    const f32x4 t0 = x0 * rs * g0 + s0, t1 = x1 * rs * g1 + s1;
                    u32x4 hi; hi.x = pk2(t0.x, t0.y); hi.y = pk2(t0.z, t0.w); hi.z = pk2(t1.x, t1.y); hi.w = pk2(t1.z, t1.w);
                    *(u32x4*)(ar + ks * 32) = hi;
                    u32x4 lo;
                    lo.x = pk2(t0.x - __uint_as_float(hi.x << 16), t0.y - __uint_as_float(hi.x & 0xffff0000u)); lo.y = pk2(t0.z - __uint_as_float(hi.y << 16), t0.w - __uint_as_float(hi.y & 0xffff0000u));
                    lo.z = pk2(t1.x - __uint_as_float(hi.z << 16), t1.y - __uint_as_float(hi.z & 0xffff0000u)); lo.w = pk2(t1.z - __uint_as_float(hi.w << 16), t1.w - __uint_as_float(hi.w & 0xffff0000u));
                    const bf16x8 ah = __builtin_bit_cast(bf16x8, hi), al = __builtin_bit_cast(bf16x8, lo);
#pragma unroll
                    for (int nt = 0; nt < 3; ++nt) { const bf16x8 bw = *(const bf16x8*)(lds + (16 * nt + fr) * RT_WP + k0 * 2);
                        acc[nt] = __builtin_amdgcn_mfma_f32_16x16x32_bf16(ah, bw, acc[nt], 0, 0, 0); acc[nt] = __builtin_amdgcn_mfma_f32_16x16x32_bf16(al, bw, acc[nt], 0, 0, 0); }
                }
                if (half == 0 && kc + 2 < 4) {
#pragma unroll
                    for (int i = 0; i < 8; ++i) xa[i] = *(const u32x4*)(xr + (kc + 2) * 256 + i * 32);
                }
            }
        }
#pragma unroll
        for (int nt = 0; nt < 3; ++nt)
#pragma unroll
            for (int r = 0; r < 4; ++r) scr[(4 * fq + r) * 48 + 16 * nt + fr] = acc[nt][r];
        __syncthreads();
        if (lane < 16 && commit) {
            const int rrow = row0 + lane; const float* lg = scr + lane * 48;
            float gl[4];
#pragma unroll
            for (int o = 0; o < 4; ++o) gl[o] = lg[o] + p.b_group[o];
            float gmax = gl[0]; int gi = 0;
#pragma unroll
            for (int o = 1; o < 4; ++o) if (gl[o] > gmax) { gmax = gl[o]; gi = o; }
            float se = 0.f;
#pragma unroll
            for (int o = 0; o < 4; ++o) se += __expf(gl[o] - gmax);
            const float g_w = 1.f / se;
            float ev[8];
#pragma unroll
            for (int o = 0; o < 8; ++o) ev[o] = lg[4 + gi * 8 + o] + p.b_router[gi * 8 + o];
            float v1 = ev[0]; int i1 = 0;
#pragma unroll
            for (int o = 1; o < 8; ++o) if (ev[o] > v1) { v1 = ev[o]; i1 = o; }
            float v2 = -3.0e38f; int i2 = -1;
#pragma unroll
            for (int o = 0; o < 8; ++o) if (o != i1 && ev[o] > v2) { v2 = ev[o]; i2 = o; }
            const float w1 = g_w / (1.f + __expf(v2 - v1)), w2 = g_w - w1;
            const int lo = i1 < i2 ? i1 : i2, hi = i1 < i2 ? i2 : i1; const int pos1 = i1 < i2 ? 0 : 1;
            const int e1 = gi * 8 + i1, e2 = gi * 8 + i2;
            const int cls = gi * 28 + pair_index(lo, hi);
            const unsigned q3 = atomicAdd(pcnt + cls, 1u); const unsigned cp = ((unsigned)cls << 16) | q3;
            tcp[rrow] = cp;
            const unsigned q1 = atomicAdd(ecnt + e1, 1u); elist[(size_t)e1 * 32768 + q1] = (unsigned)rrow * 2u + (unsigned)pos1; elcp[(size_t)e1 * 32768 + q1] = cp; elw[(size_t)e1 * 32768 + q1] = w1;
            const unsigned q2 = atomicAdd(ecnt + e2, 1u); elist[(size_t)e2 * 32768 + q2] = (unsigned)rrow * 2u + (unsigned)(1 - pos1); elcp[(size_t)e2 * 32768 + q2] = cp; elw[(size_t)e2 * 32768 + q2] = w2;
        }
    }
    __syncthreads();
}
constexpr int TB_OFF = 131072, TB_ETE = 64, TB_ETR = 64 + 320, TB_ETC = 64 + 640, TB_PTC = 64 + 960, TB_PTS = 64 + 1280, TB_COFF = 64 + 1600, TB_PTN = 64 + 1600 + 128 + 160, TB_BYTES = (64 + 1600 + 128 + 160 + 320) * 4;
DI void build_tiles(const Params& p, unsigned char* lds) {
    int* tb = (int*)(lds + TB_OFF); int* cnts = tb + TB_COFF + 112;
    const int tid = tidx();
    if (tid < 144) cnts[tid] = tid < 32 ? (int)((const unsigned*)(p.ws + WS_CTL + CTL_ECNT))[tid] : (int)((const unsigned*)(p.ws + WS_CTL + CTL_PCNT))[tid - 32];
    __syncthreads();
    const bool isE = tid < 32, isP = tid >= 64 && tid < 176;
    if (isE || isP) {
        const int base = isE ? 0 : 32, n = isE ? 32 : 112, me = isE ? tid : tid - 64;
        int fb = 0, pb = 0, hb = 0, ft = 0, pt = 0, rows_before = 0;
        for (int j = 0; j < n; ++j) { const int c = cnts[base + j], f = c >> 8, r = c & 255, pp = r > 128 ? 1 : 0, hh = (r > 0 && r <= 128) ? 1 : 0;
            ft += f; pt += pp; if (j < me) { fb += f; pb += pp; hb += hh; rows_before += ((c + 255) >> 8) << 8; } }
        const int c = cnts[base + me], f = c >> 8, r = c & 255;
        if (isE) {
            for (int k = 0; k < f; ++k) { tb[TB_ETE + fb + k] = me; tb[TB_ETR + fb + k] = k * 256; tb[TB_ETC + fb + k] = c; }
            if (r > 128) { const int ix = ft + pb; tb[TB_ETE + ix] = me; tb[TB_ETR + ix] = f * 256; tb[TB_ETC + ix] = c; }
            else if (r > 0) { const int ix = ft + pt + hb; tb[TB_ETE + ix] = me; tb[TB_ETR + ix] = f * 256; tb[TB_ETC + ix] = c; }
            if (me == 31) tb[0] = ft + pt + hb + ((r > 0 && r <= 128) ? 1 : 0);
        } else {
            tb[TB_COFF + me] = rows_before;
            for (int k = 0; k < f; ++k) { tb[TB_PTC + fb + k] = me; tb[TB_PTS + fb + k] = rows_before + k * 256; tb[TB_PTN + fb + k] = c - k * 256; }
            if (r > 128) { const int ix = ft + pb; tb[TB_PTC + ix] = me; tb[TB_PTS + ix] = rows_before + f * 256; tb[TB_PTN + ix] = r; }
            else if (r > 0) { const int ix = ft + pt + hb; tb[TB_PTC + ix] = me; tb[TB_PTS + ix] = rows_before + f * 256; tb[TB_PTN + ix] = r; }
            if (me == 111) tb[1] = ft + pt + hb + ((r > 0 && r <= 128) ? 1 : 0);
        }
    }
    __syncthreads();
}
struct GUPol {
    struct Unit { int e, r0, cnt, hh; };
    DI bool half(const Unit& u) const { return u.cnt - u.r0 <= 128; }
    static constexpr long KSTEP_A = 0;
    DI unsigned aoff(int R, int C) const { return (unsigned)(R * lda + C) * 2u; }
    static constexpr bool GATHER = true;
    const int* tb; int G, c; const char* A; const char* B; const unsigned* elist; int K, ksplit, lda, ldb;
    DI bool next(int i, Unit& u) const { const int L = i * G + c; if (L >= __builtin_amdgcn_readfirstlane(tb[0]) * 2) return false; const int t = L >> 1; u.hh = L & 1;
        u.e = __builtin_amdgcn_readfirstlane(tb[TB_ETE + t]); u.r0 = __builtin_amdgcn_readfirstlane(tb[TB_ETR + t]); u.cnt = __builtin_amdgcn_readfirstlane(tb[TB_ETC + t]); return true; }
    DI void ptrs(const Unit& u, pg8::UPtr& q) const { q.a0 = A; q.a1 = A; q.b0 = B + (size_t)((u.e * 2 + u.hh) * 256) * ldb * 2; q.b1 = q.b0 + (size_t)128 * ldb * 2; q.c0 = q.b0; q.c1 = q.b1; }
    DI int brow(int R) const { return R; }
    DI unsigned goff(const Unit& u, int r, int C) const { const unsigned ent = elist[(size_t)u.e * 32768 + (r < u.cnt ? r : u.r0)]; return ((ent >> 1) * 1024u + (unsigned)C) * 2u; }
    DI void gather(const Unit& u, int (&R)[2], int (&C)[2], unsigned& v00, unsigned& v01, unsigned& v10, unsigned& v11) const {
        v00 = goff(u, u.r0 + R[0], C[0]); v01 = goff(u, u.r0 + R[1], C[1]); v10 = goff(u, u.r0 + 128 + R[0], C[0]); v11 = goff(u, u.r0 + 128 + R[1], C[1]);
    }
};
struct GUEpi {
    static constexpr int MIDK_T = -1;
    const unsigned* elist; const unsigned* elcp; const float* elw; bf16* Hs; const int* tb;
    DI void operator()(const f32x4 (&acc)[2][2][4][2], const GUPol::Unit& u, int wr, int wc, int fr, int fq) const {
        unsigned ent[2][4], cp[2][4]; float w[2][4];
#pragma unroll
        for (int ai = 0; ai < 2; ++ai)
#pragma unroll
            for (int m = 0; m < 4; ++m) { const int r = u.r0 + ai * 128 + wr * 64 + m * 16 + fr; const size_t ix = (size_t)u.e * 32768 + (r < u.cnt ? r : u.r0);
                ent[ai][m] = elist[ix]; cp[ai][m] = elcp[ix]; w[ai][m] = elw[ix]; }
#pragma unroll
        for (int ai = 0; ai < 2; ++ai)
#pragma unroll
            for (int m = 0; m < 4; ++m) { const int r = u.r0 + ai * 128 + wr * 64 + m * 16 + fr;
                if (r < u.cnt) { const int srow = tb[TB_COFF + (cp[ai][m] >> 16)] + (int)(cp[ai][m] & 0xffffu); const float ww = w[ai][m];
                    bf16* dst = Hs + (size_t)srow * 512 + (ent[ai][m] & 1u) * 256 + u.hh * 128 + wc * 32 + 8 * fq;
                    const f32x4 g0 = acc[ai][0][m][0], g1 = acc[ai][0][m][1], u0 = acc[ai][1][m][0], u1 = acc[ai][1][m][1];
                    u32x4 o; o.x = pk2(siluf_(g0[0]) * u0[0] * ww, siluf_(g0[1]) * u0[1] * ww); o.y = pk2(siluf_(g0[2]) * u0[2] * ww, siluf_(g0[3]) * u0[3] * ww);
                    o.z = pk2(siluf_(g1[0]) * u1[0] * ww, siluf_(g1[1]) * u1[1] * ww); o.w = pk2(siluf_(g1[2]) * u1[2] * ww, siluf_(g1[3]) * u1[3] * ww);
                    *(u32x4*)dst = o; } }
    }
};
DI void phase6_gateup(const Params& p, unsigned char* lds, int bid, int nb) {
    GUPol P; P.tb = (const int*)(lds + TB_OFF); P.G = nb; P.c = (nb % 8 == 0) ? (bid % 8) * (nb / 8) + bid / 8 : bid; P.A = (const char*)(p.ws + WS_A2); P.B = (const char*)(p.ws + WS_WGUT); P.elist = (const unsigned*)(p.ws + WS_ELIST); P.K = 1024; P.ksplit = 16; P.lda = 1024; P.ldb = 1024;
    GUEpi E{(const unsigned*)(p.ws + WS_ELIST), (const unsigned*)(p.ws + WS_ELCP), (const float*)(p.ws + WS_ELW), (bf16*)(p.ws + WS_HS), (const int*)(lds + TB_OFF)};
    pg8::gemm_phase<GUPol, GUEpi, true>((PG8_LAS unsigned char*)lds, P, E);
}
struct DnPol {
    struct Unit { int s0, cls, pn, nrows; };
    DI bool half(const Unit& u) const { return u.nrows <= 128; }
    static constexpr long KSTEP_A = 0;
    DI unsigned aoff(int R, int C) const { return (unsigned)(R * lda + C) * 2u; }
    static constexpr bool GATHER = false;
    const int* tb; int G, c; const char* A; const char* B; int K, ksplit, lda, ldb;
    DI bool next(int i, Unit& u) const { const int L = i * G + c; if (L >= __builtin_amdgcn_readfirstlane(tb[1]) * 4) return false; const int t = L >> 2; u.pn = L & 3;
        u.cls = __builtin_amdgcn_readfirstlane(tb[TB_PTC + t]); u.s0 = __builtin_amdgcn_readfirstlane(tb[TB_PTS + t]); u.nrows = __builtin_amdgcn_readfirstlane(tb[TB_PTN + t]); return true; }
    DI void ptrs(const Unit& u, pg8::UPtr& q) const {
        const int gi = u.cls / 28; int lo = 0, rem = u.cls % 28;
        while (rem >= 7 - lo) { rem -= 7 - lo; ++lo; }
        const int hi = lo + 1 + rem, elo = gi * 8 + lo, ehi = gi * 8 + hi;
        q.a0 = A + (size_t)u.s0 * lda * 2; q.a1 = q.a0 + (size_t)128 * lda * 2;
        q.b0 = B + ((size_t)elo * 1024 + u.pn * 256) * ldb * 2; q.b1 = q.b0 + (size_t)128 * ldb * 2;
        q.c0 = B + ((size_t)ehi * 1024 + u.pn * 256) * ldb * 2; q.c1 = q.c0 + (size_t)128 * ldb * 2; }
    DI int brow(int R) const { return R; }
    DI void gather(const Unit&, int (&)[2], int (&)[2], unsigned&, unsigned&, unsigned&, unsigned&) const {}
};
struct DnEpi {
    static constexpr int MIDK_T = -1;
    bf16* moe;
    DI void operator()(const f32x4 (&acc)[2][2][4][2], const DnPol::Unit& u, int wr, int wc, int fr, int fq) const {
#pragma unroll
        for (int ai = 0; ai < 2; ++ai) { if (ai == 1 && u.nrows <= 128) break;
#pragma unroll
            for (int m = 0; m < 4; ++m) { bf16* dst = moe + (size_t)(u.s0 + ai * 128 + wr * 64 + m * 16 + fr) * 1024 + u.pn * 256 + wc * 32 + 8 * fq;
#pragma unroll
                for (int bj = 0; bj < 2; ++bj) { const f32x4 v0 = acc[ai][bj][m][0], v1 = acc[ai][bj][m][1];
                    u32x4 w; w.x = pk2(v0[0], v0[1]); w.y = pk2(v0[2], v0[3]); w.z = pk2(v1[0], v1[1]); w.w = pk2(v1[2], v1[3]);
                    *(u32x4*)(dst + bj * 128) = w; } } }
    }
};
DI void phase7_down(const Params& p, unsigned char* lds, int bid, int nb) {
    DnPol P; P.tb = (const int*)(lds + TB_OFF); P.G = nb; P.c = (nb % 8 == 0) ? (bid % 8) * (nb / 8) + bid / 8 : bid; P.A = (const char*)(p.ws + WS_HS); P.B = (const char*)(p.ws + WS_WDT); P.K = 512; P.ksplit = 4; P.lda = 512; P.ldb = 256;
    DnEpi E{(bf16*)(p.ws + WS_MOE)};
    pg8::gemm_phase<DnPol, DnEpi, true>((PG8_LAS unsigned char*)lds, P, E);
}
DI void phase8_final(const Params& p, unsigned char* lds, int bid, int nb) {
    const int lane = tidx() & 63, wave = tidx() >> 6;
    const float* mod = (const float*)(p.ws + WS_MOD); const unsigned* tcp = (const unsigned*)(p.ws + WS_TCP); const bf16* moe = (const bf16*)(p.ws + WS_MOE); const bf16* x1b = (const bf16*)(p.ws + WS_X1B); const int* tb = (const int*)(lds + TB_OFF);
    constexpr int RW = 4;
    for (int r0 = (bid * 8 + wave) * RW; r0 < NTOK; r0 += nb * 8 * RW) {
        const int b = r0 >> 12; unsigned cp[RW]; u32x2 xx[RW][4], mm[RW][4];
#pragma unroll
        for (int q = 0; q < RW; ++q) cp[q] = tcp[r0 + q];
#pragma unroll
        for (int q = 0; q < RW; ++q)
#pragma unroll
            for (int j = 0; j < 4; ++j) xx[q][j] = ((const u32x2*)(x1b + (size_t)(r0 + q) * D) + lane)[64 * j];
#pragma unroll
        for (int q = 0; q < RW; ++q) { const int srow = tb[TB_COFF + (cp[q] >> 16)] + (int)(cp[q] & 0xffffu);
#pragma unroll
            for (int j = 0; j < 4; ++j) mm[q][j] = ((const u32x2*)(moe + (size_t)srow * D) + lane)[64 * j]; }
        f32x4 g2[4], fg[4];
#pragma unroll
        for (int j = 0; j < 4; ++j) { g2[j] = *(const f32x4*)(mod + b * 6144 + 5120 + lane * 4 + 256 * j); fg[j] = *(const f32x4*)(p.final_g + lane * 4 + 256 * j); }
        f32x4 v[RW][4]; float s[RW];
#pragma unroll
        for (int q = 0; q < RW; ++q) { float t = 0.f;
#pragma unroll
            for (int j = 0; j < 4; ++j) { f32x4 x1, mv; x1.x = __uint_as_float(xx[q][j].x << 16); x1.y = __uint_as_float(xx[q][j].x & 0xffff0000u); x1.z = __uint_as_float(xx[q][j].y << 16); x1.w = __uint_as_float(xx[q][j].y & 0xffff0000u);
                mv.x = __uint_as_float(mm[q][j].x << 16); mv.y = __uint_as_float(mm[q][j].x & 0xffff0000u); mv.z = __uint_as_float(mm[q][j].y << 16); mv.w = __uint_as_float(mm[q][j].y & 0xffff0000u);
                v[q][j] = x1 + g2[j] * mv; t += (v[q][j].x * v[q][j].x + v[q][j].y * v[q][j].y) + (v[q][j].z * v[q][j].z + v[q][j].w * v[q][j].w); }
            s[q] = t; }
#pragma unroll
        for (int o = 1; o < 64; o <<= 1) {
#pragma unroll
            for (int q = 0; q < RW; ++q) s[q] += __shfl_xor(s[q], o); }
#pragma unroll
        for (int q = 0; q < RW; ++q) { const float rs = rsqrtf(s[q] * (1.f / D) + EPS); f32x4* orow = (f32x4*)(p.out + (size_t)(r0 + q) * D) + lane;
#pragma unroll
            for (int j = 0; j < 4; ++j) { f32x4 o = v[q][j] * rs * fg[j];
                if (MK_TS1 >= 0) { const unsigned* tsv = (const unsigned*)(p.ws + WS_CTL + CTL_TS); o = o * (1.f + (float)(tsv[0] / 1000u) * 0.01f); }
                orow[64 * j] = o; } }
    }
}

#define XB_TMO      128
#define XB_XCNT(j)  (256  + 64 * (j))
#define XB_XSUB(j)  (1280 + 64 * (j))
#define XB_XGEN(j)  (2304 + 64 * (j))
#define XB_TOP      3328
#define XB_TOPGEN   3392
#define XCD_BAR_WORDS 3456
#define XB_SPIN_CAP (1u << 18)
#define LAS __attribute__((address_space(3)))
DI unsigned xb_ld(unsigned* p)              { return __hip_atomic_load(p, __ATOMIC_RELAXED, __HIP_MEMORY_SCOPE_AGENT); }
DI unsigned xb_add(unsigned* p, unsigned v) { return __hip_atomic_fetch_add(p, v, __ATOMIC_RELAXED, __HIP_MEMORY_SCOPE_AGENT); }
DI unsigned xb_xcc_id() { return (unsigned)__builtin_amdgcn_s_getreg((3 << 11) | 20) & 0xFu; }
#define XB_SPIN(cond, bar) do { unsigned _sp = 0; while (cond) { __builtin_amdgcn_s_sleep(1); \
    if ((++_sp & 255u) == 0u) { if (xb_ld(&(bar)[XB_TMO])) break; if (_sp > XB_SPIN_CAP) { atomicAdd(&(bar)[XB_TMO], 1u); break; } } } } while (0)
struct XcdBarrier { unsigned* bar; unsigned x; volatile LAS unsigned* st; };
DI XcdBarrier xcd_barrier_post(unsigned* bar, volatile LAS unsigned* st) {
    XcdBarrier b; b.bar = bar; b.x = xb_xcc_id(); b.st = st;
    if (tidx() == 0) (void)xb_add(&bar[XB_XCNT(b.x)], 1u);
    return b;
}
DI void xcd_barrier_complete(unsigned* bar, unsigned x, unsigned& nloc, unsigned& nx) {
    const unsigned G = gridDim.x * gridDim.y * gridDim.z;
    unsigned sum, cnt, mine, sp = 0u;
    for (;;) {
        sum = 0u; cnt = 0u; mine = 0u;
#pragma unroll
        for (unsigned j = 0; j < 16; ++j) { const unsigned c = xb_ld(&bar[XB_XCNT(j)]); sum += c; cnt += (c > 0u) ? 1u : 0u; mine = (j == x) ? c : mine; }
        if (sum == G) break;
        __builtin_amdgcn_s_sleep(1);
        if ((++sp & 255u) == 0u) { if (xb_ld(&bar[XB_TMO])) break; if (sp > XB_SPIN_CAP) { atomicAdd(&bar[XB_TMO], 1u); break; } }
    }
    nloc = mine > 0u ? mine : 1u; nx = cnt > 0u ? cnt : 1u;
}
DI void xcd_barrier(const XcdBarrier& b) {
    asm volatile("s_waitcnt vmcnt(0)" ::: "memory");
    __syncthreads();
    if (tidx() == 0) {
        unsigned* bar = b.bar;
        __builtin_amdgcn_s_waitcnt(0);
        unsigned nloc = b.st[0], nx = b.st[1];
        if (nloc == 0u) { xcd_barrier_complete(bar, b.x, nloc, nx); b.st[0] = nloc; b.st[1] = nx; }
        const unsigned old = xb_add(&bar[XB_XSUB(b.x)], 1u);
        const unsigned gen = old / nloc;
        if (old + 1u == (gen + 1u) * nloc) {
            __builtin_amdgcn_fence(__ATOMIC_RELEASE, "agent");
            asm volatile("s_waitcnt vmcnt(0)" ::: "memory");
            const unsigned og = xb_add(&bar[XB_TOP], 1u);
            const unsigned tg = og / nx;
            if (og + 1u == (tg + 1u) * nx) xb_add(&bar[XB_TOPGEN], 1u);
            else XB_SPIN(xb_ld(&bar[XB_TOPGEN]) == tg, bar);
            __builtin_amdgcn_fence(__ATOMIC_ACQUIRE, "agent");
            xb_add(&bar[XB_XGEN(b.x)], 1u);
            asm volatile("s_waitcnt vmcnt(0)" ::: "memory");
        } else {
            XB_SPIN(xb_ld(&bar[XB_XGEN(b.x)]) == gen, bar);
            __builtin_amdgcn_fence(__ATOMIC_ACQUIRE, "agent");
            asm volatile("s_waitcnt vmcnt(0)" ::: "memory");
        }
    }
    __syncthreads();
}

constexpr int CTL_BAR = 16384;
constexpr int MK_LDS = 163840;
constexpr int MK_ST_OFF = MK_LDS - 16;
static_assert(FF_LDS <= MK_ST_OFF && RT_LDS <= MK_ST_OFF && TB_OFF + TB_BYTES <= MK_ST_OFF && TB_OFF >= pg8::STAGE_BYTES, "LDS map");
static_assert(4 * (4096 + 4096 + 8448 + 16384) <= MK_ST_OFF, "prep LDS");
#ifndef MK_REP
#define MK_REP -1
#endif
constexpr int MK_PT_OFF = MK_ST_OFF - 256;
static_assert(RT_LDS <= MK_PT_OFF && TB_OFF + TB_BYTES <= MK_PT_OFF, "LDS map (pointer table)");
DI Params ldp(const unsigned char* lds) {
    Params p; unsigned long long* d = (unsigned long long*)&p; const unsigned* t = (const unsigned*)(lds + MK_PT_OFF);
#pragma unroll
    for (int i = 0; i < 32; ++i) { const unsigned lo = __builtin_amdgcn_readfirstlane(t[2 * i]), hi = __builtin_amdgcn_readfirstlane(t[2 * i + 1]); d[i] = ((unsigned long long)hi << 32) | lo; }
    return p;
}
#define TSTAMP(i) do { if (MK_TS1 >= 0 && bid == 0 && tidx() == 0) ((unsigned long long*)(lds + MK_PT_OFF - 256))[i] = __builtin_amdgcn_s_memrealtime(); } while (0)
#define RUNPH(k, body) do { { const Params p = ldp(lds); body; } if (MK_REP == (k)) { xcd_barrier(bar); { const Params p = ldp(lds); body; } } } while (0)
#ifdef MK_ONLY
__global__ void __launch_bounds__(NT, 2) only_kernel(Params p) {
    extern __shared__ __attribute__((aligned(16))) unsigned char lds[];
    const int bid = blockIdx.x, nb = gridDim.x;
    if (MK_ONLY == 1) phaseAB_prep(p, lds, bid, nb);
    if (MK_ONLY == 2) phase1b(p, lds, bid, nb);
    if (MK_ONLY == 3) phase2a_s5states(p, lds, bid, nb);
    if (MK_ONLY == 13) phase2b_scan(p, bid, nb);
    if (MK_ONLY == 4) phase2_fft(p, lds, bid, nb);
    if (MK_ONLY == 9) phase2c_s5out(p, lds, bid, nb);
    if (MK_ONLY == 5) phase3_glu(p, lds, bid, nb);
    if (MK_ONLY == 6) phase3_fin(p, lds, bid, nb);
    if (MK_ONLY == 7) phase4_out(p, lds, bid, nb);
    if (MK_ONLY == 8) phase5_route(p, lds, bid, nb);
    if (MK_ONLY == 10) { build_tiles(p, lds); phase6_gateup(p, lds, bid, nb); }
    if (MK_ONLY == 11) { build_tiles(p, lds); phase7_down(p, lds, bid, nb); }
    if (MK_ONLY == 12) { build_tiles(p, lds); phase8_final(p, lds, bid, nb); }
}
#endif
__global__ void __launch_bounds__(NT, 2) mega_kernel(Params pk) {
    extern __shared__ __attribute__((aligned(16))) unsigned char lds[];
    const int bid = blockIdx.x, nb = gridDim.x;
    static_assert(sizeof(Params) == 256, "Params = 32 pointers");
    if (tidx() < 64) ((unsigned*)(lds + MK_PT_OFF))[tidx()] = ((const unsigned*)&pk)[tidx()];
    if (tidx() < 4) ((unsigned*)(lds + MK_ST_OFF))[tidx()] = 0u;
    __syncthreads();
    XcdBarrier bar;
    { const Params p = ldp(lds); bar = xcd_barrier_post((unsigned*)(p.ws + WS_CTL + CTL_BAR), (volatile LAS unsigned*)(lds + MK_ST_OFF)); }
    TSTAMP(0);
    TSTAMP(1);
    RUNPH(-2, phaseAB_prep(p, lds, bid, nb));     xcd_barrier(bar); TSTAMP(2);
    RUNPH(2, phase1b(p, lds, bid, nb));           xcd_barrier(bar); TSTAMP(3);
    RUNPH(3, phase2a_s5states(p, lds, bid, nb));  xcd_barrier(bar);
    RUNPH(13, phase2b_scan(p, bid, nb));
    RUNPH(4, phase2_fft(p, lds, bid, nb));        xcd_barrier(bar); TSTAMP(4);
    RUNPH(9, phase2c_s5out(p, lds, bid, nb));     xcd_barrier(bar); TSTAMP(5);
    RUNPH(6, phase3_fin(p, lds, bid, nb));
    RUNPH(5, phase3_glu(p, lds, bid, nb));        xcd_barrier(bar); TSTAMP(6); TSTAMP(7);
    RUNPH(7, phase4_out(p, lds, bid, nb));        xcd_barrier(bar); TSTAMP(8);
    RUNPH(-2, phase5_route(p, lds, bid, nb));     xcd_barrier(bar); TSTAMP(9);
    if (MK_REP == 8) { { const Params p = ldp(lds); phase5_route(p, lds, bid, nb, false); } xcd_barrier(bar); }
    if (MK_REP == 20) { xcd_barrier(bar); xcd_barrier(bar); xcd_barrier(bar); xcd_barrier(bar); }
    RUNPH(-2, build_tiles(p, lds));
    RUNPH(10, phase6_gateup(p, lds, bid, nb));    xcd_barrier(bar); TSTAMP(10);
    RUNPH(11, phase7_down(p, lds, bid, nb));      xcd_barrier(bar); TSTAMP(11);
    if (MK_TS1 >= 0) { if (bid == 0 && tidx() == 0) { const unsigned long long* ts = (const unsigned long long*)(lds + MK_PT_OFF - 256); const Params p = ldp(lds); unsigned* o = (unsigned*)(p.ws + WS_CTL + CTL_TS);
            o[0] = (unsigned)(ts[MK_TS1 + 1] - ts[MK_TS1]); o[1] = MK_TS2 >= 0 ? (unsigned)(ts[MK_TS2 + 1] - ts[MK_TS2]) : 0u; } xcd_barrier(bar); }
    RUNPH(-2, phase8_final(p, lds, bid, nb));
}

extern "C" void kernel_launch(void* const* d_in, const int* in_sizes, int n_in, void* d_out, int out_size, void* d_ws, size_t ws_size, hipStream_t stream) {
    static int grid = 0;
    if (grid == 0) {
        if (n_in != 30 || ws_size < WS_END || out_size != NTOK * D) { fprintf(stderr, "kernel_launch: unexpected inputs (n_in %d, ws %zu, out %d)\n", n_in, ws_size, out_size); grid = -1; return; }
        int dev = 0, cus = 0, per_cu = 0;
        if (hipGetDevice(&dev) != hipSuccess || hipDeviceGetAttribute(&cus, hipDeviceAttributeMultiprocessorCount, dev) != hipSuccess) { grid = -1; return; }
        if (hipFuncSetAttribute((const void*)mega_kernel, hipFuncAttributeMaxDynamicSharedMemorySize, MK_LDS) != hipSuccess) { fprintf(stderr, "kernel_launch: hipFuncSetAttribute failed\n"); grid = -1; return; }
        if (hipOccupancyMaxActiveBlocksPerMultiprocessor(&per_cu, (const void*)mega_kernel, NT, MK_LDS) != hipSuccess || per_cu < 1) { fprintf(stderr, "kernel_launch: occupancy query says %d blocks/CU\n", per_cu); (void)hipGetLastError(); grid = -1; return; }
        grid = cus;
    }
    if (grid < 0) return;
    Params p{};
    const float** f = (const float**)&p;
    for (int i = 0; i < 30; ++i) f[i] = (const float*)d_in[i];
    p.out = (float*)d_out; p.ws = (unsigned char*)d_ws;
    (void)hipMemsetAsync((char*)d_ws + WS_CTL, 0, CTL_BYTES, stream);
    hipLaunchKernelGGL(mega_kernel, dim3(grid), dim3(NT), MK_LDS, stream, p);
}
```

```cpp
#include <hip/hip_runtime.h>
#include <cstdio>
#include <cstdint>

typedef unsigned short bf16;
typedef short bf16x8 __attribute__((ext_vector_type(8)));
typedef short bf16x4 __attribute__((ext_vector_type(4)));
typedef float f32x4 __attribute__((ext_vector_type(4)));
typedef unsigned u32x4 __attribute__((ext_vector_type(4)));
typedef unsigned u32x2 __attribute__((ext_vector_type(2)));
typedef __bf16 bf16v2 __attribute__((ext_vector_type(2)));
#define DI __device__ __forceinline__

constexpr int D = 1024, NB = 8, L = 4096, CTX = 256, NTOK = NB * L, NCTX = NB * CTX, NROWS1 = NTOK + NCTX;
constexpr int NEXP = 32, DE = 256;
constexpr float EPS = 1e-6f;
constexpr int NT = 512;

constexpr size_t MiB = 1u << 20;
constexpr size_t WS_CTL = 0;
constexpr size_t CTL_BYTES = 1 * MiB;
constexpr size_t CTL_ZERO = 4096;
#ifndef MK_TS1
#define MK_TS1 -1
#endif
#ifndef MK_TS2
#define MK_TS2 -1
#endif
constexpr size_t CTL_TS = 12288;
constexpr size_t CTL_FLAGA = 12800;
constexpr size_t CTL_WQ = 12544;
constexpr size_t CTL_ECNT = 8192;
constexpr size_t CTL_PCNT = 8192 + 256;
constexpr size_t CTL_RSQ1 = 256 * 1024;
constexpr size_t CTL_RSQ2 = 384 * 1024;
constexpr size_t WS_MOD = 1 * MiB;
constexpr size_t WS_TILES = WS_MOD + 256 * 1024;
constexpr size_t WS_ABART = WS_TILES + 64 * 1024;
constexpr size_t WS_FFTC = 2 * MiB;
constexpr size_t WS_GW = 3 * MiB;
constexpr size_t WS_WINT = 4 * MiB;
constexpr size_t WS_WGLUT = 7 * MiB;
constexpr size_t WS_WOUTT = 8 * MiB;
constexpr size_t WS_WGUT = 10 * MiB;
constexpr size_t WS_WDT = 42 * MiB;
constexpr size_t WS_WST = 58 * MiB;
constexpr size_t WS_MGW = 66 * MiB;
constexpr size_t WS_ELIST = 90 * MiB;
constexpr size_t WS_ELCP = 94 * MiB;
constexpr size_t WS_ELW = 98 * MiB;
constexpr size_t WS_TCP = 102 * MiB;
constexpr size_t WS_R1 = 108 * MiB;
constexpr size_t WS_R2 = 176 * MiB;
constexpr size_t WS_R3 = 240 * MiB;
constexpr size_t WS_UCTX = 288 * MiB;
constexpr size_t WS_R4 = 290 * MiB;
constexpr size_t WS_R5 = 322 * MiB;
constexpr size_t WS_X1B = 290 * MiB;
constexpr size_t WS_A2 = 108 * MiB;
constexpr size_t WS_HS = 228 * MiB;
constexpr size_t WS_MOE = 108 * MiB;
constexpr size_t WS_RSQP1 = 354 * MiB;
constexpr size_t WS_RSQS = 356 * MiB;
constexpr size_t WS_RSS = 357 * MiB;
constexpr size_t WS_ETAB = 357 * MiB + 512 * 1024;
constexpr size_t WS_WRT = 358 * MiB;
constexpr size_t WS_END = 359 * MiB;

struct Params {
    const float *x, *c, *ctx, *c_ctx, *w_ada, *b_ada, *norm1_g, *norm2_g, *w_in;
    const float *lam_re, *lam_im, *b_re, *b_im, *c_re, *c_im, *log_step, *s5_d, *w_glu, *fourier_w, *g_s, *g_f, *w_out;
    const float *w_group, *b_group, *w_router, *b_router, *w_gate, *w_up, *w_down, *final_g;
    float* out; unsigned char* ws;
};

DI int tidx() { int t = threadIdx.x; asm volatile("" : "+v"(t)); return t; }
DI unsigned pk2(float lo, float hi) { bf16v2 v; v.x = (__bf16)lo; v.y = (__bf16)hi; return __builtin_bit_cast(unsigned, v); }
typedef int i32x4 __attribute__((ext_vector_type(4)));
typedef int i32x8 __attribute__((ext_vector_type(8)));
DI unsigned pk4_fp8(float a, float b, float c, float d) { int w = 0; w = __builtin_amdgcn_cvt_pk_fp8_f32(a, b, w, false); w = __builtin_amdgcn_cvt_pk_fp8_f32(c, d, w, true); return (unsigned)w; }
DI float bf2f(unsigned short b) { return __uint_as_float(((unsigned)b) << 16); }
DI float wave_sum(float v) {
#pragma unroll
    for (int o = 1; o < 64; o <<= 1) v += __shfl_xor(v, o);
    return v;
}
DI float sigmoidf_(float x) { return 1.f / (1.f + __expf(-x)); }
DI float siluf_(float x) { return x / (1.f + __expf(-x)); }
DI float geluf_(float x) { const float u = 0.7978845608028654f * (x + 0.044715f * x * x * x); return x / (1.f + __expf(-2.f * u)); }

template <int MT> struct GC {
    static constexpr int BM = 64 * MT, PA = MT, ABYTES = BM * 128, BBYTES = 128 * 128, BUF = ABYTES + BBYTES, LDS = 2 * BUF;
};
template <int MT>
DI void gemm_loop(f32x4 (&acc)[MT][4], const bf16* (&ap)[MT], const int (&as)[MT], const bf16* (&bp)[2], int nk, unsigned char* lds) {
    typedef GC<MT> G;
    const int tid = tidx(), lane = tid & 63, wid = tid >> 6, wm = wid >> 1, wn = wid & 1, fr = lane & 15, fq = lane >> 4;
    const int srow = tid >> 3, sck = tid & 7;
    const int soff = srow * 128 + ((sck ^ (srow & 7)) << 4);
    u32x4 ra[MT], rb[2];
#pragma unroll
    for (int i = 0; i < MT; ++i) ra[i] = *(const u32x4*)(ap[i]);
#pragma unroll
    for (int i = 0; i < 2; ++i) rb[i] = *(const u32x4*)(bp[i]);
#pragma unroll
    for (int i = 0; i < MT; ++i) *(u32x4*)(lds + i * 8192 + soff) = ra[i];
#pragma unroll
    for (int i = 0; i < 2; ++i) *(u32x4*)(lds + G::ABYTES + i * 8192 + soff) = rb[i];
    __syncthreads();
    const int aro = (wm * MT * 16 + fr) * 128, bro = (wn * 64 + fr) * 128;
    const int sw0 = ((0 + fq) ^ (fr & 7)) << 4, sw1 = ((4 + fq) ^ (fr & 7)) << 4;
    for (int kt = 0; kt < nk; ++kt) {
        const bool more = kt + 1 < nk;
        if (more) {
#pragma unroll
            for (int i = 0; i < MT; ++i) ra[i] = *(const u32x4*)(ap[i] + (size_t)(kt + 1) * as[i]);
#pragma unroll
            for (int i = 0; i < 2; ++i) rb[i] = *(const u32x4*)(bp[i] + (size_t)(kt + 1) * 64);
        }
        const unsigned char* Ab = lds + (kt & 1) * G::BUF; const unsigned char* Bb = Ab + G::ABYTES;
#pragma unroll
        for (int kk = 0; kk < 2; ++kk) {
            const int sw = kk ? sw1 : sw0;
            bf16x8 af[MT], bfr[4];
#pragma unroll
            for (int mt = 0; mt < MT; ++mt) af[mt] = *(const bf16x8*)(Ab + aro + mt * 2048 + sw);
#pragma unroll
            for (int nt = 0; nt < 4; ++nt) bfr[nt] = *(const bf16x8*)(Bb + bro + nt * 2048 + sw);
#pragma unroll
            for (int mt = 0; mt < MT; ++mt)
#pragma unroll
                for (int nt = 0; nt < 4; ++nt) acc[mt][nt] = __builtin_amdgcn_mfma_f32_16x16x32_bf16(bfr[nt], af[mt], acc[mt][nt], 0, 0, 0);
        }
        if (more) {
            unsigned char* nb = lds + ((kt + 1) & 1) * G::BUF;
#pragma unroll
            for (int i = 0; i < MT; ++i) *(u32x4*)(nb + i * 8192 + soff) = ra[i];
#pragma unroll
            for (int i = 0; i < 2; ++i) *(u32x4*)(nb + G::ABYTES + i * 8192 + soff) = rb[i];
        }
        __syncthreads();
    }
}
template <int MT>
DI void gemm_loop_alds(f32x4 (&acc)[MT][4], const unsigned char* abase, int apitch, const bf16* (&bp)[2], int nk, unsigned char* lds) {
    typedef GC<MT> G;
    const int tid = tidx(), lane = tid & 63, wid = tid >> 6, wm = wid >> 1, wn = wid & 1, fr = lane & 15, fq = lane >> 4;
    const int srow = tid >> 3, sck = tid & 7;
    const int soff = srow * 128 + ((sck ^ (srow & 7)) << 4);
    u32x4 rb[2];
#pragma unroll
    for (int i = 0; i < 2; ++i) rb[i] = *(const u32x4*)(bp[i]);
#pragma unroll
    for (int i = 0; i < 2; ++i) *(u32x4*)(lds + G::ABYTES + i * 8192 + soff) = rb[i];
    __syncthreads();
    const int bro = (wn * 64 + fr) * 128;
    const int sw0 = ((0 + fq) ^ (fr & 7)) << 4, sw1 = ((4 + fq) ^ (fr & 7)) << 4;
    const unsigned char* arow = abase + (size_t)(wm * MT * 16 + fr) * apitch + fq * 16;
    for (int kt = 0; kt < nk; ++kt) {
        const bool more = kt + 1 < nk;
        if (more) {
#pragma unroll
            for (int i = 0; i < 2; ++i) rb[i] = *(const u32x4*)(bp[i] + (size_t)(kt + 1) * 64);
        }
        const unsigned char* Bb = lds + (kt & 1) * G::BUF + G::ABYTES;
#pragma unroll
        for (int kk = 0; kk < 2; ++kk) {
            const int sw = kk ? sw1 : sw0;
            bf16x8 af[MT], bfr[4];
#pragma unroll
            for (int mt = 0; mt < MT; ++mt) af[mt] = *(const bf16x8*)(arow + (size_t)mt * 16 * apitch + kt * 128 + kk * 64);
#pragma unroll
            for (int nt = 0; nt < 4; ++nt) bfr[nt] = *(const bf16x8*)(Bb + bro + nt * 2048 + sw);
#pragma unroll
            for (int mt = 0; mt < MT; ++mt)
#pragma unroll
                for (int nt = 0; nt < 4; ++nt) acc[mt][nt] = __builtin_amdgcn_mfma_f32_16x16x32_bf16(bfr[nt], af[mt], acc[mt][nt], 0, 0, 0);
        }
        if (more) {
            unsigned char* nb = lds + ((kt + 1) & 1) * G::BUF;
#pragma unroll
            for (int i = 0; i < 2; ++i) *(u32x4*)(nb + G::ABYTES + i * 8192 + soff) = rb[i];
        }
        __syncthreads();
    }
}
template <int MT> DI void zero_acc(f32x4 (&acc)[MT][4]) {
#pragma unroll
    for (int m = 0; m < MT; ++m)
#pragma unroll
        for (int n = 0; n < 4; ++n) acc[m][n] = (f32x4){0.f, 0.f, 0.f, 0.f};
}

namespace pg8 {
#define PG8_LAS __attribute__((address_space(3)))
constexpr int BM = 256, BK = 64, HALF = 128, HTB = HALF * BK * 2, STAGE_BYTES = 8 * HTB;
DI int lds_byte(int r, int c) { const int st = (r >> 4) * 2 + (c >> 5), rr = r & 15, cc = c & 31, ob = rr * 64 + cc * 2; return st * 1024 + (ob ^ (((ob >> 9) & 1) << 5)); }
DI int perm32(int rho) { const int n = rho >> 4, i = rho & 15; return 8 * (i >> 2) + 4 * n + (i & 3); }
DI void stage_rc(int b, int& R, int& C) { const int st = b / 1024, sb = b % 1024, swz = sb ^ (((sb >> 9) & 1) << 5); R = (st >> 1) * 16 + swz / 64; C = (st & 1) * 32 + (swz % 64) / 2; }
struct UPtr { const char *a0, *a1, *b0, *b1, *c0, *c1; };
template <class Pol, class Epi, bool ALIGN_EPI>
DI void gemm_phase(PG8_LAS unsigned char* lds, const Pol& P, const Epi& E) {
    typedef typename Pol::Unit Unit;
    const int tid = tidx(), wid = __builtin_amdgcn_readfirstlane(tid >> 6), lane = tid & 63, wr = wid >> 2, wc = wid & 3, fr = lane & 15, fq = lane >> 4;
    const int nt = P.K / BK, ksplit = P.ksplit;
    int Rr[2], Cc[2]; unsigned voffB[2];
#pragma unroll
    for (int i = 0; i < 2; ++i) { stage_rc(tid * 16 + i * 8192, Rr[i], Cc[i]); voffB[i] = (unsigned)(P.brow((Rr[i] & ~31) + perm32(Rr[i] & 31)) * P.ldb + Cc[i]) * 2u; }
    unsigned c00 = P.aoff(Rr[0], Cc[0]), c01 = P.aoff(Rr[1], Cc[1]), c10 = c00, c11 = c01, n00 = c00, n01 = c01, n10 = c00, n11 = c01;
#define PG8_STAGE2(bufoff, gbase, o0, o1) do { \
        __builtin_amdgcn_global_load_lds((const unsigned*)((const char*)(gbase) + (o0)), (PG8_LAS unsigned*)(lds + (bufoff) + ldsw), 16, 0, 0); \
        __builtin_amdgcn_global_load_lds((const unsigned*)((const char*)(gbase) + (o1)), (PG8_LAS unsigned*)(lds + (bufoff) + ldsw + 8192), 16, 0, 0); } while (0)
    const size_t kstep = (size_t)(BK * 2);
    const size_t kstepA = Pol::KSTEP_A ? (size_t)Pol::KSTEP_A : kstep;
    const unsigned ldsw = (unsigned)wid * 1024u;
    const int aoff = lds_byte(wr * 64 + fr, fq * 8), boff = lds_byte(wc * 32 + fr, fq * 8);
#define PG8_SA(b, h) (((b) * 2 + (h)) * HTB)
#define PG8_SB(b, h) ((4 + (b) * 2 + (h)) * HTB)
#define PG8_STAGE(bufoff, gbase, voff) do { _Pragma("unroll") for (int _i = 0; _i < 2; ++_i) \
        __builtin_amdgcn_global_load_lds((const unsigned*)((const char*)(gbase) + (voff)[_i]), (PG8_LAS unsigned*)(lds + (bufoff) + ldsw + _i * 8192), 16, 0, 0); } while (0)
#define PG8_LDA(dst, b, h) do { _Pragma("unroll") for (int m = 0; m < 4; ++m) _Pragma("unroll") for (int k = 0; k < 2; ++k) dst[m][k] = *(const PG8_LAS bf16x8*)(lds + PG8_SA(b, h) + aoff + m * 2048 + k * 1024); } while (0)
#define PG8_LDB(dst, b, h) do { _Pragma("unroll") for (int n = 0; n < 2; ++n) _Pragma("unroll") for (int k = 0; k < 2; ++k) dst[n][k] = *(const PG8_LAS bf16x8*)(lds + PG8_SB(b, h) + boff + n * 2048 + k * 1024); } while (0)
#define PG8_MMA(ai, bj, At, Bt) do { __builtin_amdgcn_s_setprio(1); _Pragma("unroll") for (int m = 0; m < 4; ++m) _Pragma("unroll") for (int n = 0; n < 2; ++n) _Pragma("unroll") for (int k = 0; k < 2; ++k) \
        acc[ai][bj][m][n] = __builtin_amdgcn_mfma_f32_16x16x32_bf16(Bt[n][k], At[m][k], acc[ai][bj][m][n], 0, 0, 0); __builtin_amdgcn_s_setprio(0); } while (0)
#define PG8_LDA8(dst, b, h) do { _Pragma("unroll") for (int m = 0; m < 4; ++m) dst[m] = __builtin_shufflevector(*(const PG8_LAS i32x4*)(lds + PG8_SA(b, h) + aoff + m * 2048), *(const PG8_LAS i32x4*)(lds + PG8_SA(b, h) + aoff + m * 2048 + 1024), 0, 1, 2, 3, 4, 5, 6, 7); } while (0)
#define PG8_LDB8(dst, b, h) do { _Pragma("unroll") for (int n = 0; n < 2; ++n) dst[n] = __builtin_shufflevector(*(const PG8_LAS i32x4*)(lds + PG8_SB(b, h) + boff + n * 2048), *(const PG8_LAS i32x4*)(lds + PG8_SB(b, h) + boff + n * 2048 + 1024), 0, 1, 2, 3, 4, 5, 6, 7); } while (0)
#define PG8_MMA8(ai, bj, A8_, B8_) do { __builtin_amdgcn_s_setprio(1); _Pragma("unroll") for (int m = 0; m < 4; ++m) _Pragma("unroll") for (int n = 0; n < 2; ++n) \
        asm volatile("v_mfma_scale_f32_16x16x128_f8f6f4 %0, %1, %2, %0, %3, %3 op_sel_hi:[0,0,0]" : "+v"(acc[ai][bj][m][n]) : "v"(B8_[n]), "v"(A8_[m]), "v"(one8)); __builtin_amdgcn_s_setprio(0); } while (0)
#define PG8_MM(ai, bj, sel) do { if constexpr (Pol::FP8) PG8_MMA8(ai, bj, A8, sel##8); else PG8_MMA(ai, bj, At, sel); } while (0)
#define PG8_RDA(b, h) do { if constexpr (Pol::FP8) PG8_LDA8(A8, b, h); else PG8_LDA(At, b, h); } while (0)
#define PG8_RDB(sel, b, h) do { if constexpr (Pol::FP8) PG8_LDB8(sel##8, b, h); else PG8_LDB(sel, b, h); } while (0)
#define PG8_WAIT_V(n) asm volatile("s_waitcnt vmcnt(" #n ")" ::: "memory")
#define PG8_WAIT_L(n) asm volatile("s_waitcnt lgkmcnt(" #n ")" ::: "memory")
#define PG8_BAR __builtin_amdgcn_s_barrier()
#define PG8_SCHED __builtin_amdgcn_sched_barrier(0)
#define PG8_BSEL(q, tk, h) ((tk) < ksplit ? (q).b##h + (size_t)(tk) * kstep : (q).c##h + (size_t)((tk) - ksplit) * kstep)
    Unit cur, nxt; UPtr cp, np_; int ui = 0;
    if (!P.next(0, cur)) return;
    P.ptrs(cur, cp);
    if constexpr (Pol::GATHER) P.gather(cur, Rr, Cc, c00, c01, c10, c11);
    f32x4 acc[2][2][4][2];
#pragma unroll
    for (int a = 0; a < 2; ++a)
#pragma unroll
        for (int b = 0; b < 2; ++b)
#pragma unroll
            for (int m = 0; m < 4; ++m)
#pragma unroll
                for (int n = 0; n < 2; ++n) acc[a][b][m][n] = (f32x4){0.f, 0.f, 0.f, 0.f};
    const int one8 = 0x7f7f7f7f;
    bf16x8 At[4][2], B0[2][2], B1[2][2]; i32x8 A8[4], B08[2], B18[2];
    PG8_STAGE(PG8_SB(0, 0), cp.b0, voffB); PG8_STAGE(PG8_SB(0, 1), cp.b1, voffB); PG8_STAGE2(PG8_SA(0, 0), cp.a0, c00, c01); PG8_STAGE2(PG8_SA(0, 1), cp.a1, c10, c11);
    if (wr == 1) PG8_BAR;
    PG8_WAIT_V(2); PG8_BAR;
    PG8_STAGE(PG8_SB(1, 0), cp.b0 + kstep, voffB); PG8_STAGE2(PG8_SA(1, 0), cp.a0 + kstepA, c00, c01); PG8_STAGE(PG8_SB(1, 1), cp.b1 + kstep, voffB);
    PG8_WAIT_V(6); PG8_BAR;
    for (;;) {
        const bool has_next = P.next(ui + 1, nxt);
        if (has_next) { P.ptrs(nxt, np_); if constexpr (Pol::GATHER) P.gather(nxt, Rr, Cc, n00, n01, n10, n11); }
        else { np_ = cp; if constexpr (Pol::GATHER) { n00 = c00; n01 = c01; n10 = c10; n11 = c11; } }
#pragma unroll 1
        for (int t = 0; t < nt; t += 2) {
            const bool last = (t == nt - 2);
            int hf = __builtin_amdgcn_readfirstlane(P.half(cur) ? 1 : 0); asm volatile("" : "+s"(hf));
            if constexpr (Epi::MIDK_T >= 0) { if (t == Epi::MIDK_T) E.midk(acc, cur, wr, wc, fr, fq); }
            const char* a1_1 = cp.a1 + (size_t)(t + 1) * kstepA;
            const char *a2_0, *a2_1, *a3_0, *b2_0, *b2_1, *b3_0, *b3_1;
            if (!last) { a2_0 = cp.a0 + (size_t)(t + 2) * kstepA; a2_1 = cp.a1 + (size_t)(t + 2) * kstepA; a3_0 = cp.a0 + (size_t)(t + 3) * kstepA;
                         b2_0 = PG8_BSEL(cp, t + 2, 0); b2_1 = PG8_BSEL(cp, t + 2, 1); b3_0 = PG8_BSEL(cp, t + 3, 0); b3_1 = PG8_BSEL(cp, t + 3, 1); }
            else { a2_0 = np_.a0; a2_1 = np_.a1; a3_0 = np_.a0 + kstepA; b2_0 = np_.b0; b2_1 = np_.b1; b3_0 = np_.b0 + kstep; b3_1 = np_.b1 + kstep; }
            const unsigned s00 = (Pol::GATHER && last) ? n00 : c00, s01 = (Pol::GATHER && last) ? n01 : c01, s10 = (Pol::GATHER && last) ? n10 : c10, s11 = (Pol::GATHER && last) ? n11 : c11;
            PG8_RDB(B0, 0, 0); PG8_RDB(B1, 0, 1); PG8_SCHED; PG8_RDA(0, 0); PG8_STAGE2(PG8_SA(1, 1), a1_1, c10, c11);
            PG8_WAIT_V(8); PG8_WAIT_L(0); PG8_BAR; PG8_MM(0, 0, B0); PG8_MM(0, 1, B1); PG8_BAR; PG8_SCHED;
            if (!hf) PG8_RDA(0, 1); PG8_STAGE(PG8_SB(0, 0), b2_0, voffB); PG8_STAGE(PG8_SB(0, 1), b2_1, voffB); PG8_STAGE2(PG8_SA(0, 0), a2_0, s00, s01);
            PG8_WAIT_V(8); PG8_WAIT_L(0); PG8_BAR; if (!hf) { PG8_MM(1, 0, B0); PG8_MM(1, 1, B1); } PG8_BAR; PG8_SCHED;
            PG8_RDB(B0, 1, 0); PG8_RDB(B1, 1, 1); PG8_SCHED; PG8_RDA(1, 0); PG8_STAGE2(PG8_SA(0, 1), a2_1, s10, s11);
            PG8_WAIT_V(8); PG8_WAIT_L(0); PG8_BAR; PG8_MM(0, 0, B0); PG8_MM(0, 1, B1); PG8_BAR; PG8_SCHED;
            if (!hf) PG8_RDA(1, 1); PG8_STAGE(PG8_SB(1, 0), b3_0, voffB); PG8_STAGE(PG8_SB(1, 1), b3_1, voffB); PG8_STAGE2(PG8_SA(1, 0), a3_0, s00, s01);
            PG8_WAIT_V(8); PG8_WAIT_L(0); PG8_BAR; if (!hf) { PG8_MM(1, 0, B0); PG8_MM(1, 1, B1); } PG8_BAR; PG8_SCHED;
        }
        if constexpr (ALIGN_EPI) { if (wr == 0) PG8_BAR; }
        E(acc, cur, wr, wc, fr, fq);
        if (!has_next) break;
#pragma unroll
        for (int a = 0; a < 2; ++a)
#pragma unroll
            for (int b = 0; b < 2; ++b)
#pragma unroll
                for (int m = 0; m < 4; ++m)
#pragma unroll
                    for (int n = 0; n < 2; ++n) acc[a][b][m][n] = (f32x4){0.f, 0.f, 0.f, 0.f};
        cur = nxt; cp = np_; ++ui;
        if constexpr (Pol::GATHER) { c00 = n00; c01 = n01; c10 = n10; c11 = n11; }
        if constexpr (ALIGN_EPI) { if (wr == 1) PG8_BAR; }
    }
    PG8_WAIT_V(0);
    if constexpr (!ALIGN_EPI) { if (wr == 0) PG8_BAR; }
    PG8_BAR;
#undef PG8_SA
#undef PG8_SB
#undef PG8_STAGE
#undef PG8_STAGE2
#undef PG8_LDA
#undef PG8_LDB
#undef PG8_MMA
#undef PG8_MMA8
#undef PG8_MM
#undef PG8_RDA
#undef PG8_RDB
#undef PG8_LDA8
#undef PG8_LDB8
#undef PG8_WAIT_V
#undef PG8_WAIT_L
#undef PG8_BAR
#undef PG8_SCHED
#undef PG8_BSEL
}
struct DenseOrder {
    int nM, nN, nwg, G, c;
    DI void init(int nM_, int nN_, int G_, int c_) { nM = nM_; nN = nN_; nwg = nM * nN; G = G_; c = c_; }
    DI bool get(int i, int& pm, int& pn) const {
        const long L = (long)i * G + c; if (L >= nwg) return false;
        int wgid = (int)L; { const int q = nwg / 8, r = nwg % 8, xcd = wgid % 8, off = wgid / 8; wgid = (xcd < r ? xcd * (q + 1) : r * (q + 1) + (xcd - r) * q) + off; }
        const int nig = 8 * nN, gid = wgid / nig, fm = gid * 8, gsz = (nM - fm) < 8 ? (nM - fm) : 8;
        pm = fm + ((wgid % nig) % gsz); pn = (wgid % nig) / gsz; return true;
    }
};
}

DI void adaln_item(const Params& p, unsigned char* lds, int item) {
    float* scond = (float*)lds;
    float* red = scond + 9 * 1024;
    const int tid = tidx();
    for (int i = tid; i < 9 * 1024; i += NT) { const int r = i >> 10, k = i & 1023; const float v = r < 8 ? p.c[r * 1024 + k] : p.c_ctx[k]; scond[i] = v / (1.f + __expf(-v)); }
    __syncthreads();
    const int cc = tid & 31, ks = tid >> 5, col = item * 32 + cc;
    float a[9];
#pragma unroll
    for (int r = 0; r < 9; ++r) a[r] = 0.f;
#pragma unroll 1
    for (int kb = 0; kb < 4; ++kb) {
        const int kbase = ks * 64 + kb * 16; float w[16];
#pragma unroll
        for (int u = 0; u < 16; ++u) w[u] = p.w_ada[(size_t)(kbase + u) * 6144 + col];
#pragma unroll
        for (int u = 0; u < 16; ++u)
#pragma unroll
            for (int r = 0; r < 9; ++r) a[r] += scond[r * 1024 + kbase + u] * w[u];
    }
#pragma unroll
    for (int r = 0; r < 9; ++r) red[(ks * 9 + r) * 32 + cc] = a[r];
    __syncthreads();
    float* mod = (float*)(p.ws + WS_MOD);
    for (int o = tid; o < 9 * 32; o += NT) { const int r = o >> 5, c2 = o & 31; float s = 0.f;
#pragma unroll
        for (int q = 0; q < 16; ++q) s += red[(q * 9 + r) * 32 + c2];
        mod[r * 6144 + item * 32 + c2] = s + p.b_ada[item * 32 + c2]; }
    __syncthreads();
}
DI void tp_tile(const float* src, int ld, int k0, int n0, unsigned char* lds, bf16* dst, int jobkind, int e, const float* kscale = nullptr) {
    const int lane = tidx() & 63, q = lane >> 4, c = lane & 15;
    f32x4 v[16];
#pragma unroll
    for (int i = 0; i < 16; ++i) v[i] = *(const f32x4*)(src + (size_t)(k0 + 16 * q + i) * ld + n0 + 4 * c);
    if (kscale) {
#pragma unroll
        for (int i = 0; i < 16; ++i) v[i] = v[i] * kscale[k0 + 16 * q + i]; }
#pragma unroll
    for (int j = 0; j < 4; ++j) { const int ng = n0 + 4 * c + j;
        u32x4 o0, o1;
        o0.x = pk2(v[0][j], v[1][j]); o0.y = pk2(v[2][j], v[3][j]); o0.z = pk2(v[4][j], v[5][j]); o0.w = pk2(v[6][j], v[7][j]);
        o1.x = pk2(v[8][j], v[9][j]); o1.y = pk2(v[10][j], v[11][j]); o1.z = pk2(v[12][j], v[13][j]); o1.w = pk2(v[14][j], v[15][j]);
        size_t drow; int K;
        switch (jobkind) {
          case 0: drow = ng; K = 1024; break;
          case 1: drow = ng; K = 512; break;
          case 2: drow = ng; K = 1024; break;
          case 3: case 4: { const int h = ng, R = (h >> 7) * 256 + (jobkind == 4 ? 128 : 0) + (h & 127); drow = (size_t)e * 512 + R; K = 1024; } break;
          default: drow = (size_t)e * 1024 + ng; K = 256; break;
        }
        if (jobkind == 3 || jobkind == 4) {
            u32x4 o8; o8.x = pk4_fp8(v[0][j] * 32.f, v[1][j] * 32.f, v[2][j] * 32.f, v[3][j] * 32.f); o8.y = pk4_fp8(v[4][j] * 32.f, v[5][j] * 32.f, v[6][j] * 32.f, v[7][j] * 32.f);
            o8.z = pk4_fp8(v[8][j] * 32.f, v[9][j] * 32.f, v[10][j] * 32.f, v[11][j] * 32.f); o8.w = pk4_fp8(v[12][j] * 32.f, v[13][j] * 32.f, v[14][j] * 32.f, v[15][j] * 32.f);
            *(u32x4*)((unsigned char*)dst + drow * 1024 + k0 + 16 * q) = o8;
        } else if (jobkind == 5) {
            u32x4 o8; o8.x = pk4_fp8(v[0][j] * 16.f, v[1][j] * 16.f, v[2][j] * 16.f, v[3][j] * 16.f); o8.y = pk4_fp8(v[4][j] * 16.f, v[5][j] * 16.f, v[6][j] * 16.f, v[7][j] * 16.f);
            o8.z = pk4_fp8(v[8][j] * 16.f, v[9][j] * 16.f, v[10][j] * 16.f, v[11][j] * 16.f); o8.w = pk4_fp8(v[12][j] * 16.f, v[13][j] * 16.f, v[14][j] * 16.f, v[15][j] * 16.f);
            *(u32x4*)((unsigned char*)dst + drow * 256 + k0 + 16 * q) = o8;
        } else {
        bf16* d = dst + drow * K + k0 + 16 * q;
        *(u32x4*)d = o0; *(u32x4*)(d + 8) = o1; } }
}
constexpr int TP_J0 = 16 * 8, TP_J1 = 8 * 8, TP_J2 = 16 * 16, TP_J3 = 32 * 16 * 4, TP_J4 = TP_J3, TP_J5 = 32 * 4 * 16;
constexpr int TP_ITEMS = TP_J0 + TP_J1 + TP_J2 + TP_J3 + TP_J4 + TP_J5;
DI void tp_item(const Params& p, unsigned char* lds, int it) {
    unsigned char* ws = p.ws;
    if (it < TP_J0) { tp_tile(p.w_in, 1024, (it >> 3) * 64, (it & 7) * 64, lds, (bf16*)(ws + WS_WINT), 0, 0); return; } it -= TP_J0;
    if (it < TP_J1) { tp_tile(p.w_glu, 512, (it >> 3) * 64, (it & 7) * 64, lds, (bf16*)(ws + WS_WGLUT), 1, 0); return; } it -= TP_J1;
    if (it < TP_J2) { tp_tile(p.w_out, 1024, (it >> 4) * 64, (it & 15) * 64, lds, (bf16*)(ws + WS_WOUTT), 2, 0, (it >> 4) * 64 < 512 ? p.g_s : nullptr); return; } it -= TP_J2;
    if (it < TP_J3) { const int e = it >> 6, r = it & 63; tp_tile(p.w_gate + (size_t)e * 1024 * 256, 256, (r >> 2) * 64, (r & 3) * 64, lds, (bf16*)(ws + WS_WGUT), 3, e); return; } it -= TP_J3;
    if (it < TP_J4) { const int e = it >> 6, r = it & 63; tp_tile(p.w_up + (size_t)e * 1024 * 256, 256, (r >> 2) * 64, (r & 3) * 64, lds, (bf16*)(ws + WS_WGUT), 4, e); return; } it -= TP_J4;
    { const int e = it >> 6, r = it & 63; tp_tile(p.w_down + (size_t)e * 256 * 1024, 1024, (r >> 4) * 64, (r & 15) * 64, lds, (bf16*)(ws + WS_WDT), 5, e); }
}
DI void gfold_item(const Params& p, unsigned char* lds, int item) {
    const int q = item >> 6, k0 = (item & 63) * 16, tid = tidx(), lane = tid & 63, wid = tid >> 6, fr = lane & 15, fq = lane >> 4;
    const bf16* E = (const bf16*)(p.ws + WS_ETAB); const bf16* fwT = E + 256 * 128 + (size_t)q * 128 * 128;
    bf16* Tl = (bf16*)lds;
    bf16x8 af[4];
#pragma unroll
    for (int ks = 0; ks < 4; ++ks) { const float* wp = p.w_in + (size_t)(k0 + fr) * 1024 + 512 + 128 * q + ks * 32 + 8 * fq; const f32x4 w0 = *(const f32x4*)wp, w1 = *(const f32x4*)(wp + 4);
        u32x4 t; t.x = pk2(w0.x, w0.y); t.y = pk2(w0.z, w0.w); t.z = pk2(w1.x, w1.y); t.w = pk2(w1.z, w1.w); af[ks] = __builtin_bit_cast(bf16x8, t); }
#pragma unroll
    for (int t2 = 0; t2 < 2; ++t2) { const int nt = wid * 2 + t2, c = nt >> 3; f32x4 d = (f32x4){0.f, 0.f, 0.f, 0.f};
#pragma unroll
        for (int ks = 0; ks < 4; ++ks) { const bf16x8 bfr = *(const bf16x8*)(E + (size_t)(nt * 16 + fr) * 128 + ks * 32 + 8 * fq); d = __builtin_amdgcn_mfma_f32_16x16x32_bf16(af[ks], bfr, d, 0, 0, 0); }
#pragma unroll
        for (int r = 0; r < 4; ++r) Tl[(c * 16 + 4 * fq + r) * 136 + (nt & 7) * 16 + fr] = (bf16)(pk2(d[r], 0.f) & 0xffffu); }
    __syncthreads();
    bf16* WinT = (bf16*)(p.ws + WS_WINT);
    const float scale = 1.0f / 724.0773439350247f;
    { const int c = wid >> 2;
      bf16x8 a2[4];
#pragma unroll
      for (int ks = 0; ks < 4; ++ks) a2[ks] = *(const bf16x8*)(Tl + (c * 16 + fr) * 136 + ks * 32 + 8 * fq);
#pragma unroll
      for (int t2 = 0; t2 < 2; ++t2) { const int jt = (wid & 3) * 2 + t2; f32x4 d = (f32x4){0.f, 0.f, 0.f, 0.f};
#pragma unroll
          for (int ks = 0; ks < 4; ++ks) { const bf16x8 bfr = *(const bf16x8*)(fwT + (size_t)(jt * 16 + fr) * 128 + ks * 32 + 8 * fq); d = __builtin_amdgcn_mfma_f32_16x16x32_bf16(bfr, a2[ks], d, 0, 0, 0); }
#pragma unroll
          for (int r = 0; r < 4; ++r) WinT[(size_t)(512 + c * 512 + q * 128 + jt * 16 + 4 * fq + r) * 1024 + k0 + fr] = (bf16)(pk2(d[r] * scale, 0.f) & 0xffffu); } }
    __syncthreads();
}
DI void s5mats_item(const Params& p, unsigned char* lds, int item) {
    const int g = item >> 3, part = item & 7;
    const int tid = tidx();
    float* Bb = (float*)lds;
    float* Cc = Bb + 4096;
    float* pw = Cc + 4096;
    float* Kt = pw + 8448;
    float* qv = Kt;
    if (tid < 128) { const int d = tid >> 6, pp = tid & 63;
        const double dt = exp((double)p.log_step[d * 32 + g]); const double lr = p.lam_re[(d * 32 + g) * 64 + pp], li = p.lam_im[(d * 32 + g) * 64 + pp];
        const double mag = exp(lr * dt); double tt = li * dt / 3.14159265358979323846; tt -= 2.0 * floor(tt * 0.5);
        double sn, cs; sincospi(tt, &sn, &cs); const double ar = mag * cs, ai = mag * sn;
        const double nr = ar - 1.0, ni = ai, den = lr * lr + li * li;
        qv[tid * 2] = (float)((nr * lr + ni * li) / den); qv[tid * 2 + 1] = (float)((ni * lr - nr * li) / den);
        double pr = 1.0, pi = 0.0;
        for (int k = 0; k < 33; ++k) { pw[(tid * 33 + k) * 2] = (float)pr; pw[(tid * 33 + k) * 2 + 1] = (float)pi; const double t2 = pr * ar - pi * ai; pi = pr * ai + pi * ar; pr = t2; } }
    __syncthreads();
    for (int idx = tid; idx < 2 * 64 * 16; idx += NT) { const int dp = idx >> 4, h = idx & 15; const float qr = qv[dp * 2], qi = qv[dp * 2 + 1];
        const int d = dp >> 6, pp = dp & 63;
        const float br = p.b_re[((size_t)(d * 32 + g) * 64 + pp) * 16 + h], bi = p.b_im[((size_t)(d * 32 + g) * 64 + pp) * 16 + h];
        Bb[idx * 2] = qr * br - qi * bi; Bb[idx * 2 + 1] = qr * bi + qi * br; }
    for (int idx = tid; idx < 2 * 16 * 64; idx += NT) { const int d = idx >> 10, i = (idx >> 6) & 15, pp = idx & 63;
        Cc[idx * 2] = p.c_re[((size_t)(d * 32 + g) * 16 + i) * 64 + pp]; Cc[idx * 2 + 1] = p.c_im[((size_t)(d * 32 + g) * 16 + i) * 64 + pp]; }
    __syncthreads();
    { const int t3 = tid >> 2, pq = tid & 3, d = t3 >> 6, k = (t3 >> 1) & 31, i = part * 2 + (t3 & 1);
      float acc[16];
#pragma unroll
      for (int h = 0; h < 16; ++h) acc[h] = 0.f;
      for (int pp = pq * 16; pp < pq * 16 + 16; ++pp) {
          const float cr = Cc[((d * 16 + i) * 64 + pp) * 2], ci = Cc[((d * 16 + i) * 64 + pp) * 2 + 1];
          const float wr = pw[((d * 64 + pp) * 33 + k) * 2], wi = pw[((d * 64 + pp) * 33 + k) * 2 + 1];
          const float xr = cr * wr - ci * wi, xi = cr * wi + ci * wr;
          const f32x4* bb = (const f32x4*)(Bb + (d * 64 + pp) * 32);
#pragma unroll
          for (int h2 = 0; h2 < 8; ++h2) { const f32x4 b2 = bb[h2]; acc[2 * h2] += xr * b2.x - xi * b2.y; acc[2 * h2 + 1] += xr * b2.z - xi * b2.w; } }
#pragma unroll
      for (int h = 0; h < 16; ++h) { acc[h] += __shfl_xor(acc[h], 1); acc[h] += __shfl_xor(acc[h], 2); }
      if (pq == 0) {
#pragma unroll
          for (int h4 = 0; h4 < 4; ++h4) *(f32x4*)(Kt + ((d * 32 + k) * 16 + i) * 16 + h4 * 4) = (f32x4){acc[h4 * 4], acc[h4 * 4 + 1], acc[h4 * 4 + 2], acc[h4 * 4 + 3]}; } }
    __syncthreads();
    bf16* Mg = (bf16*)(p.ws + WS_MGW) + (size_t)g * 512 * 768;
    for (int c4 = tid; c4 < 64 * 64; c4 += NT) { const int rq = c4 >> 6, c8 = c4 & 63, j = rq >> 1, i = part * 2 + (rq & 1), row = j * 16 + i, s = c8 >> 1, h0 = (c8 & 1) * 8; float v[8];
#pragma unroll
        for (int t = 0; t < 8; ++t) { float a = 0.f; if (s <= j) a += Kt[((0 * 32 + (j - s)) * 16 + i) * 16 + h0 + t]; if (s >= j) a += Kt[((1 * 32 + (s - j)) * 16 + i) * 16 + h0 + t]; v[t] = a; }
        u32x4 o; o.x = pk2(v[0], v[1]); o.y = pk2(v[2], v[3]); o.z = pk2(v[4], v[5]); o.w = pk2(v[6], v[7]);
        *(u32x4*)(Mg + (size_t)row * 768 + c8 * 8) = o; }
    bf16* Wst = (bf16*)(p.ws + WS_WST) + (size_t)g * 256 * 512;
    for (int c4 = tid; c4 < 32 * 64; c4 += NT) { const int r = part * 32 + (c4 >> 6), c8 = c4 & 63, s = c8 >> 1, h0 = (c8 & 1) * 8, d = r >> 7, c = r & 1, pp = (r >> 1) & 63;
        const int e = d == 0 ? 31 - s : s; const float wr = pw[((d * 64 + pp) * 33 + e) * 2], wi = pw[((d * 64 + pp) * 33 + e) * 2 + 1]; float v[8];
#pragma unroll
        for (int t = 0; t < 8; ++t) { const float br = Bb[((d * 64 + pp) * 16 + h0 + t) * 2], bi = Bb[((d * 64 + pp) * 16 + h0 + t) * 2 + 1]; v[t] = c == 0 ? wr * br - wi * bi : wr * bi + wi * br; }
        u32x4 o; o.x = pk2(v[0], v[1]); o.y = pk2(v[2], v[3]); o.z = pk2(v[4], v[5]); o.w = pk2(v[6], v[7]);
        *(u32x4*)(Wst + (size_t)r * 512 + c8 * 8) = o; }
    bf16* Wos = (bf16*)(p.ws + WS_MGW) + (size_t)g * 512 * 768 + 512;
    for (int c4 = tid; c4 < 64 * 32; c4 += NT) { const int rq = c4 >> 5, c8 = c4 & 31, j = rq >> 1, i = part * 2 + (rq & 1), row = j * 16 + i, col0 = c8 * 8, d = col0 >> 7, p0 = (col0 >> 1) & 63;
        const int e = d == 0 ? j + 1 : 32 - j; float v[8];
#pragma unroll
        for (int t = 0; t < 8; ++t) { const int pp = p0 + (t >> 1), c = t & 1; const float cr = Cc[((d * 16 + i) * 64 + pp) * 2], ci = Cc[((d * 16 + i) * 64 + pp) * 2 + 1];
            const float wr = pw[((d * 64 + pp) * 33 + e) * 2], wi = pw[((d * 64 + pp) * 33 + e) * 2 + 1]; v[t] = c == 0 ? cr * wr - ci * wi : -(cr * wi + ci * wr); }
        u32x4 o; o.x = pk2(v[0], v[1]); o.y = pk2(v[2], v[3]); o.z = pk2(v[4], v[5]); o.w = pk2(v[6], v[7]);
        *(u32x4*)(Wos + (size_t)row * 768 + c8 * 8) = o; }
    float* aT = (float*)(p.ws + WS_ABART) + g * 256;
    if (part == 0 && tid < 128) { const int d = tid >> 6, pp = tid & 63; aT[tid * 2] = pw[((d * 64 + pp) * 33 + 32) * 2]; aT[tid * 2 + 1] = pw[((d * 64 + pp) * 33 + 32) * 2 + 1]; }
    __syncthreads();
}
DI void fftc_item(const Params& p, int item, int nitems) {
    const int tid = tidx();
    bf16* W1 = (bf16*)(p.ws + WS_FFTC);
    bf16* W2 = W1 + 128 * 128;
    float* tw = (float*)(p.ws + WS_FFTC + 32768 + 16384);
    for (int idx = item * NT + tid; idx < 128 * 128 + 4 * 64 * 32 + 4096; idx += nitems * NT) {
        if (idx < 16384) { const int n = idx >> 7, k = idx & 127, co = n >> 6, d = n & 63, ci = k >> 6, bq = k & 63; double s, c; sincospi((double)((d * bq) & 63) / 32.0, &s, &c);
            const float v = (ci == co) ? (float)c : (ci == 1 ? (float)s : (float)(-s)); W1[idx] = (bf16)(pk2(v, 0.f) & 0xffffu); }
        else if (idx < 16384 + 8192) { const int i2 = idx - 16384, s_ = i2 >> 11, cf = (i2 >> 5) & 63, slot = i2 & 31, gq = slot >> 3, jp = slot & 7;
            const int a = 16 * (2 * (s_ & 1) + (jp >> 2)) + 4 * gq + (jp & 3); double s, c; sincospi((double)((cf * a) & 63) / 32.0, &s, &c);
            W2[i2] = (bf16)(pk2((s_ >> 1) == 0 ? (float)c : (float)s, 0.f) & 0xffffu); }
        else { const int i3 = idx - 16384 - 8192, ln = i3 & 63, r = (i3 >> 6) & 3, mt = (i3 >> 8) & 3, nt = i3 >> 10; const int d = 16 * nt + (ln & 15), a = 16 * mt + 4 * (ln >> 4) + r;
            double s, c; sincospi((double)((d * a) & 4095) / 2048.0, &s, &c); tw[i3 * 2] = (float)c; tw[i3 * 2 + 1] = (float)s; }
    }
}
constexpr int P0_S5 = 256, P0_GF = 256;
constexpr int P0_ITEMS = P0_S5 + P0_GF;
DI void rw_item(const Params& p, int item, int nitems) {
    bf16* W = (bf16*)(p.ws + WS_WRT);
    for (int i = item * NT + tidx(); i < 48 * 1024; i += nitems * NT) { const int n = i >> 10, k = i & 1023; const float v = n < 4 ? p.w_group[k * 4 + n] : (n < 36 ? p.w_router[k * 32 + (n - 4)] : 0.f); W[i] = (bf16)(pk2(v, 0.f) & 0xffffu); }
}
DI void phaseA_adaln(const Params& p, unsigned char* lds, int bid, int nb) {
    for (int it = bid; it < 192 + 64; it += nb) {
        if (it < 192) { adaln_item(p, lds, it); continue; }
        const int t = it - 192, tid = tidx();
        bf16* E = (bf16*)(p.ws + WS_ETAB); bf16* fwT = E + 256 * 128;
        for (int i = t * NT + tid; i < 256 * 128; i += 64 * NT) { const int cn = i >> 7, m = i & 127, c = cn >> 7, n = cn & 127; double sv, cv; sincospi((double)((n * m) & 127) / 64.0, &sv, &cv);
            E[i] = (bf16)(pk2(c == 0 ? (float)cv : (float)(-sv), 0.f) & 0xffffu); }
        for (int i = t * NT + tid; i < 4 * 128 * 128; i += 64 * NT) { const int q = i >> 14, j = (i >> 7) & 127, n = i & 127; fwT[i] = (bf16)(pk2(p.fourier_w[((size_t)q * 128 + n) * 128 + j], 0.f) & 0xffffu); }
        fftc_item(p, t, 64); rw_item(p, t, 64);
    }
}
DI void a1_item(const Params& p, int r0) {
    const int lane = tidx() & 63;
    const float* mod = (const float*)(p.ws + WS_MOD);
    bf16* A1 = (bf16*)(p.ws + WS_R1);
    constexpr int RW = 4;
    const float* src = r0 < NTOK ? p.x + (size_t)r0 * D : p.ctx + (size_t)(r0 - NTOK) * D;
    const int mr = r0 < NTOK ? (r0 >> 12) : 8;
    f32x4 v[RW][4]; float s[RW];
#pragma unroll
    for (int q = 0; q < RW; ++q)
#pragma unroll
        for (int j = 0; j < 4; ++j) v[q][j] = ((const f32x4*)(src + (size_t)q * D) + lane)[64 * j];
    f32x4 gm[4], sh[4];
#pragma unroll
    for (int j = 0; j < 4; ++j) { const int k = lane * 4 + 256 * j; gm[j] = *(const f32x4*)(p.norm1_g + k) * (*(const f32x4*)(mod + mr * 6144 + 1024 + k) + 1.f); sh[j] = *(const f32x4*)(mod + mr * 6144 + k); }
#pragma unroll
    for (int q = 0; q < RW; ++q) { float t = 0.f;
#pragma unroll
        for (int j = 0; j < 4; ++j) t += (v[q][j].x * v[q][j].x + v[q][j].y * v[q][j].y) + (v[q][j].z * v[q][j].z + v[q][j].w * v[q][j].w);
        s[q] = t; }
#pragma unroll
    for (int o = 1; o < 64; o <<= 1) {
#pragma unroll
        for (int q = 0; q < RW; ++q) s[q] += __shfl_xor(s[q], o); }
#pragma unroll
    for (int q = 0; q < RW; ++q) { const float rs = rsqrtf(s[q] * (1.f / D) + EPS); u32x2* o = (u32x2*)(A1 + (size_t)(r0 + q) * D) + lane;
#pragma unroll
        for (int j = 0; j < 4; ++j) { const f32x4 h = v[q][j] * rs * gm[j] + sh[j]; u32x2 w; w.x = pk2(h.x, h.y); w.y = pk2(h.z, h.w); o[64 * j] = w; } }
}
constexpr int WI_A1 = NROWS1 / 4, WI_ALL = WI_A1 + TP_ITEMS;
DI void phaseAB_prep(const Params& p, unsigned char* lds, int bid, int nb) {
    phaseA_adaln(p, lds, bid, nb);
    unsigned* flag = (unsigned*)(p.ws + WS_CTL + CTL_FLAGA);
    asm volatile("s_waitcnt vmcnt(0)" ::: "memory");
    __syncthreads();
    if (tidx() == 0) { __builtin_amdgcn_fence(__ATOMIC_RELEASE, "agent"); asm volatile("s_waitcnt vmcnt(0)" ::: "memory"); (void)__hip_atomic_fetch_add(flag, 1u, __ATOMIC_RELAXED, __HIP_MEMORY_SCOPE_AGENT); }
    for (int it = bid; it < P0_S5; it += nb) s5mats_item(p, lds, it);
    if (tidx() == 0) { unsigned sp = 0; while (__hip_atomic_load(flag, __ATOMIC_RELAXED, __HIP_MEMORY_SCOPE_AGENT) < (unsigned)nb) { __builtin_amdgcn_s_sleep(2); if (++sp > (1u << 22)) break; }
        __builtin_amdgcn_fence(__ATOMIC_ACQUIRE, "agent"); asm volatile("s_waitcnt vmcnt(0)" ::: "memory"); }
    __syncthreads();
    for (int it = bid; it < P0_GF; it += nb) gfold_item(p, lds, it);
    __syncthreads();
    const int wid = tidx() >> 6;
    for (int it = bid * 8 + wid; it < WI_ALL; it += nb * 8) {
        if (it < WI_A1) a1_item(p, it * 4); else tp_item(p, lds, it - WI_A1);
    }
}

struct G1uPol {
    static constexpr bool FP8 = false;
    template <class U> DI bool half(const U&) const { return false; }
    static constexpr long KSTEP_A = 0;
    DI unsigned aoff(int R, int C) const { return (unsigned)(R * lda + C) * 2u; }
    struct Unit { int pm, pn; };
    static constexpr bool GATHER = false;
    pg8::DenseOrder ord; const char* A; const char* B; int K, ksplit, lda, ldb;
    DI bool next(int i, Unit& u) const { return ord.get(i, u.pm, u.pn); }
    DI void ptrs(const Unit& u, pg8::UPtr& q) const { q.a0 = A + (size_t)u.pm * 256 * lda * 2; q.a1 = q.a0 + (size_t)128 * lda * 2; q.b0 = B + (size_t)u.pn * 256 * ldb * 2; q.b1 = q.b0 + (size_t)128 * ldb * 2; q.c0 = q.b0; q.c1 = q.b1; }
    DI int brow(int R) const { return R; }
    DI void gather(const Unit&, int (&)[2], int (&)[2], unsigned&, unsigned&, unsigned&, unsigned&) const {}
};
struct G1uEpi {
    static constexpr int MIDK_T = -1;
    bf16* Ul;
    DI void operator()(const f32x4 (&acc)[2][2][4][2], const G1uPol::Unit& u, int wr, int wc, int fr, int fq) const {
#pragma unroll
        for (int ai = 0; ai < 2; ++ai)
#pragma unroll
            for (int m = 0; m < 4; ++m) { const int row = u.pm * 256 + ai * 128 + wr * 64 + m * 16 + fr, b = row >> 12, l = row & 4095;
#pragma unroll
                for (int bj = 0; bj < 2; ++bj) { const int c0 = u.pn * 256 + bj * 128 + wc * 32 + 8 * fq, g = c0 >> 4, h0 = c0 & 15;
                    const f32x4 a0 = acc[ai][bj][m][0], a1 = acc[ai][bj][m][1];
                    u32x4 w; w.x = pk2(a0[0], a0[1]); w.y = pk2(a0[2], a0[3]); w.z = pk2(a1[0], a1[1]); w.w = pk2(a1[2], a1[3]);
                    *(u32x4*)(Ul + (((size_t)g * 1024 + b * 128 + (l >> 5)) * 768 + (l & 31) * 16 + h0)) = w; } }
    }
};
struct G1gPol {
    static constexpr bool FP8 = false;
    template <class U> DI bool half(const U&) const { return false; }
    static constexpr long KSTEP_A = 0;
    DI unsigned aoff(int R, int C) const { return (unsigned)(R * lda + C) * 2u; }
    struct Unit { int pm, pn; };
    static constexpr bool GATHER = false;
    pg8::DenseOrder ord; const char* A; const char* B; int K, ksplit, lda, ldb;
    DI bool next(int i, Unit& u) const { return ord.get(i, u.pm, u.pn); }
    DI void ptrs(const Unit& u, pg8::UPtr& q) const { q.a0 = A + (size_t)u.pm * 256 * lda * 2; q.a1 = q.a0 + (size_t)128 * lda * 2;
        const int b = u.pn >> 4, a0 = (u.pn & 15) * 4; q.b0 = B + (size_t)(b * 4096 + a0) * ldb * 2; q.b1 = q.b0 + (size_t)2 * ldb * 2; q.c0 = q.b0; q.c1 = q.b1; }
    DI int brow(int R) const { return (R & 63) * 64 + (R >> 6); }
    DI void gather(const Unit&, int (&)[2], int (&)[2], unsigned&, unsigned&, unsigned&, unsigned&) const {}
};
struct G1gEpi {
    static constexpr int MIDK_T = -1;
    bf16* GT;
    DI void operator()(const f32x4 (&acc)[2][2][4][2], const G1gPol::Unit& u, int wr, int wc, int fr, int fq) const {
        const int b = u.pn >> 4, a0 = (u.pn & 15) * 4;
#pragma unroll
        for (int ai = 0; ai < 2; ++ai)
#pragma unroll
            for (int m = 0; m < 4; ++m) { const int mm = u.pm * 256 + ai * 128 + wr * 64 + m * 16 + fr, c = mm >> 9, ch = mm & 511;
                bf16* base = GT + (size_t)((b * 512 + ch) * 2 + c) * 4096;
#pragma unroll
                for (int bj = 0; bj < 2; ++bj) { const int a = a0 + 2 * bj + (wc >> 1), bq = 32 * (wc & 1) + 8 * fq;
                    const f32x4 v0 = acc[ai][bj][m][0], v1 = acc[ai][bj][m][1];
                    u32x4 w; w.x = pk2(v0[0], v0[1]); w.y = pk2(v0[2], v0[3]); w.z = pk2(v1[0], v1[1]); w.w = pk2(v1[2], v1[3]);
                    *(u32x4*)(base + a * 64 + bq) = w; } }
    }
};
DI void phase1b(const Params& p, unsigned char* lds, int bid, int nb) {
    { G1gPol P; P.ord.init(4, NTOK / 256, nb, bid); P.A = (const char*)(p.ws + WS_WINT) + (size_t)512 * 2048; P.B = (const char*)(p.ws + WS_R1); P.K = 1024; P.ksplit = 16; P.lda = 1024; P.ldb = 1024;
      G1gEpi E{(bf16*)(p.ws + WS_R2)};
      pg8::gemm_phase<G1gPol, G1gEpi, true>((PG8_LAS unsigned char*)lds, P, E); }
    { G1uPol P; P.ord.init(NTOK / 256, 2, nb, bid); P.A = (const char*)(p.ws + WS_R1); P.B = (const char*)(p.ws + WS_WINT); P.K = 1024; P.ksplit = 16; P.lda = 1024; P.ldb = 1024;
      G1uEpi E{(bf16*)(p.ws + WS_R3)};
      pg8::gemm_phase<G1uPol, G1uEpi, true>((PG8_LAS unsigned char*)lds, P, E); }
    { const int tid = tidx(), lane = tid & 63, wid = tid >> 6, fr = lane & 15, fq = lane >> 4;
      for (int item = bid; item < 256; item += nb) { const int g = item >> 3, b = item & 7;
          const bf16* A1c = (const bf16*)(p.ws + WS_R1) + (size_t)(NTOK + b * 256 + wid * 32) * D; const bf16* Wg = (const bf16*)(p.ws + WS_WINT) + (size_t)(g * 16) * D;
          f32x4 ca[2] = {(f32x4){0.f, 0.f, 0.f, 0.f}, (f32x4){0.f, 0.f, 0.f, 0.f}};
#pragma unroll 8
          for (int ks = 0; ks < 32; ++ks) { const bf16x8 bw = *(const bf16x8*)(Wg + (size_t)fr * D + ks * 32 + fq * 8);
              const bf16x8 a0 = *(const bf16x8*)(A1c + (size_t)fr * D + ks * 32 + fq * 8), a1 = *(const bf16x8*)(A1c + (size_t)(16 + fr) * D + ks * 32 + fq * 8);
              ca[0] = __builtin_amdgcn_mfma_f32_16x16x32_bf16(bw, a0, ca[0], 0, 0, 0); ca[1] = __builtin_amdgcn_mfma_f32_16x16x32_bf16(bw, a1, ca[1], 0, 0, 0); }
          bf16* Ucw = (bf16*)(p.ws + WS_R4) + ((size_t)g * 256 + b * 8 + wid) * 768;
#pragma unroll
          for (int mt = 0; mt < 2; ++mt) { u32x2 w; w.x = pk2(ca[mt][0], ca[mt][1]); w.y = pk2(ca[mt][2], ca[mt][3]); *(u32x2*)(Ucw + (size_t)(mt * 16 + fr) * 16 + 4 * fq) = w; } } }
}
struct S5aPol {
    static constexpr bool FP8 = false;
    template <class U> DI bool half(const U&) const { return false; }
    struct Unit { int g, mt; };
    static constexpr bool GATHER = false;
    static constexpr long KSTEP_A = 0;
    int G, c; const char* A; const char* Ac; const char* B; int K, ksplit, lda, ldb;
    DI unsigned aoff(int R, int C) const { return (unsigned)(R * lda + C) * 2u; }
    DI bool next(int i, Unit& u) const { const int L = i * G + c; if (L >= 160) return false; u.g = L / 5; u.mt = L % 5; return true; }
    DI void ptrs(const Unit& u, pg8::UPtr& q) const { q.a0 = u.mt < 4 ? A + ((size_t)u.g * 1024 + u.mt * 256) * lda * 2 : Ac + (size_t)u.g * 256 * lda * 2; q.a1 = q.a0 + (size_t)128 * lda * 2;
        q.b0 = B + (size_t)u.g * 256 * ldb * 2; q.b1 = q.b0 + (size_t)128 * ldb * 2; q.c0 = q.b0; q.c1 = q.b1; }
    DI int brow(int R) const { return R; }
    DI void gather(const Unit&, int (&)[2], int (&)[2], unsigned&, unsigned&, unsigned&, unsigned&) const {}
};
struct S5aEpi {
    static constexpr int MIDK_T = -1;
    bf16* S;
    DI void operator()(const f32x4 (&acc)[2][2][4][2], const S5aPol::Unit& u, int wr, int wc, int fr, int fq) const {
#pragma unroll
        for (int ai = 0; ai < 2; ++ai)
#pragma unroll
            for (int m = 0; m < 4; ++m) { bf16* dst = S + ((size_t)u.g * 1280 + u.mt * 256 + ai * 128 + wr * 64 + m * 16 + fr) * 256 + wc * 32 + 8 * fq;
#pragma unroll
                for (int bj = 0; bj < 2; ++bj) { const f32x4 v0 = acc[ai][bj][m][0], v1 = acc[ai][bj][m][1];
                    u32x4 w; w.x = pk2(v0[0], v0[1]); w.y = pk2(v0[2], v0[3]); w.z = pk2(v1[0], v1[1]); w.w = pk2(v1[2], v1[3]);
                    *(u32x4*)(dst + bj * 128) = w; } }
    }
};
DI void phase2a_s5states(const Params& p, unsigned char* lds, int bid, int nb) {
    S5aPol P; P.G = nb; P.c = bid; P.A = (const char*)(p.ws + WS_R3); P.Ac = (const char*)(p.ws + WS_R4); P.B = (const char*)(p.ws + WS_WST); P.K = 512; P.ksplit = 8; P.lda = 768; P.ldb = 512;
    S5aEpi E{(bf16*)(p.ws + WS_R1)};
    pg8::gemm_phase<S5aPol, S5aEpi, true>((PG8_LAS unsigned char*)lds, P, E);
}
DI void phase2b_scan(const Params& p, int bid, int nb) {
    const int lane = tidx() & 63, wid = tidx() >> 6;
    for (int item = bid + wid * nb; item < 512; item += nb * 8) {
        const int d = item & 1, gb = item >> 1, g = gb >> 3, b = gb & 7;
        const float* aT = (const float*)(p.ws + WS_ABART) + g * 256 + (d * 64 + lane) * 2; const float ar = aT[0], ai = aT[1];
        const unsigned* Sg = (const unsigned*)((const bf16*)(p.ws + WS_R1) + (size_t)g * 1280 * 256 + d * 128) + lane;
        unsigned* Hout = (unsigned*)((bf16*)(p.ws + WS_R3) + ((size_t)g * 1024 + b * 128) * 768 + 512 + d * 128) + lane;
        float hr = 0.f, hi = 0.f;
        { unsigned sv[8];
#pragma unroll
          for (int j = 0; j < 8; ++j) { const int c = d == 0 ? j : 7 - j; sv[j] = Sg[(size_t)(1024 + b * 8 + c) * 128]; }
#pragma unroll
          for (int j = 0; j < 8; ++j) { const float sr = __uint_as_float(sv[j] << 16), si = __uint_as_float(sv[j] & 0xffff0000u); const float nr = ar * hr - ai * hi + sr, ni = ar * hi + ai * hr + si; hr = nr; hi = ni; } }
#pragma unroll 1
        for (int cb = 0; cb < 128; cb += 32) { unsigned sv[32];
#pragma unroll
            for (int j = 0; j < 32; ++j) { const int c = d == 0 ? cb + j : 127 - cb - j; sv[j] = Sg[(size_t)(b * 128 + c) * 128]; }
#pragma unroll
            for (int j = 0; j < 32; ++j) { const int c = d == 0 ? cb + j : 127 - cb - j; Hout[(size_t)c * 384] = pk2(hr, hi);
                const float sr = __uint_as_float(sv[j] << 16), si = __uint_as_float(sv[j] & 0xffff0000u); const float nr = ar * hr - ai * hi + sr, ni = ar * hi + ai * hr + si; hr = nr; hi = ni; } }
    }
}
struct S5cPol {
    static constexpr bool FP8 = false;
    template <class U> DI bool half(const U&) const { return false; }
    static constexpr long KSTEP_A = 0;
    DI unsigned aoff(int R, int C) const { return (unsigned)(R * lda + C) * 2u; }
    struct Unit { int g, mt, pn; };
    static constexpr bool GATHER = false;
    int G, c; const char* A; const char* B; int K, ksplit, lda, ldb;
    DI bool next(int i, Unit& u) const { const int L = i * G + c; if (L >= 256) return false; u.g = L >> 3; u.mt = (L >> 1) & 3; u.pn = L & 1; return true; }
    DI void ptrs(const Unit& u, pg8::UPtr& q) const { q.a0 = A + ((size_t)u.g * 1024 + u.mt * 256) * lda * 2; q.a1 = q.a0 + (size_t)128 * lda * 2; q.b0 = B + ((size_t)u.g * 512 + u.pn * 256) * ldb * 2; q.b1 = q.b0 + (size_t)128 * ldb * 2; q.c0 = q.b0; q.c1 = q.b1; }
    DI int brow(int R) const { return R; }
    DI void gather(const Unit&, int (&)[2], int (&)[2], unsigned&, unsigned&, unsigned&, unsigned&) const {}
};
struct S5cEpi {
    static constexpr int MIDK_T = -1;
    const bf16* Ucat; const float* s5d; bf16* yact;
    DI void operator()(const f32x4 (&acc)[2][2][4][2], const S5cPol::Unit& u, int wr, int wc, int fr, int fq) const {
        const int n0 = u.pn * 256 + wc * 32 + 8 * fq, i0 = n0 & 15;
        const f32x4 d0 = *(const f32x4*)(s5d + u.g * 16 + i0), d1 = *(const f32x4*)(s5d + u.g * 16 + i0 + 4);
#pragma unroll
        for (int ai = 0; ai < 2; ++ai) {
            u32x4 uu[4][2];
#pragma unroll
            for (int m = 0; m < 4; ++m) { const int row = u.mt * 256 + ai * 128 + wr * 64 + m * 16 + fr;
#pragma unroll
                for (int bj = 0; bj < 2; ++bj) uu[m][bj] = *(const u32x4*)(Ucat + ((size_t)u.g * 1024 + row) * 768 + n0 + bj * 128); }
#pragma unroll
            for (int m = 0; m < 4; ++m) { const int row = u.mt * 256 + ai * 128 + wr * 64 + m * 16 + fr, b = row >> 7, c = row & 127;
#pragma unroll
                for (int bj = 0; bj < 2; ++bj) { const int col = n0 + bj * 128, l = 32 * c + (col >> 4); const u32x4 v = uu[m][bj]; const f32x4 a0 = acc[ai][bj][m][0], a1 = acc[ai][bj][m][1];
                    const float y0 = geluf_(a0[0] + d0.x * __uint_as_float(v.x << 16)), y1 = geluf_(a0[1] + d0.y * __uint_as_float(v.x & 0xffff0000u));
                    const float y2 = geluf_(a0[2] + d0.z * __uint_as_float(v.y << 16)), y3 = geluf_(a0[3] + d0.w * __uint_as_float(v.y & 0xffff0000u));
                    const float y4 = geluf_(a1[0] + d1.x * __uint_as_float(v.z << 16)), y5 = geluf_(a1[1] + d1.y * __uint_as_float(v.z & 0xffff0000u));
                    const float y6 = geluf_(a1[2] + d1.z * __uint_as_float(v.w << 16)), y7 = geluf_(a1[3] + d1.w * __uint_as_float(v.w & 0xffff0000u));
                    u32x4 w; w.x = pk2(y0, y1); w.y = pk2(y2, y3); w.z = pk2(y4, y5); w.w = pk2(y6, y7);
                    *(u32x4*)(yact + (((size_t)u.g * NTOK + b * 4096 + l) * 16 + i0)) = w; } }
            asm volatile("" ::: "memory");
        }
    }
};
DI void phase2c_s5out(const Params& p, unsigned char* lds, int bid, int nb) {
    S5cPol P; P.G = nb; P.c = (nb % 8 == 0) ? (bid % 8) * (nb / 8) + bid / 8 : bid; P.A = (const char*)(p.ws + WS_R3); P.B = (const char*)(p.ws + WS_MGW); P.K = 768; P.ksplit = 12; P.lda = 768; P.ldb = 768;
    S5cEpi E{(const bf16*)(p.ws + WS_R3), p.s5_d, (bf16*)(p.ws + WS_R4)};
    pg8::gemm_phase<S5cPol, S5cEpi, true>((PG8_LAS unsigned char*)lds, P, E);
}
constexpr int FF_W1P = 272, FF_W2P = 80, FF_W1_OFF = 0, FF_W2_OFF = 128 * FF_W1P, FF_TW_OFF = FF_W2_OFF + 4 * 64 * FF_W2P, FF_LDS = FF_TW_OFF + 32768;
DI void phase2_fft(const Params& p, unsigned char* lds, int bid, int nb) {
    const int tid = tidx(), lane = tid & 63, wid = tid >> 6, fr = lane & 15, fq = lane >> 4;
    { const bf16* W1 = (const bf16*)(p.ws + WS_FFTC); const bf16* W2 = W1 + 128 * 128; const float* tw = (const float*)(p.ws + WS_FFTC + 32768 + 16384);
      for (int i = tid; i < 128 * 16; i += NT) { const int n = i >> 4, c = i & 15; *(u32x4*)(lds + FF_W1_OFF + n * FF_W1P + c * 16) = *(const u32x4*)(W1 + n * 128 + c * 8); }
      for (int i = tid; i < 256 * 4; i += NT) { const int r = i >> 2, c = i & 3; *(u32x4*)(lds + FF_W2_OFF + r * FF_W2P + c * 16) = *(const u32x4*)(W2 + r * 32 + c * 8); }
      for (int i = tid; i < 2048; i += NT) *(u32x4*)(lds + FF_TW_OFF + i * 16) = *(const u32x4*)(tw + i * 4);
      __syncthreads(); }
    const bf16* GT = (const bf16*)(p.ws + WS_R2); bf16* FT = (bf16*)(p.ws + WS_R5);
    const float* twl = (const float*)(lds + FF_TW_OFF) + lane * 2;
    for (int cidx = bid * 8 + wid; cidx < 4096; cidx += nb * 8) {
        const bf16* gt = GT + (size_t)cidx * 2 * 4096;
        bf16* ft = FT + (size_t)cidx * 4096;
        bf16x8 afr[4][4];
#pragma unroll
        for (int ks = 0; ks < 4; ++ks)
#pragma unroll
            for (int mt = 0; mt < 4; ++mt) afr[ks][mt] = *(const bf16x8*)(gt + (ks >> 1) * 4096 + (16 * mt + fr) * 64 + 32 * (ks & 1) + 8 * fq);
        bf16x8 frag[4][4];
        __builtin_amdgcn_sched_barrier(0);
#pragma unroll
        for (int mh = 0; mh < 2; ++mh) {
            f32x4 d1[2][8];
#pragma unroll
            for (int m = 0; m < 2; ++m)
#pragma unroll
                for (int n = 0; n < 8; ++n) d1[m][n] = (f32x4){0.f, 0.f, 0.f, 0.f};
#pragma unroll
            for (int ks = 0; ks < 4; ++ks) {
#pragma unroll
                for (int nt = 0; nt < 8; ++nt) { const bf16x8 bfr = *(const bf16x8*)(lds + FF_W1_OFF + (nt * 16 + fr) * FF_W1P + (ks * 32 + fq * 8) * 2);
#pragma unroll
                    for (int m = 0; m < 2; ++m) d1[m][nt] = __builtin_amdgcn_mfma_f32_16x16x32_bf16(afr[ks][2 * mh + m], bfr, d1[m][nt], 0, 0, 0); }
                __builtin_amdgcn_sched_barrier(0);
            }
#pragma unroll
            for (int nt = 0; nt < 4; ++nt) { unsigned pr[2][2], pi[2][2];
#pragma unroll
                for (int m = 0; m < 2; ++m) { const int mt = 2 * mh + m; float tr[4], ti[4];
#pragma unroll
                    for (int r = 0; r < 4; ++r) { const float cs = twl[((nt * 4 + mt) * 4 + r) * 128], sn = twl[((nt * 4 + mt) * 4 + r) * 128 + 1];
                        const float re = d1[m][nt][r], im = d1[m][nt + 4][r]; tr[r] = re * cs + im * sn; ti[r] = im * cs - re * sn; }
                    pr[m][0] = pk2(tr[0], tr[1]); pr[m][1] = pk2(tr[2], tr[3]); pi[m][0] = pk2(ti[0], ti[1]); pi[m][1] = pk2(ti[2], ti[3]); }
                u32x4 f0, f2;
                f0.x = pr[0][0]; f0.y = pr[0][1]; f0.z = pr[1][0]; f0.w = pr[1][1];
                f2.x = pi[0][0]; f2.y = pi[0][1]; f2.z = pi[1][0]; f2.w = pi[1][1];
                frag[nt][mh] = __builtin_bit_cast(bf16x8, f0); frag[nt][2 + mh] = __builtin_bit_cast(bf16x8, f2);
                __builtin_amdgcn_sched_barrier(0); }
        }
#pragma unroll
        for (int nt = 0; nt < 4; ++nt) {
            f32x4 z[4];
#pragma unroll
            for (int n = 0; n < 4; ++n) z[n] = (f32x4){0.f, 0.f, 0.f, 0.f};
#pragma unroll
            for (int s2 = 0; s2 < 4; ++s2)
#pragma unroll
                for (int n2 = 0; n2 < 4; ++n2) { const bf16x8 bfr = *(const bf16x8*)(lds + FF_W2_OFF + ((s2 * 64 + n2 * 16 + fr) * FF_W2P) + fq * 16);
                    z[n2] = __builtin_amdgcn_mfma_f32_16x16x32_bf16(frag[nt][s2], bfr, z[n2], 0, 0, 0); }
#pragma unroll
            for (int n2 = 0; n2 < 4; ++n2) { const int cf = 16 * n2 + fr; u32x2 w; w.x = pk2(z[n2][0], z[n2][1]); w.y = pk2(z[n2][2], z[n2][3]);
                *(u32x2*)(ft + 64 * cf + 16 * nt + 4 * fq) = w; }
            __builtin_amdgcn_sched_barrier(0);
        }
    }
}
struct GluPol {
    static constexpr bool FP8 = false;
    template <class U> DI bool half(const U&) const { return false; }
    struct Unit { int pm, pn; };
    static constexpr bool GATHER = false;
    static constexpr long KSTEP_A = 4L * NTOK * 16 * 2;
    pg8::DenseOrder ord; const char* A; const char* B; int K, ksplit, lda, ldb;
    DI unsigned aoff(int R, int C) const { return (unsigned)(((C >> 4) * NTOK + R) * 16 + (C & 15)) * 2u; }
    DI bool next(int i, Unit& u) const { return ord.get(i, u.pm, u.pn); }
    DI void ptrs(const Unit& u, pg8::UPtr& q) const { q.a0 = A + (size_t)u.pm * 256 * 32; q.a1 = q.a0 + (size_t)128 * 32; q.b0 = B + (size_t)u.pn * 256 * ldb * 2; q.b1 = q.b0 + (size_t)128 * ldb * 2; q.c0 = q.b0; q.c1 = q.b1; }
    DI int brow(int R) const { return R; }
    DI void gather(const Unit&, int (&)[2], int (&)[2], unsigned&, unsigned&, unsigned&, unsigned&) const {}
};
struct GluEpi {
    static constexpr int MIDK_T = -1;
    const bf16* yact; bf16* merged; float* rsqs;
    DI void operator()(const f32x4 (&acc)[2][2][4][2], const GluPol::Unit& u, int wr, int wc, int fr, int fq) const {
        const int col0 = u.pn * 256 + wc * 32 + 8 * fq;
#pragma unroll
        for (int ai = 0; ai < 2; ++ai) {
            u32x4 yy[4][2];
#pragma unroll
            for (int m = 0; m < 4; ++m) { const int row = u.pm * 256 + ai * 128 + wr * 64 + m * 16 + fr;
#pragma unroll
                for (int bj = 0; bj < 2; ++bj) { const int col = col0 + bj * 128; yy[m][bj] = *(const u32x4*)(yact + ((size_t)(col >> 4) * NTOK + row) * 16 + (col & 15)); } }
#pragma unroll
            for (int m = 0; m < 4; ++m) { const int row = u.pm * 256 + ai * 128 + wr * 64 + m * 16 + fr; float sq = 0.f;
#pragma unroll
                for (int bj = 0; bj < 2; ++bj) { const u32x4 y = yy[m][bj]; const f32x4 a0 = acc[ai][bj][m][0], a1 = acc[ai][bj][m][1];
                    const float y0 = __uint_as_float(y.x << 16) * sigmoidf_(a0[0]), y1 = __uint_as_float(y.x & 0xffff0000u) * sigmoidf_(a0[1]);
                    const float y2 = __uint_as_float(y.y << 16) * sigmoidf_(a0[2]), y3 = __uint_as_float(y.y & 0xffff0000u) * sigmoidf_(a0[3]);
                    const float y4 = __uint_as_float(y.z << 16) * sigmoidf_(a1[0]), y5 = __uint_as_float(y.z & 0xffff0000u) * sigmoidf_(a1[1]);
                    const float y6 = __uint_as_float(y.w << 16) * sigmoidf_(a1[2]), y7 = __uint_as_float(y.w & 0xffff0000u) * sigmoidf_(a1[3]);
                    u32x4 w; w.x = pk2(y0, y1); w.y = pk2(y2, y3); w.z = pk2(y4, y5); w.w = pk2(y6, y7); *(u32x4*)(merged + (size_t)row * 1024 + col0 + bj * 128) = w;
                    sq += ((y0 * y0 + y1 * y1) + (y2 * y2 + y3 * y3)) + ((y4 * y4 + y5 * y5) + (y6 * y6 + y7 * y7)); }
                sq += __shfl_xor(sq, 16); sq += __shfl_xor(sq, 32);
                if (fq == 0) rsqs[(size_t)row * 8 + u.pn * 4 + wc] = sq; }
            asm volatile("" ::: "memory");
        }
    }
};
DI void phase3_glu(const Params& p, unsigned char* lds, int bid, int nb) {
    GluPol P; P.ord.init(NTOK / 256, 2, nb, bid); P.A = (const char*)(p.ws + WS_R4); P.B = (const char*)(p.ws + WS_WGLUT); P.K = 512; P.ksplit = 8; P.lda = 512; P.ldb = 512;
    GluEpi E{(const bf16*)(p.ws + WS_R4), (bf16*)(p.ws + WS_R1), (float*)(p.ws + WS_RSQS)};
    pg8::gemm_phase<GluPol, GluEpi, true>((PG8_LAS unsigned char*)lds, P, E);
}
constexpr int FM_PITCH = 132, FM_LDS = 512 * FM_PITCH;
DI void phase3_fin(const Params& p, unsigned char* lds, int bid, int nb) {
    const int tid = tidx(), lane = tid & 63, wid = tid >> 6;
    const bf16* FT = (const bf16*)(p.ws + WS_R5); bf16* merged = (bf16*)(p.ws + WS_R1);
    float gf[8];
#pragma unroll
    for (int j = 0; j < 8; ++j) gf[j] = p.g_f[lane + 64 * j];
    for (int item = bid; item < 512; item += nb) {
        const int b = item >> 6, k0 = (item & 63) * 64;
        { u32x4 v[8];
#pragma unroll
          for (int i = 0; i < 8; ++i) { const int ix = tid + NT * i, ch = ix >> 3, c = ix & 7; v[i] = *(const u32x4*)(FT + ((size_t)(b * 512 + ch) * 4096 + k0 + c * 8)); }
#pragma unroll
          for (int i = 0; i < 8; ++i) { const int ix = tid + NT * i, ch = ix >> 3, c = ix & 7; unsigned* d = (unsigned*)(lds + ch * FM_PITCH + c * 16); d[0] = v[i].x; d[1] = v[i].y; d[2] = v[i].z; d[3] = v[i].w; } }
        __syncthreads();
        float f[8][8], s[8];
#pragma unroll
        for (int t = 0; t < 8; ++t)
#pragma unroll
            for (int j = 0; j < 8; ++j) f[t][j] = bf2f(*(const bf16*)(lds + (lane + 64 * j) * FM_PITCH + (wid * 8 + t) * 2));
#pragma unroll
        for (int t = 0; t < 8; ++t) { float a = 0.f;
#pragma unroll
            for (int j = 0; j < 8; ++j) a += f[t][j] * f[t][j];
            s[t] = a; }
#pragma unroll
        for (int o = 1; o < 64; o <<= 1) {
#pragma unroll
            for (int t = 0; t < 8; ++t) s[t] += __shfl_xor(s[t], o); }
#pragma unroll
        for (int t = 0; t < 8; ++t) { const size_t row = (size_t)b * 4096 + k0 + wid * 8 + t; const float rs = rsqrtf(s[t] * (1.f / 512.f) + EPS);
#pragma unroll
            for (int j = 0; j < 8; ++j) merged[row * 1024 + 512 + lane + 64 * j] = (bf16)(pk2(f[t][j] * rs * gf[j], 0.f) & 0xffffu); }
        __syncthreads();
    }
}
struct P4Pol {
    static constexpr bool FP8 = false;
    template <class U> DI bool half(const U&) const { return false; }
    static constexpr long KSTEP_A = 0;
    DI unsigned aoff(int R, int C) const { return (unsigned)(R * lda + C) * 2u; }
    struct Unit { int pm, pn; };
    static constexpr bool GATHER = false;
    pg8::DenseOrder ord; const char* A; const char* B; int K, ksplit, lda, ldb;
    DI bool next(int i, Unit& u) const { return ord.get(i, u.pm, u.pn); }
    DI void ptrs(const Unit& u, pg8::UPtr& q) const { q.a0 = A + (size_t)u.pm * 256 * lda * 2; q.a1 = q.a0 + (size_t)128 * lda * 2; q.b0 = B + (size_t)u.pn * 256 * ldb * 2; q.b1 = q.b0 + (size_t)128 * ldb * 2; q.c0 = q.b0; q.c1 = q.b1; }
    DI int brow(int R) const { return R; }
    DI void gather(const Unit&, int (&)[2], int (&)[2], unsigned&, unsigned&, unsigned&, unsigned&) const {}
};
struct P4Epi {
    static constexpr int MIDK_T = 8;
    const float* x; bf16* x1b; const float* mod; float* rsqp; const float* rss;
    DI void midk(f32x4 (&acc)[2][2][4][2], const P4Pol::Unit& u, int wr, int wc, int fr, int fq) const {
        float r[2][4]; f32x4 q0[2][4], q1[2][4];
#pragma unroll
        for (int ai = 0; ai < 2; ++ai)
#pragma unroll
            for (int m = 0; m < 4; ++m) { const f32x4* q = (const f32x4*)(rss + (size_t)(u.pm * 256 + ai * 128 + wr * 64 + m * 16 + fr) * 8); q0[ai][m] = q[0]; q1[ai][m] = q[1]; }
#pragma unroll
        for (int ai = 0; ai < 2; ++ai)
#pragma unroll
            for (int m = 0; m < 4; ++m) r[ai][m] = rsqrtf((((q0[ai][m].x + q0[ai][m].y) + (q0[ai][m].z + q0[ai][m].w)) + ((q1[ai][m].x + q1[ai][m].y) + (q1[ai][m].z + q1[ai][m].w))) * (1.f / 512.f) + EPS);
#pragma unroll
        for (int ai = 0; ai < 2; ++ai)
#pragma unroll
            for (int m = 0; m < 4; ++m)
#pragma unroll
                for (int bj = 0; bj < 2; ++bj)
#pragma unroll
                    for (int n = 0; n < 2; ++n) acc[ai][bj][m][n] = acc[ai][bj][m][n] * r[ai][m];
    }
    DI void operator()(const f32x4 (&acc)[2][2][4][2], const P4Pol::Unit& u, int wr, int wc, int fr, int fq) const {
        const int col0 = u.pn * 256 + wc * 32 + 8 * fq, b = (u.pm * 256) >> 12;
        f32x4 gv[2][2];
#pragma unroll
        for (int bj = 0; bj < 2; ++bj)
#pragma unroll
            for (int n = 0; n < 2; ++n) gv[bj][n] = *(const f32x4*)(mod + b * 6144 + 2048 + col0 + bj * 128 + n * 4);
        f32x4 xa[2][2][2], xb[2][2][2];
#define P4_LOAD(dst, q_) do { const int ai_ = (q_) >> 1, mb_ = ((q_) & 1) * 2; _Pragma("unroll") for (int m2 = 0; m2 < 2; ++m2) { const int row_ = u.pm * 256 + ai_ * 128 + wr * 64 + (mb_ + m2) * 16 + fr; \
            _Pragma("unroll") for (int bj = 0; bj < 2; ++bj) _Pragma("unroll") for (int n = 0; n < 2; ++n) dst[m2][bj][n] = *(const f32x4*)(x + (size_t)row_ * D + col0 + bj * 128 + n * 4); } } while (0)
#define P4_DO(src, q_) do { const int ai_ = (q_) >> 1, mb_ = ((q_) & 1) * 2; _Pragma("unroll") for (int m2 = 0; m2 < 2; ++m2) { const int m_ = mb_ + m2, row_ = u.pm * 256 + ai_ * 128 + wr * 64 + m_ * 16 + fr; float s_ = 0.f; \
            _Pragma("unroll") for (int bj = 0; bj < 2; ++bj) { const f32x4 o0 = src[m2][bj][0] + gv[bj][0] * acc[ai_][bj][m_][0], o1 = src[m2][bj][1] + gv[bj][1] * acc[ai_][bj][m_][1]; \
                u32x4 w; w.x = pk2(o0.x, o0.y); w.y = pk2(o0.z, o0.w); w.z = pk2(o1.x, o1.y); w.w = pk2(o1.z, o1.w); *(u32x4*)(x1b + (size_t)row_ * D + col0 + bj * 128) = w; \
                s_ += ((o0.x * o0.x + o0.y * o0.y) + (o0.z * o0.z + o0.w * o0.w)) + ((o1.x * o1.x + o1.y * o1.y) + (o1.z * o1.z + o1.w * o1.w)); } \
            s_ += __shfl_xor(s_, 16); s_ += __shfl_xor(s_, 32); if (fq == 0) rsqp[(size_t)row_ * 16 + u.pn * 4 + wc] = s_; } } while (0)
        P4_LOAD(xa, 0); P4_LOAD(xb, 1);
        P4_DO(xa, 0); asm volatile("" ::: "memory"); P4_LOAD(xa, 2);
        P4_DO(xb, 1); asm volatile("" ::: "memory"); P4_LOAD(xb, 3);
        P4_DO(xa, 2); asm volatile("" ::: "memory");
        P4_DO(xb, 3);
#undef P4_LOAD
#undef P4_DO
    }
};
DI void phase4_out(const Params& p, unsigned char* lds, int bid, int nb) {
    P4Pol P; P.ord.init(NTOK / 256, D / 256, nb, bid); P.A = (const char*)(p.ws + WS_R1); P.B = (const char*)(p.ws + WS_WOUTT); P.K = 1024; P.ksplit = 16; P.lda = 1024; P.ldb = 1024;
    P4Epi E{p.x, (bf16*)(p.ws + WS_X1B), (const float*)(p.ws + WS_MOD), (float*)(p.ws + WS_RSQP1), (const float*)(p.ws + WS_RSQS)};
    pg8::gemm_phase<P4Pol, P4Epi, true>((PG8_LAS unsigned char*)lds, P, E);
}
DI int pair_index(int lo, int hi) { return 7 * lo - (lo * (lo - 1)) / 2 + (hi - lo - 1); }
constexpr int RT_WP = 2064, RT_GM_OFF = 48 * RT_WP, RT_SH_OFF = RT_GM_OFF + 4096, RT_SC_OFF = RT_SH_OFF + 4096, RT_LDS = RT_SC_OFF + 8 * 16 * 48 * 4;
DI void phase5_route(const Params& p, unsigned char* lds, int bid, int nb, bool commit = true) {
    const int tid = tidx(), lane = tid & 63, wid = tid >> 6, fr = lane & 15, fq = lane >> 4;
    { const bf16* W = (const bf16*)(p.ws + WS_WRT);
      for (int i = tid; i < 48 * 128; i += NT) { const int n = i >> 7, c = i & 127; *(u32x4*)(lds + n * RT_WP + c * 16) = *(const u32x4*)(W + n * 1024 + c * 8); } }
    const float* mod = (const float*)(p.ws + WS_MOD); const float* rsqp = (const float*)(p.ws + WS_RSQP1);
    bf16* A2 = (bf16*)(p.ws + WS_A2); unsigned* elcp = (unsigned*)(p.ws + WS_ELCP); float* elw = (float*)(p.ws + WS_ELW); unsigned* tcp = (unsigned*)(p.ws + WS_TCP);
    unsigned* ecnt = (unsigned*)(p.ws + WS_CTL + CTL_ECNT); unsigned* pcnt = (unsigned*)(p.ws + WS_CTL + CTL_PCNT);
    unsigned* elist = (unsigned*)(p.ws + WS_ELIST);
    float* gm = (float*)(lds + RT_GM_OFF); float* shv = (float*)(lds + RT_SH_OFF); float* scr = (float*)(lds + RT_SC_OFF) + wid * 16 * 48;
    for (int t128 = bid; t128 < NTOK / 128; t128 += nb) {
        const int b = t128 >> 5;
        __syncthreads();
        for (int k = tid; k < 1024; k += NT) { gm[k] = p.norm2_g[k] * (1.f + mod[b * 6144 + 4096 + k]); shv[k] = mod[b * 6144 + 3072 + k]; }
        __syncthreads();
        const int row0 = t128 * 128 + wid * 16, row = row0 + fr;
        float rs;
        { const f32x4* pp = (const f32x4*)(rsqp + (size_t)row * 16); const f32x4 q0 = pp[0], q1 = pp[1], q2 = pp[2], q3 = pp[3];
          const float rsum = (((q0.x + q0.y) + (q0.z + q0.w)) + ((q1.x + q1.y) + (q1.z + q1.w))) + (((q2.x + q2.y) + (q2.z + q2.w)) + ((q3.x + q3.y) + (q3.z + q3.w)));
          rs = rsqrtf(rsum * (1.f / D) + EPS); }
        f32x4 acc[3];
#pragma unroll
        for (int n = 0; n < 3; ++n) acc[n] = (f32x4){0.f, 0.f, 0.f, 0.f};
        const bf16* xr = (const bf16*)(p.ws + WS_X1B) + (size_t)row * D + fq * 8; unsigned char* ar = (unsigned char*)A2 + (size_t)row * D + fq * 8;
        u32x4 xa[8], xb[8];
#pragma unroll
        for (int i = 0; i < 8; ++i) xa[i] = *(const u32x4*)(xr + i * 32);
#pragma unroll 1
        for (int kc = 0; kc < 4; kc += 2) {
#pragma unroll
            for (int i = 0; i < 8; ++i) xb[i] = *(const u32x4*)(xr + (kc + 1) * 256 + i * 32);
#pragma unroll
            for (int half = 0; half < 2; ++half) {
#pragma unroll
                for (int i = 0; i < 8; ++i) {
                    const int ks = (kc + half) * 8 + i, k0 = ks * 32 + fq * 8;
                    const u32x4 xx = half ? xb[i] : xa[i];
                    f32x4 x0, x1; x0.x = __uint_as_float(xx.x << 16); x0.y = __uint_as_float(xx.x & 0xffff0000u); x0.z = __uint_as_float(xx.y << 16); x0.w = __uint_as_float(xx.y & 0xffff0000u);
                    x1.x = __uint_as_float(xx.z << 16); x1.y = __uint_as_float(xx.z & 0xffff0000u); x1.z = __uint_as_float(xx.w << 16); x1.w = __uint_as_float(xx.w & 0xffff0000u);
                    const f32x4 g0 = *(const f32x4*)(gm + k0), g1 = *(const f32x4*)(gm + k0 + 4), s0 = *(const f32x4*)(shv + k0), s1 = *(const f32x4*)(shv + k0 + 4);
                    const f32x4 t0 = x0 * rs * g0 + s0, t1 = x1 * rs * g1 + s1;
                    u32x4 hi; hi.x = pk2(t0.x, t0.y); hi.y = pk2(t0.z, t0.w); hi.z = pk2(t1.x, t1.y); hi.w = pk2(t1.z, t1.w);
                    { u32x2 a8; a8.x = pk4_fp8(t0.x * 4.f, t0.y * 4.f, t0.z * 4.f, t0.w * 4.f); a8.y = pk4_fp8(t1.x * 4.f, t1.y * 4.f, t1.z * 4.f, t1.w * 4.f); *(u32x2*)(ar + ks * 32) = a8; }
                    u32x4 lo;
                    lo.x = pk2(t0.x - __uint_as_float(hi.x << 16), t0.y - __uint_as_float(hi.x & 0xffff0000u)); lo.y = pk2(t0.z - __uint_as_float(hi.y << 16), t0.w - __uint_as_float(hi.y & 0xffff0000u));
                    lo.z = pk2(t1.x - __uint_as_float(hi.z << 16), t1.y - __uint_as_float(hi.z & 0xffff0000u)); lo.w = pk2(t1.z - __uint_as_float(hi.w << 16), t1.w - __uint_as_float(hi.w & 0xffff0000u));
                    const bf16x8 ah = __builtin_bit_cast(bf16x8, hi), al = __builtin_bit_cast(bf16x8, lo);
#pragma unroll
                    for (int nt = 0; nt < 3; ++nt) { const bf16x8 bw = *(const bf16x8*)(lds + (16 * nt + fr) * RT_WP + k0 * 2);
                        acc[nt] = __builtin_amdgcn_mfma_f32_16x16x32_bf16(ah, bw, acc[nt], 0, 0, 0); acc[nt] = __builtin_amdgcn_mfma_f32_16x16x32_bf16(al, bw, acc[nt], 0, 0, 0); }
                }
                if (half == 0 && kc + 2 < 4) {
#pragma unroll
                    for (int i = 0; i < 8; ++i) xa[i] = *(const u32x4*)(xr + (kc + 2) * 256 + i * 32);
                }
            }
        }
#pragma unroll
        for (int nt = 0; nt < 3; ++nt)
#pragma unroll
            for (int r = 0; r < 4; ++r) scr[(4 * fq + r) * 48 + 16 * nt + fr] = acc[nt][r];
        __syncthreads();
        if (lane < 16 && commit) {
            const int rrow = row0 + lane; const float* lg = scr + lane * 48;
            float gl[4];
#pragma unroll
            for (int o = 0; o < 4; ++o) gl[o] = lg[o] + p.b_group[o];
            float gmax = gl[0]; int gi = 0;
#pragma unroll
            for (int o = 1; o < 4; ++o) if (gl[o] > gmax) { gmax = gl[o]; gi = o; }
            float se = 0.f;
#pragma unroll
            for (int o = 0; o < 4; ++o) se += __expf(gl[o] - gmax);
            const float g_w = 1.f / se;
            float ev[8];
#pragma unroll
            for (int o = 0; o < 8; ++o) ev[o] = lg[4 + gi * 8 + o] + p.b_router[gi * 8 + o];
            float v1 = ev[0]; int i1 = 0;
#pragma unroll
            for (int o = 1; o < 8; ++o) if (ev[o] > v1) { v1 = ev[o]; i1 = o; }
            float v2 = -3.0e38f; int i2 = -1;
#pragma unroll
            for (int o = 0; o < 8; ++o) if (o != i1 && ev[o] > v2) { v2 = ev[o]; i2 = o; }
            const float w1 = g_w / (1.f + __expf(v2 - v1)), w2 = g_w - w1;
            const int lo = i1 < i2 ? i1 : i2, hi = i1 < i2 ? i2 : i1; const int pos1 = i1 < i2 ? 0 : 1;
            const int e1 = gi * 8 + i1, e2 = gi * 8 + i2;
            const int cls = gi * 28 + pair_index(lo, hi);
            const unsigned q3 = atomicAdd(pcnt + cls, 1u); const unsigned cp = ((unsigned)cls << 16) | q3;
            tcp[rrow] = cp;
            const unsigned q1 = atomicAdd(ecnt + e1, 1u); elist[(size_t)e1 * 32768 + q1] = (unsigned)rrow * 2u + (unsigned)pos1; elcp[(size_t)e1 * 32768 + q1] = cp; elw[(size_t)e1 * 32768 + q1] = w1;
            const unsigned q2 = atomicAdd(ecnt + e2, 1u); elist[(size_t)e2 * 32768 + q2] = (unsigned)rrow * 2u + (unsigned)(1 - pos1); elcp[(size_t)e2 * 32768 + q2] = cp; elw[(size_t)e2 * 32768 + q2] = w2;
        }
    }
    __syncthreads();
}
constexpr int TB_OFF = 131072, TB_ETE = 64, TB_ETR = 64 + 320, TB_ETC = 64 + 640, TB_PTC = 64 + 960, TB_PTS = 64 + 1280, TB_COFF = 64 + 1600, TB_PTN = 64 + 1600 + 128 + 160, TB_BYTES = (64 + 1600 + 128 + 160 + 320) * 4;
DI void build_tiles(const Params& p, unsigned char* lds) {
    int* tb = (int*)(lds + TB_OFF); int* cnts = tb + TB_COFF + 112;
    const int tid = tidx();
    if (tid < 144) cnts[tid] = tid < 32 ? (int)((const unsigned*)(p.ws + WS_CTL + CTL_ECNT))[tid] : (int)((const unsigned*)(p.ws + WS_CTL + CTL_PCNT))[tid - 32];
    __syncthreads();
    const bool isE = tid < 32, isP = tid >= 64 && tid < 176;
    if (isE || isP) {
        const int base = isE ? 0 : 32, n = isE ? 32 : 112, me = isE ? tid : tid - 64;
        int fb = 0, pb = 0, hb = 0, ft = 0, pt = 0, rows_before = 0;
        for (int j = 0; j < n; ++j) { const int c = cnts[base + j], f = c >> 8, r = c & 255, pp = r > 128 ? 1 : 0, hh = (r > 0 && r <= 128) ? 1 : 0;
            ft += f; pt += pp; if (j < me) { fb += f; pb += pp; hb += hh; rows_before += ((c + 255) >> 8) << 8; } }
        const int c = cnts[base + me], f = c >> 8, r = c & 255;
        if (isE) {
            for (int k = 0; k < f; ++k) { tb[TB_ETE + fb + k] = me; tb[TB_ETR + fb + k] = k * 256; tb[TB_ETC + fb + k] = c; }
            if (r > 128) { const int ix = ft + pb; tb[TB_ETE + ix] = me; tb[TB_ETR + ix] = f * 256; tb[TB_ETC + ix] = c; }
            else if (r > 0) { const int ix = ft + pt + hb; tb[TB_ETE + ix] = me; tb[TB_ETR + ix] = f * 256; tb[TB_ETC + ix] = c; }
            if (me == 31) tb[0] = ft + pt + hb + ((r > 0 && r <= 128) ? 1 : 0);
        } else {
            tb[TB_COFF + me] = rows_before;
            for (int k = 0; k < f; ++k) { tb[TB_PTC + fb + k] = me; tb[TB_PTS + fb + k] = rows_before + k * 256; tb[TB_PTN + fb + k] = c - k * 256; }
            if (r > 128) { const int ix = ft + pb; tb[TB_PTC + ix] = me; tb[TB_PTS + ix] = rows_before + f * 256; tb[TB_PTN + ix] = r; }
            else if (r > 0) { const int ix = ft + pt + hb; tb[TB_PTC + ix] = me; tb[TB_PTS + ix] = rows_before + f * 256; tb[TB_PTN + ix] = r; }
            if (me == 111) tb[1] = ft + pt + hb + ((r > 0 && r <= 128) ? 1 : 0);
        }
    }
    __syncthreads();
}
struct GUPol {
    static constexpr bool FP8 = true;
    struct Unit { int e, r0, cnt, hh; };
    DI bool half(const Unit& u) const { return u.cnt - u.r0 <= 128; }
    static constexpr long KSTEP_A = 0;
    DI unsigned aoff(int R, int C) const { return (unsigned)(R * lda + C) * 2u; }
    static constexpr bool GATHER = true;
    const int* tb; int G, c; const char* A; const char* B; const unsigned* elist; int K, ksplit, lda, ldb;
    DI bool next(int i, Unit& u) const { const int L = i * G + c; if (L >= __builtin_amdgcn_readfirstlane(tb[0]) * 2) return false; const int t = L >> 1; u.hh = L & 1;
        u.e = __builtin_amdgcn_readfirstlane(tb[TB_ETE + t]); u.r0 = __builtin_amdgcn_readfirstlane(tb[TB_ETR + t]); u.cnt = __builtin_amdgcn_readfirstlane(tb[TB_ETC + t]); return true; }
    DI void ptrs(const Unit& u, pg8::UPtr& q) const { q.a0 = A; q.a1 = A; q.b0 = B + (size_t)((u.e * 2 + u.hh) * 256) * ldb * 2; q.b1 = q.b0 + (size_t)128 * ldb * 2; q.c0 = q.b0; q.c1 = q.b1; }
    DI int brow(int R) const { return R; }
    DI unsigned goff(const Unit& u, int r, int C) const { const unsigned ent = elist[(size_t)u.e * 32768 + (r < u.cnt ? r : u.r0)]; return ((ent >> 1) * 512u + (unsigned)C) * 2u; }
    DI void gather(const Unit& u, int (&R)[2], int (&C)[2], unsigned& v00, unsigned& v01, unsigned& v10, unsigned& v11) const {
        v00 = goff(u, u.r0 + R[0], C[0]); v01 = goff(u, u.r0 + R[1], C[1]); v10 = goff(u, u.r0 + 128 + R[0], C[0]); v11 = goff(u, u.r0 + 128 + R[1], C[1]);
    }
};
struct GUEpi {
    static constexpr int MIDK_T = -1;
    const unsigned* elist; const unsigned* elcp; const float* elw; bf16* Hs; const int* tb;
    DI void operator()(const f32x4 (&acc)[2][2][4][2], const GUPol::Unit& u, int wr, int wc, int fr, int fq) const {
        unsigned ent[2][4], cp[2][4]; float w[2][4];
#pragma unroll
        for (int ai = 0; ai < 2; ++ai)
#pragma unroll
            for (int m = 0; m < 4; ++m) { const int r = u.r0 + ai * 128 + wr * 64 + m * 16 + fr; const size_t ix = (size_t)u.e * 32768 + (r < u.cnt ? r : u.r0);
                ent[ai][m] = elist[ix]; cp[ai][m] = elcp[ix]; w[ai][m] = elw[ix]; }
#pragma unroll
        for (int ai = 0; ai < 2; ++ai)
#pragma unroll
            for (int m = 0; m < 4; ++m) { const int r = u.r0 + ai * 128 + wr * 64 + m * 16 + fr;
                if (r < u.cnt) { const int srow = tb[TB_COFF + (cp[ai][m] >> 16)] + (int)(cp[ai][m] & 0xffffu); const float ww = w[ai][m];
                    unsigned char* dst = (unsigned char*)Hs + (size_t)srow * 512 + (ent[ai][m] & 1u) * 256 + u.hh * 128 + wc * 32 + 8 * fq;
                    const f32x4 g0 = acc[ai][0][m][0] * (1.f / 128.f), g1 = acc[ai][0][m][1] * (1.f / 128.f), u0 = acc[ai][1][m][0] * (1.f / 128.f), u1 = acc[ai][1][m][1] * (1.f / 128.f); const float w16 = ww * 16.f;
                    u32x2 o; o.x = pk4_fp8(siluf_(g0[0]) * u0[0] * w16, siluf_(g0[1]) * u0[1] * w16, siluf_(g0[2]) * u0[2] * w16, siluf_(g0[3]) * u0[3] * w16);
                    o.y = pk4_fp8(siluf_(g1[0]) * u1[0] * w16, siluf_(g1[1]) * u1[1] * w16, siluf_(g1[2]) * u1[2] * w16, siluf_(g1[3]) * u1[3] * w16);
                    *(u32x2*)dst = o; } }
    }
};
DI void phase6_gateup(const Params& p, unsigned char* lds, int bid, int nb) {
    GUPol P; P.tb = (const int*)(lds + TB_OFF); P.G = nb; P.c = (nb % 8 == 0) ? (bid % 8) * (nb / 8) + bid / 8 : bid; P.A = (const char*)(p.ws + WS_A2); P.B = (const char*)(p.ws + WS_WGUT); P.elist = (const unsigned*)(p.ws + WS_ELIST); P.K = 512; P.ksplit = 8; P.lda = 512; P.ldb = 512;
    GUEpi E{(const unsigned*)(p.ws + WS_ELIST), (const unsigned*)(p.ws + WS_ELCP), (const float*)(p.ws + WS_ELW), (bf16*)(p.ws + WS_HS), (const int*)(lds + TB_OFF)};
    pg8::gemm_phase<GUPol, GUEpi, true>((PG8_LAS unsigned char*)lds, P, E);
}
struct DnPol {
    static constexpr bool FP8 = true;
    struct Unit { int s0, cls, pn, nrows; };
    DI bool half(const Unit& u) const { return u.nrows <= 128; }
    static constexpr long KSTEP_A = 0;
    DI unsigned aoff(int R, int C) const { return (unsigned)(R * lda + C) * 2u; }
    static constexpr bool GATHER = false;
    const int* tb; int G, c; const char* A; const char* B; int K, ksplit, lda, ldb;
    DI bool next(int i, Unit& u) const { const int L = i * G + c; if (L >= __builtin_amdgcn_readfirstlane(tb[1]) * 4) return false; const int t = L >> 2; u.pn = L & 3;
        u.cls = __builtin_amdgcn_readfirstlane(tb[TB_PTC + t]); u.s0 = __builtin_amdgcn_readfirstlane(tb[TB_PTS + t]); u.nrows = __builtin_amdgcn_readfirstlane(tb[TB_PTN + t]); return true; }
    DI void ptrs(const Unit& u, pg8::UPtr& q) const {
        const int gi = u.cls / 28; int lo = 0, rem = u.cls % 28;
        while (rem >= 7 - lo) { rem -= 7 - lo; ++lo; }
        const int hi = lo + 1 + rem, elo = gi * 8 + lo, ehi = gi * 8 + hi;
        q.a0 = A + (size_t)u.s0 * lda * 2; q.a1 = q.a0 + (size_t)128 * lda * 2;
        q.b0 = B + ((size_t)elo * 1024 + u.pn * 256) * ldb * 2; q.b1 = q.b0 + (size_t)128 * ldb * 2;
        q.c0 = B + ((size_t)ehi * 1024 + u.pn * 256) * ldb * 2; q.c1 = q.c0 + (size_t)128 * ldb * 2; }
    DI int brow(int R) const { return R; }
    DI void gather(const Unit&, int (&)[2], int (&)[2], unsigned&, unsigned&, unsigned&, unsigned&) const {}
};
struct DnEpi {
    static constexpr int MIDK_T = -1;
    bf16* moe;
    DI void operator()(const f32x4 (&acc)[2][2][4][2], const DnPol::Unit& u, int wr, int wc, int fr, int fq) const {
#pragma unroll
        for (int ai = 0; ai < 2; ++ai) { if (ai == 1 && u.nrows <= 128) break;
#pragma unroll
            for (int m = 0; m < 4; ++m) { bf16* dst = moe + (size_t)(u.s0 + ai * 128 + wr * 64 + m * 16 + fr) * 1024 + u.pn * 256 + wc * 32 + 8 * fq;
#pragma unroll
                for (int bj = 0; bj < 2; ++bj) { const f32x4 v0 = acc[ai][bj][m][0] * (1.f / 256.f), v1 = acc[ai][bj][m][1] * (1.f / 256.f);
                    u32x4 w; w.x = pk2(v0[0], v0[1]); w.y = pk2(v0[2], v0[3]); w.z = pk2(v1[0], v1[1]); w.w = pk2(v1[2], v1[3]);
                    *(u32x4*)(dst + bj * 128) = w; } } }
    }
};
DI void phase7_down(const Params& p, unsigned char* lds, int bid, int nb) {
    DnPol P; P.tb = (const int*)(lds + TB_OFF); P.G = nb; P.c = (nb % 8 == 0) ? (bid % 8) * (nb / 8) + bid / 8 : bid; P.A = (const char*)(p.ws + WS_HS); P.B = (const char*)(p.ws + WS_WDT); P.K = 256; P.ksplit = 2; P.lda = 256; P.ldb = 128;
    DnEpi E{(bf16*)(p.ws + WS_MOE)};
    pg8::gemm_phase<DnPol, DnEpi, true>((PG8_LAS unsigned char*)lds, P, E);
}
DI void phase8_final(const Params& p, unsigned char* lds, int bid, int nb) {
    const int lane = tidx() & 63, wave = tidx() >> 6;
    const float* mod = (const float*)(p.ws + WS_MOD); const unsigned* tcp = (const unsigned*)(p.ws + WS_TCP); const bf16* moe = (const bf16*)(p.ws + WS_MOE); const bf16* x1b = (const bf16*)(p.ws + WS_X1B); const int* tb = (const int*)(lds + TB_OFF);
    constexpr int RW = 4;
    for (int r0 = (bid * 8 + wave) * RW; r0 < NTOK; r0 += nb * 8 * RW) {
        const int b = r0 >> 12; unsigned cp[RW]; u32x2 xx[RW][4], mm[RW][4];
#pragma unroll
        for (int q = 0; q < RW; ++q) cp[q] = tcp[r0 + q];
#pragma unroll
        for (int q = 0; q < RW; ++q)
#pragma unroll
            for (int j = 0; j < 4; ++j) xx[q][j] = ((const u32x2*)(x1b + (size_t)(r0 + q) * D) + lane)[64 * j];
#pragma unroll
        for (int q = 0; q < RW; ++q) { const int srow = tb[TB_COFF + (cp[q] >> 16)] + (int)(cp[q] & 0xffffu);
#pragma unroll
            for (int j = 0; j < 4; ++j) mm[q][j] = ((const u32x2*)(moe + (size_t)srow * D) + lane)[64 * j]; }
        f32x4 g2[4], fg[4];
#pragma unroll
        for (int j = 0; j < 4; ++j) { g2[j] = *(const f32x4*)(mod + b * 6144 + 5120 + lane * 4 + 256 * j); fg[j] = *(const f32x4*)(p.final_g + lane * 4 + 256 * j); }
        f32x4 v[RW][4]; float s[RW];
#pragma unroll
        for (int q = 0; q < RW; ++q) { float t = 0.f;
#pragma unroll
            for (int j = 0; j < 4; ++j) { f32x4 x1, mv; x1.x = __uint_as_float(xx[q][j].x << 16); x1.y = __uint_as_float(xx[q][j].x & 0xffff0000u); x1.z = __uint_as_float(xx[q][j].y << 16); x1.w = __uint_as_float(xx[q][j].y & 0xffff0000u);
                mv.x = __uint_as_float(mm[q][j].x << 16); mv.y = __uint_as_float(mm[q][j].x & 0xffff0000u); mv.z = __uint_as_float(mm[q][j].y << 16); mv.w = __uint_as_float(mm[q][j].y & 0xffff0000u);
                v[q][j] = x1 + g2[j] * mv; t += (v[q][j].x * v[q][j].x + v[q][j].y * v[q][j].y) + (v[q][j].z * v[q][j].z + v[q][j].w * v[q][j].w); }
            s[q] = t; }
#pragma unroll
        for (int o = 1; o < 64; o <<= 1) {
#pragma unroll
            for (int q = 0; q < RW; ++q) s[q] += __shfl_xor(s[q], o); }
#pragma unroll
        for (int q = 0; q < RW; ++q) { const float rs = rsqrtf(s[q] * (1.f / D) + EPS); f32x4* orow = (f32x4*)(p.out + (size_t)(r0 + q) * D) + lane;
#pragma unroll
            for (int j = 0; j < 4; ++j) { f32x4 o = v[q][j] * rs * fg[j];
                if (MK_TS1 >= 0) { const unsigned* tsv = (const unsigned*)(p.ws + WS_CTL + CTL_TS); o = o * (1.f + (float)(tsv[0] / 1000u) * 0.01f); }
                orow[64 * j] = o; } }
    }
}

#define XB_TMO      128
#define XB_XCNT(j)  (256  + 64 * (j))
#define XB_XSUB(j)  (1280 + 64 * (j))
#define XB_XGEN(j)  (2304 + 64 * (j))
#define XB_TOP      3328
#define XB_TOPGEN   3392
#define XCD_BAR_WORDS 3456
#define XB_SPIN_CAP (1u << 18)
#define LAS __attribute__((address_space(3)))
DI unsigned xb_ld(unsigned* p)              { return __hip_atomic_load(p, __ATOMIC_RELAXED, __HIP_MEMORY_SCOPE_AGENT); }
DI unsigned xb_add(unsigned* p, unsigned v) { return __hip_atomic_fetch_add(p, v, __ATOMIC_RELAXED, __HIP_MEMORY_SCOPE_AGENT); }
DI unsigned xb_xcc_id() { return (unsigned)__builtin_amdgcn_s_getreg((3 << 11) | 20) & 0xFu; }
#define XB_SPIN(cond, bar) do { unsigned _sp = 0; while (cond) { __builtin_amdgcn_s_sleep(1); \
    if ((++_sp & 255u) == 0u) { if (xb_ld(&(bar)[XB_TMO])) break; if (_sp > XB_SPIN_CAP) { atomicAdd(&(bar)[XB_TMO], 1u); break; } } } } while (0)
struct XcdBarrier { unsigned* bar; unsigned x; volatile LAS unsigned* st; };
DI XcdBarrier xcd_barrier_post(unsigned* bar, volatile LAS unsigned* st) {
    XcdBarrier b; b.bar = bar; b.x = xb_xcc_id(); b.st = st;
    if (tidx() == 0) (void)xb_add(&bar[XB_XCNT(b.x)], 1u);
    return b;
}
DI void xcd_barrier_complete(unsigned* bar, unsigned x, unsigned& nloc, unsigned& nx) {
    const unsigned G = gridDim.x * gridDim.y * gridDim.z;
    unsigned sum, cnt, mine, sp = 0u;
    for (;;) {
        sum = 0u; cnt = 0u; mine = 0u;
#pragma unroll
        for (unsigned j = 0; j < 16; ++j) { const unsigned c = xb_ld(&bar[XB_XCNT(j)]); sum += c; cnt += (c > 0u) ? 1u : 0u; mine = (j == x) ? c : mine; }
        if (sum == G) break;
        __builtin_amdgcn_s_sleep(1);
        if ((++sp & 255u) == 0u) { if (xb_ld(&bar[XB_TMO])) break; if (sp > XB_SPIN_CAP) { atomicAdd(&bar[XB_TMO], 1u); break; } }
    }
    nloc = mine > 0u ? mine : 1u; nx = cnt > 0u ? cnt : 1u;
}
DI void xcd_barrier(const XcdBarrier& b) {
    asm volatile("s_waitcnt vmcnt(0)" ::: "memory");
    __syncthreads();
    if (tidx() == 0) {
        unsigned* bar = b.bar;
        __builtin_amdgcn_s_waitcnt(0);
        unsigned nloc = b.st[0], nx = b.st[1];
        if (nloc == 0u) { xcd_barrier_complete(bar, b.x, nloc, nx); b.st[0] = nloc; b.st[1] = nx; }
        const unsigned old = xb_add(&bar[XB_XSUB(b.x)], 1u);
        const unsigned gen = old / nloc;
        if (old + 1u == (gen + 1u) * nloc) {
            __builtin_amdgcn_fence(__ATOMIC_RELEASE, "agent");
            asm volatile("s_waitcnt vmcnt(0)" ::: "memory");
            const unsigned og = xb_add(&bar[XB_TOP], 1u);
            const unsigned tg = og / nx;
            if (og + 1u == (tg + 1u) * nx) xb_add(&bar[XB_TOPGEN], 1u);
            else XB_SPIN(xb_ld(&bar[XB_TOPGEN]) == tg, bar);
            __builtin_amdgcn_fence(__ATOMIC_ACQUIRE, "agent");
            xb_add(&bar[XB_XGEN(b.x)], 1u);
            asm volatile("s_waitcnt vmcnt(0)" ::: "memory");
        } else {
            XB_SPIN(xb_ld(&bar[XB_XGEN(b.x)]) == gen, bar);
            __builtin_amdgcn_fence(__ATOMIC_ACQUIRE, "agent");
            asm volatile("s_waitcnt vmcnt(0)" ::: "memory");
        }
    }
    __syncthreads();
}

constexpr int CTL_BAR = 16384;
constexpr int MK_LDS = 163840;
constexpr int MK_ST_OFF = MK_LDS - 16;
static_assert(FF_LDS <= MK_ST_OFF && RT_LDS <= MK_ST_OFF && TB_OFF + TB_BYTES <= MK_ST_OFF && TB_OFF >= pg8::STAGE_BYTES, "LDS map");
static_assert(4 * (4096 + 4096 + 8448 + 16384) <= MK_ST_OFF, "prep LDS");
#ifndef MK_REP
#define MK_REP -1
#endif
constexpr int MK_PT_OFF = MK_ST_OFF - 256;
static_assert(RT_LDS <= MK_PT_OFF && TB_OFF + TB_BYTES <= MK_PT_OFF, "LDS map (pointer table)");
DI Params ldp(const unsigned char* lds) {
    Params p; unsigned long long* d = (unsigned long long*)&p; const unsigned* t = (const unsigned*)(lds + MK_PT_OFF);
#pragma unroll
    for (int i = 0; i < 32; ++i) { const unsigned lo = __builtin_amdgcn_readfirstlane(t[2 * i]), hi = __builtin_amdgcn_readfirstlane(t[2 * i + 1]); d[i] = ((unsigned long long)hi << 32) | lo; }
    return p;
}
#define TSTAMP(i) do { if (MK_TS1 >= 0 && bid == 0 && tidx() == 0) ((unsigned long long*)(lds + MK_PT_OFF - 256))[i] = __builtin_amdgcn_s_memrealtime(); } while (0)
#define RUNPH(k, body) do { { const Params p = ldp(lds); body; } if (MK_REP == (k)) { xcd_barrier(bar); { const Params p = ldp(lds); body; } } } while (0)
#ifdef MK_ONLY
__global__ void __launch_bounds__(NT, 2) only_kernel(Params p) {
    extern __shared__ __attribute__((aligned(16))) unsigned char lds[];
    const int bid = blockIdx.x, nb = gridDim.x;
    if (MK_ONLY == 1) phaseAB_prep(p, lds, bid, nb);
    if (MK_ONLY == 2) phase1b(p, lds, bid, nb);
    if (MK_ONLY == 3) phase2a_s5states(p, lds, bid, nb);
    if (MK_ONLY == 13) phase2b_scan(p, bid, nb);
    if (MK_ONLY == 4) phase2_fft(p, lds, bid, nb);
    if (MK_ONLY == 9) phase2c_s5out(p, lds, bid, nb);
    if (MK_ONLY == 5) phase3_glu(p, lds, bid, nb);
    if (MK_ONLY == 6) phase3_fin(p, lds, bid, nb);
    if (MK_ONLY == 7) phase4_out(p, lds, bid, nb);
    if (MK_ONLY == 8) phase5_route(p, lds, bid, nb);
    if (MK_ONLY == 10) { build_tiles(p, lds); phase6_gateup(p, lds, bid, nb); }
    if (MK_ONLY == 11) { build_tiles(p, lds); phase7_down(p, lds, bid, nb); }
    if (MK_ONLY == 12) { build_tiles(p, lds); phase8_final(p, lds, bid, nb); }
}
#endif
__global__ void __launch_bounds__(NT, 2) mega_kernel(Params pk) {
    extern __shared__ __attribute__((aligned(16))) unsigned char lds[];
    const int bid = blockIdx.x, nb = gridDim.x;
    static_assert(sizeof(Params) == 256, "Params = 32 pointers");
    if (tidx() < 64) ((unsigned*)(lds + MK_PT_OFF))[tidx()] = ((const unsigned*)&pk)[tidx()];
    if (tidx() < 4) ((unsigned*)(lds + MK_ST_OFF))[tidx()] = 0u;
    __syncthreads();
    XcdBarrier bar;
    { const Params p = ldp(lds); bar = xcd_barrier_post((unsigned*)(p.ws + WS_CTL + CTL_BAR), (volatile LAS unsigned*)(lds + MK_ST_OFF)); }
    TSTAMP(0);
    TSTAMP(1);
    RUNPH(-2, phaseAB_prep(p, lds, bid, nb));     xcd_barrier(bar); TSTAMP(2);
    RUNPH(2, phase1b(p, lds, bid, nb));           xcd_barrier(bar); TSTAMP(3);
    RUNPH(3, phase2a_s5states(p, lds, bid, nb));  xcd_barrier(bar);
    RUNPH(13, phase2b_scan(p, bid, nb));
    RUNPH(4, phase2_fft(p, lds, bid, nb));        xcd_barrier(bar); TSTAMP(4);
    RUNPH(9, phase2c_s5out(p, lds, bid, nb));     xcd_barrier(bar); TSTAMP(5);
    RUNPH(6, phase3_fin(p, lds, bid, nb));
    RUNPH(5, phase3_glu(p, lds, bid, nb));        xcd_barrier(bar); TSTAMP(6); TSTAMP(7);
    RUNPH(7, phase4_out(p, lds, bid, nb));        xcd_barrier(bar); TSTAMP(8);
    RUNPH(-2, phase5_route(p, lds, bid, nb));     xcd_barrier(bar); TSTAMP(9);
    if (MK_REP == 8) { { const Params p = ldp(lds); phase5_route(p, lds, bid, nb, false); } xcd_barrier(bar); }
    if (MK_REP == 20) { xcd_barrier(bar); xcd_barrier(bar); xcd_barrier(bar); xcd_barrier(bar); }
    RUNPH(-2, build_tiles(p, lds));
    RUNPH(10, phase6_gateup(p, lds, bid, nb));    xcd_barrier(bar); TSTAMP(10);
    RUNPH(11, phase7_down(p, lds, bid, nb));      xcd_barrier(bar); TSTAMP(11);
    if (MK_TS1 >= 0) { if (bid == 0 && tidx() == 0) { const unsigned long long* ts = (const unsigned long long*)(lds + MK_PT_OFF - 256); const Params p = ldp(lds); unsigned* o = (unsigned*)(p.ws + WS_CTL + CTL_TS);
            o[0] = (unsigned)(ts[MK_TS1 + 1] - ts[MK_TS1]); o[1] = MK_TS2 >= 0 ? (unsigned)(ts[MK_TS2 + 1] - ts[MK_TS2]) : 0u; } xcd_barrier(bar); }
    RUNPH(-2, phase8_final(p, lds, bid, nb));
}

extern "C" void kernel_launch(void* const* d_in, const int* in_sizes, int n_in, void* d_out, int out_size, void* d_ws, size_t ws_size, hipStream_t stream) {
    static int grid = 0;
    if (grid == 0) {
        if (n_in != 30 || ws_size < WS_END || out_size != NTOK * D) { fprintf(stderr, "kernel_launch: unexpected inputs (n_in %d, ws %zu, out %d)\n", n_in, ws_size, out_size); grid = -1; return; }
        int dev = 0, cus = 0, per_cu = 0;
        if (hipGetDevice(&dev) != hipSuccess || hipDeviceGetAttribute(&cus, hipDeviceAttributeMultiprocessorCount, dev) != hipSuccess) { grid = -1; return; }
        if (hipFuncSetAttribute((const void*)mega_kernel, hipFuncAttributeMaxDynamicSharedMemorySize, MK_LDS) != hipSuccess) { fprintf(stderr, "kernel_launch: hipFuncSetAttribute failed\n"); grid = -1; return; }
        if (hipOccupancyMaxActiveBlocksPerMultiprocessor(&per_cu, (const void*)mega_kernel, NT, MK_LDS) != hipSuccess || per_cu < 1) { fprintf(stderr, "kernel_launch: occupancy query says %d blocks/CU\n", per_cu); (void)hipGetLastError(); grid = -1; return; }
        grid = cus;
    }
    if (grid < 0) return;
    Params p{};
    const float** f = (const float**)&p;
    for (int i = 0; i < 30; ++i) f[i] = (const float*)d_in[i];
    p.out = (float*)d_out; p.ws = (unsigned char*)d_ws;
    (void)hipMemsetAsync((char*)d_ws + WS_CTL, 0, CTL_BYTES, stream);
    hipLaunchKernelGGL(mega_kernel, dim3(grid), dim3(NT), MK_LDS, stream, p);
}
```

```cpp
#include <hip/hip_runtime.h>
#include <cstdio>
#include <cstdint>

typedef unsigned short bf16;
typedef short bf16x8 __attribute__((ext_vector_type(8)));
typedef short bf16x4 __attribute__((ext_vector_type(4)));
typedef float f32x4 __attribute__((ext_vector_type(4)));
typedef unsigned u32x4 __attribute__((ext_vector_type(4)));
typedef unsigned u32x2 __attribute__((ext_vector_type(2)));
typedef __bf16 bf16v2 __attribute__((ext_vector_type(2)));
#define DI __device__ __forceinline__

constexpr int D = 1024, NB = 8, L = 4096, CTX = 256, NTOK = NB * L, NCTX = NB * CTX, NROWS1 = NTOK + NCTX;
constexpr int NEXP = 32, DE = 256;
constexpr float EPS = 1e-6f;
constexpr int NT = 512;

constexpr size_t MiB = 1u << 20;
constexpr size_t WS_CTL = 0;
constexpr size_t CTL_BYTES = 1 * MiB;
constexpr size_t CTL_ZERO = 4096;
#ifndef MK_TS1
#define MK_TS1 -1
#endif
#ifndef MK_TS2
#define MK_TS2 -1
#endif
constexpr size_t CTL_TS = 12288;
constexpr size_t CTL_FLAGA = 12800;
constexpr size_t CTL_WQ = 12544;
constexpr size_t CTL_ECNT = 65536;
constexpr size_t CTL_PCNT = 65536 + 32 * 64;
constexpr int CNT_STRIDE = 16;
constexpr size_t CTL_RSQ1 = 256 * 1024;
constexpr size_t CTL_RSQ2 = 384 * 1024;
constexpr size_t WS_MOD = 1 * MiB;
constexpr size_t WS_TILES = WS_MOD + 256 * 1024;
constexpr size_t WS_ABART = WS_TILES + 64 * 1024;
constexpr size_t WS_FFTC = 2 * MiB;
constexpr size_t WS_GW = 3 * MiB;
constexpr size_t WS_WINT = 4 * MiB;
constexpr size_t WS_WGLUT = 7 * MiB;
constexpr size_t WS_WOUTT = 8 * MiB;
constexpr size_t WS_WGUT = 10 * MiB;
constexpr size_t WS_WDT = 42 * MiB;
constexpr size_t WS_WST = 58 * MiB;
constexpr size_t WS_MGW = 66 * MiB;
constexpr size_t WS_ELIST = 90 * MiB;
constexpr size_t WS_ELCP = 94 * MiB;
constexpr size_t WS_ELW = 98 * MiB;
constexpr size_t WS_TCP = 102 * MiB;
constexpr size_t WS_R1 = 108 * MiB;
constexpr size_t WS_R2 = 176 * MiB;
constexpr size_t WS_R3 = 240 * MiB;
constexpr size_t WS_UCTX = 288 * MiB;
constexpr size_t WS_R4 = 290 * MiB;
constexpr size_t WS_R5 = 322 * MiB;
constexpr size_t WS_X1B = 290 * MiB;
constexpr size_t WS_A2 = 108 * MiB;
constexpr size_t WS_HS = 228 * MiB;
constexpr size_t WS_MOE = 108 * MiB;
constexpr size_t WS_RSQP1 = 354 * MiB;
constexpr size_t WS_RSQS = 356 * MiB;
constexpr size_t WS_RSS = 357 * MiB;
constexpr size_t WS_ETAB = 357 * MiB + 512 * 1024;
constexpr size_t WS_WRT = 358 * MiB;
constexpr size_t WS_END = 359 * MiB;

struct Params {
    const float *x, *c, *ctx, *c_ctx, *w_ada, *b_ada, *norm1_g, *norm2_g, *w_in;
    const float *lam_re, *lam_im, *b_re, *b_im, *c_re, *c_im, *log_step, *s5_d, *w_glu, *fourier_w, *g_s, *g_f, *w_out;
    const float *w_group, *b_group, *w_router, *b_router, *w_gate, *w_up, *w_down, *final_g;
    float* out; unsigned char* ws;
};

DI int tidx() { int t = threadIdx.x; asm volatile("" : "+v"(t)); return t; }
DI unsigned pk2(float lo, float hi) { bf16v2 v; v.x = (__bf16)lo; v.y = (__bf16)hi; return __builtin_bit_cast(unsigned, v); }
typedef int i32x4 __attribute__((ext_vector_type(4)));
typedef int i32x8 __attribute__((ext_vector_type(8)));
DI unsigned pk4_fp8(float a, float b, float c, float d) { int w = 0; w = __builtin_amdgcn_cvt_pk_fp8_f32(a, b, w, false); w = __builtin_amdgcn_cvt_pk_fp8_f32(c, d, w, true); return (unsigned)w; }
DI float bf2f(unsigned short b) { return __uint_as_float(((unsigned)b) << 16); }
DI float wave_sum(float v) {
#pragma unroll
    for (int o = 1; o < 64; o <<= 1) v += __shfl_xor(v, o);
    return v;
}
DI float sigmoidf_(float x) { return 1.f / (1.f + __expf(-x)); }
DI float siluf_(float x) { return x / (1.f + __expf(-x)); }
DI float geluf_(float x) { const float u = 0.7978845608028654f * (x + 0.044715f * x * x * x); return x / (1.f + __expf(-2.f * u)); }

template <int MT> struct GC {
    static constexpr int BM = 64 * MT, PA = MT, ABYTES = BM * 128, BBYTES = 128 * 128, BUF = ABYTES + BBYTES, LDS = 2 * BUF;
};
template <int MT>
DI void gemm_loop(f32x4 (&acc)[MT][4], const bf16* (&ap)[MT], const int (&as)[MT], const bf16* (&bp)[2], int nk, unsigned char* lds) {
    typedef GC<MT> G;
    const int tid = tidx(), lane = tid & 63, wid = tid >> 6, wm = wid >> 1, wn = wid & 1, fr = lane & 15, fq = lane >> 4;
    const int srow = tid >> 3, sck = tid & 7;
    const int soff = srow * 128 + ((sck ^ (srow & 7)) << 4);
    u32x4 ra[MT], rb[2];
#pragma unroll
    for (int i = 0; i < MT; ++i) ra[i] = *(const u32x4*)(ap[i]);
#pragma unroll
    for (int i = 0; i < 2; ++i) rb[i] = *(const u32x4*)(bp[i]);
#pragma unroll
    for (int i = 0; i < MT; ++i) *(u32x4*)(lds + i * 8192 + soff) = ra[i];
#pragma unroll
    for (int i = 0; i < 2; ++i) *(u32x4*)(lds + G::ABYTES + i * 8192 + soff) = rb[i];
    __syncthreads();
    const int aro = (wm * MT * 16 + fr) * 128, bro = (wn * 64 + fr) * 128;
    const int sw0 = ((0 + fq) ^ (fr & 7)) << 4, sw1 = ((4 + fq) ^ (fr & 7)) << 4;
    for (int kt = 0; kt < nk; ++kt) {
        const bool more = kt + 1 < nk;
        if (more) {
#pragma unroll
            for (int i = 0; i < MT; ++i) ra[i] = *(const u32x4*)(ap[i] + (size_t)(kt + 1) * as[i]);
#pragma unroll
            for (int i = 0; i < 2; ++i) rb[i] = *(const u32x4*)(bp[i] + (size_t)(kt + 1) * 64);
        }
        const unsigned char* Ab = lds + (kt & 1) * G::BUF; const unsigned char* Bb = Ab + G::ABYTES;
#pragma unroll
        for (int kk = 0; kk < 2; ++kk) {
            const int sw = kk ? sw1 : sw0;
            bf16x8 af[MT], bfr[4];
#pragma unroll
            for (int mt = 0; mt < MT; ++mt) af[mt] = *(const bf16x8*)(Ab + aro + mt * 2048 + sw);
#pragma unroll
            for (int nt = 0; nt < 4; ++nt) bfr[nt] = *(const bf16x8*)(Bb + bro + nt * 2048 + sw);
#pragma unroll
            for (int mt = 0; mt < MT; ++mt)
#pragma unroll
                for (int nt = 0; nt < 4; ++nt) acc[mt][nt] = __builtin_amdgcn_mfma_f32_16x16x32_bf16(bfr[nt], af[mt], acc[mt][nt], 0, 0, 0);
        }
        if (more) {
            unsigned char* nb = lds + ((kt + 1) & 1) * G::BUF;
#pragma unroll
            for (int i = 0; i < MT; ++i) *(u32x4*)(nb + i * 8192 + soff) = ra[i];
#pragma unroll
            for (int i = 0; i < 2; ++i) *(u32x4*)(nb + G::ABYTES + i * 8192 + soff) = rb[i];
        }
        __syncthreads();
    }
}
template <int MT>
DI void gemm_loop_alds(f32x4 (&acc)[MT][4], const unsigned char* abase, int apitch, const bf16* (&bp)[2], int nk, unsigned char* lds) {
    typedef GC<MT> G;
    const int tid = tidx(), lane = tid & 63, wid = tid >> 6, wm = wid >> 1, wn = wid & 1, fr = lane & 15, fq = lane >> 4;
    const int srow = tid >> 3, sck = tid & 7;
    const int soff = srow * 128 + ((sck ^ (srow & 7)) << 4);
    u32x4 rb[2];
#pragma unroll
    for (int i = 0; i < 2; ++i) rb[i] = *(const u32x4*)(bp[i]);
#pragma unroll
    for (int i = 0; i < 2; ++i) *(u32x4*)(lds + G::ABYTES + i * 8192 + soff) = rb[i];
    __syncthreads();
    const int bro = (wn * 64 + fr) * 128;
    const int sw0 = ((0 + fq) ^ (fr & 7)) << 4, sw1 = ((4 + fq) ^ (fr & 7)) << 4;
    const unsigned char* arow = abase + (size_t)(wm * MT * 16 + fr) * apitch + fq * 16;
    for (int kt = 0; kt < nk; ++kt) {
        const bool more = kt + 1 < nk;
        if (more) {
#pragma unroll
            for (int i = 0; i < 2; ++i) rb[i] = *(const u32x4*)(bp[i] + (size_t)(kt + 1) * 64);
        }
        const unsigned char* Bb = lds + (kt & 1) * G::BUF + G::ABYTES;
#pragma unroll
        for (int kk = 0; kk < 2; ++kk) {
            const int sw = kk ? sw1 : sw0;
            bf16x8 af[MT], bfr[4];
#pragma unroll
            for (int mt = 0; mt < MT; ++mt) af[mt] = *(const bf16x8*)(arow + (size_t)mt * 16 * apitch + kt * 128 + kk * 64);
#pragma unroll
            for (int nt = 0; nt < 4; ++nt) bfr[nt] = *(const bf16x8*)(Bb + bro + nt * 2048 + sw);
#pragma unroll
            for (int mt = 0; mt < MT; ++mt)
#pragma unroll
                for (int nt = 0; nt < 4; ++nt) acc[mt][nt] = __builtin_amdgcn_mfma_f32_16x16x32_bf16(bfr[nt], af[mt], acc[mt][nt], 0, 0, 0);
        }
        if (more) {
            unsigned char* nb = lds + ((kt + 1) & 1) * G::BUF;
#pragma unroll
            for (int i = 0; i < 2; ++i) *(u32x4*)(nb + G::ABYTES + i * 8192 + soff) = rb[i];
        }
        __syncthreads();
    }
}
template <int MT> DI void zero_acc(f32x4 (&acc)[MT][4]) {
#pragma unroll
    for (int m = 0; m < MT; ++m)
#pragma unroll
        for (int n = 0; n < 4; ++n) acc[m][n] = (f32x4){0.f, 0.f, 0.f, 0.f};
}

namespace pg8 {
#define PG8_LAS __attribute__((address_space(3)))
constexpr int BM = 256, BK = 64, HALF = 128, HTB = HALF * BK * 2, STAGE_BYTES = 8 * HTB;
DI int lds_byte(int r, int c) { const int st = (r >> 4) * 2 + (c >> 5), rr = r & 15, cc = c & 31, ob = rr * 64 + cc * 2; return st * 1024 + (ob ^ (((ob >> 9) & 1) << 5)); }
DI int perm32(int rho) { const int n = rho >> 4, i = rho & 15; return 8 * (i >> 2) + 4 * n + (i & 3); }
DI void stage_rc(int b, int& R, int& C) { const int st = b / 1024, sb = b % 1024, swz = sb ^ (((sb >> 9) & 1) << 5); R = (st >> 1) * 16 + swz / 64; C = (st & 1) * 32 + (swz % 64) / 2; }
struct UPtr { const char *a0, *a1, *b0, *b1, *c0, *c1; };
template <class Pol, class Epi, bool ALIGN_EPI>
DI void gemm_phase(PG8_LAS unsigned char* lds, const Pol& P, const Epi& E) {
    typedef typename Pol::Unit Unit;
    const int tid = tidx(), wid = __builtin_amdgcn_readfirstlane(tid >> 6), lane = tid & 63, wr = wid >> 2, wc = wid & 3, fr = lane & 15, fq = lane >> 4;
    const int nt = P.K / BK, ksplit = P.ksplit;
    int Rr[2], Cc[2]; unsigned voffB[2];
#pragma unroll
    for (int i = 0; i < 2; ++i) { stage_rc(tid * 16 + i * 8192, Rr[i], Cc[i]); voffB[i] = (unsigned)(P.brow((Rr[i] & ~31) + perm32(Rr[i] & 31)) * P.ldb + Cc[i]) * 2u; }
    unsigned c00 = P.aoff(Rr[0], Cc[0]), c01 = P.aoff(Rr[1], Cc[1]), c10 = c00, c11 = c01, n00 = c00, n01 = c01, n10 = c00, n11 = c01;
#define PG8_STAGE2(bufoff, gbase, o0, o1) do { \
        __builtin_amdgcn_global_load_lds((const unsigned*)((const char*)(gbase) + (o0)), (PG8_LAS unsigned*)(lds + (bufoff) + ldsw), 16, 0, 0); \
        __builtin_amdgcn_global_load_lds((const unsigned*)((const char*)(gbase) + (o1)), (PG8_LAS unsigned*)(lds + (bufoff) + ldsw + 8192), 16, 0, 0); } while (0)
    const size_t kstep = (size_t)(BK * 2);
    const size_t kstepA = Pol::KSTEP_A ? (size_t)Pol::KSTEP_A : kstep;
    const unsigned ldsw = (unsigned)wid * 1024u;
    const int aoff = lds_byte(wr * 64 + fr, fq * 8), boff = lds_byte(wc * 32 + fr, fq * 8);
#define PG8_SA(b, h) (((b) * 2 + (h)) * HTB)
#define PG8_SB(b, h) ((4 + (b) * 2 + (h)) * HTB)
#define PG8_STAGE(bufoff, gbase, voff) do { _Pragma("unroll") for (int _i = 0; _i < 2; ++_i) \
        __builtin_amdgcn_global_load_lds((const unsigned*)((const char*)(gbase) + (voff)[_i]), (PG8_LAS unsigned*)(lds + (bufoff) + ldsw + _i * 8192), 16, 0, 0); } while (0)
#define PG8_LDA(dst, b, h) do { _Pragma("unroll") for (int m = 0; m < 4; ++m) _Pragma("unroll") for (int k = 0; k < 2; ++k) dst[m][k] = *(const PG8_LAS bf16x8*)(lds + PG8_SA(b, h) + aoff + m * 2048 + k * 1024); } while (0)
#define PG8_LDB(dst, b, h) do { _Pragma("unroll") for (int n = 0; n < 2; ++n) _Pragma("unroll") for (int k = 0; k < 2; ++k) dst[n][k] = *(const PG8_LAS bf16x8*)(lds + PG8_SB(b, h) + boff + n * 2048 + k * 1024); } while (0)
#define PG8_MMA(ai, bj, At, Bt) do { __builtin_amdgcn_s_setprio(1); _Pragma("unroll") for (int m = 0; m < 4; ++m) _Pragma("unroll") for (int n = 0; n < 2; ++n) _Pragma("unroll") for (int k = 0; k < 2; ++k) \
        acc[ai][bj][m][n] = __builtin_amdgcn_mfma_f32_16x16x32_bf16(Bt[n][k], At[m][k], acc[ai][bj][m][n], 0, 0, 0); __builtin_amdgcn_s_setprio(0); } while (0)
#define PG8_LDA8(dst, b, h) do { _Pragma("unroll") for (int m = 0; m < 4; ++m) dst[m] = __builtin_shufflevector(*(const PG8_LAS i32x4*)(lds + PG8_SA(b, h) + aoff + m * 2048), *(const PG8_LAS i32x4*)(lds + PG8_SA(b, h) + aoff + m * 2048 + 1024), 0, 1, 2, 3, 4, 5, 6, 7); } while (0)
#define PG8_LDB8(dst, b, h) do { _Pragma("unroll") for (int n = 0; n < 2; ++n) dst[n] = __builtin_shufflevector(*(const PG8_LAS i32x4*)(lds + PG8_SB(b, h) + boff + n * 2048), *(const PG8_LAS i32x4*)(lds + PG8_SB(b, h) + boff + n * 2048 + 1024), 0, 1, 2, 3, 4, 5, 6, 7); } while (0)
#define PG8_MMA8(ai, bj, A8_, B8_) do { __builtin_amdgcn_s_setprio(1); _Pragma("unroll") for (int m = 0; m < 4; ++m) _Pragma("unroll") for (int n = 0; n < 2; ++n) \
        asm volatile("v_mfma_scale_f32_16x16x128_f8f6f4 %0, %1, %2, %0, %3, %3 op_sel_hi:[0,0,0]" : "+v"(acc[ai][bj][m][n]) : "v"(B8_[n]), "v"(A8_[m]), "v"(one8)); __builtin_amdgcn_s_setprio(0); } while (0)
#define PG8_MM(ai, bj, sel) do { if constexpr (Pol::FP8) PG8_MMA8(ai, bj, A8, sel##8); else PG8_MMA(ai, bj, At, sel); } while (0)
#define PG8_RDA(b, h) do { if constexpr (Pol::FP8) PG8_LDA8(A8, b, h); else PG8_LDA(At, b, h); } while (0)
#define PG8_RDB(sel, b, h) do { if constexpr (Pol::FP8) PG8_LDB8(sel##8, b, h); else PG8_LDB(sel, b, h); } while (0)
#define PG8_WAIT_V(n) asm volatile("s_waitcnt vmcnt(" #n ")" ::: "memory")
#define PG8_WAIT_L(n) asm volatile("s_waitcnt lgkmcnt(" #n ")" ::: "memory")
#define PG8_BAR __builtin_amdgcn_s_barrier()
#define PG8_SCHED __builtin_amdgcn_sched_barrier(0)
#define PG8_BSEL(q, tk, h) ((tk) < ksplit ? (q).b##h + (size_t)(tk) * kstep : (q).c##h + (size_t)((tk) - ksplit) * kstep)
    Unit cur, nxt; UPtr cp, np_; int ui = 0;
    if (!P.next(0, cur)) return;
    P.ptrs(cur, cp);
    if constexpr (Pol::GATHER) P.gather(cur, Rr, Cc, c00, c01, c10, c11);
    f32x4 acc[2][2][4][2];
#pragma unroll
    for (int a = 0; a < 2; ++a)
#pragma unroll
        for (int b = 0; b < 2; ++b)
#pragma unroll
            for (int m = 0; m < 4; ++m)
#pragma unroll
                for (int n = 0; n < 2; ++n) acc[a][b][m][n] = (f32x4){0.f, 0.f, 0.f, 0.f};
    const int one8 = 0x7f7f7f7f;
    bf16x8 At[4][2], B0[2][2], B1[2][2]; i32x8 A8[4], B08[2], B18[2];
    PG8_STAGE(PG8_SB(0, 0), cp.b0, voffB); PG8_STAGE(PG8_SB(0, 1), cp.b1, voffB); PG8_STAGE2(PG8_SA(0, 0), cp.a0, c00, c01); PG8_STAGE2(PG8_SA(0, 1), cp.a1, c10, c11);
    if (wr == 1) PG8_BAR;
    PG8_WAIT_V(2); PG8_BAR;
    PG8_STAGE(PG8_SB(1, 0), cp.b0 + kstep, voffB); PG8_STAGE2(PG8_SA(1, 0), cp.a0 + kstepA, c00, c01); PG8_STAGE(PG8_SB(1, 1), cp.b1 + kstep, voffB);
    PG8_WAIT_V(6); PG8_BAR;
    for (;;) {
        const bool has_next = P.next(ui + 1, nxt);
        if (has_next) { P.ptrs(nxt, np_); if constexpr (Pol::GATHER) P.gather(nxt, Rr, Cc, n00, n01, n10, n11); }
        else { np_ = cp; if constexpr (Pol::GATHER) { n00 = c00; n01 = c01; n10 = c10; n11 = c11; } }
#pragma unroll 1
        for (int t = 0; t < nt; t += 2) {
            const bool last = (t == nt - 2);
            int hf = __builtin_amdgcn_readfirstlane(P.half(cur) ? 1 : 0); asm volatile("" : "+s"(hf));
            if constexpr (Epi::MIDK_T >= 0) { if (t == Epi::MIDK_T) E.midk(acc, cur, wr, wc, fr, fq); }
            const char* a1_1 = cp.a1 + (size_t)(t + 1) * kstepA;
            const char *a2_0, *a2_1, *a3_0, *b2_0, *b2_1, *b3_0, *b3_1;
            if (!last) { a2_0 = cp.a0 + (size_t)(t + 2) * kstepA; a2_1 = cp.a1 + (size_t)(t + 2) * kstepA; a3_0 = cp.a0 + (size_t)(t + 3) * kstepA;
                         b2_0 = PG8_BSEL(cp, t + 2, 0); b2_1 = PG8_BSEL(cp, t + 2, 1); b3_0 = PG8_BSEL(cp, t + 3, 0); b3_1 = PG8_BSEL(cp, t + 3, 1); }
            else { a2_0 = np_.a0; a2_1 = np_.a1; a3_0 = np_.a0 + kstepA; b2_0 = np_.b0; b2_1 = np_.b1; b3_0 = np_.b0 + kstep; b3_1 = np_.b1 + kstep; }
            const unsigned s00 = (Pol::GATHER && last) ? n00 : c00, s01 = (Pol::GATHER && last) ? n01 : c01, s10 = (Pol::GATHER && last) ? n10 : c10, s11 = (Pol::GATHER && last) ? n11 : c11;
            PG8_RDB(B0, 0, 0); PG8_RDB(B1, 0, 1); PG8_SCHED; PG8_RDA(0, 0); PG8_STAGE2(PG8_SA(1, 1), a1_1, c10, c11);
            PG8_WAIT_V(8); PG8_WAIT_L(0); PG8_BAR; PG8_MM(0, 0, B0); PG8_MM(0, 1, B1); PG8_BAR; PG8_SCHED;
            if (!hf) PG8_RDA(0, 1); PG8_STAGE(PG8_SB(0, 0), b2_0, voffB); PG8_STAGE(PG8_SB(0, 1), b2_1, voffB); PG8_STAGE2(PG8_SA(0, 0), a2_0, s00, s01);
            PG8_WAIT_V(8); PG8_WAIT_L(0); PG8_BAR; if (!hf) { PG8_MM(1, 0, B0); PG8_MM(1, 1, B1); } PG8_BAR; PG8_SCHED;
            PG8_RDB(B0, 1, 0); PG8_RDB(B1, 1, 1); PG8_SCHED; PG8_RDA(1, 0); PG8_STAGE2(PG8_SA(0, 1), a2_1, s10, s11);
            PG8_WAIT_V(8); PG8_WAIT_L(0); PG8_BAR; PG8_MM(0, 0, B0); PG8_MM(0, 1, B1); PG8_BAR; PG8_SCHED;
            if (!hf) PG8_RDA(1, 1); PG8_STAGE(PG8_SB(1, 0), b3_0, voffB); PG8_STAGE(PG8_SB(1, 1), b3_1, voffB); PG8_STAGE2(PG8_SA(1, 0), a3_0, s00, s01);
            PG8_WAIT_V(8); PG8_WAIT_L(0); PG8_BAR; if (!hf) { PG8_MM(1, 0, B0); PG8_MM(1, 1, B1); } PG8_BAR; PG8_SCHED;
        }
        if constexpr (ALIGN_EPI) { if (wr == 0) PG8_BAR; }
        E(acc, cur, wr, wc, fr, fq);
        if (!has_next) break;
#pragma unroll
        for (int a = 0; a < 2; ++a)
#pragma unroll
            for (int b = 0; b < 2; ++b)
#pragma unroll
                for (int m = 0; m < 4; ++m)
#pragma unroll
                    for (int n = 0; n < 2; ++n) acc[a][b][m][n] = (f32x4){0.f, 0.f, 0.f, 0.f};
        cur = nxt; cp = np_; ++ui;
        if constexpr (Pol::GATHER) { c00 = n00; c01 = n01; c10 = n10; c11 = n11; }
        if constexpr (ALIGN_EPI) { if (wr == 1) PG8_BAR; }
    }
    PG8_WAIT_V(0);
    if constexpr (!ALIGN_EPI) { if (wr == 0) PG8_BAR; }
    PG8_BAR;
#undef PG8_SA
#undef PG8_SB
#undef PG8_STAGE
#undef PG8_STAGE2
#undef PG8_LDA
#undef PG8_LDB
#undef PG8_MMA
#undef PG8_MMA8
#undef PG8_MM
#undef PG8_RDA
#undef PG8_RDB
#undef PG8_LDA8
#undef PG8_LDB8
#undef PG8_WAIT_V
#undef PG8_WAIT_L
#undef PG8_BAR
#undef PG8_SCHED
#undef PG8_BSEL
}
struct DenseOrder {
    int nM, nN, nwg, G, c;
    DI void init(int nM_, int nN_, int G_, int c_) { nM = nM_; nN = nN_; nwg = nM * nN; G = G_; c = c_; }
    DI bool get(int i, int& pm, int& pn) const {
        const long L = (long)i * G + c; if (L >= nwg) return false;
        int wgid = (int)L; { const int q = nwg / 8, r = nwg % 8, xcd = wgid % 8, off = wgid / 8; wgid = (xcd < r ? xcd * (q + 1) : r * (q + 1) + (xcd - r) * q) + off; }
        const int nig = 8 * nN, gid = wgid / nig, fm = gid * 8, gsz = (nM - fm) < 8 ? (nM - fm) : 8;
        pm = fm + ((wgid % nig) % gsz); pn = (wgid % nig) / gsz; return true;
    }
};
}

DI void adaln_item(const Params& p, unsigned char* lds, int item) {
    float* scond = (float*)lds;
    float* red = scond + 9 * 1024;
    const int tid = tidx();
    for (int i = tid; i < 9 * 1024; i += NT) { const int r = i >> 10, k = i & 1023; const float v = r < 8 ? p.c[r * 1024 + k] : p.c_ctx[k]; scond[i] = v / (1.f + __expf(-v)); }
    __syncthreads();
    const int cc = tid & 31, ks = tid >> 5, col = item * 32 + cc;
    float a[9];
#pragma unroll
    for (int r = 0; r < 9; ++r) a[r] = 0.f;
#pragma unroll 1
    for (int kb = 0; kb < 4; ++kb) {
        const int kbase = ks * 64 + kb * 16; float w[16];
#pragma unroll
        for (int u = 0; u < 16; ++u) w[u] = p.w_ada[(size_t)(kbase + u) * 6144 + col];
#pragma unroll
        for (int u = 0; u < 16; ++u)
#pragma unroll
            for (int r = 0; r < 9; ++r) a[r] += scond[r * 1024 + kbase + u] * w[u];
    }
#pragma unroll
    for (int r = 0; r < 9; ++r) red[(ks * 9 + r) * 32 + cc] = a[r];
    __syncthreads();
    float* mod = (float*)(p.ws + WS_MOD);
    for (int o = tid; o < 9 * 32; o += NT) { const int r = o >> 5, c2 = o & 31; float s = 0.f;
#pragma unroll
        for (int q = 0; q < 16; ++q) s += red[(q * 9 + r) * 32 + c2];
        mod[r * 6144 + item * 32 + c2] = s + p.b_ada[item * 32 + c2]; }
    __syncthreads();
}
DI void tp_tile(const float* src, int ld, int k0, int n0, unsigned char* lds, bf16* dst, int jobkind, int e, const float* kscale = nullptr) {
    const int lane = tidx() & 63, q = lane >> 4, c = lane & 15;
    f32x4 v[16];
#pragma unroll
    for (int i = 0; i < 16; ++i) v[i] = *(const f32x4*)(src + (size_t)(k0 + 16 * q + i) * ld + n0 + 4 * c);
    if (kscale) {
#pragma unroll
        for (int i = 0; i < 16; ++i) v[i] = v[i] * kscale[k0 + 16 * q + i]; }
#pragma unroll
    for (int j = 0; j < 4; ++j) { const int ng = n0 + 4 * c + j;
        u32x4 o0, o1;
        o0.x = pk2(v[0][j], v[1][j]); o0.y = pk2(v[2][j], v[3][j]); o0.z = pk2(v[4][j], v[5][j]); o0.w = pk2(v[6][j], v[7][j]);
        o1.x = pk2(v[8][j], v[9][j]); o1.y = pk2(v[10][j], v[11][j]); o1.z = pk2(v[12][j], v[13][j]); o1.w = pk2(v[14][j], v[15][j]);
        size_t drow; int K;
        switch (jobkind) {
          case 0: drow = ng; K = 1024; break;
          case 1: drow = ng; K = 512; break;
          case 2: drow = ng; K = 1024; break;
          case 3: case 4: { const int h = ng, R = (h >> 7) * 256 + (jobkind == 4 ? 128 : 0) + (h & 127); drow = (size_t)e * 512 + R; K = 1024; } break;
          default: drow = (size_t)e * 1024 + ng; K = 256; break;
        }
        if (jobkind == 3 || jobkind == 4) {
            u32x4 o8; o8.x = pk4_fp8(v[0][j] * 32.f, v[1][j] * 32.f, v[2][j] * 32.f, v[3][j] * 32.f); o8.y = pk4_fp8(v[4][j] * 32.f, v[5][j] * 32.f, v[6][j] * 32.f, v[7][j] * 32.f);
            o8.z = pk4_fp8(v[8][j] * 32.f, v[9][j] * 32.f, v[10][j] * 32.f, v[11][j] * 32.f); o8.w = pk4_fp8(v[12][j] * 32.f, v[13][j] * 32.f, v[14][j] * 32.f, v[15][j] * 32.f);
            *(u32x4*)((unsigned char*)dst + drow * 1024 + k0 + 16 * q) = o8;
        } else if (jobkind == 5) {
            u32x4 o8; o8.x = pk4_fp8(v[0][j] * 16.f, v[1][j] * 16.f, v[2][j] * 16.f, v[3][j] * 16.f); o8.y = pk4_fp8(v[4][j] * 16.f, v[5][j] * 16.f, v[6][j] * 16.f, v[7][j] * 16.f);
            o8.z = pk4_fp8(v[8][j] * 16.f, v[9][j] * 16.f, v[10][j] * 16.f, v[11][j] * 16.f); o8.w = pk4_fp8(v[12][j] * 16.f, v[13][j] * 16.f, v[14][j] * 16.f, v[15][j] * 16.f);
            *(u32x4*)((unsigned char*)dst + drow * 256 + k0 + 16 * q) = o8;
        } else {
        bf16* d = dst + drow * K + k0 + 16 * q;
        *(u32x4*)d = o0; *(u32x4*)(d + 8) = o1; } }
}
constexpr int TP_J0 = 16 * 8, TP_J1 = 8 * 8, TP_J2 = 16 * 16, TP_J3 = 32 * 16 * 4, TP_J4 = TP_J3, TP_J5 = 32 * 4 * 16;
constexpr int TP_ITEMS = TP_J0 + TP_J1 + TP_J2 + TP_J3 + TP_J4 + TP_J5;
DI void tp_item(const Params& p, unsigned char* lds, int it) {
    unsigned char* ws = p.ws;
    if (it < TP_J0) { tp_tile(p.w_in, 1024, (it >> 3) * 64, (it & 7) * 64, lds, (bf16*)(ws + WS_WINT), 0, 0); return; } it -= TP_J0;
    if (it < TP_J1) { tp_tile(p.w_glu, 512, (it >> 3) * 64, (it & 7) * 64, lds, (bf16*)(ws + WS_WGLUT), 1, 0); return; } it -= TP_J1;
    if (it < TP_J2) { tp_tile(p.w_out, 1024, (it >> 4) * 64, (it & 15) * 64, lds, (bf16*)(ws + WS_WOUTT), 2, 0, (it >> 4) * 64 < 512 ? p.g_s : nullptr); return; } it -= TP_J2;
    if (it < TP_J3) { const int e = it >> 6, r = it & 63; tp_tile(p.w_gate + (size_t)e * 1024 * 256, 256, (r >> 2) * 64, (r & 3) * 64, lds, (bf16*)(ws + WS_WGUT), 3, e); return; } it -= TP_J3;
    if (it < TP_J4) { const int e = it >> 6, r = it & 63; tp_tile(p.w_up + (size_t)e * 1024 * 256, 256, (r >> 2) * 64, (r & 3) * 64, lds, (bf16*)(ws + WS_WGUT), 4, e); return; } it -= TP_J4;
    { const int e = it >> 6, r = it & 63; tp_tile(p.w_down + (size_t)e * 256 * 1024, 1024, (r >> 4) * 64, (r & 15) * 64, lds, (bf16*)(ws + WS_WDT), 5, e); }
}
DI void gfold_item(const Params& p, unsigned char* lds, int item) {
    const int q = item >> 6, k0 = (item & 63) * 16, tid = tidx(), lane = tid & 63, wid = tid >> 6, fr = lane & 15, fq = lane >> 4;
    const bf16* E = (const bf16*)(p.ws + WS_ETAB); const bf16* fwT = E + 256 * 128 + (size_t)q * 128 * 128;
    bf16* Tl = (bf16*)lds;
    bf16x8 af[4];
#pragma unroll
    for (int ks = 0; ks < 4; ++ks) { const float* wp = p.w_in + (size_t)(k0 + fr) * 1024 + 512 + 128 * q + ks * 32 + 8 * fq; const f32x4 w0 = *(const f32x4*)wp, w1 = *(const f32x4*)(wp + 4);
        u32x4 t; t.x = pk2(w0.x, w0.y); t.y = pk2(w0.z, w0.w); t.z = pk2(w1.x, w1.y); t.w = pk2(w1.z, w1.w); af[ks] = __builtin_bit_cast(bf16x8, t); }
#pragma unroll
    for (int t2 = 0; t2 < 2; ++t2) { const int nt = wid * 2 + t2, c = nt >> 3; f32x4 d = (f32x4){0.f, 0.f, 0.f, 0.f};
#pragma unroll
        for (int ks = 0; ks < 4; ++ks) { const bf16x8 bfr = *(const bf16x8*)(E + (size_t)(nt * 16 + fr) * 128 + ks * 32 + 8 * fq); d = __builtin_amdgcn_mfma_f32_16x16x32_bf16(af[ks], bfr, d, 0, 0, 0); }
#pragma unroll
        for (int r = 0; r < 4; ++r) Tl[(c * 16 + 4 * fq + r) * 136 + (nt & 7) * 16 + fr] = (bf16)(pk2(d[r], 0.f) & 0xffffu); }
    __syncthreads();
    bf16* WinT = (bf16*)(p.ws + WS_WINT);
    const float scale = 1.0f / 724.0773439350247f;
    { const int c = wid >> 2;
      bf16x8 a2[4];
#pragma unroll
      for (int ks = 0; ks < 4; ++ks) a2[ks] = *(const bf16x8*)(Tl + (c * 16 + fr) * 136 + ks * 32 + 8 * fq);
#pragma unroll
      for (int t2 = 0; t2 < 2; ++t2) { const int jt = (wid & 3) * 2 + t2; f32x4 d = (f32x4){0.f, 0.f, 0.f, 0.f};
#pragma unroll
          for (int ks = 0; ks < 4; ++ks) { const bf16x8 bfr = *(const bf16x8*)(fwT + (size_t)(jt * 16 + fr) * 128 + ks * 32 + 8 * fq); d = __builtin_amdgcn_mfma_f32_16x16x32_bf16(bfr, a2[ks], d, 0, 0, 0); }
#pragma unroll
          for (int r = 0; r < 4; ++r) WinT[(size_t)(512 + c * 512 + q * 128 + jt * 16 + 4 * fq + r) * 1024 + k0 + fr] = (bf16)(pk2(d[r] * scale, 0.f) & 0xffffu); } }
    __syncthreads();
}
DI void s5mats_item(const Params& p, unsigned char* lds, int item) {
    const int g = item >> 3, part = item & 7;
    const int tid = tidx();
    float* Bb = (float*)lds;
    float* Cc = Bb + 4096;
    float* pw = Cc + 4096;
    float* Kt = pw + 8448;
    float* qv = Kt;
    if (tid < 128) { const int d = tid >> 6, pp = tid & 63;
        const double dt = exp((double)p.log_step[d * 32 + g]); const double lr = p.lam_re[(d * 32 + g) * 64 + pp], li = p.lam_im[(d * 32 + g) * 64 + pp];
        const double mag = exp(lr * dt); double tt = li * dt / 3.14159265358979323846; tt -= 2.0 * floor(tt * 0.5);
        double sn, cs; sincospi(tt, &sn, &cs); const double ar = mag * cs, ai = mag * sn;
        const double nr = ar - 1.0, ni = ai, den = lr * lr + li * li;
        qv[tid * 2] = (float)((nr * lr + ni * li) / den); qv[tid * 2 + 1] = (float)((ni * lr - nr * li) / den);
        double pr = 1.0, pi = 0.0;
        for (int k = 0; k < 33; ++k) { pw[(tid * 33 + k) * 2] = (float)pr; pw[(tid * 33 + k) * 2 + 1] = (float)pi; const double t2 = pr * ar - pi * ai; pi = pr * ai + pi * ar; pr = t2; } }
    __syncthreads();
    for (int idx = tid; idx < 2 * 64 * 16; idx += NT) { const int dp = idx >> 4, h = idx & 15; const float qr = qv[dp * 2], qi = qv[dp * 2 + 1];
        const int d = dp >> 6, pp = dp & 63;
        const float br = p.b_re[((size_t)(d * 32 + g) * 64 + pp) * 16 + h], bi = p.b_im[((size_t)(d * 32 + g) * 64 + pp) * 16 + h];
        Bb[idx * 2] = qr * br - qi * bi; Bb[idx * 2 + 1] = qr * bi + qi * br; }
    for (int idx = tid; idx < 2 * 16 * 64; idx += NT) { const int d = idx >> 10, i = (idx >> 6) & 15, pp = idx & 63;
        Cc[idx * 2] = p.c_re[((size_t)(d * 32 + g) * 16 + i) * 64 + pp]; Cc[idx * 2 + 1] = p.c_im[((size_t)(d * 32 + g) * 16 + i) * 64 + pp]; }
    __syncthreads();
    { const int t3 = tid >> 2, pq = tid & 3, d = t3 >> 6, k = (t3 >> 1) & 31, i = part * 2 + (t3 & 1);
      float acc[16];
#pragma unroll
      for (int h = 0; h < 16; ++h) acc[h] = 0.f;
      for (int pp = pq * 16; pp < pq * 16 + 16; ++pp) {
          const float cr = Cc[((d * 16 + i) * 64 + pp) * 2], ci = Cc[((d * 16 + i) * 64 + pp) * 2 + 1];
          const float wr = pw[((d * 64 + pp) * 33 + k) * 2], wi = pw[((d * 64 + pp) * 33 + k) * 2 + 1];
          const float xr = cr * wr - ci * wi, xi = cr * wi + ci * wr;
          const f32x4* bb = (const f32x4*)(Bb + (d * 64 + pp) * 32);
#pragma unroll
          for (int h2 = 0; h2 < 8; ++h2) { const f32x4 b2 = bb[h2]; acc[2 * h2] += xr * b2.x - xi * b2.y; acc[2 * h2 + 1] += xr * b2.z - xi * b2.w; } }
#pragma unroll
      for (int h = 0; h < 16; ++h) { acc[h] += __shfl_xor(acc[h], 1); acc[h] += __shfl_xor(acc[h], 2); }
      if (pq == 0) {
#pragma unroll
          for (int h4 = 0; h4 < 4; ++h4) *(f32x4*)(Kt + ((d * 32 + k) * 16 + i) * 16 + h4 * 4) = (f32x4){acc[h4 * 4], acc[h4 * 4 + 1], acc[h4 * 4 + 2], acc[h4 * 4 + 3]}; } }
    __syncthreads();
    bf16* Mg = (bf16*)(p.ws + WS_MGW) + (size_t)g * 512 * 768;
    for (int c4 = tid; c4 < 64 * 64; c4 += NT) { const int rq = c4 >> 6, c8 = c4 & 63, j = rq >> 1, i = part * 2 + (rq & 1), row = j * 16 + i, s = c8 >> 1, h0 = (c8 & 1) * 8; float v[8];
#pragma unroll
        for (int t = 0; t < 8; ++t) { float a = 0.f; if (s <= j) a += Kt[((0 * 32 + (j - s)) * 16 + i) * 16 + h0 + t]; if (s >= j) a += Kt[((1 * 32 + (s - j)) * 16 + i) * 16 + h0 + t]; v[t] = a; }
        u32x4 o; o.x = pk2(v[0], v[1]); o.y = pk2(v[2], v[3]); o.z = pk2(v[4], v[5]); o.w = pk2(v[6], v[7]);
        *(u32x4*)(Mg + (size_t)row * 768 + c8 * 8) = o; }
    bf16* Wst = (bf16*)(p.ws + WS_WST) + (size_t)g * 256 * 512;
    for (int c4 = tid; c4 < 32 * 64; c4 += NT) { const int r = part * 32 + (c4 >> 6), c8 = c4 & 63, s = c8 >> 1, h0 = (c8 & 1) * 8, d = r >> 7, c = r & 1, pp = (r >> 1) & 63;
        const int e = d == 0 ? 31 - s : s; const float wr = pw[((d * 64 + pp) * 33 + e) * 2], wi = pw[((d * 64 + pp) * 33 + e) * 2 + 1]; float v[8];
#pragma unroll
        for (int t = 0; t < 8; ++t) { const float br = Bb[((d * 64 + pp) * 16 + h0 + t) * 2], bi = Bb[((d * 64 + pp) * 16 + h0 + t) * 2 + 1]; v[t] = c == 0 ? wr * br - wi * bi : wr * bi + wi * br; }
        u32x4 o; o.x = pk2(v[0], v[1]); o.y = pk2(v[2], v[3]); o.z = pk2(v[4], v[5]); o.w = pk2(v[6], v[7]);
        *(u32x4*)(Wst + (size_t)r * 512 + c8 * 8) = o; }
    bf16* Wos = (bf16*)(p.ws + WS_MGW) + (size_t)g * 512 * 768 + 512;
    for (int c4 = tid; c4 < 64 * 32; c4 += NT) { const int rq = c4 >> 5, c8 = c4 & 31, j = rq >> 1, i = part * 2 + (rq & 1), row = j * 16 + i, col0 = c8 * 8, d = col0 >> 7, p0 = (col0 >> 1) & 63;
        const int e = d == 0 ? j + 1 : 32 - j; float v[8];
#pragma unroll
        for (int t = 0; t < 8; ++t) { const int pp = p0 + (t >> 1), c = t & 1; const float cr = Cc[((d * 16 + i) * 64 + pp) * 2], ci = Cc[((d * 16 + i) * 64 + pp) * 2 + 1];
            const float wr = pw[((d * 64 + pp) * 33 + e) * 2], wi = pw[((d * 64 + pp) * 33 + e) * 2 + 1]; v[t] = c == 0 ? cr * wr - ci * wi : -(cr * wi + ci * wr); }
        u32x4 o; o.x = pk2(v[0], v[1]); o.y = pk2(v[2], v[3]); o.z = pk2(v[4], v[5]); o.w = pk2(v[6], v[7]);
        *(u32x4*)(Wos + (size_t)row * 768 + c8 * 8) = o; }
    float* aT = (float*)(p.ws + WS_ABART) + g * 256;
    if (part == 0 && tid < 128) { const int d = tid >> 6, pp = tid & 63; aT[tid * 2] = pw[((d * 64 + pp) * 33 + 32) * 2]; aT[tid * 2 + 1] = pw[((d * 64 + pp) * 33 + 32) * 2 + 1]; }
    __syncthreads();
}
DI void fftc_item(const Params& p, int item, int nitems) {
    const int tid = tidx();
    bf16* W1 = (bf16*)(p.ws + WS_FFTC);
    bf16* W2 = W1 + 128 * 128;
    float* tw = (float*)(p.ws + WS_FFTC + 32768 + 16384);
    for (int idx = item * NT + tid; idx < 128 * 128 + 4 * 64 * 32 + 4096; idx += nitems * NT) {
        if (idx < 16384) { const int n = idx >> 7, k = idx & 127, co = n >> 6, d = n & 63, ci = k >> 6, bq = k & 63; double s, c; sincospi((double)((d * bq) & 63) / 32.0, &s, &c);
            const float v = (ci == co) ? (float)c : (ci == 1 ? (float)s : (float)(-s)); W1[idx] = (bf16)(pk2(v, 0.f) & 0xffffu); }
        else if (idx < 16384 + 8192) { const int i2 = idx - 16384, s_ = i2 >> 11, cf = (i2 >> 5) & 63, slot = i2 & 31, gq = slot >> 3, jp = slot & 7;
            const int a = 16 * (2 * (s_ & 1) + (jp >> 2)) + 4 * gq + (jp & 3); double s, c; sincospi((double)((cf * a) & 63) / 32.0, &s, &c);
            W2[i2] = (bf16)(pk2((s_ >> 1) == 0 ? (float)c : (float)s, 0.f) & 0xffffu); }
        else { const int i3 = idx - 16384 - 8192, ln = i3 & 63, r = (i3 >> 6) & 3, mt = (i3 >> 8) & 3, nt = i3 >> 10; const int d = 16 * nt + (ln & 15), a = 16 * mt + 4 * (ln >> 4) + r;
            double s, c; sincospi((double)((d * a) & 4095) / 2048.0, &s, &c); tw[i3 * 2] = (float)c; tw[i3 * 2 + 1] = (float)s; }
    }
}
constexpr int P0_S5 = 256, P0_GF = 256;
constexpr int P0_ITEMS = P0_S5 + P0_GF;
DI void rw_item(const Params& p, int item, int nitems) {
    bf16* W = (bf16*)(p.ws + WS_WRT);
    for (int i = item * NT + tidx(); i < 48 * 1024; i += nitems * NT) { const int n = i >> 10, k = i & 1023; const float v = n < 4 ? p.w_group[k * 4 + n] : (n < 36 ? p.w_router[k * 32 + (n - 4)] : 0.f); W[i] = (bf16)(pk2(v, 0.f) & 0xffffu); }
}
DI void phaseA_adaln(const Params& p, unsigned char* lds, int bid, int nb) {
    for (int it = bid; it < 192 + 64; it += nb) {
        if (it < 192) { adaln_item(p, lds, it); continue; }
        const int t = it - 192, tid = tidx();
        bf16* E = (bf16*)(p.ws + WS_ETAB); bf16* fwT = E + 256 * 128;
        for (int i = t * NT + tid; i < 256 * 128; i += 64 * NT) { const int cn = i >> 7, m = i & 127, c = cn >> 7, n = cn & 127; double sv, cv; sincospi((double)((n * m) & 127) / 64.0, &sv, &cv);
            E[i] = (bf16)(pk2(c == 0 ? (float)cv : (float)(-sv), 0.f) & 0xffffu); }
        for (int i = t * NT + tid; i < 4 * 128 * 128; i += 64 * NT) { const int q = i >> 14, j = (i >> 7) & 127, n = i & 127; fwT[i] = (bf16)(pk2(p.fourier_w[((size_t)q * 128 + n) * 128 + j], 0.f) & 0xffffu); }
        fftc_item(p, t, 64); rw_item(p, t, 64);
    }
}
DI void a1_item(const Params& p, int r0) {
    const int lane = tidx() & 63;
    const float* mod = (const float*)(p.ws + WS_MOD);
    bf16* A1 = (bf16*)(p.ws + WS_R1);
    constexpr int RW = 4;
    const float* src = r0 < NTOK ? p.x + (size_t)r0 * D : p.ctx + (size_t)(r0 - NTOK) * D;
    const int mr = r0 < NTOK ? (r0 >> 12) : 8;
    f32x4 v[RW][4]; float s[RW];
#pragma unroll
    for (int q = 0; q < RW; ++q)
#pragma unroll
        for (int j = 0; j < 4; ++j) v[q][j] = ((const f32x4*)(src + (size_t)q * D) + lane)[64 * j];
    f32x4 gm[4], sh[4];
#pragma unroll
    for (int j = 0; j < 4; ++j) { const int k = lane * 4 + 256 * j; gm[j] = *(const f32x4*)(p.norm1_g + k) * (*(const f32x4*)(mod + mr * 6144 + 1024 + k) + 1.f); sh[j] = *(const f32x4*)(mod + mr * 6144 + k); }
#pragma unroll
    for (int q = 0; q < RW; ++q) { float t = 0.f;
#pragma unroll
        for (int j = 0; j < 4; ++j) t += (v[q][j].x * v[q][j].x + v[q][j].y * v[q][j].y) + (v[q][j].z * v[q][j].z + v[q][j].w * v[q][j].w);
        s[q] = t; }
#pragma unroll
    for (int o = 1; o < 64; o <<= 1) {
#pragma unroll
        for (int q = 0; q < RW; ++q) s[q] += __shfl_xor(s[q], o); }
#pragma unroll
    for (int q = 0; q < RW; ++q) { const float rs = rsqrtf(s[q] * (1.f / D) + EPS); u32x2* o = (u32x2*)(A1 + (size_t)(r0 + q) * D) + lane;
#pragma unroll
        for (int j = 0; j < 4; ++j) { const f32x4 h = v[q][j] * rs * gm[j] + sh[j]; u32x2 w; w.x = pk2(h.x, h.y); w.y = pk2(h.z, h.w); o[64 * j] = w; } }
}
constexpr int WI_A1 = NROWS1 / 4, WI_ALL = WI_A1 + TP_ITEMS;
DI void phaseAB_prep(const Params& p, unsigned char* lds, int bid, int nb) {
    phaseA_adaln(p, lds, bid, nb);
    unsigned* flag = (unsigned*)(p.ws + WS_CTL + CTL_FLAGA);
    asm volatile("s_waitcnt vmcnt(0)" ::: "memory");
    __syncthreads();
    if (tidx() == 0) { __builtin_amdgcn_fence(__ATOMIC_RELEASE, "agent"); asm volatile("s_waitcnt vmcnt(0)" ::: "memory"); (void)__hip_atomic_fetch_add(flag, 1u, __ATOMIC_RELAXED, __HIP_MEMORY_SCOPE_AGENT); }
    for (int it = bid; it < P0_S5; it += nb) s5mats_item(p, lds, it);
    if (tidx() == 0) { unsigned sp = 0; while (__hip_atomic_load(flag, __ATOMIC_RELAXED, __HIP_MEMORY_SCOPE_AGENT) < (unsigned)nb) { __builtin_amdgcn_s_sleep(2); if (++sp > (1u << 22)) break; }
        __builtin_amdgcn_fence(__ATOMIC_ACQUIRE, "agent"); asm volatile("s_waitcnt vmcnt(0)" ::: "memory"); }
    __syncthreads();
    for (int it = bid; it < P0_GF; it += nb) gfold_item(p, lds, it);
    __syncthreads();
    const int wid = tidx() >> 6;
    for (int it = bid * 8 + wid; it < WI_ALL; it += nb * 8) {
        if (it < WI_A1) a1_item(p, it * 4); else tp_item(p, lds, it - WI_A1);
    }
}

struct G1uPol {
    static constexpr bool FP8 = false;
    template <class U> DI bool half(const U&) const { return false; }
    static constexpr long KSTEP_A = 0;
    DI unsigned aoff(int R, int C) const { return (unsigned)(R * lda + C) * 2u; }
    struct Unit { int pm, pn; };
    static constexpr bool GATHER = false;
    pg8::DenseOrder ord; const char* A; const char* B; int K, ksplit, lda, ldb;
    DI bool next(int i, Unit& u) const { return ord.get(i, u.pm, u.pn); }
    DI void ptrs(const Unit& u, pg8::UPtr& q) const { q.a0 = A + (size_t)u.pm * 256 * lda * 2; q.a1 = q.a0 + (size_t)128 * lda * 2; q.b0 = B + (size_t)u.pn * 256 * ldb * 2; q.b1 = q.b0 + (size_t)128 * ldb * 2; q.c0 = q.b0; q.c1 = q.b1; }
    DI int brow(int R) const { return R; }
    DI void gather(const Unit&, int (&)[2], int (&)[2], unsigned&, unsigned&, unsigned&, unsigned&) const {}
};
struct G1uEpi {
    static constexpr int MIDK_T = -1;
    bf16* Ul;
    DI void operator()(const f32x4 (&acc)[2][2][4][2], const G1uPol::Unit& u, int wr, int wc, int fr, int fq) const {
#pragma unroll
        for (int ai = 0; ai < 2; ++ai)
#pragma unroll
            for (int m = 0; m < 4; ++m) { const int row = u.pm * 256 + ai * 128 + wr * 64 + m * 16 + fr, b = row >> 12, l = row & 4095;
#pragma unroll
                for (int bj = 0; bj < 2; ++bj) { const int c0 = u.pn * 256 + bj * 128 + wc * 32 + 8 * fq, g = c0 >> 4, h0 = c0 & 15;
                    const f32x4 a0 = acc[ai][bj][m][0], a1 = acc[ai][bj][m][1];
                    u32x4 w; w.x = pk2(a0[0], a0[1]); w.y = pk2(a0[2], a0[3]); w.z = pk2(a1[0], a1[1]); w.w = pk2(a1[2], a1[3]);
                    *(u32x4*)(Ul + (((size_t)g * 1024 + b * 128 + (l >> 5)) * 768 + (l & 31) * 16 + h0)) = w; } }
    }
};
struct G1gPol {
    static constexpr bool FP8 = false;
    template <class U> DI bool half(const U&) const { return false; }
    static constexpr long KSTEP_A = 0;
    DI unsigned aoff(int R, int C) const { return (unsigned)(R * lda + C) * 2u; }
    struct Unit { int pm, pn; };
    static constexpr bool GATHER = false;
    pg8::DenseOrder ord; const char* A; const char* B; int K, ksplit, lda, ldb;
    DI bool next(int i, Unit& u) const { return ord.get(i, u.pm, u.pn); }
    DI void ptrs(const Unit& u, pg8::UPtr& q) const { q.a0 = A + (size_t)u.pm * 256 * lda * 2; q.a1 = q.a0 + (size_t)128 * lda * 2;
        const int b = u.pn >> 4, a0 = (u.pn & 15) * 4; q.b0 = B + (size_t)(b * 4096 + a0) * ldb * 2; q.b1 = q.b0 + (size_t)2 * ldb * 2; q.c0 = q.b0; q.c1 = q.b1; }
    DI int brow(int R) const { return (R & 63) * 64 + (R >> 6); }
    DI void gather(const Unit&, int (&)[2], int (&)[2], unsigned&, unsigned&, unsigned&, unsigned&) const {}
};
struct G1gEpi {
    static constexpr int MIDK_T = -1;
    bf16* GT;
    DI void operator()(const f32x4 (&acc)[2][2][4][2], const G1gPol::Unit& u, int wr, int wc, int fr, int fq) const {
        const int b = u.pn >> 4, a0 = (u.pn & 15) * 4;
#pragma unroll
        for (int ai = 0; ai < 2; ++ai)
#pragma unroll
            for (int m = 0; m < 4; ++m) { const int mm = u.pm * 256 + ai * 128 + wr * 64 + m * 16 + fr, c = mm >> 9, ch = mm & 511;
                bf16* base = GT + (size_t)((b * 512 + ch) * 2 + c) * 4096;
#pragma unroll
                for (int bj = 0; bj < 2; ++bj) { const int a = a0 + 2 * bj + (wc >> 1), bq = 32 * (wc & 1) + 8 * fq;
                    const f32x4 v0 = acc[ai][bj][m][0], v1 = acc[ai][bj][m][1];
                    u32x4 w; w.x = pk2(v0[0], v0[1]); w.y = pk2(v0[2], v0[3]); w.z = pk2(v1[0], v1[1]); w.w = pk2(v1[2], v1[3]);
                    *(u32x4*)(base + a * 64 + bq) = w; } }
    }
};
DI void phase1b(const Params& p, unsigned char* lds, int bid, int nb) {
    { G1gPol P; P.ord.init(4, NTOK / 256, nb, bid); P.A = (const char*)(p.ws + WS_WINT) + (size_t)512 * 2048; P.B = (const char*)(p.ws + WS_R1); P.K = 1024; P.ksplit = 16; P.lda = 1024; P.ldb = 1024;
      G1gEpi E{(bf16*)(p.ws + WS_R2)};
      pg8::gemm_phase<G1gPol, G1gEpi, true>((PG8_LAS unsigned char*)lds, P, E); }
    { G1uPol P; P.ord.init(NTOK / 256, 2, nb, bid); P.A = (const char*)(p.ws + WS_R1); P.B = (const char*)(p.ws + WS_WINT); P.K = 1024; P.ksplit = 16; P.lda = 1024; P.ldb = 1024;
      G1uEpi E{(bf16*)(p.ws + WS_R3)};
      pg8::gemm_phase<G1uPol, G1uEpi, true>((PG8_LAS unsigned char*)lds, P, E); }
    { const int tid = tidx(), lane = tid & 63, wid = tid >> 6, fr = lane & 15, fq = lane >> 4;
      for (int item = bid; item < 256; item += nb) { const int g = item >> 3, b = item & 7;
          const bf16* A1c = (const bf16*)(p.ws + WS_R1) + (size_t)(NTOK + b * 256 + wid * 32) * D; const bf16* Wg = (const bf16*)(p.ws + WS_WINT) + (size_t)(g * 16) * D;
          f32x4 ca[2] = {(f32x4){0.f, 0.f, 0.f, 0.f}, (f32x4){0.f, 0.f, 0.f, 0.f}};
#pragma unroll 8
          for (int ks = 0; ks < 32; ++ks) { const bf16x8 bw = *(const bf16x8*)(Wg + (size_t)fr * D + ks * 32 + fq * 8);
              const bf16x8 a0 = *(const bf16x8*)(A1c + (size_t)fr * D + ks * 32 + fq * 8), a1 = *(const bf16x8*)(A1c + (size_t)(16 + fr) * D + ks * 32 + fq * 8);
              ca[0] = __builtin_amdgcn_mfma_f32_16x16x32_bf16(bw, a0, ca[0], 0, 0, 0); ca[1] = __builtin_amdgcn_mfma_f32_16x16x32_bf16(bw, a1, ca[1], 0, 0, 0); }
          bf16* Ucw = (bf16*)(p.ws + WS_R4) + ((size_t)g * 256 + b * 8 + wid) * 768;
#pragma unroll
          for (int mt = 0; mt < 2; ++mt) { u32x2 w; w.x = pk2(ca[mt][0], ca[mt][1]); w.y = pk2(ca[mt][2], ca[mt][3]); *(u32x2*)(Ucw + (size_t)(mt * 16 + fr) * 16 + 4 * fq) = w; } } }
}
struct S5aPol {
    static constexpr bool FP8 = false;
    template <class U> DI bool half(const U&) const { return false; }
    struct Unit { int g, mt; };
    static constexpr bool GATHER = false;
    static constexpr long KSTEP_A = 0;
    int G, c; const char* A; const char* Ac; const char* B; int K, ksplit, lda, ldb;
    DI unsigned aoff(int R, int C) const { return (unsigned)(R * lda + C) * 2u; }
    DI bool next(int i, Unit& u) const { const int L = i * G + c; if (L >= 160) return false; u.g = L / 5; u.mt = L % 5; return true; }
    DI void ptrs(const Unit& u, pg8::UPtr& q) const { q.a0 = u.mt < 4 ? A + ((size_t)u.g * 1024 + u.mt * 256) * lda * 2 : Ac + (size_t)u.g * 256 * lda * 2; q.a1 = q.a0 + (size_t)128 * lda * 2;
        q.b0 = B + (size_t)u.g * 256 * ldb * 2; q.b1 = q.b0 + (size_t)128 * ldb * 2; q.c0 = q.b0; q.c1 = q.b1; }
    DI int brow(int R) const { return R; }
    DI void gather(const Unit&, int (&)[2], int (&)[2], unsigned&, unsigned&, unsigned&, unsigned&) const {}
};
struct S5aEpi {
    static constexpr int MIDK_T = -1;
    bf16* S;
    DI void operator()(const f32x4 (&acc)[2][2][4][2], const S5aPol::Unit& u, int wr, int wc, int fr, int fq) const {
#pragma unroll
        for (int ai = 0; ai < 2; ++ai)
#pragma unroll
            for (int m = 0; m < 4; ++m) { bf16* dst = S + ((size_t)u.g * 1280 + u.mt * 256 + ai * 128 + wr * 64 + m * 16 + fr) * 256 + wc * 32 + 8 * fq;
#pragma unroll
                for (int bj = 0; bj < 2; ++bj) { const f32x4 v0 = acc[ai][bj][m][0], v1 = acc[ai][bj][m][1];
                    u32x4 w; w.x = pk2(v0[0], v0[1]); w.y = pk2(v0[2], v0[3]); w.z = pk2(v1[0], v1[1]); w.w = pk2(v1[2], v1[3]);
                    *(u32x4*)(dst + bj * 128) = w; } }
    }
};
DI void phase2a_s5states(const Params& p, unsigned char* lds, int bid, int nb) {
    S5aPol P; P.G = nb; P.c = bid; P.A = (const char*)(p.ws + WS_R3); P.Ac = (const char*)(p.ws + WS_R4); P.B = (const char*)(p.ws + WS_WST); P.K = 512; P.ksplit = 8; P.lda = 768; P.ldb = 512;
    S5aEpi E{(bf16*)(p.ws + WS_R1)};
    pg8::gemm_phase<S5aPol, S5aEpi, true>((PG8_LAS unsigned char*)lds, P, E);
}
DI void phase2b_scan(const Params& p, int bid, int nb) {
    const int lane = tidx() & 63, wid = tidx() >> 6;
    for (int item = bid + wid * nb; item < 512; item += nb * 8) {
        const int d = item & 1, gb = item >> 1, g = gb >> 3, b = gb & 7;
        const float* aT = (const float*)(p.ws + WS_ABART) + g * 256 + (d * 64 + lane) * 2; const float ar = aT[0], ai = aT[1];
        const unsigned* Sg = (const unsigned*)((const bf16*)(p.ws + WS_R1) + (size_t)g * 1280 * 256 + d * 128) + lane;
        unsigned* Hout = (unsigned*)((bf16*)(p.ws + WS_R3) + ((size_t)g * 1024 + b * 128) * 768 + 512 + d * 128) + lane;
        float hr = 0.f, hi = 0.f;
        { unsigned sv[8];
#pragma unroll
          for (int j = 0; j < 8; ++j) { const int c = d == 0 ? j : 7 - j; sv[j] = Sg[(size_t)(1024 + b * 8 + c) * 128]; }
#pragma unroll
          for (int j = 0; j < 8; ++j) { const float sr = __uint_as_float(sv[j] << 16), si = __uint_as_float(sv[j] & 0xffff0000u); const float nr = ar * hr - ai * hi + sr, ni = ar * hi + ai * hr + si; hr = nr; hi = ni; } }
#pragma unroll 1
        for (int cb = 0; cb < 128; cb += 32) { unsigned sv[32];
#pragma unroll
            for (int j = 0; j < 32; ++j) { const int c = d == 0 ? cb + j : 127 - cb - j; sv[j] = Sg[(size_t)(b * 128 + c) * 128]; }
#pragma unroll
            for (int j = 0; j < 32; ++j) { const int c = d == 0 ? cb + j : 127 - cb - j; Hout[(size_t)c * 384] = pk2(hr, hi);
                const float sr = __uint_as_float(sv[j] << 16), si = __uint_as_float(sv[j] & 0xffff0000u); const float nr = ar * hr - ai * hi + sr, ni = ar * hi + ai * hr + si; hr = nr; hi = ni; } }
    }
}
struct S5cPol {
    static constexpr bool FP8 = false;
    template <class U> DI bool half(const U&) const { return false; }
    static constexpr long KSTEP_A = 0;
    DI unsigned aoff(int R, int C) const { return (unsigned)(R * lda + C) * 2u; }
    struct Unit { int g, mt, pn; };
    static constexpr bool GATHER = false;
    int G, c; const char* A; const char* B; int K, ksplit, lda, ldb;
    DI bool next(int i, Unit& u) const { const int L = i * G + c; if (L >= 256) return false; u.g = L >> 3; u.mt = (L >> 1) & 3; u.pn = L & 1; return true; }
    DI void ptrs(const Unit& u, pg8::UPtr& q) const { q.a0 = A + ((size_t)u.g * 1024 + u.mt * 256) * lda * 2; q.a1 = q.a0 + (size_t)128 * lda * 2; q.b0 = B + ((size_t)u.g * 512 + u.pn * 256) * ldb * 2; q.b1 = q.b0 + (size_t)128 * ldb * 2; q.c0 = q.b0; q.c1 = q.b1; }
    DI int brow(int R) const { return R; }
    DI void gather(const Unit&, int (&)[2], int (&)[2], unsigned&, unsigned&, unsigned&, unsigned&) const {}
};
struct S5cEpi {
    static constexpr int MIDK_T = -1;
    const bf16* Ucat; const float* s5d; bf16* yact;
    DI void operator()(const f32x4 (&acc)[2][2][4][2], const S5cPol::Unit& u, int wr, int wc, int fr, int fq) const {
        const int n0 = u.pn * 256 + wc * 32 + 8 * fq, i0 = n0 & 15;
        const f32x4 d0 = *(const f32x4*)(s5d + u.g * 16 + i0), d1 = *(const f32x4*)(s5d + u.g * 16 + i0 + 4);
#pragma unroll
        for (int ai = 0; ai < 2; ++ai) {
            u32x4 uu[4][2];
#pragma unroll
            for (int m = 0; m < 4; ++m) { const int row = u.mt * 256 + ai * 128 + wr * 64 + m * 16 + fr;
#pragma unroll
                for (int bj = 0; bj < 2; ++bj) uu[m][bj] = *(const u32x4*)(Ucat + ((size_t)u.g * 1024 + row) * 768 + n0 + bj * 128); }
#pragma unroll
            for (int m = 0; m < 4; ++m) { const int row = u.mt * 256 + ai * 128 + wr * 64 + m * 16 + fr, b = row >> 7, c = row & 127;
#pragma unroll
                for (int bj = 0; bj < 2; ++bj) { const int col = n0 + bj * 128, l = 32 * c + (col >> 4); const u32x4 v = uu[m][bj]; const f32x4 a0 = acc[ai][bj][m][0], a1 = acc[ai][bj][m][1];
                    const float y0 = geluf_(a0[0] + d0.x * __uint_as_float(v.x << 16)), y1 = geluf_(a0[1] + d0.y * __uint_as_float(v.x & 0xffff0000u));
                    const float y2 = geluf_(a0[2] + d0.z * __uint_as_float(v.y << 16)), y3 = geluf_(a0[3] + d0.w * __uint_as_float(v.y & 0xffff0000u));
                    const float y4 = geluf_(a1[0] + d1.x * __uint_as_float(v.z << 16)), y5 = geluf_(a1[1] + d1.y * __uint_as_float(v.z & 0xffff0000u));
                    const float y6 = geluf_(a1[2] + d1.z * __uint_as_float(v.w << 16)), y7 = geluf_(a1[3] + d1.w * __uint_as_float(v.w & 0xffff0000u));
                    u32x4 w; w.x = pk2(y0, y1); w.y = pk2(y2, y3); w.z = pk2(y4, y5); w.w = pk2(y6, y7);
                    *(u32x4*)(yact + (((size_t)u.g * NTOK + b * 4096 + l) * 16 + i0)) = w; } }
            asm volatile("" ::: "memory");
        }
    }
};
DI void phase2c_s5out(const Params& p, unsigned char* lds, int bid, int nb) {
    S5cPol P; P.G = nb; P.c = (nb % 8 == 0) ? (bid % 8) * (nb / 8) + bid / 8 : bid; P.A = (const char*)(p.ws + WS_R3); P.B = (const char*)(p.ws + WS_MGW); P.K = 768; P.ksplit = 12; P.lda = 768; P.ldb = 768;
    S5cEpi E{(const bf16*)(p.ws + WS_R3), p.s5_d, (bf16*)(p.ws + WS_R4)};
    pg8::gemm_phase<S5cPol, S5cEpi, true>((PG8_LAS unsigned char*)lds, P, E);
}
constexpr int FF_W1P = 272, FF_W2P = 80, FF_W1_OFF = 0, FF_W2_OFF = 128 * FF_W1P, FF_TW_OFF = FF_W2_OFF + 4 * 64 * FF_W2P, FF_LDS = FF_TW_OFF + 32768;
DI void phase2_fft(const Params& p, unsigned char* lds, int bid, int nb) {
    const int tid = tidx(), lane = tid & 63, wid = tid >> 6, fr = lane & 15, fq = lane >> 4;
    { const bf16* W1 = (const bf16*)(p.ws + WS_FFTC); const bf16* W2 = W1 + 128 * 128; const float* tw = (const float*)(p.ws + WS_FFTC + 32768 + 16384);
      for (int i = tid; i < 128 * 16; i += NT) { const int n = i >> 4, c = i & 15; *(u32x4*)(lds + FF_W1_OFF + n * FF_W1P + c * 16) = *(const u32x4*)(W1 + n * 128 + c * 8); }
      for (int i = tid; i < 256 * 4; i += NT) { const int r = i >> 2, c = i & 3; *(u32x4*)(lds + FF_W2_OFF + r * FF_W2P + c * 16) = *(const u32x4*)(W2 + r * 32 + c * 8); }
      for (int i = tid; i < 2048; i += NT) *(u32x4*)(lds + FF_TW_OFF + i * 16) = *(const u32x4*)(tw + i * 4);
      __syncthreads(); }
    const bf16* GT = (const bf16*)(p.ws + WS_R2); bf16* FT = (bf16*)(p.ws + WS_R5);
    const float* twl = (const float*)(lds + FF_TW_OFF) + lane * 2;
    for (int cidx = bid * 8 + wid; cidx < 4096; cidx += nb * 8) {
        const bf16* gt = GT + (size_t)cidx * 2 * 4096;
        bf16* ft = FT + (size_t)cidx * 4096;
        bf16x8 afr[4][4];
#pragma unroll
        for (int ks = 0; ks < 4; ++ks)
#pragma unroll
            for (int mt = 0; mt < 4; ++mt) afr[ks][mt] = *(const bf16x8*)(gt + (ks >> 1) * 4096 + (16 * mt + fr) * 64 + 32 * (ks & 1) + 8 * fq);
        bf16x8 frag[4][4];
        __builtin_amdgcn_sched_barrier(0);
#pragma unroll
        for (int mh = 0; mh < 2; ++mh) {
            f32x4 d1[2][8];
#pragma unroll
            for (int m = 0; m < 2; ++m)
#pragma unroll
                for (int n = 0; n < 8; ++n) d1[m][n] = (f32x4){0.f, 0.f, 0.f, 0.f};
#pragma unroll
            for (int ks = 0; ks < 4; ++ks) {
#pragma unroll
                for (int nt = 0; nt < 8; ++nt) { const bf16x8 bfr = *(const bf16x8*)(lds + FF_W1_OFF + (nt * 16 + fr) * FF_W1P + (ks * 32 + fq * 8) * 2);
#pragma unroll
                    for (int m = 0; m < 2; ++m) d1[m][nt] = __builtin_amdgcn_mfma_f32_16x16x32_bf16(afr[ks][2 * mh + m], bfr, d1[m][nt], 0, 0, 0); }
                __builtin_amdgcn_sched_barrier(0);
            }
#pragma unroll
            for (int nt = 0; nt < 4; ++nt) { unsigned pr[2][2], pi[2][2];
#pragma unroll
                for (int m = 0; m < 2; ++m) { const int mt = 2 * mh + m; float tr[4], ti[4];
#pragma unroll
                    for (int r = 0; r < 4; ++r) { const float cs = twl[((nt * 4 + mt) * 4 + r) * 128], sn = twl[((nt * 4 + mt) * 4 + r) * 128 + 1];
                        const float re = d1[m][nt][r], im = d1[m][nt + 4][r]; tr[r] = re * cs + im * sn; ti[r] = im * cs - re * sn; }
                    pr[m][0] = pk2(tr[0], tr[1]); pr[m][1] = pk2(tr[2], tr[3]); pi[m][0] = pk2(ti[0], ti[1]); pi[m][1] = pk2(ti[2], ti[3]); }
                u32x4 f0, f2;
                f0.x = pr[0][0]; f0.y = pr[0][1]; f0.z = pr[1][0]; f0.w = pr[1][1];
                f2.x = pi[0][0]; f2.y = pi[0][1]; f2.z = pi[1][0]; f2.w = pi[1][1];
                frag[nt][mh] = __builtin_bit_cast(bf16x8, f0); frag[nt][2 + mh] = __builtin_bit_cast(bf16x8, f2);
                __builtin_amdgcn_sched_barrier(0); }
        }
#pragma unroll
        for (int nt = 0; nt < 4; ++nt) {
            f32x4 z[4];
#pragma unroll
            for (int n = 0; n < 4; ++n) z[n] = (f32x4){0.f, 0.f, 0.f, 0.f};
#pragma unroll
            for (int s2 = 0; s2 < 4; ++s2)
#pragma unroll
                for (int n2 = 0; n2 < 4; ++n2) { const bf16x8 bfr = *(const bf16x8*)(lds + FF_W2_OFF + ((s2 * 64 + n2 * 16 + fr) * FF_W2P) + fq * 16);
                    z[n2] = __builtin_amdgcn_mfma_f32_16x16x32_bf16(frag[nt][s2], bfr, z[n2], 0, 0, 0); }
#pragma unroll
            for (int n2 = 0; n2 < 4; ++n2) { const int cf = 16 * n2 + fr; u32x2 w; w.x = pk2(z[n2][0], z[n2][1]); w.y = pk2(z[n2][2], z[n2][3]);
                *(u32x2*)(ft + 64 * cf + 16 * nt + 4 * fq) = w; }
            __builtin_amdgcn_sched_barrier(0);
        }
    }
}
struct GluPol {
    static constexpr bool FP8 = false;
    template <class U> DI bool half(const U&) const { return false; }
    struct Unit { int pm, pn; };
    static constexpr bool GATHER = false;
    static constexpr long KSTEP_A = 4L * NTOK * 16 * 2;
    pg8::DenseOrder ord; const char* A; const char* B; int K, ksplit, lda, ldb;
    DI unsigned aoff(int R, int C) const { return (unsigned)(((C >> 4) * NTOK + R) * 16 + (C & 15)) * 2u; }
    DI bool next(int i, Unit& u) const { return ord.get(i, u.pm, u.pn); }
    DI void ptrs(const Unit& u, pg8::UPtr& q) const { q.a0 = A + (size_t)u.pm * 256 * 32; q.a1 = q.a0 + (size_t)128 * 32; q.b0 = B + (size_t)u.pn * 256 * ldb * 2; q.b1 = q.b0 + (size_t)128 * ldb * 2; q.c0 = q.b0; q.c1 = q.b1; }
    DI int brow(int R) const { return R; }
    DI void gather(const Unit&, int (&)[2], int (&)[2], unsigned&, unsigned&, unsigned&, unsigned&) const {}
};
struct GluEpi {
    static constexpr int MIDK_T = -1;
    const bf16* yact; bf16* merged; float* rsqs;
    DI void operator()(const f32x4 (&acc)[2][2][4][2], const GluPol::Unit& u, int wr, int wc, int fr, int fq) const {
        const int col0 = u.pn * 256 + wc * 32 + 8 * fq;
#pragma unroll
        for (int ai = 0; ai < 2; ++ai) {
            u32x4 yy[4][2];
#pragma unroll
            for (int m = 0; m < 4; ++m) { const int row = u.pm * 256 + ai * 128 + wr * 64 + m * 16 + fr;
#pragma unroll
                for (int bj = 0; bj < 2; ++bj) { const int col = col0 + bj * 128; yy[m][bj] = *(const u32x4*)(yact + ((size_t)(col >> 4) * NTOK + row) * 16 + (col & 15)); } }
#pragma unroll
            for (int m = 0; m < 4; ++m) { const int row = u.pm * 256 + ai * 128 + wr * 64 + m * 16 + fr; float sq = 0.f;
#pragma unroll
                for (int bj = 0; bj < 2; ++bj) { const u32x4 y = yy[m][bj]; const f32x4 a0 = acc[ai][bj][m][0], a1 = acc[ai][bj][m][1];
                    const float y0 = __uint_as_float(y.x << 16) * sigmoidf_(a0[0]), y1 = __uint_as_float(y.x & 0xffff0000u) * sigmoidf_(a0[1]);
                    const float y2 = __uint_as_float(y.y << 16) * sigmoidf_(a0[2]), y3 = __uint_as_float(y.y & 0xffff0000u) * sigmoidf_(a0[3]);
                    const float y4 = __uint_as_float(y.z << 16) * sigmoidf_(a1[0]), y5 = __uint_as_float(y.z & 0xffff0000u) * sigmoidf_(a1[1]);
                    const float y6 = __uint_as_float(y.w << 16) * sigmoidf_(a1[2]), y7 = __uint_as_float(y.w & 0xffff0000u) * sigmoidf_(a1[3]);
                    u32x4 w; w.x = pk2(y0, y1); w.y = pk2(y2, y3); w.z = pk2(y4, y5); w.w = pk2(y6, y7); *(u32x4*)(merged + (size_t)row * 1024 + col0 + bj * 128) = w;
                    sq += ((y0 * y0 + y1 * y1) + (y2 * y2 + y3 * y3)) + ((y4 * y4 + y5 * y5) + (y6 * y6 + y7 * y7)); }
                sq += __shfl_xor(sq, 16); sq += __shfl_xor(sq, 32);
                if (fq == 0) rsqs[(size_t)row * 8 + u.pn * 4 + wc] = sq; }
            asm volatile("" ::: "memory");
        }
    }
};
DI void phase3_glu(const Params& p, unsigned char* lds, int bid, int nb) {
    GluPol P; P.ord.init(NTOK / 256, 2, nb, bid); P.A = (const char*)(p.ws + WS_R4); P.B = (const char*)(p.ws + WS_WGLUT); P.K = 512; P.ksplit = 8; P.lda = 512; P.ldb = 512;
    GluEpi E{(const bf16*)(p.ws + WS_R4), (bf16*)(p.ws + WS_R1), (float*)(p.ws + WS_RSQS)};
    pg8::gemm_phase<GluPol, GluEpi, true>((PG8_LAS unsigned char*)lds, P, E);
}
constexpr int FM_PITCH = 132, FM_LDS = 512 * FM_PITCH;
DI void phase3_fin(const Params& p, unsigned char* lds, int bid, int nb) {
    const int tid = tidx(), lane = tid & 63, wid = tid >> 6;
    const bf16* FT = (const bf16*)(p.ws + WS_R5); bf16* merged = (bf16*)(p.ws + WS_R1);
    float gf[8];
#pragma unroll
    for (int j = 0; j < 8; ++j) gf[j] = p.g_f[lane + 64 * j];
    for (int item = bid; item < 512; item += nb) {
        const int b = item >> 6, k0 = (item & 63) * 64;
        { u32x4 v[8];
#pragma unroll
          for (int i = 0; i < 8; ++i) { const int ix = tid + NT * i, ch = ix >> 3, c = ix & 7; v[i] = *(const u32x4*)(FT + ((size_t)(b * 512 + ch) * 4096 + k0 + c * 8)); }
#pragma unroll
          for (int i = 0; i < 8; ++i) { const int ix = tid + NT * i, ch = ix >> 3, c = ix & 7; unsigned* d = (unsigned*)(lds + ch * FM_PITCH + c * 16); d[0] = v[i].x; d[1] = v[i].y; d[2] = v[i].z; d[3] = v[i].w; } }
        __syncthreads();
        float f[8][8], s[8];
#pragma unroll
        for (int t = 0; t < 8; ++t)
#pragma unroll
            for (int j = 0; j < 8; ++j) f[t][j] = bf2f(*(const bf16*)(lds + (lane + 64 * j) * FM_PITCH + (wid * 8 + t) * 2));
#pragma unroll
        for (int t = 0; t < 8; ++t) { float a = 0.f;
#pragma unroll
            for (int j = 0; j < 8; ++j) a += f[t][j] * f[t][j];
            s[t] = a; }
#pragma unroll
        for (int o = 1; o < 64; o <<= 1) {
#pragma unroll
            for (int t = 0; t < 8; ++t) s[t] += __shfl_xor(s[t], o); }
#pragma unroll
        for (int t = 0; t < 8; ++t) { const size_t row = (size_t)b * 4096 + k0 + wid * 8 + t; const float rs = rsqrtf(s[t] * (1.f / 512.f) + EPS);
#pragma unroll
            for (int j = 0; j < 8; ++j) merged[row * 1024 + 512 + lane + 64 * j] = (bf16)(pk2(f[t][j] * rs * gf[j], 0.f) & 0xffffu); }
        __syncthreads();
    }
}
struct P4Pol {
    static constexpr bool FP8 = false;
    template <class U> DI bool half(const U&) const { return false; }
    static constexpr long KSTEP_A = 0;
    DI unsigned aoff(int R, int C) const { return (unsigned)(R * lda + C) * 2u; }
    struct Unit { int pm, pn; };
    static constexpr bool GATHER = false;
    pg8::DenseOrder ord; const char* A; const char* B; int K, ksplit, lda, ldb;
    DI bool next(int i, Unit& u) const { return ord.get(i, u.pm, u.pn); }
    DI void ptrs(const Unit& u, pg8::UPtr& q) const { q.a0 = A + (size_t)u.pm * 256 * lda * 2; q.a1 = q.a0 + (size_t)128 * lda * 2; q.b0 = B + (size_t)u.pn * 256 * ldb * 2; q.b1 = q.b0 + (size_t)128 * ldb * 2; q.c0 = q.b0; q.c1 = q.b1; }
    DI int brow(int R) const { return R; }
    DI void gather(const Unit&, int (&)[2], int (&)[2], unsigned&, unsigned&, unsigned&, unsigned&) const {}
};
struct P4Epi {
    static constexpr int MIDK_T = 8;
    const float* x; bf16* x1b; const float* mod; float* rsqp; const float* rss;
    DI void midk(f32x4 (&acc)[2][2][4][2], const P4Pol::Unit& u, int wr, int wc, int fr, int fq) const {
        float r[2][4]; f32x4 q0[2][4], q1[2][4];
#pragma unroll
        for (int ai = 0; ai < 2; ++ai)
#pragma unroll
            for (int m = 0; m < 4; ++m) { const f32x4* q = (const f32x4*)(rss + (size_t)(u.pm * 256 + ai * 128 + wr * 64 + m * 16 + fr) * 8); q0[ai][m] = q[0]; q1[ai][m] = q[1]; }
#pragma unroll
        for (int ai = 0; ai < 2; ++ai)
#pragma unroll
            for (int m = 0; m < 4; ++m) r[ai][m] = rsqrtf((((q0[ai][m].x + q0[ai][m].y) + (q0[ai][m].z + q0[ai][m].w)) + ((q1[ai][m].x + q1[ai][m].y) + (q1[ai][m].z + q1[ai][m].w))) * (1.f / 512.f) + EPS);
#pragma unroll
        for (int ai = 0; ai < 2; ++ai)
#pragma unroll
            for (int m = 0; m < 4; ++m)
#pragma unroll
                for (int bj = 0; bj < 2; ++bj)
#pragma unroll
                    for (int n = 0; n < 2; ++n) acc[ai][bj][m][n] = acc[ai][bj][m][n] * r[ai][m];
    }
    DI void operator()(const f32x4 (&acc)[2][2][4][2], const P4Pol::Unit& u, int wr, int wc, int fr, int fq) const {
        const int col0 = u.pn * 256 + wc * 32 + 8 * fq, b = (u.pm * 256) >> 12;
        f32x4 gv[2][2];
#pragma unroll
        for (int bj = 0; bj < 2; ++bj)
#pragma unroll
            for (int n = 0; n < 2; ++n) gv[bj][n] = *(const f32x4*)(mod + b * 6144 + 2048 + col0 + bj * 128 + n * 4);
        f32x4 xa[2][2][2], xb[2][2][2];
#define P4_LOAD(dst, q_) do { const int ai_ = (q_) >> 1, mb_ = ((q_) & 1) * 2; _Pragma("unroll") for (int m2 = 0; m2 < 2; ++m2) { const int row_ = u.pm * 256 + ai_ * 128 + wr * 64 + (mb_ + m2) * 16 + fr; \
            _Pragma("unroll") for (int bj = 0; bj < 2; ++bj) _Pragma("unroll") for (int n = 0; n < 2; ++n) dst[m2][bj][n] = *(const f32x4*)(x + (size_t)row_ * D + col0 + bj * 128 + n * 4); } } while (0)
#define P4_DO(src, q_) do { const int ai_ = (q_) >> 1, mb_ = ((q_) & 1) * 2; _Pragma("unroll") for (int m2 = 0; m2 < 2; ++m2) { const int m_ = mb_ + m2, row_ = u.pm * 256 + ai_ * 128 + wr * 64 + m_ * 16 + fr; float s_ = 0.f; \
            _Pragma("unroll") for (int bj = 0; bj < 2; ++bj) { const f32x4 o0 = src[m2][bj][0] + gv[bj][0] * acc[ai_][bj][m_][0], o1 = src[m2][bj][1] + gv[bj][1] * acc[ai_][bj][m_][1]; \
                u32x4 w; w.x = pk2(o0.x, o0.y); w.y = pk2(o0.z, o0.w); w.z = pk2(o1.x, o1.y); w.w = pk2(o1.z, o1.w); *(u32x4*)(x1b + (size_t)row_ * D + col0 + bj * 128) = w; \
                s_ += ((o0.x * o0.x + o0.y * o0.y) + (o0.z * o0.z + o0.w * o0.w)) + ((o1.x * o1.x + o1.y * o1.y) + (o1.z * o1.z + o1.w * o1.w)); } \
            s_ += __shfl_xor(s_, 16); s_ += __shfl_xor(s_, 32); if (fq == 0) rsqp[(size_t)row_ * 16 + u.pn * 4 + wc] = s_; } } while (0)
        P4_LOAD(xa, 0); P4_LOAD(xb, 1);
        P4_DO(xa, 0); asm volatile("" ::: "memory"); P4_LOAD(xa, 2);
        P4_DO(xb, 1); asm volatile("" ::: "memory"); P4_LOAD(xb, 3);
        P4_DO(xa, 2); asm volatile("" ::: "memory");
        P4_DO(xb, 3);
#undef P4_LOAD
#undef P4_DO
    }
};
DI void phase4_out(const Params& p, unsigned char* lds, int bid, int nb) {
    P4Pol P; P.ord.init(NTOK / 256, D / 256, nb, bid); P.A = (const char*)(p.ws + WS_R1); P.B = (const char*)(p.ws + WS_WOUTT); P.K = 1024; P.ksplit = 16; P.lda = 1024; P.ldb = 1024;
    P4Epi E{p.x, (bf16*)(p.ws + WS_X1B), (const float*)(p.ws + WS_MOD), (float*)(p.ws + WS_RSQP1), (const float*)(p.ws + WS_RSQS)};
    pg8::gemm_phase<P4Pol, P4Epi, true>((PG8_LAS unsigned char*)lds, P, E);
}
DI int pair_index(int lo, int hi) { return 7 * lo - (lo * (lo - 1)) / 2 + (hi - lo - 1); }
constexpr int RT_WP = 2064, RT_GM_OFF = 48 * RT_WP, RT_SH_OFF = RT_GM_OFF + 4096, RT_SC_OFF = RT_SH_OFF + 4096, RT_LC_OFF = RT_SC_OFF + 8 * 16 * 48 * 4, RT_LDS = RT_LC_OFF + 2 * 144 * 4;
DI void phase5_route(const Params& p, unsigned char* lds, int bid, int nb, bool commit = true) {
    const int tid = tidx(), lane = tid & 63, wid = tid >> 6, fr = lane & 15, fq = lane >> 4;
    { const bf16* W = (const bf16*)(p.ws + WS_WRT);
      for (int i = tid; i < 48 * 128; i += NT) { const int n = i >> 7, c = i & 127; *(u32x4*)(lds + n * RT_WP + c * 16) = *(const u32x4*)(W + n * 1024 + c * 8); } }
    const float* mod = (const float*)(p.ws + WS_MOD); const float* rsqp = (const float*)(p.ws + WS_RSQP1);
    bf16* A2 = (bf16*)(p.ws + WS_A2); unsigned* elcp = (unsigned*)(p.ws + WS_ELCP); float* elw = (float*)(p.ws + WS_ELW); unsigned* tcp = (unsigned*)(p.ws + WS_TCP);
    unsigned* ecnt = (unsigned*)(p.ws + WS_CTL + CTL_ECNT); unsigned* pcnt = (unsigned*)(p.ws + WS_CTL + CTL_PCNT);
    unsigned* elist = (unsigned*)(p.ws + WS_ELIST);
    float* gm = (float*)(lds + RT_GM_OFF); float* shv = (float*)(lds + RT_SH_OFF); float* scr = (float*)(lds + RT_SC_OFF) + wid * 16 * 48;
    unsigned* lcnt = (unsigned*)(lds + RT_LC_OFF); unsigned* lbase = lcnt + 144;
    for (int t128 = bid; t128 < NTOK / 128; t128 += nb) {
        const int b = t128 >> 5;
        __syncthreads();
        for (int k = tid; k < 1024; k += NT) { gm[k] = p.norm2_g[k] * (1.f + mod[b * 6144 + 4096 + k]); shv[k] = mod[b * 6144 + 3072 + k]; }
        if (tid < 144) lcnt[tid] = 0u;
        __syncthreads();
        const int row0 = t128 * 128 + wid * 16, row = row0 + fr;
        float rs;
        { const f32x4* pp = (const f32x4*)(rsqp + (size_t)row * 16); const f32x4 q0 = pp[0], q1 = pp[1], q2 = pp[2], q3 = pp[3];
          const float rsum = (((q0.x + q0.y) + (q0.z + q0.w)) + ((q1.x + q1.y) + (q1.z + q1.w))) + (((q2.x + q2.y) + (q2.z + q2.w)) + ((q3.x + q3.y) + (q3.z + q3.w)));
          rs = rsqrtf(rsum * (1.f / D) + EPS); }
        f32x4 acc[3];
#pragma unroll
        for (int n = 0; n < 3; ++n) acc[n] = (f32x4){0.f, 0.f, 0.f, 0.f};
        const bf16* xr = (const bf16*)(p.ws + WS_X1B) + (size_t)row * D + fq * 8; unsigned char* ar = (unsigned char*)A2 + (size_t)row * D + fq * 8;
        u32x4 xa[8], xb[8];
#pragma unroll
        for (int i = 0; i < 8; ++i) xa[i] = *(const u32x4*)(xr + i * 32);
#pragma unroll 1
        for (int kc = 0; kc < 4; kc += 2) {
#pragma unroll
            for (int i = 0; i < 8; ++i) xb[i] = *(const u32x4*)(xr + (kc + 1) * 256 + i * 32);
#pragma unroll
            for (int half = 0; half < 2; ++half) {
#pragma unroll
                for (int i = 0; i < 8; ++i) {
                    const int ks = (kc + half) * 8 + i, k0 = ks * 32 + fq * 8;
                    const u32x4 xx = half ? xb[i] : xa[i];
                    f32x4 x0, x1; x0.x = __uint_as_float(xx.x << 16); x0.y = __uint_as_float(xx.x & 0xffff0000u); x0.z = __uint_as_float(xx.y << 16); x0.w = __uint_as_float(xx.y & 0xffff0000u);
                    x1.x = __uint_as_float(xx.z << 16); x1.y = __uint_as_float(xx.z & 0xffff0000u); x1.z = __uint_as_float(xx.w << 16); x1.w = __uint_as_float(xx.w & 0xffff0000u);
                    const f32x4 g0 = *(const f32x4*)(gm + k0), g1 = *(const f32x4*)(gm + k0 + 4), s0 = *(const f32x4*)(shv + k0), s1 = *(const f32x4*)(shv + k0 + 4);
                    const f32x4 t0 = x0 * rs * g0 + s0, t1 = x1 * rs * g1 + s1;
                    u32x4 hi; hi.x = pk2(t0.x, t0.y); hi.y = pk2(t0.z, t0.w); hi.z = pk2(t1.x, t1.y); hi.w = pk2(t1.z, t1.w);
                    { u32x2 a8; a8.x = pk4_fp8(t0.x * 4.f, t0.y * 4.f, t0.z * 4.f, t0.w * 4.f); a8.y = pk4_fp8(t1.x * 4.f, t1.y * 4.f, t1.z * 4.f, t1.w * 4.f); *(u32x2*)(ar + ks * 32) = a8; }
                    u32x4 lo;
                    lo.x = pk2(t0.x - __uint_as_float(hi.x << 16), t0.y - __uint_as_float(hi.x & 0xffff0000u)); lo.y = pk2(t0.z - __uint_as_float(hi.y << 16), t0.w - __uint_as_float(hi.y & 0xffff0000u));
                    lo.z = pk2(t1.x - __uint_as_float(hi.z << 16), t1.y - __uint_as_float(hi.z & 0xffff0000u)); lo.w = pk2(t1.z - __uint_as_float(hi.w << 16), t1.w - __uint_as_float(hi.w & 0xffff0000u));
                    const bf16x8 ah = __builtin_bit_cast(bf16x8, hi), al = __builtin_bit_cast(bf16x8, lo);
#pragma unroll
                    for (int nt = 0; nt < 3; ++nt) { const bf16x8 bw = *(const bf16x8*)(lds + (16 * nt + fr) * RT_WP + k0 * 2);
                        acc[nt] = __builtin_amdgcn_mfma_f32_16x16x32_bf16(ah, bw, acc[nt], 0, 0, 0); acc[nt] = __builtin_amdgcn_mfma_f32_16x16x32_bf16(al, bw, acc[nt], 0, 0, 0); }
                }
                if (half == 0 && kc + 2 < 4) {
#pragma unroll
                    for (int i = 0; i < 8; ++i) xa[i] = *(const u32x4*)(xr + (kc + 2) * 256 + i * 32);
                }
            }
        }
#pragma unroll
        for (int nt = 0; nt < 3; ++nt)
#pragma unroll
            for (int r = 0; r < 4; ++r) scr[(4 * fq + r) * 48 + 16 * nt + fr] = acc[nt][r];
        __syncthreads();
        int e1 = 0, e2 = 0, cls = 0, pos1 = 0; float w1 = 0.f, w2 = 0.f; unsigned r1 = 0, r2 = 0, r3 = 0; const bool rt = lane < 16 && commit;
        if (rt) {
            const int rrow = row0 + lane; const float* lg = scr + lane * 48;
            float gl[4];
#pragma unroll
            for (int o = 0; o < 4; ++o) gl[o] = lg[o] + p.b_group[o];
            float gmax = gl[0]; int gi = 0;
#pragma unroll
            for (int o = 1; o < 4; ++o) if (gl[o] > gmax) { gmax = gl[o]; gi = o; }
            float se = 0.f;
#pragma unroll
            for (int o = 0; o < 4; ++o) se += __expf(gl[o] - gmax);
            const float g_w = 1.f / se;
            float ev[8];
#pragma unroll
            for (int o = 0; o < 8; ++o) ev[o] = lg[4 + gi * 8 + o] + p.b_router[gi * 8 + o];
            float v1 = ev[0]; int i1 = 0;
#pragma unroll
            for (int o = 1; o < 8; ++o) if (ev[o] > v1) { v1 = ev[o]; i1 = o; }
            float v2 = -3.0e38f; int i2 = -1;
#pragma unroll
            for (int o = 0; o < 8; ++o) if (o != i1 && ev[o] > v2) { v2 = ev[o]; i2 = o; }
            w1 = g_w / (1.f + __expf(v2 - v1)); w2 = g_w - w1;
            const int lo = i1 < i2 ? i1 : i2, hi = i1 < i2 ? i2 : i1; pos1 = i1 < i2 ? 0 : 1;
            e1 = gi * 8 + i1; e2 = gi * 8 + i2; cls = gi * 28 + pair_index(lo, hi);
            r1 = atomicAdd(lcnt + e1, 1u); r2 = atomicAdd(lcnt + e2, 1u); r3 = atomicAdd(lcnt + 32 + cls, 1u);
        }
        __syncthreads();
        if (tid < 144) { const unsigned n = lcnt[tid]; if (n) lbase[tid] = atomicAdd((tid < 32 ? ecnt + tid * CNT_STRIDE : pcnt + (tid - 32) * CNT_STRIDE), n); }
        __syncthreads();
        if (rt) {
            const int rrow = row0 + lane;
            const unsigned q3 = lbase[32 + cls] + r3, cp = ((unsigned)cls << 16) | q3;
            tcp[rrow] = cp;
            const unsigned q1 = lbase[e1] + r1; elist[(size_t)e1 * 32768 + q1] = (unsigned)rrow * 2u + (unsigned)pos1; elcp[(size_t)e1 * 32768 + q1] = cp; elw[(size_t)e1 * 32768 + q1] = w1;
            const unsigned q2 = lbase[e2] + r2; elist[(size_t)e2 * 32768 + q2] = (unsigned)rrow * 2u + (unsigned)(1 - pos1); elcp[(size_t)e2 * 32768 + q2] = cp; elw[(size_t)e2 * 32768 + q2] = w2;
        }
    }
    __syncthreads();
}
constexpr int TB_OFF = 131072, TB_ETE = 64, TB_ETR = 64 + 320, TB_ETC = 64 + 640, TB_PTC = 64 + 960, TB_PTS = 64 + 1280, TB_COFF = 64 + 1600, TB_PTN = 64 + 1600 + 128 + 160, TB_BYTES = (64 + 1600 + 128 + 160 + 320) * 4;
DI void build_tiles(const Params& p, unsigned char* lds) {
    int* tb = (int*)(lds + TB_OFF); int* cnts = tb + TB_COFF + 112;
    const int tid = tidx();
    if (tid < 144) cnts[tid] = tid < 32 ? (int)((const unsigned*)(p.ws + WS_CTL + CTL_ECNT))[tid * CNT_STRIDE] : (int)((const unsigned*)(p.ws + WS_CTL + CTL_PCNT))[(tid - 32) * CNT_STRIDE];
    __syncthreads();
    const bool isE = tid < 32, isP = tid >= 64 && tid < 176;
    if (isE || isP) {
        const int base = isE ? 0 : 32, n = isE ? 32 : 112, me = isE ? tid : tid - 64;
        int fb = 0, pb = 0, hb = 0, ft = 0, pt = 0, rows_before = 0;
        for (int j = 0; j < n; ++j) { const int c = cnts[base + j], f = c >> 8, r = c & 255, pp = r > 128 ? 1 : 0, hh = (r > 0 && r <= 128) ? 1 : 0;
            ft += f; pt += pp; if (j < me) { fb += f; pb += pp; hb += hh; rows_before += ((c + 255) >> 8) << 8; } }
        const int c = cnts[base + me], f = c >> 8, r = c & 255;
        if (isE) {
            for (int k = 0; k < f; ++k) { tb[TB_ETE + fb + k] = me; tb[TB_ETR + fb + k] = k * 256; tb[TB_ETC + fb + k] = c; }
            if (r > 128) { const int ix = ft + pb; tb[TB_ETE + ix] = me; tb[TB_ETR + ix] = f * 256; tb[TB_ETC + ix] = c; }
            else if (r > 0) { const int ix = ft + pt + hb; tb[TB_ETE + ix] = me; tb[TB_ETR + ix] = f * 256; tb[TB_ETC + ix] = c; }
            if (me == 31) tb[0] = ft + pt + hb + ((r > 0 && r <= 128) ? 1 : 0);
        } else {
            tb[TB_COFF + me] = rows_before;
            for (int k = 0; k < f; ++k) { tb[TB_PTC + fb + k] = me; tb[TB_PTS + fb + k] = rows_before + k * 256; tb[TB_PTN + fb + k] = c - k * 256; }
            if (r > 128) { const int ix = ft + pb; tb[TB_PTC + ix] = me; tb[TB_PTS + ix] = rows_before + f * 256; tb[TB_PTN + ix] = r; }
            else if (r > 0) { const int ix = ft + pt + hb; tb[TB_PTC + ix] = me; tb[TB_PTS + ix] = rows_before + f * 256; tb[TB_PTN + ix] = r; }
            if (me == 111) tb[1] = ft + pt + hb + ((r > 0 && r <= 128) ? 1 : 0);
        }
    }
    __syncthreads();
}
struct GUPol {
    static constexpr bool FP8 = true;
    struct Unit { int e, r0, cnt, hh; };
    DI bool half(const Unit& u) const { return u.cnt - u.r0 <= 128; }
    static constexpr long KSTEP_A = 0;
    DI unsigned aoff(int R, int C) const { return (unsigned)(R * lda + C) * 2u; }
    static constexpr bool GATHER = true;
    const int* tb; int G, c; const char* A; const char* B; const unsigned* elist; int K, ksplit, lda, ldb;
    DI bool next(int i, Unit& u) const { const int L = i * G + c; if (L >= __builtin_amdgcn_readfirstlane(tb[0]) * 2) return false; const int t = L >> 1; u.hh = L & 1;
        u.e = __builtin_amdgcn_readfirstlane(tb[TB_ETE + t]); u.r0 = __builtin_amdgcn_readfirstlane(tb[TB_ETR + t]); u.cnt = __builtin_amdgcn_readfirstlane(tb[TB_ETC + t]); return true; }
    DI void ptrs(const Unit& u, pg8::UPtr& q) const { q.a0 = A; q.a1 = A; q.b0 = B + (size_t)((u.e * 2 + u.hh) * 256) * ldb * 2; q.b1 = q.b0 + (size_t)128 * ldb * 2; q.c0 = q.b0; q.c1 = q.b1; }
    DI int brow(int R) const { return R; }
    DI unsigned goff(const Unit& u, int r, int C) const { const unsigned ent = elist[(size_t)u.e * 32768 + (r < u.cnt ? r : u.r0)]; return ((ent >> 1) * 512u + (unsigned)C) * 2u; }
    DI void gather(const Unit& u, int (&R)[2], int (&C)[2], unsigned& v00, unsigned& v01, unsigned& v10, unsigned& v11) const {
        v00 = goff(u, u.r0 + R[0], C[0]); v01 = goff(u, u.r0 + R[1], C[1]); v10 = goff(u, u.r0 + 128 + R[0], C[0]); v11 = goff(u, u.r0 + 128 + R[1], C[1]);
    }
};
struct GUEpi {
    static constexpr int MIDK_T = -1;
    const unsigned* elist; const unsigned* elcp; const float* elw; bf16* Hs; const int* tb;
    DI void operator()(const f32x4 (&acc)[2][2][4][2], const GUPol::Unit& u, int wr, int wc, int fr, int fq) const {
        unsigned ent[2][4], cp[2][4]; float w[2][4];
#pragma unroll
        for (int ai = 0; ai < 2; ++ai)
#pragma unroll
            for (int m = 0; m < 4; ++m) { const int r = u.r0 + ai * 128 + wr * 64 + m * 16 + fr; const size_t ix = (size_t)u.e * 32768 + (r < u.cnt ? r : u.r0);
                ent[ai][m] = elist[ix]; cp[ai][m] = elcp[ix]; w[ai][m] = elw[ix]; }
#pragma unroll
        for (int ai = 0; ai < 2; ++ai)
#pragma unroll
            for (int m = 0; m < 4; ++m) { const int r = u.r0 + ai * 128 + wr * 64 + m * 16 + fr;
                if (r < u.cnt) { const int srow = tb[TB_COFF + (cp[ai][m] >> 16)] + (int)(cp[ai][m] & 0xffffu); const float ww = w[ai][m];
                    unsigned char* dst = (unsigned char*)Hs + (size_t)srow * 512 + (ent[ai][m] & 1u) * 256 + u.hh * 128 + wc * 32 + 8 * fq;
                    const f32x4 g0 = acc[ai][0][m][0] * (1.f / 128.f), g1 = acc[ai][0][m][1] * (1.f / 128.f), u0 = acc[ai][1][m][0] * (1.f / 128.f), u1 = acc[ai][1][m][1] * (1.f / 128.f); const float w16 = ww * 16.f;
                    u32x2 o; o.x = pk4_fp8(siluf_(g0[0]) * u0[0] * w16, siluf_(g0[1]) * u0[1] * w16, siluf_(g0[2]) * u0[2] * w16, siluf_(g0[3]) * u0[3] * w16);
                    o.y = pk4_fp8(siluf_(g1[0]) * u1[0] * w16, siluf_(g1[1]) * u1[1] * w16, siluf_(g1[2]) * u1[2] * w16, siluf_(g1[3]) * u1[3] * w16);
                    *(u32x2*)dst = o; } }
    }
};
DI void phase6_gateup(const Params& p, unsigned char* lds, int bid, int nb) {
    GUPol P; P.tb = (const int*)(lds + TB_OFF); P.G = nb; P.c = (nb % 8 == 0) ? (bid % 8) * (nb / 8) + bid / 8 : bid; P.A = (const char*)(p.ws + WS_A2); P.B = (const char*)(p.ws + WS_WGUT); P.elist = (const unsigned*)(p.ws + WS_ELIST); P.K = 512; P.ksplit = 8; P.lda = 512; P.ldb = 512;
    GUEpi E{(const unsigned*)(p.ws + WS_ELIST), (const unsigned*)(p.ws + WS_ELCP), (const float*)(p.ws + WS_ELW), (bf16*)(p.ws + WS_HS), (const int*)(lds + TB_OFF)};
    pg8::gemm_phase<GUPol, GUEpi, true>((PG8_LAS unsigned char*)lds, P, E);
}
struct DnPol {
    static constexpr bool FP8 = true;
    struct Unit { int s0, cls, pn, nrows; };
    DI bool half(const Unit& u) const { return u.nrows <= 128; }
    static constexpr long KSTEP_A = 0;
    DI unsigned aoff(int R, int C) const { return (unsigned)(R * lda + C) * 2u; }
    static constexpr bool GATHER = false;
    const int* tb; int G, c; const char* A; const char* B; int K, ksplit, lda, ldb;
    DI bool next(int i, Unit& u) const { const int L = i * G + c; if (L >= __builtin_amdgcn_readfirstlane(tb[1]) * 4) return false; const int t = L >> 2; u.pn = L & 3;
        u.cls = __builtin_amdgcn_readfirstlane(tb[TB_PTC + t]); u.s0 = __builtin_amdgcn_readfirstlane(tb[TB_PTS + t]); u.nrows = __builtin_amdgcn_readfirstlane(tb[TB_PTN + t]); return true; }
    DI void ptrs(const Unit& u, pg8::UPtr& q) const {
        const int gi = u.cls / 28; int lo = 0, rem = u.cls % 28;
        while (rem >= 7 - lo) { rem -= 7 - lo; ++lo; }
        const int hi = lo + 1 + rem, elo = gi * 8 + lo, ehi = gi * 8 + hi;
        q.a0 = A + (size_t)u.s0 * lda * 2; q.a1 = q.a0 + (size_t)128 * lda * 2;
        q.b0 = B + ((size_t)elo * 1024 + u.pn * 256) * ldb * 2; q.b1 = q.b0 + (size_t)128 * ldb * 2;
        q.c0 = B + ((size_t)ehi * 1024 + u.pn * 256) * ldb * 2; q.c1 = q.c0 + (size_t)128 * ldb * 2; }
    DI int brow(int R) const { return R; }
    DI void gather(const Unit&, int (&)[2], int (&)[2], unsigned&, unsigned&, unsigned&, unsigned&) const {}
};
struct DnEpi {
    static constexpr int MIDK_T = -1;
    bf16* moe;
    DI void operator()(const f32x4 (&acc)[2][2][4][2], const DnPol::Unit& u, int wr, int wc, int fr, int fq) const {
#pragma unroll
        for (int ai = 0; ai < 2; ++ai) { if (ai == 1 && u.nrows <= 128) break;
#pragma unroll
            for (int m = 0; m < 4; ++m) { bf16* dst = moe + (size_t)(u.s0 + ai * 128 + wr * 64 + m * 16 + fr) * 1024 + u.pn * 256 + wc * 32 + 8 * fq;
#pragma unroll
                for (int bj = 0; bj < 2; ++bj) { const f32x4 v0 = acc[ai][bj][m][0] * (1.f / 256.f), v1 = acc[ai][bj][m][1] * (1.f / 256.f);
                    u32x4 w; w.x = pk2(v0[0], v0[1]); w.y = pk2(v0[2], v0[3]); w.z = pk2(v1[0], v1[1]); w.w = pk2(v1[2], v1[3]);
                    *(u32x4*)(dst + bj * 128) = w; } } }
    }
};
DI void phase7_down(const Params& p, unsigned char* lds, int bid, int nb) {
    DnPol P; P.tb = (const int*)(lds + TB_OFF); P.G = nb; P.c = (nb % 8 == 0) ? (bid % 8) * (nb / 8) + bid / 8 : bid; P.A = (const char*)(p.ws + WS_HS); P.B = (const char*)(p.ws + WS_WDT); P.K = 256; P.ksplit = 2; P.lda = 256; P.ldb = 128;
    DnEpi E{(bf16*)(p.ws + WS_MOE)};
    pg8::gemm_phase<DnPol, DnEpi, true>((PG8_LAS unsigned char*)lds, P, E);
}
DI void phase8_final(const Params& p, unsigned char* lds, int bid, int nb) {
    const int lane = tidx() & 63, wave = tidx() >> 6;
    const float* mod = (const float*)(p.ws + WS_MOD); const unsigned* tcp = (const unsigned*)(p.ws + WS_TCP); const bf16* moe = (const bf16*)(p.ws + WS_MOE); const bf16* x1b = (const bf16*)(p.ws + WS_X1B); const int* tb = (const int*)(lds + TB_OFF);
    constexpr int RW = 4;
    for (int r0 = (bid * 8 + wave) * RW; r0 < NTOK; r0 += nb * 8 * RW) {
        const int b = r0 >> 12; unsigned cp[RW]; u32x2 xx[RW][4], mm[RW][4];
#pragma unroll
        for (int q = 0; q < RW; ++q) cp[q] = tcp[r0 + q];
#pragma unroll
        for (int q = 0; q < RW; ++q)
#pragma unroll
            for (int j = 0; j < 4; ++j) xx[q][j] = ((const u32x2*)(x1b + (size_t)(r0 + q) * D) + lane)[64 * j];
#pragma unroll
        for (int q = 0; q < RW; ++q) { const int srow = tb[TB_COFF + (cp[q] >> 16)] + (int)(cp[q] & 0xffffu);
#pragma unroll
            for (int j = 0; j < 4; ++j) mm[q][j] = ((const u32x2*)(moe + (size_t)srow * D) + lane)[64 * j]; }
        f32x4 g2[4], fg[4];
#pragma unroll
        for (int j = 0; j < 4; ++j) { g2[j] = *(const f32x4*)(mod + b * 6144 + 5120 + lane * 4 + 256 * j); fg[j] = *(const f32x4*)(p.final_g + lane * 4 + 256 * j); }
        f32x4 v[RW][4]; float s[RW];
#pragma unroll
        for (int q = 0; q < RW; ++q) { float t = 0.f;
#pragma unroll
            for (int j = 0; j < 4; ++j) { f32x4 x1, mv; x1.x = __uint_as_float(xx[q][j].x << 16); x1.y = __uint_as_float(xx[q][j].x & 0xffff0000u); x1.z = __uint_as_float(xx[q][j].y << 16); x1.w = __uint_as_float(xx[q][j].y & 0xffff0000u);
                mv.x = __uint_as_float(mm[q][j].x << 16); mv.y = __uint_as_float(mm[q][j].x & 0xffff0000u); mv.z = __uint_as_float(mm[q][j].y << 16); mv.w = __uint_as_float(mm[q][j].y & 0xffff0000u);
                v[q][j] = x1 + g2[j] * mv; t += (v[q][j].x * v[q][j].x + v[q][j].y * v[q][j].y) + (v[q][j].z * v[q][j].z + v[q][j].w * v[q][j].w); }
            s[q] = t; }
#pragma unroll
        for (int o = 1; o < 64; o <<= 1) {
#pragma unroll
            for (int q = 0; q < RW; ++q) s[q] += __shfl_xor(s[q], o); }
#pragma unroll
        for (int q = 0; q < RW; ++q) { const float rs = rsqrtf(s[q] * (1.f / D) + EPS); f32x4* orow = (f32x4*)(p.out + (size_t)(r0 + q) * D) + lane;
#pragma unroll
            for (int j = 0; j < 4; ++j) { f32x4 o = v[q][j] * rs * fg[j];
                if (MK_TS1 >= 0) { const unsigned* tsv = (const unsigned*)(p.ws + WS_CTL + CTL_TS); o = o * (1.f + (float)(tsv[0] / 1000u) * 0.01f); }
                orow[64 * j] = o; } }
    }
}

#define XB_TMO      128
#define XB_XCNT(j)  (256  + 64 * (j))
#define XB_XSUB(j)  (1280 + 64 * (j))
#define XB_XGEN(j)  (2304 + 64 * (j))
#define XB_TOP      3328
#define XB_TOPGEN   3392
#define XCD_BAR_WORDS 3456
#define XB_SPIN_CAP (1u << 18)
#define LAS __attribute__((address_space(3)))
DI unsigned xb_ld(unsigned* p)              { return __hip_atomic_load(p, __ATOMIC_RELAXED, __HIP_MEMORY_SCOPE_AGENT); }
DI unsigned xb_add(unsigned* p, unsigned v) { return __hip_atomic_fetch_add(p, v, __ATOMIC_RELAXED, __HIP_MEMORY_SCOPE_AGENT); }
DI unsigned xb_xcc_id() { return (unsigned)__builtin_amdgcn_s_getreg((3 << 11) | 20) & 0xFu; }
#define XB_SPIN(cond, bar) do { unsigned _sp = 0; while (cond) { __builtin_amdgcn_s_sleep(1); \
    if ((++_sp & 255u) == 0u) { if (xb_ld(&(bar)[XB_TMO])) break; if (_sp > XB_SPIN_CAP) { atomicAdd(&(bar)[XB_TMO], 1u); break; } } } } while (0)
struct XcdBarrier { unsigned* bar; unsigned x; volatile LAS unsigned* st; };
DI XcdBarrier xcd_barrier_post(unsigned* bar, volatile LAS unsigned* st) {
    XcdBarrier b; b.bar = bar; b.x = xb_xcc_id(); b.st = st;
    if (tidx() == 0) (void)xb_add(&bar[XB_XCNT(b.x)], 1u);
    return b;
}
DI void xcd_barrier_complete(unsigned* bar, unsigned x, unsigned& nloc, unsigned& nx) {
    const unsigned G = gridDim.x * gridDim.y * gridDim.z;
    unsigned sum, cnt, mine, sp = 0u;
    for (;;) {
        sum = 0u; cnt = 0u; mine = 0u;
#pragma unroll
        for (unsigned j = 0; j < 16; ++j) { const unsigned c = xb_ld(&bar[XB_XCNT(j)]); sum += c; cnt += (c > 0u) ? 1u : 0u; mine = (j == x) ? c : mine; }
        if (sum == G) break;
        __builtin_amdgcn_s_sleep(1);
        if ((++sp & 255u) == 0u) { if (xb_ld(&bar[XB_TMO])) break; if (sp > XB_SPIN_CAP) { atomicAdd(&bar[XB_TMO], 1u); break; } }
    }
    nloc = mine > 0u ? mine : 1u; nx = cnt > 0u ? cnt : 1u;
}
DI void xcd_barrier(const XcdBarrier& b) {
    asm volatile("s_waitcnt vmcnt(0)" ::: "memory");
    __syncthreads();
    if (tidx() == 0) {
        unsigned* bar = b.bar;
        __builtin_amdgcn_s_waitcnt(0);
        unsigned nloc = b.st[0], nx = b.st[1];
        if (nloc == 0u) { xcd_barrier_complete(bar, b.x, nloc, nx); b.st[0] = nloc; b.st[1] = nx; }
        const unsigned old = xb_add(&bar[XB_XSUB(b.x)], 1u);
        const unsigned gen = old / nloc;
        if (old + 1u == (gen + 1u) * nloc) {
            __builtin_amdgcn_fence(__ATOMIC_RELEASE, "agent");
            asm volatile("s_waitcnt vmcnt(0)" ::: "memory");
            const unsigned og = xb_add(&bar[XB_TOP], 1u);
            const unsigned tg = og / nx;
            if (og + 1u == (tg + 1u) * nx) xb_add(&bar[XB_TOPGEN], 1u);
            else XB_SPIN(xb_ld(&bar[XB_TOPGEN]) == tg, bar);
            __builtin_amdgcn_fence(__ATOMIC_ACQUIRE, "agent");
            xb_add(&bar[XB_XGEN(b.x)], 1u);
            asm volatile("s_waitcnt vmcnt(0)" ::: "memory");
        } else {
            XB_SPIN(xb_ld(&bar[XB_XGEN(b.x)]) == gen, bar);
            __builtin_amdgcn_fence(__ATOMIC_ACQUIRE, "agent");
            asm volatile("s_waitcnt vmcnt(0)" ::: "memory");
        }
    }
    __syncthreads();
}

constexpr int CTL_BAR = 16384;
constexpr int MK_LDS = 163840;
constexpr int MK_ST_OFF = MK_LDS - 16;
static_assert(FF_LDS <= MK_ST_OFF && RT_LDS <= MK_ST_OFF && TB_OFF + TB_BYTES <= MK_ST_OFF && TB_OFF >= pg8::STAGE_BYTES, "LDS map");
static_assert(4 * (4096 + 4096 + 8448 + 16384) <= MK_ST_OFF, "prep LDS");
#ifndef MK_REP
#define MK_REP -1
#endif
constexpr int MK_PT_OFF = MK_ST_OFF - 256;
static_assert(RT_LDS <= MK_PT_OFF && TB_OFF + TB_BYTES <= MK_PT_OFF, "LDS map (pointer table)");
DI Params ldp(const unsigned char* lds) {
    Params p; unsigned long long* d = (unsigned long long*)&p; const unsigned* t = (const unsigned*)(lds + MK_PT_OFF);
#pragma unroll
    for (int i = 0; i < 32; ++i) { const unsigned lo = __builtin_amdgcn_readfirstlane(t[2 * i]), hi = __builtin_amdgcn_readfirstlane(t[2 * i + 1]); d[i] = ((unsigned long long)hi << 32) | lo; }
    return p;
}
#define TSTAMP(i) do { if (MK_TS1 >= 0 && bid == 0 && tidx() == 0) ((unsigned long long*)(lds + MK_PT_OFF - 256))[i] = __builtin_amdgcn_s_memrealtime(); } while (0)
#define RUNPH(k, body) do { { const Params p = ldp(lds); body; } if (MK_REP == (k)) { xcd_barrier(bar); { const Params p = ldp(lds); body; } } } while (0)
#ifdef MK_ONLY
__global__ void __launch_bounds__(NT, 2) only_kernel(Params p) {
    extern __shared__ __attribute__((aligned(16))) unsigned char lds[];
    const int bid = blockIdx.x, nb = gridDim.x;
    if (MK_ONLY == 1) phaseAB_prep(p, lds, bid, nb);
    if (MK_ONLY == 2) phase1b(p, lds, bid, nb);
    if (MK_ONLY == 3) phase2a_s5states(p, lds, bid, nb);
    if (MK_ONLY == 13) phase2b_scan(p, bid, nb);
    if (MK_ONLY == 4) phase2_fft(p, lds, bid, nb);
    if (MK_ONLY == 9) phase2c_s5out(p, lds, bid, nb);
    if (MK_ONLY == 5) phase3_glu(p, lds, bid, nb);
    if (MK_ONLY == 6) phase3_fin(p, lds, bid, nb);
    if (MK_ONLY == 7) phase4_out(p, lds, bid, nb);
    if (MK_ONLY == 8) phase5_route(p, lds, bid, nb);
    if (MK_ONLY == 10) { build_tiles(p, lds); phase6_gateup(p, lds, bid, nb); }
    if (MK_ONLY == 11) { build_tiles(p, lds); phase7_down(p, lds, bid, nb); }
    if (MK_ONLY == 12) { build_tiles(p, lds); phase8_final(p, lds, bid, nb); }
}
#endif
__global__ void __launch_bounds__(NT, 2) mega_kernel(Params pk) {
    extern __shared__ __attribute__((aligned(16))) unsigned char lds[];
    const int bid = blockIdx.x, nb = gridDim.x;
    static_assert(sizeof(Params) == 256, "Params = 32 pointers");
    if (tidx() < 64) ((unsigned*)(lds + MK_PT_OFF))[tidx()] = ((const unsigned*)&pk)[tidx()];
    if (tidx() < 4) ((unsigned*)(lds + MK_ST_OFF))[tidx()] = 0u;
    __syncthreads();
    XcdBarrier bar;
    { const Params p = ldp(lds); bar = xcd_barrier_post((unsigned*)(p.ws + WS_CTL + CTL_BAR), (volatile LAS unsigned*)(lds + MK_ST_OFF)); }
    TSTAMP(0);
    TSTAMP(1);
    RUNPH(-2, phaseAB_prep(p, lds, bid, nb));     xcd_barrier(bar); TSTAMP(2);
    RUNPH(2, phase1b(p, lds, bid, nb));           xcd_barrier(bar); TSTAMP(3);
    RUNPH(3, phase2a_s5states(p, lds, bid, nb));  xcd_barrier(bar);
    RUNPH(13, phase2b_scan(p, bid, nb));
    RUNPH(4, phase2_fft(p, lds, bid, nb));        xcd_barrier(bar); TSTAMP(4);
    RUNPH(9, phase2c_s5out(p, lds, bid, nb));     xcd_barrier(bar); TSTAMP(5);
    RUNPH(6, phase3_fin(p, lds, bid, nb));
    RUNPH(5, phase3_glu(p, lds, bid, nb));        xcd_barrier(bar); TSTAMP(6); TSTAMP(7);
    RUNPH(7, phase4_out(p, lds, bid, nb));        xcd_barrier(bar); TSTAMP(8);
    RUNPH(-2, phase5_route(p, lds, bid, nb));     xcd_barrier(bar); TSTAMP(9);
    if (MK_REP == 8) { { const Params p = ldp(lds); phase5_route(p, lds, bid, nb, false); } xcd_barrier(bar); }
    if (MK_REP == 20) { xcd_barrier(bar); xcd_barrier(bar); xcd_barrier(bar); xcd_barrier(bar); }
    RUNPH(-2, build_tiles(p, lds));
    RUNPH(10, phase6_gateup(p, lds, bid, nb));    xcd_barrier(bar); TSTAMP(10);
    RUNPH(11, phase7_down(p, lds, bid, nb));      xcd_barrier(bar); TSTAMP(11);
    if (MK_TS1 >= 0) { if (bid == 0 && tidx() == 0) { const unsigned long long* ts = (const unsigned long long*)(lds + MK_PT_OFF - 256); const Params p = ldp(lds); unsigned* o = (unsigned*)(p.ws + WS_CTL + CTL_TS);
            o[0] = (unsigned)(ts[MK_TS1 + 1] - ts[MK_TS1]); o[1] = MK_TS2 >= 0 ? (unsigned)(ts[MK_TS2 + 1] - ts[MK_TS2]) : 0u; } xcd_barrier(bar); }
    RUNPH(-2, phase8_final(p, lds, bid, nb));
}

extern "C" void kernel_launch(void* const* d_in, const int* in_sizes, int n_in, void* d_out, int out_size, void* d_ws, size_t ws_size, hipStream_t stream) {
    static int grid = 0;
    if (grid == 0) {
        if (n_in != 30 || ws_size < WS_END || out_size != NTOK * D) { fprintf(stderr, "kernel_launch: unexpected inputs (n_in %d, ws %zu, out %d)\n", n_in, ws_size, out_size); grid = -1; return; }
        int dev = 0, cus = 0, per_cu = 0;
        if (hipGetDevice(&dev) != hipSuccess || hipDeviceGetAttribute(&cus, hipDeviceAttributeMultiprocessorCount, dev) != hipSuccess) { grid = -1; return; }
        if (hipFuncSetAttribute((const void*)mega_kernel, hipFuncAttributeMaxDynamicSharedMemorySize, MK_LDS) != hipSuccess) { fprintf(stderr, "kernel_launch: hipFuncSetAttribute failed\n"); grid = -1; return; }
        if (hipOccupancyMaxActiveBlocksPerMultiprocessor(&per_cu, (const void*)mega_kernel, NT, MK_LDS) != hipSuccess || per_cu < 1) { fprintf(stderr, "kernel_launch: occupancy query says %d blocks/CU\n", per_cu); (void)hipGetLastError(); grid = -1; return; }
        grid = cus;
    }
    if (grid < 0) return;
    Params p{};
    const float** f = (const float**)&p;
    for (int i = 0; i < 30; ++i) f[i] = (const float*)d_in[i];
    p.out = (float*)d_out; p.ws = (unsigned char*)d_ws;
    (void)hipMemsetAsync((char*)d_ws + WS_CTL, 0, CTL_BYTES, stream);
    hipLaunchKernelGGL(mega_kernel, dim3(grid), dim3(NT), MK_LDS, stream, p);
}
```

```cpp
#include <hip/hip_runtime.h>
#include <cstdio>
#include <cstdint>

typedef unsigned short bf16;
typedef short bf16x8 __attribute__((ext_vector_type(8)));
typedef short bf16x4 __attribute__((ext_vector_type(4)));
typedef float f32x4 __attribute__((ext_vector_type(4)));
typedef unsigned u32x4 __attribute__((ext_vector_type(4)));
typedef unsigned u32x2 __attribute__((ext_vector_type(2)));
typedef __bf16 bf16v2 __attribute__((ext_vector_type(2)));
#define DI __device__ __forceinline__

constexpr int D = 1024, NB = 8, L = 4096, CTX = 256, NTOK = NB * L, NCTX = NB * CTX, NROWS1 = NTOK + NCTX;
constexpr int NEXP = 32, DE = 256;
constexpr float EPS = 1e-6f;
constexpr int NT = 512;

constexpr size_t MiB = 1u << 20;
constexpr size_t WS_CTL = 0;
constexpr size_t CTL_BYTES = 1 * MiB;
constexpr size_t CTL_ZERO = 4096;
#ifndef MK_TS1
#define MK_TS1 -1
#endif
#ifndef MK_TS2
#define MK_TS2 -1
#endif
constexpr size_t CTL_TS = 12288;
constexpr size_t CTL_FLAGA = 12800;
constexpr size_t CTL_WQ = 12544;
constexpr size_t CTL_ECNT = 65536;
constexpr size_t CTL_PCNT = 65536 + 32 * 64;
constexpr int CNT_STRIDE = 16;
constexpr size_t CTL_RSQ1 = 256 * 1024;
constexpr size_t CTL_RSQ2 = 384 * 1024;
constexpr size_t WS_MOD = 1 * MiB;
constexpr size_t WS_TILES = WS_MOD + 256 * 1024;
constexpr size_t WS_ABART = WS_TILES + 64 * 1024;
constexpr size_t WS_FFTC = 2 * MiB;
constexpr size_t WS_GW = 3 * MiB;
constexpr size_t WS_WINT = 4 * MiB;
constexpr size_t WS_WGLUT = 7 * MiB;
constexpr size_t WS_WOUTT = 8 * MiB;
constexpr size_t WS_WGUT = 10 * MiB;
constexpr size_t WS_WDT = 42 * MiB;
constexpr size_t WS_WST = 58 * MiB;
constexpr size_t WS_MGW = 66 * MiB;
constexpr size_t WS_ELIST = 90 * MiB;
constexpr size_t WS_ELCP = 94 * MiB;
constexpr size_t WS_ELW = 98 * MiB;
constexpr size_t WS_TCP = 102 * MiB;
constexpr size_t WS_R1 = 108 * MiB;
constexpr size_t WS_R2 = 176 * MiB;
constexpr size_t WS_R3 = 240 * MiB;
constexpr size_t WS_UCTX = 288 * MiB;
constexpr size_t WS_R4 = 290 * MiB;
constexpr size_t WS_R5 = 322 * MiB;
constexpr size_t WS_X1B = 290 * MiB;
constexpr size_t WS_A2 = 108 * MiB;
constexpr size_t WS_HS = 228 * MiB;
constexpr size_t WS_MOE = 108 * MiB;
constexpr size_t WS_RSQP1 = 354 * MiB;
constexpr size_t WS_RSQS = 356 * MiB;
constexpr size_t WS_RSS = 357 * MiB;
constexpr size_t WS_ETAB = 357 * MiB + 512 * 1024;
constexpr size_t WS_WRT = 358 * MiB;
constexpr size_t WS_A1 = 360 * MiB;
constexpr int A1P = 1088;
constexpr size_t WS_END = 434 * MiB;

struct Params {
    const float *x, *c, *ctx, *c_ctx, *w_ada, *b_ada, *norm1_g, *norm2_g, *w_in;
    const float *lam_re, *lam_im, *b_re, *b_im, *c_re, *c_im, *log_step, *s5_d, *w_glu, *fourier_w, *g_s, *g_f, *w_out;
    const float *w_group, *b_group, *w_router, *b_router, *w_gate, *w_up, *w_down, *final_g;
    float* out; unsigned char* ws;
};

DI int tidx() { int t = threadIdx.x; asm volatile("" : "+v"(t)); return t; }
DI unsigned pk2(float lo, float hi) { bf16v2 v; v.x = (__bf16)lo; v.y = (__bf16)hi; return __builtin_bit_cast(unsigned, v); }
typedef int i32x4 __attribute__((ext_vector_type(4)));
typedef int i32x8 __attribute__((ext_vector_type(8)));
DI unsigned pk4_fp8(float a, float b, float c, float d) { int w = 0; w = __builtin_amdgcn_cvt_pk_fp8_f32(a, b, w, false); w = __builtin_amdgcn_cvt_pk_fp8_f32(c, d, w, true); return (unsigned)w; }
DI float bf2f(unsigned short b) { return __uint_as_float(((unsigned)b) << 16); }
DI float wave_sum(float v) {
#pragma unroll
    for (int o = 1; o < 64; o <<= 1) v += __shfl_xor(v, o);
    return v;
}
DI float sigmoidf_(float x) { return __builtin_amdgcn_rcpf(1.f + __builtin_amdgcn_exp2f(-1.4426950408889634f * x)); }
DI float siluf_(float x) { return x * __builtin_amdgcn_rcpf(1.f + __builtin_amdgcn_exp2f(-1.4426950408889634f * x)); }
DI float geluf_(float x) { const float a = -2.302208198f - 0.102943239f * (x * x); return x * __builtin_amdgcn_rcpf(1.f + __builtin_amdgcn_exp2f(x * a)); }

template <int MT> struct GC {
    static constexpr int BM = 64 * MT, PA = MT, ABYTES = BM * 128, BBYTES = 128 * 128, BUF = ABYTES + BBYTES, LDS = 2 * BUF;
};
template <int MT>
DI void gemm_loop(f32x4 (&acc)[MT][4], const bf16* (&ap)[MT], const int (&as)[MT], const bf16* (&bp)[2], int nk, unsigned char* lds) {
    typedef GC<MT> G;
    const int tid = tidx(), lane = tid & 63, wid = tid >> 6, wm = wid >> 1, wn = wid & 1, fr = lane & 15, fq = lane >> 4;
    const int srow = tid >> 3, sck = tid & 7;
    const int soff = srow * 128 + ((sck ^ (srow & 7)) << 4);
    u32x4 ra[MT], rb[2];
#pragma unroll
    for (int i = 0; i < MT; ++i) ra[i] = *(const u32x4*)(ap[i]);
#pragma unroll
    for (int i = 0; i < 2; ++i) rb[i] = *(const u32x4*)(bp[i]);
#pragma unroll
    for (int i = 0; i < MT; ++i) *(u32x4*)(lds + i * 8192 + soff) = ra[i];
#pragma unroll
    for (int i = 0; i < 2; ++i) *(u32x4*)(lds + G::ABYTES + i * 8192 + soff) = rb[i];
    __syncthreads();
    const int aro = (wm * MT * 16 + fr) * 128, bro = (wn * 64 + fr) * 128;
    const int sw0 = ((0 + fq) ^ (fr & 7)) << 4, sw1 = ((4 + fq) ^ (fr & 7)) << 4;
    for (int kt = 0; kt < nk; ++kt) {
        const bool more = kt + 1 < nk;
        if (more) {
#pragma unroll
            for (int i = 0; i < MT; ++i) ra[i] = *(const u32x4*)(ap[i] + (size_t)(kt + 1) * as[i]);
#pragma unroll
            for (int i = 0; i < 2; ++i) rb[i] = *(const u32x4*)(bp[i] + (size_t)(kt + 1) * 64);
        }
        const unsigned char* Ab = lds + (kt & 1) * G::BUF; const unsigned char* Bb = Ab + G::ABYTES;
#pragma unroll
        for (int kk = 0; kk < 2; ++kk) {
            const int sw = kk ? sw1 : sw0;
            bf16x8 af[MT], bfr[4];
#pragma unroll
            for (int mt = 0; mt < MT; ++mt) af[mt] = *(const bf16x8*)(Ab + aro + mt * 2048 + sw);
#pragma unroll
            for (int nt = 0; nt < 4; ++nt) bfr[nt] = *(const bf16x8*)(Bb + bro + nt * 2048 + sw);
#pragma unroll
            for (int mt = 0; mt < MT; ++mt)
#pragma unroll
                for (int nt = 0; nt < 4; ++nt) acc[mt][nt] = __builtin_amdgcn_mfma_f32_16x16x32_bf16(bfr[nt], af[mt], acc[mt][nt], 0, 0, 0);
        }
        if (more) {
            unsigned char* nb = lds + ((kt + 1) & 1) * G::BUF;
#pragma unroll
            for (int i = 0; i < MT; ++i) *(u32x4*)(nb + i * 8192 + soff) = ra[i];
#pragma unroll
            for (int i = 0; i < 2; ++i) *(u32x4*)(nb + G::ABYTES + i * 8192 + soff) = rb[i];
        }
        __syncthreads();
    }
}
template <int MT>
DI void gemm_loop_alds(f32x4 (&acc)[MT][4], const unsigned char* abase, int apitch, const bf16* (&bp)[2], int nk, unsigned char* lds) {
    typedef GC<MT> G;
    const int tid = tidx(), lane = tid & 63, wid = tid >> 6, wm = wid >> 1, wn = wid & 1, fr = lane & 15, fq = lane >> 4;
    const int srow = tid >> 3, sck = tid & 7;
    const int soff = srow * 128 + ((sck ^ (srow & 7)) << 4);
    u32x4 rb[2];
#pragma unroll
    for (int i = 0; i < 2; ++i) rb[i] = *(const u32x4*)(bp[i]);
#pragma unroll
    for (int i = 0; i < 2; ++i) *(u32x4*)(lds + G::ABYTES + i * 8192 + soff) = rb[i];
    __syncthreads();
    const int bro = (wn * 64 + fr) * 128;
    const int sw0 = ((0 + fq) ^ (fr & 7)) << 4, sw1 = ((4 + fq) ^ (fr & 7)) << 4;
    const unsigned char* arow = abase + (size_t)(wm * MT * 16 + fr) * apitch + fq * 16;
    for (int kt = 0; kt < nk; ++kt) {
        const bool more = kt + 1 < nk;
        if (more) {
#pragma unroll
            for (int i = 0; i < 2; ++i) rb[i] = *(const u32x4*)(bp[i] + (size_t)(kt + 1) * 64);
        }
        const unsigned char* Bb = lds + (kt & 1) * G::BUF + G::ABYTES;
#pragma unroll
        for (int kk = 0; kk < 2; ++kk) {
            const int sw = kk ? sw1 : sw0;
            bf16x8 af[MT], bfr[4];
#pragma unroll
            for (int mt = 0; mt < MT; ++mt) af[mt] = *(const bf16x8*)(arow + (size_t)mt * 16 * apitch + kt * 128 + kk * 64);
#pragma unroll
            for (int nt = 0; nt < 4; ++nt) bfr[nt] = *(const bf16x8*)(Bb + bro + nt * 2048 + sw);
#pragma unroll
            for (int mt = 0; mt < MT; ++mt)
#pragma unroll
                for (int nt = 0; nt < 4; ++nt) acc[mt][nt] = __builtin_amdgcn_mfma_f32_16x16x32_bf16(bfr[nt], af[mt], acc[mt][nt], 0, 0, 0);
        }
        if (more) {
            unsigned char* nb = lds + ((kt + 1) & 1) * G::BUF;
#pragma unroll
            for (int i = 0; i < 2; ++i) *(u32x4*)(nb + G::ABYTES + i * 8192 + soff) = rb[i];
        }
        __syncthreads();
    }
}
template <int MT> DI void zero_acc(f32x4 (&acc)[MT][4]) {
#pragma unroll
    for (int m = 0; m < MT; ++m)
#pragma unroll
        for (int n = 0; n < 4; ++n) acc[m][n] = (f32x4){0.f, 0.f, 0.f, 0.f};
}

namespace pg8 {
#define PG8_LAS __attribute__((address_space(3)))
constexpr int BM = 256, BK = 64, HALF = 128, HTB = HALF * BK * 2, STAGE_BYTES = 8 * HTB;
DI int lds_byte(int r, int c) { const int st = (r >> 4) * 2 + (c >> 5), rr = r & 15, cc = c & 31, ob = rr * 64 + cc * 2; return st * 1024 + (ob ^ (((ob >> 9) & 1) << 5)); }
DI int perm32(int rho) { const int n = rho >> 4, i = rho & 15; return 8 * (i >> 2) + 4 * n + (i & 3); }
DI void stage_rc(int b, int& R, int& C) { const int st = b / 1024, sb = b % 1024, swz = sb ^ (((sb >> 9) & 1) << 5); R = (st >> 1) * 16 + swz / 64; C = (st & 1) * 32 + (swz % 64) / 2; }
struct UPtr { const char *a0, *a1, *b0, *b1, *c0, *c1; };
template <class Pol, class Epi, bool ALIGN_EPI>
DI void gemm_phase(PG8_LAS unsigned char* lds, const Pol& P, const Epi& E) {
    typedef typename Pol::Unit Unit;
    const int tid = tidx(), wid = __builtin_amdgcn_readfirstlane(tid >> 6), lane = tid & 63, wr = wid >> 2, wc = wid & 3, fr = lane & 15, fq = lane >> 4;
    const int nt = P.K / BK, ksplit = P.ksplit;
    int Rr[2], Cc[2]; unsigned voffB[2];
#pragma unroll
    for (int i = 0; i < 2; ++i) { stage_rc(tid * 16 + i * 8192, Rr[i], Cc[i]); voffB[i] = (unsigned)(P.brow((Rr[i] & ~31) + perm32(Rr[i] & 31)) * P.ldb + Cc[i]) * 2u; }
    unsigned c00 = P.aoff(Rr[0], Cc[0]), c01 = P.aoff(Rr[1], Cc[1]), c10 = c00, c11 = c01, n00 = c00, n01 = c01, n10 = c00, n11 = c01;
#define PG8_STAGE2(bufoff, gbase, o0, o1) do { \
        __builtin_amdgcn_global_load_lds((const unsigned*)((const char*)(gbase) + (o0)), (PG8_LAS unsigned*)(lds + (bufoff) + ldsw), 16, 0, 0); \
        __builtin_amdgcn_global_load_lds((const unsigned*)((const char*)(gbase) + (o1)), (PG8_LAS unsigned*)(lds + (bufoff) + ldsw + 8192), 16, 0, 0); } while (0)
    const size_t kstep = (size_t)(BK * 2);
    const size_t kstepA = Pol::KSTEP_A ? (size_t)Pol::KSTEP_A : kstep;
    const unsigned ldsw = (unsigned)wid * 1024u;
    const int aoff = lds_byte(wr * 64 + fr, fq * 8), boff = lds_byte(wc * 32 + fr, fq * 8);
#define PG8_SA(b, h) (((b) * 2 + (h)) * HTB)
#define PG8_SB(b, h) ((4 + (b) * 2 + (h)) * HTB)
#define PG8_STAGE(bufoff, gbase, voff) do { _Pragma("unroll") for (int _i = 0; _i < 2; ++_i) \
        __builtin_amdgcn_global_load_lds((const unsigned*)((const char*)(gbase) + (voff)[_i]), (PG8_LAS unsigned*)(lds + (bufoff) + ldsw + _i * 8192), 16, 0, 0); } while (0)
#define PG8_LDA(dst, b, h) do { _Pragma("unroll") for (int m = 0; m < 4; ++m) _Pragma("unroll") for (int k = 0; k < 2; ++k) dst[m][k] = *(const PG8_LAS bf16x8*)(lds + PG8_SA(b, h) + aoff + m * 2048 + k * 1024); } while (0)
#define PG8_LDB(dst, b, h) do { _Pragma("unroll") for (int n = 0; n < 2; ++n) _Pragma("unroll") for (int k = 0; k < 2; ++k) dst[n][k] = *(const PG8_LAS bf16x8*)(lds + PG8_SB(b, h) + boff + n * 2048 + k * 1024); } while (0)
#define PG8_MMA(ai, bj, At, Bt) do { __builtin_amdgcn_s_setprio(1); _Pragma("unroll") for (int m = 0; m < 4; ++m) _Pragma("unroll") for (int n = 0; n < 2; ++n) _Pragma("unroll") for (int k = 0; k < 2; ++k) \
        acc[ai][bj][m][n] = __builtin_amdgcn_mfma_f32_16x16x32_bf16(Bt[n][k], At[m][k], acc[ai][bj][m][n], 0, 0, 0); __builtin_amdgcn_s_setprio(0); } while (0)
#define PG8_LDA8(dst, b, h) do { _Pragma("unroll") for (int m = 0; m < 4; ++m) dst[m] = __builtin_shufflevector(*(const PG8_LAS i32x4*)(lds + PG8_SA(b, h) + aoff + m * 2048), *(const PG8_LAS i32x4*)(lds + PG8_SA(b, h) + aoff + m * 2048 + 1024), 0, 1, 2, 3, 4, 5, 6, 7); } while (0)
#define PG8_LDB8(dst, b, h) do { _Pragma("unroll") for (int n = 0; n < 2; ++n) dst[n] = __builtin_shufflevector(*(const PG8_LAS i32x4*)(lds + PG8_SB(b, h) + boff + n * 2048), *(const PG8_LAS i32x4*)(lds + PG8_SB(b, h) + boff + n * 2048 + 1024), 0, 1, 2, 3, 4, 5, 6, 7); } while (0)
#define PG8_MMA8(ai, bj, A8_, B8_) do { __builtin_amdgcn_s_setprio(1); _Pragma("unroll") for (int m = 0; m < 4; ++m) _Pragma("unroll") for (int n = 0; n < 2; ++n) \
        asm volatile("v_mfma_scale_f32_16x16x128_f8f6f4 %0, %1, %2, %0, %3, %3 op_sel_hi:[0,0,0]" : "+v"(acc[ai][bj][m][n]) : "v"(B8_[n]), "v"(A8_[m]), "v"(one8)); __builtin_amdgcn_s_setprio(0); } while (0)
#define PG8_MM(ai, bj, sel) do { if constexpr (Pol::FP8) PG8_MMA8(ai, bj, A8, sel##8); else PG8_MMA(ai, bj, At, sel); } while (0)
#define PG8_RDA(b, h) do { if constexpr (Pol::FP8) PG8_LDA8(A8, b, h); else PG8_LDA(At, b, h); } while (0)
#define PG8_RDB(sel, b, h) do { if constexpr (Pol::FP8) PG8_LDB8(sel##8, b, h); else PG8_LDB(sel, b, h); } while (0)
#define PG8_WAIT_V(n) asm volatile("s_waitcnt vmcnt(" #n ")" ::: "memory")
#define PG8_WAIT_L(n) asm volatile("s_waitcnt lgkmcnt(" #n ")" ::: "memory")
#define PG8_BAR __builtin_amdgcn_s_barrier()
#define PG8_SCHED __builtin_amdgcn_sched_barrier(0)
#define PG8_BSEL(q, tk, h) ((tk) < ksplit ? (q).b##h + (size_t)(tk) * kstep : (q).c##h + (size_t)((tk) - ksplit) * kstep)
    Unit cur, nxt; UPtr cp, np_; int ui = 0;
    if (!P.next(0, cur)) return;
    P.ptrs(cur, cp);
    if constexpr (Pol::GATHER) P.gather(cur, Rr, Cc, c00, c01, c10, c11);
    f32x4 acc[2][2][4][2];
#pragma unroll
    for (int a = 0; a < 2; ++a)
#pragma unroll
        for (int b = 0; b < 2; ++b)
#pragma unroll
            for (int m = 0; m < 4; ++m)
#pragma unroll
                for (int n = 0; n < 2; ++n) acc[a][b][m][n] = (f32x4){0.f, 0.f, 0.f, 0.f};
    const int one8 = 0x7f7f7f7f;
    bf16x8 At[4][2], B0[2][2], B1[2][2]; i32x8 A8[4], B08[2], B18[2];
    PG8_STAGE(PG8_SB(0, 0), cp.b0, voffB); PG8_STAGE(PG8_SB(0, 1), cp.b1, voffB); PG8_STAGE2(PG8_SA(0, 0), cp.a0, c00, c01); PG8_STAGE2(PG8_SA(0, 1), cp.a1, c10, c11);
    if (wr == 1) PG8_BAR;
    PG8_WAIT_V(2); PG8_BAR;
    PG8_STAGE(PG8_SB(1, 0), cp.b0 + kstep, voffB); PG8_STAGE2(PG8_SA(1, 0), cp.a0 + kstepA, c00, c01); PG8_STAGE(PG8_SB(1, 1), cp.b1 + kstep, voffB);
    PG8_WAIT_V(6); PG8_BAR;
    for (;;) {
        const bool has_next = P.next(ui + 1, nxt);
        if (has_next) { P.ptrs(nxt, np_); if constexpr (Pol::GATHER) P.gather(nxt, Rr, Cc, n00, n01, n10, n11); }
        else { np_ = cp; if constexpr (Pol::GATHER) { n00 = c00; n01 = c01; n10 = c10; n11 = c11; } }
#pragma unroll 1
        for (int t = 0; t < nt; t += 2) {
            const bool last = (t == nt - 2);
            int hf = __builtin_amdgcn_readfirstlane(P.half(cur) ? 1 : 0); asm volatile("" : "+s"(hf));
            if constexpr (Epi::MIDK_T >= 0) { if (t == Epi::MIDK_T) E.midk(acc, cur, wr, wc, fr, fq); }
            const char* a1_1 = cp.a1 + (size_t)(t + 1) * kstepA;
            const char *a2_0, *a2_1, *a3_0, *b2_0, *b2_1, *b3_0, *b3_1;
            if (!last) { a2_0 = cp.a0 + (size_t)(t + 2) * kstepA; a2_1 = cp.a1 + (size_t)(t + 2) * kstepA; a3_0 = cp.a0 + (size_t)(t + 3) * kstepA;
                         b2_0 = PG8_BSEL(cp, t + 2, 0); b2_1 = PG8_BSEL(cp, t + 2, 1); b3_0 = PG8_BSEL(cp, t + 3, 0); b3_1 = PG8_BSEL(cp, t + 3, 1); }
            else { a2_0 = np_.a0; a2_1 = np_.a1; a3_0 = np_.a0 + kstepA; b2_0 = np_.b0; b2_1 = np_.b1; b3_0 = np_.b0 + kstep; b3_1 = np_.b1 + kstep; }
            const unsigned s00 = (Pol::GATHER && last) ? n00 : c00, s01 = (Pol::GATHER && last) ? n01 : c01, s10 = (Pol::GATHER && last) ? n10 : c10, s11 = (Pol::GATHER && last) ? n11 : c11;
            PG8_RDB(B0, 0, 0); PG8_RDB(B1, 0, 1); PG8_SCHED; PG8_RDA(0, 0); PG8_STAGE2(PG8_SA(1, 1), a1_1, c10, c11);
            PG8_WAIT_V(8); PG8_WAIT_L(0); PG8_BAR; PG8_MM(0, 0, B0); PG8_MM(0, 1, B1); PG8_BAR; PG8_SCHED;
            if (!hf) PG8_RDA(0, 1); PG8_STAGE(PG8_SB(0, 0), b2_0, voffB); PG8_STAGE(PG8_SB(0, 1), b2_1, voffB); PG8_STAGE2(PG8_SA(0, 0), a2_0, s00, s01);
            PG8_WAIT_V(8); PG8_WAIT_L(0); PG8_BAR; if (!hf) { PG8_MM(1, 0, B0); PG8_MM(1, 1, B1); } PG8_BAR; PG8_SCHED;
            PG8_RDB(B0, 1, 0); PG8_RDB(B1, 1, 1); PG8_SCHED; PG8_RDA(1, 0); PG8_STAGE2(PG8_SA(0, 1), a2_1, s10, s11);
            PG8_WAIT_V(8); PG8_WAIT_L(0); PG8_BAR; PG8_MM(0, 0, B0); PG8_MM(0, 1, B1); PG8_BAR; PG8_SCHED;
            if (!hf) PG8_RDA(1, 1); PG8_STAGE(PG8_SB(1, 0), b3_0, voffB); PG8_STAGE(PG8_SB(1, 1), b3_1, voffB); PG8_STAGE2(PG8_SA(1, 0), a3_0, s00, s01);
            PG8_WAIT_V(8); PG8_WAIT_L(0); PG8_BAR; if (!hf) { PG8_MM(1, 0, B0); PG8_MM(1, 1, B1); } PG8_BAR; PG8_SCHED;
        }
        if constexpr (ALIGN_EPI) { if (wr == 0) PG8_BAR; }
        if constexpr (!Epi::AFTER_DRAIN) E(acc, cur, wr, wc, fr, fq);
        if (!has_next) break;
#pragma unroll
        for (int a = 0; a < 2; ++a)
#pragma unroll
            for (int b = 0; b < 2; ++b)
#pragma unroll
                for (int m = 0; m < 4; ++m)
#pragma unroll
                    for (int n = 0; n < 2; ++n) acc[a][b][m][n] = (f32x4){0.f, 0.f, 0.f, 0.f};
        cur = nxt; cp = np_; ++ui;
        if constexpr (Pol::GATHER) { c00 = n00; c01 = n01; c10 = n10; c11 = n11; }
        if constexpr (ALIGN_EPI) { if (wr == 1) PG8_BAR; }
    }
    PG8_WAIT_V(0);
    if constexpr (!ALIGN_EPI) { if (wr == 0) PG8_BAR; }
    PG8_BAR;
    if constexpr (Epi::AFTER_DRAIN) E(acc, cur, wr, wc, fr, fq);
#undef PG8_SA
#undef PG8_SB
#undef PG8_STAGE
#undef PG8_STAGE2
#undef PG8_LDA
#undef PG8_LDB
#undef PG8_MMA
#undef PG8_MMA8
#undef PG8_MM
#undef PG8_RDA
#undef PG8_RDB
#undef PG8_LDA8
#undef PG8_LDB8
#undef PG8_WAIT_V
#undef PG8_WAIT_L
#undef PG8_BAR
#undef PG8_SCHED
#undef PG8_BSEL
}
struct DenseOrder {
    int nM, nN, nwg, G, c;
    DI void init(int nM_, int nN_, int G_, int c_) { nM = nM_; nN = nN_; nwg = nM * nN; G = G_; c = c_; }
    DI bool get(int i, int& pm, int& pn) const {
        const long L = (long)i * G + c; if (L >= nwg) return false;
        int wgid = (int)L; { const int q = nwg / 8, r = nwg % 8, xcd = wgid % 8, off = wgid / 8; wgid = (xcd < r ? xcd * (q + 1) : r * (q + 1) + (xcd - r) * q) + off; }
        const int nig = 8 * nN, gid = wgid / nig, fm = gid * 8, gsz = (nM - fm) < 8 ? (nM - fm) : 8;
        pm = fm + ((wgid % nig) % gsz); pn = (wgid % nig) / gsz; return true;
    }
};
}

DI void adaln_item(const Params& p, unsigned char* lds, int item) {
    float* scond = (float*)lds;
    float* red = scond + 9 * 1024;
    const int tid = tidx();
    for (int i = tid; i < 9 * 1024; i += NT) { const int r = i >> 10, k = i & 1023; const float v = r < 8 ? p.c[r * 1024 + k] : p.c_ctx[k]; scond[i] = v / (1.f + __expf(-v)); }
    __syncthreads();
    const int cc = tid & 31, ks = tid >> 5, col = item * 32 + cc;
    float a[9];
#pragma unroll
    for (int r = 0; r < 9; ++r) a[r] = 0.f;
#pragma unroll 1
    for (int kb = 0; kb < 4; ++kb) {
        const int kbase = ks * 64 + kb * 16; float w[16];
#pragma unroll
        for (int u = 0; u < 16; ++u) w[u] = p.w_ada[(size_t)(kbase + u) * 6144 + col];
#pragma unroll
        for (int u = 0; u < 16; ++u)
#pragma unroll
            for (int r = 0; r < 9; ++r) a[r] += scond[r * 1024 + kbase + u] * w[u];
    }
#pragma unroll
    for (int r = 0; r < 9; ++r) red[(ks * 9 + r) * 32 + cc] = a[r];
    __syncthreads();
    float* mod = (float*)(p.ws + WS_MOD);
    for (int o = tid; o < 9 * 32; o += NT) { const int r = o >> 5, c2 = o & 31; float s = 0.f;
#pragma unroll
        for (int q = 0; q < 16; ++q) s += red[(q * 9 + r) * 32 + c2];
        mod[r * 6144 + item * 32 + c2] = s + p.b_ada[item * 32 + c2]; }
    __syncthreads();
}
DI void tp_tile(const float* src, int ld, int k0, int n0, unsigned char* lds, bf16* dst, int jobkind, int e, const float* kscale = nullptr) {
    const int lane = tidx() & 63, q = lane >> 4, c = lane & 15;
    f32x4 v[16];
#pragma unroll
    for (int i = 0; i < 16; ++i) v[i] = *(const f32x4*)(src + (size_t)(k0 + 16 * q + i) * ld + n0 + 4 * c);
    if (kscale) {
#pragma unroll
        for (int i = 0; i < 16; ++i) v[i] = v[i] * kscale[k0 + 16 * q + i]; }
#pragma unroll
    for (int j = 0; j < 4; ++j) { const int ng = n0 + 4 * c + j;
        u32x4 o0, o1;
        o0.x = pk2(v[0][j], v[1][j]); o0.y = pk2(v[2][j], v[3][j]); o0.z = pk2(v[4][j], v[5][j]); o0.w = pk2(v[6][j], v[7][j]);
        o1.x = pk2(v[8][j], v[9][j]); o1.y = pk2(v[10][j], v[11][j]); o1.z = pk2(v[12][j], v[13][j]); o1.w = pk2(v[14][j], v[15][j]);
        size_t drow; int K;
        switch (jobkind) {
          case 0: drow = ng; K = 1024; break;
          case 1: drow = ng; K = 512; break;
          case 2: drow = ng; K = 1024; break;
          case 3: case 4: { const int h = ng, R = (h >> 7) * 256 + (jobkind == 4 ? 128 : 0) + (h & 127); drow = (size_t)e * 512 + R; K = 1024; } break;
          default: drow = (size_t)e * 1024 + ng; K = 256; break;
        }
        if (jobkind == 3 || jobkind == 4) {
            u32x4 o8; o8.x = pk4_fp8(v[0][j] * 32.f, v[1][j] * 32.f, v[2][j] * 32.f, v[3][j] * 32.f); o8.y = pk4_fp8(v[4][j] * 32.f, v[5][j] * 32.f, v[6][j] * 32.f, v[7][j] * 32.f);
            o8.z = pk4_fp8(v[8][j] * 32.f, v[9][j] * 32.f, v[10][j] * 32.f, v[11][j] * 32.f); o8.w = pk4_fp8(v[12][j] * 32.f, v[13][j] * 32.f, v[14][j] * 32.f, v[15][j] * 32.f);
            *(u32x4*)((unsigned char*)dst + drow * 1024 + k0 + 16 * q) = o8;
        } else if (jobkind == 5) {
            u32x4 o8; o8.x = pk4_fp8(v[0][j] * 16.f, v[1][j] * 16.f, v[2][j] * 16.f, v[3][j] * 16.f); o8.y = pk4_fp8(v[4][j] * 16.f, v[5][j] * 16.f, v[6][j] * 16.f, v[7][j] * 16.f);
            o8.z = pk4_fp8(v[8][j] * 16.f, v[9][j] * 16.f, v[10][j] * 16.f, v[11][j] * 16.f); o8.w = pk4_fp8(v[12][j] * 16.f, v[13][j] * 16.f, v[14][j] * 16.f, v[15][j] * 16.f);
            *(u32x4*)((unsigned char*)dst + drow * 256 + k0 + 16 * q) = o8;
        } else {
        bf16* d = dst + drow * K + k0 + 16 * q;
        *(u32x4*)d = o0; *(u32x4*)(d + 8) = o1; } }
}
constexpr int TP_J0 = 16 * 8, TP_J1 = 8 * 8, TP_J2 = 16 * 16, TP_J3 = 32 * 16 * 4, TP_J4 = TP_J3, TP_J5 = 32 * 4 * 16;
constexpr int TP_ITEMS = TP_J0 + TP_J1 + TP_J2 + TP_J3 + TP_J4 + TP_J5;
DI void tp_item(const Params& p, unsigned char* lds, int it) {
    unsigned char* ws = p.ws;
    if (it < TP_J0) { tp_tile(p.w_in, 1024, (it >> 3) * 64, (it & 7) * 64, lds, (bf16*)(ws + WS_WINT), 0, 0); return; } it -= TP_J0;
    if (it < TP_J1) { tp_tile(p.w_glu, 512, (it >> 3) * 64, (it & 7) * 64, lds, (bf16*)(ws + WS_WGLUT), 1, 0); return; } it -= TP_J1;
    if (it < TP_J2) { tp_tile(p.w_out, 1024, (it >> 4) * 64, (it & 15) * 64, lds, (bf16*)(ws + WS_WOUTT), 2, 0, (it >> 4) * 64 < 512 ? p.g_s : nullptr); return; } it -= TP_J2;
    if (it < TP_J3) { const int e = it >> 6, r = it & 63; tp_tile(p.w_gate + (size_t)e * 1024 * 256, 256, (r >> 2) * 64, (r & 3) * 64, lds, (bf16*)(ws + WS_WGUT), 3, e); return; } it -= TP_J3;
    if (it < TP_J4) { const int e = it >> 6, r = it & 63; tp_tile(p.w_up + (size_t)e * 1024 * 256, 256, (r >> 2) * 64, (r & 3) * 64, lds, (bf16*)(ws + WS_WGUT), 4, e); return; } it -= TP_J4;
    { const int e = it >> 6, r = it & 63; tp_tile(p.w_down + (size_t)e * 256 * 1024, 1024, (r >> 4) * 64, (r & 15) * 64, lds, (bf16*)(ws + WS_WDT), 5, e); }
}
DI void gfold_item(const Params& p, unsigned char* lds, int item) {
    const int q = item >> 6, k0 = (item & 63) * 16, tid = tidx(), lane = tid & 63, wid = tid >> 6, fr = lane & 15, fq = lane >> 4;
    const bf16* E = (const bf16*)(p.ws + WS_ETAB); const bf16* fwT = E + 256 * 128 + (size_t)q * 128 * 128;
    bf16* Tl = (bf16*)lds;
    bf16x8 af[4];
#pragma unroll
    for (int ks = 0; ks < 4; ++ks) { const float* wp = p.w_in + (size_t)(k0 + fr) * 1024 + 512 + 128 * q + ks * 32 + 8 * fq; const f32x4 w0 = *(const f32x4*)wp, w1 = *(const f32x4*)(wp + 4);
        u32x4 t; t.x = pk2(w0.x, w0.y); t.y = pk2(w0.z, w0.w); t.z = pk2(w1.x, w1.y); t.w = pk2(w1.z, w1.w); af[ks] = __builtin_bit_cast(bf16x8, t); }
#pragma unroll
    for (int t2 = 0; t2 < 2; ++t2) { const int nt = wid * 2 + t2, c = nt >> 3; f32x4 d = (f32x4){0.f, 0.f, 0.f, 0.f};
#pragma unroll
        for (int ks = 0; ks < 4; ++ks) { const bf16x8 bfr = *(const bf16x8*)(E + (size_t)(nt * 16 + fr) * 128 + ks * 32 + 8 * fq); d = __builtin_amdgcn_mfma_f32_16x16x32_bf16(af[ks], bfr, d, 0, 0, 0); }
#pragma unroll
        for (int r = 0; r < 4; ++r) Tl[(c * 16 + 4 * fq + r) * 136 + (nt & 7) * 16 + fr] = (bf16)(pk2(d[r], 0.f) & 0xffffu); }
    __syncthreads();
    bf16* WinT = (bf16*)(p.ws + WS_WINT);
    const float scale = 1.0f / 724.0773439350247f;
    { const int c = wid >> 2;
      bf16x8 a2[4];
#pragma unroll
      for (int ks = 0; ks < 4; ++ks) a2[ks] = *(const bf16x8*)(Tl + (c * 16 + fr) * 136 + ks * 32 + 8 * fq);
#pragma unroll
      for (int t2 = 0; t2 < 2; ++t2) { const int jt = (wid & 3) * 2 + t2; f32x4 d = (f32x4){0.f, 0.f, 0.f, 0.f};
#pragma unroll
          for (int ks = 0; ks < 4; ++ks) { const bf16x8 bfr = *(const bf16x8*)(fwT + (size_t)(jt * 16 + fr) * 128 + ks * 32 + 8 * fq); d = __builtin_amdgcn_mfma_f32_16x16x32_bf16(bfr, a2[ks], d, 0, 0, 0); }
#pragma unroll
          for (int r = 0; r < 4; ++r) WinT[(size_t)(512 + c * 512 + q * 128 + jt * 16 + 4 * fq + r) * 1024 + k0 + fr] = (bf16)(pk2(d[r] * scale, 0.f) & 0xffffu); } }
    __syncthreads();
}
DI void s5mats_item(const Params& p, unsigned char* lds, int item) {
    const int g = item >> 3, part = item & 7;
    const int tid = tidx();
    float* Bb = (float*)lds;
    float* Cc = Bb + 4096;
    float* pw = Cc + 4096;
    float* Kt = pw + 8448;
    float* qv = Kt;
    if (tid < 128) { const int d = tid >> 6, pp = tid & 63;
        const double dt = exp((double)p.log_step[d * 32 + g]); const double lr = p.lam_re[(d * 32 + g) * 64 + pp], li = p.lam_im[(d * 32 + g) * 64 + pp];
        const double mag = exp(lr * dt); double tt = li * dt / 3.14159265358979323846; tt -= 2.0 * floor(tt * 0.5);
        double sn, cs; sincospi(tt, &sn, &cs); const double ar = mag * cs, ai = mag * sn;
        const double nr = ar - 1.0, ni = ai, den = lr * lr + li * li;
        qv[tid * 2] = (float)((nr * lr + ni * li) / den); qv[tid * 2 + 1] = (float)((ni * lr - nr * li) / den);
        double pr = 1.0, pi = 0.0;
        for (int k = 0; k < 33; ++k) { pw[(tid * 33 + k) * 2] = (float)pr; pw[(tid * 33 + k) * 2 + 1] = (float)pi; const double t2 = pr * ar - pi * ai; pi = pr * ai + pi * ar; pr = t2; } }
    __syncthreads();
    for (int idx = tid; idx < 2 * 64 * 16; idx += NT) { const int dp = idx >> 4, h = idx & 15; const float qr = qv[dp * 2], qi = qv[dp * 2 + 1];
        const int d = dp >> 6, pp = dp & 63;
        const float br = p.b_re[((size_t)(d * 32 + g) * 64 + pp) * 16 + h], bi = p.b_im[((size_t)(d * 32 + g) * 64 + pp) * 16 + h];
        Bb[idx * 2] = qr * br - qi * bi; Bb[idx * 2 + 1] = qr * bi + qi * br; }
    for (int idx = tid; idx < 2 * 16 * 64; idx += NT) { const int d = idx >> 10, i = (idx >> 6) & 15, pp = idx & 63;
        Cc[idx * 2] = p.c_re[((size_t)(d * 32 + g) * 16 + i) * 64 + pp]; Cc[idx * 2 + 1] = p.c_im[((size_t)(d * 32 + g) * 16 + i) * 64 + pp]; }
    __syncthreads();
    { const int t3 = tid >> 2, pq = tid & 3, d = t3 >> 6, k = (t3 >> 1) & 31, i = part * 2 + (t3 & 1);
      float acc[16];
#pragma unroll
      for (int h = 0; h < 16; ++h) acc[h] = 0.f;
      for (int pp = pq * 16; pp < pq * 16 + 16; ++pp) {
          const float cr = Cc[((d * 16 + i) * 64 + pp) * 2], ci = Cc[((d * 16 + i) * 64 + pp) * 2 + 1];
          const float wr = pw[((d * 64 + pp) * 33 + k) * 2], wi = pw[((d * 64 + pp) * 33 + k) * 2 + 1];
          const float xr = cr * wr - ci * wi, xi = cr * wi + ci * wr;
          const f32x4* bb = (const f32x4*)(Bb + (d * 64 + pp) * 32);
#pragma unroll
          for (int h2 = 0; h2 < 8; ++h2) { const f32x4 b2 = bb[h2]; acc[2 * h2] += xr * b2.x - xi * b2.y; acc[2 * h2 + 1] += xr * b2.z - xi * b2.w; } }
#pragma unroll
      for (int h = 0; h < 16; ++h) { acc[h] += __shfl_xor(acc[h], 1); acc[h] += __shfl_xor(acc[h], 2); }
      if (pq == 0) {
#pragma unroll
          for (int h4 = 0; h4 < 4; ++h4) *(f32x4*)(Kt + ((d * 32 + k) * 16 + i) * 16 + h4 * 4) = (f32x4){acc[h4 * 4], acc[h4 * 4 + 1], acc[h4 * 4 + 2], acc[h4 * 4 + 3]}; } }
    __syncthreads();
    bf16* Mg = (bf16*)(p.ws + WS_MGW) + (size_t)g * 512 * 768;
    for (int c4 = tid; c4 < 64 * 64; c4 += NT) { const int rq = c4 >> 6, c8 = c4 & 63, j = rq >> 1, i = part * 2 + (rq & 1), row = j * 16 + i, s = c8 >> 1, h0 = (c8 & 1) * 8; float v[8];
#pragma unroll
        for (int t = 0; t < 8; ++t) { float a = 0.f; if (s <= j) a += Kt[((0 * 32 + (j - s)) * 16 + i) * 16 + h0 + t]; if (s >= j) a += Kt[((1 * 32 + (s - j)) * 16 + i) * 16 + h0 + t]; v[t] = a; }
        u32x4 o; o.x = pk2(v[0], v[1]); o.y = pk2(v[2], v[3]); o.z = pk2(v[4], v[5]); o.w = pk2(v[6], v[7]);
        *(u32x4*)(Mg + (size_t)row * 768 + c8 * 8) = o; }
    bf16* Wst = (bf16*)(p.ws + WS_WST) + (size_t)g * 256 * 512;
    for (int c4 = tid; c4 < 32 * 64; c4 += NT) { const int r = part * 32 + (c4 >> 6), c8 = c4 & 63, s = c8 >> 1, h0 = (c8 & 1) * 8, d = r >> 7, c = r & 1, pp = (r >> 1) & 63;
        const int e = d == 0 ? 31 - s : s; const float wr = pw[((d * 64 + pp) * 33 + e) * 2], wi = pw[((d * 64 + pp) * 33 + e) * 2 + 1]; float v[8];
#pragma unroll
        for (int t = 0; t < 8; ++t) { const float br = Bb[((d * 64 + pp) * 16 + h0 + t) * 2], bi = Bb[((d * 64 + pp) * 16 + h0 + t) * 2 + 1]; v[t] = c == 0 ? wr * br - wi * bi : wr * bi + wi * br; }
        u32x4 o; o.x = pk2(v[0], v[1]); o.y = pk2(v[2], v[3]); o.z = pk2(v[4], v[5]); o.w = pk2(v[6], v[7]);
        *(u32x4*)(Wst + (size_t)r * 512 + c8 * 8) = o; }
    bf16* Wos = (bf16*)(p.ws + WS_MGW) + (size_t)g * 512 * 768 + 512;
    for (int c4 = tid; c4 < 64 * 32; c4 += NT) { const int rq = c4 >> 5, c8 = c4 & 31, j = rq >> 1, i = part * 2 + (rq & 1), row = j * 16 + i, col0 = c8 * 8, d = col0 >> 7, p0 = (col0 >> 1) & 63;
        const int e = d == 0 ? j + 1 : 32 - j; float v[8];
#pragma unroll
        for (int t = 0; t < 8; ++t) { const int pp = p0 + (t >> 1), c = t & 1; const float cr = Cc[((d * 16 + i) * 64 + pp) * 2], ci = Cc[((d * 16 + i) * 64 + pp) * 2 + 1];
            const float wr = pw[((d * 64 + pp) * 33 + e) * 2], wi = pw[((d * 64 + pp) * 33 + e) * 2 + 1]; v[t] = c == 0 ? cr * wr - ci * wi : -(cr * wi + ci * wr); }
        u32x4 o; o.x = pk2(v[0], v[1]); o.y = pk2(v[2], v[3]); o.z = pk2(v[4], v[5]); o.w = pk2(v[6], v[7]);
        *(u32x4*)(Wos + (size_t)row * 768 + c8 * 8) = o; }
    float* aT = (float*)(p.ws + WS_ABART) + g * 256;
    if (part == 0 && tid < 128) { const int d = tid >> 6, pp = tid & 63; aT[tid * 2] = pw[((d * 64 + pp) * 33 + 32) * 2]; aT[tid * 2 + 1] = pw[((d * 64 + pp) * 33 + 32) * 2 + 1]; }
    __syncthreads();
}
DI void fftc_item(const Params& p, int item, int nitems) {
    const int tid = tidx();
    bf16* W1 = (bf16*)(p.ws + WS_FFTC);
    bf16* W2 = W1 + 128 * 128;
    float* tw = (float*)(p.ws + WS_FFTC + 32768 + 16384);
    for (int idx = item * NT + tid; idx < 128 * 128 + 4 * 64 * 32 + 4096; idx += nitems * NT) {
        if (idx < 16384) { const int n = idx >> 7, k = idx & 127, co = n >> 6, d = n & 63, ci = k >> 6, bq = k & 63; double s, c; sincospi((double)((d * bq) & 63) / 32.0, &s, &c);
            const float v = (ci == co) ? (float)c : (ci == 1 ? (float)s : (float)(-s)); W1[idx] = (bf16)(pk2(v, 0.f) & 0xffffu); }
        else if (idx < 16384 + 8192) { const int i2 = idx - 16384, s_ = i2 >> 11, cf = (i2 >> 5) & 63, slot = i2 & 31, gq = slot >> 3, jp = slot & 7;
            const int a = 16 * (2 * (s_ & 1) + (jp >> 2)) + 4 * gq + (jp & 3); double s, c; sincospi((double)((cf * a) & 63) / 32.0, &s, &c);
            W2[i2] = (bf16)(pk2((s_ >> 1) == 0 ? (float)c : (float)s, 0.f) & 0xffffu); }
        else { const int i3 = idx - 16384 - 8192, ln = i3 & 63, r = (i3 >> 6) & 3, mt = (i3 >> 8) & 3, nt = i3 >> 10; const int d = 16 * nt + (ln & 15), a = 16 * mt + 4 * (ln >> 4) + r;
            double s, c; sincospi((double)((d * a) & 4095) / 2048.0, &s, &c); tw[i3 * 2] = (float)c; tw[i3 * 2 + 1] = (float)s; }
    }
}
constexpr int P0_S5 = 256, P0_GF = 256;
constexpr int P0_ITEMS = P0_S5 + P0_GF;
DI void rw_item(const Params& p, int item, int nitems) {
    bf16* W = (bf16*)(p.ws + WS_WRT);
    for (int i = item * NT + tidx(); i < 48 * 1024; i += nitems * NT) { const int n = i >> 10, k = i & 1023; const float v = n < 4 ? p.w_group[k * 4 + n] : (n < 36 ? p.w_router[k * 32 + (n - 4)] : 0.f); W[i] = (bf16)(pk2(v, 0.f) & 0xffffu); }
}
DI void phaseA_adaln(const Params& p, unsigned char* lds, int bid, int nb) {
    for (int it = bid; it < 192 + 64; it += nb) {
        if (it < 192) { adaln_item(p, lds, it); continue; }
        const int t = it - 192, tid = tidx();
        bf16* E = (bf16*)(p.ws + WS_ETAB); bf16* fwT = E + 256 * 128;
        for (int i = t * NT + tid; i < 256 * 128; i += 64 * NT) { const int cn = i >> 7, m = i & 127, c = cn >> 7, n = cn & 127; double sv, cv; sincospi((double)((n * m) & 127) / 64.0, &sv, &cv);
            E[i] = (bf16)(pk2(c == 0 ? (float)cv : (float)(-sv), 0.f) & 0xffffu); }
        for (int i = t * NT + tid; i < 4 * 128 * 128; i += 64 * NT) { const int q = i >> 14, j = (i >> 7) & 127, n = i & 127; fwT[i] = (bf16)(pk2(p.fourier_w[((size_t)q * 128 + n) * 128 + j], 0.f) & 0xffffu); }
        fftc_item(p, t, 64); rw_item(p, t, 64);
    }
}
DI int a1pos(int r) { if (r >= NTOK) return r; const int a = r & 63, bq = (r >> 6) & 63; return (r & ~4095) + (((a >> 2) * 16 + (bq >> 2)) * 16 + (a & 3) * 4 + (bq & 3)); }
DI void a1_item(const Params& p, int r0) {
    const int lane = tidx() & 63;
    const float* mod = (const float*)(p.ws + WS_MOD);
    bf16* A1 = (bf16*)(p.ws + WS_A1);
    constexpr int RW = 4;
    const float* src = r0 < NTOK ? p.x + (size_t)r0 * D : p.ctx + (size_t)(r0 - NTOK) * D;
    const int mr = r0 < NTOK ? (r0 >> 12) : 8;
    f32x4 v[RW][4]; float s[RW];
#pragma unroll
    for (int q = 0; q < RW; ++q)
#pragma unroll
        for (int j = 0; j < 4; ++j) v[q][j] = ((const f32x4*)(src + (size_t)q * D) + lane)[64 * j];
    f32x4 gm[4], sh[4];
#pragma unroll
    for (int j = 0; j < 4; ++j) { const int k = lane * 4 + 256 * j; gm[j] = *(const f32x4*)(p.norm1_g + k) * (*(const f32x4*)(mod + mr * 6144 + 1024 + k) + 1.f); sh[j] = *(const f32x4*)(mod + mr * 6144 + k); }
#pragma unroll
    for (int q = 0; q < RW; ++q) { float t = 0.f;
#pragma unroll
        for (int j = 0; j < 4; ++j) t += (v[q][j].x * v[q][j].x + v[q][j].y * v[q][j].y) + (v[q][j].z * v[q][j].z + v[q][j].w * v[q][j].w);
        s[q] = t; }
#pragma unroll
    for (int o = 1; o < 64; o <<= 1) {
#pragma unroll
        for (int q = 0; q < RW; ++q) s[q] += __shfl_xor(s[q], o); }
#pragma unroll
    for (int q = 0; q < RW; ++q) { const float rs = rsqrtf(s[q] * (1.f / D) + EPS); u32x2* o = (u32x2*)(A1 + (size_t)a1pos(r0 + q) * A1P) + lane;
#pragma unroll
        for (int j = 0; j < 4; ++j) { const f32x4 h = v[q][j] * rs * gm[j] + sh[j]; u32x2 w; w.x = pk2(h.x, h.y); w.y = pk2(h.z, h.w); o[64 * j] = w; } }
}
constexpr int TP_NODOWN = TP_ITEMS - TP_J5;
constexpr int WI_A1 = NROWS1 / 4, WI_ALL = WI_A1 + TP_NODOWN;
DI void phaseAB_prep(const Params& p, unsigned char* lds, int bid, int nb) {
    phaseA_adaln(p, lds, bid, nb);
    unsigned* flag = (unsigned*)(p.ws + WS_CTL + CTL_FLAGA);
    asm volatile("s_waitcnt vmcnt(0)" ::: "memory");
    __syncthreads();
    if (tidx() == 0) { __builtin_amdgcn_fence(__ATOMIC_RELEASE, "agent"); asm volatile("s_waitcnt vmcnt(0)" ::: "memory"); (void)__hip_atomic_fetch_add(flag, 1u, __ATOMIC_RELAXED, __HIP_MEMORY_SCOPE_AGENT); }
    for (int it = bid; it < P0_S5; it += nb) s5mats_item(p, lds, it);
    if (tidx() == 0) { unsigned sp = 0; while (__hip_atomic_load(flag, __ATOMIC_RELAXED, __HIP_MEMORY_SCOPE_AGENT) < (unsigned)nb) { __builtin_amdgcn_s_sleep(2); if (++sp > (1u << 22)) break; }
        __builtin_amdgcn_fence(__ATOMIC_ACQUIRE, "agent"); asm volatile("s_waitcnt vmcnt(0)" ::: "memory"); }
    __syncthreads();
    for (int it = bid; it < P0_GF; it += nb) gfold_item(p, lds, it);
    __syncthreads();
    const int wid = tidx() >> 6;
    for (int it = bid * 8 + wid; it < WI_ALL; it += nb * 8) {
        if (it < WI_A1) a1_item(p, it * 4); else tp_item(p, lds, it - WI_A1);
    }
}

struct G1uPol {
    static constexpr bool FP8 = false;
    template <class U> DI bool half(const U&) const { return false; }
    static constexpr long KSTEP_A = 0;
    DI unsigned aoff(int R, int C) const { return (unsigned)((((R & 63) >> 2) * 256 + (R & 3) * 4 + (R >> 6)) * lda + C) * 2u; }
    struct Unit { int pm, pn; };
    static constexpr bool GATHER = false;
    pg8::DenseOrder ord; const char* A; const char* B; int K, ksplit, lda, ldb;
    DI bool next(int i, Unit& u) const { return ord.get(i, u.pm, u.pn); }
    DI void ptrs(const Unit& u, pg8::UPtr& q) const { q.a0 = A + (size_t)((u.pm >> 4) * 4096 + (u.pm & 15) * 16) * lda * 2; q.a1 = q.a0 + (size_t)2 * lda * 2; q.b0 = B + (size_t)u.pn * 256 * ldb * 2; q.b1 = q.b0 + (size_t)128 * ldb * 2; q.c0 = q.b0; q.c1 = q.b1; }
    DI int brow(int R) const { return R; }
    DI void gather(const Unit&, int (&)[2], int (&)[2], unsigned&, unsigned&, unsigned&, unsigned&) const {}
};
struct G1uEpi {
    static constexpr bool AFTER_DRAIN = false;
    static constexpr int MIDK_T = -1;
    bf16* Ul;
    DI void operator()(const f32x4 (&acc)[2][2][4][2], const G1uPol::Unit& u, int wr, int wc, int fr, int fq) const {
#pragma unroll
        for (int ai = 0; ai < 2; ++ai)
#pragma unroll
            for (int m = 0; m < 4; ++m) { const int row = u.pm * 256 + ai * 128 + wr * 64 + m * 16 + fr, b = row >> 12, l = row & 4095;
#pragma unroll
                for (int bj = 0; bj < 2; ++bj) { const int c0 = u.pn * 256 + bj * 128 + wc * 32 + 8 * fq, g = c0 >> 4, h0 = c0 & 15;
                    const f32x4 a0 = acc[ai][bj][m][0], a1 = acc[ai][bj][m][1];
                    u32x4 w; w.x = pk2(a0[0], a0[1]); w.y = pk2(a0[2], a0[3]); w.z = pk2(a1[0], a1[1]); w.w = pk2(a1[2], a1[3]);
                    *(u32x4*)(Ul + (((size_t)g * 1024 + b * 128 + (l >> 5)) * 768 + (l & 31) * 16 + h0)) = w; } }
    }
};
struct G1gPol {
    static constexpr bool FP8 = false;
    template <class U> DI bool half(const U&) const { return false; }
    static constexpr long KSTEP_A = 0;
    DI unsigned aoff(int R, int C) const { return (unsigned)(R * lda + C) * 2u; }
    struct Unit { int pm, pn; };
    static constexpr bool GATHER = false;
    pg8::DenseOrder ord; const char* A; const char* B; int K, ksplit, lda, ldb;
    DI bool next(int i, Unit& u) const { return ord.get(i, u.pm, u.pn); }
    DI void ptrs(const Unit& u, pg8::UPtr& q) const { q.a0 = A + (size_t)u.pm * 256 * lda * 2; q.a1 = q.a0 + (size_t)128 * lda * 2;
        q.b0 = B + (size_t)u.pn * 256 * ldb * 2; q.b1 = q.b0 + (size_t)8 * ldb * 2; q.c0 = q.b0; q.c1 = q.b1; }
    DI int brow(int R) const { return ((R & 63) >> 2) * 16 + (R >> 6) * 4 + (R & 3); }
    DI void gather(const Unit&, int (&)[2], int (&)[2], unsigned&, unsigned&, unsigned&, unsigned&) const {}
};
struct G1gEpi {
    static constexpr bool AFTER_DRAIN = false;
    static constexpr int MIDK_T = -1;
    bf16* GT;
    DI void operator()(const f32x4 (&acc)[2][2][4][2], const G1gPol::Unit& u, int wr, int wc, int fr, int fq) const {
        const int b = u.pn >> 4, a0 = (u.pn & 15) * 4;
#pragma unroll
        for (int ai = 0; ai < 2; ++ai)
#pragma unroll
            for (int m = 0; m < 4; ++m) { const int mm = u.pm * 256 + ai * 128 + wr * 64 + m * 16 + fr, c = mm >> 9, ch = mm & 511;
                bf16* base = GT + (size_t)((b * 512 + ch) * 2 + c) * 4096;
#pragma unroll
                for (int bj = 0; bj < 2; ++bj) { const int a = a0 + 2 * bj + (wc >> 1), bq = 32 * (wc & 1) + 8 * fq;
                    const f32x4 v0 = acc[ai][bj][m][0], v1 = acc[ai][bj][m][1];
                    u32x4 w; w.x = pk2(v0[0], v0[1]); w.y = pk2(v0[2], v0[3]); w.z = pk2(v1[0], v1[1]); w.w = pk2(v1[2], v1[3]);
                    __builtin_nontemporal_store(w, (u32x4*)(base + a * 64 + bq)); } }
    }
};
DI void phase1b(const Params& p, unsigned char* lds, int bid, int nb) {
    { G1gPol P; P.ord.init(4, NTOK / 256, nb, bid); P.A = (const char*)(p.ws + WS_WINT) + (size_t)512 * 2048; P.B = (const char*)(p.ws + WS_A1); P.K = 1024; P.ksplit = 16; P.lda = 1024; P.ldb = A1P;
      G1gEpi E{(bf16*)(p.ws + WS_R2)};
      pg8::gemm_phase<G1gPol, G1gEpi, true>((PG8_LAS unsigned char*)lds, P, E); }
    { G1uPol P; P.ord.init(NTOK / 256, 2, nb, bid); P.A = (const char*)(p.ws + WS_A1); P.B = (const char*)(p.ws + WS_WINT); P.K = 1024; P.ksplit = 16; P.lda = A1P; P.ldb = 1024;
      G1uEpi E{(bf16*)(p.ws + WS_R3)};
      pg8::gemm_phase<G1uPol, G1uEpi, true>((PG8_LAS unsigned char*)lds, P, E); }
    { const int tid = tidx(), lane = tid & 63, wid = tid >> 6, fr = lane & 15, fq = lane >> 4;
      for (int item = bid; item < 256; item += nb) { const int g = item >> 3, b = item & 7;
          const bf16* A1c = (const bf16*)(p.ws + WS_A1) + (size_t)(NTOK + b * 256 + wid * 32) * A1P; const bf16* Wg = (const bf16*)(p.ws + WS_WINT) + (size_t)(g * 16) * D;
          f32x4 ca[2] = {(f32x4){0.f, 0.f, 0.f, 0.f}, (f32x4){0.f, 0.f, 0.f, 0.f}};
#pragma unroll 8
          for (int ks = 0; ks < 32; ++ks) { const bf16x8 bw = *(const bf16x8*)(Wg + (size_t)fr * D + ks * 32 + fq * 8);
              const bf16x8 a0 = *(const bf16x8*)(A1c + (size_t)fr * A1P + ks * 32 + fq * 8), a1 = *(const bf16x8*)(A1c + (size_t)(16 + fr) * A1P + ks * 32 + fq * 8);
              ca[0] = __builtin_amdgcn_mfma_f32_16x16x32_bf16(bw, a0, ca[0], 0, 0, 0); ca[1] = __builtin_amdgcn_mfma_f32_16x16x32_bf16(bw, a1, ca[1], 0, 0, 0); }
          bf16* Ucw = (bf16*)(p.ws + WS_R4) + ((size_t)g * 256 + b * 8 + wid) * 768;
#pragma unroll
          for (int mt = 0; mt < 2; ++mt) { u32x2 w; w.x = pk2(ca[mt][0], ca[mt][1]); w.y = pk2(ca[mt][2], ca[mt][3]); *(u32x2*)(Ucw + (size_t)(mt * 16 + fr) * 16 + 4 * fq) = w; } } }
}
constexpr int S5_SP = 528, S5_SC_OFF = 256 * S5_SP, S5A_LDS = S5_SC_OFF + 16 * S5_SP;
struct S5aPol {
    static constexpr bool FP8 = false;
    template <class U> DI bool half(const U&) const { return false; }
    struct Unit { int g, mt; };
    static constexpr bool GATHER = false;
    static constexpr long KSTEP_A = 0;
    int c; const char* A; const char* B; int K, ksplit, lda, ldb;
    DI unsigned aoff(int R, int C) const { return (unsigned)(R * lda + C) * 2u; }
    DI bool next(int i, Unit& u) const { if (i > 0 || c >= 128) return false; u.g = c >> 2; u.mt = c & 3; return true; }
    DI void ptrs(const Unit& u, pg8::UPtr& q) const { q.a0 = A + ((size_t)u.g * 1024 + u.mt * 256) * lda * 2; q.a1 = q.a0 + (size_t)128 * lda * 2;
        q.b0 = B + (size_t)u.g * 256 * ldb * 2; q.b1 = q.b0 + (size_t)128 * ldb * 2; q.c0 = q.b0; q.c1 = q.b1; }
    DI int brow(int R) const { return R; }
    DI void gather(const Unit&, int (&)[2], int (&)[2], unsigned&, unsigned&, unsigned&, unsigned&) const {}
};
struct S5aEpi {
    static constexpr int MIDK_T = -1;
    static constexpr bool AFTER_DRAIN = true;
    unsigned char* Sl;
    DI void operator()(const f32x4 (&acc)[2][2][4][2], const S5aPol::Unit& u, int wr, int wc, int fr, int fq) const {
#pragma unroll
        for (int ai = 0; ai < 2; ++ai)
#pragma unroll
            for (int m = 0; m < 4; ++m) { unsigned char* dst = Sl + (size_t)(ai * 128 + wr * 64 + m * 16 + fr) * S5_SP + (wc * 32 + 8 * fq) * 2;
#pragma unroll
                for (int bj = 0; bj < 2; ++bj) { const f32x4 v0 = acc[ai][bj][m][0], v1 = acc[ai][bj][m][1];
                    u32x4 w; w.x = pk2(v0[0], v0[1]); w.y = pk2(v0[2], v0[3]); w.z = pk2(v1[0], v1[1]); w.w = pk2(v1[2], v1[3]);
                    *(u32x4*)(dst + bj * 256) = w; } }
    }
};
DI void phase2a_s5(const Params& p, unsigned char* lds, int bid, int nb) {
    const int vc = (nb % 8 == 0) ? (bid % 8) * (nb / 8) + bid / 8 : bid;
    if (vc >= 128) return;
    const int tid = tidx(), lane = tid & 63, wid = tid >> 6, fr = lane & 15, fq = lane >> 4, g = vc >> 2, mt = vc & 3;
    { S5aPol P; P.c = vc; P.A = (const char*)(p.ws + WS_R3); P.B = (const char*)(p.ws + WS_WST); P.K = 512; P.ksplit = 8; P.lda = 768; P.ldb = 512;
      S5aEpi E{lds};
      pg8::gemm_phase<S5aPol, S5aEpi, true>((PG8_LAS unsigned char*)lds, P, E); }
    { const bf16* Ac = (const bf16*)(p.ws + WS_R4) + ((size_t)g * 256 + (2 * mt + (fr >> 3)) * 8 + (fr & 7)) * 768 + fq * 8; const bf16* Wst = (const bf16*)(p.ws + WS_WST) + ((size_t)g * 256 + wid * 32 + fr) * 512 + fq * 8;
      f32x4 cs[2] = {(f32x4){0.f, 0.f, 0.f, 0.f}, (f32x4){0.f, 0.f, 0.f, 0.f}};
#pragma unroll 8
      for (int ks = 0; ks < 16; ++ks) { const bf16x8 a0 = *(const bf16x8*)(Ac + ks * 32); const bf16x8 w0 = *(const bf16x8*)(Wst + ks * 32), w1 = *(const bf16x8*)(Wst + (size_t)16 * 512 + ks * 32);
          cs[0] = __builtin_amdgcn_mfma_f32_16x16x32_bf16(w0, a0, cs[0], 0, 0, 0); cs[1] = __builtin_amdgcn_mfma_f32_16x16x32_bf16(w1, a0, cs[1], 0, 0, 0); }
#pragma unroll
      for (int j = 0; j < 2; ++j) { u32x2 w; w.x = pk2(cs[j][0], cs[j][1]); w.y = pk2(cs[j][2], cs[j][3]); *(u32x2*)(lds + S5_SC_OFF + (size_t)fr * S5_SP + (wid * 32 + 16 * j + 4 * fq) * 2) = w; } }
    __syncthreads();
    if (wid < 4) {
        const int bsel = wid >> 1, d = wid & 1, b = 2 * mt + bsel;
        const float* aT = (const float*)(p.ws + WS_ABART) + g * 256 + (d * 64 + lane) * 2; const float ar = aT[0], ai = aT[1];
        const unsigned char* Sg = lds + (size_t)(bsel * 128) * S5_SP + (d * 128 + 2 * lane) * 2;
        const unsigned char* Sc = lds + S5_SC_OFF + (size_t)(bsel * 8) * S5_SP + (d * 128 + 2 * lane) * 2;
        unsigned* Hout = (unsigned*)((bf16*)(p.ws + WS_R3) + ((size_t)g * 1024 + b * 128) * 768 + 512 + d * 128) + lane;
        float hr = 0.f, hi = 0.f;
        { unsigned sv[8];
#pragma unroll
          for (int j = 0; j < 8; ++j) { const int c = d == 0 ? j : 7 - j; sv[j] = *(const unsigned*)(Sc + (size_t)c * S5_SP); }
#pragma unroll
          for (int j = 0; j < 8; ++j) { const float sr = __uint_as_float(sv[j] << 16), si = __uint_as_float(sv[j] & 0xffff0000u); const float nr = ar * hr - ai * hi + sr, ni = ar * hi + ai * hr + si; hr = nr; hi = ni; } }
#pragma unroll 1
        for (int cb = 0; cb < 128; cb += 32) { unsigned sv[32];
#pragma unroll
            for (int j = 0; j < 32; ++j) { const int c = d == 0 ? cb + j : 127 - cb - j; sv[j] = *(const unsigned*)(Sg + (size_t)c * S5_SP); }
#pragma unroll
            for (int j = 0; j < 32; ++j) { const int c = d == 0 ? cb + j : 127 - cb - j; Hout[(size_t)c * 384] = pk2(hr, hi);
                const float sr = __uint_as_float(sv[j] << 16), si = __uint_as_float(sv[j] & 0xffff0000u); const float nr = ar * hr - ai * hi + sr, ni = ar * hi + ai * hr + si; hr = nr; hi = ni; } }
    }
    __syncthreads();
}
struct S5cPol {
    static constexpr bool FP8 = false;
    template <class U> DI bool half(const U&) const { return false; }
    static constexpr long KSTEP_A = 0;
    DI unsigned aoff(int R, int C) const { return (unsigned)(R * lda + C) * 2u; }
    struct Unit { int g, mt, pn; };
    static constexpr bool GATHER = false;
    int G, c; const char* A; const char* B; int K, ksplit, lda, ldb;
    DI bool next(int i, Unit& u) const { const int L = i * G + c; if (L >= 256) return false; u.g = L >> 3; u.mt = (L >> 1) & 3; u.pn = L & 1; return true; }
    DI void ptrs(const Unit& u, pg8::UPtr& q) const { q.a0 = A + ((size_t)u.g * 1024 + u.mt * 256) * lda * 2; q.a1 = q.a0 + (size_t)128 * lda * 2; q.b0 = B + ((size_t)u.g * 512 + u.pn * 256) * ldb * 2; q.b1 = q.b0 + (size_t)128 * ldb * 2; q.c0 = q.b0; q.c1 = q.b1; }
    DI int brow(int R) const { return R; }
    DI void gather(const Unit&, int (&)[2], int (&)[2], unsigned&, unsigned&, unsigned&, unsigned&) const {}
};
struct S5cEpi {
    static constexpr bool AFTER_DRAIN = false;
    static constexpr int MIDK_T = -1;
    const bf16* Ucat; const float* s5d; bf16* yact;
    DI void operator()(const f32x4 (&acc)[2][2][4][2], const S5cPol::Unit& u, int wr, int wc, int fr, int fq) const {
        const int n0 = u.pn * 256 + wc * 32 + 8 * fq, i0 = n0 & 15;
        const f32x4 d0 = *(const f32x4*)(s5d + u.g * 16 + i0), d1 = *(const f32x4*)(s5d + u.g * 16 + i0 + 4);
#pragma unroll
        for (int ai = 0; ai < 2; ++ai) {
            u32x4 uu[4][2];
#pragma unroll
            for (int m = 0; m < 4; ++m) { const int row = u.mt * 256 + ai * 128 + wr * 64 + m * 16 + fr;
#pragma unroll
                for (int bj = 0; bj < 2; ++bj) uu[m][bj] = *(const u32x4*)(Ucat + ((size_t)u.g * 1024 + row) * 768 + n0 + bj * 128); }
#pragma unroll
            for (int m = 0; m < 4; ++m) { const int row = u.mt * 256 + ai * 128 + wr * 64 + m * 16 + fr, b = row >> 7, c = row & 127;
#pragma unroll
                for (int bj = 0; bj < 2; ++bj) { const int col = n0 + bj * 128, l = 32 * c + (col >> 4); const u32x4 v = uu[m][bj]; const f32x4 a0 = acc[ai][bj][m][0], a1 = acc[ai][bj][m][1];
                    const float y0 = geluf_(a0[0] + d0.x * __uint_as_float(v.x << 16)), y1 = geluf_(a0[1] + d0.y * __uint_as_float(v.x & 0xffff0000u));
                    const float y2 = geluf_(a0[2] + d0.z * __uint_as_float(v.y << 16)), y3 = geluf_(a0[3] + d0.w * __uint_as_float(v.y & 0xffff0000u));
                    const float y4 = geluf_(a1[0] + d1.x * __uint_as_float(v.z << 16)), y5 = geluf_(a1[1] + d1.y * __uint_as_float(v.z & 0xffff0000u));
                    const float y6 = geluf_(a1[2] + d1.z * __uint_as_float(v.w << 16)), y7 = geluf_(a1[3] + d1.w * __uint_as_float(v.w & 0xffff0000u));
                    u32x4 w; w.x = pk2(y0, y1); w.y = pk2(y2, y3); w.z = pk2(y4, y5); w.w = pk2(y6, y7);
                    *(u32x4*)(yact + (((size_t)u.g * NTOK + b * 4096 + l) * 16 + i0)) = w; } }
            asm volatile("" ::: "memory");
        }
    }
};
DI void phase2c_s5out(const Params& p, unsigned char* lds, int bid, int nb) {
    S5cPol P; P.G = nb; P.c = (nb % 8 == 0) ? (bid % 8) * (nb / 8) + bid / 8 : bid; P.A = (const char*)(p.ws + WS_R3); P.B = (const char*)(p.ws + WS_MGW); P.K = 768; P.ksplit = 12; P.lda = 768; P.ldb = 768;
    S5cEpi E{(const bf16*)(p.ws + WS_R3), p.s5_d, (bf16*)(p.ws + WS_R4)};
    pg8::gemm_phase<S5cPol, S5cEpi, true>((PG8_LAS unsigned char*)lds, P, E);
}
constexpr int FF_W1P = 272, FF_W2P = 80, FF_W1_OFF = 0, FF_W2_OFF = 128 * FF_W1P, FF_TW_OFF = FF_W2_OFF + 4 * 64 * FF_W2P, FF_LDS = FF_TW_OFF + 32768, FF_STP = 144, FF_LDS2 = FF_LDS + 8 * 64 * FF_STP;
DI void phase2_fft(const Params& p, unsigned char* lds, int bid, int nb) {
    const int tid = tidx(), lane = tid & 63, wid = tid >> 6, fr = lane & 15, fq = lane >> 4;
    { const bf16* W1 = (const bf16*)(p.ws + WS_FFTC); const bf16* W2 = W1 + 128 * 128; const float* tw = (const float*)(p.ws + WS_FFTC + 32768 + 16384);
      for (int i = tid; i < 128 * 16; i += NT) { const int n = i >> 4, c = i & 15; *(u32x4*)(lds + FF_W1_OFF + n * FF_W1P + c * 16) = *(const u32x4*)(W1 + n * 128 + c * 8); }
      for (int i = tid; i < 256 * 4; i += NT) { const int r = i >> 2, c = i & 3; *(u32x4*)(lds + FF_W2_OFF + r * FF_W2P + c * 16) = *(const u32x4*)(W2 + r * 32 + c * 8); }
      for (int i = tid; i < 2048; i += NT) *(u32x4*)(lds + FF_TW_OFF + i * 16) = *(const u32x4*)(tw + i * 4);
      __syncthreads(); }
    const bf16* GT = (const bf16*)(p.ws + WS_R2); bf16* FT = (bf16*)(p.ws + WS_R5);
    unsigned char* fst = lds + FF_LDS + wid * (64 * FF_STP);
    const float* twl = (const float*)(lds + FF_TW_OFF) + lane * 2;
    const int vcf = (nb % 8 == 0) ? (bid % 8) * (nb / 8) + bid / 8 : bid;
    const bool bal = nb == 256; const int nch = bal ? (vcf < 128 ? 1 : 3) : 0;
    const int cstep = bal ? 1 : nb * 8, c0 = bal ? (vcf < 128 ? vcf * 8 + wid : 1024 + ((vcf - 128) * 8 + wid) * 3) : bid * 8 + wid, cend = bal ? c0 + nch : 4096;
    bf16x8 afr[4][4];
#define FFT_LOAD(cix) do { const bf16* gt_ = GT + (size_t)(cix) * 2 * 4096; _Pragma("unroll") for (int ks = 0; ks < 4; ++ks) _Pragma("unroll") for (int mt = 0; mt < 4; ++mt) \
        afr[ks][mt] = *(const bf16x8*)(gt_ + (ks >> 1) * 4096 + (16 * mt + fr) * 64 + 32 * (ks & 1) + 8 * fq); } while (0)
    if (c0 < cend) FFT_LOAD(c0);
    for (int cidx = c0; cidx < cend; cidx += cstep) {
        bf16* ft = FT + (size_t)cidx * 4096;
        bf16x8 frag[4][4];
        __builtin_amdgcn_sched_barrier(0);
#pragma unroll
        for (int mh = 0; mh < 2; ++mh) {
            f32x4 d1[2][8];
#pragma unroll
            for (int m = 0; m < 2; ++m)
#pragma unroll
                for (int n = 0; n < 8; ++n) d1[m][n] = (f32x4){0.f, 0.f, 0.f, 0.f};
#pragma unroll
            for (int ks = 0; ks < 4; ++ks) {
#pragma unroll
                for (int nt = 0; nt < 8; ++nt) { const bf16x8 bfr = *(const bf16x8*)(lds + FF_W1_OFF + (nt * 16 + fr) * FF_W1P + (ks * 32 + fq * 8) * 2);
#pragma unroll
                    for (int m = 0; m < 2; ++m) d1[m][nt] = __builtin_amdgcn_mfma_f32_16x16x32_bf16(afr[ks][2 * mh + m], bfr, d1[m][nt], 0, 0, 0); }
                __builtin_amdgcn_sched_barrier(0);
            }
            if (mh == 1) { FFT_LOAD(cidx + cstep < cend ? cidx + cstep : cidx); __builtin_amdgcn_sched_barrier(0); }
#pragma unroll
            for (int nt = 0; nt < 4; ++nt) { unsigned pr[2][2], pi[2][2];
#pragma unroll
                for (int m = 0; m < 2; ++m) { const int mt = 2 * mh + m; float tr[4], ti[4];
#pragma unroll
                    for (int r = 0; r < 4; ++r) { const float cs = twl[((nt * 4 + mt) * 4 + r) * 128], sn = twl[((nt * 4 + mt) * 4 + r) * 128 + 1];
                        const float re = d1[m][nt][r], im = d1[m][nt + 4][r]; tr[r] = re * cs + im * sn; ti[r] = im * cs - re * sn; }
                    pr[m][0] = pk2(tr[0], tr[1]); pr[m][1] = pk2(tr[2], tr[3]); pi[m][0] = pk2(ti[0], ti[1]); pi[m][1] = pk2(ti[2], ti[3]); }
                u32x4 f0, f2;
                f0.x = pr[0][0]; f0.y = pr[0][1]; f0.z = pr[1][0]; f0.w = pr[1][1];
                f2.x = pi[0][0]; f2.y = pi[0][1]; f2.z = pi[1][0]; f2.w = pi[1][1];
                frag[nt][mh] = __builtin_bit_cast(bf16x8, f0); frag[nt][2 + mh] = __builtin_bit_cast(bf16x8, f2);
                __builtin_amdgcn_sched_barrier(0); }
        }
#pragma unroll
        for (int nt = 0; nt < 4; ++nt) {
            f32x4 z[4];
#pragma unroll
            for (int n = 0; n < 4; ++n) z[n] = (f32x4){0.f, 0.f, 0.f, 0.f};
#pragma unroll
            for (int s2 = 0; s2 < 4; ++s2)
#pragma unroll
                for (int n2 = 0; n2 < 4; ++n2) { const bf16x8 bfr = *(const bf16x8*)(lds + FF_W2_OFF + ((s2 * 64 + n2 * 16 + fr) * FF_W2P) + fq * 16);
                    z[n2] = __builtin_amdgcn_mfma_f32_16x16x32_bf16(frag[nt][s2], bfr, z[n2], 0, 0, 0); }
#pragma unroll
            for (int n2 = 0; n2 < 4; ++n2) { const int cf = 16 * n2 + fr; u32x2 w; w.x = pk2(z[n2][0], z[n2][1]); w.y = pk2(z[n2][2], z[n2][3]);
                *(u32x2*)(fst + cf * FF_STP + (16 * nt + 4 * fq) * 2) = w; }
            __builtin_amdgcn_sched_barrier(0);
        }
#pragma unroll
        for (int j = 0; j < 8; ++j) { const int idx = j * 64 + lane, r = idx >> 3, sg = idx & 7; const u32x4 v = *(const u32x4*)(fst + r * FF_STP + sg * 16); *(u32x4*)(ft + 64 * r + 8 * sg) = v; }
        __builtin_amdgcn_sched_barrier(0);
    }
}
struct GluPol {
    static constexpr bool FP8 = false;
    template <class U> DI bool half(const U&) const { return false; }
    struct Unit { int pm, pn; };
    static constexpr bool GATHER = false;
    static constexpr long KSTEP_A = 4L * NTOK * 16 * 2;
    pg8::DenseOrder ord; const char* A; const char* B; int K, ksplit, lda, ldb;
    DI unsigned aoff(int R, int C) const { return (unsigned)(((C >> 4) * NTOK + R) * 16 + (C & 15)) * 2u; }
    DI bool next(int i, Unit& u) const { return ord.get(i, u.pm, u.pn); }
    DI void ptrs(const Unit& u, pg8::UPtr& q) const { q.a0 = A + (size_t)u.pm * 256 * 32; q.a1 = q.a0 + (size_t)128 * 32; q.b0 = B + (size_t)u.pn * 256 * ldb * 2; q.b1 = q.b0 + (size_t)128 * ldb * 2; q.c0 = q.b0; q.c1 = q.b1; }
    DI int brow(int R) const { return R; }
    DI void gather(const Unit&, int (&)[2], int (&)[2], unsigned&, unsigned&, unsigned&, unsigned&) const {}
#undef FFT_LOAD
};
struct GluEpi {
    static constexpr bool AFTER_DRAIN = false;
    static constexpr int MIDK_T = -1;
    const bf16* yact; bf16* merged; float* rsqs;
    DI void operator()(const f32x4 (&acc)[2][2][4][2], const GluPol::Unit& u, int wr, int wc, int fr, int fq) const {
        const int col0 = u.pn * 256 + wc * 32 + 8 * fq;
#pragma unroll
        for (int ai = 0; ai < 2; ++ai) {
            u32x4 yy[4][2];
#pragma unroll
            for (int m = 0; m < 4; ++m) { const int row = u.pm * 256 + ai * 128 + wr * 64 + m * 16 + fr;
#pragma unroll
                for (int bj = 0; bj < 2; ++bj) { const int col = col0 + bj * 128; yy[m][bj] = *(const u32x4*)(yact + ((size_t)(col >> 4) * NTOK + row) * 16 + (col & 15)); } }
#pragma unroll
            for (int m = 0; m < 4; ++m) { const int row = u.pm * 256 + ai * 128 + wr * 64 + m * 16 + fr; float sq = 0.f;
#pragma unroll
                for (int bj = 0; bj < 2; ++bj) { const u32x4 y = yy[m][bj]; const f32x4 a0 = acc[ai][bj][m][0], a1 = acc[ai][bj][m][1];
                    const float y0 = __uint_as_float(y.x << 16) * sigmoidf_(a0[0]), y1 = __uint_as_float(y.x & 0xffff0000u) * sigmoidf_(a0[1]);
                    const float y2 = __uint_as_float(y.y << 16) * sigmoidf_(a0[2]), y3 = __uint_as_float(y.y & 0xffff0000u) * sigmoidf_(a0[3]);
                    const float y4 = __uint_as_float(y.z << 16) * sigmoidf_(a1[0]), y5 = __uint_as_float(y.z & 0xffff0000u) * sigmoidf_(a1[1]);
                    const float y6 = __uint_as_float(y.w << 16) * sigmoidf_(a1[2]), y7 = __uint_as_float(y.w & 0xffff0000u) * sigmoidf_(a1[3]);
                    u32x4 w; w.x = pk2(y0, y1); w.y = pk2(y2, y3); w.z = pk2(y4, y5); w.w = pk2(y6, y7); *(u32x4*)(merged + (size_t)row * 1024 + col0 + bj * 128) = w;
                    sq += ((y0 * y0 + y1 * y1) + (y2 * y2 + y3 * y3)) + ((y4 * y4 + y5 * y5) + (y6 * y6 + y7 * y7)); }
                sq += __shfl_xor(sq, 16); sq += __shfl_xor(sq, 32);
                if (fq == 0) rsqs[(size_t)row * 8 + u.pn * 4 + wc] = sq; }
            asm volatile("" ::: "memory");
        }
    }
};
DI void phase3_glu(const Params& p, unsigned char* lds, int bid, int nb) {
    GluPol P; P.ord.init(NTOK / 256, 2, nb, bid); P.A = (const char*)(p.ws + WS_R4); P.B = (const char*)(p.ws + WS_WGLUT); P.K = 512; P.ksplit = 8; P.lda = 512; P.ldb = 512;
    GluEpi E{(const bf16*)(p.ws + WS_R4), (bf16*)(p.ws + WS_R1), (float*)(p.ws + WS_RSQS)};
    pg8::gemm_phase<GluPol, GluEpi, true>((PG8_LAS unsigned char*)lds, P, E);
}
constexpr int FM_PITCH = 132, FM_LDS = 512 * FM_PITCH;
DI void phase3_fin(const Params& p, unsigned char* lds, int bid, int nb) {
    const int tid = tidx(), lane = tid & 63, wid = tid >> 6;
    const bf16* FT = (const bf16*)(p.ws + WS_R5); bf16* merged = (bf16*)(p.ws + WS_R1);
    float gf[8];
#pragma unroll
    for (int j = 0; j < 8; ++j) gf[j] = p.g_f[lane + 64 * j];
    for (int item = bid; item < 512; item += nb) {
        const int b = item >> 6, k0 = (item & 63) * 64;
        { u32x4 v[8];
#pragma unroll
          for (int i = 0; i < 8; ++i) { const int ix = tid + NT * i, ch = ix >> 3, c = ix & 7; v[i] = *(const u32x4*)(FT + ((size_t)(b * 512 + ch) * 4096 + k0 + c * 8)); }
#pragma unroll
          for (int i = 0; i < 8; ++i) { const int ix = tid + NT * i, ch = ix >> 3, c = ix & 7; unsigned* d = (unsigned*)(lds + ch * FM_PITCH + c * 16); d[0] = v[i].x; d[1] = v[i].y; d[2] = v[i].z; d[3] = v[i].w; } }
        __syncthreads();
        float f[8][8], s[8];
#pragma unroll
        for (int t = 0; t < 8; ++t)
#pragma unroll
            for (int j = 0; j < 8; ++j) f[t][j] = bf2f(*(const bf16*)(lds + (lane + 64 * j) * FM_PITCH + (wid * 8 + t) * 2));
#pragma unroll
        for (int t = 0; t < 8; ++t) { float a = 0.f;
#pragma unroll
            for (int j = 0; j < 8; ++j) a += f[t][j] * f[t][j];
            s[t] = a; }
#pragma unroll
        for (int o = 1; o < 64; o <<= 1) {
#pragma unroll
            for (int t = 0; t < 8; ++t) s[t] += __shfl_xor(s[t], o); }
#pragma unroll
        for (int t = 0; t < 8; ++t) { const size_t row = (size_t)b * 4096 + k0 + wid * 8 + t; const float rs = rsqrtf(s[t] * (1.f / 512.f) + EPS);
#pragma unroll
            for (int j = 0; j < 8; ++j) merged[row * 1024 + 512 + lane + 64 * j] = (bf16)(pk2(f[t][j] * rs * gf[j], 0.f) & 0xffffu); }
        __syncthreads();
    }
}
struct P4Pol {
    static constexpr bool FP8 = false;
    template <class U> DI bool half(const U&) const { return false; }
    static constexpr long KSTEP_A = 0;
    DI unsigned aoff(int R, int C) const { return (unsigned)(R * lda + C) * 2u; }
    struct Unit { int pm, pn; };
    static constexpr bool GATHER = false;
    pg8::DenseOrder ord; const char* A; const char* B; int K, ksplit, lda, ldb;
    DI bool next(int i, Unit& u) const { return ord.get(i, u.pm, u.pn); }
    DI void ptrs(const Unit& u, pg8::UPtr& q) const { q.a0 = A + (size_t)u.pm * 256 * lda * 2; q.a1 = q.a0 + (size_t)128 * lda * 2; q.b0 = B + (size_t)u.pn * 256 * ldb * 2; q.b1 = q.b0 + (size_t)128 * ldb * 2; q.c0 = q.b0; q.c1 = q.b1; }
    DI int brow(int R) const { return R; }
    DI void gather(const Unit&, int (&)[2], int (&)[2], unsigned&, unsigned&, unsigned&, unsigned&) const {}
};
struct P4Epi {
    static constexpr bool AFTER_DRAIN = false;
    static constexpr int MIDK_T = 8;
    const float* x; bf16* x1b; const float* mod; float* rsqp; const float* rss;
    DI void midk(f32x4 (&acc)[2][2][4][2], const P4Pol::Unit& u, int wr, int wc, int fr, int fq) const {
        float r[2][4]; f32x4 q0[2][4], q1[2][4];
#pragma unroll
        for (int ai = 0; ai < 2; ++ai)
#pragma unroll
            for (int m = 0; m < 4; ++m) { const f32x4* q = (const f32x4*)(rss + (size_t)(u.pm * 256 + ai * 128 + wr * 64 + m * 16 + fr) * 8); q0[ai][m] = q[0]; q1[ai][m] = q[1]; }
#pragma unroll
        for (int ai = 0; ai < 2; ++ai)
#pragma unroll
            for (int m = 0; m < 4; ++m) r[ai][m] = rsqrtf((((q0[ai][m].x + q0[ai][m].y) + (q0[ai][m].z + q0[ai][m].w)) + ((q1[ai][m].x + q1[ai][m].y) + (q1[ai][m].z + q1[ai][m].w))) * (1.f / 512.f) + EPS);
#pragma unroll
        for (int ai = 0; ai < 2; ++ai)
#pragma unroll
            for (int m = 0; m < 4; ++m)
#pragma unroll
                for (int bj = 0; bj < 2; ++bj)
#pragma unroll
                    for (int n = 0; n < 2; ++n) acc[ai][bj][m][n] = acc[ai][bj][m][n] * r[ai][m];
    }
    DI void operator()(const f32x4 (&acc)[2][2][4][2], const P4Pol::Unit& u, int wr, int wc, int fr, int fq) const {
        const int col0 = u.pn * 256 + wc * 32 + 8 * fq, b = (u.pm * 256) >> 12;
        f32x4 gv[2][2];
#pragma unroll
        for (int bj = 0; bj < 2; ++bj)
#pragma unroll
            for (int n = 0; n < 2; ++n) gv[bj][n] = *(const f32x4*)(mod + b * 6144 + 2048 + col0 + bj * 128 + n * 4);
        f32x4 xa[2][2][2], xb[2][2][2];
#define P4_LOAD(dst, q_) do { const int ai_ = (q_) >> 1, mb_ = ((q_) & 1) * 2; _Pragma("unroll") for (int m2 = 0; m2 < 2; ++m2) { const int row_ = u.pm * 256 + ai_ * 128 + wr * 64 + (mb_ + m2) * 16 + fr; \
            _Pragma("unroll") for (int bj = 0; bj < 2; ++bj) _Pragma("unroll") for (int n = 0; n < 2; ++n) dst[m2][bj][n] = *(const f32x4*)(x + (size_t)row_ * D + col0 + bj * 128 + n * 4); } } while (0)
#define P4_DO(src, q_) do { const int ai_ = (q_) >> 1, mb_ = ((q_) & 1) * 2; _Pragma("unroll") for (int m2 = 0; m2 < 2; ++m2) { const int m_ = mb_ + m2, row_ = u.pm * 256 + ai_ * 128 + wr * 64 + m_ * 16 + fr; float s_ = 0.f; \
            _Pragma("unroll") for (int bj = 0; bj < 2; ++bj) { const f32x4 o0 = src[m2][bj][0] + gv[bj][0] * acc[ai_][bj][m_][0], o1 = src[m2][bj][1] + gv[bj][1] * acc[ai_][bj][m_][1]; \
                u32x4 w; w.x = pk2(o0.x, o0.y); w.y = pk2(o0.z, o0.w); w.z = pk2(o1.x, o1.y); w.w = pk2(o1.z, o1.w); *(u32x4*)(x1b + (size_t)row_ * D + col0 + bj * 128) = w; \
                s_ += ((o0.x * o0.x + o0.y * o0.y) + (o0.z * o0.z + o0.w * o0.w)) + ((o1.x * o1.x + o1.y * o1.y) + (o1.z * o1.z + o1.w * o1.w)); } \
            s_ += __shfl_xor(s_, 16); s_ += __shfl_xor(s_, 32); if (fq == 0) rsqp[(size_t)row_ * 16 + u.pn * 4 + wc] = s_; } } while (0)
        P4_LOAD(xa, 0); P4_LOAD(xb, 1);
        P4_DO(xa, 0); asm volatile("" ::: "memory"); P4_LOAD(xa, 2);
        P4_DO(xb, 1); asm volatile("" ::: "memory"); P4_LOAD(xb, 3);
        P4_DO(xa, 2); asm volatile("" ::: "memory");
        P4_DO(xb, 3);
#undef P4_LOAD
#undef P4_DO
    }
};
DI void phase4_out(const Params& p, unsigned char* lds, int bid, int nb) {
    P4Pol P; P.ord.init(NTOK / 256, D / 256, nb, bid); P.A = (const char*)(p.ws + WS_R1); P.B = (const char*)(p.ws + WS_WOUTT); P.K = 1024; P.ksplit = 16; P.lda = 1024; P.ldb = 1024;
    P4Epi E{p.x, (bf16*)(p.ws + WS_X1B), (const float*)(p.ws + WS_MOD), (float*)(p.ws + WS_RSQP1), (const float*)(p.ws + WS_RSQS)};
    pg8::gemm_phase<P4Pol, P4Epi, true>((PG8_LAS unsigned char*)lds, P, E);
}
DI int pair_index(int lo, int hi) { return 7 * lo - (lo * (lo - 1)) / 2 + (hi - lo - 1); }
constexpr int RT_WP = 2064, RT_GM_OFF = 48 * RT_WP, RT_SH_OFF = RT_GM_OFF + 4096, RT_SC_OFF = RT_SH_OFF + 4096, RT_LC_OFF = RT_SC_OFF + 8 * 16 * 48 * 4, RT_LDS = RT_LC_OFF + 2 * 144 * 4;
DI void phase5_route(const Params& p, unsigned char* lds, int bid, int nb, bool commit = true) {
    const int tid = tidx(), lane = tid & 63, wid = tid >> 6, fr = lane & 15, fq = lane >> 4;
    { const bf16* W = (const bf16*)(p.ws + WS_WRT);
      for (int i = tid; i < 48 * 128; i += NT) { const int n = i >> 7, c = i & 127; *(u32x4*)(lds + n * RT_WP + c * 16) = *(const u32x4*)(W + n * 1024 + c * 8); } }
    const float* mod = (const float*)(p.ws + WS_MOD); const float* rsqp = (const float*)(p.ws + WS_RSQP1);
    bf16* A2 = (bf16*)(p.ws + WS_A2); unsigned* elcp = (unsigned*)(p.ws + WS_ELCP); float* elw = (float*)(p.ws + WS_ELW); unsigned* tcp = (unsigned*)(p.ws + WS_TCP);
    unsigned* ecnt = (unsigned*)(p.ws + WS_CTL + CTL_ECNT); unsigned* pcnt = (unsigned*)(p.ws + WS_CTL + CTL_PCNT);
    unsigned* elist = (unsigned*)(p.ws + WS_ELIST);
    float* gm = (float*)(lds + RT_GM_OFF); float* shv = (float*)(lds + RT_SH_OFF); float* scr = (float*)(lds + RT_SC_OFF) + wid * 16 * 48;
    unsigned* lcnt = (unsigned*)(lds + RT_LC_OFF); unsigned* lbase = lcnt + 144;
    for (int t128 = bid; t128 < NTOK / 128; t128 += nb) {
        const int b = t128 >> 5;
        __syncthreads();
        for (int k = tid; k < 1024; k += NT) { gm[k] = p.norm2_g[k] * (1.f + mod[b * 6144 + 4096 + k]); shv[k] = mod[b * 6144 + 3072 + k]; }
        if (tid < 144) lcnt[tid] = 0u;
        __syncthreads();
        const int row0 = t128 * 128 + wid * 16, row = row0 + fr;
        float rs;
        { const f32x4* pp = (const f32x4*)(rsqp + (size_t)row * 16); const f32x4 q0 = pp[0], q1 = pp[1], q2 = pp[2], q3 = pp[3];
          const float rsum = (((q0.x + q0.y) + (q0.z + q0.w)) + ((q1.x + q1.y) + (q1.z + q1.w))) + (((q2.x + q2.y) + (q2.z + q2.w)) + ((q3.x + q3.y) + (q3.z + q3.w)));
          rs = rsqrtf(rsum * (1.f / D) + EPS); }
        f32x4 acc[3];
#pragma unroll
        for (int n = 0; n < 3; ++n) acc[n] = (f32x4){0.f, 0.f, 0.f, 0.f};
        const bf16* xr = (const bf16*)(p.ws + WS_X1B) + (size_t)row * D + fq * 16; unsigned char* ar = (unsigned char*)A2 + (size_t)row * D + fq * 16;
        u32x4 xa[8], xb[8]; u32x2 pend = {0u, 0u}; unsigned char* stg = (unsigned char*)scr;
#pragma unroll
        for (int i = 0; i < 8; ++i) xa[i] = *(const u32x4*)(xr + (i >> 1) * 64 + (i & 1) * 8);
#pragma unroll 1
        for (int kc = 0; kc < 4; kc += 2) {
#pragma unroll
            for (int i = 0; i < 8; ++i) xb[i] = *(const u32x4*)(xr + (kc + 1) * 256 + (i >> 1) * 64 + (i & 1) * 8);
#pragma unroll
            for (int half = 0; half < 2; ++half) {
#pragma unroll
                for (int i = 0; i < 8; ++i) {
                    const int ks = (kc + half) * 8 + i, k0 = (ks >> 1) * 64 + fq * 16 + (ks & 1) * 8;
                    const u32x4 xx = half ? xb[i] : xa[i];
                    f32x4 x0, x1; x0.x = __uint_as_float(xx.x << 16); x0.y = __uint_as_float(xx.x & 0xffff0000u); x0.z = __uint_as_float(xx.y << 16); x0.w = __uint_as_float(xx.y & 0xffff0000u);
                    x1.x = __uint_as_float(xx.z << 16); x1.y = __uint_as_float(xx.z & 0xffff0000u); x1.z = __uint_as_float(xx.w << 16); x1.w = __uint_as_float(xx.w & 0xffff0000u);
                    const f32x4 g0 = *(const f32x4*)(gm + k0), g1 = *(const f32x4*)(gm + k0 + 4), s0 = *(const f32x4*)(shv + k0), s1 = *(const f32x4*)(shv + k0 + 4);
                    const f32x4 t0 = x0 * rs * g0 + s0, t1 = x1 * rs * g1 + s1;
                    u32x4 hi; hi.x = pk2(t0.x, t0.y); hi.y = pk2(t0.z, t0.w); hi.z = pk2(t1.x, t1.y); hi.w = pk2(t1.z, t1.w);
                    { u32x2 a8; a8.x = pk4_fp8(t0.x * 4.f, t0.y * 4.f, t0.z * 4.f, t0.w * 4.f); a8.y = pk4_fp8(t1.x * 4.f, t1.y * 4.f, t1.z * 4.f, t1.w * 4.f); if (i & 1) { u32x4 a16; a16.x = pend.x; a16.y = pend.y; a16.z = a8.x; a16.w = a8.y; *(u32x4*)(stg + fr * 144 + ((ks >> 1) & 1) * 64 + fq * 16) = a16;
                        if ((i & 3) == 3) {
#pragma unroll
                            for (int j = 0; j < 2; ++j) { const int idx = j * 64 + lane, r = idx >> 3, sg = idx & 7; const u32x4 v = *(const u32x4*)(stg + r * 144 + sg * 16);
                                *(u32x4*)((unsigned char*)A2 + (size_t)(row0 + r) * D + (ks >> 2) * 128 + sg * 16) = v; } }
                      } else pend = a8; }
                    u32x4 lo;
                    lo.x = pk2(t0.x - __uint_as_float(hi.x << 16), t0.y - __uint_as_float(hi.x & 0xffff0000u)); lo.y = pk2(t0.z - __uint_as_float(hi.y << 16), t0.w - __uint_as_float(hi.y & 0xffff0000u));
                    lo.z = pk2(t1.x - __uint_as_float(hi.z << 16), t1.y - __uint_as_float(hi.z & 0xffff0000u)); lo.w = pk2(t1.z - __uint_as_float(hi.w << 16), t1.w - __uint_as_float(hi.w & 0xffff0000u));
                    const bf16x8 ah = __builtin_bit_cast(bf16x8, hi), al = __builtin_bit_cast(bf16x8, lo);
#pragma unroll
                    for (int nt = 0; nt < 3; ++nt) { const bf16x8 bw = *(const bf16x8*)(lds + (16 * nt + fr) * RT_WP + k0 * 2);
                        acc[nt] = __builtin_amdgcn_mfma_f32_16x16x32_bf16(ah, bw, acc[nt], 0, 0, 0); acc[nt] = __builtin_amdgcn_mfma_f32_16x16x32_bf16(al, bw, acc[nt], 0, 0, 0); }
                }
                if (half == 0 && kc + 2 < 4) {
#pragma unroll
                    for (int i = 0; i < 8; ++i) xa[i] = *(const u32x4*)(xr + (kc + 2) * 256 + (i >> 1) * 64 + (i & 1) * 8);
                }
            }
        }
#pragma unroll
        for (int nt = 0; nt < 3; ++nt)
#pragma unroll
            for (int r = 0; r < 4; ++r) scr[(4 * fq + r) * 48 + 16 * nt + fr] = acc[nt][r];
        __syncthreads();
        int e1 = 0, e2 = 0, cls = 0, pos1 = 0; float w1 = 0.f, w2 = 0.f; unsigned r1 = 0, r2 = 0, r3 = 0; const bool rt = lane < 16 && commit;
        if (rt) {
            const int rrow = row0 + lane; const float* lg = scr + lane * 48;
            float gl[4];
#pragma unroll
            for (int o = 0; o < 4; ++o) gl[o] = lg[o] + p.b_group[o];
            float gmax = gl[0]; int gi = 0;
#pragma unroll
            for (int o = 1; o < 4; ++o) if (gl[o] > gmax) { gmax = gl[o]; gi = o; }
            float se = 0.f;
#pragma unroll
            for (int o = 0; o < 4; ++o) se += __expf(gl[o] - gmax);
            const float g_w = 1.f / se;
            float ev[8];
#pragma unroll
            for (int o = 0; o < 8; ++o) ev[o] = lg[4 + gi * 8 + o] + p.b_router[gi * 8 + o];
            float v1 = ev[0]; int i1 = 0;
#pragma unroll
            for (int o = 1; o < 8; ++o) if (ev[o] > v1) { v1 = ev[o]; i1 = o; }
            float v2 = -3.0e38f; int i2 = -1;
#pragma unroll
            for (int o = 0; o < 8; ++o) if (o != i1 && ev[o] > v2) { v2 = ev[o]; i2 = o; }
            w1 = g_w / (1.f + __expf(v2 - v1)); w2 = g_w - w1;
            const int lo = i1 < i2 ? i1 : i2, hi = i1 < i2 ? i2 : i1; pos1 = i1 < i2 ? 0 : 1;
            e1 = gi * 8 + i1; e2 = gi * 8 + i2; cls = gi * 28 + pair_index(lo, hi);
            r1 = atomicAdd(lcnt + e1, 1u); r2 = atomicAdd(lcnt + e2, 1u); r3 = atomicAdd(lcnt + 32 + cls, 1u);
        }
        __syncthreads();
        if (tid < 144) { const unsigned n = lcnt[tid]; if (n) lbase[tid] = atomicAdd((tid < 32 ? ecnt + tid * CNT_STRIDE : pcnt + (tid - 32) * CNT_STRIDE), n); }
        __syncthreads();
        if (rt) {
            const int rrow = row0 + lane;
            const unsigned q3 = lbase[32 + cls] + r3, cp = ((unsigned)cls << 16) | q3;
            tcp[rrow] = cp;
            const unsigned q1 = lbase[e1] + r1; elist[(size_t)e1 * 32768 + q1] = (unsigned)rrow * 2u + (unsigned)pos1; elcp[(size_t)e1 * 32768 + q1] = cp; elw[(size_t)e1 * 32768 + q1] = w1;
            const unsigned q2 = lbase[e2] + r2; elist[(size_t)e2 * 32768 + q2] = (unsigned)rrow * 2u + (unsigned)(1 - pos1); elcp[(size_t)e2 * 32768 + q2] = cp; elw[(size_t)e2 * 32768 + q2] = w2;
        }
    }
    __syncthreads();
}
constexpr int TB_OFF = 131072, TB_ETE = 64, TB_ETR = 64 + 320, TB_ETC = 64 + 640, TB_PTC = 64 + 960, TB_PTS = 64 + 1280, TB_COFF = 64 + 1600, TB_PTN = 64 + 1600 + 128 + 160, TB_BYTES = (64 + 1600 + 128 + 160 + 320) * 4;
DI void build_tiles(const Params& p, unsigned char* lds) {
    int* tb = (int*)(lds + TB_OFF); int* cnts = tb + TB_COFF + 112;
    const int tid = tidx();
    if (tid < 144) cnts[tid] = tid < 32 ? (int)((const unsigned*)(p.ws + WS_CTL + CTL_ECNT))[tid * CNT_STRIDE] : (int)((const unsigned*)(p.ws + WS_CTL + CTL_PCNT))[(tid - 32) * CNT_STRIDE];
    __syncthreads();
    const bool isE = tid < 32, isP = tid >= 64 && tid < 176;
    if (isE || isP) {
        const int base = isE ? 0 : 32, n = isE ? 32 : 112, me = isE ? tid : tid - 64;
        int fb = 0, pb = 0, hb = 0, ft = 0, pt = 0, rows_before = 0;
        for (int j = 0; j < n; ++j) { const int c = cnts[base + j], f = c >> 8, r = c & 255, pp = r > 128 ? 1 : 0, hh = (r > 0 && r <= 128) ? 1 : 0;
            ft += f; pt += pp; if (j < me) { fb += f; pb += pp; hb += hh; rows_before += ((c + 255) >> 8) << 8; } }
        const int c = cnts[base + me], f = c >> 8, r = c & 255;
        if (isE) {
            for (int k = 0; k < f; ++k) { tb[TB_ETE + fb + k] = me; tb[TB_ETR + fb + k] = k * 256; tb[TB_ETC + fb + k] = c; }
            if (r > 128) { const int ix = ft + pb; tb[TB_ETE + ix] = me; tb[TB_ETR + ix] = f * 256; tb[TB_ETC + ix] = c; }
            else if (r > 0) { const int ix = ft + pt + hb; tb[TB_ETE + ix] = me; tb[TB_ETR + ix] = f * 256; tb[TB_ETC + ix] = c; }
            if (me == 31) tb[0] = ft + pt + hb + ((r > 0 && r <= 128) ? 1 : 0);
        } else {
            tb[TB_COFF + me] = rows_before;
            for (int k = 0; k < f; ++k) { tb[TB_PTC + fb + k] = me; tb[TB_PTS + fb + k] = rows_before + k * 256; tb[TB_PTN + fb + k] = c - k * 256; }
            if (r > 128) { const int ix = ft + pb; tb[TB_PTC + ix] = me; tb[TB_PTS + ix] = rows_before + f * 256; tb[TB_PTN + ix] = r; }
            else if (r > 0) { const int ix = ft + pt + hb; tb[TB_PTC + ix] = me; tb[TB_PTS + ix] = rows_before + f * 256; tb[TB_PTN + ix] = r; }
            if (me == 111) tb[1] = ft + pt + hb + ((r > 0 && r <= 128) ? 1 : 0);
        }
    }
    __syncthreads();
}
struct GUPol {
    static constexpr bool FP8 = true;
    struct Unit { int e, r0, cnt, hh; };
    DI bool half(const Unit& u) const { return u.cnt - u.r0 <= 128; }
    static constexpr long KSTEP_A = 0;
    DI unsigned aoff(int R, int C) const { return (unsigned)(R * lda + C) * 2u; }
    static constexpr bool GATHER = true;
    const int* tb; int G, c; const char* A; const char* B; const unsigned* elist; int K, ksplit, lda, ldb;
    DI bool next(int i, Unit& u) const { const int L = i * G + c; if (L >= __builtin_amdgcn_readfirstlane(tb[0]) * 2) return false; const int t = L >> 1; u.hh = L & 1;
        u.e = __builtin_amdgcn_readfirstlane(tb[TB_ETE + t]); u.r0 = __builtin_amdgcn_readfirstlane(tb[TB_ETR + t]); u.cnt = __builtin_amdgcn_readfirstlane(tb[TB_ETC + t]); return true; }
    DI void ptrs(const Unit& u, pg8::UPtr& q) const { q.a0 = A; q.a1 = A; q.b0 = B + (size_t)((u.e * 2 + u.hh) * 256) * ldb * 2; q.b1 = q.b0 + (size_t)128 * ldb * 2; q.c0 = q.b0; q.c1 = q.b1; }
    DI int brow(int R) const { return R; }
    DI unsigned goff(const Unit& u, int r, int C) const { const unsigned ent = elist[(size_t)u.e * 32768 + (r < u.cnt ? r : u.r0)]; return ((ent >> 1) * 512u + (unsigned)C) * 2u; }
    DI void gather(const Unit& u, int (&R)[2], int (&C)[2], unsigned& v00, unsigned& v01, unsigned& v10, unsigned& v11) const {
        v00 = goff(u, u.r0 + R[0], C[0]); v01 = goff(u, u.r0 + R[1], C[1]); v10 = goff(u, u.r0 + 128 + R[0], C[0]); v11 = goff(u, u.r0 + 128 + R[1], C[1]);
    }
};
struct GUEpi {
    static constexpr bool AFTER_DRAIN = false;
    static constexpr int MIDK_T = -1;
    const unsigned* elist; const unsigned* elcp; const float* elw; bf16* Hs; const int* tb;
    DI void operator()(const f32x4 (&acc)[2][2][4][2], const GUPol::Unit& u, int wr, int wc, int fr, int fq) const {
        unsigned ent[2][4], cp[2][4]; float w[2][4];
#pragma unroll
        for (int ai = 0; ai < 2; ++ai)
#pragma unroll
            for (int m = 0; m < 4; ++m) { const int r = u.r0 + ai * 128 + wr * 64 + m * 16 + fr; const size_t ix = (size_t)u.e * 32768 + (r < u.cnt ? r : u.r0);
                ent[ai][m] = elist[ix]; cp[ai][m] = elcp[ix]; w[ai][m] = elw[ix]; }
#pragma unroll
        for (int ai = 0; ai < 2; ++ai)
#pragma unroll
            for (int m = 0; m < 4; ++m) { const int r = u.r0 + ai * 128 + wr * 64 + m * 16 + fr;
                if (r < u.cnt) { const int srow = tb[TB_COFF + (cp[ai][m] >> 16)] + (int)(cp[ai][m] & 0xffffu); const float ww = w[ai][m];
                    unsigned char* dst = (unsigned char*)Hs + (size_t)srow * 512 + (ent[ai][m] & 1u) * 256 + u.hh * 128 + wc * 32 + 8 * fq;
                    const f32x4 g0 = acc[ai][0][m][0] * (1.f / 128.f), g1 = acc[ai][0][m][1] * (1.f / 128.f), u0 = acc[ai][1][m][0] * (1.f / 128.f), u1 = acc[ai][1][m][1] * (1.f / 128.f); const float w16 = ww * 8.f;
                    u32x2 o; o.x = pk4_fp8(siluf_(g0[0]) * u0[0] * w16, siluf_(g0[1]) * u0[1] * w16, siluf_(g0[2]) * u0[2] * w16, siluf_(g0[3]) * u0[3] * w16);
                    o.y = pk4_fp8(siluf_(g1[0]) * u1[0] * w16, siluf_(g1[1]) * u1[1] * w16, siluf_(g1[2]) * u1[2] * w16, siluf_(g1[3]) * u1[3] * w16);
                    *(u32x2*)dst = o; } }
    }
};
DI void phase6_gateup(const Params& p, unsigned char* lds, int bid, int nb) {
    GUPol P; P.tb = (const int*)(lds + TB_OFF); P.G = nb; P.c = (nb % 8 == 0) ? (bid % 8) * (nb / 8) + bid / 8 : bid; P.A = (const char*)(p.ws + WS_A2); P.B = (const char*)(p.ws + WS_WGUT); P.elist = (const unsigned*)(p.ws + WS_ELIST); P.K = 512; P.ksplit = 8; P.lda = 512; P.ldb = 512;
    GUEpi E{(const unsigned*)(p.ws + WS_ELIST), (const unsigned*)(p.ws + WS_ELCP), (const float*)(p.ws + WS_ELW), (bf16*)(p.ws + WS_HS), (const int*)(lds + TB_OFF)};
    pg8::gemm_phase<GUPol, GUEpi, true>((PG8_LAS unsigned char*)lds, P, E);
    { const int nu = __builtin_amdgcn_readfirstlane(((const int*)(lds + TB_OFF))[0]) * 2, rounds = (nu + nb - 1) / nb, full = nu - (rounds - 1) * nb;
      const int nidle = nb - full, wid = tidx() >> 6;
      if (nidle >= nb / 4) { if (P.c >= full) for (int it = (P.c - full) * 8 + wid; it < TP_J5; it += nidle * 8) tp_item(p, lds, TP_NODOWN + it); }
      else { for (int it = bid * 8 + wid; it < TP_J5; it += nb * 8) tp_item(p, lds, TP_NODOWN + it); } }
}
struct DnPol {
    static constexpr bool FP8 = true;
    struct Unit { int s0, cls, pn, nrows; };
    DI bool half(const Unit& u) const { return u.nrows <= 128; }
    static constexpr long KSTEP_A = 0;
    DI unsigned aoff(int R, int C) const { return (unsigned)(R * lda + C) * 2u; }
    static constexpr bool GATHER = false;
    const int* tb; int G, c; const char* A; const char* B; int K, ksplit, lda, ldb;
    DI bool next(int i, Unit& u) const { const int L = i * G + c; if (L >= __builtin_amdgcn_readfirstlane(tb[1]) * 4) return false; const int t = L >> 2; u.pn = L & 3;
        u.cls = __builtin_amdgcn_readfirstlane(tb[TB_PTC + t]); u.s0 = __builtin_amdgcn_readfirstlane(tb[TB_PTS + t]); u.nrows = __builtin_amdgcn_readfirstlane(tb[TB_PTN + t]); return true; }
    DI void ptrs(const Unit& u, pg8::UPtr& q) const {
        const int gi = u.cls / 28; int lo = 0, rem = u.cls % 28;
        while (rem >= 7 - lo) { rem -= 7 - lo; ++lo; }
        const int hi = lo + 1 + rem, elo = gi * 8 + lo, ehi = gi * 8 + hi;
        q.a0 = A + (size_t)u.s0 * lda * 2; q.a1 = q.a0 + (size_t)128 * lda * 2;
        q.b0 = B + ((size_t)elo * 1024 + u.pn * 256) * ldb * 2; q.b1 = q.b0 + (size_t)128 * ldb * 2;
        q.c0 = B + ((size_t)ehi * 1024 + u.pn * 256) * ldb * 2; q.c1 = q.c0 + (size_t)128 * ldb * 2; }
    DI int brow(int R) const { return R; }
    DI void gather(const Unit&, int (&)[2], int (&)[2], unsigned&, unsigned&, unsigned&, unsigned&) const {}
};
struct DnEpi {
    static constexpr bool AFTER_DRAIN = false;
    static constexpr int MIDK_T = -1;
    bf16* moe;
    DI void operator()(const f32x4 (&acc)[2][2][4][2], const DnPol::Unit& u, int wr, int wc, int fr, int fq) const {
#pragma unroll
        for (int ai = 0; ai < 2; ++ai) { if (ai == 1 && u.nrows <= 128) break;
#pragma unroll
            for (int m = 0; m < 4; ++m) { bf16* dst = moe + (size_t)(u.s0 + ai * 128 + wr * 64 + m * 16 + fr) * 1024 + u.pn * 256 + wc * 32 + 8 * fq;
#pragma unroll
                for (int bj = 0; bj < 2; ++bj) { const f32x4 v0 = acc[ai][bj][m][0] * (1.f / 128.f), v1 = acc[ai][bj][m][1] * (1.f / 128.f);
                    u32x4 w; w.x = pk2(v0[0], v0[1]); w.y = pk2(v0[2], v0[3]); w.z = pk2(v1[0], v1[1]); w.w = pk2(v1[2], v1[3]);
                    *(u32x4*)(dst + bj * 128) = w; } } }
    }
};
DI void phase7_down(const Params& p, unsigned char* lds, int bid, int nb) {
    DnPol P; P.tb = (const int*)(lds + TB_OFF); P.G = nb; P.c = (nb % 8 == 0) ? (bid % 8) * (nb / 8) + bid / 8 : bid; P.A = (const char*)(p.ws + WS_HS); P.B = (const char*)(p.ws + WS_WDT); P.K = 256; P.ksplit = 2; P.lda = 256; P.ldb = 128;
    DnEpi E{(bf16*)(p.ws + WS_MOE)};
    pg8::gemm_phase<DnPol, DnEpi, true>((PG8_LAS unsigned char*)lds, P, E);
}
DI void phase8_final(const Params& p, unsigned char* lds, int bid, int nb) {
    const int lane = tidx() & 63, wave = tidx() >> 6;
    const float* mod = (const float*)(p.ws + WS_MOD); const unsigned* tcp = (const unsigned*)(p.ws + WS_TCP); const bf16* moe = (const bf16*)(p.ws + WS_MOE); const bf16* x1b = (const bf16*)(p.ws + WS_X1B); const int* tb = (const int*)(lds + TB_OFF);
    constexpr int RW = 4;
    for (int r0 = (bid * 8 + wave) * RW; r0 < NTOK; r0 += nb * 8 * RW) {
        const int b = r0 >> 12; unsigned cp[RW]; u32x2 xx[RW][4], mm[RW][4];
#pragma unroll
        for (int q = 0; q < RW; ++q) cp[q] = tcp[r0 + q];
#pragma unroll
        for (int q = 0; q < RW; ++q)
#pragma unroll
            for (int j = 0; j < 4; ++j) xx[q][j] = ((const u32x2*)(x1b + (size_t)(r0 + q) * D) + lane)[64 * j];
#pragma unroll
        for (int q = 0; q < RW; ++q) { const int srow = tb[TB_COFF + (cp[q] >> 16)] + (int)(cp[q] & 0xffffu);
#pragma unroll
            for (int j = 0; j < 4; ++j) mm[q][j] = ((const u32x2*)(moe + (size_t)srow * D) + lane)[64 * j]; }
        f32x4 g2[4], fg[4];
#pragma unroll
        for (int j = 0; j < 4; ++j) { g2[j] = *(const f32x4*)(mod + b * 6144 + 5120 + lane * 4 + 256 * j); fg[j] = *(const f32x4*)(p.final_g + lane * 4 + 256 * j); }
        f32x4 v[RW][4]; float s[RW];
#pragma unroll
        for (int q = 0; q < RW; ++q) { float t = 0.f;
#pragma unroll
            for (int j = 0; j < 4; ++j) { f32x4 x1, mv; x1.x = __uint_as_float(xx[q][j].x << 16); x1.y = __uint_as_float(xx[q][j].x & 0xffff0000u); x1.z = __uint_as_float(xx[q][j].y << 16); x1.w = __uint_as_float(xx[q][j].y & 0xffff0000u);
                mv.x = __uint_as_float(mm[q][j].x << 16); mv.y = __uint_as_float(mm[q][j].x & 0xffff0000u); mv.z = __uint_as_float(mm[q][j].y << 16); mv.w = __uint_as_float(mm[q][j].y & 0xffff0000u);
                v[q][j] = x1 + g2[j] * mv; t += (v[q][j].x * v[q][j].x + v[q][j].y * v[q][j].y) + (v[q][j].z * v[q][j].z + v[q][j].w * v[q][j].w); }
            s[q] = t; }
#pragma unroll
        for (int o = 1; o < 64; o <<= 1) {
#pragma unroll
            for (int q = 0; q < RW; ++q) s[q] += __shfl_xor(s[q], o); }
#pragma unroll
        for (int q = 0; q < RW; ++q) { const float rs = rsqrtf(s[q] * (1.f / D) + EPS); f32x4* orow = (f32x4*)(p.out + (size_t)(r0 + q) * D) + lane;
#pragma unroll
            for (int j = 0; j < 4; ++j) { f32x4 o = v[q][j] * rs * fg[j];
                if (MK_TS1 >= 0) { const unsigned* tsv = (const unsigned*)(p.ws + WS_CTL + CTL_TS); o = o * (1.f + (float)(tsv[0] / 1000u) * 0.01f); }
                orow[64 * j] = o; } }
    }
}

#define XB_TMO      128
#define XB_XCNT(j)  (256  + 64 * (j))
#define XB_XSUB(j)  (1280 + 64 * (j))
#define XB_XGEN(j)  (2304 + 64 * (j))
#define XB_TOP      3328
#define XB_TOPGEN   3392
#define XCD_BAR_WORDS 3456
#define XB_SPIN_CAP (1u << 18)
#define LAS __attribute__((address_space(3)))
DI unsigned xb_ld(unsigned* p)              { return __hip_atomic_load(p, __ATOMIC_RELAXED, __HIP_MEMORY_SCOPE_AGENT); }
DI unsigned xb_add(unsigned* p, unsigned v) { return __hip_atomic_fetch_add(p, v, __ATOMIC_RELAXED, __HIP_MEMORY_SCOPE_AGENT); }
DI unsigned xb_xcc_id() { return (unsigned)__builtin_amdgcn_s_getreg((3 << 11) | 20) & 0xFu; }
#define XB_SPIN(cond, bar) do { unsigned _sp = 0; while (cond) { __builtin_amdgcn_s_sleep(1); \
    if ((++_sp & 255u) == 0u) { if (xb_ld(&(bar)[XB_TMO])) break; if (_sp > XB_SPIN_CAP) { atomicAdd(&(bar)[XB_TMO], 1u); break; } } } } while (0)
struct XcdBarrier { unsigned* bar; unsigned x; volatile LAS unsigned* st; };
DI XcdBarrier xcd_barrier_post(unsigned* bar, volatile LAS unsigned* st) {
    XcdBarrier b; b.bar = bar; b.x = xb_xcc_id(); b.st = st;
    if (tidx() == 0) (void)xb_add(&bar[XB_XCNT(b.x)], 1u);
    return b;
}
DI void xcd_barrier_complete(unsigned* bar, unsigned x, unsigned& nloc, unsigned& nx) {
    const unsigned G = gridDim.x * gridDim.y * gridDim.z;
    unsigned sum, cnt, mine, sp = 0u;
    for (;;) {
        sum = 0u; cnt = 0u; mine = 0u;
#pragma unroll
        for (unsigned j = 0; j < 16; ++j) { const unsigned c = xb_ld(&bar[XB_XCNT(j)]); sum += c; cnt += (c > 0u) ? 1u : 0u; mine = (j == x) ? c : mine; }
        if (sum == G) break;
        __builtin_amdgcn_s_sleep(1);
        if ((++sp & 255u) == 0u) { if (xb_ld(&bar[XB_TMO])) break; if (sp > XB_SPIN_CAP) { atomicAdd(&bar[XB_TMO], 1u); break; } }
    }
    nloc = mine > 0u ? mine : 1u; nx = cnt > 0u ? cnt : 1u;
}
DI void xcd_barrier(const XcdBarrier& b) {
    asm volatile("s_waitcnt vmcnt(0)" ::: "memory");
    __syncthreads();
    if (tidx() == 0) {
        unsigned* bar = b.bar;
        __builtin_amdgcn_s_waitcnt(0);
        unsigned nloc = b.st[0], nx = b.st[1];
        if (nloc == 0u) { xcd_barrier_complete(bar, b.x, nloc, nx); b.st[0] = nloc; b.st[1] = nx; }
        const unsigned old = xb_add(&bar[XB_XSUB(b.x)], 1u);
        const unsigned gen = old / nloc;
        if (old + 1u == (gen + 1u) * nloc) {
            __builtin_amdgcn_fence(__ATOMIC_RELEASE, "agent");
            asm volatile("s_waitcnt vmcnt(0)" ::: "memory");
            const unsigned og = xb_add(&bar[XB_TOP], 1u);
            const unsigned tg = og / nx;
            if (og + 1u == (tg + 1u) * nx) xb_add(&bar[XB_TOPGEN], 1u);
            else XB_SPIN(xb_ld(&bar[XB_TOPGEN]) == tg, bar);
            __builtin_amdgcn_fence(__ATOMIC_ACQUIRE, "agent");
            xb_add(&bar[XB_XGEN(b.x)], 1u);
            asm volatile("s_waitcnt vmcnt(0)" ::: "memory");
        } else {
            XB_SPIN(xb_ld(&bar[XB_XGEN(b.x)]) == gen, bar);
            __builtin_amdgcn_fence(__ATOMIC_ACQUIRE, "agent");
            asm volatile("s_waitcnt vmcnt(0)" ::: "memory");
        }
    }
    __syncthreads();
}

constexpr int CTL_BAR = 16384;
constexpr int MK_LDS = 163840;
constexpr int MK_ST_OFF = MK_LDS - 16;
static_assert(S5A_LDS <= MK_ST_OFF - 1024 && FF_LDS2 <= MK_ST_OFF - 512 && RT_LDS <= MK_ST_OFF && TB_OFF + TB_BYTES <= MK_ST_OFF && TB_OFF >= pg8::STAGE_BYTES, "LDS map");
static_assert(4 * (4096 + 4096 + 8448 + 16384) <= MK_ST_OFF, "prep LDS");
#ifndef MK_REP
#define MK_REP -1
#endif
constexpr int MK_PT_OFF = MK_ST_OFF - 256;
static_assert(RT_LDS <= MK_PT_OFF && TB_OFF + TB_BYTES <= MK_PT_OFF, "LDS map (pointer table)");
DI Params ldp(const unsigned char* lds) {
    Params p; unsigned long long* d = (unsigned long long*)&p; const unsigned* t = (const unsigned*)(lds + MK_PT_OFF);
#pragma unroll
    for (int i = 0; i < 32; ++i) { const unsigned lo = __builtin_amdgcn_readfirstlane(t[2 * i]), hi = __builtin_amdgcn_readfirstlane(t[2 * i + 1]); d[i] = ((unsigned long long)hi << 32) | lo; }
    return p;
}
#define TSTAMP(i) do { if (MK_TS1 >= 0 && bid == 0 && tidx() == 0) ((unsigned long long*)(lds + MK_PT_OFF - 256))[i] = __builtin_amdgcn_s_memrealtime(); } while (0)
#define RUNPH(k, body) do { { const Params p = ldp(lds); body; } if (MK_REP == (k)) { xcd_barrier(bar); { const Params p = ldp(lds); body; } } } while (0)
#ifdef MK_ONLY
__global__ void __launch_bounds__(NT, 2) only_kernel(Params p) {
    extern __shared__ __attribute__((aligned(16))) unsigned char lds[];
    const int bid = blockIdx.x, nb = gridDim.x;
    if (MK_ONLY == 1) phaseAB_prep(p, lds, bid, nb);
    if (MK_ONLY == 2) phase1b(p, lds, bid, nb);
    if (MK_ONLY == 3) phase2a_s5(p, lds, bid, nb);
    if (MK_ONLY == 4) phase2_fft(p, lds, bid, nb);
    if (MK_ONLY == 9) phase2c_s5out(p, lds, bid, nb);
    if (MK_ONLY == 5) phase3_glu(p, lds, bid, nb);
    if (MK_ONLY == 6) phase3_fin(p, lds, bid, nb);
    if (MK_ONLY == 7) phase4_out(p, lds, bid, nb);
    if (MK_ONLY == 8) phase5_route(p, lds, bid, nb);
    if (MK_ONLY == 10) { build_tiles(p, lds); phase6_gateup(p, lds, bid, nb); }
    if (MK_ONLY == 11) { build_tiles(p, lds); phase7_down(p, lds, bid, nb); }
    if (MK_ONLY == 12) { build_tiles(p, lds); phase8_final(p, lds, bid, nb); }
}
#endif
__global__ void __launch_bounds__(NT, 2) mega_kernel(Params pk) {
    extern __shared__ __attribute__((aligned(16))) unsigned char lds[];
    const int bid = blockIdx.x, nb = gridDim.x;
    static_assert(sizeof(Params) == 256, "Params = 32 pointers");
    if (tidx() < 64) ((unsigned*)(lds + MK_PT_OFF))[tidx()] = ((const unsigned*)&pk)[tidx()];
    if (tidx() < 4) ((unsigned*)(lds + MK_ST_OFF))[tidx()] = 0u;
    __syncthreads();
    XcdBarrier bar;
    { const Params p = ldp(lds); bar = xcd_barrier_post((unsigned*)(p.ws + WS_CTL + CTL_BAR), (volatile LAS unsigned*)(lds + MK_ST_OFF)); }
    TSTAMP(0);
    TSTAMP(1);
    RUNPH(-2, phaseAB_prep(p, lds, bid, nb));     xcd_barrier(bar); TSTAMP(2);
    RUNPH(2, phase1b(p, lds, bid, nb));           xcd_barrier(bar); TSTAMP(3);
    RUNPH(3, phase2a_s5(p, lds, bid, nb));
    RUNPH(4, phase2_fft(p, lds, bid, nb));        xcd_barrier(bar); TSTAMP(4);
    RUNPH(9, phase2c_s5out(p, lds, bid, nb));     xcd_barrier(bar); TSTAMP(5);
    RUNPH(6, phase3_fin(p, lds, bid, nb));
    RUNPH(5, phase3_glu(p, lds, bid, nb));        xcd_barrier(bar); TSTAMP(6); TSTAMP(7);
    RUNPH(7, phase4_out(p, lds, bid, nb));        xcd_barrier(bar); TSTAMP(8);
    RUNPH(-2, phase5_route(p, lds, bid, nb));     xcd_barrier(bar); TSTAMP(9);
    if (MK_REP == 8) { { const Params p = ldp(lds); phase5_route(p, lds, bid, nb, false); } xcd_barrier(bar); }
    if (MK_REP == 20) { xcd_barrier(bar); xcd_barrier(bar); xcd_barrier(bar); xcd_barrier(bar); }
    RUNPH(-2, build_tiles(p, lds));
    RUNPH(10, phase6_gateup(p, lds, bid, nb));    xcd_barrier(bar); TSTAMP(10);
    RUNPH(11, phase7_down(p, lds, bid, nb));      xcd_barrier(bar); TSTAMP(11);
    if (MK_TS1 >= 0) { if (bid == 0 && tidx() == 0) { const unsigned long long* ts = (const unsigned long long*)(lds + MK_PT_OFF - 256); const Params p = ldp(lds); unsigned* o = (unsigned*)(p.ws + WS_CTL + CTL_TS);
            o[0] = (unsigned)(ts[MK_TS1 + 1] - ts[MK_TS1]); o[1] = MK_TS2 >= 0 ? (unsigned)(ts[MK_TS2 + 1] - ts[MK_TS2]) : 0u; } xcd_barrier(bar); }
    RUNPH(-2, phase8_final(p, lds, bid, nb));
}

extern "C" void kernel_launch(void* const* d_in, const int* in_sizes, int n_in, void* d_out, int out_size, void* d_ws, size_t ws_size, hipStream_t stream) {
    static int grid = 0;
    if (grid == 0) {
        if (n_in != 30 || ws_size < WS_END || out_size != NTOK * D) { fprintf(stderr, "kernel_launch: unexpected inputs (n_in %d, ws %zu, out %d)\n", n_in, ws_size, out_size); grid = -1; return; }
        int dev = 0, cus = 0, per_cu = 0;
        if (hipGetDevice(&dev) != hipSuccess || hipDeviceGetAttribute(&cus, hipDeviceAttributeMultiprocessorCount, dev) != hipSuccess) { grid = -1; return; }
        if (hipFuncSetAttribute((const void*)mega_kernel, hipFuncAttributeMaxDynamicSharedMemorySize, MK_LDS) != hipSuccess) { fprintf(stderr, "kernel_launch: hipFuncSetAttribute failed\n"); grid = -1; return; }
        if (hipOccupancyMaxActiveBlocksPerMultiprocessor(&per_cu, (const void*)mega_kernel, NT, MK_LDS) != hipSuccess || per_cu < 1) { fprintf(stderr, "kernel_launch: occupancy query says %d blocks/CU\n", per_cu); (void)hipGetLastError(); grid = -1; return; }
        grid = cus;
    }
    if (grid < 0) return;
    Params p{};
    const float** f = (const float**)&p;
    for (int i = 0; i < 30; ++i) f[i] = (const float*)d_in[i];
    p.out = (float*)d_out; p.ws = (unsigned char*)d_ws;
    (void)hipMemsetAsync((char*)d_ws + WS_CTL, 0, CTL_BYTES, stream);
    hipLaunchKernelGGL(mega_kernel, dim3(grid), dim3(NT), MK_LDS, stream, p);
}
```

```cpp
#include <hip/hip_runtime.h>
#include <cstdio>
#include <cstdint>

typedef unsigned short bf16;
typedef short bf16x8 __attribute__((ext_vector_type(8)));
typedef short bf16x4 __attribute__((ext_vector_type(4)));
typedef float f32x4 __attribute__((ext_vector_type(4)));
typedef unsigned u32x4 __attribute__((ext_vector_type(4)));
typedef unsigned u32x2 __attribute__((ext_vector_type(2)));
typedef __bf16 bf16v2 __attribute__((ext_vector_type(2)));
#define DI __device__ __forceinline__

constexpr int D = 1024, NB = 8, L = 4096, CTX = 256, NTOK = NB * L, NCTX = NB * CTX, NROWS1 = NTOK + NCTX;
constexpr int NEXP = 32, DE = 256;
constexpr float EPS = 1e-6f;
constexpr int NT = 512;

constexpr size_t MiB = 1u << 20;
constexpr size_t WS_CTL = 0;
constexpr size_t CTL_BYTES = 1 * MiB;
constexpr size_t CTL_ZERO = 4096;
#ifndef MK_TS1
#define MK_TS1 -1
#endif
#ifndef MK_TS2
#define MK_TS2 -1
#endif
constexpr size_t CTL_TS = 12288;
constexpr size_t CTL_FLAGA = 12800;
constexpr size_t CTL_WQ = 12544;
constexpr size_t CTL_ECNT = 65536;
constexpr size_t CTL_PCNT = 65536 + 32 * 64;
constexpr int CNT_STRIDE = 16;
constexpr size_t CTL_RSQ1 = 256 * 1024;
constexpr size_t CTL_RSQ2 = 384 * 1024;
constexpr size_t WS_MOD = 1 * MiB;
constexpr size_t WS_TILES = WS_MOD + 256 * 1024;
constexpr size_t WS_ABART = WS_TILES + 64 * 1024;
constexpr size_t WS_FFTC = 2 * MiB;
constexpr size_t WS_GW = 3 * MiB;
constexpr size_t WS_WINT = 4 * MiB;
constexpr size_t WS_WGLUT = 7 * MiB;
constexpr size_t WS_WOUTT = 8 * MiB;
constexpr size_t WS_WGUT = 10 * MiB;
constexpr size_t WS_WDT = 42 * MiB;
constexpr size_t WS_WST = 58 * MiB;
constexpr size_t WS_MGW = 66 * MiB;
constexpr size_t WS_ELIST = 90 * MiB;
constexpr size_t WS_ELCP = 94 * MiB;
constexpr size_t WS_ELW = 98 * MiB;
constexpr size_t WS_TCP = 102 * MiB;
constexpr size_t WS_R1 = 108 * MiB;
constexpr size_t WS_R2 = 176 * MiB;
constexpr size_t WS_R3 = 240 * MiB;
constexpr size_t WS_UCTX = 288 * MiB;
constexpr size_t WS_R4 = 290 * MiB;
constexpr size_t WS_R5 = 322 * MiB;
constexpr size_t WS_X1B = 290 * MiB;
constexpr size_t WS_A2 = 108 * MiB;
constexpr size_t WS_HS = 228 * MiB;
constexpr size_t WS_MOE = 108 * MiB;
constexpr size_t WS_RSQP1 = 354 * MiB;
constexpr size_t WS_RSQS = 356 * MiB;
constexpr size_t WS_RSS = 357 * MiB;
constexpr size_t WS_ETAB = 357 * MiB + 512 * 1024;
constexpr size_t WS_WRT = 358 * MiB;
constexpr size_t WS_A1 = 360 * MiB;
constexpr int A1P = 1088;
constexpr size_t WS_END = 434 * MiB;

struct Params {
    const float *x, *c, *ctx, *c_ctx, *w_ada, *b_ada, *norm1_g, *norm2_g, *w_in;
    const float *lam_re, *lam_im, *b_re, *b_im, *c_re, *c_im, *log_step, *s5_d, *w_glu, *fourier_w, *g_s, *g_f, *w_out;
    const float *w_group, *b_group, *w_router, *b_router, *w_gate, *w_up, *w_down, *final_g;
    float* out; unsigned char* ws;
};

DI int tidx() { int t = threadIdx.x; asm volatile("" : "+v"(t)); return t; }
DI unsigned pk2(float lo, float hi) { bf16v2 v; v.x = (__bf16)lo; v.y = (__bf16)hi; return __builtin_bit_cast(unsigned, v); }
typedef int i32x4 __attribute__((ext_vector_type(4)));
typedef int i32x8 __attribute__((ext_vector_type(8)));
DI unsigned pk4_fp8(float a, float b, float c, float d) { int w = 0; w = __builtin_amdgcn_cvt_pk_fp8_f32(a, b, w, false); w = __builtin_amdgcn_cvt_pk_fp8_f32(c, d, w, true); return (unsigned)w; }
DI float bf2f(unsigned short b) { return __uint_as_float(((unsigned)b) << 16); }
DI float wave_sum(float v) {
#pragma unroll
    for (int o = 1; o < 64; o <<= 1) v += __shfl_xor(v, o);
    return v;
}
DI float sigmoidf_(float x) { return __builtin_amdgcn_rcpf(1.f + __builtin_amdgcn_exp2f(-1.4426950408889634f * x)); }
DI float siluf_(float x) { return x * __builtin_amdgcn_rcpf(1.f + __builtin_amdgcn_exp2f(-1.4426950408889634f * x)); }
DI float geluf_(float x) { const float a = -2.302208198f - 0.102943239f * (x * x); return x * __builtin_amdgcn_rcpf(1.f + __builtin_amdgcn_exp2f(x * a)); }

template <int MT> struct GC {
    static constexpr int BM = 64 * MT, PA = MT, ABYTES = BM * 128, BBYTES = 128 * 128, BUF = ABYTES + BBYTES, LDS = 2 * BUF;
};
template <int MT>
DI void gemm_loop(f32x4 (&acc)[MT][4], const bf16* (&ap)[MT], const int (&as)[MT], const bf16* (&bp)[2], int nk, unsigned char* lds) {
    typedef GC<MT> G;
    const int tid = tidx(), lane = tid & 63, wid = tid >> 6, wm = wid >> 1, wn = wid & 1, fr = lane & 15, fq = lane >> 4;
    const int srow = tid >> 3, sck = tid & 7;
    const int soff = srow * 128 + ((sck ^ (srow & 7)) << 4);
    u32x4 ra[MT], rb[2];
#pragma unroll
    for (int i = 0; i < MT; ++i) ra[i] = *(const u32x4*)(ap[i]);
#pragma unroll
    for (int i = 0; i < 2; ++i) rb[i] = *(const u32x4*)(bp[i]);
#pragma unroll
    for (int i = 0; i < MT; ++i) *(u32x4*)(lds + i * 8192 + soff) = ra[i];
#pragma unroll
    for (int i = 0; i < 2; ++i) *(u32x4*)(lds + G::ABYTES + i * 8192 + soff) = rb[i];
    __syncthreads();
    const int aro = (wm * MT * 16 + fr) * 128, bro = (wn * 64 + fr) * 128;
    const int sw0 = ((0 + fq) ^ (fr & 7)) << 4, sw1 = ((4 + fq) ^ (fr & 7)) << 4;
    for (int kt = 0; kt < nk; ++kt) {
        const bool more = kt + 1 < nk;
        if (more) {
#pragma unroll
            for (int i = 0; i < MT; ++i) ra[i] = *(const u32x4*)(ap[i] + (size_t)(kt + 1) * as[i]);
#pragma unroll
            for (int i = 0; i < 2; ++i) rb[i] = *(const u32x4*)(bp[i] + (size_t)(kt + 1) * 64);
        }
        const unsigned char* Ab = lds + (kt & 1) * G::BUF; const unsigned char* Bb = Ab + G::ABYTES;
#pragma unroll
        for (int kk = 0; kk < 2; ++kk) {
            const int sw = kk ? sw1 : sw0;
            bf16x8 af[MT], bfr[4];
#pragma unroll
            for (int mt = 0; mt < MT; ++mt) af[mt] = *(const bf16x8*)(Ab + aro + mt * 2048 + sw);
#pragma unroll
            for (int nt = 0; nt < 4; ++nt) bfr[nt] = *(const bf16x8*)(Bb + bro + nt * 2048 + sw);
#pragma unroll
            for (int mt = 0; mt < MT; ++mt)
#pragma unroll
                for (int nt = 0; nt < 4; ++nt) acc[mt][nt] = __builtin_amdgcn_mfma_f32_16x16x32_bf16(bfr[nt], af[mt], acc[mt][nt], 0, 0, 0);
        }
        if (more) {
            unsigned char* nb = lds + ((kt + 1) & 1) * G::BUF;
#pragma unroll
            for (int i = 0; i < MT; ++i) *(u32x4*)(nb + i * 8192 + soff) = ra[i];
#pragma unroll
            for (int i = 0; i < 2; ++i) *(u32x4*)(nb + G::ABYTES + i * 8192 + soff) = rb[i];
        }
        __syncthreads();
    }
}
template <int MT>
DI void gemm_loop_alds(f32x4 (&acc)[MT][4], const unsigned char* abase, int apitch, const bf16* (&bp)[2], int nk, unsigned char* lds) {
    typedef GC<MT> G;
    const int tid = tidx(), lane = tid & 63, wid = tid >> 6, wm = wid >> 1, wn = wid & 1, fr = lane & 15, fq = lane >> 4;
    const int srow = tid >> 3, sck = tid & 7;
    const int soff = srow * 128 + ((sck ^ (srow & 7)) << 4);
    u32x4 rb[2];
#pragma unroll
    for (int i = 0; i < 2; ++i) rb[i] = *(const u32x4*)(bp[i]);
#pragma unroll
    for (int i = 0; i < 2; ++i) *(u32x4*)(lds + G::ABYTES + i * 8192 + soff) = rb[i];
    __syncthreads();
    const int bro = (wn * 64 + fr) * 128;
    const int sw0 = ((0 + fq) ^ (fr & 7)) << 4, sw1 = ((4 + fq) ^ (fr & 7)) << 4;
    const unsigned char* arow = abase + (size_t)(wm * MT * 16 + fr) * apitch + fq * 16;
    for (int kt = 0; kt < nk; ++kt) {
        const bool more = kt + 1 < nk;
        if (more) {
#pragma unroll
            for (int i = 0; i < 2; ++i) rb[i] = *(const u32x4*)(bp[i] + (size_t)(kt + 1) * 64);
        }
        const unsigned char* Bb = lds + (kt & 1) * G::BUF + G::ABYTES;
#pragma unroll
        for (int kk = 0; kk < 2; ++kk) {
            const int sw = kk ? sw1 : sw0;
            bf16x8 af[MT], bfr[4];
#pragma unroll
            for (int mt = 0; mt < MT; ++mt) af[mt] = *(const bf16x8*)(arow + (size_t)mt * 16 * apitch + kt * 128 + kk * 64);
#pragma unroll
            for (int nt = 0; nt < 4; ++nt) bfr[nt] = *(const bf16x8*)(Bb + bro + nt * 2048 + sw);
#pragma unroll
            for (int mt = 0; mt < MT; ++mt)
#pragma unroll
                for (int nt = 0; nt < 4; ++nt) acc[mt][nt] = __builtin_amdgcn_mfma_f32_16x16x32_bf16(bfr[nt], af[mt], acc[mt][nt], 0, 0, 0);
        }
        if (more) {
            unsigned char* nb = lds + ((kt + 1) & 1) * G::BUF;
#pragma unroll
            for (int i = 0; i < 2; ++i) *(u32x4*)(nb + G::ABYTES + i * 8192 + soff) = rb[i];
        }
        __syncthreads();
    }
}
template <int MT> DI void zero_acc(f32x4 (&acc)[MT][4]) {
#pragma unroll
    for (int m = 0; m < MT; ++m)
#pragma unroll
        for (int n = 0; n < 4; ++n) acc[m][n] = (f32x4){0.f, 0.f, 0.f, 0.f};
}

namespace pg8 {
#define PG8_LAS __attribute__((address_space(3)))
constexpr int BM = 256, BK = 64, HALF = 128, HTB = HALF * BK * 2, STAGE_BYTES = 8 * HTB;
DI int lds_byte(int r, int c) { const int st = (r >> 4) * 2 + (c >> 5), rr = r & 15, cc = c & 31, ob = rr * 64 + cc * 2; return st * 1024 + (ob ^ (((ob >> 9) & 1) << 5)); }
DI int perm32(int rho) { const int n = rho >> 4, i = rho & 15; return 8 * (i >> 2) + 4 * n + (i & 3); }
DI void stage_rc(int b, int& R, int& C) { const int st = b / 1024, sb = b % 1024, swz = sb ^ (((sb >> 9) & 1) << 5); R = (st >> 1) * 16 + swz / 64; C = (st & 1) * 32 + (swz % 64) / 2; }
struct UPtr { const char *a0, *a1, *b0, *b1, *c0, *c1; };
template <class Pol, class Epi, bool ALIGN_EPI>
DI void gemm_phase(PG8_LAS unsigned char* lds, const Pol& P, const Epi& E) {
    typedef typename Pol::Unit Unit;
    const int tid = tidx(), wid = __builtin_amdgcn_readfirstlane(tid >> 6), lane = tid & 63, wr = wid >> 2, wc = wid & 3, fr = lane & 15, fq = lane >> 4;
    const int nt = P.K / BK, ksplit = P.ksplit;
    int Rr[2], Cc[2]; unsigned voffB[2];
#pragma unroll
    for (int i = 0; i < 2; ++i) { stage_rc(tid * 16 + i * 8192, Rr[i], Cc[i]); voffB[i] = (unsigned)(P.brow((Rr[i] & ~31) + perm32(Rr[i] & 31)) * P.ldb + Cc[i]) * 2u; }
    unsigned c00 = P.aoff(Rr[0], Cc[0]), c01 = P.aoff(Rr[1], Cc[1]), c10 = c00, c11 = c01, n00 = c00, n01 = c01, n10 = c00, n11 = c01;
#define PG8_STAGE2(bufoff, gbase, o0, o1) do { \
        __builtin_amdgcn_global_load_lds((const unsigned*)((const char*)(gbase) + (o0)), (PG8_LAS unsigned*)(lds + (bufoff) + ldsw), 16, 0, 0); \
        __builtin_amdgcn_global_load_lds((const unsigned*)((const char*)(gbase) + (o1)), (PG8_LAS unsigned*)(lds + (bufoff) + ldsw + 8192), 16, 0, 0); } while (0)
    const size_t kstep = (size_t)(BK * 2);
    const size_t kstepA = Pol::KSTEP_A ? (size_t)Pol::KSTEP_A : kstep;
    const unsigned ldsw = (unsigned)wid * 1024u;
    const int aoff = lds_byte(wr * 64 + fr, fq * 8), boff = lds_byte(wc * 32 + fr, fq * 8);
#define PG8_SA(b, h) (((b) * 2 + (h)) * HTB)
#define PG8_SB(b, h) ((4 + (b) * 2 + (h)) * HTB)
#define PG8_STAGE(bufoff, gbase, voff) do { _Pragma("unroll") for (int _i = 0; _i < 2; ++_i) \
        __builtin_amdgcn_global_load_lds((const unsigned*)((const char*)(gbase) + (voff)[_i]), (PG8_LAS unsigned*)(lds + (bufoff) + ldsw + _i * 8192), 16, 0, 0); } while (0)
#define PG8_LDA(dst, b, h) do { _Pragma("unroll") for (int m = 0; m < 4; ++m) _Pragma("unroll") for (int k = 0; k < 2; ++k) dst[m][k] = *(const PG8_LAS bf16x8*)(lds + PG8_SA(b, h) + aoff + m * 2048 + k * 1024); } while (0)
#define PG8_LDB(dst, b, h) do { _Pragma("unroll") for (int n = 0; n < 2; ++n) _Pragma("unroll") for (int k = 0; k < 2; ++k) dst[n][k] = *(const PG8_LAS bf16x8*)(lds + PG8_SB(b, h) + boff + n * 2048 + k * 1024); } while (0)
#define PG8_MMA(ai, bj, At, Bt) do { __builtin_amdgcn_s_setprio(1); _Pragma("unroll") for (int m = 0; m < 4; ++m) _Pragma("unroll") for (int n = 0; n < 2; ++n) _Pragma("unroll") for (int k = 0; k < 2; ++k) \
        acc[ai][bj][m][n] = __builtin_amdgcn_mfma_f32_16x16x32_bf16(Bt[n][k], At[m][k], acc[ai][bj][m][n], 0, 0, 0); __builtin_amdgcn_s_setprio(0); } while (0)
#define PG8_LDA8(dst, b, h) do { _Pragma("unroll") for (int m = 0; m < 4; ++m) dst[m] = __builtin_shufflevector(*(const PG8_LAS i32x4*)(lds + PG8_SA(b, h) + aoff + m * 2048), *(const PG8_LAS i32x4*)(lds + PG8_SA(b, h) + aoff + m * 2048 + 1024), 0, 1, 2, 3, 4, 5, 6, 7); } while (0)
#define PG8_LDB8(dst, b, h) do { _Pragma("unroll") for (int n = 0; n < 2; ++n) dst[n] = __builtin_shufflevector(*(const PG8_LAS i32x4*)(lds + PG8_SB(b, h) + boff + n * 2048), *(const PG8_LAS i32x4*)(lds + PG8_SB(b, h) + boff + n * 2048 + 1024), 0, 1, 2, 3, 4, 5, 6, 7); } while (0)
#define PG8_MMA8(ai, bj, A8_, B8_) do { __builtin_amdgcn_s_setprio(1); _Pragma("unroll") for (int m = 0; m < 4; ++m) _Pragma("unroll") for (int n = 0; n < 2; ++n) \
        asm volatile("v_mfma_scale_f32_16x16x128_f8f6f4 %0, %1, %2, %0, %3, %3 op_sel_hi:[0,0,0]" : "+v"(acc[ai][bj][m][n]) : "v"(B8_[n]), "v"(A8_[m]), "v"(one8)); __builtin_amdgcn_s_setprio(0); } while (0)
#define PG8_MM(ai, bj, sel) do { if constexpr (Pol::FP8) PG8_MMA8(ai, bj, A8, sel##8); else PG8_MMA(ai, bj, At, sel); } while (0)
#define PG8_RDA(b, h) do { if constexpr (Pol::FP8) PG8_LDA8(A8, b, h); else PG8_LDA(At, b, h); } while (0)
#define PG8_RDB(sel, b, h) do { if constexpr (Pol::FP8) PG8_LDB8(sel##8, b, h); else PG8_LDB(sel, b, h); } while (0)
#define PG8_WAIT_V(n) asm volatile("s_waitcnt vmcnt(" #n ")" ::: "memory")
#define PG8_WAIT_L(n) asm volatile("s_waitcnt lgkmcnt(" #n ")" ::: "memory")
#define PG8_BAR __builtin_amdgcn_s_barrier()
#define PG8_SCHED __builtin_amdgcn_sched_barrier(0)
#define PG8_BSEL(q, tk, h) ((tk) < ksplit ? (q).b##h + (size_t)(tk) * kstep : (q).c##h + (size_t)((tk) - ksplit) * kstep)
    Unit cur, nxt; UPtr cp, np_; int ui = 0;
    if (!P.next(0, cur)) return;
    P.ptrs(cur, cp);
    if constexpr (Pol::GATHER) P.gather(cur, Rr, Cc, c00, c01, c10, c11);
    f32x4 acc[2][2][4][2];
#pragma unroll
    for (int a = 0; a < 2; ++a)
#pragma unroll
        for (int b = 0; b < 2; ++b)
#pragma unroll
            for (int m = 0; m < 4; ++m)
#pragma unroll
                for (int n = 0; n < 2; ++n) acc[a][b][m][n] = (f32x4){0.f, 0.f, 0.f, 0.f};
    const int one8 = 0x7f7f7f7f;
    bf16x8 At[4][2], B0[2][2], B1[2][2]; i32x8 A8[4], B08[2], B18[2];
    PG8_STAGE(PG8_SB(0, 0), cp.b0, voffB); PG8_STAGE(PG8_SB(0, 1), cp.b1, voffB); PG8_STAGE2(PG8_SA(0, 0), cp.a0, c00, c01); PG8_STAGE2(PG8_SA(0, 1), cp.a1, c10, c11);
    if (wr == 1) PG8_BAR;
    PG8_WAIT_V(2); PG8_BAR;
    PG8_STAGE(PG8_SB(1, 0), cp.b0 + kstep, voffB); PG8_STAGE2(PG8_SA(1, 0), cp.a0 + kstepA, c00, c01); PG8_STAGE(PG8_SB(1, 1), cp.b1 + kstep, voffB);
    PG8_WAIT_V(6); PG8_BAR;
    for (;;) {
        const bool has_next = P.next(ui + 1, nxt);
        if (has_next) { P.ptrs(nxt, np_); if constexpr (Pol::GATHER) P.gather(nxt, Rr, Cc, n00, n01, n10, n11); }
        else { np_ = cp; if constexpr (Pol::GATHER) { n00 = c00; n01 = c01; n10 = c10; n11 = c11; } }
#pragma unroll 1
        for (int t = 0; t < nt; t += 2) {
            const bool last = (t == nt - 2);
            int hf = __builtin_amdgcn_readfirstlane(P.half(cur) ? 1 : 0); asm volatile("" : "+s"(hf));
            if constexpr (Epi::MIDK_T >= 0) { if (t == Epi::MIDK_T) E.midk(acc, cur, wr, wc, fr, fq); }
            const char* a1_1 = cp.a1 + (size_t)(t + 1) * kstepA;
            const char *a2_0, *a2_1, *a3_0, *b2_0, *b2_1, *b3_0, *b3_1;
            if (!last) { a2_0 = cp.a0 + (size_t)(t + 2) * kstepA; a2_1 = cp.a1 + (size_t)(t + 2) * kstepA; a3_0 = cp.a0 + (size_t)(t + 3) * kstepA;
                         b2_0 = PG8_BSEL(cp, t + 2, 0); b2_1 = PG8_BSEL(cp, t + 2, 1); b3_0 = PG8_BSEL(cp, t + 3, 0); b3_1 = PG8_BSEL(cp, t + 3, 1); }
            else { a2_0 = np_.a0; a2_1 = np_.a1; a3_0 = np_.a0 + kstepA; b2_0 = np_.b0; b2_1 = np_.b1; b3_0 = np_.b0 + kstep; b3_1 = np_.b1 + kstep; }
            const unsigned s00 = (Pol::GATHER && last) ? n00 : c00, s01 = (Pol::GATHER && last) ? n01 : c01, s10 = (Pol::GATHER && last) ? n10 : c10, s11 = (Pol::GATHER && last) ? n11 : c11;
            PG8_RDB(B0, 0, 0); PG8_RDB(B1, 0, 1); PG8_SCHED; PG8_RDA(0, 0); PG8_STAGE2(PG8_SA(1, 1), a1_1, c10, c11);
            PG8_WAIT_V(8); PG8_WAIT_L(0); PG8_BAR; PG8_MM(0, 0, B0); PG8_MM(0, 1, B1); PG8_BAR; PG8_SCHED;
            if (!hf) PG8_RDA(0, 1); PG8_STAGE(PG8_SB(0, 0), b2_0, voffB); PG8_STAGE(PG8_SB(0, 1), b2_1, voffB); PG8_STAGE2(PG8_SA(0, 0), a2_0, s00, s01);
            PG8_WAIT_V(8); PG8_WAIT_L(0); PG8_BAR; if (!hf) { PG8_MM(1, 0, B0); PG8_MM(1, 1, B1); } PG8_BAR; PG8_SCHED;
            PG8_RDB(B0, 1, 0); PG8_RDB(B1, 1, 1); PG8_SCHED; PG8_RDA(1, 0); PG8_STAGE2(PG8_SA(0, 1), a2_1, s10, s11);
            PG8_WAIT_V(8); PG8_WAIT_L(0); PG8_BAR; PG8_MM(0, 0, B0); PG8_MM(0, 1, B1); PG8_BAR; PG8_SCHED;
            if (!hf) PG8_RDA(1, 1); PG8_STAGE(PG8_SB(1, 0), b3_0, voffB); PG8_STAGE(PG8_SB(1, 1), b3_1, voffB); PG8_STAGE2(PG8_SA(1, 0), a3_0, s00, s01);
            PG8_WAIT_V(8); PG8_WAIT_L(0); PG8_BAR; if (!hf) { PG8_MM(1, 0, B0); PG8_MM(1, 1, B1); } PG8_BAR; PG8_SCHED;
        }
        if constexpr (ALIGN_EPI) { if (wr == 0) PG8_BAR; }
        if constexpr (!Epi::AFTER_DRAIN) E(acc, cur, wr, wc, fr, fq);
        if (!has_next) break;
#pragma unroll
        for (int a = 0; a < 2; ++a)
#pragma unroll
            for (int b = 0; b < 2; ++b)
#pragma unroll
                for (int m = 0; m < 4; ++m)
#pragma unroll
                    for (int n = 0; n < 2; ++n) acc[a][b][m][n] = (f32x4){0.f, 0.f, 0.f, 0.f};
        cur = nxt; cp = np_; ++ui;
        if constexpr (Pol::GATHER) { c00 = n00; c01 = n01; c10 = n10; c11 = n11; }
        if constexpr (ALIGN_EPI) { if (wr == 1) PG8_BAR; }
    }
    PG8_WAIT_V(0);
    if constexpr (!ALIGN_EPI) { if (wr == 0) PG8_BAR; }
    PG8_BAR;
    if constexpr (Epi::AFTER_DRAIN) E(acc, cur, wr, wc, fr, fq);
#undef PG8_SA
#undef PG8_SB
#undef PG8_STAGE
#undef PG8_STAGE2
#undef PG8_LDA
#undef PG8_LDB
#undef PG8_MMA
#undef PG8_MMA8
#undef PG8_MM
#undef PG8_RDA
#undef PG8_RDB
#undef PG8_LDA8
#undef PG8_LDB8
#undef PG8_WAIT_V
#undef PG8_WAIT_L
#undef PG8_BAR
#undef PG8_SCHED
#undef PG8_BSEL
}
struct DenseOrder {
    int nM, nN, nwg, G, c;
    DI void init(int nM_, int nN_, int G_, int c_) { nM = nM_; nN = nN_; nwg = nM * nN; G = G_; c = c_; }
    DI bool get(int i, int& pm, int& pn) const {
        const long L = (long)i * G + c; if (L >= nwg) return false;
        int wgid = (int)L; { const int q = nwg / 8, r = nwg % 8, xcd = wgid % 8, off = wgid / 8; wgid = (xcd < r ? xcd * (q + 1) : r * (q + 1) + (xcd - r) * q) + off; }
        const int nig = 8 * nN, gid = wgid / nig, fm = gid * 8, gsz = (nM - fm) < 8 ? (nM - fm) : 8;
        pm = fm + ((wgid % nig) % gsz); pn = (wgid % nig) / gsz; return true;
    }
};
}

DI void adaln_item(const Params& p, unsigned char* lds, int item) {
    float* scond = (float*)lds;
    float* red = scond + 9 * 1024;
    const int tid = tidx();
    const int cc = tid & 31, ks = tid >> 5, col = item * 32 + cc;
    float w[64];
#pragma unroll
    for (int u = 0; u < 64; ++u) w[u] = p.w_ada[(size_t)(ks * 64 + u) * 6144 + col];
    { float cv[18];
#pragma unroll
      for (int j = 0; j < 18; ++j) { const int r = j >> 1, k = (tid + NT * j) & 1023; cv[j] = r < 8 ? p.c[r * 1024 + k] : p.c_ctx[k]; }
#pragma unroll
      for (int j = 0; j < 18; ++j) scond[tid + NT * j] = siluf_(cv[j]); }
    __syncthreads();
    float a[9];
#pragma unroll
    for (int r = 0; r < 9; ++r) a[r] = 0.f;
#pragma unroll
    for (int u = 0; u < 64; ++u)
#pragma unroll
        for (int r = 0; r < 9; ++r) a[r] += scond[r * 1024 + ks * 64 + u] * w[u];
#pragma unroll
    for (int r = 0; r < 9; ++r) red[(ks * 9 + r) * 32 + cc] = a[r];
    __syncthreads();
    float* mod = (float*)(p.ws + WS_MOD);
    for (int o = tid; o < 9 * 32; o += NT) { const int r = o >> 5, c2 = o & 31; float s = 0.f;
#pragma unroll
        for (int q = 0; q < 16; ++q) s += red[(q * 9 + r) * 32 + c2];
        mod[r * 6144 + item * 32 + c2] = s + p.b_ada[item * 32 + c2]; }
    __syncthreads();
}
DI void tp_tile(const float* src, int ld, int k0, int n0, unsigned char* lds, bf16* dst, int jobkind, int e, const float* kscale = nullptr) {
    const int lane = tidx() & 63, q = lane >> 4, c = lane & 15;
    f32x4 v[16];
#pragma unroll
    for (int i = 0; i < 16; ++i) v[i] = __builtin_nontemporal_load((const f32x4*)(src + (size_t)(k0 + 16 * q + i) * ld + n0 + 4 * c));
    if (kscale) {
#pragma unroll
        for (int i = 0; i < 16; ++i) v[i] = v[i] * kscale[k0 + 16 * q + i]; }
#pragma unroll
    for (int j = 0; j < 4; ++j) { const int ng = n0 + 4 * c + j;
        u32x4 o0, o1;
        o0.x = pk2(v[0][j], v[1][j]); o0.y = pk2(v[2][j], v[3][j]); o0.z = pk2(v[4][j], v[5][j]); o0.w = pk2(v[6][j], v[7][j]);
        o1.x = pk2(v[8][j], v[9][j]); o1.y = pk2(v[10][j], v[11][j]); o1.z = pk2(v[12][j], v[13][j]); o1.w = pk2(v[14][j], v[15][j]);
        size_t drow; int K;
        switch (jobkind) {
          case 0: drow = ng; K = 1024; break;
          case 1: drow = ng; K = 512; break;
          case 2: drow = ng; K = 1024; break;
          case 3: case 4: { const int h = ng, R = (h >> 7) * 256 + (jobkind == 4 ? 128 : 0) + (h & 127); drow = (size_t)e * 512 + R; K = 1024; } break;
          default: drow = (size_t)e * 1024 + ng; K = 256; break;
        }
        if (jobkind == 3 || jobkind == 4) {
            u32x4 o8; o8.x = pk4_fp8(v[0][j] * 32.f, v[1][j] * 32.f, v[2][j] * 32.f, v[3][j] * 32.f); o8.y = pk4_fp8(v[4][j] * 32.f, v[5][j] * 32.f, v[6][j] * 32.f, v[7][j] * 32.f);
            o8.z = pk4_fp8(v[8][j] * 32.f, v[9][j] * 32.f, v[10][j] * 32.f, v[11][j] * 32.f); o8.w = pk4_fp8(v[12][j] * 32.f, v[13][j] * 32.f, v[14][j] * 32.f, v[15][j] * 32.f);
            *(u32x4*)((unsigned char*)dst + drow * 1024 + k0 + 16 * q) = o8;
        } else if (jobkind == 5) {
            u32x4 o8; o8.x = pk4_fp8(v[0][j] * 16.f, v[1][j] * 16.f, v[2][j] * 16.f, v[3][j] * 16.f); o8.y = pk4_fp8(v[4][j] * 16.f, v[5][j] * 16.f, v[6][j] * 16.f, v[7][j] * 16.f);
            o8.z = pk4_fp8(v[8][j] * 16.f, v[9][j] * 16.f, v[10][j] * 16.f, v[11][j] * 16.f); o8.w = pk4_fp8(v[12][j] * 16.f, v[13][j] * 16.f, v[14][j] * 16.f, v[15][j] * 16.f);
            *(u32x4*)((unsigned char*)dst + drow * 256 + k0 + 16 * q) = o8;
        } else {
        bf16* d = dst + drow * K + k0 + 16 * q;
        *(u32x4*)d = o0; *(u32x4*)(d + 8) = o1; } }
}
constexpr int TP_J0 = 16 * 8, TP_J1 = 8 * 8, TP_J2 = 16 * 16, TP_J3 = 32 * 16 * 4, TP_J4 = TP_J3, TP_J5 = 32 * 4 * 16;
constexpr int TP_ITEMS = TP_J0 + TP_J1 + TP_J2 + TP_J3 + TP_J4 + TP_J5;
DI void tp_item(const Params& p, unsigned char* lds, int it) {
    unsigned char* ws = p.ws;
    if (it < TP_J0) { tp_tile(p.w_in, 1024, (it >> 3) * 64, (it & 7) * 64, lds, (bf16*)(ws + WS_WINT), 0, 0); return; } it -= TP_J0;
    if (it < TP_J1) { tp_tile(p.w_glu, 512, (it >> 3) * 64, (it & 7) * 64, lds, (bf16*)(ws + WS_WGLUT), 1, 0); return; } it -= TP_J1;
    if (it < TP_J2) { tp_tile(p.w_out, 1024, (it >> 4) * 64, (it & 15) * 64, lds, (bf16*)(ws + WS_WOUTT), 2, 0, (it >> 4) * 64 < 512 ? p.g_s : nullptr); return; } it -= TP_J2;
    if (it < TP_J3) { const int e = it >> 6, r = it & 63; tp_tile(p.w_gate + (size_t)e * 1024 * 256, 256, (r >> 2) * 64, (r & 3) * 64, lds, (bf16*)(ws + WS_WGUT), 3, e); return; } it -= TP_J3;
    if (it < TP_J4) { const int e = it >> 6, r = it & 63; tp_tile(p.w_up + (size_t)e * 1024 * 256, 256, (r >> 2) * 64, (r & 3) * 64, lds, (bf16*)(ws + WS_WGUT), 4, e); return; } it -= TP_J4;
    { const int e = it >> 6, r = it & 63; tp_tile(p.w_down + (size_t)e * 256 * 1024, 1024, (r >> 4) * 64, (r & 15) * 64, lds, (bf16*)(ws + WS_WDT), 5, e); }
}
DI void gfold_item(const Params& p, unsigned char* lds, int item) {
    const int q = item >> 6, k0 = (item & 63) * 16, tid = tidx(), lane = tid & 63, wid = tid >> 6, fr = lane & 15, fq = lane >> 4;
    const bf16* E = (const bf16*)(p.ws + WS_ETAB); const bf16* fwT = E + 256 * 128 + (size_t)q * 128 * 128;
    bf16* Tl = (bf16*)lds;
    bf16x8 fwf[2][4];
#pragma unroll
    for (int t2 = 0; t2 < 2; ++t2)
#pragma unroll
        for (int ks = 0; ks < 4; ++ks) fwf[t2][ks] = *(const bf16x8*)(fwT + (size_t)(((wid & 3) * 2 + t2) * 16 + fr) * 128 + ks * 32 + 8 * fq);
    bf16x8 af[4];
#pragma unroll
    for (int ks = 0; ks < 4; ++ks) { const float* wp = p.w_in + (size_t)(k0 + fr) * 1024 + 512 + 128 * q + ks * 32 + 8 * fq; const f32x4 w0 = *(const f32x4*)wp, w1 = *(const f32x4*)(wp + 4);
        u32x4 t; t.x = pk2(w0.x, w0.y); t.y = pk2(w0.z, w0.w); t.z = pk2(w1.x, w1.y); t.w = pk2(w1.z, w1.w); af[ks] = __builtin_bit_cast(bf16x8, t); }
#pragma unroll
    for (int t2 = 0; t2 < 2; ++t2) { const int nt = wid * 2 + t2, c = nt >> 3; f32x4 d = (f32x4){0.f, 0.f, 0.f, 0.f};
#pragma unroll
        for (int ks = 0; ks < 4; ++ks) { const bf16x8 bfr = *(const bf16x8*)(E + (size_t)(nt * 16 + fr) * 128 + ks * 32 + 8 * fq); d = __builtin_amdgcn_mfma_f32_16x16x32_bf16(af[ks], bfr, d, 0, 0, 0); }
#pragma unroll
        for (int r = 0; r < 4; ++r) Tl[(c * 16 + 4 * fq + r) * 136 + (nt & 7) * 16 + fr] = (bf16)(pk2(d[r], 0.f) & 0xffffu); }
    __syncthreads();
    bf16* WinT = (bf16*)(p.ws + WS_WINT);
    const float scale = 1.0f / 724.0773439350247f;
    { const int c = wid >> 2;
      bf16x8 a2[4];
#pragma unroll
      for (int ks = 0; ks < 4; ++ks) a2[ks] = *(const bf16x8*)(Tl + (c * 16 + fr) * 136 + ks * 32 + 8 * fq);
#pragma unroll
      for (int t2 = 0; t2 < 2; ++t2) { const int jt = (wid & 3) * 2 + t2; f32x4 d = (f32x4){0.f, 0.f, 0.f, 0.f};
#pragma unroll
          for (int ks = 0; ks < 4; ++ks) d = __builtin_amdgcn_mfma_f32_16x16x32_bf16(fwf[t2][ks], a2[ks], d, 0, 0, 0);
#pragma unroll
          for (int r = 0; r < 4; ++r) WinT[(size_t)(512 + c * 512 + q * 128 + jt * 16 + 4 * fq + r) * 1024 + k0 + fr] = (bf16)(pk2(d[r] * scale, 0.f) & 0xffffu); } }
    __syncthreads();
}
DI void s5mats_item(const Params& p, unsigned char* lds, int item) {
    const int g = item >> 3, part = item & 7;
    const int tid = tidx();
    float gbr[4], gbi[4], gcr[4], gci[4];
#pragma unroll
    for (int j4 = 0; j4 < 4; ++j4) { const int idx = tid + NT * j4, dp = idx >> 4, h = idx & 15, d = dp >> 6, pp = dp & 63;
        gbr[j4] = p.b_re[((size_t)(d * 32 + g) * 64 + pp) * 16 + h]; gbi[j4] = p.b_im[((size_t)(d * 32 + g) * 64 + pp) * 16 + h]; }
#pragma unroll
    for (int j4 = 0; j4 < 4; ++j4) { const int idx = tid + NT * j4, d = idx >> 10, i = (idx >> 6) & 15, pp = idx & 63;
        gcr[j4] = p.c_re[((size_t)(d * 32 + g) * 16 + i) * 64 + pp]; gci[j4] = p.c_im[((size_t)(d * 32 + g) * 16 + i) * 64 + pp]; }
    float* Bb = (float*)lds;
    float* Cc = Bb + 4096;
    float* pw = Cc + 4096;
    constexpr int KTP = 272;
    float* Kt = pw + 8448;
    float* qv = Kt;
    if (tid < 128) { const int d = tid >> 6, pp = tid & 63;
        const double dt = exp((double)p.log_step[d * 32 + g]); const double lr = p.lam_re[(d * 32 + g) * 64 + pp], li = p.lam_im[(d * 32 + g) * 64 + pp];
        const double mag = exp(lr * dt); double tt = li * dt / 3.14159265358979323846; tt -= 2.0 * floor(tt * 0.5);
        double sn, cs; sincospi(tt, &sn, &cs); const double ar = mag * cs, ai = mag * sn;
        const double nr = ar - 1.0, ni = ai, den = lr * lr + li * li;
        qv[tid * 2] = (float)((nr * lr + ni * li) / den); qv[tid * 2 + 1] = (float)((ni * lr - nr * li) / den);
        double pr = 1.0, pi = 0.0;
        for (int k = 0; k < 33; ++k) { pw[(tid * 33 + k) * 2] = (float)pr; pw[(tid * 33 + k) * 2 + 1] = (float)pi; const double t2 = pr * ar - pi * ai; pi = pr * ai + pi * ar; pr = t2; } }
    __syncthreads();
#pragma unroll
    for (int j4 = 0; j4 < 4; ++j4) { const int idx = tid + NT * j4, dp = idx >> 4; const float qr = qv[dp * 2], qi = qv[dp * 2 + 1];
        Bb[idx * 2] = qr * gbr[j4] - qi * gbi[j4]; Bb[idx * 2 + 1] = qr * gbi[j4] + qi * gbr[j4]; }
#pragma unroll
    for (int j4 = 0; j4 < 4; ++j4) { const int idx = tid + NT * j4; Cc[idx * 2] = gcr[j4]; Cc[idx * 2 + 1] = gci[j4]; }
    __syncthreads();
    { const int t3 = tid >> 2, pq = tid & 3, d = t3 >> 6, k = (t3 >> 1) & 31, i = part * 2 + (t3 & 1);
      float acc[16];
#pragma unroll
      for (int h = 0; h < 16; ++h) acc[h] = 0.f;
      for (int pp = pq; pp < 64; pp += 4) {
          const float cr = Cc[((d * 16 + i) * 64 + pp) * 2], ci = Cc[((d * 16 + i) * 64 + pp) * 2 + 1];
          const float wr = pw[((d * 64 + pp) * 33 + k) * 2], wi = pw[((d * 64 + pp) * 33 + k) * 2 + 1];
          const float xr = cr * wr - ci * wi, xi = cr * wi + ci * wr;
          const f32x4* bb = (const f32x4*)(Bb + (d * 64 + pp) * 32);
#pragma unroll
          for (int h2 = 0; h2 < 8; ++h2) { const f32x4 b2 = bb[h2]; acc[2 * h2] += xr * b2.x - xi * b2.y; acc[2 * h2 + 1] += xr * b2.z - xi * b2.w; } }
#pragma unroll
      for (int h = 0; h < 16; ++h) { acc[h] += __shfl_xor(acc[h], 1); acc[h] += __shfl_xor(acc[h], 2); }
      if (pq == 0) {
#pragma unroll
          for (int h4 = 0; h4 < 4; ++h4) *(f32x4*)(Kt + (d * 32 + k) * KTP + i * 16 + h4 * 4) = (f32x4){acc[h4 * 4], acc[h4 * 4 + 1], acc[h4 * 4 + 2], acc[h4 * 4 + 3]}; } }
    __syncthreads();
    bf16* Mg = (bf16*)(p.ws + WS_MGW) + (size_t)g * 512 * 768;
    for (int c4 = tid; c4 < 64 * 64; c4 += NT) { const int rq = c4 >> 6, c8 = c4 & 63, j = rq >> 1, i = part * 2 + (rq & 1), row = j * 16 + i, s = c8 >> 1, h0 = (c8 & 1) * 8; float v[8];
#pragma unroll
        for (int t = 0; t < 8; ++t) { float a = 0.f; if (s <= j) a += Kt[(0 * 32 + (j - s)) * KTP + i * 16 + h0 + t]; if (s >= j) a += Kt[(1 * 32 + (s - j)) * KTP + i * 16 + h0 + t]; v[t] = a; }
        u32x4 o; o.x = pk2(v[0], v[1]); o.y = pk2(v[2], v[3]); o.z = pk2(v[4], v[5]); o.w = pk2(v[6], v[7]);
        *(u32x4*)(Mg + (size_t)row * 768 + c8 * 8) = o; }
    bf16* Wst = (bf16*)(p.ws + WS_WST) + (size_t)g * 256 * 512;
    for (int c4 = tid; c4 < 32 * 64; c4 += NT) { const int r = part * 32 + (c4 >> 6), c8 = c4 & 63, s = c8 >> 1, h0 = (c8 & 1) * 8, d = r >> 7, c = r & 1, pp = (r >> 1) & 63;
        const int e = d == 0 ? 31 - s : s; const float wr = pw[((d * 64 + pp) * 33 + e) * 2], wi = pw[((d * 64 + pp) * 33 + e) * 2 + 1]; float v[8];
#pragma unroll
        for (int t = 0; t < 8; ++t) { const float br = Bb[((d * 64 + pp) * 16 + h0 + t) * 2], bi = Bb[((d * 64 + pp) * 16 + h0 + t) * 2 + 1]; v[t] = c == 0 ? wr * br - wi * bi : wr * bi + wi * br; }
        u32x4 o; o.x = pk2(v[0], v[1]); o.y = pk2(v[2], v[3]); o.z = pk2(v[4], v[5]); o.w = pk2(v[6], v[7]);
        *(u32x4*)(Wst + (size_t)r * 512 + c8 * 8) = o; }
    bf16* Wos = (bf16*)(p.ws + WS_MGW) + (size_t)g * 512 * 768 + 512;
    for (int c4 = tid; c4 < 64 * 32; c4 += NT) { const int rq = c4 >> 5, c8 = c4 & 31, j = rq >> 1, i = part * 2 + (rq & 1), row = j * 16 + i, col0 = c8 * 8, d = col0 >> 7, p0 = (col0 >> 1) & 63;
        const int e = d == 0 ? j + 1 : 32 - j; float v[8];
#pragma unroll
        for (int t = 0; t < 8; ++t) { const int pp = p0 + (t >> 1), c = t & 1; const float cr = Cc[((d * 16 + i) * 64 + pp) * 2], ci = Cc[((d * 16 + i) * 64 + pp) * 2 + 1];
            const float wr = pw[((d * 64 + pp) * 33 + e) * 2], wi = pw[((d * 64 + pp) * 33 + e) * 2 + 1]; v[t] = c == 0 ? cr * wr - ci * wi : -(cr * wi + ci * wr); }
        u32x4 o; o.x = pk2(v[0], v[1]); o.y = pk2(v[2], v[3]); o.z = pk2(v[4], v[5]); o.w = pk2(v[6], v[7]);
        *(u32x4*)(Wos + (size_t)row * 768 + c8 * 8) = o; }
    float* aT = (float*)(p.ws + WS_ABART) + g * 256;
    if (part == 0 && tid < 128) { const int d = tid >> 6, pp = tid & 63; aT[tid * 2] = pw[((d * 64 + pp) * 33 + 32) * 2]; aT[tid * 2 + 1] = pw[((d * 64 + pp) * 33 + 32) * 2 + 1]; }
    __syncthreads();
}
DI void fftc_item(const Params& p, int item, int nitems) {
    const int tid = tidx();
    bf16* W1 = (bf16*)(p.ws + WS_FFTC);
    bf16* W2 = W1 + 128 * 128;
    float* tw = (float*)(p.ws + WS_FFTC + 32768 + 16384);
    for (int idx = item * NT + tid; idx < 128 * 128 + 4 * 64 * 32 + 4096; idx += nitems * NT) {
        if (idx < 16384) { const int n = idx >> 7, k = idx & 127, co = n >> 6, d = n & 63, ci = k >> 6, bq = k & 63; double s, c; sincospi((double)((d * bq) & 63) / 32.0, &s, &c);
            const float v = (ci == co) ? (float)c : (ci == 1 ? (float)s : (float)(-s)); W1[idx] = (bf16)(pk2(v, 0.f) & 0xffffu); }
        else if (idx < 16384 + 8192) { const int i2 = idx - 16384, s_ = i2 >> 11, cf = (i2 >> 5) & 63, slot = i2 & 31, gq = slot >> 3, jp = slot & 7;
            const int a = 16 * (2 * (s_ & 1) + (jp >> 2)) + 4 * gq + (jp & 3); double s, c; sincospi((double)((cf * a) & 63) / 32.0, &s, &c);
            W2[i2] = (bf16)(pk2((s_ >> 1) == 0 ? (float)c : (float)s, 0.f) & 0xffffu); }
        else { const int i3 = idx - 16384 - 8192, ln = i3 & 63, r = (i3 >> 6) & 3, mt = (i3 >> 8) & 3, nt = i3 >> 10; const int d = 16 * nt + (ln & 15), a = 16 * mt + 4 * (ln >> 4) + r;
            double s, c; sincospi((double)((d * a) & 4095) / 2048.0, &s, &c); tw[i3 * 2] = (float)c; tw[i3 * 2 + 1] = (float)s; }
    }
}
constexpr int P0_S5 = 256, P0_GF = 256;
constexpr int P0_ITEMS = P0_S5 + P0_GF;
DI void rw_item(const Params& p, int item, int nitems) {
    bf16* W = (bf16*)(p.ws + WS_WRT);
    for (int i = item * NT + tidx(); i < 48 * 1024; i += nitems * NT) { const int n = i >> 10, k = i & 1023; const float v = n < 4 ? p.w_group[k * 4 + n] : (n < 36 ? p.w_router[k * 32 + (n - 4)] : 0.f); W[i] = (bf16)(pk2(v, 0.f) & 0xffffu); }
}
DI void phaseA_adaln(const Params& p, unsigned char* lds, int bid, int nb) {
    for (int it = bid; it < 192 + 64; it += nb) {
        if (it < 192) { adaln_item(p, lds, it); continue; }
        const int t = it - 192, tid = tidx();
        bf16* E = (bf16*)(p.ws + WS_ETAB); bf16* fwT = E + 256 * 128;
        for (int i = t * NT + tid; i < 256 * 128; i += 64 * NT) { const int cn = i >> 7, m = i & 127, c = cn >> 7, n = cn & 127; double sv, cv; sincospi((double)((n * m) & 127) / 64.0, &sv, &cv);
            E[i] = (bf16)(pk2(c == 0 ? (float)cv : (float)(-sv), 0.f) & 0xffffu); }
        for (int i = t * NT + tid; i < 4 * 128 * 128; i += 64 * NT) { const int q = i >> 14, j = (i >> 7) & 127, n = i & 127; fwT[i] = (bf16)(pk2(p.fourier_w[((size_t)q * 128 + n) * 128 + j], 0.f) & 0xffffu); }
        fftc_item(p, t, 64); rw_item(p, t, 64);
    }
}
DI int a1pos(int r) { if (r >= NTOK) return r; const int a = r & 63, bq = (r >> 6) & 63; return (r & ~4095) + (((a >> 2) * 16 + (bq >> 2)) * 16 + (a & 3) * 4 + (bq & 3)); }
DI void a1_item(const Params& p, int r0) {
    const int lane = tidx() & 63;
    const float* mod = (const float*)(p.ws + WS_MOD);
    bf16* A1 = (bf16*)(p.ws + WS_A1);
    constexpr int RW = 4;
    const float* src = r0 < NTOK ? p.x + (size_t)r0 * D : p.ctx + (size_t)(r0 - NTOK) * D;
    const int mr = r0 < NTOK ? (r0 >> 12) : 8;
    f32x4 v[RW][4]; float s[RW];
#pragma unroll
    for (int q = 0; q < RW; ++q)
#pragma unroll
        for (int j = 0; j < 4; ++j) v[q][j] = __builtin_nontemporal_load((const f32x4*)(src + (size_t)q * D) + lane + 64 * j);
    f32x4 gm[4], sh[4];
#pragma unroll
    for (int j = 0; j < 4; ++j) { const int k = lane * 4 + 256 * j; gm[j] = *(const f32x4*)(p.norm1_g + k) * (*(const f32x4*)(mod + mr * 6144 + 1024 + k) + 1.f); sh[j] = *(const f32x4*)(mod + mr * 6144 + k); }
#pragma unroll
    for (int q = 0; q < RW; ++q) { float t = 0.f;
#pragma unroll
        for (int j = 0; j < 4; ++j) t += (v[q][j].x * v[q][j].x + v[q][j].y * v[q][j].y) + (v[q][j].z * v[q][j].z + v[q][j].w * v[q][j].w);
        s[q] = t; }
#pragma unroll
    for (int o = 1; o < 64; o <<= 1) {
#pragma unroll
        for (int q = 0; q < RW; ++q) s[q] += __shfl_xor(s[q], o); }
#pragma unroll
    for (int q = 0; q < RW; ++q) { const float rs = rsqrtf(s[q] * (1.f / D) + EPS); u32x2* o = (u32x2*)(A1 + (size_t)a1pos(r0 + q) * A1P) + lane;
#pragma unroll
        for (int j = 0; j < 4; ++j) { const f32x4 h = v[q][j] * rs * gm[j] + sh[j]; u32x2 w; w.x = pk2(h.x, h.y); w.y = pk2(h.z, h.w); o[64 * j] = w; } }
}
constexpr int TP_NODOWN = TP_ITEMS - TP_J5;
constexpr int WI_A1 = NROWS1 / 4, WI_ALL = WI_A1 + TP_NODOWN;
DI void phaseAB_prep(const Params& p, unsigned char* lds, int bid, int nb) {
    phaseA_adaln(p, lds, bid, nb);
    unsigned* flag = (unsigned*)(p.ws + WS_CTL + CTL_FLAGA);
    asm volatile("s_waitcnt vmcnt(0)" ::: "memory");
    __syncthreads();
    if (tidx() == 0) { __builtin_amdgcn_fence(__ATOMIC_RELEASE, "agent"); asm volatile("s_waitcnt vmcnt(0)" ::: "memory"); (void)__hip_atomic_fetch_add(flag, 1u, __ATOMIC_RELAXED, __HIP_MEMORY_SCOPE_AGENT); }
    for (int it = bid; it < P0_S5; it += nb) s5mats_item(p, lds, it);
    if (tidx() == 0) { unsigned sp = 0; while (__hip_atomic_load(flag, __ATOMIC_RELAXED, __HIP_MEMORY_SCOPE_AGENT) < (unsigned)nb) { __builtin_amdgcn_s_sleep(2); if (++sp > (1u << 22)) break; }
        __builtin_amdgcn_fence(__ATOMIC_ACQUIRE, "agent"); asm volatile("s_waitcnt vmcnt(0)" ::: "memory"); }
    __syncthreads();
    for (int it = bid; it < P0_GF; it += nb) gfold_item(p, lds, it);
    __syncthreads();
    { const int wid = tidx() >> 6; constexpr int NGRP = (WI_ALL + 7) / 8; unsigned* wq = (unsigned*)(p.ws + WS_CTL + CTL_WQ); volatile int* nx = (volatile int*)(lds + 65536);
      int cur = bid;
      while (cur < NGRP) {
          if (tidx() == 0) nx[0] = (int)__hip_atomic_fetch_add(wq, 1u, __ATOMIC_RELAXED, __HIP_MEMORY_SCOPE_AGENT) + nb;
          const int it = cur * 8 + wid;
          if (it < WI_ALL) { if (it < WI_A1) a1_item(p, it * 4); else tp_item(p, lds, it - WI_A1); }
          __syncthreads();
          cur = nx[0];
          __syncthreads();
      } }
}

struct G1uPol {
    static constexpr bool FP8 = false;
    template <class U> DI bool half(const U&) const { return false; }
    static constexpr long KSTEP_A = 0;
    DI unsigned aoff(int R, int C) const { return (unsigned)((((R & 63) >> 2) * 256 + (R & 3) * 4 + (R >> 6)) * lda + C) * 2u; }
    struct Unit { int pm, pn; };
    static constexpr bool GATHER = false;
    pg8::DenseOrder ord; const char* A; const char* B; int K, ksplit, lda, ldb;
    DI bool next(int i, Unit& u) const { return ord.get(i, u.pm, u.pn); }
    DI void ptrs(const Unit& u, pg8::UPtr& q) const { q.a0 = A + (size_t)((u.pm >> 4) * 4096 + (u.pm & 15) * 16) * lda * 2; q.a1 = q.a0 + (size_t)2 * lda * 2; q.b0 = B + (size_t)u.pn * 256 * ldb * 2; q.b1 = q.b0 + (size_t)128 * ldb * 2; q.c0 = q.b0; q.c1 = q.b1; }
    DI int brow(int R) const { return R; }
    DI void gather(const Unit&, int (&)[2], int (&)[2], unsigned&, unsigned&, unsigned&, unsigned&) const {}
};
struct G1uEpi {
    static constexpr bool AFTER_DRAIN = false;
    static constexpr int MIDK_T = -1;
    bf16* Ul;
    DI void operator()(const f32x4 (&acc)[2][2][4][2], const G1uPol::Unit& u, int wr, int wc, int fr, int fq) const {
#pragma unroll
        for (int ai = 0; ai < 2; ++ai)
#pragma unroll
            for (int m = 0; m < 4; ++m) { const int row = u.pm * 256 + ai * 128 + wr * 64 + m * 16 + fr, b = row >> 12, l = row & 4095;
#pragma unroll
                for (int bj = 0; bj < 2; ++bj) { const int c0 = u.pn * 256 + bj * 128 + wc * 32 + 8 * fq, g = c0 >> 4, h0 = c0 & 15;
                    const f32x4 a0 = acc[ai][bj][m][0], a1 = acc[ai][bj][m][1];
                    u32x4 w; w.x = pk2(a0[0], a0[1]); w.y = pk2(a0[2], a0[3]); w.z = pk2(a1[0], a1[1]); w.w = pk2(a1[2], a1[3]);
                    *(u32x4*)(Ul + (((size_t)g * 1024 + b * 128 + (l >> 5)) * 768 + (l & 31) * 16 + h0)) = w; } }
    }
};
struct G1gPol {
    static constexpr bool FP8 = false;
    template <class U> DI bool half(const U&) const { return false; }
    static constexpr long KSTEP_A = 0;
    DI unsigned aoff(int R, int C) const { return (unsigned)(R * lda + C) * 2u; }
    struct Unit { int pm, pn; };
    static constexpr bool GATHER = false;
    pg8::DenseOrder ord; const char* A; const char* B; int K, ksplit, lda, ldb;
    DI bool next(int i, Unit& u) const { return ord.get(i, u.pm, u.pn); }
    DI void ptrs(const Unit& u, pg8::UPtr& q) const { q.a0 = A + (size_t)u.pm * 256 * lda * 2; q.a1 = q.a0 + (size_t)128 * lda * 2;
        q.b0 = B + (size_t)u.pn * 256 * ldb * 2; q.b1 = q.b0 + (size_t)8 * ldb * 2; q.c0 = q.b0; q.c1 = q.b1; }
    DI int brow(int R) const { return ((R & 63) >> 2) * 16 + (R >> 6) * 4 + (R & 3); }
    DI void gather(const Unit&, int (&)[2], int (&)[2], unsigned&, unsigned&, unsigned&, unsigned&) const {}
};
struct G1gEpi {
    static constexpr bool AFTER_DRAIN = false;
    static constexpr int MIDK_T = -1;
    bf16* GT;
    DI void operator()(const f32x4 (&acc)[2][2][4][2], const G1gPol::Unit& u, int wr, int wc, int fr, int fq) const {
        const int b = u.pn >> 4, a0 = (u.pn & 15) * 4;
#pragma unroll
        for (int ai = 0; ai < 2; ++ai)
#pragma unroll
            for (int m = 0; m < 4; ++m) { const int mm = u.pm * 256 + ai * 128 + wr * 64 + m * 16 + fr, c = mm >> 9, ch = mm & 511;
                bf16* base = GT + (size_t)((b * 512 + ch) * 2 + c) * 4096;
#pragma unroll
                for (int bj = 0; bj < 2; ++bj) { const int a = a0 + 2 * bj + (wc >> 1), bq = 32 * (wc & 1) + 8 * fq;
                    const f32x4 v0 = acc[ai][bj][m][0], v1 = acc[ai][bj][m][1];
                    u32x4 w; w.x = pk2(v0[0], v0[1]); w.y = pk2(v0[2], v0[3]); w.z = pk2(v1[0], v1[1]); w.w = pk2(v1[2], v1[3]);
                    __builtin_nontemporal_store(w, (u32x4*)(base + a * 64 + bq)); } }
    }
};
DI void phase1b(const Params& p, unsigned char* lds, int bid, int nb) {
    { G1gPol P; P.ord.init(4, NTOK / 256, nb, bid); P.A = (const char*)(p.ws + WS_WINT) + (size_t)512 * 2048; P.B = (const char*)(p.ws + WS_A1); P.K = 1024; P.ksplit = 16; P.lda = 1024; P.ldb = A1P;
      G1gEpi E{(bf16*)(p.ws + WS_R2)};
      pg8::gemm_phase<G1gPol, G1gEpi, true>((PG8_LAS unsigned char*)lds, P, E); }
    { G1uPol P; P.ord.init(NTOK / 256, 2, nb, bid); P.A = (const char*)(p.ws + WS_A1); P.B = (const char*)(p.ws + WS_WINT); P.K = 1024; P.ksplit = 16; P.lda = A1P; P.ldb = 1024;
      G1uEpi E{(bf16*)(p.ws + WS_R3)};
      pg8::gemm_phase<G1uPol, G1uEpi, true>((PG8_LAS unsigned char*)lds, P, E); }
    { const int tid = tidx(), lane = tid & 63, wid = tid >> 6, fr = lane & 15, fq = lane >> 4, tsub = wid & 3, gh = wid >> 2;
      constexpr int CW_P = 2064;
      for (int item = bid; item < 256; item += nb) { const int b = item & 7, gq = (item >> 3) & 7, tq = item >> 6;
          __syncthreads();
          { const bf16* Wq = (const bf16*)(p.ws + WS_WINT) + (size_t)(gq * 64) * D; u32x4 wv[16];
#pragma unroll
            for (int j = 0; j < 16; ++j) { const int i = tid + NT * j, r = i >> 7, c = i & 127; wv[j] = *(const u32x4*)(Wq + (size_t)r * D + c * 8); }
#pragma unroll
            for (int j = 0; j < 16; ++j) { const int i = tid + NT * j, r = i >> 7, c = i & 127; *(u32x4*)(lds + r * CW_P + c * 16) = wv[j]; } }
          const int t0 = tq * 64 + tsub * 16;
          const bf16* Ar = (const bf16*)(p.ws + WS_A1) + (size_t)(NTOK + b * 256 + t0 + fr) * A1P + fq * 8;
          bf16x8 af[32];
#pragma unroll
          for (int ks = 0; ks < 32; ++ks) af[ks] = *(const bf16x8*)(Ar + ks * 32);
          __syncthreads();
          f32x4 ca[2] = {(f32x4){0.f, 0.f, 0.f, 0.f}, (f32x4){0.f, 0.f, 0.f, 0.f}};
          const unsigned char* wl = lds + (gh * 32 + fr) * CW_P + fq * 16;
#pragma unroll
          for (int ks = 0; ks < 32; ++ks) { const bf16x8 w0 = *(const bf16x8*)(wl + ks * 64), w1 = *(const bf16x8*)(wl + 16 * CW_P + ks * 64);
              ca[0] = __builtin_amdgcn_mfma_f32_16x16x32_bf16(w0, af[ks], ca[0], 0, 0, 0); ca[1] = __builtin_amdgcn_mfma_f32_16x16x32_bf16(w1, af[ks], ca[1], 0, 0, 0); }
          const int t = t0 + fr, chunk = t >> 5, tin = t & 31;
#pragma unroll
          for (int j = 0; j < 2; ++j) { const int g = gq * 4 + gh * 2 + j; bf16* Ucw = (bf16*)(p.ws + WS_R4) + ((size_t)g * 256 + b * 8 + chunk) * 768;
              u32x2 w; w.x = pk2(ca[j][0], ca[j][1]); w.y = pk2(ca[j][2], ca[j][3]); *(u32x2*)(Ucw + tin * 16 + 4 * fq) = w; } } }
}
constexpr int S5_SP = 528, S5_SC_OFF = 256 * S5_SP, S5A_LDS = S5_SC_OFF + 16 * S5_SP;
struct S5aPol {
    static constexpr bool FP8 = false;
    template <class U> DI bool half(const U&) const { return false; }
    struct Unit { int g, mt; };
    static constexpr bool GATHER = false;
    static constexpr long KSTEP_A = 0;
    int c; const char* A; const char* B; int K, ksplit, lda, ldb;
    DI unsigned aoff(int R, int C) const { return (unsigned)(R * lda + C) * 2u; }
    DI bool next(int i, Unit& u) const { if (i > 0 || c >= 128) return false; u.g = c >> 2; u.mt = c & 3; return true; }
    DI void ptrs(const Unit& u, pg8::UPtr& q) const { q.a0 = A + ((size_t)u.g * 1024 + u.mt * 256) * lda * 2; q.a1 = q.a0 + (size_t)128 * lda * 2;
        q.b0 = B + (size_t)u.g * 256 * ldb * 2; q.b1 = q.b0 + (size_t)128 * ldb * 2; q.c0 = q.b0; q.c1 = q.b1; }
    DI int brow(int R) const { return R; }
    DI void gather(const Unit&, int (&)[2], int (&)[2], unsigned&, unsigned&, unsigned&, unsigned&) const {}
};
struct S5aEpi {
    static constexpr int MIDK_T = -1;
    static constexpr bool AFTER_DRAIN = true;
    unsigned char* Sl;
    DI void operator()(const f32x4 (&acc)[2][2][4][2], const S5aPol::Unit& u, int wr, int wc, int fr, int fq) const {
#pragma unroll
        for (int ai = 0; ai < 2; ++ai)
#pragma unroll
            for (int m = 0; m < 4; ++m) { unsigned char* dst = Sl + (size_t)(ai * 128 + wr * 64 + m * 16 + fr) * S5_SP + (wc * 32 + 8 * fq) * 2;
#pragma unroll
                for (int bj = 0; bj < 2; ++bj) { const f32x4 v0 = acc[ai][bj][m][0], v1 = acc[ai][bj][m][1];
                    u32x4 w; w.x = pk2(v0[0], v0[1]); w.y = pk2(v0[2], v0[3]); w.z = pk2(v1[0], v1[1]); w.w = pk2(v1[2], v1[3]);
                    *(u32x4*)(dst + bj * 256) = w; } }
    }
};
DI void phase2a_s5(const Params& p, unsigned char* lds, int bid, int nb) {
    const int vc = (nb % 8 == 0) ? (bid % 8) * (nb / 8) + bid / 8 : bid;
    if (vc >= 128) return;
    const int tid = tidx(), lane = tid & 63, wid = tid >> 6, fr = lane & 15, fq = lane >> 4, g = vc >> 2, mt = vc & 3;
    { S5aPol P; P.c = vc; P.A = (const char*)(p.ws + WS_R3); P.B = (const char*)(p.ws + WS_WST); P.K = 512; P.ksplit = 8; P.lda = 768; P.ldb = 512;
      S5aEpi E{lds};
      pg8::gemm_phase<S5aPol, S5aEpi, true>((PG8_LAS unsigned char*)lds, P, E); }
    {
      constexpr int UC_OFF = S5A_LDS, UC_P = 1040;
      { const bf16* Uc = (const bf16*)(p.ws + WS_R4); u32x4 uv[2];
#pragma unroll
        for (int j = 0; j < 2; ++j) { const int i = tid + NT * j, r = i >> 6, c = i & 63; uv[j] = *(const u32x4*)(Uc + ((size_t)g * 256 + (2 * mt + (r >> 3)) * 8 + (r & 7)) * 768 + c * 8); }
#pragma unroll
        for (int j = 0; j < 2; ++j) { const int i = tid + NT * j, r = i >> 6, c = i & 63; *(u32x4*)(lds + UC_OFF + r * UC_P + c * 16) = uv[j]; } }
      const bf16* Wst = (const bf16*)(p.ws + WS_WST) + ((size_t)g * 256 + wid * 32 + fr) * 512 + fq * 8;
      bf16x8 w0[16], w1[16];
#pragma unroll
      for (int ks = 0; ks < 16; ++ks) { w0[ks] = *(const bf16x8*)(Wst + ks * 32); w1[ks] = *(const bf16x8*)(Wst + (size_t)16 * 512 + ks * 32); }
      __syncthreads();
      f32x4 cs[2] = {(f32x4){0.f, 0.f, 0.f, 0.f}, (f32x4){0.f, 0.f, 0.f, 0.f}};
      const unsigned char* al = lds + UC_OFF + fr * UC_P + fq * 16;
#pragma unroll
      for (int ks = 0; ks < 16; ++ks) { const bf16x8 a0 = *(const bf16x8*)(al + ks * 64);
          cs[0] = __builtin_amdgcn_mfma_f32_16x16x32_bf16(w0[ks], a0, cs[0], 0, 0, 0); cs[1] = __builtin_amdgcn_mfma_f32_16x16x32_bf16(w1[ks], a0, cs[1], 0, 0, 0); }
#pragma unroll
      for (int j = 0; j < 2; ++j) { u32x2 w; w.x = pk2(cs[j][0], cs[j][1]); w.y = pk2(cs[j][2], cs[j][3]); *(u32x2*)(lds + S5_SC_OFF + (size_t)fr * S5_SP + (wid * 32 + 16 * j + 4 * fq) * 2) = w; } }
    __syncthreads();
    if (wid < 4) {
        const int bsel = wid >> 1, d = wid & 1, b = 2 * mt + bsel;
        const float* aT = (const float*)(p.ws + WS_ABART) + g * 256 + (d * 64 + lane) * 2; const float ar = aT[0], ai = aT[1];
        const unsigned char* Sg = lds + (size_t)(bsel * 128) * S5_SP + (d * 128 + 2 * lane) * 2;
        const unsigned char* Sc = lds + S5_SC_OFF + (size_t)(bsel * 8) * S5_SP + (d * 128 + 2 * lane) * 2;
        unsigned* Hout = (unsigned*)((bf16*)(p.ws + WS_R3) + ((size_t)g * 1024 + b * 128) * 768 + 512 + d * 128) + lane;
        float hr = 0.f, hi = 0.f;
        { unsigned sv[8];
#pragma unroll
          for (int j = 0; j < 8; ++j) { const int c = d == 0 ? j : 7 - j; sv[j] = *(const unsigned*)(Sc + (size_t)c * S5_SP); }
#pragma unroll
          for (int j = 0; j < 8; ++j) { const float sr = __uint_as_float(sv[j] << 16), si = __uint_as_float(sv[j] & 0xffff0000u); const float nr = ar * hr - ai * hi + sr, ni = ar * hi + ai * hr + si; hr = nr; hi = ni; } }
#pragma unroll 1
        for (int cb = 0; cb < 128; cb += 32) { unsigned sv[32];
#pragma unroll
            for (int j = 0; j < 32; ++j) { const int c = d == 0 ? cb + j : 127 - cb - j; sv[j] = *(const unsigned*)(Sg + (size_t)c * S5_SP); }
#pragma unroll
            for (int j = 0; j < 32; ++j) { const int c = d == 0 ? cb + j : 127 - cb - j; Hout[(size_t)c * 384] = pk2(hr, hi);
                const float sr = __uint_as_float(sv[j] << 16), si = __uint_as_float(sv[j] & 0xffff0000u); const float nr = ar * hr - ai * hi + sr, ni = ar * hi + ai * hr + si; hr = nr; hi = ni; } }
    }
    __syncthreads();
}
struct S5cPol {
    static constexpr bool FP8 = false;
    template <class U> DI bool half(const U&) const { return false; }
    static constexpr long KSTEP_A = 0;
    DI unsigned aoff(int R, int C) const { return (unsigned)(R * lda + C) * 2u; }
    struct Unit { int g, mt, pn; };
    static constexpr bool GATHER = false;
    int G, c; const char* A; const char* B; int K, ksplit, lda, ldb;
    DI bool next(int i, Unit& u) const { const int L = i * G + c; if (L >= 256) return false; u.g = L >> 3; u.mt = (L >> 1) & 3; u.pn = L & 1; return true; }
    DI void ptrs(const Unit& u, pg8::UPtr& q) const { q.a0 = A + ((size_t)u.g * 1024 + u.mt * 256) * lda * 2; q.a1 = q.a0 + (size_t)128 * lda * 2; q.b0 = B + ((size_t)u.g * 512 + u.pn * 256) * ldb * 2; q.b1 = q.b0 + (size_t)128 * ldb * 2; q.c0 = q.b0; q.c1 = q.b1; }
    DI int brow(int R) const { return R; }
    DI void gather(const Unit&, int (&)[2], int (&)[2], unsigned&, unsigned&, unsigned&, unsigned&) const {}
};
struct S5cEpi {
    static constexpr bool AFTER_DRAIN = false;
    static constexpr int MIDK_T = -1;
    const bf16* Ucat; const float* s5d; bf16* yact;
    DI void operator()(const f32x4 (&acc)[2][2][4][2], const S5cPol::Unit& u, int wr, int wc, int fr, int fq) const {
        const int n0 = u.pn * 256 + wc * 32 + 8 * fq, i0 = n0 & 15;
        const f32x4 d0 = *(const f32x4*)(s5d + u.g * 16 + i0), d1 = *(const f32x4*)(s5d + u.g * 16 + i0 + 4);
#pragma unroll
        for (int ai = 0; ai < 2; ++ai) {
            u32x4 uu[4][2];
#pragma unroll
            for (int m = 0; m < 4; ++m) { const int row = u.mt * 256 + ai * 128 + wr * 64 + m * 16 + fr;
#pragma unroll
                for (int bj = 0; bj < 2; ++bj) uu[m][bj] = *(const u32x4*)(Ucat + ((size_t)u.g * 1024 + row) * 768 + n0 + bj * 128); }
#pragma unroll
            for (int m = 0; m < 4; ++m) { const int row = u.mt * 256 + ai * 128 + wr * 64 + m * 16 + fr, b = row >> 7, c = row & 127;
#pragma unroll
                for (int bj = 0; bj < 2; ++bj) { const int col = n0 + bj * 128, l = 32 * c + (col >> 4); const u32x4 v = uu[m][bj]; const f32x4 a0 = acc[ai][bj][m][0], a1 = acc[ai][bj][m][1];
                    const float y0 = geluf_(a0[0] + d0.x * __uint_as_float(v.x << 16)), y1 = geluf_(a0[1] + d0.y * __uint_as_float(v.x & 0xffff0000u));
                    const float y2 = geluf_(a0[2] + d0.z * __uint_as_float(v.y << 16)), y3 = geluf_(a0[3] + d0.w * __uint_as_float(v.y & 0xffff0000u));
                    const float y4 = geluf_(a1[0] + d1.x * __uint_as_float(v.z << 16)), y5 = geluf_(a1[1] + d1.y * __uint_as_float(v.z & 0xffff0000u));
                    const float y6 = geluf_(a1[2] + d1.z * __uint_as_float(v.w << 16)), y7 = geluf_(a1[3] + d1.w * __uint_as_float(v.w & 0xffff0000u));
                    u32x4 w; w.x = pk2(y0, y1); w.y = pk2(y2, y3); w.z = pk2(y4, y5); w.w = pk2(y6, y7);
                    *(u32x4*)(yact + (((size_t)u.g * NTOK + b * 4096 + l) * 16 + i0)) = w; } }
            asm volatile("" ::: "memory");
        }
    }
};
DI void phase2c_s5out(const Params& p, unsigned char* lds, int bid, int nb) {
    S5cPol P; P.G = nb; P.c = (nb % 8 == 0) ? (bid % 8) * (nb / 8) + bid / 8 : bid; P.A = (const char*)(p.ws + WS_R3); P.B = (const char*)(p.ws + WS_MGW); P.K = 768; P.ksplit = 12; P.lda = 768; P.ldb = 768;
    S5cEpi E{(const bf16*)(p.ws + WS_R3), p.s5_d, (bf16*)(p.ws + WS_R4)};
    pg8::gemm_phase<S5cPol, S5cEpi, true>((PG8_LAS unsigned char*)lds, P, E);
}
constexpr int FF_W1P = 272, FF_W2P = 80, FF_W1_OFF = 0, FF_W2_OFF = 128 * FF_W1P, FF_TW_OFF = FF_W2_OFF + 4 * 64 * FF_W2P, FF_LDS = FF_TW_OFF + 32768, FF_STP = 144, FF_LDS2 = FF_LDS + 8 * 64 * FF_STP;
DI void phase2_fft(const Params& p, unsigned char* lds, int bid, int nb) {
    const int tid = tidx(), lane = tid & 63, wid = tid >> 6, fr = lane & 15, fq = lane >> 4;
    { const bf16* W1 = (const bf16*)(p.ws + WS_FFTC); const bf16* W2 = W1 + 128 * 128; const float* tw = (const float*)(p.ws + WS_FFTC + 32768 + 16384);
      u32x4 t1[4], t2[2], t3[4];
#pragma unroll
      for (int j = 0; j < 4; ++j) { const int i = tid + NT * j, n = i >> 4, c = i & 15; t1[j] = *(const u32x4*)(W1 + n * 128 + c * 8); }
#pragma unroll
      for (int j = 0; j < 2; ++j) { const int i = tid + NT * j, r = i >> 2, c = i & 3; t2[j] = *(const u32x4*)(W2 + r * 32 + c * 8); }
#pragma unroll
      for (int j = 0; j < 4; ++j) { const int i = tid + NT * j; t3[j] = *(const u32x4*)(tw + i * 4); }
#pragma unroll
      for (int j = 0; j < 4; ++j) { const int i = tid + NT * j, n = i >> 4, c = i & 15; *(u32x4*)(lds + FF_W1_OFF + n * FF_W1P + c * 16) = t1[j]; }
#pragma unroll
      for (int j = 0; j < 2; ++j) { const int i = tid + NT * j, r = i >> 2, c = i & 3; *(u32x4*)(lds + FF_W2_OFF + r * FF_W2P + c * 16) = t2[j]; }
#pragma unroll
      for (int j = 0; j < 4; ++j) { const int i = tid + NT * j; *(u32x4*)(lds + FF_TW_OFF + i * 16) = t3[j]; }
      __syncthreads(); }
    const bf16* GT = (const bf16*)(p.ws + WS_R2); bf16* FT = (bf16*)(p.ws + WS_R5);
    unsigned char* fst = lds + FF_LDS + wid * (64 * FF_STP);
    const float* twl = (const float*)(lds + FF_TW_OFF) + lane * 2;
    const int vcf = (nb % 8 == 0) ? (bid % 8) * (nb / 8) + bid / 8 : bid;
    const bool bal = nb == 256; const int nch = bal ? (vcf < 128 ? 1 : 3) : 0;
    const int cstep = bal ? 1 : nb * 8, c0 = bal ? (vcf < 128 ? vcf * 8 + wid : 1024 + ((vcf - 128) * 8 + wid) * 3) : bid * 8 + wid, cend = bal ? c0 + nch : 4096;
    bf16x8 afr[4][4];
#define FFT_LOAD(cix) do { const bf16* gt_ = GT + (size_t)(cix) * 2 * 4096; _Pragma("unroll") for (int ks = 0; ks < 4; ++ks) _Pragma("unroll") for (int mt = 0; mt < 4; ++mt) \
        afr[ks][mt] = *(const bf16x8*)(gt_ + (ks >> 1) * 4096 + (16 * mt + fr) * 64 + 32 * (ks & 1) + 8 * fq); } while (0)
    if (c0 < cend) FFT_LOAD(c0);
    for (int cidx = c0; cidx < cend; cidx += cstep) {
        bf16* ft = FT + (size_t)cidx * 4096;
        bf16x8 frag[4][4];
        __builtin_amdgcn_sched_barrier(0);
#pragma unroll
        for (int mh = 0; mh < 2; ++mh) {
            f32x4 d1[2][8];
#pragma unroll
            for (int m = 0; m < 2; ++m)
#pragma unroll
                for (int n = 0; n < 8; ++n) d1[m][n] = (f32x4){0.f, 0.f, 0.f, 0.f};
#pragma unroll
            for (int ks = 0; ks < 4; ++ks) {
#pragma unroll
                for (int nt = 0; nt < 8; ++nt) { const bf16x8 bfr = *(const bf16x8*)(lds + FF_W1_OFF + (nt * 16 + fr) * FF_W1P + (ks * 32 + fq * 8) * 2);
#pragma unroll
                    for (int m = 0; m < 2; ++m) d1[m][nt] = __builtin_amdgcn_mfma_f32_16x16x32_bf16(afr[ks][2 * mh + m], bfr, d1[m][nt], 0, 0, 0); }
                __builtin_amdgcn_sched_barrier(0);
            }
            if (mh == 1) { FFT_LOAD(cidx + cstep < cend ? cidx + cstep : cidx); __builtin_amdgcn_sched_barrier(0); }
#pragma unroll
            for (int nt = 0; nt < 4; ++nt) { unsigned pr[2][2], pi[2][2];
#pragma unroll
                for (int m = 0; m < 2; ++m) { const int mt = 2 * mh + m; float tr[4], ti[4];
#pragma unroll
                    for (int r = 0; r < 4; ++r) { const float cs = twl[((nt * 4 + mt) * 4 + r) * 128], sn = twl[((nt * 4 + mt) * 4 + r) * 128 + 1];
                        const float re = d1[m][nt][r], im = d1[m][nt + 4][r]; tr[r] = re * cs + im * sn; ti[r] = im * cs - re * sn; }
                    pr[m][0] = pk2(tr[0], tr[1]); pr[m][1] = pk2(tr[2], tr[3]); pi[m][0] = pk2(ti[0], ti[1]); pi[m][1] = pk2(ti[2], ti[3]); }
                u32x4 f0, f2;
                f0.x = pr[0][0]; f0.y = pr[0][1]; f0.z = pr[1][0]; f0.w = pr[1][1];
                f2.x = pi[0][0]; f2.y = pi[0][1]; f2.z = pi[1][0]; f2.w = pi[1][1];
                frag[nt][mh] = __builtin_bit_cast(bf16x8, f0); frag[nt][2 + mh] = __builtin_bit_cast(bf16x8, f2);
                __builtin_amdgcn_sched_barrier(0); }
        }
        bf16x8 w2f[4][4];
#pragma unroll
        for (int s2 = 0; s2 < 4; ++s2)
#pragma unroll
            for (int n2 = 0; n2 < 4; ++n2) w2f[s2][n2] = *(const bf16x8*)(lds + FF_W2_OFF + ((s2 * 64 + n2 * 16 + fr) * FF_W2P) + fq * 16);
#pragma unroll
        for (int nt = 0; nt < 4; ++nt) {
            f32x4 z[4];
#pragma unroll
            for (int n = 0; n < 4; ++n) z[n] = (f32x4){0.f, 0.f, 0.f, 0.f};
#pragma unroll
            for (int s2 = 0; s2 < 4; ++s2)
#pragma unroll
                for (int n2 = 0; n2 < 4; ++n2) z[n2] = __builtin_amdgcn_mfma_f32_16x16x32_bf16(frag[nt][s2], w2f[s2][n2], z[n2], 0, 0, 0);
#pragma unroll
            for (int n2 = 0; n2 < 4; ++n2) { const int cf = 16 * n2 + fr; u32x2 w; w.x = pk2(z[n2][0], z[n2][1]); w.y = pk2(z[n2][2], z[n2][3]);
                *(u32x2*)(fst + cf * FF_STP + (16 * nt + 4 * fq) * 2) = w; }
            __builtin_amdgcn_sched_barrier(0);
        }
#pragma unroll
        for (int j = 0; j < 8; ++j) { const int idx = j * 64 + lane, r = idx >> 3, sg = idx & 7; const u32x4 v = *(const u32x4*)(fst + r * FF_STP + sg * 16); *(u32x4*)(ft + 64 * r + 8 * sg) = v; }
        __builtin_amdgcn_sched_barrier(0);
    }
}
struct GluPol {
    static constexpr bool FP8 = false;
    template <class U> DI bool half(const U&) const { return false; }
    struct Unit { int pm, pn; };
    static constexpr bool GATHER = false;
    static constexpr long KSTEP_A = 4L * NTOK * 16 * 2;
    pg8::DenseOrder ord; const char* A; const char* B; int K, ksplit, lda, ldb;
    DI unsigned aoff(int R, int C) const { return (unsigned)(((C >> 4) * NTOK + R) * 16 + (C & 15)) * 2u; }
    DI bool next(int i, Unit& u) const { return ord.get(i, u.pm, u.pn); }
    DI void ptrs(const Unit& u, pg8::UPtr& q) const { q.a0 = A + (size_t)u.pm * 256 * 32; q.a1 = q.a0 + (size_t)128 * 32; q.b0 = B + (size_t)u.pn * 256 * ldb * 2; q.b1 = q.b0 + (size_t)128 * ldb * 2; q.c0 = q.b0; q.c1 = q.b1; }
    DI int brow(int R) const { return R; }
    DI void gather(const Unit&, int (&)[2], int (&)[2], unsigned&, unsigned&, unsigned&, unsigned&) const {}
#undef FFT_LOAD
};
struct GluEpi {
    static constexpr bool AFTER_DRAIN = false;
    static constexpr int MIDK_T = -1;
    const bf16* yact; bf16* merged; float* rsqs;
    DI void operator()(const f32x4 (&acc)[2][2][4][2], const GluPol::Unit& u, int wr, int wc, int fr, int fq) const {
        const int col0 = u.pn * 256 + wc * 32 + 8 * fq;
#pragma unroll
        for (int ai = 0; ai < 2; ++ai) {
            u32x4 yy[4][2];
#pragma unroll
            for (int m = 0; m < 4; ++m) { const int row = u.pm * 256 + ai * 128 + wr * 64 + m * 16 + fr;
#pragma unroll
                for (int bj = 0; bj < 2; ++bj) { const int col = col0 + bj * 128; yy[m][bj] = *(const u32x4*)(yact + ((size_t)(col >> 4) * NTOK + row) * 16 + (col & 15)); } }
#pragma unroll
            for (int m = 0; m < 4; ++m) { const int row = u.pm * 256 + ai * 128 + wr * 64 + m * 16 + fr; float sq = 0.f;
#pragma unroll
                for (int bj = 0; bj < 2; ++bj) { const u32x4 y = yy[m][bj]; const f32x4 a0 = acc[ai][bj][m][0], a1 = acc[ai][bj][m][1];
                    const float y0 = __uint_as_float(y.x << 16) * sigmoidf_(a0[0]), y1 = __uint_as_float(y.x & 0xffff0000u) * sigmoidf_(a0[1]);
                    const float y2 = __uint_as_float(y.y << 16) * sigmoidf_(a0[2]), y3 = __uint_as_float(y.y & 0xffff0000u) * sigmoidf_(a0[3]);
                    const float y4 = __uint_as_float(y.z << 16) * sigmoidf_(a1[0]), y5 = __uint_as_float(y.z & 0xffff0000u) * sigmoidf_(a1[1]);
                    const float y6 = __uint_as_float(y.w << 16) * sigmoidf_(a1[2]), y7 = __uint_as_float(y.w & 0xffff0000u) * sigmoidf_(a1[3]);
                    u32x4 w; w.x = pk2(y0, y1); w.y = pk2(y2, y3); w.z = pk2(y4, y5); w.w = pk2(y6, y7); *(u32x4*)(merged + (size_t)row * 1024 + col0 + bj * 128) = w;
                    sq += ((y0 * y0 + y1 * y1) + (y2 * y2 + y3 * y3)) + ((y4 * y4 + y5 * y5) + (y6 * y6 + y7 * y7)); }
                sq += __shfl_xor(sq, 16); sq += __shfl_xor(sq, 32);
                if (fq == 0) rsqs[(size_t)row * 8 + u.pn * 4 + wc] = sq; }
            asm volatile("" ::: "memory");
        }
    }
};
DI void phase3_glu(const Params& p, unsigned char* lds, int bid, int nb) {
    GluPol P; P.ord.init(NTOK / 256, 2, nb, bid); P.A = (const char*)(p.ws + WS_R4); P.B = (const char*)(p.ws + WS_WGLUT); P.K = 512; P.ksplit = 8; P.lda = 512; P.ldb = 512;
    GluEpi E{(const bf16*)(p.ws + WS_R4), (bf16*)(p.ws + WS_R1), (float*)(p.ws + WS_RSQS)};
    pg8::gemm_phase<GluPol, GluEpi, true>((PG8_LAS unsigned char*)lds, P, E);
}
constexpr int FM_PITCH = 132, FM_LDS = 512 * FM_PITCH;
DI void phase3_fin(const Params& p, unsigned char* lds, int bid, int nb) {
    const int tid = tidx(), lane = tid & 63, wid = tid >> 6;
    const bf16* FT = (const bf16*)(p.ws + WS_R5); bf16* merged = (bf16*)(p.ws + WS_R1);
    float gf[8];
#pragma unroll
    for (int j = 0; j < 8; ++j) gf[j] = p.g_f[lane + 64 * j];
    for (int item = bid; item < 512; item += nb) {
        const int b = item >> 6, k0 = (item & 63) * 64;
        { u32x4 v[8];
#pragma unroll
          for (int i = 0; i < 8; ++i) { const int ix = tid + NT * i, ch = ix >> 3, c = ix & 7; v[i] = *(const u32x4*)(FT + ((size_t)(b * 512 + ch) * 4096 + k0 + c * 8)); }
#pragma unroll
          for (int i = 0; i < 8; ++i) { const int ix = tid + NT * i, ch = ix >> 3, c = ix & 7; unsigned* d = (unsigned*)(lds + ch * FM_PITCH + c * 16); d[0] = v[i].x; d[1] = v[i].y; d[2] = v[i].z; d[3] = v[i].w; } }
        __syncthreads();
        float f[8][8], s[8];
#pragma unroll
        for (int t = 0; t < 8; ++t)
#pragma unroll
            for (int j = 0; j < 8; ++j) f[t][j] = bf2f(*(const bf16*)(lds + (lane + 64 * j) * FM_PITCH + (wid * 8 + t) * 2));
#pragma unroll
        for (int t = 0; t < 8; ++t) { float a = 0.f;
#pragma unroll
            for (int j = 0; j < 8; ++j) a += f[t][j] * f[t][j];
            s[t] = a; }
#pragma unroll
        for (int o = 1; o < 64; o <<= 1) {
#pragma unroll
            for (int t = 0; t < 8; ++t) s[t] += __shfl_xor(s[t], o); }
#pragma unroll
        for (int t = 0; t < 8; ++t) { const size_t row = (size_t)b * 4096 + k0 + wid * 8 + t; const float rs = rsqrtf(s[t] * (1.f / 512.f) + EPS);
#pragma unroll
            for (int j = 0; j < 8; ++j) merged[row * 1024 + 512 + lane + 64 * j] = (bf16)(pk2(f[t][j] * rs * gf[j], 0.f) & 0xffffu); }
        __syncthreads();
    }
}
struct P4Pol {
    static constexpr bool FP8 = false;
    template <class U> DI bool half(const U&) const { return false; }
    static constexpr long KSTEP_A = 0;
    DI unsigned aoff(int R, int C) const { return (unsigned)(R * lda + C) * 2u; }
    struct Unit { int pm, pn; };
    static constexpr bool GATHER = false;
    pg8::DenseOrder ord; const char* A; const char* B; int K, ksplit, lda, ldb;
    DI bool next(int i, Unit& u) const { return ord.get(i, u.pm, u.pn); }
    DI void ptrs(const Unit& u, pg8::UPtr& q) const { q.a0 = A + (size_t)u.pm * 256 * lda * 2; q.a1 = q.a0 + (size_t)128 * lda * 2; q.b0 = B + (size_t)u.pn * 256 * ldb * 2; q.b1 = q.b0 + (size_t)128 * ldb * 2; q.c0 = q.b0; q.c1 = q.b1; }
    DI int brow(int R) const { return R; }
    DI void gather(const Unit&, int (&)[2], int (&)[2], unsigned&, unsigned&, unsigned&, unsigned&) const {}
};
struct P4Epi {
    static constexpr bool AFTER_DRAIN = false;
    static constexpr int MIDK_T = 8;
    const float* x; bf16* x1b; const float* mod; float* rsqp; const float* rss;
    DI void midk(f32x4 (&acc)[2][2][4][2], const P4Pol::Unit& u, int wr, int wc, int fr, int fq) const {
        float r[2][4]; f32x4 q0[2][4], q1[2][4];
#pragma unroll
        for (int ai = 0; ai < 2; ++ai)
#pragma unroll
            for (int m = 0; m < 4; ++m) { const f32x4* q = (const f32x4*)(rss + (size_t)(u.pm * 256 + ai * 128 + wr * 64 + m * 16 + fr) * 8); q0[ai][m] = q[0]; q1[ai][m] = q[1]; }
#pragma unroll
        for (int ai = 0; ai < 2; ++ai)
#pragma unroll
            for (int m = 0; m < 4; ++m) r[ai][m] = rsqrtf((((q0[ai][m].x + q0[ai][m].y) + (q0[ai][m].z + q0[ai][m].w)) + ((q1[ai][m].x + q1[ai][m].y) + (q1[ai][m].z + q1[ai][m].w))) * (1.f / 512.f) + EPS);
#pragma unroll
        for (int ai = 0; ai < 2; ++ai)
#pragma unroll
            for (int m = 0; m < 4; ++m)
#pragma unroll
                for (int bj = 0; bj < 2; ++bj)
#pragma unroll
                    for (int n = 0; n < 2; ++n) acc[ai][bj][m][n] = acc[ai][bj][m][n] * r[ai][m];
    }
    DI void operator()(const f32x4 (&acc)[2][2][4][2], const P4Pol::Unit& u, int wr, int wc, int fr, int fq) const {
        const int col0 = u.pn * 256 + wc * 32 + 8 * fq, b = (u.pm * 256) >> 12;
        f32x4 gv[2][2];
#pragma unroll
        for (int bj = 0; bj < 2; ++bj)
#pragma unroll
            for (int n = 0; n < 2; ++n) gv[bj][n] = *(const f32x4*)(mod + b * 6144 + 2048 + col0 + bj * 128 + n * 4);
        f32x4 xa[2][2][2], xb[2][2][2];
#define P4_LOAD(dst, q_) do { const int ai_ = (q_) >> 1, mb_ = ((q_) & 1) * 2; _Pragma("unroll") for (int m2 = 0; m2 < 2; ++m2) { const int row_ = u.pm * 256 + ai_ * 128 + wr * 64 + (mb_ + m2) * 16 + fr; \
            _Pragma("unroll") for (int bj = 0; bj < 2; ++bj) _Pragma("unroll") for (int n = 0; n < 2; ++n) dst[m2][bj][n] = __builtin_nontemporal_load((const f32x4*)(x + (size_t)row_ * D + col0 + bj * 128 + n * 4)); } } while (0)
#define P4_DO(src, q_) do { const int ai_ = (q_) >> 1, mb_ = ((q_) & 1) * 2; _Pragma("unroll") for (int m2 = 0; m2 < 2; ++m2) { const int m_ = mb_ + m2, row_ = u.pm * 256 + ai_ * 128 + wr * 64 + m_ * 16 + fr; float s_ = 0.f; \
            _Pragma("unroll") for (int bj = 0; bj < 2; ++bj) { const f32x4 o0 = src[m2][bj][0] + gv[bj][0] * acc[ai_][bj][m_][0], o1 = src[m2][bj][1] + gv[bj][1] * acc[ai_][bj][m_][1]; \
                u32x4 w; w.x = pk2(o0.x, o0.y); w.y = pk2(o0.z, o0.w); w.z = pk2(o1.x, o1.y); w.w = pk2(o1.z, o1.w); *(u32x4*)(x1b + (size_t)row_ * D + col0 + bj * 128) = w; \
                s_ += ((o0.x * o0.x + o0.y * o0.y) + (o0.z * o0.z + o0.w * o0.w)) + ((o1.x * o1.x + o1.y * o1.y) + (o1.z * o1.z + o1.w * o1.w)); } \
            s_ += __shfl_xor(s_, 16); s_ += __shfl_xor(s_, 32); if (fq == 0) rsqp[(size_t)row_ * 16 + u.pn * 4 + wc] = s_; } } while (0)
        P4_LOAD(xa, 0); P4_LOAD(xb, 1);
        P4_DO(xa, 0); asm volatile("" ::: "memory"); P4_LOAD(xa, 2);
        P4_DO(xb, 1); asm volatile("" ::: "memory"); P4_LOAD(xb, 3);
        P4_DO(xa, 2); asm volatile("" ::: "memory");
        P4_DO(xb, 3);
#undef P4_LOAD
#undef P4_DO
    }
};
DI void phase4_out(const Params& p, unsigned char* lds, int bid, int nb) {
    P4Pol P; P.ord.init(NTOK / 256, D / 256, nb, bid); P.A = (const char*)(p.ws + WS_R1); P.B = (const char*)(p.ws + WS_WOUTT); P.K = 1024; P.ksplit = 16; P.lda = 1024; P.ldb = 1024;
    P4Epi E{p.x, (bf16*)(p.ws + WS_X1B), (const float*)(p.ws + WS_MOD), (float*)(p.ws + WS_RSQP1), (const float*)(p.ws + WS_RSQS)};
    pg8::gemm_phase<P4Pol, P4Epi, true>((PG8_LAS unsigned char*)lds, P, E);
}
DI int pair_index(int lo, int hi) { return 7 * lo - (lo * (lo - 1)) / 2 + (hi - lo - 1); }
constexpr int RT_WP = 2064, RT_GM_OFF = 48 * RT_WP, RT_SH_OFF = RT_GM_OFF + 4096, RT_SC_OFF = RT_SH_OFF + 4096, RT_LC_OFF = RT_SC_OFF + 8 * 16 * 48 * 4, RT_LDS = RT_LC_OFF + 2 * 144 * 4;
DI void phase5_route(const Params& p, unsigned char* lds, int bid, int nb, bool commit = true) {
    const int tid = tidx(), lane = tid & 63, wid = tid >> 6, fr = lane & 15, fq = lane >> 4;
    const float* mod = (const float*)(p.ws + WS_MOD); const float* rsqp = (const float*)(p.ws + WS_RSQP1);
    bf16* A2 = (bf16*)(p.ws + WS_A2); unsigned* elcp = (unsigned*)(p.ws + WS_ELCP); float* elw = (float*)(p.ws + WS_ELW); unsigned* tcp = (unsigned*)(p.ws + WS_TCP);
    unsigned* ecnt = (unsigned*)(p.ws + WS_CTL + CTL_ECNT); unsigned* pcnt = (unsigned*)(p.ws + WS_CTL + CTL_PCNT);
    unsigned* elist = (unsigned*)(p.ws + WS_ELIST);
    float* gm = (float*)(lds + RT_GM_OFF); float* shv = (float*)(lds + RT_SH_OFF); float* scr = (float*)(lds + RT_SC_OFF) + wid * 16 * 48;
    unsigned* lcnt = (unsigned*)(lds + RT_LC_OFF); unsigned* lbase = lcnt + 144; float* rbias = (float*)(lds + RT_LDS);
    float ng[2], ms[2], mh[2], bv = 0.f; f32x4 q0, q1, q2, q3; u32x4 xa[8], xb[8];
#define P5_PRELOAD(t128_) do { const int b_ = (t128_) >> 5, row_ = (t128_) * 128 + wid * 16 + fr; \
        _Pragma("unroll") for (int j = 0; j < 2; ++j) { const int k = tid + NT * j; ng[j] = p.norm2_g[k]; ms[j] = mod[b_ * 6144 + 4096 + k]; mh[j] = mod[b_ * 6144 + 3072 + k]; } \
        bv = tid < 4 ? p.b_group[tid] : (tid < 36 ? p.b_router[tid - 4] : 0.f); \
        { const f32x4* pp = (const f32x4*)(rsqp + (size_t)row_ * 16); q0 = pp[0]; q1 = pp[1]; q2 = pp[2]; q3 = pp[3]; } \
        { const bf16* xr_ = (const bf16*)(p.ws + WS_X1B) + (size_t)row_ * D + fq * 16; _Pragma("unroll") for (int i = 0; i < 8; ++i) xa[i] = *(const u32x4*)(xr_ + (i >> 1) * 64 + (i & 1) * 8); } } while (0)
    { const bf16* W = (const bf16*)(p.ws + WS_WRT);
      u32x4 wv[12];
#pragma unroll
      for (int j = 0; j < 12; ++j) { const int i = tid + NT * j, n = i >> 7, c = i & 127; wv[j] = *(const u32x4*)(W + n * 1024 + c * 8); }
      if (bid < NTOK / 128) P5_PRELOAD(bid);
#pragma unroll
      for (int j = 0; j < 12; ++j) { const int i = tid + NT * j, n = i >> 7, c = i & 127; *(u32x4*)(lds + n * RT_WP + c * 16) = wv[j]; } }
    for (int t128 = bid; t128 < NTOK / 128; t128 += nb) {
        __syncthreads();
        if (t128 != bid) P5_PRELOAD(t128);
#pragma unroll
        for (int j = 0; j < 2; ++j) { const int k = tid + NT * j; gm[k] = ng[j] * (1.f + ms[j]); shv[k] = mh[j]; }
        if (tid < 36) rbias[tid] = bv;
        if (tid < 144) lcnt[tid] = 0u;
        __syncthreads();
        const int row0 = t128 * 128 + wid * 16, row = row0 + fr;
        float rs;
        { const float rsum = (((q0.x + q0.y) + (q0.z + q0.w)) + ((q1.x + q1.y) + (q1.z + q1.w))) + (((q2.x + q2.y) + (q2.z + q2.w)) + ((q3.x + q3.y) + (q3.z + q3.w)));
          rs = rsqrtf(rsum * (1.f / D) + EPS); }
        f32x4 acc[3];
#pragma unroll
        for (int n = 0; n < 3; ++n) acc[n] = (f32x4){0.f, 0.f, 0.f, 0.f};
        const bf16* xr = (const bf16*)(p.ws + WS_X1B) + (size_t)row * D + fq * 16; unsigned char* ar = (unsigned char*)A2 + (size_t)row * D + fq * 16;
        u32x2 pend = {0u, 0u}; unsigned char* stg = (unsigned char*)scr;
#pragma unroll 1
        for (int kc = 0; kc < 4; kc += 2) {
#pragma unroll
            for (int i = 0; i < 8; ++i) xb[i] = *(const u32x4*)(xr + (kc + 1) * 256 + (i >> 1) * 64 + (i & 1) * 8);
#pragma unroll
            for (int half = 0; half < 2; ++half) {
#pragma unroll
                for (int i = 0; i < 8; ++i) {
                    const int ks = (kc + half) * 8 + i, k0 = (ks >> 1) * 64 + fq * 16 + (ks & 1) * 8;
                    const u32x4 xx = half ? xb[i] : xa[i];
                    f32x4 x0, x1; x0.x = __uint_as_float(xx.x << 16); x0.y = __uint_as_float(xx.x & 0xffff0000u); x0.z = __uint_as_float(xx.y << 16); x0.w = __uint_as_float(xx.y & 0xffff0000u);
                    x1.x = __uint_as_float(xx.z << 16); x1.y = __uint_as_float(xx.z & 0xffff0000u); x1.z = __uint_as_float(xx.w << 16); x1.w = __uint_as_float(xx.w & 0xffff0000u);
                    const f32x4 g0 = *(const f32x4*)(gm + k0), g1 = *(const f32x4*)(gm + k0 + 4), s0 = *(const f32x4*)(shv + k0), s1 = *(const f32x4*)(shv + k0 + 4);
                    const f32x4 t0 = x0 * rs * g0 + s0, t1 = x1 * rs * g1 + s1;
                    u32x4 hi; hi.x = pk2(t0.x, t0.y); hi.y = pk2(t0.z, t0.w); hi.z = pk2(t1.x, t1.y); hi.w = pk2(t1.z, t1.w);
                    { u32x2 a8; a8.x = pk4_fp8(t0.x * 4.f, t0.y * 4.f, t0.z * 4.f, t0.w * 4.f); a8.y = pk4_fp8(t1.x * 4.f, t1.y * 4.f, t1.z * 4.f, t1.w * 4.f); if (i & 1) { u32x4 a16; a16.x = pend.x; a16.y = pend.y; a16.z = a8.x; a16.w = a8.y; *(u32x4*)(stg + fr * 144 + ((ks >> 1) & 1) * 64 + fq * 16) = a16;
                        if ((i & 3) == 3) {
#pragma unroll
                            for (int j = 0; j < 2; ++j) { const int idx = j * 64 + lane, r = idx >> 3, sg = idx & 7; const u32x4 v = *(const u32x4*)(stg + r * 144 + sg * 16);
                                *(u32x4*)((unsigned char*)A2 + (size_t)(row0 + r) * D + (ks >> 2) * 128 + sg * 16) = v; } }
                      } else pend = a8; }
                    u32x4 lo;
                    lo.x = pk2(t0.x - __uint_as_float(hi.x << 16), t0.y - __uint_as_float(hi.x & 0xffff0000u)); lo.y = pk2(t0.z - __uint_as_float(hi.y << 16), t0.w - __uint_as_float(hi.y & 0xffff0000u));
                    lo.z = pk2(t1.x - __uint_as_float(hi.z << 16), t1.y - __uint_as_float(hi.z & 0xffff0000u)); lo.w = pk2(t1.z - __uint_as_float(hi.w << 16), t1.w - __uint_as_float(hi.w & 0xffff0000u));
                    const bf16x8 ah = __builtin_bit_cast(bf16x8, hi), al = __builtin_bit_cast(bf16x8, lo);
#pragma unroll
                    for (int nt = 0; nt < 3; ++nt) { const bf16x8 bw = *(const bf16x8*)(lds + (16 * nt + fr) * RT_WP + k0 * 2);
                        acc[nt] = __builtin_amdgcn_mfma_f32_16x16x32_bf16(ah, bw, acc[nt], 0, 0, 0); acc[nt] = __builtin_amdgcn_mfma_f32_16x16x32_bf16(al, bw, acc[nt], 0, 0, 0); }
                }
                if (half == 0 && kc + 2 < 4) {
#pragma unroll
                    for (int i = 0; i < 8; ++i) xa[i] = *(const u32x4*)(xr + (kc + 2) * 256 + (i >> 1) * 64 + (i & 1) * 8);
                }
            }
        }
#pragma unroll
        for (int nt = 0; nt < 3; ++nt)
#pragma unroll
            for (int r = 0; r < 4; ++r) scr[(4 * fq + r) * 48 + 16 * nt + fr] = acc[nt][r];
        __syncthreads();
        int e1 = 0, e2 = 0, cls = 0, pos1 = 0; float w1 = 0.f, w2 = 0.f; unsigned r1 = 0, r2 = 0, r3 = 0; const bool rt = lane < 16 && commit;
        if (rt) {
            const int rrow = row0 + lane; const float* lg = scr + lane * 48;
            float gl[4];
#pragma unroll
            for (int o = 0; o < 4; ++o) gl[o] = lg[o] + rbias[o];
            float gmax = gl[0]; int gi = 0;
#pragma unroll
            for (int o = 1; o < 4; ++o) if (gl[o] > gmax) { gmax = gl[o]; gi = o; }
            float se = 0.f;
#pragma unroll
            for (int o = 0; o < 4; ++o) se += __expf(gl[o] - gmax);
            const float g_w = 1.f / se;
            float ev[8];
#pragma unroll
            for (int o = 0; o < 8; ++o) ev[o] = lg[4 + gi * 8 + o] + rbias[4 + gi * 8 + o];
            float v1 = ev[0]; int i1 = 0;
#pragma unroll
            for (int o = 1; o < 8; ++o) if (ev[o] > v1) { v1 = ev[o]; i1 = o; }
            float v2 = -3.0e38f; int i2 = -1;
#pragma unroll
            for (int o = 0; o < 8; ++o) if (o != i1 && ev[o] > v2) { v2 = ev[o]; i2 = o; }
            w1 = g_w / (1.f + __expf(v2 - v1)); w2 = g_w - w1;
            const int lo = i1 < i2 ? i1 : i2, hi = i1 < i2 ? i2 : i1; pos1 = i1 < i2 ? 0 : 1;
            e1 = gi * 8 + i1; e2 = gi * 8 + i2; cls = gi * 28 + pair_index(lo, hi);
            r1 = atomicAdd(lcnt + e1, 1u); r2 = atomicAdd(lcnt + e2, 1u); r3 = atomicAdd(lcnt + 32 + cls, 1u);
        }
        __syncthreads();
        if (tid < 144) { const unsigned n = lcnt[tid]; if (n) lbase[tid] = atomicAdd((tid < 32 ? ecnt + tid * CNT_STRIDE : pcnt + (tid - 32) * CNT_STRIDE), n); }
        __syncthreads();
        if (rt) {
            const int rrow = row0 + lane;
            const unsigned q3 = lbase[32 + cls] + r3, cp = ((unsigned)cls << 16) | q3;
            tcp[rrow] = cp;
            const unsigned q1 = lbase[e1] + r1; elist[(size_t)e1 * 32768 + q1] = (unsigned)rrow * 2u + (unsigned)pos1; elcp[(size_t)e1 * 32768 + q1] = cp; elw[(size_t)e1 * 32768 + q1] = w1;
            const unsigned q2 = lbase[e2] + r2; elist[(size_t)e2 * 32768 + q2] = (unsigned)rrow * 2u + (unsigned)(1 - pos1); elcp[(size_t)e2 * 32768 + q2] = cp; elw[(size_t)e2 * 32768 + q2] = w2;
        }
    }
    __syncthreads();
}
#undef P5_PRELOAD
constexpr int TB_OFF = 131072, TB_ETE = 64, TB_ETR = 64 + 320, TB_ETC = 64 + 640, TB_PTC = 64 + 960, TB_PTS = 64 + 1280, TB_COFF = 64 + 1600, TB_PTN = 64 + 1600 + 128 + 160, TB_BYTES = (64 + 1600 + 128 + 160 + 320) * 4;
DI void build_tiles(const Params& p, unsigned char* lds) {
    int* tb = (int*)(lds + TB_OFF); int* cnts = tb + TB_COFF + 112;
    const int tid = tidx();
    if (tid < 144) cnts[tid] = tid < 32 ? (int)((const unsigned*)(p.ws + WS_CTL + CTL_ECNT))[tid * CNT_STRIDE] : (int)((const unsigned*)(p.ws + WS_CTL + CTL_PCNT))[(tid - 32) * CNT_STRIDE];
    __syncthreads();
    const bool isE = tid < 32, isP = tid >= 64 && tid < 176;
    if (isE || isP) {
        const int base = isE ? 0 : 32, n = isE ? 32 : 112, me = isE ? tid : tid - 64;
        int fb = 0, pb = 0, hb = 0, ft = 0, pt = 0, rows_before = 0;
        for (int j = 0; j < n; ++j) { const int c = cnts[base + j], f = c >> 8, r = c & 255, pp = r > 128 ? 1 : 0, hh = (r > 0 && r <= 128) ? 1 : 0;
            ft += f; pt += pp; if (j < me) { fb += f; pb += pp; hb += hh; rows_before += ((c + 255) >> 8) << 8; } }
        const int c = cnts[base + me], f = c >> 8, r = c & 255;
        if (isE) {
            for (int k = 0; k < f; ++k) { tb[TB_ETE + fb + k] = me; tb[TB_ETR + fb + k] = k * 256; tb[TB_ETC + fb + k] = c; }
            if (r > 128) { const int ix = ft + pb; tb[TB_ETE + ix] = me; tb[TB_ETR + ix] = f * 256; tb[TB_ETC + ix] = c; }
            else if (r > 0) { const int ix = ft + pt + hb; tb[TB_ETE + ix] = me; tb[TB_ETR + ix] = f * 256; tb[TB_ETC + ix] = c; }
            if (me == 31) tb[0] = ft + pt + hb + ((r > 0 && r <= 128) ? 1 : 0);
        } else {
            tb[TB_COFF + me] = rows_before;
            for (int k = 0; k < f; ++k) { tb[TB_PTC + fb + k] = me; tb[TB_PTS + fb + k] = rows_before + k * 256; tb[TB_PTN + fb + k] = c - k * 256; }
            if (r > 128) { const int ix = ft + pb; tb[TB_PTC + ix] = me; tb[TB_PTS + ix] = rows_before + f * 256; tb[TB_PTN + ix] = r; }
            else if (r > 0) { const int ix = ft + pt + hb; tb[TB_PTC + ix] = me; tb[TB_PTS + ix] = rows_before + f * 256; tb[TB_PTN + ix] = r; }
            if (me == 111) tb[1] = ft + pt + hb + ((r > 0 && r <= 128) ? 1 : 0);
        }
    }
    __syncthreads();
}
struct GUPol {
    static constexpr bool FP8 = true;
    struct Unit { int e, r0, cnt, hh; };
    DI bool half(const Unit& u) const { return u.cnt - u.r0 <= 128; }
    static constexpr long KSTEP_A = 0;
    DI unsigned aoff(int R, int C) const { return (unsigned)(R * lda + C) * 2u; }
    static constexpr bool GATHER = true;
    const int* tb; int G, c; const char* A; const char* B; const unsigned* elist; int K, ksplit, lda, ldb;
    DI bool next(int i, Unit& u) const { const int L = i * G + c; if (L >= __builtin_amdgcn_readfirstlane(tb[0]) * 2) return false; const int t = L >> 1; u.hh = L & 1;
        u.e = __builtin_amdgcn_readfirstlane(tb[TB_ETE + t]); u.r0 = __builtin_amdgcn_readfirstlane(tb[TB_ETR + t]); u.cnt = __builtin_amdgcn_readfirstlane(tb[TB_ETC + t]); return true; }
    DI void ptrs(const Unit& u, pg8::UPtr& q) const { q.a0 = A; q.a1 = A; q.b0 = B + (size_t)((u.e * 2 + u.hh) * 256) * ldb * 2; q.b1 = q.b0 + (size_t)128 * ldb * 2; q.c0 = q.b0; q.c1 = q.b1; }
    DI int brow(int R) const { return R; }
    DI unsigned goff(const Unit& u, int r, int C) const { const unsigned ent = elist[(size_t)u.e * 32768 + (r < u.cnt ? r : u.r0)]; return ((ent >> 1) * 512u + (unsigned)C) * 2u; }
    DI void gather(const Unit& u, int (&R)[2], int (&C)[2], unsigned& v00, unsigned& v01, unsigned& v10, unsigned& v11) const {
        v00 = goff(u, u.r0 + R[0], C[0]); v01 = goff(u, u.r0 + R[1], C[1]); v10 = goff(u, u.r0 + 128 + R[0], C[0]); v11 = goff(u, u.r0 + 128 + R[1], C[1]);
    }
};
struct GUEpi {
    static constexpr bool AFTER_DRAIN = false;
    static constexpr int MIDK_T = -1;
    const unsigned* elist; const unsigned* elcp; const float* elw; bf16* Hs; const int* tb;
    DI void operator()(const f32x4 (&acc)[2][2][4][2], const GUPol::Unit& u, int wr, int wc, int fr, int fq) const {
        unsigned ent[2][4], cp[2][4]; float w[2][4];
#pragma unroll
        for (int ai = 0; ai < 2; ++ai)
#pragma unroll
            for (int m = 0; m < 4; ++m) { const int r = u.r0 + ai * 128 + wr * 64 + m * 16 + fr; const size_t ix = (size_t)u.e * 32768 + (r < u.cnt ? r : u.r0);
                ent[ai][m] = elist[ix]; cp[ai][m] = elcp[ix]; w[ai][m] = elw[ix]; }
#pragma unroll
        for (int ai = 0; ai < 2; ++ai)
#pragma unroll
            for (int m = 0; m < 4; ++m) { const int r = u.r0 + ai * 128 + wr * 64 + m * 16 + fr;
                if (r < u.cnt) { const int srow = tb[TB_COFF + (cp[ai][m] >> 16)] + (int)(cp[ai][m] & 0xffffu); const float ww = w[ai][m];
                    unsigned char* dst = (unsigned char*)Hs + (size_t)srow * 512 + (ent[ai][m] & 1u) * 256 + u.hh * 128 + wc * 32 + 8 * fq;
                    const f32x4 g0 = acc[ai][0][m][0] * (1.f / 128.f), g1 = acc[ai][0][m][1] * (1.f / 128.f), u0 = acc[ai][1][m][0] * (1.f / 128.f), u1 = acc[ai][1][m][1] * (1.f / 128.f); const float w16 = ww * 8.f;
                    u32x2 o; o.x = pk4_fp8(siluf_(g0[0]) * u0[0] * w16, siluf_(g0[1]) * u0[1] * w16, siluf_(g0[2]) * u0[2] * w16, siluf_(g0[3]) * u0[3] * w16);
                    o.y = pk4_fp8(siluf_(g1[0]) * u1[0] * w16, siluf_(g1[1]) * u1[1] * w16, siluf_(g1[2]) * u1[2] * w16, siluf_(g1[3]) * u1[3] * w16);
                    *(u32x2*)dst = o; } }
    }
};
DI void phase6_gateup(const Params& p, unsigned char* lds, int bid, int nb) {
    GUPol P; P.tb = (const int*)(lds + TB_OFF); P.G = nb; P.c = (nb % 8 == 0) ? (bid % 8) * (nb / 8) + bid / 8 : bid; P.A = (const char*)(p.ws + WS_A2); P.B = (const char*)(p.ws + WS_WGUT); P.elist = (const unsigned*)(p.ws + WS_ELIST); P.K = 512; P.ksplit = 8; P.lda = 512; P.ldb = 512;
    GUEpi E{(const unsigned*)(p.ws + WS_ELIST), (const unsigned*)(p.ws + WS_ELCP), (const float*)(p.ws + WS_ELW), (bf16*)(p.ws + WS_HS), (const int*)(lds + TB_OFF)};
    pg8::gemm_phase<GUPol, GUEpi, true>((PG8_LAS unsigned char*)lds, P, E);
    { const int nu = __builtin_amdgcn_readfirstlane(((const int*)(lds + TB_OFF))[0]) * 2, rounds = (nu + nb - 1) / nb, full = nu - (rounds - 1) * nb;
      const int nidle = nb - full, wid = tidx() >> 6;
      if (nidle >= nb / 4) { if (P.c >= full) for (int it = (P.c - full) * 8 + wid; it < TP_J5; it += nidle * 8) tp_item(p, lds, TP_NODOWN + it); }
      else { for (int it = bid * 8 + wid; it < TP_J5; it += nb * 8) tp_item(p, lds, TP_NODOWN + it); } }
}
struct DnPol {
    static constexpr bool FP8 = true;
    struct Unit { int s0, cls, pn, nrows; };
    DI bool half(const Unit& u) const { return u.nrows <= 128; }
    static constexpr long KSTEP_A = 0;
    DI unsigned aoff(int R, int C) const { return (unsigned)(R * lda + C) * 2u; }
    static constexpr bool GATHER = false;
    const int* tb; int G, c; const char* A; const char* B; int K, ksplit, lda, ldb;
    DI bool next(int i, Unit& u) const { const int L = i * G + c; if (L >= __builtin_amdgcn_readfirstlane(tb[1]) * 4) return false; const int t = L >> 2; u.pn = L & 3;
        u.cls = __builtin_amdgcn_readfirstlane(tb[TB_PTC + t]); u.s0 = __builtin_amdgcn_readfirstlane(tb[TB_PTS + t]); u.nrows = __builtin_amdgcn_readfirstlane(tb[TB_PTN + t]); return true; }
    DI void ptrs(const Unit& u, pg8::UPtr& q) const {
        const int gi = u.cls / 28; int lo = 0, rem = u.cls % 28;
        while (rem >= 7 - lo) { rem -= 7 - lo; ++lo; }
        const int hi = lo + 1 + rem, elo = gi * 8 + lo, ehi = gi * 8 + hi;
        q.a0 = A + (size_t)u.s0 * lda * 2; q.a1 = q.a0 + (size_t)128 * lda * 2;
        q.b0 = B + ((size_t)elo * 1024 + u.pn * 256) * ldb * 2; q.b1 = q.b0 + (size_t)128 * ldb * 2;
        q.c0 = B + ((size_t)ehi * 1024 + u.pn * 256) * ldb * 2; q.c1 = q.c0 + (size_t)128 * ldb * 2; }
    DI int brow(int R) const { return R; }
    DI void gather(const Unit&, int (&)[2], int (&)[2], unsigned&, unsigned&, unsigned&, unsigned&) const {}
};
struct DnEpi {
    static constexpr bool AFTER_DRAIN = false;
    static constexpr int MIDK_T = -1;
    bf16* moe;
    DI void operator()(const f32x4 (&acc)[2][2][4][2], const DnPol::Unit& u, int wr, int wc, int fr, int fq) const {
#pragma unroll
        for (int ai = 0; ai < 2; ++ai) { if (ai == 1 && u.nrows <= 128) break;
#pragma unroll
            for (int m = 0; m < 4; ++m) { bf16* dst = moe + (size_t)(u.s0 + ai * 128 + wr * 64 + m * 16 + fr) * 1024 + u.pn * 256 + wc * 32 + 8 * fq;
#pragma unroll
                for (int bj = 0; bj < 2; ++bj) { const f32x4 v0 = acc[ai][bj][m][0] * (1.f / 128.f), v1 = acc[ai][bj][m][1] * (1.f / 128.f);
                    u32x4 w; w.x = pk2(v0[0], v0[1]); w.y = pk2(v0[2], v0[3]); w.z = pk2(v1[0], v1[1]); w.w = pk2(v1[2], v1[3]);
                    *(u32x4*)(dst + bj * 128) = w; } } }
    }
};
DI void phase7_down(const Params& p, unsigned char* lds, int bid, int nb) {
    DnPol P; P.tb = (const int*)(lds + TB_OFF); P.G = nb; P.c = (nb % 8 == 0) ? (bid % 8) * (nb / 8) + bid / 8 : bid; P.A = (const char*)(p.ws + WS_HS); P.B = (const char*)(p.ws + WS_WDT); P.K = 256; P.ksplit = 2; P.lda = 256; P.ldb = 128;
    DnEpi E{(bf16*)(p.ws + WS_MOE)};
    pg8::gemm_phase<DnPol, DnEpi, true>((PG8_LAS unsigned char*)lds, P, E);
}
DI void phase8_final(const Params& p, unsigned char* lds, int bid, int nb) {
    const int lane = tidx() & 63, wave = tidx() >> 6;
    const float* mod = (const float*)(p.ws + WS_MOD); const unsigned* tcp = (const unsigned*)(p.ws + WS_TCP); const bf16* moe = (const bf16*)(p.ws + WS_MOE); const bf16* x1b = (const bf16*)(p.ws + WS_X1B); const int* tb = (const int*)(lds + TB_OFF);
    constexpr int RW = 4;
    for (int r0 = (bid * 8 + wave) * RW; r0 < NTOK; r0 += nb * 8 * RW) {
        const int b = r0 >> 12; unsigned cp[RW]; u32x2 xx[RW][4], mm[RW][4];
#pragma unroll
        for (int q = 0; q < RW; ++q) cp[q] = tcp[r0 + q];
#pragma unroll
        for (int q = 0; q < RW; ++q)
#pragma unroll
            for (int j = 0; j < 4; ++j) xx[q][j] = ((const u32x2*)(x1b + (size_t)(r0 + q) * D) + lane)[64 * j];
#pragma unroll
        for (int q = 0; q < RW; ++q) { const int srow = tb[TB_COFF + (cp[q] >> 16)] + (int)(cp[q] & 0xffffu);
#pragma unroll
            for (int j = 0; j < 4; ++j) mm[q][j] = ((const u32x2*)(moe + (size_t)srow * D) + lane)[64 * j]; }
        f32x4 g2[4], fg[4];
#pragma unroll
        for (int j = 0; j < 4; ++j) { g2[j] = *(const f32x4*)(mod + b * 6144 + 5120 + lane * 4 + 256 * j); fg[j] = *(const f32x4*)(p.final_g + lane * 4 + 256 * j); }
        f32x4 v[RW][4]; float s[RW];
#pragma unroll
        for (int q = 0; q < RW; ++q) { float t = 0.f;
#pragma unroll
            for (int j = 0; j < 4; ++j) { f32x4 x1, mv; x1.x = __uint_as_float(xx[q][j].x << 16); x1.y = __uint_as_float(xx[q][j].x & 0xffff0000u); x1.z = __uint_as_float(xx[q][j].y << 16); x1.w = __uint_as_float(xx[q][j].y & 0xffff0000u);
                mv.x = __uint_as_float(mm[q][j].x << 16); mv.y = __uint_as_float(mm[q][j].x & 0xffff0000u); mv.z = __uint_as_float(mm[q][j].y << 16); mv.w = __uint_as_float(mm[q][j].y & 0xffff0000u);
                v[q][j] = x1 + g2[j] * mv; t += (v[q][j].x * v[q][j].x + v[q][j].y * v[q][j].y) + (v[q][j].z * v[q][j].z + v[q][j].w * v[q][j].w); }
            s[q] = t; }
#pragma unroll
        for (int o = 1; o < 64; o <<= 1) {
#pragma unroll
            for (int q = 0; q < RW; ++q) s[q] += __shfl_xor(s[q], o); }
#pragma unroll
        for (int q = 0; q < RW; ++q) { const float rs = rsqrtf(s[q] * (1.f / D) + EPS); f32x4* orow = (f32x4*)(p.out + (size_t)(r0 + q) * D) + lane;
#pragma unroll
            for (int j = 0; j < 4; ++j) { f32x4 o = v[q][j] * rs * fg[j];
                if (MK_TS1 >= 0) { const unsigned* tsv = (const unsigned*)(p.ws + WS_CTL + CTL_TS); o = o * (1.f + (float)(tsv[0] / 1000u) * 0.01f); }
                orow[64 * j] = o; } }
    }
}

#define XB_TMO      128
#define XB_XCNT(j)  (256  + 64 * (j))
#define XB_XSUB(j)  (1280 + 64 * (j))
#define XB_XGEN(j)  (2304 + 64 * (j))
#define XB_TOP      3328
#define XB_TOPGEN   3392
#define XCD_BAR_WORDS 3456
#define XB_SPIN_CAP (1u << 18)
#define LAS __attribute__((address_space(3)))
DI unsigned xb_ld(unsigned* p)              { return __hip_atomic_load(p, __ATOMIC_RELAXED, __HIP_MEMORY_SCOPE_AGENT); }
DI unsigned xb_add(unsigned* p, unsigned v) { return __hip_atomic_fetch_add(p, v, __ATOMIC_RELAXED, __HIP_MEMORY_SCOPE_AGENT); }
DI unsigned xb_xcc_id() { return (unsigned)__builtin_amdgcn_s_getreg((3 << 11) | 20) & 0xFu; }
#define XB_SPIN(cond, bar) do { unsigned _sp = 0; while (cond) { __builtin_amdgcn_s_sleep(1); \
    if ((++_sp & 255u) == 0u) { if (xb_ld(&(bar)[XB_TMO])) break; if (_sp > XB_SPIN_CAP) { atomicAdd(&(bar)[XB_TMO], 1u); break; } } } } while (0)
struct XcdBarrier { unsigned* bar; unsigned x; volatile LAS unsigned* st; };
DI XcdBarrier xcd_barrier_post(unsigned* bar, volatile LAS unsigned* st) {
    XcdBarrier b; b.bar = bar; b.x = xb_xcc_id(); b.st = st;
    if (tidx() == 0) (void)xb_add(&bar[XB_XCNT(b.x)], 1u);
    return b;
}
DI void xcd_barrier_complete(unsigned* bar, unsigned x, unsigned& nloc, unsigned& nx) {
    const unsigned G = gridDim.x * gridDim.y * gridDim.z;
    unsigned sum, cnt, mine, sp = 0u;
    for (;;) {
        sum = 0u; cnt = 0u; mine = 0u;
#pragma unroll
        for (unsigned j = 0; j < 16; ++j) { const unsigned c = xb_ld(&bar[XB_XCNT(j)]); sum += c; cnt += (c > 0u) ? 1u : 0u; mine = (j == x) ? c : mine; }
        if (sum == G) break;
        __builtin_amdgcn_s_sleep(1);
        if ((++sp & 255u) == 0u) { if (xb_ld(&bar[XB_TMO])) break; if (sp > XB_SPIN_CAP) { atomicAdd(&bar[XB_TMO], 1u); break; } }
    }
    nloc = mine > 0u ? mine : 1u; nx = cnt > 0u ? cnt : 1u;
}
DI void xcd_barrier(const XcdBarrier& b) {
    asm volatile("s_waitcnt vmcnt(0)" ::: "memory");
    __syncthreads();
    if (tidx() == 0) {
        unsigned* bar = b.bar;
        __builtin_amdgcn_s_waitcnt(0);
        unsigned nloc = b.st[0], nx = b.st[1];
        if (nloc == 0u) { xcd_barrier_complete(bar, b.x, nloc, nx); b.st[0] = nloc; b.st[1] = nx; }
        const unsigned old = xb_add(&bar[XB_XSUB(b.x)], 1u);
        const unsigned gen = old / nloc;
        if (old + 1u == (gen + 1u) * nloc) {
            __builtin_amdgcn_fence(__ATOMIC_RELEASE, "agent");
            asm volatile("s_waitcnt vmcnt(0)" ::: "memory");
            const unsigned og = xb_add(&bar[XB_TOP], 1u);
            const unsigned tg = og / nx;
            if (og + 1u == (tg + 1u) * nx) xb_add(&bar[XB_TOPGEN], 1u);
            else XB_SPIN(xb_ld(&bar[XB_TOPGEN]) == tg, bar);
            __builtin_amdgcn_fence(__ATOMIC_ACQUIRE, "agent");
            xb_add(&bar[XB_XGEN(b.x)], 1u);
            asm volatile("s_waitcnt vmcnt(0)" ::: "memory");
        } else {
            XB_SPIN(xb_ld(&bar[XB_XGEN(b.x)]) == gen, bar);
            __builtin_amdgcn_fence(__ATOMIC_ACQUIRE, "agent");
            asm volatile("s_waitcnt vmcnt(0)" ::: "memory");
        }
    }
    __syncthreads();
}

constexpr int CTL_BAR = 16384;
constexpr int MK_LDS = 163840;
constexpr int MK_ST_OFF = MK_LDS - 16;
static_assert(S5A_LDS + 16 * 1040 <= MK_ST_OFF - 512 && FF_LDS2 <= MK_ST_OFF - 512 && RT_LDS + 256 <= MK_ST_OFF && TB_OFF + TB_BYTES <= MK_ST_OFF && TB_OFF >= pg8::STAGE_BYTES, "LDS map");
static_assert(4 * (4096 + 4096 + 8448 + 2 * 32 * 272) <= MK_ST_OFF, "prep LDS");
#ifndef MK_REP
#define MK_REP -1
#endif
constexpr int MK_PT_OFF = MK_ST_OFF - 256;
static_assert(RT_LDS <= MK_PT_OFF && TB_OFF + TB_BYTES <= MK_PT_OFF, "LDS map (pointer table)");
DI Params ldp(const unsigned char* lds) {
    Params p; unsigned long long* d = (unsigned long long*)&p; const unsigned* t = (const unsigned*)(lds + MK_PT_OFF);
#pragma unroll
    for (int i = 0; i < 32; ++i) { const unsigned lo = __builtin_amdgcn_readfirstlane(t[2 * i]), hi = __builtin_amdgcn_readfirstlane(t[2 * i + 1]); d[i] = ((unsigned long long)hi << 32) | lo; }
    return p;
}
#define TSTAMP(i) do { if (MK_TS1 >= 0 && bid == 0 && tidx() == 0) ((unsigned long long*)(lds + MK_PT_OFF - 256))[i] = __builtin_amdgcn_s_memrealtime(); } while (0)
#define RUNPH(k, body) do { { const Params p = ldp(lds); body; } if (MK_REP == (k)) { xcd_barrier(bar); { const Params p = ldp(lds); body; } } } while (0)
#ifdef MK_ONLY
__global__ void __launch_bounds__(NT, 2) only_kernel(Params p) {
    extern __shared__ __attribute__((aligned(16))) unsigned char lds[];
    const int bid = blockIdx.x, nb = gridDim.x;
    if (MK_ONLY == 1) phaseAB_prep(p, lds, bid, nb);
    if (MK_ONLY == 2) phase1b(p, lds, bid, nb);
    if (MK_ONLY == 3) phase2a_s5(p, lds, bid, nb);
    if (MK_ONLY == 4) phase2_fft(p, lds, bid, nb);
    if (MK_ONLY == 9) phase2c_s5out(p, lds, bid, nb);
    if (MK_ONLY == 5) phase3_glu(p, lds, bid, nb);
    if (MK_ONLY == 6) phase3_fin(p, lds, bid, nb);
    if (MK_ONLY == 7) phase4_out(p, lds, bid, nb);
    if (MK_ONLY == 8) phase5_route(p, lds, bid, nb);
    if (MK_ONLY == 10) { build_tiles(p, lds); phase6_gateup(p, lds, bid, nb); }
    if (MK_ONLY == 11) { build_tiles(p, lds); phase7_down(p, lds, bid, nb); }
    if (MK_ONLY == 12) { build_tiles(p, lds); phase8_final(p, lds, bid, nb); }
}
#endif
__global__ void __launch_bounds__(NT, 2) mega_kernel(Params pk) {
    extern __shared__ __attribute__((aligned(16))) unsigned char lds[];
    const int bid = blockIdx.x, nb = gridDim.x;
    static_assert(sizeof(Params) == 256, "Params = 32 pointers");
    if (tidx() < 64) ((unsigned*)(lds + MK_PT_OFF))[tidx()] = ((const unsigned*)&pk)[tidx()];
    if (tidx() < 4) ((unsigned*)(lds + MK_ST_OFF))[tidx()] = 0u;
    __syncthreads();
    XcdBarrier bar;
    { const Params p = ldp(lds); bar = xcd_barrier_post((unsigned*)(p.ws + WS_CTL + CTL_BAR), (volatile LAS unsigned*)(lds + MK_ST_OFF)); }
    TSTAMP(0);
    TSTAMP(1);
    RUNPH(-2, phaseAB_prep(p, lds, bid, nb));     xcd_barrier(bar); TSTAMP(2);
    RUNPH(2, phase1b(p, lds, bid, nb));           xcd_barrier(bar); TSTAMP(3);
    RUNPH(3, phase2a_s5(p, lds, bid, nb));
    RUNPH(4, phase2_fft(p, lds, bid, nb));        xcd_barrier(bar); TSTAMP(4);
    RUNPH(9, phase2c_s5out(p, lds, bid, nb));     xcd_barrier(bar); TSTAMP(5);
    RUNPH(5, phase3_glu(p, lds, bid, nb));
    RUNPH(6, phase3_fin(p, lds, bid, nb));        xcd_barrier(bar); TSTAMP(6); TSTAMP(7);
    RUNPH(7, phase4_out(p, lds, bid, nb));        xcd_barrier(bar); TSTAMP(8);
    RUNPH(-2, phase5_route(p, lds, bid, nb));     xcd_barrier(bar); TSTAMP(9);
    if (MK_REP == 8) { { const Params p = ldp(lds); phase5_route(p, lds, bid, nb, false); } xcd_barrier(bar); }
    if (MK_REP == 20) { xcd_barrier(bar); xcd_barrier(bar); xcd_barrier(bar); xcd_barrier(bar); }
    RUNPH(-2, build_tiles(p, lds));
    RUNPH(10, phase6_gateup(p, lds, bid, nb));    xcd_barrier(bar); TSTAMP(10);
    RUNPH(11, phase7_down(p, lds, bid, nb));      xcd_barrier(bar); TSTAMP(11);
    if (MK_TS1 >= 0) { if (bid == 0 && tidx() == 0) { const unsigned long long* ts = (const unsigned long long*)(lds + MK_PT_OFF - 256); const Params p = ldp(lds); unsigned* o = (unsigned*)(p.ws + WS_CTL + CTL_TS);
            o[0] = (unsigned)(ts[MK_TS1 + 1] - ts[MK_TS1]); o[1] = MK_TS2 >= 0 ? (unsigned)(ts[MK_TS2 + 1] - ts[MK_TS2]) : 0u; } xcd_barrier(bar); }
    RUNPH(-2, phase8_final(p, lds, bid, nb));
}

extern "C" void kernel_launch(void* const* d_in, const int* in_sizes, int n_in, void* d_out, int out_size, void* d_ws, size_t ws_size, hipStream_t stream) {
    static int grid = 0;
    if (grid == 0) {
        if (n_in != 30 || ws_size < WS_END || out_size != NTOK * D) { fprintf(stderr, "kernel_launch: unexpected inputs (n_in %d, ws %zu, out %d)\n", n_in, ws_size, out_size); grid = -1; return; }
        int dev = 0, cus = 0, per_cu = 0;
        if (hipGetDevice(&dev) != hipSuccess || hipDeviceGetAttribute(&cus, hipDeviceAttributeMultiprocessorCount, dev) != hipSuccess) { grid = -1; return; }
        if (hipFuncSetAttribute((const void*)mega_kernel, hipFuncAttributeMaxDynamicSharedMemorySize, MK_LDS) != hipSuccess) { fprintf(stderr, "kernel_launch: hipFuncSetAttribute failed\n"); grid = -1; return; }
        if (hipOccupancyMaxActiveBlocksPerMultiprocessor(&per_cu, (const void*)mega_kernel, NT, MK_LDS) != hipSuccess || per_cu < 1) { fprintf(stderr, "kernel_launch: occupancy query says %d blocks/CU\n", per_cu); (void)hipGetLastError(); grid = -1; return; }
        grid = cus;
    }
    if (grid < 0) return;
    Params p{};
    const float** f = (const float**)&p;
    for (int i = 0; i < 30; ++i) f[i] = (const float*)d_in[i];
    p.out = (float*)d_out; p.ws = (unsigned char*)d_ws;
    (void)hipMemsetAsync((char*)d_ws + WS_CTL, 0, CTL_BYTES, stream);
    hipLaunchKernelGGL(mega_kernel, dim3(grid), dim3(NT), MK_LDS, stream, p);
}
```
